# Optimizing an MI355X kernel written in HIP

```python
import math
import numpy as np
import jax
import jax.numpy as jnp
from jax import lax

D_MODEL = 1024
BATCH = 16
SEQ = 2048
DEPTH = 2

DN_ALPHA = (2.0 * DEPTH) ** 0.25
DN_BETA = (8.0 * DEPTH) ** -0.25
LN_EPS = 1e-5
NEG = -1e30
BIG = 1e6

POOL_WINDOWS = (2, 4, 8, 16)
POOL_GROUP = D_MODEL // 8
POOL_WIDTH = POOL_GROUP * len(POOL_WINDOWS)

NSA_HEAD_DIM = 64
NSA_HEADS = D_MODEL // 128
NSA_KV_HEADS = 2
NSA_HPG = NSA_HEADS // NSA_KV_HEADS
NSA_WIDTH = NSA_HEADS * NSA_HEAD_DIM
NSA_KV_WIDTH = 3 * 2 * NSA_KV_HEADS * NSA_HEAD_DIM
CMP_LEN = 32
CMP_STRIDE = 16
CMP_HIDDEN = 2 * NSA_HEAD_DIM
SLC_LEN = 64
SLC_TOPN = 8
WIN_LEN = 512
Q_BLOCK = 128

REL_BUCKETS = 32
REL_MAX_DIST = 128

SSD_D_INNER = D_MODEL
SSD_HEAD_DIM = 64
SSD_HEADS = SSD_D_INNER // SSD_HEAD_DIM
SSD_GROUPS = 4
SSD_HPG = SSD_HEADS // SSD_GROUPS
SSD_STATE = 128
SSD_CONV = 4
SSD_CHUNK = 128
SSD_XBC = SSD_D_INNER + 2 * SSD_GROUPS * SSD_STATE
SSD_IN_WIDTH = SSD_D_INNER + SSD_XBC + SSD_HEADS

N_EXPERTS = 16
N_EXPERT_GROUPS = 4
EXPERTS_PER_GROUP = N_EXPERTS // N_EXPERT_GROUPS
TOP_K = 2
D_EXPERT = 512

IN_SPLITS = (POOL_WIDTH, NSA_WIDTH, NSA_KV_WIDTH, 3 * NSA_HEADS, SSD_IN_WIDTH, 3 * D_MODEL)
D_IN = POOL_WIDTH + NSA_WIDTH + NSA_KV_WIDTH + 3 * NSA_HEADS + SSD_IN_WIDTH + 3 * D_MODEL

kernel_name = 'hybrid_pool_nsa_ssd_moe_deepnorm'


def layer_norm(x, g, b):
    xf = x.astype(jnp.float32)
    mu = jnp.mean(xf, -1, keepdims=True)
    var = jnp.mean(jnp.square(xf - mu), -1, keepdims=True)
    return ((xf - mu) * lax.rsqrt(var + LN_EPS) * g + b).astype(x.dtype)


def rel_bucket(dist):
    n = jnp.maximum(dist, 0)
    max_exact = REL_BUCKETS // 2
    nf = jnp.maximum(n, 1).astype(jnp.float32)
    large = max_exact + (jnp.log(nf / max_exact) / math.log(REL_MAX_DIST / max_exact)
                         * (REL_BUCKETS - max_exact)).astype(jnp.int32)
    large = jnp.minimum(large, REL_BUCKETS - 1)
    return jnp.where(n < max_exact, n, large)


def masked_softmax(s, mask):
    p = jax.nn.softmax(jnp.where(mask, s.astype(jnp.float32), NEG), axis=-1)
    return p * mask


def pool_mixer(u, w_grp, scale):
    bsz, s, _ = u.shape
    uf = u.astype(jnp.float32)
    csum = jnp.concatenate([jnp.zeros_like(uf[:, :1]), jnp.cumsum(uf, axis=1)], axis=1)
    t = jnp.arange(s)
    outs = []
    for gi, w in enumerate(POOL_WINDOWS):
        sl = slice(gi * POOL_GROUP, (gi + 1) * POOL_GROUP)
        lo = jnp.maximum(t + 1 - w, 0)
        cnt = jnp.minimum(t + 1, w).astype(jnp.float32)
        mean = (csum[:, 1:, sl] - csum[:, lo, sl]) / cnt[None, :, None]
        outs.append(mean - uf[..., sl])
    r = jnp.stack(outs, axis=2).astype(u.dtype)
    y = jnp.einsum('bsgc,gcd->bsgd', r, w_grp).reshape(bsz, s, POOL_WIDTH)
    return y * scale


def nsa_mixer(q, kv, gate_logits, pe_k, w1_k, w2_k, pe_v, w1_v, w2_v, rel_bias):
    bsz, s, _ = q.shape
    G, hpg, dh = NSA_KV_HEADS, NSA_HPG, NSA_HEAD_DIM
    q = q.reshape(bsz, s, G, hpg, dh) * (dh ** -0.5)
    kv = kv.reshape(bsz, s, 3, 2, G, dh)
    k_cmp_tok, v_cmp_tok = kv[:, :, 0, 0], kv[:, :, 0, 1]
    k_slc, v_slc = kv[:, :, 1, 0], kv[:, :, 1, 1]
    k_win, v_win = kv[:, :, 2, 0], kv[:, :, 2, 1]
    gates = jax.nn.sigmoid(gate_logits.astype(jnp.float32)).reshape(bsz, s, 3, G, hpg).astype(q.dtype)
    tbl = rel_bias.astype(jnp.float32).reshape(REL_BUCKETS, G, hpg)

    n_cmp = (s - CMP_LEN) // CMP_STRIDE + 1
    cidx = np.arange(n_cmp)[:, None] * CMP_STRIDE + np.arange(CMP_LEN)[None, :]

    def compress(tok, pe, w1, w2):
        blk = tok[:, cidx] + pe[None, None, :, None, :]
        blk = blk.transpose(0, 1, 3, 2, 4).reshape(bsz, n_cmp, G, CMP_LEN * dh)
        return jax.nn.gelu(blk @ w1) @ w2

    k_c = compress(k_cmp_tok, pe_k, w1_k, w2_k)
    v_c = compress(v_cmp_tok, pe_v, w1_v, w2_v)
    cmp_end = jnp.arange(n_cmp) * CMP_STRIDE + CMP_LEN - 1

    n_slc = s // SLC_LEN
    n_top = min(SLC_TOPN, n_slc)
    c0 = np.arange(n_cmp) * CMP_STRIDE
    s0s = np.arange(n_slc) * SLC_LEN
    ov = np.clip(np.minimum(c0[:, None] + CMP_LEN, s0s[None, :] + SLC_LEN)
                 - np.maximum(c0[:, None], s0s[None, :]), 0, None) / CMP_LEN
    overlap = jnp.asarray(ov, dtype=jnp.float32)
    kb = k_slc.reshape(bsz, n_slc, SLC_LEN, G, dh).transpose(0, 3, 1, 2, 4)
    vb = v_slc.reshape(bsz, n_slc, SLC_LEN, G, dh).transpose(0, 3, 1, 2, 4)
    gather_blocks = jax.vmap(jax.vmap(lambda blocks, ids: blocks[ids]))

    pad = ((0, 0), (WIN_LEN, 0), (0, 0), (0, 0))
    k_wp = jnp.pad(k_win, pad)
    v_wp = jnp.pad(v_win, pad)
    span = WIN_LEN + Q_BLOCK
    jpos = jnp.arange(n_slc)

    def block(bi):
        st = bi * Q_BLOCK
        t = st + jnp.arange(Q_BLOCK)
        qb = lax.dynamic_slice_in_dim(q, st, Q_BLOCK, axis=1)
        gb = lax.dynamic_slice_in_dim(gates, st, Q_BLOCK, axis=1)
        dist_c = t[:, None] - cmp_end[None, :]
        sc = jnp.einsum('bqghd,bngd->bghqn', qb, k_c).astype(jnp.float32) \
            + tbl[rel_bucket(dist_c)].transpose(2, 3, 0, 1)
        p_c = masked_softmax(sc, dist_c >= 0)
        o_c = jnp.einsum('bghqn,bngd->bqghd', p_c.astype(v_c.dtype), v_c)
        imp = jnp.einsum('bghqn,nj->bgqj', p_c, overlap)
        jt = t // SLC_LEN
        valid = jpos[None, :] * SLC_LEN <= t[:, None]
        forced = (jpos[None, :] == 0) | (jpos[None, :] == jt[:, None]) | (jpos[None, :] == jt[:, None] - 1)
        imp = jnp.where(forced, BIG, jnp.where(valid, imp, -BIG))
        _, sel = lax.top_k(imp, n_top)
        k_sel = gather_blocks(kb, sel).reshape(bsz, G, Q_BLOCK, n_top * SLC_LEN, dh)
        v_sel = gather_blocks(vb, sel).reshape(bsz, G, Q_BLOCK, n_top * SLC_LEN, dh)
        kpos = (sel[..., None] * SLC_LEN + jnp.arange(SLC_LEN)).reshape(bsz, G, Q_BLOCK, n_top * SLC_LEN)
        dist_s = t[None, None, :, None] - kpos
        bias_s = jax.vmap(lambda tb, bk: tb[bk], in_axes=(1, 1), out_axes=1)(tbl, rel_bucket(dist_s))
        ss = jnp.einsum('bqghd,bgqkd->bghqk', qb, k_sel).astype(jnp.float32) + jnp.moveaxis(bias_s, -1, 2)
        p_s = masked_softmax(ss, (dist_s >= 0)[:, :, None])
        o_s = jnp.einsum('bghqk,bgqkd->bqghd', p_s.astype(v_sel.dtype), v_sel)
        kw = lax.dynamic_slice_in_dim(k_wp, st, span, axis=1)
        vw = lax.dynamic_slice_in_dim(v_wp, st, span, axis=1)
        kpos_w = st - WIN_LEN + jnp.arange(span)
        dist_w = t[:, None] - kpos_w[None, :]
        mask_w = (dist_w >= 0) & (dist_w < WIN_LEN) & (kpos_w[None, :] >= 0)
        sw = jnp.einsum('bqghd,bkgd->bghqk', qb, kw).astype(jnp.float32) \
            + tbl[rel_bucket(dist_w)].transpose(2, 3, 0, 1)
        p_w = masked_softmax(sw, mask_w)
        o_w = jnp.einsum('bghqk,bkgd->bqghd', p_w.astype(vw.dtype), vw)
        return (gb[:, :, 0, ..., None] * o_c + gb[:, :, 1, ..., None] * o_s
                + gb[:, :, 2, ..., None] * o_w)

    out = lax.map(block, jnp.arange(s // Q_BLOCK))
    return out.transpose(1, 0, 2, 3, 4, 5).reshape(bsz, s, NSA_WIDTH)


def ssd_mixer(zxbcdt, conv_w, conv_b, dt_bias, a_log, d_skip, norm_g):
    bsz, s, _ = zxbcdt.shape
    G, E, P, N, L = SSD_GROUPS, SSD_HPG, SSD_HEAD_DIM, SSD_STATE, SSD_CHUNK
    nc = s // L
    z = zxbcdt[..., :SSD_D_INNER]
    xbc = zxbcdt[..., SSD_D_INNER:SSD_D_INNER + SSD_XBC]
    dt = zxbcdt[..., SSD_D_INNER + SSD_XBC:]
    xbc = lax.conv_general_dilated(xbc, conv_w[:, None, :], window_strides=(1,),
                                   padding=[(SSD_CONV - 1, 0)],
                                   dimension_numbers=('NWC', 'WIO', 'NWC'),
                                   feature_group_count=SSD_XBC) + conv_b
    xbc = jax.nn.silu(xbc)
    xs = xbc[..., :SSD_D_INNER].reshape(bsz, s, G, E, P)
    Bc = xbc[..., SSD_D_INNER:SSD_D_INNER + G * N].reshape(bsz, nc, L, G, N)
    Cc = xbc[..., SSD_D_INNER + G * N:].reshape(bsz, nc, L, G, N)
    dt = jax.nn.softplus(dt.astype(jnp.float32) + dt_bias)
    A = -jnp.exp(a_log.astype(jnp.float32))
    a = (dt * A).reshape(bsz, nc, L, G, E)
    xdt = (xs * dt.reshape(bsz, s, G, E)[..., None]).reshape(bsz, nc, L, G, E, P)
    acs = jnp.cumsum(a, axis=2)
    acs_t = jnp.moveaxis(acs, 2, -1)
    tri = jnp.tril(jnp.ones((L, L), dtype=bool))
    seg = jnp.exp(jnp.where(tri, acs_t[..., :, None] - acs_t[..., None, :], -jnp.inf))
    cb = jnp.einsum('bclgn,bcsgn->bcgls', Cc, Bc)
    y_diag = jnp.einsum('bcgls,bcgels,bcsgep->bclgep', cb, seg, xdt)
    decay_in = jnp.exp(acs[:, :, -1:] - acs)
    states = jnp.einsum('bclgn,bclge,bclgep->bcgepn', Bc, decay_in, xdt)
    chunk_decay = jnp.exp(acs[:, :, -1])

    def step(h, inp):
        dec, st = inp
        return dec[..., None, None] * h + st, h

    _, h_in = lax.scan(step, jnp.zeros_like(states[:, 0]),
                       (jnp.moveaxis(chunk_decay, 1, 0), jnp.moveaxis(states, 1, 0)))
    h_in = jnp.moveaxis(h_in, 0, 1)
    y_off = jnp.einsum('bclgn,bcgepn,bclge->bclgep', Cc, h_in, jnp.exp(acs))
    y = (y_diag + y_off).reshape(bsz, s, G, E, P) + xs * d_skip.reshape(G, E)[..., None]
    y = y.reshape(bsz, s, SSD_D_INNER) * jax.nn.silu(z.astype(jnp.float32))
    yg = y.reshape(bsz, s, SSD_GROUPS, -1)
    yg = yg * lax.rsqrt(jnp.mean(yg * yg, -1, keepdims=True) + LN_EPS)
    return (yg.reshape(bsz, s, SSD_D_INNER) * norm_g).astype(zxbcdt.dtype)


def moe(x, router_w, router_b, w1, w3, w2):
    bsz, s, d = x.shape
    xt = x.reshape(-1, d)
    probs = jax.nn.softmax((xt @ router_w).astype(jnp.float32), axis=-1)
    sel_score = (probs + router_b).reshape(-1, N_EXPERT_GROUPS, EXPERTS_PER_GROUP)
    grp_score = jnp.sum(lax.top_k(sel_score, TOP_K)[0], axis=-1)
    grp = jnp.argmax(grp_score, axis=-1)
    in_grp = grp[:, None] == jnp.arange(N_EXPERT_GROUPS)[None, :]
    masked = jnp.where(in_grp[..., None], sel_score, -jnp.inf).reshape(-1, N_EXPERTS)
    _, idx = lax.top_k(masked, TOP_K)
    wsel = jnp.take_along_axis(probs, idx, axis=-1)
    wsel = wsel / jnp.sum(wsel, -1, keepdims=True)
    combine = jnp.sum(jax.nn.one_hot(idx, N_EXPERTS, dtype=jnp.float32) * wsel[..., None], axis=1)
    y = jnp.zeros(xt.shape, jnp.float32)
    for e in range(N_EXPERTS):
        h = jax.nn.silu(xt @ w1[e]) * (xt @ w3[e])
        y = y + combine[:, e:e + 1] * (h @ w2[e])
    return y.reshape(bsz, s, d).astype(x.dtype)


def setup_inputs(seed: int = 0) -> dict:
    key = jax.random.key(seed)
    ks = iter(jax.random.split(key, 40))

    def nrm(shape, scale):
        return scale * jax.random.normal(next(ks), shape, jnp.float32)

    Ld = DEPTH
    dt0 = jnp.exp(jax.random.uniform(next(ks), (Ld, SSD_HEADS), jnp.float32)
                  * (math.log(0.1) - math.log(0.001)) + math.log(0.001))
    return {
        'x': nrm((BATCH, SEQ, D_MODEL), 1.0),
        'ln0_g': 1.0 + nrm((D_MODEL,), 0.1),
        'ln0_b': nrm((D_MODEL,), 0.02),
        'w_in': nrm((Ld, D_MODEL, D_IN), D_MODEL ** -0.5),
        'pool_w': nrm((Ld, len(POOL_WINDOWS), POOL_GROUP, POOL_GROUP), POOL_GROUP ** -0.5),
        'pool_scale': 1.0 + nrm((Ld, POOL_WIDTH), 0.1),
        'cmp_k_pe': nrm((Ld, CMP_LEN, NSA_HEAD_DIM), 0.1),
        'cmp_k_w1': nrm((Ld, CMP_LEN * NSA_HEAD_DIM, CMP_HIDDEN), (CMP_LEN * NSA_HEAD_DIM) ** -0.5),
        'cmp_k_w2': nrm((Ld, CMP_HIDDEN, NSA_HEAD_DIM), CMP_HIDDEN ** -0.5),
        'cmp_v_pe': nrm((Ld, CMP_LEN, NSA_HEAD_DIM), 0.1),
        'cmp_v_w1': nrm((Ld, CMP_LEN * NSA_HEAD_DIM, CMP_HIDDEN), (CMP_LEN * NSA_HEAD_DIM) ** -0.5),
        'cmp_v_w2': nrm((Ld, CMP_HIDDEN, NSA_HEAD_DIM), CMP_HIDDEN ** -0.5),
        'rel_bias': nrm((REL_BUCKETS, NSA_HEADS), 0.3),
        'conv_w': nrm((Ld, SSD_CONV, SSD_XBC), SSD_CONV ** -0.5),
        'conv_b': nrm((Ld, SSD_XBC), 0.02),
        'dt_bias': dt0 + jnp.log(-jnp.expm1(-dt0)),
        'a_log': jnp.log(jax.random.uniform(next(ks), (Ld, SSD_HEADS), jnp.float32, 1.0, 16.0)),
        'd_skip': 1.0 + nrm((Ld, SSD_HEADS), 0.1),
        'ssd_norm_g': 1.0 + nrm((Ld, SSD_D_INNER), 0.1),
        'w_br_pool': nrm((Ld, POOL_WIDTH, D_MODEL), POOL_WIDTH ** -0.5),
        'w_br_nsa': nrm((Ld, NSA_WIDTH, D_MODEL), NSA_WIDTH ** -0.5),
        'w_br_ssd': nrm((Ld, SSD_D_INNER, D_MODEL), SSD_D_INNER ** -0.5),
        'w_out': nrm((Ld, D_MODEL, D_MODEL), DN_BETA * D_MODEL ** -0.5),
        'ln1_g': 1.0 + nrm((Ld, D_MODEL), 0.1),
        'ln1_b': nrm((Ld, D_MODEL), 0.02),
        'router_w': nrm((D_MODEL, N_EXPERTS), D_MODEL ** -0.5),
        'router_b': nrm((N_EXPERTS,), 0.01),
        'exp_w1': nrm((Ld, N_EXPERTS, D_MODEL, D_EXPERT), D_MODEL ** -0.5),
        'exp_w3': nrm((Ld, N_EXPERTS, D_MODEL, D_EXPERT), D_MODEL ** -0.5),
        'exp_w2': nrm((Ld, N_EXPERTS, D_EXPERT, D_MODEL), DN_BETA * D_EXPERT ** -0.5),
        'ln2_g': 1.0 + nrm((Ld, D_MODEL), 0.1),
        'ln2_b': nrm((Ld, D_MODEL), 0.02),
    }


def reference(x, ln0_g, ln0_b, w_in, pool_w, pool_scale, cmp_k_pe, cmp_k_w1, cmp_k_w2,
              cmp_v_pe, cmp_v_w1, cmp_v_w2, rel_bias, conv_w, conv_b, dt_bias, a_log, d_skip,
              ssd_norm_g, w_br_pool, w_br_nsa, w_br_ssd, w_out, ln1_g, ln1_b, router_w, router_b,
              exp_w1, exp_w3, exp_w2, ln2_g, ln2_b):
    split_points = np.cumsum(IN_SPLITS)[:-1].tolist()
    h = layer_norm(x, ln0_g, ln0_b)
    for i in range(DEPTH):
        proj = h @ w_in[i]
        u_pool, u_q, u_kv, u_ng, u_ssd, u_gate = jnp.split(proj, split_points, axis=-1)
        br_a = pool_mixer(u_pool, pool_w[i], pool_scale[i]) @ w_br_pool[i]
        br_b = nsa_mixer(u_q, u_kv, u_ng, cmp_k_pe[i], cmp_k_w1[i], cmp_k_w2[i],
                         cmp_v_pe[i], cmp_v_w1[i], cmp_v_w2[i], rel_bias) @ w_br_nsa[i]
        br_c = ssd_mixer(u_ssd, conv_w[i], conv_b[i], dt_bias[i], a_log[i], d_skip[i],
                         ssd_norm_g[i]) @ w_br_ssd[i]
        g_a, g_b, g_c = jnp.split(jax.nn.sigmoid(u_gate), 3, axis=-1)
        mix = (g_a * br_a + g_b * br_b + g_c * br_c) @ w_out[i]
        h = layer_norm(DN_ALPHA * h + mix, ln1_g[i], ln1_b[i])
        h = layer_norm(DN_ALPHA * h + moe(h, router_w, router_b, exp_w1[i], exp_w3[i], exp_w2[i]),
                       ln2_g[i], ln2_b[i])
    return h
```

```cpp
#include <hip/hip_runtime.h>
#include <cstdio>
#include <cstdint>

#define LAS __attribute__((address_space(3)))
#define GAS __attribute__((address_space(1)))
typedef unsigned short bf16_t;
typedef short bf16x8 __attribute__((ext_vector_type(8)));
typedef short s16x4 __attribute__((ext_vector_type(4)));
typedef float f32x2 __attribute__((ext_vector_type(2)));
typedef float f32x4 __attribute__((ext_vector_type(4)));
typedef float f32x16 __attribute__((ext_vector_type(16)));
typedef unsigned u32x2 __attribute__((ext_vector_type(2)));
typedef unsigned u32x4 __attribute__((ext_vector_type(4)));

constexpr int T_ = 32768, SEQ = 2048, DM = 1024, NBATCH = 16, DEPTH = 2;
constexpr int NG = 2, BG = NBATCH / NG, TG = T_ / NG;
constexpr int LDP = 5120;
constexpr int C_POOL = 0, C_Q = 512, C_KV = 1024, C_Z = 1792, C_XBC = 2816, C_NG = 4864, C_DT = 4888;
constexpr int D_IN = 7976;
constexpr float LN_EPS = 1e-5f, DN_ALPHA = 1.41421356237f, LOG2E = 1.4426950408889634f;
constexpr float QSCALE = 0.125f * LOG2E;
constexpr float NEGBIG = -1e30f;
constexpr int MOE_ROWS = 69632;

constexpr size_t MiB = 1ull << 20;
constexpr size_t WS_CTL = 0, CTL_ZERO_BYTES = 65536;
constexpr size_t WS_MISC = 1 * MiB;
constexpr size_t WS_W = 8 * MiB, W_LAYER = 72 * MiB;
constexpr size_t WO_IN = 0, WO_GATE = 10 * MiB, WO_C = 16 * MiB, WO_NSA = 17 * MiB, WO_SSD = 18 * MiB, WO_OUT = 20 * MiB, WO_W1 = 22 * MiB, WO_W2 = 23 * MiB, WO_UP = 24 * MiB, WO_DN = 56 * MiB;
constexpr size_t WS_H = 152 * MiB, WS_PRE1 = 216 * MiB, WS_ARENA = 280 * MiB;
constexpr size_t AR_P = 0, AR_GATES = 0, AR_MIXIN = 96 * MiB;
constexpr size_t AR_XS = 0, AR_HID = 136 * MiB;
constexpr size_t WS_END = 484 * MiB;
constexpr size_t DO_XC = 0, DO_TMP = 0, DO_YC = 64 * MiB, DO_R = 96 * MiB, DO_YB = 112 * MiB;
constexpr size_t MI_BIAS = 0, MI_B1 = 4096, MI_KC = 65536, MI_VC = MI_KC + 262144, MI_ROUTE = 1 * MiB, MI_RINFO = 2 * MiB;
constexpr int CW_BAR = 4096, CW_WQ = 8192, CW_CNT = 12288;
constexpr int LDS_TOTAL = 147456, LDSX = 131072;
constexpr int LX_BAR = 0, LX_WQ = 16, LX_OFF = 64, LX_TILE = 256, LX_CNTL = 1536, LX_BASE = 1600, LX_ROWS = 2048;

__device__ __forceinline__ float bflo(unsigned u) { return __uint_as_float(u << 16); }
__device__ __forceinline__ float bfhi(unsigned u) { return __uint_as_float(u & 0xffff0000u); }
__device__ __forceinline__ float bf1(bf16_t b) { return __uint_as_float(((unsigned)b) << 16); }
typedef __bf16 bf16x2_t __attribute__((ext_vector_type(2)));
__device__ __forceinline__ unsigned cvt_pk_bf16(float lo, float hi) { const f32x2 v = {lo, hi}; const bf16x2_t b = __builtin_convertvector(v, bf16x2_t); return __builtin_bit_cast(unsigned, b); }
__device__ __forceinline__ bf16_t f2bf(float f) { return (bf16_t)(cvt_pk_bf16(f, 0.f) & 0xffffu); }
__device__ __forceinline__ float fexp2(float x) { return __builtin_amdgcn_exp2f(x); }
__device__ __forceinline__ float frcp(float x) { return __builtin_amdgcn_rcpf(x); }
__device__ __forceinline__ float sigmoidf_(float x) { return frcp(1.f + fexp2(-x * LOG2E)); }
__device__ __forceinline__ float siluf_(float x) { return x * sigmoidf_(x); }
__device__ __forceinline__ float wave_sum(float v) {
#pragma unroll
    for (int o = 1; o < 64; o <<= 1) v += __shfl_xor(v, o);
    return v;
}
__device__ __forceinline__ void unpack8(const u32x4 v, float (&x)[8]) {
    x[0] = bflo(v.x); x[1] = bfhi(v.x); x[2] = bflo(v.y); x[3] = bfhi(v.y); x[4] = bflo(v.z); x[5] = bfhi(v.z); x[6] = bflo(v.w); x[7] = bfhi(v.w);
}
__device__ __forceinline__ u32x4 pack8(const float (&x)[8]) {
    u32x4 w; w.x = cvt_pk_bf16(x[0], x[1]); w.y = cvt_pk_bf16(x[2], x[3]); w.z = cvt_pk_bf16(x[4], x[5]); w.w = cvt_pk_bf16(x[6], x[7]); return w;
}
#define LDS_WAIT() asm volatile("s_waitcnt lgkmcnt(0)" ::: "memory")
__device__ __forceinline__ int crow(int r, int hi) { return (r & 3) + 8 * (r >> 2) + 4 * hi; }
__device__ __forceinline__ f32x16 mfma32(bf16x8 a, bf16x8 b, f32x16 c) { return __builtin_amdgcn_mfma_f32_32x32x16_bf16(a, b, c, 0, 0, 0); }
__device__ __forceinline__ f32x4 mfma16(bf16x8 a, bf16x8 b, f32x4 c) { return __builtin_amdgcn_mfma_f32_16x16x32_bf16(a, b, c, 0, 0, 0); }
typedef short v4i16_t __attribute__((ext_vector_type(4)));
__device__ __forceinline__ s16x4 trrd(const LAS unsigned char* p) { return __builtin_bit_cast(s16x4, __builtin_amdgcn_ds_read_tr16_b64_v4i16((LAS v4i16_t*)p)); }
__device__ __forceinline__ bf16x8 cat8(s16x4 lo, s16x4 hi) { return (bf16x8){lo[0], lo[1], lo[2], lo[3], hi[0], hi[1], hi[2], hi[3]}; }

namespace pg8 {
constexpr int BM = 256, BK = 64, HALF = 128, HTB = HALF * BK * 2, STAGE_BYTES = 8 * HTB, NXCD = 8, WGM = 8;
__host__ __device__ __forceinline__ int lds_byte(int r, int c) { const int st = (r >> 4) * 2 + (c >> 5), rr = r & 15, cc = c & 31, ob = rr * 64 + cc * 2; return st * 1024 + (ob ^ (((ob >> 9) & 1) << 5)); }
__host__ __device__ __forceinline__ void stage_rc(int b, int& R, int& C) { const int st = b / 1024, sb = b % 1024, swz = sb ^ (((sb >> 9) & 1) << 5); R = (st >> 1) * 16 + swz / 64; C = (st & 1) * 32 + (swz % 64) / 2; }
__host__ __device__ __forceinline__ int perm32(int rho) { const int n = rho >> 4, i = rho & 15; return 8 * (i >> 2) + 4 * n + (i & 3); }

struct Unit { int pm, pn; long ab, bb; };
struct Gemm { const bf16_t* A; const bf16_t* Bt; int lda, ldb, K; };

struct StaticOrder {
    int nM, nN, nwg, G, c; long tsA, tsB;
    __device__ void init(int M, int N, int lda, int ldb, int G_, int c_) { nM = M / BM; nN = N / BM; nwg = nM * nN; G = G_; c = c_; tsA = (long)BM * lda * 2; tsB = (long)BM * ldb * 2; }
    __device__ bool next(int i, Unit& u) const {
        const long L = (long)i * G + c; if (L >= nwg) return false;
        int wgid = (int)L; { const int q = nwg / NXCD, r = nwg % NXCD, xcd = wgid % NXCD, off = wgid / NXCD; wgid = (xcd < r ? xcd * (q + 1) : r * (q + 1) + (xcd - r) * q) + off; }
        const int nig = WGM * nN, gid = wgid / nig, fm = gid * WGM, gsz = (nM - fm) < WGM ? (nM - fm) : WGM;
        u.pm = fm + ((wgid % nig) % gsz); u.pn = (wgid % nig) / gsz; u.ab = u.pm * tsA; u.bb = u.pn * tsB; return true;
    }
};
struct GateOrder {
    StaticOrder so;
    __device__ bool next(int i, Unit& u) const { const int base = i / 3, x = i - 3 * base; if (!so.next(base, u)) return false; u.pn += 4 * x; u.bb = u.pn * so.tsB; return true; }
};
struct MoeOrder {
    const LAS int* tile_e; int nrt, G, vcu; long tsA, tsB, eB;
    __device__ bool next(int i, Unit& u) const {
        const long L = (long)i * G + vcu; if (L >= (long)nrt * 4) return false;
        const int rt = (int)(L >> 2), pn = (int)(L & 3), e = tile_e[rt];
        u.pm = rt; u.pn = pn; u.ab = rt * tsA; u.bb = e * eB + pn * tsB; return true;
    }
};

template <class Epi, class Sched>
__device__ __forceinline__ void gemm_phase(LAS unsigned char* lds, const Gemm g, const Sched& S, const Epi& E) {
    int tid_ = threadIdx.x; asm volatile("" : "+v"(tid_));
    const int tid = tid_, wid = __builtin_amdgcn_readfirstlane(tid >> 6), lane = tid & 63, wr = wid >> 2, wc = wid & 3, fr = lane & 15, fq = lane >> 4;
    const int K = g.K, nt = K / BK;
    unsigned voffA[2], voffB[2];
#pragma unroll
    for (int i = 0; i < 2; ++i) { int R, C; stage_rc(tid * 16 + i * 8192, R, C); const int Rb = Epi::PERM ? ((R & ~31) + perm32(R & 31)) : R;
        voffA[i] = (unsigned)(R * g.lda + C) * 2u; voffB[i] = (unsigned)(Rb * g.ldb + C) * 2u; }
    const size_t kstep = (size_t)(BK * 2);
    const size_t hstepA = (size_t)HALF * g.lda * 2, hstepB = (size_t)HALF * g.ldb * 2;
    const unsigned ldsw = (unsigned)wid * 1024u;
    const int aoff = lds_byte(wr * 64 + fr, fq * 8), boff = lds_byte(wc * 32 + fr, fq * 8);
#define PG8_SA(b, h) (((b) * 2 + (h)) * HTB)
#define PG8_SB(b, h) ((4 + (b) * 2 + (h)) * HTB)
#define PG8_STAGE(bufoff, gbase, voff) do { _Pragma("unroll") for (int _i = 0; _i < 2; ++_i) \
        __builtin_amdgcn_global_load_lds((const unsigned*)((const char*)(gbase) + (voff)[_i]), (LAS unsigned*)(lds + (bufoff) + ldsw + _i * 8192), 16, 0, 0); } while (0)
#define PG8_LDA(dst, b, h) do { _Pragma("unroll") for (int m = 0; m < 4; ++m) _Pragma("unroll") for (int k = 0; k < 2; ++k) dst[m][k] = *(const LAS bf16x8*)(lds + PG8_SA(b, h) + aoff + m * 2048 + k * 1024); } while (0)
#define PG8_LDB(dst, b, h) do { _Pragma("unroll") for (int n = 0; n < 2; ++n) _Pragma("unroll") for (int k = 0; k < 2; ++k) dst[n][k] = *(const LAS bf16x8*)(lds + PG8_SB(b, h) + boff + n * 2048 + k * 1024); } while (0)
#define PG8_MMA(ai, bj, At, Bt) do { __builtin_amdgcn_s_setprio(1); _Pragma("unroll") for (int m = 0; m < 4; ++m) _Pragma("unroll") for (int n = 0; n < 2; ++n) _Pragma("unroll") for (int k = 0; k < 2; ++k) \
        acc[ai][bj][m][n] = __builtin_amdgcn_mfma_f32_16x16x32_bf16(Bt[n][k], At[m][k], acc[ai][bj][m][n], 0, 0, 0); __builtin_amdgcn_s_setprio(0); } while (0)
#define PG8_WAIT_V(n) asm volatile("s_waitcnt vmcnt(" #n ")" ::: "memory")
#define PG8_WAIT_L(n) asm volatile("s_waitcnt lgkmcnt(" #n ")" ::: "memory")
#define PG8_BAR __builtin_amdgcn_s_barrier()
#define PG8_SCHED __builtin_amdgcn_sched_barrier(0)
    Unit cur, nxt; int ui = 0;
    if (!S.next(0, cur)) return;
    f32x4 acc[2][2][4][2];
#pragma unroll
    for (int a = 0; a < 2; ++a)
#pragma unroll
        for (int b = 0; b < 2; ++b)
#pragma unroll
            for (int m = 0; m < 4; ++m)
#pragma unroll
                for (int n = 0; n < 2; ++n) acc[a][b][m][n] = (f32x4){0.f, 0.f, 0.f, 0.f};
    bf16x8 At[4][2], B0[2][2], B1[2][2];
    const char* cA = (const char*)g.A + cur.ab; const char* cB = (const char*)g.Bt + cur.bb;
    PG8_STAGE(PG8_SB(0, 0), cB, voffB); PG8_STAGE(PG8_SB(0, 1), cB + hstepB, voffB); PG8_STAGE(PG8_SA(0, 0), cA, voffA); PG8_STAGE(PG8_SA(0, 1), cA + hstepA, voffA);
    if (wr == 1) PG8_BAR;
    PG8_WAIT_V(2); PG8_BAR;
    PG8_STAGE(PG8_SB(1, 0), cB + kstep, voffB); PG8_STAGE(PG8_SA(1, 0), cA + kstep, voffA); PG8_STAGE(PG8_SB(1, 1), cB + hstepB + kstep, voffB);
    PG8_WAIT_V(6); PG8_BAR;
    for (;;) {
        const bool has_next = S.next(ui + 1, nxt);
        const char* nA = has_next ? (const char*)g.A + nxt.ab : cA; const char* nB = has_next ? (const char*)g.Bt + nxt.bb : cB;
        for (int t = 0; t < nt; t += 2) {
            const bool last = (t == nt - 2);
            const char* a1 = cA + (size_t)(t + 1) * kstep;
            const char* a2 = last ? nA : cA + (size_t)(t + 2) * kstep; const char* b2 = last ? nB : cB + (size_t)(t + 2) * kstep;
            const char* a3 = a2 + kstep; const char* b3 = b2 + kstep;
            PG8_LDB(B0, 0, 0); PG8_LDB(B1, 0, 1); PG8_SCHED; PG8_LDA(At, 0, 0); PG8_STAGE(PG8_SA(1, 1), a1 + hstepA, voffA);
            PG8_WAIT_V(8); PG8_WAIT_L(0); PG8_BAR; PG8_MMA(0, 0, At, B0); PG8_MMA(0, 1, At, B1); PG8_BAR; PG8_SCHED;
            PG8_LDA(At, 0, 1); PG8_STAGE(PG8_SB(0, 0), b2, voffB); PG8_STAGE(PG8_SB(0, 1), b2 + hstepB, voffB); PG8_STAGE(PG8_SA(0, 0), a2, voffA);
            PG8_WAIT_V(8); PG8_WAIT_L(0); PG8_BAR; PG8_MMA(1, 0, At, B0); PG8_MMA(1, 1, At, B1); PG8_BAR; PG8_SCHED;
            PG8_LDB(B0, 1, 0); PG8_LDB(B1, 1, 1); PG8_SCHED; PG8_LDA(At, 1, 0); PG8_STAGE(PG8_SA(0, 1), a2 + hstepA, voffA);
            PG8_WAIT_V(8); PG8_WAIT_L(0); PG8_BAR; PG8_MMA(0, 0, At, B0); PG8_MMA(0, 1, At, B1); PG8_BAR; PG8_SCHED;
            PG8_LDA(At, 1, 1); PG8_STAGE(PG8_SB(1, 0), b3, voffB); PG8_STAGE(PG8_SB(1, 1), b3 + hstepB, voffB); PG8_STAGE(PG8_SA(1, 0), a3, voffA);
            PG8_WAIT_V(8); PG8_WAIT_L(0); PG8_BAR; PG8_MMA(1, 0, At, B0); PG8_MMA(1, 1, At, B1); PG8_BAR; PG8_SCHED;
        }
        if (wr == 0) PG8_BAR;
        E(acc, cur, wr, wc, fr, fq);
        if (!has_next) break;
#pragma unroll
        for (int a = 0; a < 2; ++a)
#pragma unroll
            for (int b = 0; b < 2; ++b)
#pragma unroll
                for (int m = 0; m < 4; ++m)
#pragma unroll
                    for (int n = 0; n < 2; ++n) acc[a][b][m][n] = (f32x4){0.f, 0.f, 0.f, 0.f};
        cur = nxt; cA = nA; cB = nB; ++ui;
        if (wr == 1) PG8_BAR;
    }
    PG8_WAIT_V(0);
    PG8_BAR;
#undef PG8_SA
#undef PG8_SB
#undef PG8_STAGE
#undef PG8_LDA
#undef PG8_LDB
#undef PG8_MMA
#undef PG8_WAIT_V
#undef PG8_WAIT_L
#undef PG8_BAR
#undef PG8_SCHED
}

enum { EK_PROJ = 0, EK_GATE, EK_BR0, EK_BR1, EK_BR2, EK_WOUT, EK_GLU, EK_DOWN };
template <int KIND> struct Epi {
    static constexpr bool PERM = true;
    bf16_t* O; int ldo;
    const bf16_t* X; int ldx;
    float* F;
    const int2* RI;
    __device__ __forceinline__ void operator()(const f32x4 (&acc)[2][2][4][2], const Unit& u, int wr, int wc, int fr, int fq) const {
        const int row0 = u.pm * BM + wr * 64 + fr, col0 = u.pn * BM + wc * 32 + 8 * fq;
        if constexpr (KIND == EK_GLU) {
            const int hc0 = u.pn * 128 + wc * 32 + 8 * fq;
#pragma unroll
            for (int ai = 0; ai < 2; ++ai)
#pragma unroll
                for (int m = 0; m < 4; ++m) {
                    const int row = row0 + ai * HALF + m * 16; float o[8];
#pragma unroll
                    for (int n = 0; n < 2; ++n)
#pragma unroll
                        for (int j = 0; j < 4; ++j) o[4 * n + j] = siluf_(acc[ai][0][m][n][j]) * acc[ai][1][m][n][j];
                    *(u32x4*)(O + (size_t)row * ldo + hc0) = pack8(o);
                    asm volatile("" ::: "memory");
                }
        } else if constexpr (KIND == EK_DOWN) {
#pragma unroll
            for (int ai = 0; ai < 2; ++ai)
#pragma unroll
                for (int m = 0; m < 4; ++m) {
                    const int row = row0 + ai * HALF + m * 16; const int2 ri = RI[row]; const float w = __int_as_float(ri.y);
                    if (ri.x >= 0) {
#pragma unroll
                        for (int bj = 0; bj < 2; ++bj) { float o[8];
#pragma unroll
                            for (int n = 0; n < 2; ++n)
#pragma unroll
                                for (int j = 0; j < 4; ++j) o[4 * n + j] = w * acc[ai][bj][m][n][j];
                            *(u32x4*)(O + (size_t)ri.x * ldo + col0 + bj * HALF) = pack8(o); }
                    }
                    asm volatile("" ::: "memory");
                }
        } else {
            int act = 0;
            if constexpr (KIND == EK_PROJ) act = (u.pn == 2 || u.pn == 3) ? 1 : ((u.pn >= 7 && u.pn <= 10) ? 2 : 0);
#pragma unroll
            for (int ai = 0; ai < 2; ++ai)
#pragma unroll
                for (int m = 0; m < 4; ++m) {
                    const int row = row0 + ai * HALF + m * 16;
#pragma unroll
                    for (int bj = 0; bj < 2; ++bj) {
                        const int col = col0 + bj * HALF; float v[8];
#pragma unroll
                        for (int n = 0; n < 2; ++n)
#pragma unroll
                            for (int j = 0; j < 4; ++j) v[4 * n + j] = acc[ai][bj][m][n][j];
                        if constexpr (KIND == EK_PROJ) {
                            if (act == 1) {
#pragma unroll
                                for (int j = 0; j < 8; ++j) v[j] *= QSCALE;
                            } else if (act == 2) {
#pragma unroll
                                for (int j = 0; j < 8; ++j) v[j] = siluf_(v[j]);
                            }
                            *(u32x4*)(O + (size_t)row * ldo + col) = pack8(v);
                        } else if constexpr (KIND == EK_GATE) {
#pragma unroll
                            for (int j = 0; j < 8; ++j) v[j] = sigmoidf_(v[j]);
                            *(u32x4*)(O + (size_t)row * ldo + col) = pack8(v);
                        } else if constexpr (KIND == EK_BR0 || KIND == EK_BR1 || KIND == EK_BR2) {
                            float gt[8]; unpack8(*(const u32x4*)(X + (size_t)row * ldx + col), gt);
                            float* fp = F + (size_t)row * 1024 + col;
                            if constexpr (KIND == EK_BR0) {
                                *(f32x4*)fp = (f32x4){gt[0] * v[0], gt[1] * v[1], gt[2] * v[2], gt[3] * v[3]};
                                *(f32x4*)(fp + 4) = (f32x4){gt[4] * v[4], gt[5] * v[5], gt[6] * v[6], gt[7] * v[7]};
                            } else {
                                const f32x4 t0 = *(const f32x4*)fp, t1 = *(const f32x4*)(fp + 4);
                                float s[8];
#pragma unroll
                                for (int j = 0; j < 4; ++j) { s[j] = t0[j] + gt[j] * v[j]; s[4 + j] = t1[j] + gt[4 + j] * v[4 + j]; }
                                if constexpr (KIND == EK_BR1) { *(f32x4*)fp = (f32x4){s[0], s[1], s[2], s[3]}; *(f32x4*)(fp + 4) = (f32x4){s[4], s[5], s[6], s[7]}; }
                                else *(u32x4*)(O + (size_t)row * ldo + col) = pack8(s);
                            }
                        } else if constexpr (KIND == EK_WOUT) {
                            float hv[8]; unpack8(*(const u32x4*)(X + (size_t)row * ldx + col), hv);
#pragma unroll
                            for (int j = 0; j < 8; ++j) v[j] += DN_ALPHA * hv[j];
                            *(u32x4*)(O + (size_t)row * ldo + col) = pack8(v);
                        }
                        asm volatile("" ::: "memory");
                    }
                }
        }
    }
};
}

#define XB_TMO      128
#define XB_XCNT(j)  (256  + 64 * (j))
#define XB_XSUB(j)  (1280 + 64 * (j))
#define XB_XGEN(j)  (2304 + 64 * (j))
#define XB_TOP      3328
#define XB_TOPGEN   3392
#define XCD_BAR_WORDS 3456
#define XB_SPIN_CAP (1u << 20)
__device__ __forceinline__ unsigned xb_ld(unsigned* p)              { return __hip_atomic_load(p, __ATOMIC_RELAXED, __HIP_MEMORY_SCOPE_AGENT); }
__device__ __forceinline__ unsigned xb_add(unsigned* p, unsigned v) { return __hip_atomic_fetch_add(p, v, __ATOMIC_RELAXED, __HIP_MEMORY_SCOPE_AGENT); }
__device__ __forceinline__ unsigned xb_xcc_id() { return (unsigned)__builtin_amdgcn_s_getreg((3 << 11) | 20) & 0xFu; }
#define XB_SPIN(cond, bar) do { unsigned _sp = 0; while (cond) { __builtin_amdgcn_s_sleep(1); \
    if ((++_sp & 255u) == 0u) { if (xb_ld(&(bar)[XB_TMO])) break; if (_sp > XB_SPIN_CAP) { atomicAdd(&(bar)[XB_TMO], 1u); break; } } } } while (0)
struct XcdBarrier { unsigned* bar; unsigned x; volatile LAS unsigned* st; };
__device__ __forceinline__ XcdBarrier xcd_barrier_post(unsigned* bar, volatile LAS unsigned* st) {
    XcdBarrier b; b.bar = bar; b.x = xb_xcc_id(); b.st = st;
    if (threadIdx.x == 0) (void)xb_add(&bar[XB_XCNT(b.x)], 1u);
    return b;
}
__device__ __forceinline__ void xcd_barrier_complete(unsigned* bar, unsigned x, unsigned& nloc, unsigned& nx) {
    const unsigned G = gridDim.x * gridDim.y * gridDim.z;
    unsigned sum, cnt, mine, sp = 0u;
    for (;;) {
        sum = 0u; cnt = 0u; mine = 0u;
#pragma unroll
        for (unsigned j = 0; j < 16; ++j) { const unsigned c = xb_ld(&bar[XB_XCNT(j)]); sum += c; cnt += (c > 0u) ? 1u : 0u; mine = (j == x) ? c : mine; }
        if (sum == G) break;
        __builtin_amdgcn_s_sleep(1);
        if ((++sp & 255u) == 0u) { if (xb_ld(&bar[XB_TMO])) break; if (sp > XB_SPIN_CAP) { atomicAdd(&bar[XB_TMO], 1u); break; } }
    }
    nloc = mine > 0u ? mine : 1u; nx = cnt > 0u ? cnt : 1u;
}
__device__ __forceinline__ void xcd_barrier(const XcdBarrier& b) {
    asm volatile("s_waitcnt vmcnt(0)" ::: "memory");
    __syncthreads();
    if (threadIdx.x == 0) {
        unsigned* bar = b.bar;
        __builtin_amdgcn_s_waitcnt(0);
        unsigned nloc = b.st[0], nx = b.st[1];
        if (nloc == 0u) { xcd_barrier_complete(bar, b.x, nloc, nx); b.st[0] = nloc; b.st[1] = nx; }
        const unsigned old = xb_add(&bar[XB_XSUB(b.x)], 1u);
        const unsigned gen = old / nloc;
        if (old + 1u == (gen + 1u) * nloc) {
            __builtin_amdgcn_fence(__ATOMIC_RELEASE, "agent");
            asm volatile("s_waitcnt vmcnt(0)" ::: "memory");
            const unsigned og = xb_add(&bar[XB_TOP], 1u);
            const unsigned tg = og / nx;
            if (og + 1u == (tg + 1u) * nx) xb_add(&bar[XB_TOPGEN], 1u);
            else XB_SPIN(xb_ld(&bar[XB_TOPGEN]) == tg, bar);
            __builtin_amdgcn_fence(__ATOMIC_ACQUIRE, "agent");
            xb_add(&bar[XB_XGEN(b.x)], 1u);
            asm volatile("s_waitcnt vmcnt(0)" ::: "memory");
        } else {
            XB_SPIN(xb_ld(&bar[XB_XGEN(b.x)]) == gen, bar);
            __builtin_amdgcn_fence(__ATOMIC_ACQUIRE, "agent");
            asm volatile("s_waitcnt vmcnt(0)" ::: "memory");
        }
    }
    __syncthreads();
}

struct Args { const float* in[32]; float* out; unsigned char* ws; int lo, hi; };
typedef const __attribute__((address_space(4))) Args* ArgsP;
enum { I_X = 0, I_LN0G, I_LN0B, I_WIN, I_POOLW, I_POOLS, I_CKPE, I_CKW1, I_CKW2, I_CVPE, I_CVW1, I_CVW2, I_RELB, I_CONVW, I_CONVB, I_DTB, I_ALOG, I_DSKIP, I_SNG,
       I_WBP, I_WBN, I_WBS, I_WOUT, I_LN1G, I_LN1B, I_RW, I_RB, I_EW1, I_EW3, I_EW2, I_LN2G, I_LN2B };


struct Ctx {
    LAS unsigned char* lds;
    unsigned* ctl;
    unsigned char* ws; unsigned char* dout;
    int tid, lane, wave, G, vcu, gw, NGW;
};

struct Job { const float* src; size_t sbatch; int ldw, K, c0, ncols; bf16_t* dst; int dbatch_rows, ldt, drow0, mode, nbatch; };
constexpr int NJOBS = 15;
__device__ __forceinline__ Job get_job(ArgsP a, int l, int j) {
    unsigned char* wl = a->ws + WS_W + (size_t)l * W_LAYER;
    bf16_t* win = (bf16_t*)(wl + WO_IN); bf16_t* wg = (bf16_t*)(wl + WO_GATE);
    const float* w_in = a->in[I_WIN] + (size_t)l * DM * D_IN;
    Job J; J.sbatch = 0; J.dbatch_rows = 0; J.mode = 0; J.nbatch = 1; J.c0 = 0; J.drow0 = 0;
    switch (j) {
    case 0:  J.src = w_in; J.ldw = D_IN; J.K = 1024; J.c0 = 0;    J.ncols = 1792; J.dst = win; J.ldt = 1024; J.drow0 = 0; break;
    case 1:  J.src = w_in; J.ldw = D_IN; J.K = 1024; J.c0 = 1792; J.ncols = 24;   J.dst = win; J.ldt = 1024; J.drow0 = C_NG; break;
    case 2:  J.src = w_in; J.ldw = D_IN; J.K = 1024; J.c0 = 1816; J.ncols = 3072; J.dst = win; J.ldt = 1024; J.drow0 = C_Z; break;
    case 3:  J.src = w_in; J.ldw = D_IN; J.K = 1024; J.c0 = 4888; J.ncols = 16;   J.dst = win; J.ldt = 1024; J.drow0 = C_DT; break;
    case 4:  J.src = w_in; J.ldw = D_IN; J.K = 1024; J.c0 = 4904; J.ncols = 3072; J.dst = wg;  J.ldt = 1024; J.drow0 = 0; break;
    case 5:  J.src = a->in[I_WBN] + (size_t)l * 512 * 1024;  J.ldw = 1024; J.K = 512;  J.ncols = 1024; J.dst = (bf16_t*)(wl + WO_NSA); J.ldt = 512; break;
    case 6:  J.src = a->in[I_WBS] + (size_t)l * 1024 * 1024; J.ldw = 1024; J.K = 1024; J.ncols = 1024; J.dst = (bf16_t*)(wl + WO_SSD); J.ldt = 1024; break;
    case 7:  J.src = a->in[I_WOUT] + (size_t)l * 1024 * 1024; J.ldw = 1024; J.K = 1024; J.ncols = 1024; J.dst = (bf16_t*)(wl + WO_OUT); J.ldt = 1024; break;
    case 8:  J.src = a->in[I_CKW1] + (size_t)l * 2048 * 128; J.ldw = 128; J.K = 2048; J.ncols = 128; J.dst = (bf16_t*)(wl + WO_W1); J.ldt = 2048; break;
    case 9:  J.src = a->in[I_CVW1] + (size_t)l * 2048 * 128; J.ldw = 128; J.K = 2048; J.ncols = 128; J.dst = (bf16_t*)(wl + WO_W1) + 128 * 2048; J.ldt = 2048; break;
    case 10: J.src = a->in[I_CKW2] + (size_t)l * 128 * 64; J.ldw = 64; J.K = 128; J.ncols = 64; J.dst = (bf16_t*)(wl + WO_W2); J.ldt = 128; break;
    case 11: J.src = a->in[I_CVW2] + (size_t)l * 128 * 64; J.ldw = 64; J.K = 128; J.ncols = 64; J.dst = (bf16_t*)(wl + WO_W2) + 64 * 128; J.ldt = 128; break;
    case 12: J.src = a->in[I_EW1] + (size_t)l * 16 * 1024 * 512; J.sbatch = (size_t)1024 * 512; J.ldw = 512; J.K = 1024; J.ncols = 512; J.dst = (bf16_t*)(wl + WO_UP); J.dbatch_rows = 1024; J.ldt = 1024; J.drow0 = 0;   J.mode = 1; J.nbatch = 16; break;
    case 13: J.src = a->in[I_EW3] + (size_t)l * 16 * 1024 * 512; J.sbatch = (size_t)1024 * 512; J.ldw = 512; J.K = 1024; J.ncols = 512; J.dst = (bf16_t*)(wl + WO_UP); J.dbatch_rows = 1024; J.ldt = 1024; J.drow0 = 128; J.mode = 1; J.nbatch = 16; break;
    default: J.src = a->in[I_EW2] + (size_t)l * 16 * 512 * 1024; J.sbatch = (size_t)512 * 1024; J.ldw = 1024; J.K = 512; J.ncols = 1024; J.dst = (bf16_t*)(wl + WO_DN); J.dbatch_rows = 1024; J.ldt = 512; J.nbatch = 16; break;
    }
    return J;
}
__device__ __forceinline__ void tr_item(const Job& J, int item, LAS float* scr, int lane) {
    const int nblk = (J.ncols + 31) >> 5, kblk = J.K >> 6, per = nblk * kblk;
    const int bt = item / per, r = item - bt * per, kb = r / nblk, nb = r - kb * nblk, k0 = 64 * kb, n0 = 32 * nb;
    const int nv = (J.ncols - n0) < 32 ? (J.ncols - n0) : 32;
    const float* W = J.src + (size_t)bt * J.sbatch;
#pragma unroll 8
    for (int i = 0; i < 32; ++i) { const int kk = 2 * i + (lane >> 5), nn = lane & 31;
        scr[kk * 33 + nn] = (nn < nv) ? W[(size_t)(k0 + kk) * J.ldw + J.c0 + n0 + nn] : 0.f; }
    LDS_WAIT();
    const int c = lane & 7;
#pragma unroll
    for (int j = 0; j < 4; ++j) { const int n = (lane >> 3) + 8 * j;
        if (n < nv) {
            const LAS float* s = scr + (8 * c) * 33 + n; const int nn = n0 + n;
            const int drow = bt * J.dbatch_rows + J.drow0 + (J.mode == 1 ? ((nn >> 7) * 256 + (nn & 127)) : nn);
            u32x4 o; o.x = cvt_pk_bf16(s[0 * 33], s[1 * 33]); o.y = cvt_pk_bf16(s[2 * 33], s[3 * 33]); o.z = cvt_pk_bf16(s[4 * 33], s[5 * 33]); o.w = cvt_pk_bf16(s[6 * 33], s[7 * 33]);
            *(u32x4*)(J.dst + (size_t)drow * J.ldt + k0 + 8 * c) = o; } }
    LDS_WAIT();
}
__device__ __forceinline__ void ln_row_f32(const float* xrow, const float* g, const float* b, bf16_t* orow, int lane) {
    const f32x4* xr = (const f32x4*)xrow + lane; f32x4 v[4]; float s = 0.f;
#pragma unroll
    for (int j = 0; j < 4; ++j) { v[j] = xr[64 * j]; s += (v[j].x + v[j].y) + (v[j].z + v[j].w); }
    const float mean = wave_sum(s) * (1.f / DM); float s2 = 0.f;
#pragma unroll
    for (int j = 0; j < 4; ++j) { v[j] = v[j] - mean; s2 += (v[j].x * v[j].x + v[j].y * v[j].y) + (v[j].z * v[j].z + v[j].w * v[j].w); }
    const float rstd = 1.f / sqrtf(wave_sum(s2) * (1.f / DM) + LN_EPS);
    u32x2* o8 = (u32x2*)orow + lane;
#pragma unroll
    for (int j = 0; j < 4; ++j) { const f32x4 gg = ((const f32x4*)g + lane)[64 * j], bb = ((const f32x4*)b + lane)[64 * j];
        u32x2 w; w.x = cvt_pk_bf16(v[j].x * rstd * gg.x + bb.x, v[j].y * rstd * gg.y + bb.y); w.y = cvt_pk_bf16(v[j].z * rstd * gg.z + bb.z, v[j].w * rstd * gg.w + bb.w); o8[64 * j] = w; }
}
__device__ __forceinline__ int rel_bucket_dev(int n) {
    if (n < 16) return n;
    int b = 16;
    b += (n >= 19) + (n >= 21) + (n >= 24) + (n >= 27) + (n >= 31) + (n >= 35) + (n >= 40) + (n >= 46) + (n >= 52) + (n >= 59) + (n >= 67) + (n >= 77) + (n >= 87) + (n >= 99) + (n >= 113);
    return b;
}
__device__ __forceinline__ void p0_prologue(const Ctx& F, ArgsP a) {
    LAS float* scr = (LAS float*)(F.lds + F.wave * 16384);
    int base = 0;
    for (int l = 0; l < DEPTH; ++l)
        for (int j = 0; j < NJOBS; ++j) {
            const Job J = get_job(a, l, j);
            const int nitems = J.nbatch * (J.K >> 6) * ((J.ncols + 31) >> 5);
            int first = (F.gw - base) % F.NGW; if (first < 0) first += F.NGW;
            for (int it = first; it < nitems; it += F.NGW) tr_item(J, it, scr, F.lane);
            base = (base + nitems) % F.NGW;
        }
    { bf16_t* H = (bf16_t*)(a->ws + WS_H);
      for (int m = F.gw; m < T_; m += F.NGW) ln_row_f32(a->in[I_X] + (size_t)m * DM, a->in[I_LN0G], a->in[I_LN0B], H + (size_t)m * DM, F.lane); }
    { const int gt = blockIdx.x * 512 + F.tid, nthr = F.G * 512;
      for (int id = gt; id < DEPTH * 65536; id += nthr) {
          const int l = id >> 16, r = id & 65535, n = r & 1023, k8 = r >> 10, g = k8 >> 4, c0 = (k8 & 15) * 8;
          const float* pw = a->in[I_POOLW] + (size_t)l * 4 * 128 * 128 + (size_t)(g * 128 + c0) * 128;
          const float* sc = a->in[I_POOLS] + l * 512 + g * 128;
          const float* wb = a->in[I_WBP] + (size_t)l * 512 * 1024 + (size_t)(g * 128) * 1024 + n;
          float acc[8] = {0.f, 0.f, 0.f, 0.f, 0.f, 0.f, 0.f, 0.f};
          for (int d = 0; d < 128; ++d) { const float w = wb[(size_t)d * 1024] * sc[d];
#pragma unroll
              for (int i = 0; i < 8; ++i) acc[i] += pw[i * 128 + d] * w; }
          bf16_t* dst = (bf16_t*)(a->ws + WS_W + (size_t)l * W_LAYER + WO_C) + (size_t)n * 512 + g * 128 + c0;
          *(u32x4*)dst = pack8(acc);
      } }
    for (int o = F.gw; o < DEPTH * 2 * 128; o += F.NGW) {
        const int l = o >> 8, kv = (o >> 7) & 1, col = o & 127;
        const float* pe = a->in[kv ? I_CVPE : I_CKPE] + (size_t)l * 2048; const float* w1 = a->in[kv ? I_CVW1 : I_CKW1] + (size_t)l * 2048 * 128 + col;
        float s = 0.f;
        for (int k = F.lane; k < 2048; k += 64) s += pe[k] * w1[(size_t)k * 128];
        s = wave_sum(s);
        if (F.lane == 0) ((float*)(a->ws + WS_MISC + MI_B1))[o] = s;
    }
    if (blockIdx.x == 0) {
        float* bt = (float*)(a->ws + WS_MISC + MI_BIAS);
        for (int i = F.tid; i < 8 * 128; i += 512) { const int hd = i >> 7, d = i & 127;
            bt[i] = (a->in[I_RELB][rel_bucket_dev(d) * 8 + hd] - a->in[I_RELB][31 * 8 + hd]) * LOG2E; }
    }
}

__device__ __forceinline__ void conv_phase(const Ctx& F, const bf16_t* P, bf16_t* XC, const float* cw, const float* cb) {
    const int gt = blockIdx.x * 512 + F.tid, nthr = F.G * 512;
    const int c = gt & 255;
    float w[4][8], b[8];
#pragma unroll
    for (int k = 0; k < 4; ++k)
#pragma unroll
        for (int i = 0; i < 8; ++i) w[k][i] = cw[k * 2048 + 8 * c + i];
#pragma unroll
    for (int i = 0; i < 8; ++i) b[i] = cb[8 * c + i];
    for (int id = gt; id < TG * 256; id += nthr) {
        const int tl = id >> 8, s = tl & (SEQ - 1);
        float acc[8];
#pragma unroll
        for (int i = 0; i < 8; ++i) acc[i] = b[i];
#pragma unroll
        for (int k = 0; k < 4; ++k) {
            if (s - 3 + k >= 0) { float x[8]; unpack8(*(const u32x4*)(P + (size_t)(tl - 3 + k) * LDP + C_XBC + 8 * c), x);
#pragma unroll
                for (int i = 0; i < 8; ++i) acc[i] += w[k][i] * x[i]; }
        }
#pragma unroll
        for (int i = 0; i < 8; ++i) acc[i] = siluf_(acc[i]);
        *(u32x4*)(XC + (size_t)tl * 2048 + 8 * c) = pack8(acc);
    }
}
__device__ __forceinline__ void compress_unit(const Ctx& F, int cu, const bf16_t* P, const bf16_t* W1t, const bf16_t* W2t, const float* b1, bf16_t* KC, bf16_t* VC) {
    const int kv = cu & 1, g = (cu >> 1) & 1, nb = (cu >> 2) & 3, bl = cu >> 4;
    const int lane = F.lane, w = F.wave, fr = lane & 15, fq = lane >> 4;
    LAS bf16_t* hid = (LAS bf16_t*)F.lds;
    const bf16_t* w1 = W1t + (size_t)kv * 128 * 2048 + (size_t)(16 * w + fr) * 2048 + 8 * fq;
    int n0 = nb * 32 + fr, n1 = n0 + 16; if (n0 > 126) n0 = 126; if (n1 > 126) n1 = 126;
    const bf16_t* a0 = P + (size_t)(bl * SEQ + 16 * n0) * LDP + C_KV + kv * 128 + g * 64 + 8 * fq;
    const bf16_t* a1 = P + (size_t)(bl * SEQ + 16 * n1) * LDP + C_KV + kv * 128 + g * 64 + 8 * fq;
    f32x4 acc0 = {0.f, 0.f, 0.f, 0.f}, acc1 = {0.f, 0.f, 0.f, 0.f};
#pragma unroll 4
    for (int kk = 0; kk < 64; ++kk) {
        const int l = kk >> 1, d = (kk & 1) * 32;
        const bf16x8 bb = *(const bf16x8*)(w1 + kk * 32);
        const bf16x8 x0 = *(const bf16x8*)(a0 + (size_t)l * LDP + d), x1 = *(const bf16x8*)(a1 + (size_t)l * LDP + d);
        acc0 = mfma16(x0, bb, acc0); acc1 = mfma16(x1, bb, acc1);
    }
    const float bias = b1[kv * 128 + 16 * w + fr];
#pragma unroll
    for (int r = 0; r < 4; ++r) {
        float x = acc0[r] + bias, u = 0.7978845608f * (x + 0.044715f * x * x * x); hid[(4 * fq + r) * 136 + 16 * w + fr] = f2bf(x * sigmoidf_(2.f * u));
        x = acc1[r] + bias; u = 0.7978845608f * (x + 0.044715f * x * x * x); hid[(16 + 4 * fq + r) * 136 + 16 * w + fr] = f2bf(x * sigmoidf_(2.f * u));
    }
    __syncthreads();
    { const int mt = w >> 2, ntl = w & 3; f32x4 acc = {0.f, 0.f, 0.f, 0.f};
      const bf16_t* w2 = W2t + (size_t)kv * 64 * 128 + (size_t)(16 * ntl + fr) * 128 + 8 * fq;
#pragma unroll
      for (int ks = 0; ks < 4; ++ks) { const bf16x8 aa = *(const LAS bf16x8*)(hid + (mt * 16 + fr) * 136 + ks * 32 + 8 * fq); const bf16x8 bb = *(const bf16x8*)(w2 + ks * 32); acc = mfma16(aa, bb, acc); }
      bf16_t* dst = kv ? VC : KC;
#pragma unroll
      for (int r = 0; r < 4; ++r) { const int n = nb * 32 + mt * 16 + 4 * fq + r; if (n < 127) dst[(size_t)(bl * 128 + n) * 128 + g * 64 + 16 * ntl + fr] = f2bf(acc[r]); }
    }
    __syncthreads();
}

__device__ __forceinline__ void fin_phase(const Ctx& F, const bf16_t* P, bf16_t* R, bf16_t* Y, const float* normg) {
    { const int gt = blockIdx.x * 512 + F.tid, nthr = F.G * 512;
      for (int id = gt; id < TG * 64; id += nthr) {
          const int tl = id >> 6, c = id & 63, win = 2 << (c >> 4), s = tl & (SEQ - 1), cnt = (s + 1) < win ? (s + 1) : win;
          float sum[8] = {0.f, 0.f, 0.f, 0.f, 0.f, 0.f, 0.f, 0.f}, u0[8];
          unpack8(*(const u32x4*)(P + (size_t)tl * LDP + C_POOL + 8 * c), u0);
#pragma unroll
          for (int i = 0; i < 8; ++i) sum[i] = u0[i];
          for (int j = 1; j < cnt; ++j) { float x[8]; unpack8(*(const u32x4*)(P + (size_t)(tl - j) * LDP + C_POOL + 8 * c), x);
#pragma unroll
              for (int i = 0; i < 8; ++i) sum[i] += x[i]; }
          const float inv = 1.f / (float)cnt;
#pragma unroll
          for (int i = 0; i < 8; ++i) sum[i] = sum[i] * inv - u0[i];
          *(u32x4*)(R + (size_t)tl * 512 + 8 * c) = pack8(sum);
      } }
    for (int tl = F.gw; tl < TG; tl += F.NGW) {
        const int lane = F.lane; float y[16], z[16];
        { float t[8]; unpack8(*(const u32x4*)(Y + (size_t)tl * 1024 + 16 * lane), t);
#pragma unroll
          for (int i = 0; i < 8; ++i) y[i] = t[i];
          unpack8(*(const u32x4*)(Y + (size_t)tl * 1024 + 16 * lane + 8), t);
#pragma unroll
          for (int i = 0; i < 8; ++i) y[8 + i] = t[i];
          unpack8(*(const u32x4*)(P + (size_t)tl * LDP + C_Z + 16 * lane), t);
#pragma unroll
          for (int i = 0; i < 8; ++i) z[i] = t[i];
          unpack8(*(const u32x4*)(P + (size_t)tl * LDP + C_Z + 16 * lane + 8), t);
#pragma unroll
          for (int i = 0; i < 8; ++i) z[8 + i] = t[i]; }
        float ss = 0.f;
#pragma unroll
        for (int i = 0; i < 16; ++i) { y[i] *= z[i]; ss += y[i] * y[i]; }
        ss += __shfl_xor(ss, 1); ss += __shfl_xor(ss, 2); ss += __shfl_xor(ss, 4); ss += __shfl_xor(ss, 8);
        const float rstd = 1.f / sqrtf(ss * (1.f / 256.f) + LN_EPS);
        float o[8];
#pragma unroll
        for (int i = 0; i < 8; ++i) o[i] = y[i] * rstd * normg[16 * lane + i];
        *(u32x4*)(Y + (size_t)tl * 1024 + 16 * lane) = pack8(o);
#pragma unroll
        for (int i = 0; i < 8; ++i) o[i] = y[8 + i] * rstd * normg[16 * lane + 8 + i];
        *(u32x4*)(Y + (size_t)tl * 1024 + 16 * lane + 8) = pack8(o);
    }
}

constexpr int NL_KT = 0, NL_VT = 16384, NL_BIAS = 32768, NL_IMP = 34816, NL_SEL = 68608, NL_UNI = 68864;

#define NSA_STORE_TILE(buf) do { \
    *(LAS u32x4*)(lds + NL_KT + (buf) * 8192 + (tid >> 6) * 1024 + (tid & 63) * 16) = kreg; \
    *(LAS u32x4*)(lds + NL_VT + (buf) * 8192 + ((tid & 7) >> 2) * 4096 + (tid >> 3) * 64 + (tid & 3) * 16) = vreg; } while (0)

__device__ __forceinline__ void nsa_qk(const LAS unsigned char* Kt, const bf16x8 (&qB)[4], int r32, int hi, f32x16& p0, f32x16& p1) {
    p0 = (f32x16){0.f, 0.f, 0.f, 0.f, 0.f, 0.f, 0.f, 0.f, 0.f, 0.f, 0.f, 0.f, 0.f, 0.f, 0.f, 0.f}; p1 = p0;
#pragma unroll
    for (int d0 = 0; d0 < 4; ++d0) {
        const bf16x8 k0 = *(const LAS bf16x8*)(Kt + (2 * d0 + hi) * 1024 + r32 * 16);
        const bf16x8 k1 = *(const LAS bf16x8*)(Kt + (2 * d0 + hi) * 1024 + 512 + r32 * 16);
        p0 = mfma32(k0, qB[d0], p0); p1 = mfma32(k1, qB[d0], p1);
    }
}
__device__ __forceinline__ void nsa_pv(const LAS unsigned char* Vt, int lane, int hi, const f32x16& p0, const f32x16& p1, f32x16& o0, f32x16& o1) {
    bf16x8 pB[4];
    { u32x4 t; t.x = cvt_pk_bf16(p0[0], p0[1]); t.y = cvt_pk_bf16(p0[2], p0[3]); t.z = cvt_pk_bf16(p0[4], p0[5]); t.w = cvt_pk_bf16(p0[6], p0[7]); pB[0] = __builtin_bit_cast(bf16x8, t);
      t.x = cvt_pk_bf16(p0[8], p0[9]); t.y = cvt_pk_bf16(p0[10], p0[11]); t.z = cvt_pk_bf16(p0[12], p0[13]); t.w = cvt_pk_bf16(p0[14], p0[15]); pB[1] = __builtin_bit_cast(bf16x8, t);
      t.x = cvt_pk_bf16(p1[0], p1[1]); t.y = cvt_pk_bf16(p1[2], p1[3]); t.z = cvt_pk_bf16(p1[4], p1[5]); t.w = cvt_pk_bf16(p1[6], p1[7]); pB[2] = __builtin_bit_cast(bf16x8, t);
      t.x = cvt_pk_bf16(p1[8], p1[9]); t.y = cvt_pk_bf16(p1[10], p1[11]); t.z = cvt_pk_bf16(p1[12], p1[13]); t.w = cvt_pk_bf16(p1[14], p1[15]); pB[3] = __builtin_bit_cast(bf16x8, t); }
    const LAS unsigned char* vb = Vt + (4 * hi + ((lane & 15) >> 2)) * 64 + ((lane >> 4) & 1) * 32 + (lane & 3) * 8;
#pragma unroll
    for (int ks = 0; ks < 4; ++ks) {
        const bf16x8 va0 = cat8(trrd(vb + ks * 1024), trrd(vb + ks * 1024 + 512));
        const bf16x8 va1 = cat8(trrd(vb + 4096 + ks * 1024), trrd(vb + 4096 + ks * 1024 + 512));
        o0 = mfma32(va0, pB[ks], o0); o1 = mfma32(va1, pB[ks], o1);
    }
}

template <int MODE>
__device__ __forceinline__ void nsa_branch(const Ctx& F, const bf16_t* Kg, const bf16_t* Vg, unsigned tiles, int qt, int ql, unsigned mysel,
                                           const LAS float* biasH, const bf16_t* qptr, float gate, f32x16& out0, f32x16& out1) {
    LAS unsigned char* lds = F.lds; int tid_ = F.tid; asm volatile("" : "+v"(tid_)); const int tid = tid_, lane = tid & 63, r32 = lane & 31, hi = lane >> 5;
    bf16x8 qB[4];
#pragma unroll
    for (int d0 = 0; d0 < 4; ++d0) qB[d0] = *(const bf16x8*)(qptr + 16 * d0);
    float m = NEGBIG, l = 0.f;
    f32x16 o0 = (f32x16){0.f, 0.f, 0.f, 0.f, 0.f, 0.f, 0.f, 0.f, 0.f, 0.f, 0.f, 0.f, 0.f, 0.f, 0.f, 0.f}, o1 = o0;
    unsigned rem = tiles;
    int j = (MODE == 1) ? (__ffs(rem) - 1) : (31 - __clz(rem)); rem &= ~(1u << j);
    u32x4 kreg = *(const u32x4*)(Kg + (size_t)(64 * j + (tid & 63)) * LDP + 8 * (tid >> 6));
    u32x4 vreg = *(const u32x4*)(Vg + (size_t)(64 * j + (tid >> 3)) * LDP + 8 * (tid & 7));
    int buf = 0;
    for (;;) {
        NSA_STORE_TILE(buf);
        __syncthreads();
        int jn = -1;
        if (rem) { jn = (MODE == 1) ? (__ffs(rem) - 1) : (31 - __clz(rem)); rem &= ~(1u << jn);
            kreg = *(const u32x4*)(Kg + (size_t)(64 * jn + (tid & 63)) * LDP + 8 * (tid >> 6));
            vreg = *(const u32x4*)(Vg + (size_t)(64 * jn + (tid >> 3)) * LDP + 8 * (tid & 7)); }
        f32x16 p0, p1;
        nsa_qk(lds + NL_KT + buf * 8192, qB, r32, hi, p0, p1);
        const int dj = qt - j, dq = 64 * dj + ql - 4 * hi;
        const bool near = dj <= 2, edge = (MODE == 2) && (dj == 8);
        const bool selq = (MODE == 1) ? (((mysel >> j) & 1u) != 0u) : true;
        if (near || edge) {
#pragma unroll
            for (int r = 0; r < 16; ++r) {
                const int d0 = dq - ((r & 3) + 8 * (r >> 2)), d1 = d0 - 32;
                const bool v0 = selq && d0 >= 0 && (MODE == 1 || d0 < 512), v1 = selq && d1 >= 0 && (MODE == 1 || d1 < 512);
                float b0 = 0.f, b1 = 0.f;
                if (near) { const int c0 = d0 < 0 ? 0 : (d0 > 127 ? 127 : d0), c1 = d1 < 0 ? 0 : (d1 > 127 ? 127 : d1); b0 = biasH[c0]; b1 = biasH[c1]; }
                p0[r] = v0 ? p0[r] + b0 : NEGBIG; p1[r] = v1 ? p1[r] + b1 : NEGBIG;
            }
        } else if (MODE == 1) {
#pragma unroll
            for (int r = 0; r < 16; ++r) { p0[r] = selq ? p0[r] : NEGBIG; p1[r] = selq ? p1[r] : NEGBIG; }
        }
        float mx = p0[0];
#pragma unroll
        for (int r = 1; r < 16; ++r) mx = fmaxf(mx, p0[r]);
#pragma unroll
        for (int r = 0; r < 16; ++r) mx = fmaxf(mx, p1[r]);
        mx = fmaxf(mx, __shfl_xor(mx, 32));
        const float mn = fmaxf(m, mx), f = fexp2(m - mn); m = mn;
        float ls = 0.f;
#pragma unroll
        for (int r = 0; r < 16; ++r) { p0[r] = fexp2(p0[r] - mn); p1[r] = fexp2(p1[r] - mn); ls += p0[r] + p1[r]; }
        l = l * f + ls;
#pragma unroll
        for (int r = 0; r < 16; ++r) { o0[r] *= f; o1[r] *= f; }
        nsa_pv(lds + NL_VT + buf * 8192, lane, hi, p0, p1, o0, o1);
        if (jn < 0) break;
        j = jn; buf ^= 1;
    }
    __syncthreads();
    const float lt = l + __shfl_xor(l, 32), sc = gate * frcp(lt);
#pragma unroll
    for (int r = 0; r < 16; ++r) { out0[r] += sc * o0[r]; out1[r] += sc * o1[r]; }
}

__device__ __forceinline__ void nsa_unit(const Ctx& F, int bl, int g, int qt, const bf16_t* P, const bf16_t* KC, const bf16_t* VC, const float* biasT, bf16_t* YB) {
    LAS unsigned char* lds = F.lds; int tid_ = F.tid; asm volatile("" : "+v"(tid_)); const int tid = tid_, lane = tid & 63, w = F.wave, r32 = lane & 31, hi = lane >> 5;
    const int h = w >> 1, ql = 32 * (w & 1) + r32, t = 64 * qt + ql;
    const size_t row = (size_t)bl * SEQ + t;
    ((LAS float*)(lds + NL_BIAS))[tid] = biasT[(g * 4 + (tid >> 7)) * 128 + (tid & 127)];
    if (tid == 0) *(LAS unsigned*)(lds + NL_UNI) = 0u;
    const bf16_t* qptr = P + row * LDP + C_Q + g * 256 + h * 64 + 8 * hi;
    const float g_c = sigmoidf_(bf1(P[row * LDP + C_NG + g * 4 + h])), g_s = sigmoidf_(bf1(P[row * LDP + C_NG + 8 + g * 4 + h])), g_w = sigmoidf_(bf1(P[row * LDP + C_NG + 16 + g * 4 + h]));
    const LAS float* biasH = (const LAS float*)(lds + NL_BIAS) + h * 128;
    f32x16 out0 = (f32x16){0.f, 0.f, 0.f, 0.f, 0.f, 0.f, 0.f, 0.f, 0.f, 0.f, 0.f, 0.f, 0.f, 0.f, 0.f, 0.f}, out1 = out0;

    const int ntile = (qt >= 16) ? 2 : 1;
    for (int tl = 0; tl < ntile; ++tl) {
        int nk = 64 * tl + (tid & 63); if (nk > 126) nk = 126;
        int nv = 64 * tl + (tid >> 3); if (nv > 126) nv = 126;
        const u32x4 kreg = *(const u32x4*)(KC + (size_t)(bl * 128 + nk) * 128 + g * 64 + 8 * (tid >> 6));
        const u32x4 vreg = *(const u32x4*)(VC + (size_t)(bl * 128 + nv) * 128 + g * 64 + 8 * (tid & 7));
        NSA_STORE_TILE(tl);
    }
    __syncthreads();
    {
        f32x16 s0, s1, s2, s3;
        { bf16x8 qB[4];
#pragma unroll
          for (int d0 = 0; d0 < 4; ++d0) qB[d0] = *(const bf16x8*)(qptr + 16 * d0);
          nsa_qk(lds + NL_KT, qB, r32, hi, s0, s1);
          if (ntile == 2) nsa_qk(lds + NL_KT + 8192, qB, r32, hi, s2, s3);
          else { s2 = (f32x16){0.f, 0.f, 0.f, 0.f, 0.f, 0.f, 0.f, 0.f, 0.f, 0.f, 0.f, 0.f, 0.f, 0.f, 0.f, 0.f}; s3 = s2; } }
        const int db = t - 31 - 64 * hi;
        float mx = NEGBIG;
#define CMP_MASK(S, V) _Pragma("unroll") for (int r = 0; r < 16; ++r) { const int d = db - 16 * (32 * (V) + (r & 3) + 8 * (r >> 2)); \
            const int c = d < 0 ? 0 : (d > 127 ? 127 : d); S[r] = (d >= 0) ? S[r] + biasH[c] : NEGBIG; mx = fmaxf(mx, S[r]); }
        CMP_MASK(s0, 0) CMP_MASK(s1, 1)
        if (ntile == 2) { CMP_MASK(s2, 2) CMP_MASK(s3, 3) }
#undef CMP_MASK
        mx = fmaxf(mx, __shfl_xor(mx, 32));
        float ls = 0.f;
#define CMP_EXP(S) _Pragma("unroll") for (int r = 0; r < 16; ++r) { S[r] = (S[r] > -1e29f) ? fexp2(S[r] - mx) : 0.f; ls += S[r]; }
        CMP_EXP(s0) CMP_EXP(s1)
        if (ntile == 2) { CMP_EXP(s2) CMP_EXP(s3) }
#undef CMP_EXP
        ls += __shfl_xor(ls, 32);
        const float inv = ls > 0.f ? 1.f / ls : 0.f;
#pragma unroll
        for (int r = 0; r < 16; ++r) { s0[r] *= inv; s1[r] *= inv; s2[r] *= inv; s3[r] *= inv; }
        LAS float* I = (LAS float*)(lds + NL_IMP) + (h * 64 + ql) * 33 + hi;
        float yprev = 0.f;
#define CMP_IMP(S, V) _Pragma("unroll") for (int a = 0; a < 4; ++a) { const float own = S[4 * a] + S[4 * a + 1] + S[4 * a + 2] + 0.5f * S[4 * a + 3]; \
            const float y = __shfl_xor(0.5f * S[4 * a + 3], 32); I[2 * (4 * (V) + a)] = own + (hi ? y : yprev); yprev = y; }
        CMP_IMP(s0, 0) CMP_IMP(s1, 1) CMP_IMP(s2, 2) CMP_IMP(s3, 3)
#undef CMP_IMP
        f32x16 o0 = (f32x16){0.f, 0.f, 0.f, 0.f, 0.f, 0.f, 0.f, 0.f, 0.f, 0.f, 0.f, 0.f, 0.f, 0.f, 0.f, 0.f}, o1 = o0;
        nsa_pv(lds + NL_VT, lane, hi, s0, s1, o0, o1);
        if (ntile == 2) nsa_pv(lds + NL_VT + 8192, lane, hi, s2, s3, o0, o1);
#pragma unroll
        for (int r = 0; r < 16; ++r) { out0[r] += g_c * o0[r]; out1[r] += g_c * o1[r]; }
    }
    __syncthreads();
    if (w == 0) {
        const LAS float* I = (const LAS float*)(lds + NL_IMP) + lane * 33;
        float v[32];
#pragma unroll
        for (int jj = 0; jj < 32; ++jj) v[jj] = (I[jj] + I[64 * 33 + jj]) + (I[128 * 33 + jj] + I[192 * 33 + jj]);
        unsigned sel = 1u | (1u << qt) | (qt >= 1 ? (1u << (qt - 1)) : 0u);
        const int need = 8 - __popc(sel);
#pragma unroll
        for (int it = 0; it < 5; ++it) {
            if (it < need) {
                int best = -1; float bv = -1e30f;
#pragma unroll
                for (int jj = 1; jj < 32; ++jj) { const bool ok = (jj <= qt - 2) && (((sel >> jj) & 1u) == 0u) && (v[jj] > bv); bv = ok ? v[jj] : bv; best = ok ? jj : best; }
                if (best >= 0) sel |= 1u << best;
            }
        }
        ((LAS unsigned*)(lds + NL_SEL))[lane] = sel;
        atomicOr((unsigned*)(lds + NL_UNI), sel);
    }
    __syncthreads();
    const unsigned uni = *(const LAS unsigned*)(lds + NL_UNI) & ((qt >= 31) ? 0xffffffffu : ((2u << qt) - 1u));
    const unsigned mysel = ((const LAS unsigned*)(lds + NL_SEL))[ql];
    const bf16_t* Pb = P + (size_t)bl * SEQ * LDP + C_KV + g * 64;
    nsa_branch<1>(F, Pb + 256, Pb + 384, uni, qt, ql, mysel, biasH, qptr, g_s, out0, out1);
    { const int lo = qt >= 8 ? qt - 8 : 0; const unsigned wm = (((qt >= 31) ? 0xffffffffu : ((2u << qt) - 1u)) >> lo) << lo;
      nsa_branch<2>(F, Pb + 512, Pb + 640, wm, qt, ql, 0u, biasH, qptr, g_w, out0, out1); }
    bf16_t* yo = YB + row * 512 + g * 256 + h * 64 + 4 * hi;
#pragma unroll
    for (int a = 0; a < 4; ++a) {
        u32x2 w0; w0.x = cvt_pk_bf16(out0[4 * a], out0[4 * a + 1]); w0.y = cvt_pk_bf16(out0[4 * a + 2], out0[4 * a + 3]); *(u32x2*)(yo + 8 * a) = w0;
        u32x2 w1; w1.x = cvt_pk_bf16(out1[4 * a], out1[4 * a + 1]); w1.y = cvt_pk_bf16(out1[4 * a + 2], out1[4 * a + 3]); *(u32x2*)(yo + 32 + 8 * a) = w1;
    }
    __syncthreads();
}

constexpr int SL_CT = 0, SL_BT = 34816, SL_XT = 69632, SL_XD = 77824, SL_XW = 86016, SL_HT = 94208, SL_YO = 102912, SL_ACS = 119296, SL_DTV = 119808;
__device__ __forceinline__ void ssd_unit(const Ctx& F, int bl, int hd, int ph, const bf16_t* P, const bf16_t* XC, float dtb, float Aneg, float Dh, bf16_t* YP) {
    LAS unsigned char* lds = F.lds; int tid_ = F.tid; asm volatile("" : "+v"(tid_)); const int tid = tid_, lane = tid & 63, w = F.wave, r32 = lane & 31, hi = lane >> 5;
    const int g = hd >> 2, p0 = 32 * ph; const size_t rowb = (size_t)bl * SEQ;
    const int q4 = (lane & 15) >> 2, p4 = lane & 3, g1 = (lane >> 4) & 1;
    LAS float* ACS = (LAS float*)(lds + SL_ACS); LAS float* DTV = (LAS float*)(lds + SL_DTV);
    u32x4 creg[4], breg[4], xreg; float dtraw = 0.f;
#define SSD_LOAD(ch) do { const bf16_t* xc = XC + (rowb + (size_t)(ch) * 128) * 2048; \
        _Pragma("unroll") for (int i = 0; i < 4; ++i) { const int r = (tid >> 4) + 32 * i; \
            creg[i] = *(const u32x4*)(xc + (size_t)r * 2048 + 1536 + g * 128 + 8 * (tid & 15)); breg[i] = *(const u32x4*)(xc + (size_t)r * 2048 + 1024 + g * 128 + 8 * (tid & 15)); } \
        xreg = *(const u32x4*)(xc + (size_t)(tid >> 2) * 2048 + hd * 64 + p0 + 8 * (tid & 3)); \
        if (tid < 128) dtraw = bf1(P[(rowb + (size_t)(ch) * 128 + tid) * LDP + C_DT + hd]); } while (0)
    f32x16 hs = (f32x16){0.f, 0.f, 0.f, 0.f, 0.f, 0.f, 0.f, 0.f, 0.f, 0.f, 0.f, 0.f, 0.f, 0.f, 0.f, 0.f};
    SSD_LOAD(0);
    for (int ch = 0; ch < 16; ++ch) {
#pragma unroll
        for (int i = 0; i < 4; ++i) { const int r = (tid >> 4) + 32 * i;
            *(LAS u32x4*)(lds + SL_CT + r * 272 + (tid & 15) * 16) = creg[i]; *(LAS u32x4*)(lds + SL_BT + r * 272 + (tid & 15) * 16) = breg[i]; }
        *(LAS u32x4*)(lds + SL_XT + (tid >> 2) * 64 + (tid & 3) * 16) = xreg;
        if (tid < 128) { const float x = dtraw + dtb; const float dtv = x > 20.f ? x : log1pf(__expf(x)); DTV[tid] = dtv; ACS[tid] = dtv * Aneg * LOG2E; }
        __syncthreads();
        if (w == 0) { const float a0 = ACS[2 * lane], a1 = ACS[2 * lane + 1]; float s = a0 + a1;
#pragma unroll
            for (int o = 1; o < 64; o <<= 1) { const float tt = __shfl_up(s, o); if (lane >= o) s += tt; }
            ACS[2 * lane] = s - a1; ACS[2 * lane + 1] = s; }
        __syncthreads();
        { const int lrow = tid >> 2; const float dl = DTV[lrow], wl = dl * fexp2(ACS[127] - ACS[lrow]);
          float x[8], xd[8], xw[8]; unpack8(xreg, x);
#pragma unroll
          for (int i = 0; i < 8; ++i) { xd[i] = x[i] * dl; xw[i] = x[i] * wl; }
          *(LAS u32x4*)(lds + SL_XD + lrow * 64 + (tid & 3) * 16) = pack8(xd); *(LAS u32x4*)(lds + SL_XW + lrow * 64 + (tid & 3) * 16) = pack8(xw); }
        if (w >= 4) {
#pragma unroll
            for (int a = 0; a < 4; ++a) { u32x2 t; t.x = cvt_pk_bf16(hs[4 * a], hs[4 * a + 1]); t.y = cvt_pk_bf16(hs[4 * a + 2], hs[4 * a + 3]);
                *(LAS u32x2*)(lds + SL_HT + r32 * 272 + (32 * (w - 4) + 8 * a + 4 * hi) * 2) = t; }
        }
        if (ch + 1 < 16) SSD_LOAD(ch + 1);
        __syncthreads();
        f32x16 y = (f32x16){0.f, 0.f, 0.f, 0.f, 0.f, 0.f, 0.f, 0.f, 0.f, 0.f, 0.f, 0.f, 0.f, 0.f, 0.f, 0.f};
        if (w < 4) {
            const int li = w, lidx = 32 * li + r32; const float acl = ACS[lidx];
            for (int si = 0; si <= li; ++si) {
                f32x16 s = (f32x16){0.f, 0.f, 0.f, 0.f, 0.f, 0.f, 0.f, 0.f, 0.f, 0.f, 0.f, 0.f, 0.f, 0.f, 0.f, 0.f};
#pragma unroll
                for (int kk = 0; kk < 8; ++kk) {
                    const bf16x8 aa = *(const LAS bf16x8*)(lds + SL_BT + (32 * si + r32) * 272 + (16 * kk + 8 * hi) * 2);
                    const bf16x8 bb = *(const LAS bf16x8*)(lds + SL_CT + lidx * 272 + (16 * kk + 8 * hi) * 2);
                    s = mfma32(aa, bb, s);
                }
#pragma unroll
                for (int r = 0; r < 16; ++r) { const int sidx = 32 * si + crow(r, hi); const float e = fexp2(acl - ACS[sidx]); s[r] = (sidx <= lidx) ? s[r] * e : 0.f; }
                u32x4 t0, t1;
                t0.x = cvt_pk_bf16(s[0], s[1]); t0.y = cvt_pk_bf16(s[2], s[3]); t0.z = cvt_pk_bf16(s[4], s[5]); t0.w = cvt_pk_bf16(s[6], s[7]);
                t1.x = cvt_pk_bf16(s[8], s[9]); t1.y = cvt_pk_bf16(s[10], s[11]); t1.z = cvt_pk_bf16(s[12], s[13]); t1.w = cvt_pk_bf16(s[14], s[15]);
                const LAS unsigned char* xb = lds + SL_XD + (32 * si + 4 * hi + q4) * 64 + g1 * 32 + p4 * 8;
                y = mfma32(cat8(trrd(xb), trrd(xb + 512)), __builtin_bit_cast(bf16x8, t0), y);
                y = mfma32(cat8(trrd(xb + 1024), trrd(xb + 1536)), __builtin_bit_cast(bf16x8, t1), y);
            }
        } else {
            const int wi = w - 4, lidx = 32 * wi + r32;
            f32x16 yo = (f32x16){0.f, 0.f, 0.f, 0.f, 0.f, 0.f, 0.f, 0.f, 0.f, 0.f, 0.f, 0.f, 0.f, 0.f, 0.f, 0.f};
#pragma unroll
            for (int kk = 0; kk < 8; ++kk) {
                const bf16x8 aa = *(const LAS bf16x8*)(lds + SL_HT + r32 * 272 + (16 * kk + 8 * hi) * 2);
                const bf16x8 bb = *(const LAS bf16x8*)(lds + SL_CT + lidx * 272 + (16 * kk + 8 * hi) * 2);
                yo = mfma32(aa, bb, yo);
            }
            const float el = fexp2(ACS[lidx]);
#pragma unroll
            for (int r = 0; r < 16; ++r) *(LAS float*)(lds + SL_YO + wi * 4096 + r * 256 + lane * 4) = yo[r] * el;
            const float dec = fexp2(ACS[127]);
#pragma unroll
            for (int r = 0; r < 16; ++r) hs[r] *= dec;
#pragma unroll
            for (int kk = 0; kk < 8; ++kk) {
                const LAS unsigned char* ab = lds + SL_BT + (16 * kk + 8 * hi + q4) * 272 + (32 * wi + 16 * g1 + 4 * p4) * 2;
                const LAS unsigned char* bb = lds + SL_XW + (16 * kk + 8 * hi + q4) * 64 + g1 * 32 + p4 * 8;
                hs = mfma32(cat8(trrd(ab), trrd(ab + 4 * 272)), cat8(trrd(bb), trrd(bb + 256)), hs);
            }
        }
        __syncthreads();
        if (w < 4) {
            const int li = w; bf16_t* yp = YP + (rowb + (size_t)ch * 128 + 32 * li + r32) * 1024 + hd * 64 + p0 + 4 * hi;
#pragma unroll
            for (int a = 0; a < 4; ++a) {
                const u32x2 xr = *(const LAS u32x2*)(lds + SL_XT + (32 * li + r32) * 64 + (8 * a + 4 * hi) * 2);
                const float x0 = bflo(xr.x), x1 = bfhi(xr.x), x2 = bflo(xr.y), x3 = bfhi(xr.y);
                const float v0 = y[4 * a] + *(const LAS float*)(lds + SL_YO + li * 4096 + (4 * a) * 256 + lane * 4) + Dh * x0;
                const float v1 = y[4 * a + 1] + *(const LAS float*)(lds + SL_YO + li * 4096 + (4 * a + 1) * 256 + lane * 4) + Dh * x1;
                const float v2 = y[4 * a + 2] + *(const LAS float*)(lds + SL_YO + li * 4096 + (4 * a + 2) * 256 + lane * 4) + Dh * x2;
                const float v3 = y[4 * a + 3] + *(const LAS float*)(lds + SL_YO + li * 4096 + (4 * a + 3) * 256 + lane * 4) + Dh * x3;
                u32x2 o; o.x = cvt_pk_bf16(v0, v1); o.y = cvt_pk_bf16(v2, v3); *(u32x2*)(yp + 8 * a) = o;
            }
        }
        __syncthreads();
    }
#undef SSD_LOAD
}

__device__ __forceinline__ void attn_phase(const Ctx& F, ArgsP a, int l, int gi) {
    LAS unsigned char* lds = F.lds;
    const bf16_t* P = (const bf16_t*)(a->ws + WS_ARENA + AR_P);
    const bf16_t* XC = (const bf16_t*)(F.dout + DO_XC);
    bf16_t* YP = (bf16_t*)(F.dout + DO_YC); bf16_t* YB = (bf16_t*)(F.dout + DO_YB);
    const bf16_t* KC = (const bf16_t*)(a->ws + WS_MISC + MI_KC); const bf16_t* VC = (const bf16_t*)(a->ws + WS_MISC + MI_VC);
    const float* biasT = (const float*)(a->ws + WS_MISC + MI_BIAS);
    unsigned* ctr = F.ctl + CW_WQ + 64 * (l * NG + gi);
    constexpr int NSSD = BG * 16 * 2, NNSA = BG * 2 * 32;
    for (;;) {
        if (F.tid == 0) *(LAS int*)(lds + LDSX + LX_WQ) = (int)__hip_atomic_fetch_add(ctr, 1u, __ATOMIC_RELAXED, __HIP_MEMORY_SCOPE_AGENT);
        __syncthreads();
        const int item = *(const LAS int*)(lds + LDSX + LX_WQ);
        __syncthreads();
        if (item >= NSSD + NNSA) break;
        if (item < NSSD) {
            const int bl = item >> 5, hd = (item >> 1) & 15, ph = item & 1;
            ssd_unit(F, bl, hd, ph, P, XC, a->in[I_DTB][l * 16 + hd], -__expf(a->in[I_ALOG][l * 16 + hd]), a->in[I_DSKIP][l * 16 + hd], YP);
        } else {
            const int idx = item - NSSD, qt = 31 - (idx >> 4), bg = idx & 15;
            nsa_unit(F, bg >> 1, bg & 1, qt, P, KC, VC, biasT, YB);
        }
    }
}

__device__ __forceinline__ void ln1_route_phase(const Ctx& F, ArgsP a, int l) {
    LAS unsigned char* lds = F.lds; const int tid = F.tid, lane = F.lane, w = F.wave;
    LAS float* RWT = (LAS float*)lds;
    LAS int* lcnt = (LAS int*)(lds + LDSX + LX_CNTL); LAS int* lbase = (LAS int*)(lds + LDSX + LX_BASE); LAS int* rows = (LAS int*)(lds + LDSX + LX_ROWS);
    for (int i = tid; i < 16384; i += 512) RWT[(i & 15) * 1024 + (i >> 4)] = a->in[I_RW][i];
    bf16_t* H1 = (bf16_t*)(a->ws + WS_PRE1);
    const float* g = a->in[I_LN1G] + l * DM; const float* b = a->in[I_LN1B] + l * DM;
    float gg[16], bb[16], rb[16];
#pragma unroll
    for (int i = 0; i < 8; ++i) { gg[i] = g[8 * lane + i]; gg[8 + i] = g[512 + 8 * lane + i]; bb[i] = b[8 * lane + i]; bb[8 + i] = b[512 + 8 * lane + i]; }
#pragma unroll
    for (int e = 0; e < 16; ++e) rb[e] = a->in[I_RB][e];
    unsigned* gcnt = F.ctl + CW_CNT + 64 * l;
    int* route = (int*)(a->ws + WS_MISC + MI_ROUTE);
    for (int rb0 = blockIdx.x * 128; rb0 < T_; rb0 += F.G * 128) {
        if (tid < 16) lcnt[tid] = 0;
        __syncthreads();
        for (int rr = 0; rr < 16; ++rr) {
            const int rl = w * 16 + rr; const size_t row = (size_t)rb0 + rl;
            float v[16];
            { float t[8]; unpack8(*(const u32x4*)(H1 + row * DM + 8 * lane), t);
#pragma unroll
              for (int i = 0; i < 8; ++i) v[i] = t[i];
              unpack8(*(const u32x4*)(H1 + row * DM + 512 + 8 * lane), t);
#pragma unroll
              for (int i = 0; i < 8; ++i) v[8 + i] = t[i]; }
            float s = 0.f;
#pragma unroll
            for (int i = 0; i < 16; ++i) s += v[i];
            const float mean = wave_sum(s) * (1.f / DM); float s2 = 0.f;
#pragma unroll
            for (int i = 0; i < 16; ++i) { v[i] -= mean; s2 += v[i] * v[i]; }
            const float rstd = 1.f / sqrtf(wave_sum(s2) * (1.f / DM) + LN_EPS);
#pragma unroll
            for (int i = 0; i < 16; ++i) v[i] = v[i] * rstd * gg[i] + bb[i];
            { float t[8];
#pragma unroll
              for (int i = 0; i < 8; ++i) t[i] = v[i];
              *(u32x4*)(H1 + row * DM + 8 * lane) = pack8(t);
#pragma unroll
              for (int i = 0; i < 8; ++i) t[i] = v[8 + i];
              *(u32x4*)(H1 + row * DM + 512 + 8 * lane) = pack8(t); }
            float lg[16];
#pragma unroll
            for (int e = 0; e < 16; ++e) {
                const f32x4 r0 = *(const LAS f32x4*)(RWT + e * 1024 + 8 * lane), r1 = *(const LAS f32x4*)(RWT + e * 1024 + 8 * lane + 4);
                const f32x4 r2 = *(const LAS f32x4*)(RWT + e * 1024 + 512 + 8 * lane), r3 = *(const LAS f32x4*)(RWT + e * 1024 + 512 + 8 * lane + 4);
                lg[e] = (v[0] * r0[0] + v[1] * r0[1] + v[2] * r0[2] + v[3] * r0[3]) + (v[4] * r1[0] + v[5] * r1[1] + v[6] * r1[2] + v[7] * r1[3])
                      + (v[8] * r2[0] + v[9] * r2[1] + v[10] * r2[2] + v[11] * r2[3]) + (v[12] * r3[0] + v[13] * r3[1] + v[14] * r3[2] + v[15] * r3[3]);
            }
#pragma unroll
            for (int e = 0; e < 16; ++e) lg[e] = wave_sum(lg[e]);
            float mx = lg[0];
#pragma unroll
            for (int e = 1; e < 16; ++e) mx = fmaxf(mx, lg[e]);
            float pr[16], ps = 0.f;
#pragma unroll
            for (int e = 0; e < 16; ++e) { pr[e] = __expf(lg[e] - mx); ps += pr[e]; }
            const float pinv = 1.f / ps;
            float sc[16];
#pragma unroll
            for (int e = 0; e < 16; ++e) { pr[e] *= pinv; sc[e] = pr[e] + rb[e]; }
            int grp = 0; float gbest = -1e30f;
#pragma unroll
            for (int q = 0; q < 4; ++q) {
                const float s0 = sc[4 * q], s1 = sc[4 * q + 1], s2_ = sc[4 * q + 2], s3 = sc[4 * q + 3];
                const float tot = (s0 + s1) + (s2_ + s3), mn1 = fminf(fminf(s0, s1), fminf(s2_, s3));
                const float m2 = fminf(fminf(fminf(fmaxf(s0, s1), fmaxf(s0, s2_)), fminf(fmaxf(s0, s3), fmaxf(s1, s2_))), fminf(fmaxf(s1, s3), fmaxf(s2_, s3)));
                const float top2 = tot - mn1 - m2;
                if (top2 > gbest) { gbest = top2; grp = q; }
            }
            float c0 = 0.f, c1 = 0.f, c2 = 0.f, c3 = 0.f, q0 = 0.f, q1 = 0.f, q2 = 0.f, q3 = 0.f;
#pragma unroll
            for (int q = 0; q < 4; ++q) if (grp == q) { c0 = sc[4 * q]; c1 = sc[4 * q + 1]; c2 = sc[4 * q + 2]; c3 = sc[4 * q + 3]; q0 = pr[4 * q]; q1 = pr[4 * q + 1]; q2 = pr[4 * q + 2]; q3 = pr[4 * q + 3]; }
            int i0 = 0; float b0 = c0; if (c1 > b0) { b0 = c1; i0 = 1; } if (c2 > b0) { b0 = c2; i0 = 2; } if (c3 > b0) { b0 = c3; i0 = 3; }
            int i1 = -1; float b1 = -1e30f;
            if (i0 != 0 && c0 > b1) { b1 = c0; i1 = 0; } if (i0 != 1 && c1 > b1) { b1 = c1; i1 = 1; } if (i0 != 2 && c2 > b1) { b1 = c2; i1 = 2; } if (i0 != 3 && c3 > b1) { b1 = c3; i1 = 3; }
            const float w0 = (i0 == 0) ? q0 : (i0 == 1) ? q1 : (i0 == 2) ? q2 : q3, w1 = (i1 == 0) ? q0 : (i1 == 1) ? q1 : (i1 == 2) ? q2 : q3;
            const float wn = 1.f / (w0 + w1);
            if (lane == 0) {
                const int e0 = 4 * grp + i0, e1 = 4 * grp + i1;
                const int pos0 = atomicAdd((int*)(lds + LDSX + LX_CNTL) + e0, 1), pos1 = atomicAdd((int*)(lds + LDSX + LX_CNTL) + e1, 1);
                rows[rl * 8 + 0] = e0; rows[rl * 8 + 1] = e1; rows[rl * 8 + 2] = pos0; rows[rl * 8 + 3] = pos1; rows[rl * 8 + 4] = __float_as_int(w0 * wn); rows[rl * 8 + 5] = __float_as_int(w1 * wn);
            }
        }
        __syncthreads();
        if (tid < 16) lbase[tid] = (int)__hip_atomic_fetch_add(gcnt + tid, (unsigned)lcnt[tid], __ATOMIC_RELAXED, __HIP_MEMORY_SCOPE_AGENT);
        __syncthreads();
        if (tid < 128) {
            const int e0 = rows[tid * 8], e1 = rows[tid * 8 + 1]; const int t = rb0 + tid;
            route[t] = e0 | (e1 << 8); route[T_ + t] = lbase[e0] + rows[tid * 8 + 2]; route[2 * T_ + t] = lbase[e1] + rows[tid * 8 + 3];
            route[3 * T_ + t] = rows[tid * 8 + 4]; route[4 * T_ + t] = rows[tid * 8 + 5];
        }
        __syncthreads();
    }
}

__device__ __forceinline__ int moe_tables(const Ctx& F, int l) {
    LAS int* off = (LAS int*)(F.lds + LDSX + LX_OFF); LAS int* tile_e = (LAS int*)(F.lds + LDSX + LX_TILE);
    __syncthreads();
    if (F.tid == 0) { int o = 0;
        for (int e = 0; e < 16; ++e) { off[e] = o; const int c = (int)__hip_atomic_load(F.ctl + CW_CNT + 64 * l + e, __ATOMIC_RELAXED, __HIP_MEMORY_SCOPE_AGENT); const int nt = (c + 255) >> 8;
            for (int k = 0; k < nt; ++k) tile_e[(o >> 8) + k] = e; o += nt << 8; }
        off[16] = o; }
    __syncthreads();
    return off[16] >> 8;
}
__device__ __forceinline__ void gather_phase(const Ctx& F, ArgsP a, int l) {
    const int nrt = moe_tables(F, l); (void)nrt;
    const LAS int* off = (const LAS int*)(F.lds + LDSX + LX_OFF);
    const bf16_t* H1 = (const bf16_t*)(a->ws + WS_PRE1); bf16_t* XS = (bf16_t*)(a->ws + WS_ARENA + AR_XS);
    const int* route = (const int*)(a->ws + WS_MISC + MI_ROUTE); int2* rinfo = (int2*)(a->ws + WS_MISC + MI_RINFO);
    for (int t = F.gw; t < T_; t += F.NGW) {
        const int ee = route[t], e0 = ee & 255, e1 = ee >> 8;
        const int r0 = off[e0] + route[T_ + t], r1 = off[e1] + route[2 * T_ + t];
        const u32x4 v0 = *(const u32x4*)(H1 + (size_t)t * DM + 8 * F.lane), v1 = *(const u32x4*)(H1 + (size_t)t * DM + 512 + 8 * F.lane);
        *(u32x4*)(XS + (size_t)r0 * DM + 8 * F.lane) = v0; *(u32x4*)(XS + (size_t)r0 * DM + 512 + 8 * F.lane) = v1;
        *(u32x4*)(XS + (size_t)r1 * DM + 8 * F.lane) = v0; *(u32x4*)(XS + (size_t)r1 * DM + 512 + 8 * F.lane) = v1;
        if (F.lane == 0) { rinfo[r0] = make_int2(t, route[3 * T_ + t]); rinfo[r1] = make_int2(T_ + t, route[4 * T_ + t]); }
    }
    if (blockIdx.x == 0) {
        for (int e = 0; e < 16; ++e) { const int c = (int)__hip_atomic_load(F.ctl + CW_CNT + 64 * l + e, __ATOMIC_RELAXED, __HIP_MEMORY_SCOPE_AGENT);
            for (int r = off[e] + c + F.tid; r < off[e + 1]; r += 512) rinfo[r] = make_int2(-1, 0); }
    }
}

__device__ __forceinline__ void ln2_phase(const Ctx& F, ArgsP a, int l, bool last) {
    const bf16_t* H1 = (const bf16_t*)(a->ws + WS_PRE1); const bf16_t* YS = (const bf16_t*)(a->ws + WS_ARENA + AR_XS);
    bf16_t* H = (bf16_t*)(a->ws + WS_H); float* OUT = a->out;
    const float* g = a->in[I_LN2G] + l * DM; const float* b = a->in[I_LN2B] + l * DM; const int lane = F.lane;
    float gg[16], bb[16];
#pragma unroll
    for (int i = 0; i < 8; ++i) { gg[i] = g[8 * lane + i]; gg[8 + i] = g[512 + 8 * lane + i]; bb[i] = b[8 * lane + i]; bb[8 + i] = b[512 + 8 * lane + i]; }
    for (int t = F.gw; t < T_; t += F.NGW) {
        float v[16];
#pragma unroll
        for (int hf = 0; hf < 2; ++hf) { float x[8], y0[8], y1[8];
            unpack8(*(const u32x4*)(H1 + (size_t)t * DM + 512 * hf + 8 * lane), x);
            unpack8(*(const u32x4*)(YS + (size_t)t * DM + 512 * hf + 8 * lane), y0);
            unpack8(*(const u32x4*)(YS + (size_t)(T_ + t) * DM + 512 * hf + 8 * lane), y1);
#pragma unroll
            for (int i = 0; i < 8; ++i) v[8 * hf + i] = DN_ALPHA * x[i] + (y0[i] + y1[i]); }
        float s = 0.f;
#pragma unroll
        for (int i = 0; i < 16; ++i) s += v[i];
        const float mean = wave_sum(s) * (1.f / DM); float s2 = 0.f;
#pragma unroll
        for (int i = 0; i < 16; ++i) { v[i] -= mean; s2 += v[i] * v[i]; }
        const float rstd = 1.f / sqrtf(wave_sum(s2) * (1.f / DM) + LN_EPS);
#pragma unroll
        for (int i = 0; i < 16; ++i) v[i] = v[i] * rstd * gg[i] + bb[i];
        if (last) {
#pragma unroll
            for (int hf = 0; hf < 2; ++hf) { float* o = OUT + (size_t)t * DM + 512 * hf + 8 * lane;
                *(f32x4*)o = (f32x4){v[8 * hf], v[8 * hf + 1], v[8 * hf + 2], v[8 * hf + 3]}; *(f32x4*)(o + 4) = (f32x4){v[8 * hf + 4], v[8 * hf + 5], v[8 * hf + 6], v[8 * hf + 7]}; }
        } else {
#pragma unroll
            for (int hf = 0; hf < 2; ++hf) { float tt[8];
#pragma unroll
                for (int i = 0; i < 8; ++i) tt[i] = v[8 * hf + i];
                *(u32x4*)(H + (size_t)t * DM + 512 * hf + 8 * lane) = pack8(tt); }
        }
    }
}

#ifndef PH_MASK
#define PH_MASK 0xfff
#endif
constexpr int NSTEPS = 1 + DEPTH * (NG * 6 + 5);
__global__ void __launch_bounds__(512, 2) fwd_kernel(Args a_unused) {
    const ArgsP a = (ArgsP)__builtin_amdgcn_kernarg_segment_ptr();
    extern __shared__ __attribute__((aligned(16))) unsigned char smem[];
    const int wave0_ = __builtin_amdgcn_readfirstlane((int)threadIdx.x >> 6);
    Ctx F;
#define MKCTX do { int t_ = wave0_ * 64 + (int)__builtin_amdgcn_mbcnt_hi(~0u, __builtin_amdgcn_mbcnt_lo(~0u, 0u)); asm volatile("" : "+v"(t_)); F.lds = (LAS unsigned char*)smem; F.tid = t_; F.lane = t_ & 63; F.wave = wave0_; \
        F.G = gridDim.x; { const int bx = blockIdx.x; F.vcu = (F.G % 8 == 0) ? (bx % 8) * (F.G / 8) + bx / 8 : bx; } \
        F.gw = blockIdx.x * 8 + F.wave; F.NGW = F.G * 8; F.ws = a->ws; F.dout = (unsigned char*)a->out; F.ctl = (unsigned*)(a->ws + WS_CTL); } while (0)
    MKCTX;
    for (int u = F.tid; u < (LDS_TOTAL - LDSX) / 4; u += 512) ((LAS unsigned*)(F.lds + LDSX))[u] = 0u;
    __syncthreads();
    const bool multi = (a->hi - a->lo) > 1;
    XcdBarrier bar; bar.bar = F.ctl + CW_BAR; bar.x = 0; bar.st = (volatile LAS unsigned*)(F.lds + LDSX + LX_BAR);
    if (multi) bar = xcd_barrier_post(F.ctl + CW_BAR, (volatile LAS unsigned*)(F.lds + LDSX + LX_BAR));
    int step = 0;
#define RUN_STEP (step >= a->lo && step < a->hi)
#define END_STEP do { if (RUN_STEP && step + 1 < a->hi) xcd_barrier(bar); ++step; } while (0)

    if (RUN_STEP && ((PH_MASK >> 0) & 1)) { MKCTX; p0_prologue(F, a); }
    END_STEP;

    {
        unsigned char* wl = a->ws + WS_W + (size_t)0 * W_LAYER;
        bf16_t* Hb = (bf16_t*)(a->ws + WS_H);
        bf16_t* P = (bf16_t*)(a->ws + WS_ARENA + AR_P);
        {
            const bf16_t* Hg = Hb + (size_t)0 * TG * DM;
            if (RUN_STEP && ((PH_MASK >> 1) & 1)) { MKCTX;
                pg8::Gemm g{Hg, (const bf16_t*)(wl + WO_IN), DM, DM, DM}; pg8::StaticOrder S; S.init(TG, LDP, DM, DM, F.G, (int)blockIdx.x);
                pg8::Epi<pg8::EK_PROJ> E{P, LDP, nullptr, 0, nullptr, nullptr};
                pg8::gemm_phase(F.lds, g, S, E);
            }
            END_STEP;
            if (RUN_STEP && ((PH_MASK >> 2) & 1)) { MKCTX;
                for (int cu = blockIdx.x; cu < BG * 16; cu += F.G)
                    compress_unit(F, cu, P, (const bf16_t*)(wl + WO_W1), (const bf16_t*)(wl + WO_W2), (const float*)(a->ws + WS_MISC + MI_B1) + 0 * 256,
                                  (bf16_t*)(a->ws + WS_MISC + MI_KC), (bf16_t*)(a->ws + WS_MISC + MI_VC));
                conv_phase(F, P, (bf16_t*)(F.dout + DO_XC), a->in[I_CONVW] + (size_t)0 * 4 * 2048, a->in[I_CONVB] + (size_t)0 * 2048);
            }
            END_STEP;
            if (RUN_STEP && ((PH_MASK >> 3) & 1)) { MKCTX; attn_phase(F, a, 0, 0); }
            END_STEP;
            if (RUN_STEP && ((PH_MASK >> 4) & 1)) { MKCTX; fin_phase(F, P, (bf16_t*)(F.dout + DO_R), (bf16_t*)(F.dout + DO_YC), a->in[I_SNG] + (size_t)0 * DM); }
            END_STEP;
            if (RUN_STEP && ((PH_MASK >> 5) & 1)) { MKCTX;
                bf16_t* GT = (bf16_t*)(a->ws + WS_ARENA + AR_GATES); bf16_t* MX = (bf16_t*)(a->ws + WS_ARENA + AR_MIXIN); float* TMP = (float*)(F.dout + DO_TMP);
                { pg8::Gemm g{Hg, (const bf16_t*)(wl + WO_GATE), DM, DM, DM}; pg8::GateOrder S; S.so.init(TG, DM, DM, DM, F.G, (int)blockIdx.x);
                  pg8::Epi<pg8::EK_GATE> E{GT, 3072, nullptr, 0, nullptr, nullptr}; pg8::gemm_phase(F.lds, g, S, E); }
                { pg8::Gemm g{(const bf16_t*)(F.dout + DO_R), (const bf16_t*)(wl + WO_C), 512, 512, 512}; pg8::StaticOrder S; S.init(TG, DM, 512, 512, F.G, (int)blockIdx.x);
                  pg8::Epi<pg8::EK_BR0> E{nullptr, 0, GT, 3072, TMP, nullptr}; pg8::gemm_phase(F.lds, g, S, E); }
                { pg8::Gemm g{(const bf16_t*)(F.dout + DO_YB), (const bf16_t*)(wl + WO_NSA), 512, 512, 512}; pg8::StaticOrder S; S.init(TG, DM, 512, 512, F.G, (int)blockIdx.x);
                  pg8::Epi<pg8::EK_BR1> E{nullptr, 0, GT + 1024, 3072, TMP, nullptr}; pg8::gemm_phase(F.lds, g, S, E); }
                { pg8::Gemm g{(const bf16_t*)(F.dout + DO_YC), (const bf16_t*)(wl + WO_SSD), DM, DM, DM}; pg8::StaticOrder S; S.init(TG, DM, DM, DM, F.G, (int)blockIdx.x);
                  pg8::Epi<pg8::EK_BR2> E{MX, DM, GT + 2048, 3072, TMP, nullptr}; pg8::gemm_phase(F.lds, g, S, E); }
            }
            END_STEP;
            if (RUN_STEP && ((PH_MASK >> 6) & 1)) { MKCTX;
                pg8::Gemm g{(const bf16_t*)(a->ws + WS_ARENA + AR_MIXIN), (const bf16_t*)(wl + WO_OUT), DM, DM, DM}; pg8::StaticOrder S; S.init(TG, DM, DM, DM, F.G, (int)blockIdx.x);
                pg8::Epi<pg8::EK_WOUT> E{(bf16_t*)(a->ws + WS_PRE1) + (size_t)0 * TG * DM, DM, Hg, DM, nullptr, nullptr};
                pg8::gemm_phase(F.lds, g, S, E);
            }
            END_STEP;
        }
        {
            const bf16_t* Hg = Hb + (size_t)1 * TG * DM;
            if (RUN_STEP && ((PH_MASK >> 1) & 1)) { MKCTX;
                pg8::Gemm g{Hg, (const bf16_t*)(wl + WO_IN), DM, DM, DM}; pg8::StaticOrder S; S.init(TG, LDP, DM, DM, F.G, (int)blockIdx.x);
                pg8::Epi<pg8::EK_PROJ> E{P, LDP, nullptr, 0, nullptr, nullptr};
                pg8::gemm_phase(F.lds, g, S, E);
            }
            END_STEP;
            if (RUN_STEP && ((PH_MASK >> 2) & 1)) { MKCTX;
                for (int cu = blockIdx.x; cu < BG * 16; cu += F.G)
                    compress_unit(F, cu, P, (const bf16_t*)(wl + WO_W1), (const bf16_t*)(wl + WO_W2), (const float*)(a->ws + WS_MISC + MI_B1) + 0 * 256,
                                  (bf16_t*)(a->ws + WS_MISC + MI_KC), (bf16_t*)(a->ws + WS_MISC + MI_VC));
                conv_phase(F, P, (bf16_t*)(F.dout + DO_XC), a->in[I_CONVW] + (size_t)0 * 4 * 2048, a->in[I_CONVB] + (size_t)0 * 2048);
            }
            END_STEP;
            if (RUN_STEP && ((PH_MASK >> 3) & 1)) { MKCTX; attn_phase(F, a, 0, 1); }
            END_STEP;
            if (RUN_STEP && ((PH_MASK >> 4) & 1)) { MKCTX; fin_phase(F, P, (bf16_t*)(F.dout + DO_R), (bf16_t*)(F.dout + DO_YC), a->in[I_SNG] + (size_t)0 * DM); }
            END_STEP;
            if (RUN_STEP && ((PH_MASK >> 5) & 1)) { MKCTX;
                bf16_t* GT = (bf16_t*)(a->ws + WS_ARENA + AR_GATES); bf16_t* MX = (bf16_t*)(a->ws + WS_ARENA + AR_MIXIN); float* TMP = (float*)(F.dout + DO_TMP);
                { pg8::Gemm g{Hg, (const bf16_t*)(wl + WO_GATE), DM, DM, DM}; pg8::GateOrder S; S.so.init(TG, DM, DM, DM, F.G, (int)blockIdx.x);
                  pg8::Epi<pg8::EK_GATE> E{GT, 3072, nullptr, 0, nullptr, nullptr}; pg8::gemm_phase(F.lds, g, S, E); }
                { pg8::Gemm g{(const bf16_t*)(F.dout + DO_R), (const bf16_t*)(wl + WO_C), 512, 512, 512}; pg8::StaticOrder S; S.init(TG, DM, 512, 512, F.G, (int)blockIdx.x);
                  pg8::Epi<pg8::EK_BR0> E{nullptr, 0, GT, 3072, TMP, nullptr}; pg8::gemm_phase(F.lds, g, S, E); }
                { pg8::Gemm g{(const bf16_t*)(F.dout + DO_YB), (const bf16_t*)(wl + WO_NSA), 512, 512, 512}; pg8::StaticOrder S; S.init(TG, DM, 512, 512, F.G, (int)blockIdx.x);
                  pg8::Epi<pg8::EK_BR1> E{nullptr, 0, GT + 1024, 3072, TMP, nullptr}; pg8::gemm_phase(F.lds, g, S, E); }
                { pg8::Gemm g{(const bf16_t*)(F.dout + DO_YC), (const bf16_t*)(wl + WO_SSD), DM, DM, DM}; pg8::StaticOrder S; S.init(TG, DM, DM, DM, F.G, (int)blockIdx.x);
                  pg8::Epi<pg8::EK_BR2> E{MX, DM, GT + 2048, 3072, TMP, nullptr}; pg8::gemm_phase(F.lds, g, S, E); }
            }
            END_STEP;
            if (RUN_STEP && ((PH_MASK >> 6) & 1)) { MKCTX;
                pg8::Gemm g{(const bf16_t*)(a->ws + WS_ARENA + AR_MIXIN), (const bf16_t*)(wl + WO_OUT), DM, DM, DM}; pg8::StaticOrder S; S.init(TG, DM, DM, DM, F.G, (int)blockIdx.x);
                pg8::Epi<pg8::EK_WOUT> E{(bf16_t*)(a->ws + WS_PRE1) + (size_t)1 * TG * DM, DM, Hg, DM, nullptr, nullptr};
                pg8::gemm_phase(F.lds, g, S, E);
            }
            END_STEP;
        }
        if (RUN_STEP && ((PH_MASK >> 7) & 1)) { MKCTX; ln1_route_phase(F, a, 0); }
        END_STEP;
        if (RUN_STEP && ((PH_MASK >> 8) & 1)) { MKCTX; gather_phase(F, a, 0); }
        END_STEP;
        if (RUN_STEP && ((PH_MASK >> 9) & 1)) { MKCTX;
            const int nrt = moe_tables(F, 0);
            pg8::Gemm g{(const bf16_t*)(a->ws + WS_ARENA + AR_XS), (const bf16_t*)(wl + WO_UP), DM, DM, DM};
            pg8::MoeOrder S{(const LAS int*)(F.lds + LDSX + LX_TILE), nrt, F.G, F.vcu, (long)256 * DM * 2, (long)256 * DM * 2, (long)1024 * DM * 2};
            pg8::Epi<pg8::EK_GLU> E{(bf16_t*)(a->ws + WS_ARENA + AR_HID), 512, nullptr, 0, nullptr, nullptr};
            pg8::gemm_phase(F.lds, g, S, E);
        }
        END_STEP;
        if (RUN_STEP && ((PH_MASK >> 10) & 1)) { MKCTX;
            const int nrt = moe_tables(F, 0);
            pg8::Gemm g{(const bf16_t*)(a->ws + WS_ARENA + AR_HID), (const bf16_t*)(wl + WO_DN), 512, 512, 512};
            pg8::MoeOrder S{(const LAS int*)(F.lds + LDSX + LX_TILE), nrt, F.G, F.vcu, (long)256 * 512 * 2, (long)256 * 512 * 2, (long)1024 * 512 * 2};
            pg8::Epi<pg8::EK_DOWN> E{(bf16_t*)(a->ws + WS_ARENA + AR_XS), DM, nullptr, 0, nullptr, (const int2*)(a->ws + WS_MISC + MI_RINFO)};
            pg8::gemm_phase(F.lds, g, S, E);
        }
        END_STEP;
        if (RUN_STEP && ((PH_MASK >> 11) & 1)) { MKCTX; ln2_phase(F, a, 0, 0 == DEPTH - 1); }
        END_STEP;
    }
    {
        unsigned char* wl = a->ws + WS_W + (size_t)1 * W_LAYER;
        bf16_t* Hb = (bf16_t*)(a->ws + WS_H);
        bf16_t* P = (bf16_t*)(a->ws + WS_ARENA + AR_P);
        {
            const bf16_t* Hg = Hb + (size_t)0 * TG * DM;
            if (RUN_STEP && ((PH_MASK >> 1) & 1)) { MKCTX;
                pg8::Gemm g{Hg, (const bf16_t*)(wl + WO_IN), DM, DM, DM}; pg8::StaticOrder S; S.init(TG, LDP, DM, DM, F.G, (int)blockIdx.x);
                pg8::Epi<pg8::EK_PROJ> E{P, LDP, nullptr, 0, nullptr, nullptr};
                pg8::gemm_phase(F.lds, g, S, E);
            }
            END_STEP;
            if (RUN_STEP && ((PH_MASK >> 2) & 1)) { MKCTX;
                for (int cu = blockIdx.x; cu < BG * 16; cu += F.G)
                    compress_unit(F, cu, P, (const bf16_t*)(wl + WO_W1), (const bf16_t*)(wl + WO_W2), (const float*)(a->ws + WS_MISC + MI_B1) + 1 * 256,
                                  (bf16_t*)(a->ws + WS_MISC + MI_KC), (bf16_t*)(a->ws + WS_MISC + MI_VC));
                conv_phase(F, P, (bf16_t*)(F.dout + DO_XC), a->in[I_CONVW] + (size_t)1 * 4 * 2048, a->in[I_CONVB] + (size_t)1 * 2048);
            }
            END_STEP;
            if (RUN_STEP && ((PH_MASK >> 3) & 1)) { MKCTX; attn_phase(F, a, 1, 0); }
            END_STEP;
            if (RUN_STEP && ((PH_MASK >> 4) & 1)) { MKCTX; fin_phase(F, P, (bf16_t*)(F.dout + DO_R), (bf16_t*)(F.dout + DO_YC), a->in[I_SNG] + (size_t)1 * DM); }
            END_STEP;
            if (RUN_STEP && ((PH_MASK >> 5) & 1)) { MKCTX;
                bf16_t* GT = (bf16_t*)(a->ws + WS_ARENA + AR_GATES); bf16_t* MX = (bf16_t*)(a->ws + WS_ARENA + AR_MIXIN); float* TMP = (float*)(F.dout + DO_TMP);
                { pg8::Gemm g{Hg, (const bf16_t*)(wl + WO_GATE), DM, DM, DM}; pg8::GateOrder S; S.so.init(TG, DM, DM, DM, F.G, (int)blockIdx.x);
                  pg8::Epi<pg8::EK_GATE> E{GT, 3072, nullptr, 0, nullptr, nullptr}; pg8::gemm_phase(F.lds, g, S, E); }
                { pg8::Gemm g{(const bf16_t*)(F.dout + DO_R), (const bf16_t*)(wl + WO_C), 512, 512, 512}; pg8::StaticOrder S; S.init(TG, DM, 512, 512, F.G, (int)blockIdx.x);
                  pg8::Epi<pg8::EK_BR0> E{nullptr, 0, GT, 3072, TMP, nullptr}; pg8::gemm_phase(F.lds, g, S, E); }
                { pg8::Gemm g{(const bf16_t*)(F.dout + DO_YB), (const bf16_t*)(wl + WO_NSA), 512, 512, 512}; pg8::StaticOrder S; S.init(TG, DM, 512, 512, F.G, (int)blockIdx.x);
                  pg8::Epi<pg8::EK_BR1> E{nullptr, 0, GT + 1024, 3072, TMP, nullptr}; pg8::gemm_phase(F.lds, g, S, E); }
                { pg8::Gemm g{(const bf16_t*)(F.dout + DO_YC), (const bf16_t*)(wl + WO_SSD), DM, DM, DM}; pg8::StaticOrder S; S.init(TG, DM, DM, DM, F.G, (int)blockIdx.x);
                  pg8::Epi<pg8::EK_BR2> E{MX, DM, GT + 2048, 3072, TMP, nullptr}; pg8::gemm_phase(F.lds, g, S, E); }
            }
            END_STEP;
            if (RUN_STEP && ((PH_MASK >> 6) & 1)) { MKCTX;
                pg8::Gemm g{(const bf16_t*)(a->ws + WS_ARENA + AR_MIXIN), (const bf16_t*)(wl + WO_OUT), DM, DM, DM}; pg8::StaticOrder S; S.init(TG, DM, DM, DM, F.G, (int)blockIdx.x);
                pg8::Epi<pg8::EK_WOUT> E{(bf16_t*)(a->ws + WS_PRE1) + (size_t)0 * TG * DM, DM, Hg, DM, nullptr, nullptr};
                pg8::gemm_phase(F.lds, g, S, E);
            }
            END_STEP;
        }
        {
            const bf16_t* Hg = Hb + (size_t)1 * TG * DM;
            if (RUN_STEP && ((PH_MASK >> 1) & 1)) { MKCTX;
                pg8::Gemm g{Hg, (const bf16_t*)(wl + WO_IN), DM, DM, DM}; pg8::StaticOrder S; S.init(TG, LDP, DM, DM, F.G, (int)blockIdx.x);
                pg8::Epi<pg8::EK_PROJ> E{P, LDP, nullptr, 0, nullptr, nullptr};
                pg8::gemm_phase(F.lds, g, S, E);
            }
            END_STEP;
            if (RUN_STEP && ((PH_MASK >> 2) & 1)) { MKCTX;
                for (int cu = blockIdx.x; cu < BG * 16; cu += F.G)
                    compress_unit(F, cu, P, (const bf16_t*)(wl + WO_W1), (const bf16_t*)(wl + WO_W2), (const float*)(a->ws + WS_MISC + MI_B1) + 1 * 256,
                                  (bf16_t*)(a->ws + WS_MISC + MI_KC), (bf16_t*)(a->ws + WS_MISC + MI_VC));
                conv_phase(F, P, (bf16_t*)(F.dout + DO_XC), a->in[I_CONVW] + (size_t)1 * 4 * 2048, a->in[I_CONVB] + (size_t)1 * 2048);
            }
            END_STEP;
            if (RUN_STEP && ((PH_MASK >> 3) & 1)) { MKCTX; attn_phase(F, a, 1, 1); }
            END_STEP;
            if (RUN_STEP && ((PH_MASK >> 4) & 1)) { MKCTX; fin_phase(F, P, (bf16_t*)(F.dout + DO_R), (bf16_t*)(F.dout + DO_YC), a->in[I_SNG] + (size_t)1 * DM); }
            END_STEP;
            if (RUN_STEP && ((PH_MASK >> 5) & 1)) { MKCTX;
                bf16_t* GT = (bf16_t*)(a->ws + WS_ARENA + AR_GATES); bf16_t* MX = (bf16_t*)(a->ws + WS_ARENA + AR_MIXIN); float* TMP = (float*)(F.dout + DO_TMP);
                { pg8::Gemm g{Hg, (const bf16_t*)(wl + WO_GATE), DM, DM, DM}; pg8::GateOrder S; S.so.init(TG, DM, DM, DM, F.G, (int)blockIdx.x);
                  pg8::Epi<pg8::EK_GATE> E{GT, 3072, nullptr, 0, nullptr, nullptr}; pg8::gemm_phase(F.lds, g, S, E); }
                { pg8::Gemm g{(const bf16_t*)(F.dout + DO_R), (const bf16_t*)(wl + WO_C), 512, 512, 512}; pg8::StaticOrder S; S.init(TG, DM, 512, 512, F.G, (int)blockIdx.x);
                  pg8::Epi<pg8::EK_BR0> E{nullptr, 0, GT, 3072, TMP, nullptr}; pg8::gemm_phase(F.lds, g, S, E); }
                { pg8::Gemm g{(const bf16_t*)(F.dout + DO_YB), (const bf16_t*)(wl + WO_NSA), 512, 512, 512}; pg8::StaticOrder S; S.init(TG, DM, 512, 512, F.G, (int)blockIdx.x);
                  pg8::Epi<pg8::EK_BR1> E{nullptr, 0, GT + 1024, 3072, TMP, nullptr}; pg8::gemm_phase(F.lds, g, S, E); }
                { pg8::Gemm g{(const bf16_t*)(F.dout + DO_YC), (const bf16_t*)(wl + WO_SSD), DM, DM, DM}; pg8::StaticOrder S; S.init(TG, DM, DM, DM, F.G, (int)blockIdx.x);
                  pg8::Epi<pg8::EK_BR2> E{MX, DM, GT + 2048, 3072, TMP, nullptr}; pg8::gemm_phase(F.lds, g, S, E); }
            }
            END_STEP;
            if (RUN_STEP && ((PH_MASK >> 6) & 1)) { MKCTX;
                pg8::Gemm g{(const bf16_t*)(a->ws + WS_ARENA + AR_MIXIN), (const bf16_t*)(wl + WO_OUT), DM, DM, DM}; pg8::StaticOrder S; S.init(TG, DM, DM, DM, F.G, (int)blockIdx.x);
                pg8::Epi<pg8::EK_WOUT> E{(bf16_t*)(a->ws + WS_PRE1) + (size_t)1 * TG * DM, DM, Hg, DM, nullptr, nullptr};
                pg8::gemm_phase(F.lds, g, S, E);
            }
            END_STEP;
        }
        if (RUN_STEP && ((PH_MASK >> 7) & 1)) { MKCTX; ln1_route_phase(F, a, 1); }
        END_STEP;
        if (RUN_STEP && ((PH_MASK >> 8) & 1)) { MKCTX; gather_phase(F, a, 1); }
        END_STEP;
        if (RUN_STEP && ((PH_MASK >> 9) & 1)) { MKCTX;
            const int nrt = moe_tables(F, 1);
            pg8::Gemm g{(const bf16_t*)(a->ws + WS_ARENA + AR_XS), (const bf16_t*)(wl + WO_UP), DM, DM, DM};
            pg8::MoeOrder S{(const LAS int*)(F.lds + LDSX + LX_TILE), nrt, F.G, F.vcu, (long)256 * DM * 2, (long)256 * DM * 2, (long)1024 * DM * 2};
            pg8::Epi<pg8::EK_GLU> E{(bf16_t*)(a->ws + WS_ARENA + AR_HID), 512, nullptr, 0, nullptr, nullptr};
            pg8::gemm_phase(F.lds, g, S, E);
        }
        END_STEP;
        if (RUN_STEP && ((PH_MASK >> 10) & 1)) { MKCTX;
            const int nrt = moe_tables(F, 1);
            pg8::Gemm g{(const bf16_t*)(a->ws + WS_ARENA + AR_HID), (const bf16_t*)(wl + WO_DN), 512, 512, 512};
            pg8::MoeOrder S{(const LAS int*)(F.lds + LDSX + LX_TILE), nrt, F.G, F.vcu, (long)256 * 512 * 2, (long)256 * 512 * 2, (long)1024 * 512 * 2};
            pg8::Epi<pg8::EK_DOWN> E{(bf16_t*)(a->ws + WS_ARENA + AR_XS), DM, nullptr, 0, nullptr, (const int2*)(a->ws + WS_MISC + MI_RINFO)};
            pg8::gemm_phase(F.lds, g, S, E);
        }
        END_STEP;
        if (RUN_STEP && ((PH_MASK >> 11) & 1)) { MKCTX; ln2_phase(F, a, 1, 1 == DEPTH - 1); }
        END_STEP;
    }
#undef RUN_STEP
#undef END_STEP
}

__global__ void dump_bf16(const bf16_t* src, float* dst, size_t n) { for (size_t i = (size_t)blockIdx.x * blockDim.x + threadIdx.x; i < n; i += (size_t)gridDim.x * blockDim.x) dst[i] = bf1(src[i]); }
#ifndef N_LAUNCH_MODE
#define N_LAUNCH_MODE 0
#endif
extern "C" void kernel_launch(void* const* d_in, const int* in_sizes, int n_in, void* d_out, int out_size, void* d_ws, size_t ws_size, hipStream_t stream) {
    static int grid = 0;
    if (grid == 0) {
        if (n_in != 32 || out_size != T_ * DM || ws_size < WS_END) { fprintf(stderr, "kernel_launch: unexpected problem (n_in %d out %d ws %zu)\n", n_in, out_size, ws_size); grid = -1; return; }
        int dev = 0, cus = 0, per_cu = 0;
        if (hipGetDevice(&dev) != hipSuccess || hipDeviceGetAttribute(&cus, hipDeviceAttributeMultiprocessorCount, dev) != hipSuccess) { grid = -1; return; }
        if (hipFuncSetAttribute((const void*)fwd_kernel, hipFuncAttributeMaxDynamicSharedMemorySize, LDS_TOTAL) != hipSuccess) { fprintf(stderr, "kernel_launch: hipFuncSetAttribute failed\n"); grid = -1; return; }
        if (hipOccupancyMaxActiveBlocksPerMultiprocessor(&per_cu, (const void*)fwd_kernel, 512, LDS_TOTAL) != hipSuccess || per_cu < 1)
            fprintf(stderr, "kernel_launch: occupancy query reports %d workgroups per CU\n", per_cu);
        (void)hipGetLastError();
        grid = cus;
    }
    if (grid < 0) return;
    (void)hipMemsetAsync((char*)d_ws + WS_CTL, 0, CTL_ZERO_BYTES, stream);
    Args a{};
    for (int i = 0; i < 32; ++i) a.in[i] = (const float*)d_in[i];
    a.out = (float*)d_out; a.ws = (unsigned char*)d_ws;
#if N_LAUNCH_MODE == 1
    a.lo = 0; a.hi = NSTEPS;
    hipLaunchKernelGGL(fwd_kernel, dim3(grid), dim3(512), LDS_TOTAL, stream, a);
#else
#ifdef DBG_STOP
    for (int s = 0; s <= DBG_STOP; ++s) { a.lo = s; a.hi = s + 1; hipLaunchKernelGGL(fwd_kernel, dim3(grid), dim3(512), LDS_TOTAL, stream, a); }
    hipLaunchKernelGGL(dump_bf16, dim3(1024), dim3(256), 0, stream, (const bf16_t*)((char*)d_ws + DBG_SRC), (float*)d_out, (size_t)T_ * DM);
#else
    for (int s = 0; s < NSTEPS; ++s) { a.lo = s; a.hi = s + 1; hipLaunchKernelGGL(fwd_kernel, dim3(grid), dim3(512), LDS_TOTAL, stream, a); }
#endif
#endif
}
```

```cpp
#define N_LAUNCH_MODE 1
#include <hip/hip_runtime.h>
#include <cstdio>
#include <cstdint>

#define LAS __attribute__((address_space(3)))
#define GAS __attribute__((address_space(1)))
typedef unsigned short bf16_t;
typedef short bf16x8 __attribute__((ext_vector_type(8)));
typedef short s16x4 __attribute__((ext_vector_type(4)));
typedef float f32x2 __attribute__((ext_vector_type(2)));
typedef float f32x4 __attribute__((ext_vector_type(4)));
typedef float f32x16 __attribute__((ext_vector_type(16)));
typedef unsigned u32x2 __attribute__((ext_vector_type(2)));
typedef unsigned u32x4 __attribute__((ext_vector_type(4)));

constexpr int T_ = 32768, SEQ = 2048, DM = 1024, NBATCH = 16, DEPTH = 2;
constexpr int NG = 2, BG = NBATCH / NG, TG = T_ / NG;
constexpr int LDP = 5120;
constexpr int C_POOL = 0, C_Q = 512, C_KV = 1024, C_Z = 1792, C_XBC = 2816, C_NG = 4864, C_DT = 4888;
constexpr int D_IN = 7976;
constexpr float LN_EPS = 1e-5f, DN_ALPHA = 1.41421356237f, LOG2E = 1.4426950408889634f;
constexpr float QSCALE = 0.125f * LOG2E;
constexpr float NEGBIG = -1e30f;
constexpr int MOE_ROWS = 69632;

constexpr size_t MiB = 1ull << 20;
constexpr size_t WS_CTL = 0, CTL_ZERO_BYTES = 65536;
constexpr size_t WS_MISC = 1 * MiB;
constexpr size_t WS_W = 8 * MiB, W_LAYER = 72 * MiB;
constexpr size_t WO_IN = 0, WO_GATE = 10 * MiB, WO_C = 16 * MiB, WO_NSA = 17 * MiB, WO_SSD = 18 * MiB, WO_OUT = 20 * MiB, WO_W1 = 22 * MiB, WO_W2 = 23 * MiB, WO_UP = 24 * MiB, WO_DN = 56 * MiB;
constexpr size_t WS_H = 152 * MiB, WS_PRE1 = 216 * MiB, WS_ARENA = 280 * MiB;
constexpr size_t AR_P = 0, AR_GATES = 0, AR_MIXIN = 96 * MiB;
constexpr size_t AR_XS = 0, AR_HID = 136 * MiB;
constexpr size_t WS_END = 484 * MiB;
constexpr size_t DO_XC = 0, DO_TMP = 0, DO_YC = 64 * MiB, DO_R = 96 * MiB, DO_YB = 112 * MiB;
constexpr size_t MI_BIAS = 0, MI_B1 = 4096, MI_KC = 65536, MI_VC = MI_KC + 262144, MI_ROUTE = 1 * MiB, MI_RINFO = 2 * MiB;
constexpr int CW_BAR = 4096, CW_WQ = 8192, CW_CNT = 12288;
constexpr int LDS_TOTAL = 147456, LDSX = 131072;
constexpr int LX_BAR = 0, LX_WQ = 16, LX_OFF = 64, LX_TILE = 256, LX_CNTL = 1536, LX_BASE = 1600, LX_ROWS = 2048;

__device__ __forceinline__ float bflo(unsigned u) { return __uint_as_float(u << 16); }
__device__ __forceinline__ float bfhi(unsigned u) { return __uint_as_float(u & 0xffff0000u); }
__device__ __forceinline__ float bf1(bf16_t b) { return __uint_as_float(((unsigned)b) << 16); }
typedef __bf16 bf16x2_t __attribute__((ext_vector_type(2)));
__device__ __forceinline__ unsigned cvt_pk_bf16(float lo, float hi) { const f32x2 v = {lo, hi}; const bf16x2_t b = __builtin_convertvector(v, bf16x2_t); return __builtin_bit_cast(unsigned, b); }
__device__ __forceinline__ bf16_t f2bf(float f) { return (bf16_t)(cvt_pk_bf16(f, 0.f) & 0xffffu); }
__device__ __forceinline__ float fexp2(float x) { return __builtin_amdgcn_exp2f(x); }
__device__ __forceinline__ float frcp(float x) { return __builtin_amdgcn_rcpf(x); }
__device__ __forceinline__ float sigmoidf_(float x) { return frcp(1.f + fexp2(-x * LOG2E)); }
__device__ __forceinline__ float siluf_(float x) { return x * sigmoidf_(x); }
__device__ __forceinline__ float wave_sum(float v) {
#pragma unroll
    for (int o = 1; o < 64; o <<= 1) v += __shfl_xor(v, o);
    return v;
}
__device__ __forceinline__ void unpack8(const u32x4 v, float (&x)[8]) {
    x[0] = bflo(v.x); x[1] = bfhi(v.x); x[2] = bflo(v.y); x[3] = bfhi(v.y); x[4] = bflo(v.z); x[5] = bfhi(v.z); x[6] = bflo(v.w); x[7] = bfhi(v.w);
}
__device__ __forceinline__ u32x4 pack8(const float (&x)[8]) {
    u32x4 w; w.x = cvt_pk_bf16(x[0], x[1]); w.y = cvt_pk_bf16(x[2], x[3]); w.z = cvt_pk_bf16(x[4], x[5]); w.w = cvt_pk_bf16(x[6], x[7]); return w;
}
#define LDS_WAIT() asm volatile("s_waitcnt lgkmcnt(0)" ::: "memory")
__device__ __forceinline__ int crow(int r, int hi) { return (r & 3) + 8 * (r >> 2) + 4 * hi; }
__device__ __forceinline__ f32x16 mfma32(bf16x8 a, bf16x8 b, f32x16 c) { return __builtin_amdgcn_mfma_f32_32x32x16_bf16(a, b, c, 0, 0, 0); }
__device__ __forceinline__ f32x4 mfma16(bf16x8 a, bf16x8 b, f32x4 c) { return __builtin_amdgcn_mfma_f32_16x16x32_bf16(a, b, c, 0, 0, 0); }
typedef short v4i16_t __attribute__((ext_vector_type(4)));
__device__ __forceinline__ s16x4 trrd(const LAS unsigned char* p) { return __builtin_bit_cast(s16x4, __builtin_amdgcn_ds_read_tr16_b64_v4i16((LAS v4i16_t*)p)); }
__device__ __forceinline__ bf16x8 cat8(s16x4 lo, s16x4 hi) { return (bf16x8){lo[0], lo[1], lo[2], lo[3], hi[0], hi[1], hi[2], hi[3]}; }

namespace pg8 {
constexpr int BM = 256, BK = 64, HALF = 128, HTB = HALF * BK * 2, STAGE_BYTES = 8 * HTB, NXCD = 8, WGM = 8;
__host__ __device__ __forceinline__ int lds_byte(int r, int c) { const int st = (r >> 4) * 2 + (c >> 5), rr = r & 15, cc = c & 31, ob = rr * 64 + cc * 2; return st * 1024 + (ob ^ (((ob >> 9) & 1) << 5)); }
__host__ __device__ __forceinline__ void stage_rc(int b, int& R, int& C) { const int st = b / 1024, sb = b % 1024, swz = sb ^ (((sb >> 9) & 1) << 5); R = (st >> 1) * 16 + swz / 64; C = (st & 1) * 32 + (swz % 64) / 2; }
__host__ __device__ __forceinline__ int perm32(int rho) { const int n = rho >> 4, i = rho & 15; return 8 * (i >> 2) + 4 * n + (i & 3); }

struct Unit { int pm, pn; long ab, bb; };
struct Gemm { const bf16_t* A; const bf16_t* Bt; int lda, ldb, K; };

struct StaticOrder {
    int nM, nN, nwg, G, c; long tsA, tsB;
    __device__ void init(int M, int N, int lda, int ldb, int G_, int c_) { nM = M / BM; nN = N / BM; nwg = nM * nN; G = G_; c = c_; tsA = (long)BM * lda * 2; tsB = (long)BM * ldb * 2; }
    __device__ bool next(int i, Unit& u) const {
        const long L = (long)i * G + c; if (L >= nwg) return false;
        int wgid = (int)L; { const int q = nwg / NXCD, r = nwg % NXCD, xcd = wgid % NXCD, off = wgid / NXCD; wgid = (xcd < r ? xcd * (q + 1) : r * (q + 1) + (xcd - r) * q) + off; }
        const int nig = WGM * nN, gid = wgid / nig, fm = gid * WGM, gsz = (nM - fm) < WGM ? (nM - fm) : WGM;
        u.pm = fm + ((wgid % nig) % gsz); u.pn = (wgid % nig) / gsz; u.ab = u.pm * tsA; u.bb = u.pn * tsB; return true;
    }
};
struct GateOrder {
    StaticOrder so;
    __device__ bool next(int i, Unit& u) const { const int base = i / 3, x = i - 3 * base; if (!so.next(base, u)) return false; u.pn += 4 * x; u.bb = u.pn * so.tsB; return true; }
};
struct MoeOrder {
    const LAS int* tile_e; int nrt, G, vcu; long tsA, tsB, eB;
    __device__ bool next(int i, Unit& u) const {
        const long L = (long)i * G + vcu; if (L >= (long)nrt * 4) return false;
        const int rt = (int)(L >> 2), pn = (int)(L & 3), e = tile_e[rt];
        u.pm = rt; u.pn = pn; u.ab = rt * tsA; u.bb = e * eB + pn * tsB; return true;
    }
};

template <class Epi, class Sched>
__device__ __forceinline__ void gemm_phase(LAS unsigned char* lds, const Gemm g, const Sched& S, const Epi& E) {
    int tid_ = threadIdx.x; asm volatile("" : "+v"(tid_));
    const int tid = tid_, wid = __builtin_amdgcn_readfirstlane(tid >> 6), lane = tid & 63, wr = wid >> 2, wc = wid & 3, fr = lane & 15, fq = lane >> 4;
    const int K = g.K, nt = K / BK;
    unsigned voffA[2], voffB[2];
#pragma unroll
    for (int i = 0; i < 2; ++i) { int R, C; stage_rc(tid * 16 + i * 8192, R, C); const int Rb = Epi::PERM ? ((R & ~31) + perm32(R & 31)) : R;
        voffA[i] = (unsigned)(R * g.lda + C) * 2u; voffB[i] = (unsigned)(Rb * g.ldb + C) * 2u; }
    const size_t kstep = (size_t)(BK * 2);
    const size_t hstepA = (size_t)HALF * g.lda * 2, hstepB = (size_t)HALF * g.ldb * 2;
    const unsigned ldsw = (unsigned)wid * 1024u;
    const int aoff = lds_byte(wr * 64 + fr, fq * 8), boff = lds_byte(wc * 32 + fr, fq * 8);
#define PG8_SA(b, h) (((b) * 2 + (h)) * HTB)
#define PG8_SB(b, h) ((4 + (b) * 2 + (h)) * HTB)
#define PG8_STAGE(bufoff, gbase, voff) do { _Pragma("unroll") for (int _i = 0; _i < 2; ++_i) \
        __builtin_amdgcn_global_load_lds((const unsigned*)((const char*)(gbase) + (voff)[_i]), (LAS unsigned*)(lds + (bufoff) + ldsw + _i * 8192), 16, 0, 0); } while (0)
#define PG8_LDA(dst, b, h) do { _Pragma("unroll") for (int m = 0; m < 4; ++m) _Pragma("unroll") for (int k = 0; k < 2; ++k) dst[m][k] = *(const LAS bf16x8*)(lds + PG8_SA(b, h) + aoff + m * 2048 + k * 1024); } while (0)
#define PG8_LDB(dst, b, h) do { _Pragma("unroll") for (int n = 0; n < 2; ++n) _Pragma("unroll") for (int k = 0; k < 2; ++k) dst[n][k] = *(const LAS bf16x8*)(lds + PG8_SB(b, h) + boff + n * 2048 + k * 1024); } while (0)
#define PG8_MMA(ai, bj, At, Bt) do { __builtin_amdgcn_s_setprio(1); _Pragma("unroll") for (int m = 0; m < 4; ++m) _Pragma("unroll") for (int n = 0; n < 2; ++n) _Pragma("unroll") for (int k = 0; k < 2; ++k) \
        acc[ai][bj][m][n] = __builtin_amdgcn_mfma_f32_16x16x32_bf16(Bt[n][k], At[m][k], acc[ai][bj][m][n], 0, 0, 0); __builtin_amdgcn_s_setprio(0); } while (0)
#define PG8_WAIT_V(n) asm volatile("s_waitcnt vmcnt(" #n ")" ::: "memory")
#define PG8_WAIT_L(n) asm volatile("s_waitcnt lgkmcnt(" #n ")" ::: "memory")
#define PG8_BAR __builtin_amdgcn_s_barrier()
#define PG8_SCHED __builtin_amdgcn_sched_barrier(0)
    Unit cur, nxt; int ui = 0;
    if (!S.next(0, cur)) return;
    f32x4 acc[2][2][4][2];
#pragma unroll
    for (int a = 0; a < 2; ++a)
#pragma unroll
        for (int b = 0; b < 2; ++b)
#pragma unroll
            for (int m = 0; m < 4; ++m)
#pragma unroll
                for (int n = 0; n < 2; ++n) acc[a][b][m][n] = (f32x4){0.f, 0.f, 0.f, 0.f};
    bf16x8 At[4][2], B0[2][2], B1[2][2];
    const char* cA = (const char*)g.A + cur.ab; const char* cB = (const char*)g.Bt + cur.bb;
    PG8_STAGE(PG8_SB(0, 0), cB, voffB); PG8_STAGE(PG8_SB(0, 1), cB + hstepB, voffB); PG8_STAGE(PG8_SA(0, 0), cA, voffA); PG8_STAGE(PG8_SA(0, 1), cA + hstepA, voffA);
    if (wr == 1) PG8_BAR;
    PG8_WAIT_V(2); PG8_BAR;
    PG8_STAGE(PG8_SB(1, 0), cB + kstep, voffB); PG8_STAGE(PG8_SA(1, 0), cA + kstep, voffA); PG8_STAGE(PG8_SB(1, 1), cB + hstepB + kstep, voffB);
    PG8_WAIT_V(6); PG8_BAR;
    for (;;) {
        const bool has_next = S.next(ui + 1, nxt);
        const char* nA = has_next ? (const char*)g.A + nxt.ab : cA; const char* nB = has_next ? (const char*)g.Bt + nxt.bb : cB;
        for (int t = 0; t < nt; t += 2) {
            const bool last = (t == nt - 2);
            const char* a1 = cA + (size_t)(t + 1) * kstep;
            const char* a2 = last ? nA : cA + (size_t)(t + 2) * kstep; const char* b2 = last ? nB : cB + (size_t)(t + 2) * kstep;
            const char* a3 = a2 + kstep; const char* b3 = b2 + kstep;
            PG8_LDB(B0, 0, 0); PG8_LDB(B1, 0, 1); PG8_SCHED; PG8_LDA(At, 0, 0); PG8_STAGE(PG8_SA(1, 1), a1 + hstepA, voffA);
            PG8_WAIT_V(8); PG8_WAIT_L(0); PG8_BAR; PG8_MMA(0, 0, At, B0); PG8_MMA(0, 1, At, B1); PG8_BAR; PG8_SCHED;
            PG8_LDA(At, 0, 1); PG8_STAGE(PG8_SB(0, 0), b2, voffB); PG8_STAGE(PG8_SB(0, 1), b2 + hstepB, voffB); PG8_STAGE(PG8_SA(0, 0), a2, voffA);
            PG8_WAIT_V(8); PG8_WAIT_L(0); PG8_BAR; PG8_MMA(1, 0, At, B0); PG8_MMA(1, 1, At, B1); PG8_BAR; PG8_SCHED;
            PG8_LDB(B0, 1, 0); PG8_LDB(B1, 1, 1); PG8_SCHED; PG8_LDA(At, 1, 0); PG8_STAGE(PG8_SA(0, 1), a2 + hstepA, voffA);
            PG8_WAIT_V(8); PG8_WAIT_L(0); PG8_BAR; PG8_MMA(0, 0, At, B0); PG8_MMA(0, 1, At, B1); PG8_BAR; PG8_SCHED;
            PG8_LDA(At, 1, 1); PG8_STAGE(PG8_SB(1, 0), b3, voffB); PG8_STAGE(PG8_SB(1, 1), b3 + hstepB, voffB); PG8_STAGE(PG8_SA(1, 0), a3, voffA);
            PG8_WAIT_V(8); PG8_WAIT_L(0); PG8_BAR; PG8_MMA(1, 0, At, B0); PG8_MMA(1, 1, At, B1); PG8_BAR; PG8_SCHED;
        }
        if (wr == 0) PG8_BAR;
        E(acc, cur, wr, wc, fr, fq);
        if (!has_next) break;
#pragma unroll
        for (int a = 0; a < 2; ++a)
#pragma unroll
            for (int b = 0; b < 2; ++b)
#pragma unroll
                for (int m = 0; m < 4; ++m)
#pragma unroll
                    for (int n = 0; n < 2; ++n) acc[a][b][m][n] = (f32x4){0.f, 0.f, 0.f, 0.f};
        cur = nxt; cA = nA; cB = nB; ++ui;
        if (wr == 1) PG8_BAR;
    }
    PG8_WAIT_V(0);
    PG8_BAR;
#undef PG8_SA
#undef PG8_SB
#undef PG8_STAGE
#undef PG8_LDA
#undef PG8_LDB
#undef PG8_MMA
#undef PG8_WAIT_V
#undef PG8_WAIT_L
#undef PG8_BAR
#undef PG8_SCHED
}

enum { EK_PROJ = 0, EK_GATE, EK_BR0, EK_BR1, EK_BR2, EK_WOUT, EK_GLU, EK_DOWN };
template <int KIND> struct Epi {
    static constexpr bool PERM = true;
    bf16_t* O; int ldo;
    const bf16_t* X; int ldx;
    float* F;
    const int2* RI;
    __device__ __forceinline__ void operator()(const f32x4 (&acc)[2][2][4][2], const Unit& u, int wr, int wc, int fr, int fq) const {
        const int row0 = u.pm * BM + wr * 64 + fr, col0 = u.pn * BM + wc * 32 + 8 * fq;
        if constexpr (KIND == EK_GLU) {
            const int hc0 = u.pn * 128 + wc * 32 + 8 * fq;
#pragma unroll
            for (int ai = 0; ai < 2; ++ai)
#pragma unroll
                for (int m = 0; m < 4; ++m) {
                    const int row = row0 + ai * HALF + m * 16; float o[8];
#pragma unroll
                    for (int n = 0; n < 2; ++n)
#pragma unroll
                        for (int j = 0; j < 4; ++j) o[4 * n + j] = siluf_(acc[ai][0][m][n][j]) * acc[ai][1][m][n][j];
                    *(u32x4*)(O + (size_t)row * ldo + hc0) = pack8(o);
                    asm volatile("" ::: "memory");
                }
        } else if constexpr (KIND == EK_DOWN) {
#pragma unroll
            for (int ai = 0; ai < 2; ++ai)
#pragma unroll
                for (int m = 0; m < 4; ++m) {
                    const int row = row0 + ai * HALF + m * 16; const int2 ri = RI[row]; const float w = __int_as_float(ri.y);
                    if (ri.x >= 0) {
#pragma unroll
                        for (int bj = 0; bj < 2; ++bj) { float o[8];
#pragma unroll
                            for (int n = 0; n < 2; ++n)
#pragma unroll
                                for (int j = 0; j < 4; ++j) o[4 * n + j] = w * acc[ai][bj][m][n][j];
                            *(u32x4*)(O + (size_t)ri.x * ldo + col0 + bj * HALF) = pack8(o); }
                    }
                    asm volatile("" ::: "memory");
                }
        } else {
            int act = 0;
            if constexpr (KIND == EK_PROJ) act = (u.pn == 2 || u.pn == 3) ? 1 : ((u.pn >= 7 && u.pn <= 10) ? 2 : 0);
#pragma unroll
            for (int ai = 0; ai < 2; ++ai)
#pragma unroll
                for (int m = 0; m < 4; ++m) {
                    const int row = row0 + ai * HALF + m * 16;
#pragma unroll
                    for (int bj = 0; bj < 2; ++bj) {
                        const int col = col0 + bj * HALF; float v[8];
#pragma unroll
                        for (int n = 0; n < 2; ++n)
#pragma unroll
                            for (int j = 0; j < 4; ++j) v[4 * n + j] = acc[ai][bj][m][n][j];
                        if constexpr (KIND == EK_PROJ) {
                            if (act == 1) {
#pragma unroll
                                for (int j = 0; j < 8; ++j) v[j] *= QSCALE;
                            } else if (act == 2) {
#pragma unroll
                                for (int j = 0; j < 8; ++j) v[j] = siluf_(v[j]);
                            }
                            *(u32x4*)(O + (size_t)row * ldo + col) = pack8(v);
                        } else if constexpr (KIND == EK_GATE) {
#pragma unroll
                            for (int j = 0; j < 8; ++j) v[j] = sigmoidf_(v[j]);
                            *(u32x4*)(O + (size_t)row * ldo + col) = pack8(v);
                        } else if constexpr (KIND == EK_BR0 || KIND == EK_BR1 || KIND == EK_BR2) {
                            float gt[8]; unpack8(*(const u32x4*)(X + (size_t)row * ldx + col), gt);
                            float* fp = F + (size_t)row * 1024 + col;
                            if constexpr (KIND == EK_BR0) {
                                *(f32x4*)fp = (f32x4){gt[0] * v[0], gt[1] * v[1], gt[2] * v[2], gt[3] * v[3]};
                                *(f32x4*)(fp + 4) = (f32x4){gt[4] * v[4], gt[5] * v[5], gt[6] * v[6], gt[7] * v[7]};
                            } else {
                                const f32x4 t0 = *(const f32x4*)fp, t1 = *(const f32x4*)(fp + 4);
                                float s[8];
#pragma unroll
                                for (int j = 0; j < 4; ++j) { s[j] = t0[j] + gt[j] * v[j]; s[4 + j] = t1[j] + gt[4 + j] * v[4 + j]; }
                                if constexpr (KIND == EK_BR1) { *(f32x4*)fp = (f32x4){s[0], s[1], s[2], s[3]}; *(f32x4*)(fp + 4) = (f32x4){s[4], s[5], s[6], s[7]}; }
                                else *(u32x4*)(O + (size_t)row * ldo + col) = pack8(s);
                            }
                        } else if constexpr (KIND == EK_WOUT) {
                            float hv[8]; unpack8(*(const u32x4*)(X + (size_t)row * ldx + col), hv);
#pragma unroll
                            for (int j = 0; j < 8; ++j) v[j] += DN_ALPHA * hv[j];
                            *(u32x4*)(O + (size_t)row * ldo + col) = pack8(v);
                        }
                        asm volatile("" ::: "memory");
                    }
                }
        }
    }
};
}

#define XB_TMO      128
#define XB_XCNT(j)  (256  + 64 * (j))
#define XB_XSUB(j)  (1280 + 64 * (j))
#define XB_XGEN(j)  (2304 + 64 * (j))
#define XB_TOP      3328
#define XB_TOPGEN   3392
#define XCD_BAR_WORDS 3456
#define XB_SPIN_CAP (1u << 20)
__device__ __forceinline__ unsigned xb_ld(unsigned* p)              { return __hip_atomic_load(p, __ATOMIC_RELAXED, __HIP_MEMORY_SCOPE_AGENT); }
__device__ __forceinline__ unsigned xb_add(unsigned* p, unsigned v) { return __hip_atomic_fetch_add(p, v, __ATOMIC_RELAXED, __HIP_MEMORY_SCOPE_AGENT); }
__device__ __forceinline__ unsigned xb_xcc_id() { return (unsigned)__builtin_amdgcn_s_getreg((3 << 11) | 20) & 0xFu; }
#define XB_SPIN(cond, bar) do { unsigned _sp = 0; while (cond) { __builtin_amdgcn_s_sleep(1); \
    if ((++_sp & 255u) == 0u) { if (xb_ld(&(bar)[XB_TMO])) break; if (_sp > XB_SPIN_CAP) { atomicAdd(&(bar)[XB_TMO], 1u); break; } } } } while (0)
struct XcdBarrier { unsigned* bar; unsigned x; volatile LAS unsigned* st; };
__device__ __forceinline__ XcdBarrier xcd_barrier_post(unsigned* bar, volatile LAS unsigned* st) {
    XcdBarrier b; b.bar = bar; b.x = xb_xcc_id(); b.st = st;
    if (threadIdx.x == 0) (void)xb_add(&bar[XB_XCNT(b.x)], 1u);
    return b;
}
__device__ __forceinline__ void xcd_barrier_complete(unsigned* bar, unsigned x, unsigned& nloc, unsigned& nx) {
    const unsigned G = gridDim.x * gridDim.y * gridDim.z;
    unsigned sum, cnt, mine, sp = 0u;
    for (;;) {
        sum = 0u; cnt = 0u; mine = 0u;
#pragma unroll
        for (unsigned j = 0; j < 16; ++j) { const unsigned c = xb_ld(&bar[XB_XCNT(j)]); sum += c; cnt += (c > 0u) ? 1u : 0u; mine = (j == x) ? c : mine; }
        if (sum == G) break;
        __builtin_amdgcn_s_sleep(1);
        if ((++sp & 255u) == 0u) { if (xb_ld(&bar[XB_TMO])) break; if (sp > XB_SPIN_CAP) { atomicAdd(&bar[XB_TMO], 1u); break; } }
    }
    nloc = mine > 0u ? mine : 1u; nx = cnt > 0u ? cnt : 1u;
}
__device__ __forceinline__ void xcd_barrier(const XcdBarrier& b) {
    asm volatile("s_waitcnt vmcnt(0)" ::: "memory");
    __syncthreads();
    if (threadIdx.x == 0) {
        unsigned* bar = b.bar;
        __builtin_amdgcn_s_waitcnt(0);
        unsigned nloc = b.st[0], nx = b.st[1];
        if (nloc == 0u) { xcd_barrier_complete(bar, b.x, nloc, nx); b.st[0] = nloc; b.st[1] = nx; }
        const unsigned old = xb_add(&bar[XB_XSUB(b.x)], 1u);
        const unsigned gen = old / nloc;
        if (old + 1u == (gen + 1u) * nloc) {
            __builtin_amdgcn_fence(__ATOMIC_RELEASE, "agent");
            asm volatile("s_waitcnt vmcnt(0)" ::: "memory");
            const unsigned og = xb_add(&bar[XB_TOP], 1u);
            const unsigned tg = og / nx;
            if (og + 1u == (tg + 1u) * nx) xb_add(&bar[XB_TOPGEN], 1u);
            else XB_SPIN(xb_ld(&bar[XB_TOPGEN]) == tg, bar);
            __builtin_amdgcn_fence(__ATOMIC_ACQUIRE, "agent");
            xb_add(&bar[XB_XGEN(b.x)], 1u);
            asm volatile("s_waitcnt vmcnt(0)" ::: "memory");
        } else {
            XB_SPIN(xb_ld(&bar[XB_XGEN(b.x)]) == gen, bar);
            __builtin_amdgcn_fence(__ATOMIC_ACQUIRE, "agent");
            asm volatile("s_waitcnt vmcnt(0)" ::: "memory");
        }
    }
    __syncthreads();
}

struct Args { const float* in[32]; float* out; unsigned char* ws; int lo, hi; };
typedef const __attribute__((address_space(4))) Args* ArgsP;
enum { I_X = 0, I_LN0G, I_LN0B, I_WIN, I_POOLW, I_POOLS, I_CKPE, I_CKW1, I_CKW2, I_CVPE, I_CVW1, I_CVW2, I_RELB, I_CONVW, I_CONVB, I_DTB, I_ALOG, I_DSKIP, I_SNG,
       I_WBP, I_WBN, I_WBS, I_WOUT, I_LN1G, I_LN1B, I_RW, I_RB, I_EW1, I_EW3, I_EW2, I_LN2G, I_LN2B };


struct Ctx {
    LAS unsigned char* lds;
    unsigned* ctl;
    unsigned char* ws; unsigned char* dout;
    int tid, lane, wave, G, vcu, gw, NGW;
};

struct Job { const float* src; size_t sbatch; int ldw, K, c0, ncols; bf16_t* dst; int dbatch_rows, ldt, drow0, mode, nbatch; };
constexpr int NJOBS = 15;
__device__ __forceinline__ Job get_job(ArgsP a, int l, int j) {
    unsigned char* wl = a->ws + WS_W + (size_t)l * W_LAYER;
    bf16_t* win = (bf16_t*)(wl + WO_IN); bf16_t* wg = (bf16_t*)(wl + WO_GATE);
    const float* w_in = a->in[I_WIN] + (size_t)l * DM * D_IN;
    Job J; J.sbatch = 0; J.dbatch_rows = 0; J.mode = 0; J.nbatch = 1; J.c0 = 0; J.drow0 = 0;
    switch (j) {
    case 0:  J.src = w_in; J.ldw = D_IN; J.K = 1024; J.c0 = 0;    J.ncols = 1792; J.dst = win; J.ldt = 1024; J.drow0 = 0; break;
    case 1:  J.src = w_in; J.ldw = D_IN; J.K = 1024; J.c0 = 1792; J.ncols = 24;   J.dst = win; J.ldt = 1024; J.drow0 = C_NG; break;
    case 2:  J.src = w_in; J.ldw = D_IN; J.K = 1024; J.c0 = 1816; J.ncols = 3072; J.dst = win; J.ldt = 1024; J.drow0 = C_Z; break;
    case 3:  J.src = w_in; J.ldw = D_IN; J.K = 1024; J.c0 = 4888; J.ncols = 16;   J.dst = win; J.ldt = 1024; J.drow0 = C_DT; break;
    case 4:  J.src = w_in; J.ldw = D_IN; J.K = 1024; J.c0 = 4904; J.ncols = 3072; J.dst = wg;  J.ldt = 1024; J.drow0 = 0; break;
    case 5:  J.src = a->in[I_WBN] + (size_t)l * 512 * 1024;  J.ldw = 1024; J.K = 512;  J.ncols = 1024; J.dst = (bf16_t*)(wl + WO_NSA); J.ldt = 512; break;
    case 6:  J.src = a->in[I_WBS] + (size_t)l * 1024 * 1024; J.ldw = 1024; J.K = 1024; J.ncols = 1024; J.dst = (bf16_t*)(wl + WO_SSD); J.ldt = 1024; break;
    case 7:  J.src = a->in[I_WOUT] + (size_t)l * 1024 * 1024; J.ldw = 1024; J.K = 1024; J.ncols = 1024; J.dst = (bf16_t*)(wl + WO_OUT); J.ldt = 1024; break;
    case 8:  J.src = a->in[I_CKW1] + (size_t)l * 2048 * 128; J.ldw = 128; J.K = 2048; J.ncols = 128; J.dst = (bf16_t*)(wl + WO_W1); J.ldt = 2048; break;
    case 9:  J.src = a->in[I_CVW1] + (size_t)l * 2048 * 128; J.ldw = 128; J.K = 2048; J.ncols = 128; J.dst = (bf16_t*)(wl + WO_W1) + 128 * 2048; J.ldt = 2048; break;
    case 10: J.src = a->in[I_CKW2] + (size_t)l * 128 * 64; J.ldw = 64; J.K = 128; J.ncols = 64; J.dst = (bf16_t*)(wl + WO_W2); J.ldt = 128; break;
    case 11: J.src = a->in[I_CVW2] + (size_t)l * 128 * 64; J.ldw = 64; J.K = 128; J.ncols = 64; J.dst = (bf16_t*)(wl + WO_W2) + 64 * 128; J.ldt = 128; break;
    case 12: J.src = a->in[I_EW1] + (size_t)l * 16 * 1024 * 512; J.sbatch = (size_t)1024 * 512; J.ldw = 512; J.K = 1024; J.ncols = 512; J.dst = (bf16_t*)(wl + WO_UP); J.dbatch_rows = 1024; J.ldt = 1024; J.drow0 = 0;   J.mode = 1; J.nbatch = 16; break;
    case 13: J.src = a->in[I_EW3] + (size_t)l * 16 * 1024 * 512; J.sbatch = (size_t)1024 * 512; J.ldw = 512; J.K = 1024; J.ncols = 512; J.dst = (bf16_t*)(wl + WO_UP); J.dbatch_rows = 1024; J.ldt = 1024; J.drow0 = 128; J.mode = 1; J.nbatch = 16; break;
    default: J.src = a->in[I_EW2] + (size_t)l * 16 * 512 * 1024; J.sbatch = (size_t)512 * 1024; J.ldw = 1024; J.K = 512; J.ncols = 1024; J.dst = (bf16_t*)(wl + WO_DN); J.dbatch_rows = 1024; J.ldt = 512; J.nbatch = 16; break;
    }
    return J;
}
__device__ __forceinline__ void tr_item(const Job& J, int item, LAS float* scr, int lane) {
    const int nblk = (J.ncols + 31) >> 5, kblk = J.K >> 6, per = nblk * kblk;
    const int bt = item / per, r = item - bt * per, kb = r / nblk, nb = r - kb * nblk, k0 = 64 * kb, n0 = 32 * nb;
    const int nv = (J.ncols - n0) < 32 ? (J.ncols - n0) : 32;
    const float* W = J.src + (size_t)bt * J.sbatch;
#pragma unroll 8
    for (int i = 0; i < 32; ++i) { const int kk = 2 * i + (lane >> 5), nn = lane & 31;
        scr[kk * 33 + nn] = (nn < nv) ? W[(size_t)(k0 + kk) * J.ldw + J.c0 + n0 + nn] : 0.f; }
    LDS_WAIT();
    const int c = lane & 7;
#pragma unroll
    for (int j = 0; j < 4; ++j) { const int n = (lane >> 3) + 8 * j;
        if (n < nv) {
            const LAS float* s = scr + (8 * c) * 33 + n; const int nn = n0 + n;
            const int drow = bt * J.dbatch_rows + J.drow0 + (J.mode == 1 ? ((nn >> 7) * 256 + (nn & 127)) : nn);
            u32x4 o; o.x = cvt_pk_bf16(s[0 * 33], s[1 * 33]); o.y = cvt_pk_bf16(s[2 * 33], s[3 * 33]); o.z = cvt_pk_bf16(s[4 * 33], s[5 * 33]); o.w = cvt_pk_bf16(s[6 * 33], s[7 * 33]);
            *(u32x4*)(J.dst + (size_t)drow * J.ldt + k0 + 8 * c) = o; } }
    LDS_WAIT();
}
__device__ __forceinline__ void ln_row_f32(const float* xrow, const float* g, const float* b, bf16_t* orow, int lane) {
    const f32x4* xr = (const f32x4*)xrow + lane; f32x4 v[4]; float s = 0.f;
#pragma unroll
    for (int j = 0; j < 4; ++j) { v[j] = xr[64 * j]; s += (v[j].x + v[j].y) + (v[j].z + v[j].w); }
    const float mean = wave_sum(s) * (1.f / DM); float s2 = 0.f;
#pragma unroll
    for (int j = 0; j < 4; ++j) { v[j] = v[j] - mean; s2 += (v[j].x * v[j].x + v[j].y * v[j].y) + (v[j].z * v[j].z + v[j].w * v[j].w); }
    const float rstd = 1.f / sqrtf(wave_sum(s2) * (1.f / DM) + LN_EPS);
    u32x2* o8 = (u32x2*)orow + lane;
#pragma unroll
    for (int j = 0; j < 4; ++j) { const f32x4 gg = ((const f32x4*)g + lane)[64 * j], bb = ((const f32x4*)b + lane)[64 * j];
        u32x2 w; w.x = cvt_pk_bf16(v[j].x * rstd * gg.x + bb.x, v[j].y * rstd * gg.y + bb.y); w.y = cvt_pk_bf16(v[j].z * rstd * gg.z + bb.z, v[j].w * rstd * gg.w + bb.w); o8[64 * j] = w; }
}
__device__ __forceinline__ int rel_bucket_dev(int n) {
    if (n < 16) return n;
    int b = 16;
    b += (n >= 19) + (n >= 21) + (n >= 24) + (n >= 27) + (n >= 31) + (n >= 35) + (n >= 40) + (n >= 46) + (n >= 52) + (n >= 59) + (n >= 67) + (n >= 77) + (n >= 87) + (n >= 99) + (n >= 113);
    return b;
}
__device__ __forceinline__ void p0_prologue(const Ctx& F, ArgsP a) {
    LAS float* scr = (LAS float*)(F.lds + F.wave * 16384);
    int base = 0;
    for (int l = 0; l < DEPTH; ++l)
        for (int j = 0; j < NJOBS; ++j) {
            const Job J = get_job(a, l, j);
            const int nitems = J.nbatch * (J.K >> 6) * ((J.ncols + 31) >> 5);
            int first = (F.gw - base) % F.NGW; if (first < 0) first += F.NGW;
            for (int it = first; it < nitems; it += F.NGW) tr_item(J, it, scr, F.lane);
            base = (base + nitems) % F.NGW;
        }
    { bf16_t* H = (bf16_t*)(a->ws + WS_H);
      for (int m = F.gw; m < T_; m += F.NGW) ln_row_f32(a->in[I_X] + (size_t)m * DM, a->in[I_LN0G], a->in[I_LN0B], H + (size_t)m * DM, F.lane); }
    { const int gt = blockIdx.x * 512 + F.tid, nthr = F.G * 512;
      for (int id = gt; id < DEPTH * 65536; id += nthr) {
          const int l = id >> 16, r = id & 65535, n = r & 1023, k8 = r >> 10, g = k8 >> 4, c0 = (k8 & 15) * 8;
          const float* pw = a->in[I_POOLW] + (size_t)l * 4 * 128 * 128 + (size_t)(g * 128 + c0) * 128;
          const float* sc = a->in[I_POOLS] + l * 512 + g * 128;
          const float* wb = a->in[I_WBP] + (size_t)l * 512 * 1024 + (size_t)(g * 128) * 1024 + n;
          float acc[8] = {0.f, 0.f, 0.f, 0.f, 0.f, 0.f, 0.f, 0.f};
          for (int d = 0; d < 128; ++d) { const float w = wb[(size_t)d * 1024] * sc[d];
#pragma unroll
              for (int i = 0; i < 8; ++i) acc[i] += pw[i * 128 + d] * w; }
          bf16_t* dst = (bf16_t*)(a->ws + WS_W + (size_t)l * W_LAYER + WO_C) + (size_t)n * 512 + g * 128 + c0;
          *(u32x4*)dst = pack8(acc);
      } }
    for (int o = F.gw; o < DEPTH * 2 * 128; o += F.NGW) {
        const int l = o >> 8, kv = (o >> 7) & 1, col = o & 127;
        const float* pe = a->in[kv ? I_CVPE : I_CKPE] + (size_t)l * 2048; const float* w1 = a->in[kv ? I_CVW1 : I_CKW1] + (size_t)l * 2048 * 128 + col;
        float s = 0.f;
        for (int k = F.lane; k < 2048; k += 64) s += pe[k] * w1[(size_t)k * 128];
        s = wave_sum(s);
        if (F.lane == 0) ((float*)(a->ws + WS_MISC + MI_B1))[o] = s;
    }
    if (blockIdx.x == 0) {
        float* bt = (float*)(a->ws + WS_MISC + MI_BIAS);
        for (int i = F.tid; i < 8 * 128; i += 512) { const int hd = i >> 7, d = i & 127;
            bt[i] = (a->in[I_RELB][rel_bucket_dev(d) * 8 + hd] - a->in[I_RELB][31 * 8 + hd]) * LOG2E; }
    }
}

__device__ __forceinline__ void conv_phase(const Ctx& F, const bf16_t* P, bf16_t* XC, const float* cw, const float* cb) {
    const int gt = blockIdx.x * 512 + F.tid, nthr = F.G * 512;
    const int c = gt & 255;
    float w[4][8], b[8];
#pragma unroll
    for (int k = 0; k < 4; ++k)
#pragma unroll
        for (int i = 0; i < 8; ++i) w[k][i] = cw[k * 2048 + 8 * c + i];
#pragma unroll
    for (int i = 0; i < 8; ++i) b[i] = cb[8 * c + i];
    for (int id = gt; id < TG * 256; id += nthr) {
        const int tl = id >> 8, s = tl & (SEQ - 1);
        float acc[8];
#pragma unroll
        for (int i = 0; i < 8; ++i) acc[i] = b[i];
#pragma unroll
        for (int k = 0; k < 4; ++k) {
            if (s - 3 + k >= 0) { float x[8]; unpack8(*(const u32x4*)(P + (size_t)(tl - 3 + k) * LDP + C_XBC + 8 * c), x);
#pragma unroll
                for (int i = 0; i < 8; ++i) acc[i] += w[k][i] * x[i]; }
        }
#pragma unroll
        for (int i = 0; i < 8; ++i) acc[i] = siluf_(acc[i]);
        *(u32x4*)(XC + (size_t)tl * 2048 + 8 * c) = pack8(acc);
    }
}
__device__ __forceinline__ void compress_unit(const Ctx& F, int cu, const bf16_t* P, const bf16_t* W1t, const bf16_t* W2t, const float* b1, bf16_t* KC, bf16_t* VC) {
    const int kv = cu & 1, g = (cu >> 1) & 1, nb = (cu >> 2) & 3, bl = cu >> 4;
    const int lane = F.lane, w = F.wave, fr = lane & 15, fq = lane >> 4;
    LAS bf16_t* hid = (LAS bf16_t*)F.lds;
    const bf16_t* w1 = W1t + (size_t)kv * 128 * 2048 + (size_t)(16 * w + fr) * 2048 + 8 * fq;
    int n0 = nb * 32 + fr, n1 = n0 + 16; if (n0 > 126) n0 = 126; if (n1 > 126) n1 = 126;
    const bf16_t* a0 = P + (size_t)(bl * SEQ + 16 * n0) * LDP + C_KV + kv * 128 + g * 64 + 8 * fq;
    const bf16_t* a1 = P + (size_t)(bl * SEQ + 16 * n1) * LDP + C_KV + kv * 128 + g * 64 + 8 * fq;
    f32x4 acc0 = {0.f, 0.f, 0.f, 0.f}, acc1 = {0.f, 0.f, 0.f, 0.f};
#pragma unroll 4
    for (int kk = 0; kk < 64; ++kk) {
        const int l = kk >> 1, d = (kk & 1) * 32;
        const bf16x8 bb = *(const bf16x8*)(w1 + kk * 32);
        const bf16x8 x0 = *(const bf16x8*)(a0 + (size_t)l * LDP + d), x1 = *(const bf16x8*)(a1 + (size_t)l * LDP + d);
        acc0 = mfma16(x0, bb, acc0); acc1 = mfma16(x1, bb, acc1);
    }
    const float bias = b1[kv * 128 + 16 * w + fr];
#pragma unroll
    for (int r = 0; r < 4; ++r) {
        float x = acc0[r] + bias, u = 0.7978845608f * (x + 0.044715f * x * x * x); hid[(4 * fq + r) * 136 + 16 * w + fr] = f2bf(x * sigmoidf_(2.f * u));
        x = acc1[r] + bias; u = 0.7978845608f * (x + 0.044715f * x * x * x); hid[(16 + 4 * fq + r) * 136 + 16 * w + fr] = f2bf(x * sigmoidf_(2.f * u));
    }
    __syncthreads();
    { const int mt = w >> 2, ntl = w & 3; f32x4 acc = {0.f, 0.f, 0.f, 0.f};
      const bf16_t* w2 = W2t + (size_t)kv * 64 * 128 + (size_t)(16 * ntl + fr) * 128 + 8 * fq;
#pragma unroll
      for (int ks = 0; ks < 4; ++ks) { const bf16x8 aa = *(const LAS bf16x8*)(hid + (mt * 16 + fr) * 136 + ks * 32 + 8 * fq); const bf16x8 bb = *(const bf16x8*)(w2 + ks * 32); acc = mfma16(aa, bb, acc); }
      bf16_t* dst = kv ? VC : KC;
#pragma unroll
      for (int r = 0; r < 4; ++r) { const int n = nb * 32 + mt * 16 + 4 * fq + r; if (n < 127) dst[(size_t)(bl * 128 + n) * 128 + g * 64 + 16 * ntl + fr] = f2bf(acc[r]); }
    }
    __syncthreads();
}

__device__ __forceinline__ void fin_phase(const Ctx& F, const bf16_t* P, bf16_t* R, bf16_t* Y, const float* normg) {
    { const int gt = blockIdx.x * 512 + F.tid, nthr = F.G * 512;
      for (int id = gt; id < TG * 64; id += nthr) {
          const int tl = id >> 6, c = id & 63, win = 2 << (c >> 4), s = tl & (SEQ - 1), cnt = (s + 1) < win ? (s + 1) : win;
          float sum[8] = {0.f, 0.f, 0.f, 0.f, 0.f, 0.f, 0.f, 0.f}, u0[8];
          unpack8(*(const u32x4*)(P + (size_t)tl * LDP + C_POOL + 8 * c), u0);
#pragma unroll
          for (int i = 0; i < 8; ++i) sum[i] = u0[i];
          for (int j = 1; j < cnt; ++j) { float x[8]; unpack8(*(const u32x4*)(P + (size_t)(tl - j) * LDP + C_POOL + 8 * c), x);
#pragma unroll
              for (int i = 0; i < 8; ++i) sum[i] += x[i]; }
          const float inv = 1.f / (float)cnt;
#pragma unroll
          for (int i = 0; i < 8; ++i) sum[i] = sum[i] * inv - u0[i];
          *(u32x4*)(R + (size_t)tl * 512 + 8 * c) = pack8(sum);
      } }
    for (int tl = F.gw; tl < TG; tl += F.NGW) {
        const int lane = F.lane; float y[16], z[16];
        { float t[8]; unpack8(*(const u32x4*)(Y + (size_t)tl * 1024 + 16 * lane), t);
#pragma unroll
          for (int i = 0; i < 8; ++i) y[i] = t[i];
          unpack8(*(const u32x4*)(Y + (size_t)tl * 1024 + 16 * lane + 8), t);
#pragma unroll
          for (int i = 0; i < 8; ++i) y[8 + i] = t[i];
          unpack8(*(const u32x4*)(P + (size_t)tl * LDP + C_Z + 16 * lane), t);
#pragma unroll
          for (int i = 0; i < 8; ++i) z[i] = t[i];
          unpack8(*(const u32x4*)(P + (size_t)tl * LDP + C_Z + 16 * lane + 8), t);
#pragma unroll
          for (int i = 0; i < 8; ++i) z[8 + i] = t[i]; }
        float ss = 0.f;
#pragma unroll
        for (int i = 0; i < 16; ++i) { y[i] *= z[i]; ss += y[i] * y[i]; }
        ss += __shfl_xor(ss, 1); ss += __shfl_xor(ss, 2); ss += __shfl_xor(ss, 4); ss += __shfl_xor(ss, 8);
        const float rstd = 1.f / sqrtf(ss * (1.f / 256.f) + LN_EPS);
        float o[8];
#pragma unroll
        for (int i = 0; i < 8; ++i) o[i] = y[i] * rstd * normg[16 * lane + i];
        *(u32x4*)(Y + (size_t)tl * 1024 + 16 * lane) = pack8(o);
#pragma unroll
        for (int i = 0; i < 8; ++i) o[i] = y[8 + i] * rstd * normg[16 * lane + 8 + i];
        *(u32x4*)(Y + (size_t)tl * 1024 + 16 * lane + 8) = pack8(o);
    }
}

constexpr int NL_KT = 0, NL_VT = 16384, NL_BIAS = 32768, NL_IMP = 34816, NL_SEL = 68608, NL_UNI = 68864;

#define NSA_STORE_TILE(buf) do { \
    *(LAS u32x4*)(lds + NL_KT + (buf) * 8192 + (tid >> 6) * 1024 + (tid & 63) * 16) = kreg; \
    *(LAS u32x4*)(lds + NL_VT + (buf) * 8192 + ((tid & 7) >> 2) * 4096 + (tid >> 3) * 64 + (tid & 3) * 16) = vreg; } while (0)

__device__ __forceinline__ void nsa_qk(const LAS unsigned char* Kt, const bf16x8 (&qB)[4], int r32, int hi, f32x16& p0, f32x16& p1) {
    p0 = (f32x16){0.f, 0.f, 0.f, 0.f, 0.f, 0.f, 0.f, 0.f, 0.f, 0.f, 0.f, 0.f, 0.f, 0.f, 0.f, 0.f}; p1 = p0;
#pragma unroll
    for (int d0 = 0; d0 < 4; ++d0) {
        const bf16x8 k0 = *(const LAS bf16x8*)(Kt + (2 * d0 + hi) * 1024 + r32 * 16);
        const bf16x8 k1 = *(const LAS bf16x8*)(Kt + (2 * d0 + hi) * 1024 + 512 + r32 * 16);
        p0 = mfma32(k0, qB[d0], p0); p1 = mfma32(k1, qB[d0], p1);
    }
}
__device__ __forceinline__ void nsa_pv(const LAS unsigned char* Vt, int lane, int hi, const f32x16& p0, const f32x16& p1, f32x16& o0, f32x16& o1) {
    bf16x8 pB[4];
    { u32x4 t; t.x = cvt_pk_bf16(p0[0], p0[1]); t.y = cvt_pk_bf16(p0[2], p0[3]); t.z = cvt_pk_bf16(p0[4], p0[5]); t.w = cvt_pk_bf16(p0[6], p0[7]); pB[0] = __builtin_bit_cast(bf16x8, t);
      t.x = cvt_pk_bf16(p0[8], p0[9]); t.y = cvt_pk_bf16(p0[10], p0[11]); t.z = cvt_pk_bf16(p0[12], p0[13]); t.w = cvt_pk_bf16(p0[14], p0[15]); pB[1] = __builtin_bit_cast(bf16x8, t);
      t.x = cvt_pk_bf16(p1[0], p1[1]); t.y = cvt_pk_bf16(p1[2], p1[3]); t.z = cvt_pk_bf16(p1[4], p1[5]); t.w = cvt_pk_bf16(p1[6], p1[7]); pB[2] = __builtin_bit_cast(bf16x8, t);
      t.x = cvt_pk_bf16(p1[8], p1[9]); t.y = cvt_pk_bf16(p1[10], p1[11]); t.z = cvt_pk_bf16(p1[12], p1[13]); t.w = cvt_pk_bf16(p1[14], p1[15]); pB[3] = __builtin_bit_cast(bf16x8, t); }
    const LAS unsigned char* vb = Vt + (4 * hi + ((lane & 15) >> 2)) * 64 + ((lane >> 4) & 1) * 32 + (lane & 3) * 8;
#pragma unroll
    for (int ks = 0; ks < 4; ++ks) {
        const bf16x8 va0 = cat8(trrd(vb + ks * 1024), trrd(vb + ks * 1024 + 512));
        const bf16x8 va1 = cat8(trrd(vb + 4096 + ks * 1024), trrd(vb + 4096 + ks * 1024 + 512));
        o0 = mfma32(va0, pB[ks], o0); o1 = mfma32(va1, pB[ks], o1);
    }
}

template <int MODE>
__device__ __forceinline__ void nsa_branch(const Ctx& F, const bf16_t* Kg, const bf16_t* Vg, unsigned tiles, int qt, int ql, unsigned mysel,
                                           const LAS float* biasH, const bf16_t* qptr, float gate, f32x16& out0, f32x16& out1) {
    LAS unsigned char* lds = F.lds; int tid_ = F.tid; asm volatile("" : "+v"(tid_)); const int tid = tid_, lane = tid & 63, r32 = lane & 31, hi = lane >> 5;
    bf16x8 qB[4];
#pragma unroll
    for (int d0 = 0; d0 < 4; ++d0) qB[d0] = *(const bf16x8*)(qptr + 16 * d0);
    float m = NEGBIG, l = 0.f;
    f32x16 o0 = (f32x16){0.f, 0.f, 0.f, 0.f, 0.f, 0.f, 0.f, 0.f, 0.f, 0.f, 0.f, 0.f, 0.f, 0.f, 0.f, 0.f}, o1 = o0;
    unsigned rem = tiles;
    int j = (MODE == 1) ? (__ffs(rem) - 1) : (31 - __clz(rem)); rem &= ~(1u << j);
    u32x4 kreg = *(const u32x4*)(Kg + (size_t)(64 * j + (tid & 63)) * LDP + 8 * (tid >> 6));
    u32x4 vreg = *(const u32x4*)(Vg + (size_t)(64 * j + (tid >> 3)) * LDP + 8 * (tid & 7));
    int buf = 0;
    for (;;) {
        NSA_STORE_TILE(buf);
        __syncthreads();
        int jn = -1;
        if (rem) { jn = (MODE == 1) ? (__ffs(rem) - 1) : (31 - __clz(rem)); rem &= ~(1u << jn);
            kreg = *(const u32x4*)(Kg + (size_t)(64 * jn + (tid & 63)) * LDP + 8 * (tid >> 6));
            vreg = *(const u32x4*)(Vg + (size_t)(64 * jn + (tid >> 3)) * LDP + 8 * (tid & 7)); }
        f32x16 p0, p1;
        nsa_qk(lds + NL_KT + buf * 8192, qB, r32, hi, p0, p1);
        const int dj = qt - j, dq = 64 * dj + ql - 4 * hi;
        const bool near = dj <= 2, edge = (MODE == 2) && (dj == 8);
        const bool selq = (MODE == 1) ? (((mysel >> j) & 1u) != 0u) : true;
        if (near || edge) {
#pragma unroll
            for (int r = 0; r < 16; ++r) {
                const int d0 = dq - ((r & 3) + 8 * (r >> 2)), d1 = d0 - 32;
                const bool v0 = selq && d0 >= 0 && (MODE == 1 || d0 < 512), v1 = selq && d1 >= 0 && (MODE == 1 || d1 < 512);
                float b0 = 0.f, b1 = 0.f;
                if (near) { const int c0 = d0 < 0 ? 0 : (d0 > 127 ? 127 : d0), c1 = d1 < 0 ? 0 : (d1 > 127 ? 127 : d1); b0 = biasH[c0]; b1 = biasH[c1]; }
                p0[r] = v0 ? p0[r] + b0 : NEGBIG; p1[r] = v1 ? p1[r] + b1 : NEGBIG;
            }
        } else if (MODE == 1) {
#pragma unroll
            for (int r = 0; r < 16; ++r) { p0[r] = selq ? p0[r] : NEGBIG; p1[r] = selq ? p1[r] : NEGBIG; }
        }
        float mx = p0[0];
#pragma unroll
        for (int r = 1; r < 16; ++r) mx = fmaxf(mx, p0[r]);
#pragma unroll
        for (int r = 0; r < 16; ++r) mx = fmaxf(mx, p1[r]);
        mx = fmaxf(mx, __shfl_xor(mx, 32));
        const float mn = fmaxf(m, mx), f = fexp2(m - mn); m = mn;
        float ls = 0.f;
#pragma unroll
        for (int r = 0; r < 16; ++r) { p0[r] = fexp2(p0[r] - mn); p1[r] = fexp2(p1[r] - mn); ls += p0[r] + p1[r]; }
        l = l * f + ls;
#pragma unroll
        for (int r = 0; r < 16; ++r) { o0[r] *= f; o1[r] *= f; }
        nsa_pv(lds + NL_VT + buf * 8192, lane, hi, p0, p1, o0, o1);
        if (jn < 0) break;
        j = jn; buf ^= 1;
    }
    __syncthreads();
    const float lt = l + __shfl_xor(l, 32), sc = gate * frcp(lt);
#pragma unroll
    for (int r = 0; r < 16; ++r) { out0[r] += sc * o0[r]; out1[r] += sc * o1[r]; }
}

__device__ __forceinline__ void nsa_unit(const Ctx& F, int bl, int g, int qt, const bf16_t* P, const bf16_t* KC, const bf16_t* VC, const float* biasT, bf16_t* YB) {
    LAS unsigned char* lds = F.lds; int tid_ = F.tid; asm volatile("" : "+v"(tid_)); const int tid = tid_, lane = tid & 63, w = F.wave, r32 = lane & 31, hi = lane >> 5;
    const int h = w >> 1, ql = 32 * (w & 1) + r32, t = 64 * qt + ql;
    const size_t row = (size_t)bl * SEQ + t;
    ((LAS float*)(lds + NL_BIAS))[tid] = biasT[(g * 4 + (tid >> 7)) * 128 + (tid & 127)];
    if (tid == 0) *(LAS unsigned*)(lds + NL_UNI) = 0u;
    const bf16_t* qptr = P + row * LDP + C_Q + g * 256 + h * 64 + 8 * hi;
    const float g_c = sigmoidf_(bf1(P[row * LDP + C_NG + g * 4 + h])), g_s = sigmoidf_(bf1(P[row * LDP + C_NG + 8 + g * 4 + h])), g_w = sigmoidf_(bf1(P[row * LDP + C_NG + 16 + g * 4 + h]));
    const LAS float* biasH = (const LAS float*)(lds + NL_BIAS) + h * 128;
    f32x16 out0 = (f32x16){0.f, 0.f, 0.f, 0.f, 0.f, 0.f, 0.f, 0.f, 0.f, 0.f, 0.f, 0.f, 0.f, 0.f, 0.f, 0.f}, out1 = out0;

    const int ntile = (qt >= 16) ? 2 : 1;
    for (int tl = 0; tl < ntile; ++tl) {
        int nk = 64 * tl + (tid & 63); if (nk > 126) nk = 126;
        int nv = 64 * tl + (tid >> 3); if (nv > 126) nv = 126;
        const u32x4 kreg = *(const u32x4*)(KC + (size_t)(bl * 128 + nk) * 128 + g * 64 + 8 * (tid >> 6));
        const u32x4 vreg = *(const u32x4*)(VC + (size_t)(bl * 128 + nv) * 128 + g * 64 + 8 * (tid & 7));
        NSA_STORE_TILE(tl);
    }
    __syncthreads();
    {
        f32x16 s0, s1, s2, s3;
        { bf16x8 qB[4];
#pragma unroll
          for (int d0 = 0; d0 < 4; ++d0) qB[d0] = *(const bf16x8*)(qptr + 16 * d0);
          nsa_qk(lds + NL_KT, qB, r32, hi, s0, s1);
          if (ntile == 2) nsa_qk(lds + NL_KT + 8192, qB, r32, hi, s2, s3);
          else { s2 = (f32x16){0.f, 0.f, 0.f, 0.f, 0.f, 0.f, 0.f, 0.f, 0.f, 0.f, 0.f, 0.f, 0.f, 0.f, 0.f, 0.f}; s3 = s2; } }
        const int db = t - 31 - 64 * hi;
        float mx = NEGBIG;
#define CMP_MASK(S, V) _Pragma("unroll") for (int r = 0; r < 16; ++r) { const int d = db - 16 * (32 * (V) + (r & 3) + 8 * (r >> 2)); \
            const int c = d < 0 ? 0 : (d > 127 ? 127 : d); S[r] = (d >= 0) ? S[r] + biasH[c] : NEGBIG; mx = fmaxf(mx, S[r]); }
        CMP_MASK(s0, 0) CMP_MASK(s1, 1)
        if (ntile == 2) { CMP_MASK(s2, 2) CMP_MASK(s3, 3) }
#undef CMP_MASK
        mx = fmaxf(mx, __shfl_xor(mx, 32));
        float ls = 0.f;
#define CMP_EXP(S) _Pragma("unroll") for (int r = 0; r < 16; ++r) { S[r] = (S[r] > -1e29f) ? fexp2(S[r] - mx) : 0.f; ls += S[r]; }
        CMP_EXP(s0) CMP_EXP(s1)
        if (ntile == 2) { CMP_EXP(s2) CMP_EXP(s3) }
#undef CMP_EXP
        ls += __shfl_xor(ls, 32);
        const float inv = ls > 0.f ? 1.f / ls : 0.f;
#pragma unroll
        for (int r = 0; r < 16; ++r) { s0[r] *= inv; s1[r] *= inv; s2[r] *= inv; s3[r] *= inv; }
        LAS float* I = (LAS float*)(lds + NL_IMP) + (h * 64 + ql) * 33 + hi;
        float yprev = 0.f;
#define CMP_IMP(S, V) _Pragma("unroll") for (int a = 0; a < 4; ++a) { const float own = S[4 * a] + S[4 * a + 1] + S[4 * a + 2] + 0.5f * S[4 * a + 3]; \
            const float y = __shfl_xor(0.5f * S[4 * a + 3], 32); I[2 * (4 * (V) + a)] = own + (hi ? y : yprev); yprev = y; }
        CMP_IMP(s0, 0) CMP_IMP(s1, 1) CMP_IMP(s2, 2) CMP_IMP(s3, 3)
#undef CMP_IMP
        f32x16 o0 = (f32x16){0.f, 0.f, 0.f, 0.f, 0.f, 0.f, 0.f, 0.f, 0.f, 0.f, 0.f, 0.f, 0.f, 0.f, 0.f, 0.f}, o1 = o0;
        nsa_pv(lds + NL_VT, lane, hi, s0, s1, o0, o1);
        if (ntile == 2) nsa_pv(lds + NL_VT + 8192, lane, hi, s2, s3, o0, o1);
#pragma unroll
        for (int r = 0; r < 16; ++r) { out0[r] += g_c * o0[r]; out1[r] += g_c * o1[r]; }
    }
    __syncthreads();
    if (w == 0) {
        const LAS float* I = (const LAS float*)(lds + NL_IMP) + lane * 33;
        float v[32];
#pragma unroll
        for (int jj = 0; jj < 32; ++jj) v[jj] = (I[jj] + I[64 * 33 + jj]) + (I[128 * 33 + jj] + I[192 * 33 + jj]);
        unsigned sel = 1u | (1u << qt) | (qt >= 1 ? (1u << (qt - 1)) : 0u);
        const int need = 8 - __popc(sel);
#pragma unroll
        for (int it = 0; it < 5; ++it) {
            if (it < need) {
                int best = -1; float bv = -1e30f;
#pragma unroll
                for (int jj = 1; jj < 32; ++jj) { const bool ok = (jj <= qt - 2) && (((sel >> jj) & 1u) == 0u) && (v[jj] > bv); bv = ok ? v[jj] : bv; best = ok ? jj : best; }
                if (best >= 0) sel |= 1u << best;
            }
        }
        ((LAS unsigned*)(lds + NL_SEL))[lane] = sel;
        atomicOr((unsigned*)(lds + NL_UNI), sel);
    }
    __syncthreads();
    const unsigned uni = *(const LAS unsigned*)(lds + NL_UNI) & ((qt >= 31) ? 0xffffffffu : ((2u << qt) - 1u));
    const unsigned mysel = ((const LAS unsigned*)(lds + NL_SEL))[ql];
    const bf16_t* Pb = P + (size_t)bl * SEQ * LDP + C_KV + g * 64;
    nsa_branch<1>(F, Pb + 256, Pb + 384, uni, qt, ql, mysel, biasH, qptr, g_s, out0, out1);
    { const int lo = qt >= 8 ? qt - 8 : 0; const unsigned wm = (((qt >= 31) ? 0xffffffffu : ((2u << qt) - 1u)) >> lo) << lo;
      nsa_branch<2>(F, Pb + 512, Pb + 640, wm, qt, ql, 0u, biasH, qptr, g_w, out0, out1); }
    bf16_t* yo = YB + row * 512 + g * 256 + h * 64 + 4 * hi;
#pragma unroll
    for (int a = 0; a < 4; ++a) {
        u32x2 w0; w0.x = cvt_pk_bf16(out0[4 * a], out0[4 * a + 1]); w0.y = cvt_pk_bf16(out0[4 * a + 2], out0[4 * a + 3]); *(u32x2*)(yo + 8 * a) = w0;
        u32x2 w1; w1.x = cvt_pk_bf16(out1[4 * a], out1[4 * a + 1]); w1.y = cvt_pk_bf16(out1[4 * a + 2], out1[4 * a + 3]); *(u32x2*)(yo + 32 + 8 * a) = w1;
    }
    __syncthreads();
}

constexpr int SL_CT = 0, SL_BT = 34816, SL_XT = 69632, SL_XD = 77824, SL_XW = 86016, SL_HT = 94208, SL_YO = 102912, SL_ACS = 119296, SL_DTV = 119808;
__device__ __forceinline__ void ssd_unit(const Ctx& F, int bl, int hd, int ph, const bf16_t* P, const bf16_t* XC, float dtb, float Aneg, float Dh, bf16_t* YP) {
    LAS unsigned char* lds = F.lds; int tid_ = F.tid; asm volatile("" : "+v"(tid_)); const int tid = tid_, lane = tid & 63, w = F.wave, r32 = lane & 31, hi = lane >> 5;
    const int g = hd >> 2, p0 = 32 * ph; const size_t rowb = (size_t)bl * SEQ;
    const int q4 = (lane & 15) >> 2, p4 = lane & 3, g1 = (lane >> 4) & 1;
    LAS float* ACS = (LAS float*)(lds + SL_ACS); LAS float* DTV = (LAS float*)(lds + SL_DTV);
    u32x4 creg[4], breg[4], xreg; float dtraw = 0.f;
#define SSD_LOAD(ch) do { const bf16_t* xc = XC + (rowb + (size_t)(ch) * 128) * 2048; \
        _Pragma("unroll") for (int i = 0; i < 4; ++i) { const int r = (tid >> 4) + 32 * i; \
            creg[i] = *(const u32x4*)(xc + (size_t)r * 2048 + 1536 + g * 128 + 8 * (tid & 15)); breg[i] = *(const u32x4*)(xc + (size_t)r * 2048 + 1024 + g * 128 + 8 * (tid & 15)); } \
        xreg = *(const u32x4*)(xc + (size_t)(tid >> 2) * 2048 + hd * 64 + p0 + 8 * (tid & 3)); \
        if (tid < 128) dtraw = bf1(P[(rowb + (size_t)(ch) * 128 + tid) * LDP + C_DT + hd]); } while (0)
    f32x16 hs = (f32x16){0.f, 0.f, 0.f, 0.f, 0.f, 0.f, 0.f, 0.f, 0.f, 0.f, 0.f, 0.f, 0.f, 0.f, 0.f, 0.f};
    SSD_LOAD(0);
    for (int ch = 0; ch < 16; ++ch) {
#pragma unroll
        for (int i = 0; i < 4; ++i) { const int r = (tid >> 4) + 32 * i;
            *(LAS u32x4*)(lds + SL_CT + r * 272 + (tid & 15) * 16) = creg[i]; *(LAS u32x4*)(lds + SL_BT + r * 272 + (tid & 15) * 16) = breg[i]; }
        *(LAS u32x4*)(lds + SL_XT + (tid >> 2) * 64 + (tid & 3) * 16) = xreg;
        if (tid < 128) { const float x = dtraw + dtb; const float dtv = x > 20.f ? x : log1pf(__expf(x)); DTV[tid] = dtv; ACS[tid] = dtv * Aneg * LOG2E; }
        __syncthreads();
        if (w == 0) { const float a0 = ACS[2 * lane], a1 = ACS[2 * lane + 1]; float s = a0 + a1;
#pragma unroll
            for (int o = 1; o < 64; o <<= 1) { const float tt = __shfl_up(s, o); if (lane >= o) s += tt; }
            ACS[2 * lane] = s - a1; ACS[2 * lane + 1] = s; }
        __syncthreads();
        { const int lrow = tid >> 2; const float dl = DTV[lrow], wl = dl * fexp2(ACS[127] - ACS[lrow]);
          float x[8], xd[8], xw[8]; unpack8(xreg, x);
#pragma unroll
          for (int i = 0; i < 8; ++i) { xd[i] = x[i] * dl; xw[i] = x[i] * wl; }
          *(LAS u32x4*)(lds + SL_XD + lrow * 64 + (tid & 3) * 16) = pack8(xd); *(LAS u32x4*)(lds + SL_XW + lrow * 64 + (tid & 3) * 16) = pack8(xw); }
        if (w >= 4) {
#pragma unroll
            for (int a = 0; a < 4; ++a) { u32x2 t; t.x = cvt_pk_bf16(hs[4 * a], hs[4 * a + 1]); t.y = cvt_pk_bf16(hs[4 * a + 2], hs[4 * a + 3]);
                *(LAS u32x2*)(lds + SL_HT + r32 * 272 + (32 * (w - 4) + 8 * a + 4 * hi) * 2) = t; }
        }
        if (ch + 1 < 16) SSD_LOAD(ch + 1);
        __syncthreads();
        f32x16 y = (f32x16){0.f, 0.f, 0.f, 0.f, 0.f, 0.f, 0.f, 0.f, 0.f, 0.f, 0.f, 0.f, 0.f, 0.f, 0.f, 0.f};
        if (w < 4) {
            const int li = w, lidx = 32 * li + r32; const float acl = ACS[lidx];
            for (int si = 0; si <= li; ++si) {
                f32x16 s = (f32x16){0.f, 0.f, 0.f, 0.f, 0.f, 0.f, 0.f, 0.f, 0.f, 0.f, 0.f, 0.f, 0.f, 0.f, 0.f, 0.f};
#pragma unroll
                for (int kk = 0; kk < 8; ++kk) {
                    const bf16x8 aa = *(const LAS bf16x8*)(lds + SL_BT + (32 * si + r32) * 272 + (16 * kk + 8 * hi) * 2);
                    const bf16x8 bb = *(const LAS bf16x8*)(lds + SL_CT + lidx * 272 + (16 * kk + 8 * hi) * 2);
                    s = mfma32(aa, bb, s);
                }
#pragma unroll
                for (int r = 0; r < 16; ++r) { const int sidx = 32 * si + crow(r, hi); const float e = fexp2(acl - ACS[sidx]); s[r] = (sidx <= lidx) ? s[r] * e : 0.f; }
                u32x4 t0, t1;
                t0.x = cvt_pk_bf16(s[0], s[1]); t0.y = cvt_pk_bf16(s[2], s[3]); t0.z = cvt_pk_bf16(s[4], s[5]); t0.w = cvt_pk_bf16(s[6], s[7]);
                t1.x = cvt_pk_bf16(s[8], s[9]); t1.y = cvt_pk_bf16(s[10], s[11]); t1.z = cvt_pk_bf16(s[12], s[13]); t1.w = cvt_pk_bf16(s[14], s[15]);
                const LAS unsigned char* xb = lds + SL_XD + (32 * si + 4 * hi + q4) * 64 + g1 * 32 + p4 * 8;
                y = mfma32(cat8(trrd(xb), trrd(xb + 512)), __builtin_bit_cast(bf16x8, t0), y);
                y = mfma32(cat8(trrd(xb + 1024), trrd(xb + 1536)), __builtin_bit_cast(bf16x8, t1), y);
            }
        } else {
            const int wi = w - 4, lidx = 32 * wi + r32;
            f32x16 yo = (f32x16){0.f, 0.f, 0.f, 0.f, 0.f, 0.f, 0.f, 0.f, 0.f, 0.f, 0.f, 0.f, 0.f, 0.f, 0.f, 0.f};
#pragma unroll
            for (int kk = 0; kk < 8; ++kk) {
                const bf16x8 aa = *(const LAS bf16x8*)(lds + SL_HT + r32 * 272 + (16 * kk + 8 * hi) * 2);
                const bf16x8 bb = *(const LAS bf16x8*)(lds + SL_CT + lidx * 272 + (16 * kk + 8 * hi) * 2);
                yo = mfma32(aa, bb, yo);
            }
            const float el = fexp2(ACS[lidx]);
#pragma unroll
            for (int r = 0; r < 16; ++r) *(LAS float*)(lds + SL_YO + wi * 4096 + r * 256 + lane * 4) = yo[r] * el;
            const float dec = fexp2(ACS[127]);
#pragma unroll
            for (int r = 0; r < 16; ++r) hs[r] *= dec;
#pragma unroll
            for (int kk = 0; kk < 8; ++kk) {
                const LAS unsigned char* ab = lds + SL_BT + (16 * kk + 8 * hi + q4) * 272 + (32 * wi + 16 * g1 + 4 * p4) * 2;
                const LAS unsigned char* bb = lds + SL_XW + (16 * kk + 8 * hi + q4) * 64 + g1 * 32 + p4 * 8;
                hs = mfma32(cat8(trrd(ab), trrd(ab + 4 * 272)), cat8(trrd(bb), trrd(bb + 256)), hs);
            }
        }
        __syncthreads();
        if (w < 4) {
            const int li = w; bf16_t* yp = YP + (rowb + (size_t)ch * 128 + 32 * li + r32) * 1024 + hd * 64 + p0 + 4 * hi;
#pragma unroll
            for (int a = 0; a < 4; ++a) {
                const u32x2 xr = *(const LAS u32x2*)(lds + SL_XT + (32 * li + r32) * 64 + (8 * a + 4 * hi) * 2);
                const float x0 = bflo(xr.x), x1 = bfhi(xr.x), x2 = bflo(xr.y), x3 = bfhi(xr.y);
                const float v0 = y[4 * a] + *(const LAS float*)(lds + SL_YO + li * 4096 + (4 * a) * 256 + lane * 4) + Dh * x0;
                const float v1 = y[4 * a + 1] + *(const LAS float*)(lds + SL_YO + li * 4096 + (4 * a + 1) * 256 + lane * 4) + Dh * x1;
                const float v2 = y[4 * a + 2] + *(const LAS float*)(lds + SL_YO + li * 4096 + (4 * a + 2) * 256 + lane * 4) + Dh * x2;
                const float v3 = y[4 * a + 3] + *(const LAS float*)(lds + SL_YO + li * 4096 + (4 * a + 3) * 256 + lane * 4) + Dh * x3;
                u32x2 o; o.x = cvt_pk_bf16(v0, v1); o.y = cvt_pk_bf16(v2, v3); *(u32x2*)(yp + 8 * a) = o;
            }
        }
        __syncthreads();
    }
#undef SSD_LOAD
}

__device__ __forceinline__ void attn_phase(const Ctx& F, ArgsP a, int l, int gi) {
    LAS unsigned char* lds = F.lds;
    const bf16_t* P = (const bf16_t*)(a->ws + WS_ARENA + AR_P);
    const bf16_t* XC = (const bf16_t*)(F.dout + DO_XC);
    bf16_t* YP = (bf16_t*)(F.dout + DO_YC); bf16_t* YB = (bf16_t*)(F.dout + DO_YB);
    const bf16_t* KC = (const bf16_t*)(a->ws + WS_MISC + MI_KC); const bf16_t* VC = (const bf16_t*)(a->ws + WS_MISC + MI_VC);
    const float* biasT = (const float*)(a->ws + WS_MISC + MI_BIAS);
    unsigned* ctr = F.ctl + CW_WQ + 64 * (l * NG + gi);
    constexpr int NSSD = BG * 16 * 2, NNSA = BG * 2 * 32;
    for (;;) {
        if (F.tid == 0) *(LAS int*)(lds + LDSX + LX_WQ) = (int)__hip_atomic_fetch_add(ctr, 1u, __ATOMIC_RELAXED, __HIP_MEMORY_SCOPE_AGENT);
        __syncthreads();
        const int item = *(const LAS int*)(lds + LDSX + LX_WQ);
        __syncthreads();
        if (item >= NSSD + NNSA) break;
        if (item < NSSD) {
            const int bl = item >> 5, hd = (item >> 1) & 15, ph = item & 1;
            ssd_unit(F, bl, hd, ph, P, XC, a->in[I_DTB][l * 16 + hd], -__expf(a->in[I_ALOG][l * 16 + hd]), a->in[I_DSKIP][l * 16 + hd], YP);
        } else {
            const int idx = item - NSSD, qt = 31 - (idx >> 4), bg = idx & 15;
            nsa_unit(F, bg >> 1, bg & 1, qt, P, KC, VC, biasT, YB);
        }
    }
}

__device__ __forceinline__ void ln1_route_phase(const Ctx& F, ArgsP a, int l) {
    LAS unsigned char* lds = F.lds; const int tid = F.tid, lane = F.lane, w = F.wave;
    LAS float* RWT = (LAS float*)lds;
    LAS int* lcnt = (LAS int*)(lds + LDSX + LX_CNTL); LAS int* lbase = (LAS int*)(lds + LDSX + LX_BASE); LAS int* rows = (LAS int*)(lds + LDSX + LX_ROWS);
    for (int i = tid; i < 16384; i += 512) RWT[(i & 15) * 1024 + (i >> 4)] = a->in[I_RW][i];
    bf16_t* H1 = (bf16_t*)(a->ws + WS_PRE1);
    const float* g = a->in[I_LN1G] + l * DM; const float* b = a->in[I_LN1B] + l * DM;
    float gg[16], bb[16], rb[16];
#pragma unroll
    for (int i = 0; i < 8; ++i) { gg[i] = g[8 * lane + i]; gg[8 + i] = g[512 + 8 * lane + i]; bb[i] = b[8 * lane + i]; bb[8 + i] = b[512 + 8 * lane + i]; }
#pragma unroll
    for (int e = 0; e < 16; ++e) rb[e] = a->in[I_RB][e];
    unsigned* gcnt = F.ctl + CW_CNT + 64 * l;
    int* route = (int*)(a->ws + WS_MISC + MI_ROUTE);
    for (int rb0 = blockIdx.x * 128; rb0 < T_; rb0 += F.G * 128) {
        if (tid < 16) lcnt[tid] = 0;
        __syncthreads();
        for (int rr = 0; rr < 16; ++rr) {
            const int rl = w * 16 + rr; const size_t row = (size_t)rb0 + rl;
            float v[16];
            { float t[8]; unpack8(*(const u32x4*)(H1 + row * DM + 8 * lane), t);
#pragma unroll
              for (int i = 0; i < 8; ++i) v[i] = t[i];
              unpack8(*(const u32x4*)(H1 + row * DM + 512 + 8 * lane), t);
#pragma unroll
              for (int i = 0; i < 8; ++i) v[8 + i] = t[i]; }
            float s = 0.f;
#pragma unroll
            for (int i = 0; i < 16; ++i) s += v[i];
            const float mean = wave_sum(s) * (1.f / DM); float s2 = 0.f;
#pragma unroll
            for (int i = 0; i < 16; ++i) { v[i] -= mean; s2 += v[i] * v[i]; }
            const float rstd = 1.f / sqrtf(wave_sum(s2) * (1.f / DM) + LN_EPS);
#pragma unroll
            for (int i = 0; i < 16; ++i) v[i] = v[i] * rstd * gg[i] + bb[i];
            { float t[8];
#pragma unroll
              for (int i = 0; i < 8; ++i) t[i] = v[i];
              *(u32x4*)(H1 + row * DM + 8 * lane) = pack8(t);
#pragma unroll
              for (int i = 0; i < 8; ++i) t[i] = v[8 + i];
              *(u32x4*)(H1 + row * DM + 512 + 8 * lane) = pack8(t); }
            float lg[16];
#pragma unroll
            for (int e = 0; e < 16; ++e) {
                const f32x4 r0 = *(const LAS f32x4*)(RWT + e * 1024 + 8 * lane), r1 = *(const LAS f32x4*)(RWT + e * 1024 + 8 * lane + 4);
                const f32x4 r2 = *(const LAS f32x4*)(RWT + e * 1024 + 512 + 8 * lane), r3 = *(const LAS f32x4*)(RWT + e * 1024 + 512 + 8 * lane + 4);
                lg[e] = (v[0] * r0[0] + v[1] * r0[1] + v[2] * r0[2] + v[3] * r0[3]) + (v[4] * r1[0] + v[5] * r1[1] + v[6] * r1[2] + v[7] * r1[3])
                      + (v[8] * r2[0] + v[9] * r2[1] + v[10] * r2[2] + v[11] * r2[3]) + (v[12] * r3[0] + v[13] * r3[1] + v[14] * r3[2] + v[15] * r3[3]);
            }
#pragma unroll
            for (int e = 0; e < 16; ++e) lg[e] = wave_sum(lg[e]);
            float mx = lg[0];
#pragma unroll
            for (int e = 1; e < 16; ++e) mx = fmaxf(mx, lg[e]);
            float pr[16], ps = 0.f;
#pragma unroll
            for (int e = 0; e < 16; ++e) { pr[e] = __expf(lg[e] - mx); ps += pr[e]; }
            const float pinv = 1.f / ps;
            float sc[16];
#pragma unroll
            for (int e = 0; e < 16; ++e) { pr[e] *= pinv; sc[e] = pr[e] + rb[e]; }
            int grp = 0; float gbest = -1e30f;
#pragma unroll
            for (int q = 0; q < 4; ++q) {
                const float s0 = sc[4 * q], s1 = sc[4 * q + 1], s2_ = sc[4 * q + 2], s3 = sc[4 * q + 3];
                const float tot = (s0 + s1) + (s2_ + s3), mn1 = fminf(fminf(s0, s1), fminf(s2_, s3));
                const float m2 = fminf(fminf(fminf(fmaxf(s0, s1), fmaxf(s0, s2_)), fminf(fmaxf(s0, s3), fmaxf(s1, s2_))), fminf(fmaxf(s1, s3), fmaxf(s2_, s3)));
                const float top2 = tot - mn1 - m2;
                if (top2 > gbest) { gbest = top2; grp = q; }
            }
            float c0 = 0.f, c1 = 0.f, c2 = 0.f, c3 = 0.f, q0 = 0.f, q1 = 0.f, q2 = 0.f, q3 = 0.f;
#pragma unroll
            for (int q = 0; q < 4; ++q) if (grp == q) { c0 = sc[4 * q]; c1 = sc[4 * q + 1]; c2 = sc[4 * q + 2]; c3 = sc[4 * q + 3]; q0 = pr[4 * q]; q1 = pr[4 * q + 1]; q2 = pr[4 * q + 2]; q3 = pr[4 * q + 3]; }
            int i0 = 0; float b0 = c0; if (c1 > b0) { b0 = c1; i0 = 1; } if (c2 > b0) { b0 = c2; i0 = 2; } if (c3 > b0) { b0 = c3; i0 = 3; }
            int i1 = -1; float b1 = -1e30f;
            if (i0 != 0 && c0 > b1) { b1 = c0; i1 = 0; } if (i0 != 1 && c1 > b1) { b1 = c1; i1 = 1; } if (i0 != 2 && c2 > b1) { b1 = c2; i1 = 2; } if (i0 != 3 && c3 > b1) { b1 = c3; i1 = 3; }
            const float w0 = (i0 == 0) ? q0 : (i0 == 1) ? q1 : (i0 == 2) ? q2 : q3, w1 = (i1 == 0) ? q0 : (i1 == 1) ? q1 : (i1 == 2) ? q2 : q3;
            const float wn = 1.f / (w0 + w1);
            if (lane == 0) {
                const int e0 = 4 * grp + i0, e1 = 4 * grp + i1;
                const int pos0 = atomicAdd((int*)(lds + LDSX + LX_CNTL) + e0, 1), pos1 = atomicAdd((int*)(lds + LDSX + LX_CNTL) + e1, 1);
                rows[rl * 8 + 0] = e0; rows[rl * 8 + 1] = e1; rows[rl * 8 + 2] = pos0; rows[rl * 8 + 3] = pos1; rows[rl * 8 + 4] = __float_as_int(w0 * wn); rows[rl * 8 + 5] = __float_as_int(w1 * wn);
            }
        }
        __syncthreads();
        if (tid < 16) lbase[tid] = (int)__hip_atomic_fetch_add(gcnt + tid, (unsigned)lcnt[tid], __ATOMIC_RELAXED, __HIP_MEMORY_SCOPE_AGENT);
        __syncthreads();
        if (tid < 128) {
            const int e0 = rows[tid * 8], e1 = rows[tid * 8 + 1]; const int t = rb0 + tid;
            route[t] = e0 | (e1 << 8); route[T_ + t] = lbase[e0] + rows[tid * 8 + 2]; route[2 * T_ + t] = lbase[e1] + rows[tid * 8 + 3];
            route[3 * T_ + t] = rows[tid * 8 + 4]; route[4 * T_ + t] = rows[tid * 8 + 5];
        }
        __syncthreads();
    }
}

__device__ __forceinline__ int moe_tables(const Ctx& F, int l) {
    LAS int* off = (LAS int*)(F.lds + LDSX + LX_OFF); LAS int* tile_e = (LAS int*)(F.lds + LDSX + LX_TILE);
    __syncthreads();
    if (F.tid == 0) { int o = 0;
        for (int e = 0; e < 16; ++e) { off[e] = o; const int c = (int)__hip_atomic_load(F.ctl + CW_CNT + 64 * l + e, __ATOMIC_RELAXED, __HIP_MEMORY_SCOPE_AGENT); const int nt = (c + 255) >> 8;
            for (int k = 0; k < nt; ++k) tile_e[(o >> 8) + k] = e; o += nt << 8; }
        off[16] = o; }
    __syncthreads();
    return off[16] >> 8;
}
__device__ __forceinline__ void gather_phase(const Ctx& F, ArgsP a, int l) {
    const int nrt = moe_tables(F, l); (void)nrt;
    const LAS int* off = (const LAS int*)(F.lds + LDSX + LX_OFF);
    const bf16_t* H1 = (const bf16_t*)(a->ws + WS_PRE1); bf16_t* XS = (bf16_t*)(a->ws + WS_ARENA + AR_XS);
    const int* route = (const int*)(a->ws + WS_MISC + MI_ROUTE); int2* rinfo = (int2*)(a->ws + WS_MISC + MI_RINFO);
    for (int t = F.gw; t < T_; t += F.NGW) {
        const int ee = route[t], e0 = ee & 255, e1 = ee >> 8;
        const int r0 = off[e0] + route[T_ + t], r1 = off[e1] + route[2 * T_ + t];
        const u32x4 v0 = *(const u32x4*)(H1 + (size_t)t * DM + 8 * F.lane), v1 = *(const u32x4*)(H1 + (size_t)t * DM + 512 + 8 * F.lane);
        *(u32x4*)(XS + (size_t)r0 * DM + 8 * F.lane) = v0; *(u32x4*)(XS + (size_t)r0 * DM + 512 + 8 * F.lane) = v1;
        *(u32x4*)(XS + (size_t)r1 * DM + 8 * F.lane) = v0; *(u32x4*)(XS + (size_t)r1 * DM + 512 + 8 * F.lane) = v1;
        if (F.lane == 0) { rinfo[r0] = make_int2(t, route[3 * T_ + t]); rinfo[r1] = make_int2(T_ + t, route[4 * T_ + t]); }
    }
    if (blockIdx.x == 0) {
        for (int e = 0; e < 16; ++e) { const int c = (int)__hip_atomic_load(F.ctl + CW_CNT + 64 * l + e, __ATOMIC_RELAXED, __HIP_MEMORY_SCOPE_AGENT);
            for (int r = off[e] + c + F.tid; r < off[e + 1]; r += 512) rinfo[r] = make_int2(-1, 0); }
    }
}

__device__ __forceinline__ void ln2_phase(const Ctx& F, ArgsP a, int l, bool last) {
    const bf16_t* H1 = (const bf16_t*)(a->ws + WS_PRE1); const bf16_t* YS = (const bf16_t*)(a->ws + WS_ARENA + AR_XS);
    bf16_t* H = (bf16_t*)(a->ws + WS_H); float* OUT = a->out;
    const float* g = a->in[I_LN2G] + l * DM; const float* b = a->in[I_LN2B] + l * DM; const int lane = F.lane;
    float gg[16], bb[16];
#pragma unroll
    for (int i = 0; i < 8; ++i) { gg[i] = g[8 * lane + i]; gg[8 + i] = g[512 + 8 * lane + i]; bb[i] = b[8 * lane + i]; bb[8 + i] = b[512 + 8 * lane + i]; }
    for (int t = F.gw; t < T_; t += F.NGW) {
        float v[16];
#pragma unroll
        for (int hf = 0; hf < 2; ++hf) { float x[8], y0[8], y1[8];
            unpack8(*(const u32x4*)(H1 + (size_t)t * DM + 512 * hf + 8 * lane), x);
            unpack8(*(const u32x4*)(YS + (size_t)t * DM + 512 * hf + 8 * lane), y0);
            unpack8(*(const u32x4*)(YS + (size_t)(T_ + t) * DM + 512 * hf + 8 * lane), y1);
#pragma unroll
            for (int i = 0; i < 8; ++i) v[8 * hf + i] = DN_ALPHA * x[i] + (y0[i] + y1[i]); }
        float s = 0.f;
#pragma unroll
        for (int i = 0; i < 16; ++i) s += v[i];
        const float mean = wave_sum(s) * (1.f / DM); float s2 = 0.f;
#pragma unroll
        for (int i = 0; i < 16; ++i) { v[i] -= mean; s2 += v[i] * v[i]; }
        const float rstd = 1.f / sqrtf(wave_sum(s2) * (1.f / DM) + LN_EPS);
#pragma unroll
        for (int i = 0; i < 16; ++i) v[i] = v[i] * rstd * gg[i] + bb[i];
        if (last) {
#pragma unroll
            for (int hf = 0; hf < 2; ++hf) { float* o = OUT + (size_t)t * DM + 512 * hf + 8 * lane;
                *(f32x4*)o = (f32x4){v[8 * hf], v[8 * hf + 1], v[8 * hf + 2], v[8 * hf + 3]}; *(f32x4*)(o + 4) = (f32x4){v[8 * hf + 4], v[8 * hf + 5], v[8 * hf + 6], v[8 * hf + 7]}; }
        } else {
#pragma unroll
            for (int hf = 0; hf < 2; ++hf) { float tt[8];
#pragma unroll
                for (int i = 0; i < 8; ++i) tt[i] = v[8 * hf + i];
                *(u32x4*)(H + (size_t)t * DM + 512 * hf + 8 * lane) = pack8(tt); }
        }
    }
}

#ifndef PH_MASK
#define PH_MASK 0xfff
#endif
constexpr int NSTEPS = 1 + DEPTH * (NG * 6 + 5);
__global__ void __launch_bounds__(512, 2) fwd_kernel(Args a_unused) {
    const ArgsP a = (ArgsP)__builtin_amdgcn_kernarg_segment_ptr();
    extern __shared__ __attribute__((aligned(16))) unsigned char smem[];
    const int wave0_ = __builtin_amdgcn_readfirstlane((int)threadIdx.x >> 6);
    Ctx F;
#define MKCTX do { int t_ = wave0_ * 64 + (int)__builtin_amdgcn_mbcnt_hi(~0u, __builtin_amdgcn_mbcnt_lo(~0u, 0u)); asm volatile("" : "+v"(t_)); F.lds = (LAS unsigned char*)smem; F.tid = t_; F.lane = t_ & 63; F.wave = wave0_; \
        F.G = gridDim.x; { const int bx = blockIdx.x; F.vcu = (F.G % 8 == 0) ? (bx % 8) * (F.G / 8) + bx / 8 : bx; } \
        F.gw = blockIdx.x * 8 + F.wave; F.NGW = F.G * 8; F.ws = a->ws; F.dout = (unsigned char*)a->out; F.ctl = (unsigned*)(a->ws + WS_CTL); } while (0)
    MKCTX;
    for (int u = F.tid; u < (LDS_TOTAL - LDSX) / 4; u += 512) ((LAS unsigned*)(F.lds + LDSX))[u] = 0u;
    __syncthreads();
    const bool multi = (a->hi - a->lo) > 1;
    XcdBarrier bar; bar.bar = F.ctl + CW_BAR; bar.x = 0; bar.st = (volatile LAS unsigned*)(F.lds + LDSX + LX_BAR);
    if (multi) bar = xcd_barrier_post(F.ctl + CW_BAR, (volatile LAS unsigned*)(F.lds + LDSX + LX_BAR));
    int step = 0;
#define RUN_STEP (step >= a->lo && step < a->hi)
#define END_STEP do { if (RUN_STEP && step + 1 < a->hi) xcd_barrier(bar); ++step; } while (0)

    if (RUN_STEP && ((PH_MASK >> 0) & 1)) { MKCTX; p0_prologue(F, a); }
    END_STEP;

    {
        unsigned char* wl = a->ws + WS_W + (size_t)0 * W_LAYER;
        bf16_t* Hb = (bf16_t*)(a->ws + WS_H);
        bf16_t* P = (bf16_t*)(a->ws + WS_ARENA + AR_P);
        {
            const bf16_t* Hg = Hb + (size_t)0 * TG * DM;
            if (RUN_STEP && ((PH_MASK >> 1) & 1)) { MKCTX;
                pg8::Gemm g{Hg, (const bf16_t*)(wl + WO_IN), DM, DM, DM}; pg8::StaticOrder S; S.init(TG, LDP, DM, DM, F.G, (int)blockIdx.x);
                pg8::Epi<pg8::EK_PROJ> E{P, LDP, nullptr, 0, nullptr, nullptr};
                pg8::gemm_phase(F.lds, g, S, E);
            }
            END_STEP;
            if (RUN_STEP && ((PH_MASK >> 2) & 1)) { MKCTX;
                for (int cu = blockIdx.x; cu < BG * 16; cu += F.G)
                    compress_unit(F, cu, P, (const bf16_t*)(wl + WO_W1), (const bf16_t*)(wl + WO_W2), (const float*)(a->ws + WS_MISC + MI_B1) + 0 * 256,
                                  (bf16_t*)(a->ws + WS_MISC + MI_KC), (bf16_t*)(a->ws + WS_MISC + MI_VC));
                conv_phase(F, P, (bf16_t*)(F.dout + DO_XC), a->in[I_CONVW] + (size_t)0 * 4 * 2048, a->in[I_CONVB] + (size_t)0 * 2048);
            }
            END_STEP;
            if (RUN_STEP && ((PH_MASK >> 3) & 1)) { MKCTX; attn_phase(F, a, 0, 0); }
            END_STEP;
            if (RUN_STEP && ((PH_MASK >> 4) & 1)) { MKCTX; fin_phase(F, P, (bf16_t*)(F.dout + DO_R), (bf16_t*)(F.dout + DO_YC), a->in[I_SNG] + (size_t)0 * DM); }
            END_STEP;
            if (RUN_STEP && ((PH_MASK >> 5) & 1)) { MKCTX;
                bf16_t* GT = (bf16_t*)(a->ws + WS_ARENA + AR_GATES); bf16_t* MX = (bf16_t*)(a->ws + WS_ARENA + AR_MIXIN); float* TMP = (float*)(F.dout + DO_TMP);
                { pg8::Gemm g{Hg, (const bf16_t*)(wl + WO_GATE), DM, DM, DM}; pg8::GateOrder S; S.so.init(TG, DM, DM, DM, F.G, (int)blockIdx.x);
                  pg8::Epi<pg8::EK_GATE> E{GT, 3072, nullptr, 0, nullptr, nullptr}; pg8::gemm_phase(F.lds, g, S, E); }
                { pg8::Gemm g{(const bf16_t*)(F.dout + DO_R), (const bf16_t*)(wl + WO_C), 512, 512, 512}; pg8::StaticOrder S; S.init(TG, DM, 512, 512, F.G, (int)blockIdx.x);
                  pg8::Epi<pg8::EK_BR0> E{nullptr, 0, GT, 3072, TMP, nullptr}; pg8::gemm_phase(F.lds, g, S, E); }
                { pg8::Gemm g{(const bf16_t*)(F.dout + DO_YB), (const bf16_t*)(wl + WO_NSA), 512, 512, 512}; pg8::StaticOrder S; S.init(TG, DM, 512, 512, F.G, (int)blockIdx.x);
                  pg8::Epi<pg8::EK_BR1> E{nullptr, 0, GT + 1024, 3072, TMP, nullptr}; pg8::gemm_phase(F.lds, g, S, E); }
                { pg8::Gemm g{(const bf16_t*)(F.dout + DO_YC), (const bf16_t*)(wl + WO_SSD), DM, DM, DM}; pg8::StaticOrder S; S.init(TG, DM, DM, DM, F.G, (int)blockIdx.x);
                  pg8::Epi<pg8::EK_BR2> E{MX, DM, GT + 2048, 3072, TMP, nullptr}; pg8::gemm_phase(F.lds, g, S, E); }
            }
            END_STEP;
            if (RUN_STEP && ((PH_MASK >> 6) & 1)) { MKCTX;
                pg8::Gemm g{(const bf16_t*)(a->ws + WS_ARENA + AR_MIXIN), (const bf16_t*)(wl + WO_OUT), DM, DM, DM}; pg8::StaticOrder S; S.init(TG, DM, DM, DM, F.G, (int)blockIdx.x);
                pg8::Epi<pg8::EK_WOUT> E{(bf16_t*)(a->ws + WS_PRE1) + (size_t)0 * TG * DM, DM, Hg, DM, nullptr, nullptr};
                pg8::gemm_phase(F.lds, g, S, E);
            }
            END_STEP;
        }
        {
            const bf16_t* Hg = Hb + (size_t)1 * TG * DM;
            if (RUN_STEP && ((PH_MASK >> 1) & 1)) { MKCTX;
                pg8::Gemm g{Hg, (const bf16_t*)(wl + WO_IN), DM, DM, DM}; pg8::StaticOrder S; S.init(TG, LDP, DM, DM, F.G, (int)blockIdx.x);
                pg8::Epi<pg8::EK_PROJ> E{P, LDP, nullptr, 0, nullptr, nullptr};
                pg8::gemm_phase(F.lds, g, S, E);
            }
            END_STEP;
            if (RUN_STEP && ((PH_MASK >> 2) & 1)) { MKCTX;
                for (int cu = blockIdx.x; cu < BG * 16; cu += F.G)
                    compress_unit(F, cu, P, (const bf16_t*)(wl + WO_W1), (const bf16_t*)(wl + WO_W2), (const float*)(a->ws + WS_MISC + MI_B1) + 0 * 256,
                                  (bf16_t*)(a->ws + WS_MISC + MI_KC), (bf16_t*)(a->ws + WS_MISC + MI_VC));
                conv_phase(F, P, (bf16_t*)(F.dout + DO_XC), a->in[I_CONVW] + (size_t)0 * 4 * 2048, a->in[I_CONVB] + (size_t)0 * 2048);
            }
            END_STEP;
            if (RUN_STEP && ((PH_MASK >> 3) & 1)) { MKCTX; attn_phase(F, a, 0, 1); }
            END_STEP;
            if (RUN_STEP && ((PH_MASK >> 4) & 1)) { MKCTX; fin_phase(F, P, (bf16_t*)(F.dout + DO_R), (bf16_t*)(F.dout + DO_YC), a->in[I_SNG] + (size_t)0 * DM); }
            END_STEP;
            if (RUN_STEP && ((PH_MASK >> 5) & 1)) { MKCTX;
                bf16_t* GT = (bf16_t*)(a->ws + WS_ARENA + AR_GATES); bf16_t* MX = (bf16_t*)(a->ws + WS_ARENA + AR_MIXIN); float* TMP = (float*)(F.dout + DO_TMP);
                { pg8::Gemm g{Hg, (const bf16_t*)(wl + WO_GATE), DM, DM, DM}; pg8::GateOrder S; S.so.init(TG, DM, DM, DM, F.G, (int)blockIdx.x);
                  pg8::Epi<pg8::EK_GATE> E{GT, 3072, nullptr, 0, nullptr, nullptr}; pg8::gemm_phase(F.lds, g, S, E); }
                { pg8::Gemm g{(const bf16_t*)(F.dout + DO_R), (const bf16_t*)(wl + WO_C), 512, 512, 512}; pg8::StaticOrder S; S.init(TG, DM, 512, 512, F.G, (int)blockIdx.x);
                  pg8::Epi<pg8::EK_BR0> E{nullptr, 0, GT, 3072, TMP, nullptr}; pg8::gemm_phase(F.lds, g, S, E); }
                { pg8::Gemm g{(const bf16_t*)(F.dout + DO_YB), (const bf16_t*)(wl + WO_NSA), 512, 512, 512}; pg8::StaticOrder S; S.init(TG, DM, 512, 512, F.G, (int)blockIdx.x);
                  pg8::Epi<pg8::EK_BR1> E{nullptr, 0, GT + 1024, 3072, TMP, nullptr}; pg8::gemm_phase(F.lds, g, S, E); }
                { pg8::Gemm g{(const bf16_t*)(F.dout + DO_YC), (const bf16_t*)(wl + WO_SSD), DM, DM, DM}; pg8::StaticOrder S; S.init(TG, DM, DM, DM, F.G, (int)blockIdx.x);
                  pg8::Epi<pg8::EK_BR2> E{MX, DM, GT + 2048, 3072, TMP, nullptr}; pg8::gemm_phase(F.lds, g, S, E); }
            }
            END_STEP;
            if (RUN_STEP && ((PH_MASK >> 6) & 1)) { MKCTX;
                pg8::Gemm g{(const bf16_t*)(a->ws + WS_ARENA + AR_MIXIN), (const bf16_t*)(wl + WO_OUT), DM, DM, DM}; pg8::StaticOrder S; S.init(TG, DM, DM, DM, F.G, (int)blockIdx.x);
                pg8::Epi<pg8::EK_WOUT> E{(bf16_t*)(a->ws + WS_PRE1) + (size_t)1 * TG * DM, DM, Hg, DM, nullptr, nullptr};
                pg8::gemm_phase(F.lds, g, S, E);
            }
            END_STEP;
        }
        if (RUN_STEP && ((PH_MASK >> 7) & 1)) { MKCTX; ln1_route_phase(F, a, 0); }
        END_STEP;
        if (RUN_STEP && ((PH_MASK >> 8) & 1)) { MKCTX; gather_phase(F, a, 0); }
        END_STEP;
        if (RUN_STEP && ((PH_MASK >> 9) & 1)) { MKCTX;
            const int nrt = moe_tables(F, 0);
            pg8::Gemm g{(const bf16_t*)(a->ws + WS_ARENA + AR_XS), (const bf16_t*)(wl + WO_UP), DM, DM, DM};
            pg8::MoeOrder S{(const LAS int*)(F.lds + LDSX + LX_TILE), nrt, F.G, F.vcu, (long)256 * DM * 2, (long)256 * DM * 2, (long)1024 * DM * 2};
            pg8::Epi<pg8::EK_GLU> E{(bf16_t*)(a->ws + WS_ARENA + AR_HID), 512, nullptr, 0, nullptr, nullptr};
            pg8::gemm_phase(F.lds, g, S, E);
        }
        END_STEP;
        if (RUN_STEP && ((PH_MASK >> 10) & 1)) { MKCTX;
            const int nrt = moe_tables(F, 0);
            pg8::Gemm g{(const bf16_t*)(a->ws + WS_ARENA + AR_HID), (const bf16_t*)(wl + WO_DN), 512, 512, 512};
            pg8::MoeOrder S{(const LAS int*)(F.lds + LDSX + LX_TILE), nrt, F.G, F.vcu, (long)256 * 512 * 2, (long)256 * 512 * 2, (long)1024 * 512 * 2};
            pg8::Epi<pg8::EK_DOWN> E{(bf16_t*)(a->ws + WS_ARENA + AR_XS), DM, nullptr, 0, nullptr, (const int2*)(a->ws + WS_MISC + MI_RINFO)};
            pg8::gemm_phase(F.lds, g, S, E);
        }
        END_STEP;
        if (RUN_STEP && ((PH_MASK >> 11) & 1)) { MKCTX; ln2_phase(F, a, 0, 0 == DEPTH - 1); }
        END_STEP;
    }
    {
        unsigned char* wl = a->ws + WS_W + (size_t)1 * W_LAYER;
        bf16_t* Hb = (bf16_t*)(a->ws + WS_H);
        bf16_t* P = (bf16_t*)(a->ws + WS_ARENA + AR_P);
        {
            const bf16_t* Hg = Hb + (size_t)0 * TG * DM;
            if (RUN_STEP && ((PH_MASK >> 1) & 1)) { MKCTX;
                pg8::Gemm g{Hg, (const bf16_t*)(wl + WO_IN), DM, DM, DM}; pg8::StaticOrder S; S.init(TG, LDP, DM, DM, F.G, (int)blockIdx.x);
                pg8::Epi<pg8::EK_PROJ> E{P, LDP, nullptr, 0, nullptr, nullptr};
                pg8::gemm_phase(F.lds, g, S, E);
            }
            END_STEP;
            if (RUN_STEP && ((PH_MASK >> 2) & 1)) { MKCTX;
                for (int cu = blockIdx.x; cu < BG * 16; cu += F.G)
                    compress_unit(F, cu, P, (const bf16_t*)(wl + WO_W1), (const bf16_t*)(wl + WO_W2), (const float*)(a->ws + WS_MISC + MI_B1) + 1 * 256,
                                  (bf16_t*)(a->ws + WS_MISC + MI_KC), (bf16_t*)(a->ws + WS_MISC + MI_VC));
                conv_phase(F, P, (bf16_t*)(F.dout + DO_XC), a->in[I_CONVW] + (size_t)1 * 4 * 2048, a->in[I_CONVB] + (size_t)1 * 2048);
            }
            END_STEP;
            if (RUN_STEP && ((PH_MASK >> 3) & 1)) { MKCTX; attn_phase(F, a, 1, 0); }
            END_STEP;
            if (RUN_STEP && ((PH_MASK >> 4) & 1)) { MKCTX; fin_phase(F, P, (bf16_t*)(F.dout + DO_R), (bf16_t*)(F.dout + DO_YC), a->in[I_SNG] + (size_t)1 * DM); }
            END_STEP;
            if (RUN_STEP && ((PH_MASK >> 5) & 1)) { MKCTX;
                bf16_t* GT = (bf16_t*)(a->ws + WS_ARENA + AR_GATES); bf16_t* MX = (bf16_t*)(a->ws + WS_ARENA + AR_MIXIN); float* TMP = (float*)(F.dout + DO_TMP);
                { pg8::Gemm g{Hg, (const bf16_t*)(wl + WO_GATE), DM, DM, DM}; pg8::GateOrder S; S.so.init(TG, DM, DM, DM, F.G, (int)blockIdx.x);
                  pg8::Epi<pg8::EK_GATE> E{GT, 3072, nullptr, 0, nullptr, nullptr}; pg8::gemm_phase(F.lds, g, S, E); }
                { pg8::Gemm g{(const bf16_t*)(F.dout + DO_R), (const bf16_t*)(wl + WO_C), 512, 512, 512}; pg8::StaticOrder S; S.init(TG, DM, 512, 512, F.G, (int)blockIdx.x);
                  pg8::Epi<pg8::EK_BR0> E{nullptr, 0, GT, 3072, TMP, nullptr}; pg8::gemm_phase(F.lds, g, S, E); }
                { pg8::Gemm g{(const bf16_t*)(F.dout + DO_YB), (const bf16_t*)(wl + WO_NSA), 512, 512, 512}; pg8::StaticOrder S; S.init(TG, DM, 512, 512, F.G, (int)blockIdx.x);
                  pg8::Epi<pg8::EK_BR1> E{nullptr, 0, GT + 1024, 3072, TMP, nullptr}; pg8::gemm_phase(F.lds, g, S, E); }
                { pg8::Gemm g{(const bf16_t*)(F.dout + DO_YC), (const bf16_t*)(wl + WO_SSD), DM, DM, DM}; pg8::StaticOrder S; S.init(TG, DM, DM, DM, F.G, (int)blockIdx.x);
                  pg8::Epi<pg8::EK_BR2> E{MX, DM, GT + 2048, 3072, TMP, nullptr}; pg8::gemm_phase(F.lds, g, S, E); }
            }
            END_STEP;
            if (RUN_STEP && ((PH_MASK >> 6) & 1)) { MKCTX;
                pg8::Gemm g{(const bf16_t*)(a->ws + WS_ARENA + AR_MIXIN), (const bf16_t*)(wl + WO_OUT), DM, DM, DM}; pg8::StaticOrder S; S.init(TG, DM, DM, DM, F.G, (int)blockIdx.x);
                pg8::Epi<pg8::EK_WOUT> E{(bf16_t*)(a->ws + WS_PRE1) + (size_t)0 * TG * DM, DM, Hg, DM, nullptr, nullptr};
                pg8::gemm_phase(F.lds, g, S, E);
            }
            END_STEP;
        }
        {
            const bf16_t* Hg = Hb + (size_t)1 * TG * DM;
            if (RUN_STEP && ((PH_MASK >> 1) & 1)) { MKCTX;
                pg8::Gemm g{Hg, (const bf16_t*)(wl + WO_IN), DM, DM, DM}; pg8::StaticOrder S; S.init(TG, LDP, DM, DM, F.G, (int)blockIdx.x);
                pg8::Epi<pg8::EK_PROJ> E{P, LDP, nullptr, 0, nullptr, nullptr};
                pg8::gemm_phase(F.lds, g, S, E);
            }
            END_STEP;
            if (RUN_STEP && ((PH_MASK >> 2) & 1)) { MKCTX;
                for (int cu = blockIdx.x; cu < BG * 16; cu += F.G)
                    compress_unit(F, cu, P, (const bf16_t*)(wl + WO_W1), (const bf16_t*)(wl + WO_W2), (const float*)(a->ws + WS_MISC + MI_B1) + 1 * 256,
                                  (bf16_t*)(a->ws + WS_MISC + MI_KC), (bf16_t*)(a->ws + WS_MISC + MI_VC));
                conv_phase(F, P, (bf16_t*)(F.dout + DO_XC), a->in[I_CONVW] + (size_t)1 * 4 * 2048, a->in[I_CONVB] + (size_t)1 * 2048);
            }
            END_STEP;
            if (RUN_STEP && ((PH_MASK >> 3) & 1)) { MKCTX; attn_phase(F, a, 1, 1); }
            END_STEP;
            if (RUN_STEP && ((PH_MASK >> 4) & 1)) { MKCTX; fin_phase(F, P, (bf16_t*)(F.dout + DO_R), (bf16_t*)(F.dout + DO_YC), a->in[I_SNG] + (size_t)1 * DM); }
            END_STEP;
            if (RUN_STEP && ((PH_MASK >> 5) & 1)) { MKCTX;
                bf16_t* GT = (bf16_t*)(a->ws + WS_ARENA + AR_GATES); bf16_t* MX = (bf16_t*)(a->ws + WS_ARENA + AR_MIXIN); float* TMP = (float*)(F.dout + DO_TMP);
                { pg8::Gemm g{Hg, (const bf16_t*)(wl + WO_GATE), DM, DM, DM}; pg8::GateOrder S; S.so.init(TG, DM, DM, DM, F.G, (int)blockIdx.x);
                  pg8::Epi<pg8::EK_GATE> E{GT, 3072, nullptr, 0, nullptr, nullptr}; pg8::gemm_phase(F.lds, g, S, E); }
                { pg8::Gemm g{(const bf16_t*)(F.dout + DO_R), (const bf16_t*)(wl + WO_C), 512, 512, 512}; pg8::StaticOrder S; S.init(TG, DM, 512, 512, F.G, (int)blockIdx.x);
                  pg8::Epi<pg8::EK_BR0> E{nullptr, 0, GT, 3072, TMP, nullptr}; pg8::gemm_phase(F.lds, g, S, E); }
                { pg8::Gemm g{(const bf16_t*)(F.dout + DO_YB), (const bf16_t*)(wl + WO_NSA), 512, 512, 512}; pg8::StaticOrder S; S.init(TG, DM, 512, 512, F.G, (int)blockIdx.x);
                  pg8::Epi<pg8::EK_BR1> E{nullptr, 0, GT + 1024, 3072, TMP, nullptr}; pg8::gemm_phase(F.lds, g, S, E); }
                { pg8::Gemm g{(const bf16_t*)(F.dout + DO_YC), (const bf16_t*)(wl + WO_SSD), DM, DM, DM}; pg8::StaticOrder S; S.init(TG, DM, DM, DM, F.G, (int)blockIdx.x);
                  pg8::Epi<pg8::EK_BR2> E{MX, DM, GT + 2048, 3072, TMP, nullptr}; pg8::gemm_phase(F.lds, g, S, E); }
            }
            END_STEP;
            if (RUN_STEP && ((PH_MASK >> 6) & 1)) { MKCTX;
                pg8::Gemm g{(const bf16_t*)(a->ws + WS_ARENA + AR_MIXIN), (const bf16_t*)(wl + WO_OUT), DM, DM, DM}; pg8::StaticOrder S; S.init(TG, DM, DM, DM, F.G, (int)blockIdx.x);
                pg8::Epi<pg8::EK_WOUT> E{(bf16_t*)(a->ws + WS_PRE1) + (size_t)1 * TG * DM, DM, Hg, DM, nullptr, nullptr};
                pg8::gemm_phase(F.lds, g, S, E);
            }
            END_STEP;
        }
        if (RUN_STEP && ((PH_MASK >> 7) & 1)) { MKCTX; ln1_route_phase(F, a, 1); }
        END_STEP;
        if (RUN_STEP && ((PH_MASK >> 8) & 1)) { MKCTX; gather_phase(F, a, 1); }
        END_STEP;
        if (RUN_STEP && ((PH_MASK >> 9) & 1)) { MKCTX;
            const int nrt = moe_tables(F, 1);
            pg8::Gemm g{(const bf16_t*)(a->ws + WS_ARENA + AR_XS), (const bf16_t*)(wl + WO_UP), DM, DM, DM};
            pg8::MoeOrder S{(const LAS int*)(F.lds + LDSX + LX_TILE), nrt, F.G, F.vcu, (long)256 * DM * 2, (long)256 * DM * 2, (long)1024 * DM * 2};
            pg8::Epi<pg8::EK_GLU> E{(bf16_t*)(a->ws + WS_ARENA + AR_HID), 512, nullptr, 0, nullptr, nullptr};
            pg8::gemm_phase(F.lds, g, S, E);
        }
        END_STEP;
        if (RUN_STEP && ((PH_MASK >> 10) & 1)) { MKCTX;
            const int nrt = moe_tables(F, 1);
            pg8::Gemm g{(const bf16_t*)(a->ws + WS_ARENA + AR_HID), (const bf16_t*)(wl + WO_DN), 512, 512, 512};
            pg8::MoeOrder S{(const LAS int*)(F.lds + LDSX + LX_TILE), nrt, F.G, F.vcu, (long)256 * 512 * 2, (long)256 * 512 * 2, (long)1024 * 512 * 2};
            pg8::Epi<pg8::EK_DOWN> E{(bf16_t*)(a->ws + WS_ARENA + AR_XS), DM, nullptr, 0, nullptr, (const int2*)(a->ws + WS_MISC + MI_RINFO)};
            pg8::gemm_phase(F.lds, g, S, E);
        }
        END_STEP;
        if (RUN_STEP && ((PH_MASK >> 11) & 1)) { MKCTX; ln2_phase(F, a, 1, 1 == DEPTH - 1); }
        END_STEP;
    }
#undef RUN_STEP
#undef END_STEP
}

__global__ void dump_bf16(const bf16_t* src, float* dst, size_t n) { for (size_t i = (size_t)blockIdx.x * blockDim.x + threadIdx.x; i < n; i += (size_t)gridDim.x * blockDim.x) dst[i] = bf1(src[i]); }
#ifndef N_LAUNCH_MODE
#define N_LAUNCH_MODE 0
#endif
extern "C" void kernel_launch(void* const* d_in, const int* in_sizes, int n_in, void* d_out, int out_size, void* d_ws, size_t ws_size, hipStream_t stream) {
    static int grid = 0;
    if (grid == 0) {
        if (n_in != 32 || out_size != T_ * DM || ws_size < WS_END) { fprintf(stderr, "kernel_launch: unexpected problem (n_in %d out %d ws %zu)\n", n_in, out_size, ws_size); grid = -1; return; }
        int dev = 0, cus = 0, per_cu = 0;
        if (hipGetDevice(&dev) != hipSuccess || hipDeviceGetAttribute(&cus, hipDeviceAttributeMultiprocessorCount, dev) != hipSuccess) { grid = -1; return; }
        if (hipFuncSetAttribute((const void*)fwd_kernel, hipFuncAttributeMaxDynamicSharedMemorySize, LDS_TOTAL) != hipSuccess) { fprintf(stderr, "kernel_launch: hipFuncSetAttribute failed\n"); grid = -1; return; }
        if (hipOccupancyMaxActiveBlocksPerMultiprocessor(&per_cu, (const void*)fwd_kernel, 512, LDS_TOTAL) != hipSuccess || per_cu < 1)
            fprintf(stderr, "kernel_launch: occupancy query reports %d workgroups per CU\n", per_cu);
        (void)hipGetLastError();
        grid = cus;
    }
    if (grid < 0) return;
    (void)hipMemsetAsync((char*)d_ws + WS_CTL, 0, CTL_ZERO_BYTES, stream);
    Args a{};
    for (int i = 0; i < 32; ++i) a.in[i] = (const float*)d_in[i];
    a.out = (float*)d_out; a.ws = (unsigned char*)d_ws;
#if N_LAUNCH_MODE == 1
    a.lo = 0; a.hi = NSTEPS;
    hipLaunchKernelGGL(fwd_kernel, dim3(grid), dim3(512), LDS_TOTAL, stream, a);
#else
#ifdef DBG_STOP
    for (int s = 0; s <= DBG_STOP; ++s) { a.lo = s; a.hi = s + 1; hipLaunchKernelGGL(fwd_kernel, dim3(grid), dim3(512), LDS_TOTAL, stream, a); }
    hipLaunchKernelGGL(dump_bf16, dim3(1024), dim3(256), 0, stream, (const bf16_t*)((char*)d_ws + DBG_SRC), (float*)d_out, (size_t)T_ * DM);
#else
    for (int s = 0; s < NSTEPS; ++s) { a.lo = s; a.hi = s + 1; hipLaunchKernelGGL(fwd_kernel, dim3(grid), dim3(512), LDS_TOTAL, stream, a); }
#endif
#endif
}
```

```cpp
#define N_LAUNCH_MODE 1
#include <hip/hip_runtime.h>
#include <cstdio>
#include <cstdint>

#define LAS __attribute__((address_space(3)))
#define GAS __attribute__((address_space(1)))
typedef unsigned short bf16_t;
typedef short bf16x8 __attribute__((ext_vector_type(8)));
typedef short s16x4 __attribute__((ext_vector_type(4)));
typedef float f32x2 __attribute__((ext_vector_type(2)));
typedef float f32x4 __attribute__((ext_vector_type(4)));
typedef float f32x16 __attribute__((ext_vector_type(16)));
typedef unsigned u32x2 __attribute__((ext_vector_type(2)));
typedef unsigned u32x4 __attribute__((ext_vector_type(4)));

constexpr int T_ = 32768, SEQ = 2048, DM = 1024, NBATCH = 16, DEPTH = 2;
constexpr int NG = 2, BG = NBATCH / NG, TG = T_ / NG;
constexpr int LDP = 5120;
constexpr int C_POOL = 0, C_Q = 512, C_KV = 1024, C_Z = 1792, C_XBC = 2816, C_NG = 4864, C_DT = 4888;
constexpr int D_IN = 7976;
constexpr float LN_EPS = 1e-5f, DN_ALPHA = 1.41421356237f, LOG2E = 1.4426950408889634f;
constexpr float QSCALE = 0.125f * LOG2E;
constexpr float NEGBIG = -1e30f;
constexpr int MOE_ROWS = 69632;

constexpr size_t MiB = 1ull << 20;
constexpr size_t WS_CTL = 0, CTL_ZERO_BYTES = 65536;
constexpr size_t WS_MISC = 1 * MiB;
constexpr size_t WS_W = 8 * MiB, W_LAYER = 72 * MiB;
constexpr size_t WO_IN = 0, WO_GATE = 10 * MiB, WO_C = 16 * MiB, WO_NSA = 17 * MiB, WO_SSD = 18 * MiB, WO_OUT = 20 * MiB, WO_W1 = 22 * MiB, WO_W2 = 23 * MiB, WO_UP = 24 * MiB, WO_DN = 56 * MiB;
constexpr size_t WS_H = 152 * MiB, WS_PRE1 = 216 * MiB, WS_ARENA = 280 * MiB;
constexpr size_t AR_P = 0, AR_GATES = 0, AR_MIXIN = 96 * MiB;
constexpr size_t AR_XS = 0, AR_HID = 136 * MiB;
constexpr size_t WS_END = 484 * MiB;
constexpr size_t DO_XC = 0, DO_TMP = 0, DO_YC = 64 * MiB, DO_R = 96 * MiB, DO_YB = 112 * MiB;
constexpr size_t MI_BIAS = 0, MI_B1 = 4096, MI_KC = 65536, MI_VC = MI_KC + 262144, MI_ROUTE = 1 * MiB, MI_RINFO = 2 * MiB;
constexpr int CW_BAR = 4096, CW_WQ = 8192, CW_CNT = 12288;
constexpr int LDS_TOTAL = 147456, LDSX = 131072;
constexpr int LX_BAR = 0, LX_WQ = 16, LX_OFF = 64, LX_TILE = 256, LX_CNTL = 1536, LX_BASE = 1600, LX_ROWS = 2048;

__device__ __forceinline__ float bflo(unsigned u) { return __uint_as_float(u << 16); }
__device__ __forceinline__ float bfhi(unsigned u) { return __uint_as_float(u & 0xffff0000u); }
__device__ __forceinline__ float bf1(bf16_t b) { return __uint_as_float(((unsigned)b) << 16); }
typedef __bf16 bf16x2_t __attribute__((ext_vector_type(2)));
__device__ __forceinline__ unsigned cvt_pk_bf16(float lo, float hi) { const f32x2 v = {lo, hi}; const bf16x2_t b = __builtin_convertvector(v, bf16x2_t); return __builtin_bit_cast(unsigned, b); }
__device__ __forceinline__ bf16_t f2bf(float f) { return (bf16_t)(cvt_pk_bf16(f, 0.f) & 0xffffu); }
__device__ __forceinline__ float fexp2(float x) { return __builtin_amdgcn_exp2f(x); }
__device__ __forceinline__ float frcp(float x) { return __builtin_amdgcn_rcpf(x); }
__device__ __forceinline__ float sigmoidf_(float x) { return frcp(1.f + fexp2(-x * LOG2E)); }
__device__ __forceinline__ float siluf_(float x) { return x * sigmoidf_(x); }
__device__ __forceinline__ float wave_sum(float v) {
#pragma unroll
    for (int o = 1; o < 64; o <<= 1) v += __shfl_xor(v, o);
    return v;
}
__device__ __forceinline__ void unpack8(const u32x4 v, float (&x)[8]) {
    x[0] = bflo(v.x); x[1] = bfhi(v.x); x[2] = bflo(v.y); x[3] = bfhi(v.y); x[4] = bflo(v.z); x[5] = bfhi(v.z); x[6] = bflo(v.w); x[7] = bfhi(v.w);
}
__device__ __forceinline__ u32x4 pack8(const float (&x)[8]) {
    u32x4 w; w.x = cvt_pk_bf16(x[0], x[1]); w.y = cvt_pk_bf16(x[2], x[3]); w.z = cvt_pk_bf16(x[4], x[5]); w.w = cvt_pk_bf16(x[6], x[7]); return w;
}
#define LDS_WAIT() asm volatile("s_waitcnt lgkmcnt(0)" ::: "memory")
__device__ __forceinline__ int crow(int r, int hi) { return (r & 3) + 8 * (r >> 2) + 4 * hi; }
__device__ __forceinline__ f32x16 mfma32(bf16x8 a, bf16x8 b, f32x16 c) { return __builtin_amdgcn_mfma_f32_32x32x16_bf16(a, b, c, 0, 0, 0); }
__device__ __forceinline__ f32x4 mfma16(bf16x8 a, bf16x8 b, f32x4 c) { return __builtin_amdgcn_mfma_f32_16x16x32_bf16(a, b, c, 0, 0, 0); }
typedef short v4i16_t __attribute__((ext_vector_type(4)));
__device__ __forceinline__ s16x4 trrd(const LAS unsigned char* p) { return __builtin_bit_cast(s16x4, __builtin_amdgcn_ds_read_tr16_b64_v4i16((LAS v4i16_t*)p)); }
__device__ __forceinline__ bf16x8 cat8(s16x4 lo, s16x4 hi) { return (bf16x8){lo[0], lo[1], lo[2], lo[3], hi[0], hi[1], hi[2], hi[3]}; }

namespace pg8 {
constexpr int BM = 256, BK = 64, HALF = 128, HTB = HALF * BK * 2, STAGE_BYTES = 8 * HTB, NXCD = 8, WGM = 8;
__host__ __device__ __forceinline__ int lds_byte(int r, int c) { const int st = (r >> 4) * 2 + (c >> 5), rr = r & 15, cc = c & 31, ob = rr * 64 + cc * 2; return st * 1024 + (ob ^ (((ob >> 9) & 1) << 5)); }
__host__ __device__ __forceinline__ void stage_rc(int b, int& R, int& C) { const int st = b / 1024, sb = b % 1024, swz = sb ^ (((sb >> 9) & 1) << 5); R = (st >> 1) * 16 + swz / 64; C = (st & 1) * 32 + (swz % 64) / 2; }
__host__ __device__ __forceinline__ int perm32(int rho) { const int n = rho >> 4, i = rho & 15; return 8 * (i >> 2) + 4 * n + (i & 3); }

struct Unit { int pm, pn; long ab, bb; };
struct Gemm { const bf16_t* A; const bf16_t* Bt; int lda, ldb, K; };

struct StaticOrder {
    int nM, nN, nwg, G, c; long tsA, tsB;
    __device__ void init(int M, int N, int lda, int ldb, int G_, int c_) { nM = M / BM; nN = N / BM; nwg = nM * nN; G = G_; c = c_; tsA = (long)BM * lda * 2; tsB = (long)BM * ldb * 2; }
    __device__ bool next(int i, Unit& u) const {
        const long L = (long)i * G + c; if (L >= nwg) return false;
        int wgid = (int)L; { const int q = nwg / NXCD, r = nwg % NXCD, xcd = wgid % NXCD, off = wgid / NXCD; wgid = (xcd < r ? xcd * (q + 1) : r * (q + 1) + (xcd - r) * q) + off; }
        const int nig = WGM * nN, gid = wgid / nig, fm = gid * WGM, gsz = (nM - fm) < WGM ? (nM - fm) : WGM;
        u.pm = fm + ((wgid % nig) % gsz); u.pn = (wgid % nig) / gsz; u.ab = u.pm * tsA; u.bb = u.pn * tsB; return true;
    }
};
struct GateOrder {
    StaticOrder so;
    __device__ bool next(int i, Unit& u) const { const int base = i / 3, x = i - 3 * base; if (!so.next(base, u)) return false; u.pn += 4 * x; u.bb = u.pn * so.tsB; return true; }
};
struct MoeOrder {
    const LAS int* tile_e; int nrt, G, vcu; long tsA, tsB, eB;
    __device__ bool next(int i, Unit& u) const {
        const long L = (long)i * G + vcu; if (L >= (long)nrt * 4) return false;
        const int rt = (int)(L >> 2), pn = (int)(L & 3), e = tile_e[rt];
        u.pm = rt; u.pn = pn; u.ab = rt * tsA; u.bb = e * eB + pn * tsB; return true;
    }
};

template <class Epi, class Sched>
__device__ __forceinline__ void gemm_phase(LAS unsigned char* lds, int tid_, const Gemm g, const Sched& S, const Epi& E) {
    asm volatile("" : "+v"(tid_));
    const int tid = tid_, wid = __builtin_amdgcn_readfirstlane(tid >> 6), lane = tid & 63, wr = wid >> 2, wc = wid & 3, fr = lane & 15, fq = lane >> 4;
    const int K = g.K, nt = K / BK;
    unsigned voffA[2], voffB[2];
#pragma unroll
    for (int i = 0; i < 2; ++i) { int R, C; stage_rc(tid * 16 + i * 8192, R, C); const int Rb = Epi::PERM ? ((R & ~31) + perm32(R & 31)) : R;
        voffA[i] = (unsigned)(R * g.lda + C) * 2u; voffB[i] = (unsigned)(Rb * g.ldb + C) * 2u; }
    const size_t kstep = (size_t)(BK * 2);
    const size_t hstepA = (size_t)HALF * g.lda * 2, hstepB = (size_t)HALF * g.ldb * 2;
    const unsigned ldsw = (unsigned)wid * 1024u;
    const int aoff = lds_byte(wr * 64 + fr, fq * 8), boff = lds_byte(wc * 32 + fr, fq * 8);
#define PG8_SA(b, h) (((b) * 2 + (h)) * HTB)
#define PG8_SB(b, h) ((4 + (b) * 2 + (h)) * HTB)
#define PG8_STAGE(bufoff, gbase, voff) do { _Pragma("unroll") for (int _i = 0; _i < 2; ++_i) \
        __builtin_amdgcn_global_load_lds((const unsigned*)((const char*)(gbase) + (voff)[_i]), (LAS unsigned*)(lds + (bufoff) + ldsw + _i * 8192), 16, 0, 0); } while (0)
#define PG8_LDA(dst, b, h) do { _Pragma("unroll") for (int m = 0; m < 4; ++m) _Pragma("unroll") for (int k = 0; k < 2; ++k) dst[m][k] = *(const LAS bf16x8*)(lds + PG8_SA(b, h) + aoff + m * 2048 + k * 1024); } while (0)
#define PG8_LDB(dst, b, h) do { _Pragma("unroll") for (int n = 0; n < 2; ++n) _Pragma("unroll") for (int k = 0; k < 2; ++k) dst[n][k] = *(const LAS bf16x8*)(lds + PG8_SB(b, h) + boff + n * 2048 + k * 1024); } while (0)
#define PG8_MMA(ai, bj, At, Bt) do { __builtin_amdgcn_s_setprio(1); _Pragma("unroll") for (int m = 0; m < 4; ++m) _Pragma("unroll") for (int n = 0; n < 2; ++n) _Pragma("unroll") for (int k = 0; k < 2; ++k) \
        acc[ai][bj][m][n] = __builtin_amdgcn_mfma_f32_16x16x32_bf16(Bt[n][k], At[m][k], acc[ai][bj][m][n], 0, 0, 0); __builtin_amdgcn_s_setprio(0); } while (0)
#define PG8_WAIT_V(n) asm volatile("s_waitcnt vmcnt(" #n ")" ::: "memory")
#define PG8_WAIT_L(n) asm volatile("s_waitcnt lgkmcnt(" #n ")" ::: "memory")
#define PG8_BAR __builtin_amdgcn_s_barrier()
#define PG8_SCHED __builtin_amdgcn_sched_barrier(0)
    Unit cur, nxt; int ui = 0;
    if (!S.next(0, cur)) return;
    f32x4 acc[2][2][4][2];
#pragma unroll
    for (int a = 0; a < 2; ++a)
#pragma unroll
        for (int b = 0; b < 2; ++b)
#pragma unroll
            for (int m = 0; m < 4; ++m)
#pragma unroll
                for (int n = 0; n < 2; ++n) acc[a][b][m][n] = (f32x4){0.f, 0.f, 0.f, 0.f};
    bf16x8 At[4][2], B0[2][2], B1[2][2];
    const char* cA = (const char*)g.A + cur.ab; const char* cB = (const char*)g.Bt + cur.bb;
    PG8_STAGE(PG8_SB(0, 0), cB, voffB); PG8_STAGE(PG8_SB(0, 1), cB + hstepB, voffB); PG8_STAGE(PG8_SA(0, 0), cA, voffA); PG8_STAGE(PG8_SA(0, 1), cA + hstepA, voffA);
    if (wr == 1) PG8_BAR;
    PG8_WAIT_V(2); PG8_BAR;
    PG8_STAGE(PG8_SB(1, 0), cB + kstep, voffB); PG8_STAGE(PG8_SA(1, 0), cA + kstep, voffA); PG8_STAGE(PG8_SB(1, 1), cB + hstepB + kstep, voffB);
    PG8_WAIT_V(6); PG8_BAR;
    for (;;) {
        const bool has_next = S.next(ui + 1, nxt);
        const char* nA = has_next ? (const char*)g.A + nxt.ab : cA; const char* nB = has_next ? (const char*)g.Bt + nxt.bb : cB;
        for (int t = 0; t < nt; t += 2) {
            const bool last = (t == nt - 2);
            const char* a1 = cA + (size_t)(t + 1) * kstep;
            const char* a2 = last ? nA : cA + (size_t)(t + 2) * kstep; const char* b2 = last ? nB : cB + (size_t)(t + 2) * kstep;
            const char* a3 = a2 + kstep; const char* b3 = b2 + kstep;
            PG8_LDB(B0, 0, 0); PG8_LDB(B1, 0, 1); PG8_SCHED; PG8_LDA(At, 0, 0); PG8_STAGE(PG8_SA(1, 1), a1 + hstepA, voffA);
            PG8_WAIT_V(8); PG8_WAIT_L(0); PG8_BAR; PG8_MMA(0, 0, At, B0); PG8_MMA(0, 1, At, B1); PG8_BAR; PG8_SCHED;
            PG8_LDA(At, 0, 1); PG8_STAGE(PG8_SB(0, 0), b2, voffB); PG8_STAGE(PG8_SB(0, 1), b2 + hstepB, voffB); PG8_STAGE(PG8_SA(0, 0), a2, voffA);
            PG8_WAIT_V(8); PG8_WAIT_L(0); PG8_BAR; PG8_MMA(1, 0, At, B0); PG8_MMA(1, 1, At, B1); PG8_BAR; PG8_SCHED;
            PG8_LDB(B0, 1, 0); PG8_LDB(B1, 1, 1); PG8_SCHED; PG8_LDA(At, 1, 0); PG8_STAGE(PG8_SA(0, 1), a2 + hstepA, voffA);
            PG8_WAIT_V(8); PG8_WAIT_L(0); PG8_BAR; PG8_MMA(0, 0, At, B0); PG8_MMA(0, 1, At, B1); PG8_BAR; PG8_SCHED;
            PG8_LDA(At, 1, 1); PG8_STAGE(PG8_SB(1, 0), b3, voffB); PG8_STAGE(PG8_SB(1, 1), b3 + hstepB, voffB); PG8_STAGE(PG8_SA(1, 0), a3, voffA);
            PG8_WAIT_V(8); PG8_WAIT_L(0); PG8_BAR; PG8_MMA(1, 0, At, B0); PG8_MMA(1, 1, At, B1); PG8_BAR; PG8_SCHED;
        }
        if (wr == 0) PG8_BAR;
        E(acc, cur, wr, wc, fr, fq);
        if (!has_next) break;
#pragma unroll
        for (int a = 0; a < 2; ++a)
#pragma unroll
            for (int b = 0; b < 2; ++b)
#pragma unroll
                for (int m = 0; m < 4; ++m)
#pragma unroll
                    for (int n = 0; n < 2; ++n) acc[a][b][m][n] = (f32x4){0.f, 0.f, 0.f, 0.f};
        cur = nxt; cA = nA; cB = nB; ++ui;
        if (wr == 1) PG8_BAR;
    }
    PG8_WAIT_V(0);
    PG8_BAR;
#undef PG8_SA
#undef PG8_SB
#undef PG8_STAGE
#undef PG8_LDA
#undef PG8_LDB
#undef PG8_MMA
#undef PG8_WAIT_V
#undef PG8_WAIT_L
#undef PG8_BAR
#undef PG8_SCHED
}

enum { EK_PROJ = 0, EK_GATE, EK_BR0, EK_BR1, EK_BR2, EK_WOUT, EK_GLU, EK_DOWN };
template <int KIND> struct Epi {
    static constexpr bool PERM = true;
    bf16_t* O; int ldo;
    const bf16_t* X; int ldx;
    float* F;
    const int2* RI;
    __device__ __forceinline__ void operator()(const f32x4 (&acc)[2][2][4][2], const Unit& u, int wr, int wc, int fr, int fq) const {
        const int row0 = u.pm * BM + wr * 64 + fr, col0 = u.pn * BM + wc * 32 + 8 * fq;
        if constexpr (KIND == EK_GLU) {
            const int hc0 = u.pn * 128 + wc * 32 + 8 * fq;
#pragma unroll
            for (int ai = 0; ai < 2; ++ai)
#pragma unroll
                for (int m = 0; m < 4; ++m) {
                    const int row = row0 + ai * HALF + m * 16; float o[8];
#pragma unroll
                    for (int n = 0; n < 2; ++n)
#pragma unroll
                        for (int j = 0; j < 4; ++j) o[4 * n + j] = siluf_(acc[ai][0][m][n][j]) * acc[ai][1][m][n][j];
                    *(u32x4*)(O + (size_t)row * ldo + hc0) = pack8(o);
                    asm volatile("" ::: "memory");
                }
        } else if constexpr (KIND == EK_DOWN) {
#pragma unroll
            for (int ai = 0; ai < 2; ++ai)
#pragma unroll
                for (int m = 0; m < 4; ++m) {
                    const int row = row0 + ai * HALF + m * 16; const int2 ri = RI[row]; const float w = __int_as_float(ri.y);
                    if (ri.x >= 0) {
#pragma unroll
                        for (int bj = 0; bj < 2; ++bj) { float o[8];
#pragma unroll
                            for (int n = 0; n < 2; ++n)
#pragma unroll
                                for (int j = 0; j < 4; ++j) o[4 * n + j] = w * acc[ai][bj][m][n][j];
                            *(u32x4*)(O + (size_t)ri.x * ldo + col0 + bj * HALF) = pack8(o); }
                    }
                    asm volatile("" ::: "memory");
                }
        } else {
            int act = 0;
            if constexpr (KIND == EK_PROJ) act = (u.pn == 2 || u.pn == 3) ? 1 : ((u.pn >= 7 && u.pn <= 10) ? 2 : 0);
#pragma unroll
            for (int ai = 0; ai < 2; ++ai)
#pragma unroll
                for (int m = 0; m < 4; ++m) {
                    const int row = row0 + ai * HALF + m * 16;
#pragma unroll
                    for (int bj = 0; bj < 2; ++bj) {
                        const int col = col0 + bj * HALF; float v[8];
#pragma unroll
                        for (int n = 0; n < 2; ++n)
#pragma unroll
                            for (int j = 0; j < 4; ++j) v[4 * n + j] = acc[ai][bj][m][n][j];
                        if constexpr (KIND == EK_PROJ) {
                            if (act == 1) {
#pragma unroll
                                for (int j = 0; j < 8; ++j) v[j] *= QSCALE;
                            } else if (act == 2) {
#pragma unroll
                                for (int j = 0; j < 8; ++j) v[j] = siluf_(v[j]);
                            }
                            *(u32x4*)(O + (size_t)row * ldo + col) = pack8(v);
                        } else if constexpr (KIND == EK_GATE) {
#pragma unroll
                            for (int j = 0; j < 8; ++j) v[j] = sigmoidf_(v[j]);
                            *(u32x4*)(O + (size_t)row * ldo + col) = pack8(v);
                        } else if constexpr (KIND == EK_BR0 || KIND == EK_BR1 || KIND == EK_BR2) {
                            float gt[8]; unpack8(*(const u32x4*)(X + (size_t)row * ldx + col), gt);
                            float* fp = F + (size_t)row * 1024 + col;
                            if constexpr (KIND == EK_BR0) {
                                *(f32x4*)fp = (f32x4){gt[0] * v[0], gt[1] * v[1], gt[2] * v[2], gt[3] * v[3]};
                                *(f32x4*)(fp + 4) = (f32x4){gt[4] * v[4], gt[5] * v[5], gt[6] * v[6], gt[7] * v[7]};
                            } else {
                                const f32x4 t0 = *(const f32x4*)fp, t1 = *(const f32x4*)(fp + 4);
                                float s[8];
#pragma unroll
                                for (int j = 0; j < 4; ++j) { s[j] = t0[j] + gt[j] * v[j]; s[4 + j] = t1[j] + gt[4 + j] * v[4 + j]; }
                                if constexpr (KIND == EK_BR1) { *(f32x4*)fp = (f32x4){s[0], s[1], s[2], s[3]}; *(f32x4*)(fp + 4) = (f32x4){s[4], s[5], s[6], s[7]}; }
                                else *(u32x4*)(O + (size_t)row * ldo + col) = pack8(s);
                            }
                        } else if constexpr (KIND == EK_WOUT) {
                            float hv[8]; unpack8(*(const u32x4*)(X + (size_t)row * ldx + col), hv);
#pragma unroll
                            for (int j = 0; j < 8; ++j) v[j] += DN_ALPHA * hv[j];
                            *(u32x4*)(O + (size_t)row * ldo + col) = pack8(v);
                        }
                        asm volatile("" ::: "memory");
                    }
                }
        }
    }
};
}

#define XB_TMO      128
#define XB_XCNT(j)  (256  + 64 * (j))
#define XB_XSUB(j)  (1280 + 64 * (j))
#define XB_XGEN(j)  (2304 + 64 * (j))
#define XB_TOP      3328
#define XB_TOPGEN   3392
#define XCD_BAR_WORDS 3456
#define XB_SPIN_CAP (1u << 20)
__device__ __forceinline__ unsigned xb_ld(unsigned* p)              { return __hip_atomic_load(p, __ATOMIC_RELAXED, __HIP_MEMORY_SCOPE_AGENT); }
__device__ __forceinline__ unsigned xb_add(unsigned* p, unsigned v) { return __hip_atomic_fetch_add(p, v, __ATOMIC_RELAXED, __HIP_MEMORY_SCOPE_AGENT); }
__device__ __forceinline__ unsigned xb_xcc_id() { return (unsigned)__builtin_amdgcn_s_getreg((3 << 11) | 20) & 0xFu; }
#define XB_SPIN(cond, bar) do { unsigned _sp = 0; while (cond) { __builtin_amdgcn_s_sleep(1); \
    if ((++_sp & 255u) == 0u) { if (xb_ld(&(bar)[XB_TMO])) break; if (_sp > XB_SPIN_CAP) { atomicAdd(&(bar)[XB_TMO], 1u); break; } } } } while (0)
struct XcdBarrier { unsigned* bar; unsigned x; volatile LAS unsigned* st; };
__device__ __forceinline__ XcdBarrier xcd_barrier_post(unsigned* bar, volatile LAS unsigned* st, int tid) {
    XcdBarrier b; b.bar = bar; b.x = xb_xcc_id(); b.st = st;
    if (tid == 0) (void)xb_add(&bar[XB_XCNT(b.x)], 1u);
    return b;
}
__device__ __forceinline__ void xcd_barrier_complete(unsigned* bar, unsigned x, unsigned& nloc, unsigned& nx) {
    const unsigned G = gridDim.x * gridDim.y * gridDim.z;
    unsigned sum, cnt, mine, sp = 0u;
    for (;;) {
        sum = 0u; cnt = 0u; mine = 0u;
#pragma unroll
        for (unsigned j = 0; j < 16; ++j) { const unsigned c = xb_ld(&bar[XB_XCNT(j)]); sum += c; cnt += (c > 0u) ? 1u : 0u; mine = (j == x) ? c : mine; }
        if (sum == G) break;
        __builtin_amdgcn_s_sleep(1);
        if ((++sp & 255u) == 0u) { if (xb_ld(&bar[XB_TMO])) break; if (sp > XB_SPIN_CAP) { atomicAdd(&bar[XB_TMO], 1u); break; } }
    }
    nloc = mine > 0u ? mine : 1u; nx = cnt > 0u ? cnt : 1u;
}
__device__ __forceinline__ void xcd_barrier(const XcdBarrier& b, int tid) {
    asm volatile("s_waitcnt vmcnt(0)" ::: "memory");
    __syncthreads();
    if (tid == 0) {
        unsigned* bar = b.bar;
        __builtin_amdgcn_s_waitcnt(0);
        unsigned nloc = b.st[0], nx = b.st[1];
        if (nloc == 0u) { xcd_barrier_complete(bar, b.x, nloc, nx); b.st[0] = nloc; b.st[1] = nx; }
        const unsigned old = xb_add(&bar[XB_XSUB(b.x)], 1u);
        const unsigned gen = old / nloc;
        if (old + 1u == (gen + 1u) * nloc) {
            __builtin_amdgcn_fence(__ATOMIC_RELEASE, "agent");
            asm volatile("s_waitcnt vmcnt(0)" ::: "memory");
            const unsigned og = xb_add(&bar[XB_TOP], 1u);
            const unsigned tg = og / nx;
            if (og + 1u == (tg + 1u) * nx) xb_add(&bar[XB_TOPGEN], 1u);
            else XB_SPIN(xb_ld(&bar[XB_TOPGEN]) == tg, bar);
            __builtin_amdgcn_fence(__ATOMIC_ACQUIRE, "agent");
            xb_add(&bar[XB_XGEN(b.x)], 1u);
            asm volatile("s_waitcnt vmcnt(0)" ::: "memory");
        } else {
            XB_SPIN(xb_ld(&bar[XB_XGEN(b.x)]) == gen, bar);
            __builtin_amdgcn_fence(__ATOMIC_ACQUIRE, "agent");
            asm volatile("s_waitcnt vmcnt(0)" ::: "memory");
        }
    }
    __syncthreads();
}

struct Args { const float* in[32]; float* out; unsigned char* ws; int lo, hi; };
typedef const __attribute__((address_space(4))) Args* ArgsP;
enum { I_X = 0, I_LN0G, I_LN0B, I_WIN, I_POOLW, I_POOLS, I_CKPE, I_CKW1, I_CKW2, I_CVPE, I_CVW1, I_CVW2, I_RELB, I_CONVW, I_CONVB, I_DTB, I_ALOG, I_DSKIP, I_SNG,
       I_WBP, I_WBN, I_WBS, I_WOUT, I_LN1G, I_LN1B, I_RW, I_RB, I_EW1, I_EW3, I_EW2, I_LN2G, I_LN2B };


struct Ctx {
    LAS unsigned char* lds;
    unsigned* ctl;
    unsigned char* ws; unsigned char* dout;
    int tid, lane, wave, G, vcu, gw, NGW;
};

struct Job { const float* src; size_t sbatch; int ldw, K, c0, ncols; bf16_t* dst; int dbatch_rows, ldt, drow0, mode, nbatch; };
constexpr int NJOBS = 15;
__device__ __forceinline__ Job get_job(ArgsP a, int l, int j) {
    unsigned char* wl = a->ws + WS_W + (size_t)l * W_LAYER;
    bf16_t* win = (bf16_t*)(wl + WO_IN); bf16_t* wg = (bf16_t*)(wl + WO_GATE);
    const float* w_in = a->in[I_WIN] + (size_t)l * DM * D_IN;
    Job J; J.sbatch = 0; J.dbatch_rows = 0; J.mode = 0; J.nbatch = 1; J.c0 = 0; J.drow0 = 0;
    switch (j) {
    case 0:  J.src = w_in; J.ldw = D_IN; J.K = 1024; J.c0 = 0;    J.ncols = 1792; J.dst = win; J.ldt = 1024; J.drow0 = 0; break;
    case 1:  J.src = w_in; J.ldw = D_IN; J.K = 1024; J.c0 = 1792; J.ncols = 24;   J.dst = win; J.ldt = 1024; J.drow0 = C_NG; break;
    case 2:  J.src = w_in; J.ldw = D_IN; J.K = 1024; J.c0 = 1816; J.ncols = 3072; J.dst = win; J.ldt = 1024; J.drow0 = C_Z; break;
    case 3:  J.src = w_in; J.ldw = D_IN; J.K = 1024; J.c0 = 4888; J.ncols = 16;   J.dst = win; J.ldt = 1024; J.drow0 = C_DT; break;
    case 4:  J.src = w_in; J.ldw = D_IN; J.K = 1024; J.c0 = 4904; J.ncols = 3072; J.dst = wg;  J.ldt = 1024; J.drow0 = 0; break;
    case 5:  J.src = a->in[I_WBN] + (size_t)l * 512 * 1024;  J.ldw = 1024; J.K = 512;  J.ncols = 1024; J.dst = (bf16_t*)(wl + WO_NSA); J.ldt = 512; break;
    case 6:  J.src = a->in[I_WBS] + (size_t)l * 1024 * 1024; J.ldw = 1024; J.K = 1024; J.ncols = 1024; J.dst = (bf16_t*)(wl + WO_SSD); J.ldt = 1024; break;
    case 7:  J.src = a->in[I_WOUT] + (size_t)l * 1024 * 1024; J.ldw = 1024; J.K = 1024; J.ncols = 1024; J.dst = (bf16_t*)(wl + WO_OUT); J.ldt = 1024; break;
    case 8:  J.src = a->in[I_CKW1] + (size_t)l * 2048 * 128; J.ldw = 128; J.K = 2048; J.ncols = 128; J.dst = (bf16_t*)(wl + WO_W1); J.ldt = 2048; break;
    case 9:  J.src = a->in[I_CVW1] + (size_t)l * 2048 * 128; J.ldw = 128; J.K = 2048; J.ncols = 128; J.dst = (bf16_t*)(wl + WO_W1) + 128 * 2048; J.ldt = 2048; break;
    case 10: J.src = a->in[I_CKW2] + (size_t)l * 128 * 64; J.ldw = 64; J.K = 128; J.ncols = 64; J.dst = (bf16_t*)(wl + WO_W2); J.ldt = 128; break;
    case 11: J.src = a->in[I_CVW2] + (size_t)l * 128 * 64; J.ldw = 64; J.K = 128; J.ncols = 64; J.dst = (bf16_t*)(wl + WO_W2) + 64 * 128; J.ldt = 128; break;
    case 12: J.src = a->in[I_EW1] + (size_t)l * 16 * 1024 * 512; J.sbatch = (size_t)1024 * 512; J.ldw = 512; J.K = 1024; J.ncols = 512; J.dst = (bf16_t*)(wl + WO_UP); J.dbatch_rows = 1024; J.ldt = 1024; J.drow0 = 0;   J.mode = 1; J.nbatch = 16; break;
    case 13: J.src = a->in[I_EW3] + (size_t)l * 16 * 1024 * 512; J.sbatch = (size_t)1024 * 512; J.ldw = 512; J.K = 1024; J.ncols = 512; J.dst = (bf16_t*)(wl + WO_UP); J.dbatch_rows = 1024; J.ldt = 1024; J.drow0 = 128; J.mode = 1; J.nbatch = 16; break;
    default: J.src = a->in[I_EW2] + (size_t)l * 16 * 512 * 1024; J.sbatch = (size_t)512 * 1024; J.ldw = 1024; J.K = 512; J.ncols = 1024; J.dst = (bf16_t*)(wl + WO_DN); J.dbatch_rows = 1024; J.ldt = 512; J.nbatch = 16; break;
    }
    return J;
}
__device__ __forceinline__ void tr_item(const Job& J, int item, LAS float* scr, int lane) {
    const int nblk = (J.ncols + 31) >> 5, kblk = J.K >> 6, per = nblk * kblk;
    const int bt = item / per, r = item - bt * per, kb = r / nblk, nb = r - kb * nblk, k0 = 64 * kb, n0 = 32 * nb;
    const int nv = (J.ncols - n0) < 32 ? (J.ncols - n0) : 32;
    const float* W = J.src + (size_t)bt * J.sbatch;
    { const int nn = lane & 31; const float* wp = W + (size_t)(k0 + (lane >> 5)) * J.ldw + J.c0 + n0 + nn; float v[32];
#pragma unroll
      for (int i = 0; i < 32; ++i) v[i] = (nn < nv) ? wp[(size_t)(2 * i) * J.ldw] : 0.f;
#pragma unroll
      for (int i = 0; i < 32; ++i) scr[(2 * i + (lane >> 5)) * 33 + nn] = v[i]; }
    LDS_WAIT();
    const int c = lane & 7;
#pragma unroll
    for (int j = 0; j < 4; ++j) { const int n = (lane >> 3) + 8 * j;
        if (n < nv) {
            const LAS float* s = scr + (8 * c) * 33 + n; const int nn = n0 + n;
            const int drow = bt * J.dbatch_rows + J.drow0 + (J.mode == 1 ? ((nn >> 7) * 256 + (nn & 127)) : nn);
            u32x4 o; o.x = cvt_pk_bf16(s[0 * 33], s[1 * 33]); o.y = cvt_pk_bf16(s[2 * 33], s[3 * 33]); o.z = cvt_pk_bf16(s[4 * 33], s[5 * 33]); o.w = cvt_pk_bf16(s[6 * 33], s[7 * 33]);
            *(u32x4*)(J.dst + (size_t)drow * J.ldt + k0 + 8 * c) = o; } }
    LDS_WAIT();
}
__device__ __forceinline__ void ln_row_f32(const float* xrow, const float* g, const float* b, bf16_t* orow, int lane) {
    const f32x4* xr = (const f32x4*)xrow + lane; f32x4 v[4]; float s = 0.f;
#pragma unroll
    for (int j = 0; j < 4; ++j) { v[j] = xr[64 * j]; s += (v[j].x + v[j].y) + (v[j].z + v[j].w); }
    const float mean = wave_sum(s) * (1.f / DM); float s2 = 0.f;
#pragma unroll
    for (int j = 0; j < 4; ++j) { v[j] = v[j] - mean; s2 += (v[j].x * v[j].x + v[j].y * v[j].y) + (v[j].z * v[j].z + v[j].w * v[j].w); }
    const float rstd = 1.f / sqrtf(wave_sum(s2) * (1.f / DM) + LN_EPS);
    u32x2* o8 = (u32x2*)orow + lane;
#pragma unroll
    for (int j = 0; j < 4; ++j) { const f32x4 gg = ((const f32x4*)g + lane)[64 * j], bb = ((const f32x4*)b + lane)[64 * j];
        u32x2 w; w.x = cvt_pk_bf16(v[j].x * rstd * gg.x + bb.x, v[j].y * rstd * gg.y + bb.y); w.y = cvt_pk_bf16(v[j].z * rstd * gg.z + bb.z, v[j].w * rstd * gg.w + bb.w); o8[64 * j] = w; }
}
__device__ __forceinline__ int rel_bucket_dev(int n) {
    if (n < 16) return n;
    int b = 16;
    b += (n >= 19) + (n >= 21) + (n >= 24) + (n >= 27) + (n >= 31) + (n >= 35) + (n >= 40) + (n >= 46) + (n >= 52) + (n >= 59) + (n >= 67) + (n >= 77) + (n >= 87) + (n >= 99) + (n >= 113);
    return b;
}
__device__ __forceinline__ void p0_prologue(const Ctx& F, ArgsP a) {
    LAS float* scr = (LAS float*)(F.lds + F.wave * 16384);
    int base = 0;
    for (int l = 0; l < DEPTH; ++l)
        for (int j = 0; j < NJOBS; ++j) {
            const Job J = get_job(a, l, j);
            const int nitems = J.nbatch * (J.K >> 6) * ((J.ncols + 31) >> 5);
            int first = (F.gw - base) % F.NGW; if (first < 0) first += F.NGW;
            for (int it = first; it < nitems; it += F.NGW) tr_item(J, it, scr, F.lane);
            base = (base + nitems) % F.NGW;
        }
    { bf16_t* H = (bf16_t*)(a->ws + WS_H);
      for (int m = F.gw; m < T_; m += F.NGW) ln_row_f32(a->in[I_X] + (size_t)m * DM, a->in[I_LN0G], a->in[I_LN0B], H + (size_t)m * DM, F.lane); }
    { const int gt = blockIdx.x * 512 + F.tid, nthr = F.G * 512;
      for (int id = gt; id < DEPTH * 65536; id += nthr) {
          const int l = id >> 16, r = id & 65535, n = r & 1023, k8 = r >> 10, g = k8 >> 4, c0 = (k8 & 15) * 8;
          const float* pw = a->in[I_POOLW] + (size_t)l * 4 * 128 * 128 + (size_t)(g * 128 + c0) * 128;
          const float* sc = a->in[I_POOLS] + l * 512 + g * 128;
          const float* wb = a->in[I_WBP] + (size_t)l * 512 * 1024 + (size_t)(g * 128) * 1024 + n;
          float acc[8] = {0.f, 0.f, 0.f, 0.f, 0.f, 0.f, 0.f, 0.f};
          for (int d = 0; d < 128; ++d) { const float w = wb[(size_t)d * 1024] * sc[d];
#pragma unroll
              for (int i = 0; i < 8; ++i) acc[i] += pw[i * 128 + d] * w; }
          bf16_t* dst = (bf16_t*)(a->ws + WS_W + (size_t)l * W_LAYER + WO_C) + (size_t)n * 512 + g * 128 + c0;
          *(u32x4*)dst = pack8(acc);
      } }
    for (int o = F.gw; o < DEPTH * 2 * 128; o += F.NGW) {
        const int l = o >> 8, kv = (o >> 7) & 1, col = o & 127;
        const float* pe = a->in[kv ? I_CVPE : I_CKPE] + (size_t)l * 2048; const float* w1 = a->in[kv ? I_CVW1 : I_CKW1] + (size_t)l * 2048 * 128 + col;
        float s = 0.f;
        for (int k = F.lane; k < 2048; k += 64) s += pe[k] * w1[(size_t)k * 128];
        s = wave_sum(s);
        if (F.lane == 0) ((float*)(a->ws + WS_MISC + MI_B1))[o] = s;
    }
    if (blockIdx.x == 0) {
        float* bt = (float*)(a->ws + WS_MISC + MI_BIAS);
        for (int i = F.tid; i < 8 * 128; i += 512) { const int hd = i >> 7, d = i & 127;
            bt[i] = (a->in[I_RELB][rel_bucket_dev(d) * 8 + hd] - a->in[I_RELB][31 * 8 + hd]) * LOG2E; }
    }
}

__device__ __forceinline__ void conv_phase(const Ctx& F, const bf16_t* P, bf16_t* XC, const float* cw, const float* cb) {
    const int gt = blockIdx.x * 512 + F.tid, nthr = F.G * 512;
    const int c = gt & 255;
    float w[4][8], b[8];
#pragma unroll
    for (int k = 0; k < 4; ++k)
#pragma unroll
        for (int i = 0; i < 8; ++i) w[k][i] = cw[k * 2048 + 8 * c + i];
#pragma unroll
    for (int i = 0; i < 8; ++i) b[i] = cb[8 * c + i];
    for (int id = gt; id < (TG / 16) * 256; id += nthr) {
        const int tl0 = (id >> 8) * 16, s0 = tl0 & (SEQ - 1);
        u32x4 raw[19];
#pragma unroll
        for (int r = 0; r < 19; ++r) raw[r] = (s0 + r - 3 >= 0) ? *(const u32x4*)(P + (size_t)(tl0 + r - 3) * LDP + C_XBC + 8 * c) : (u32x4){0u, 0u, 0u, 0u};
#pragma unroll
        for (int i = 0; i < 16; ++i) {
            float acc[8];
#pragma unroll
            for (int j = 0; j < 8; ++j) acc[j] = b[j];
#pragma unroll
            for (int k = 0; k < 4; ++k) { float x[8]; unpack8(raw[i + k], x);
#pragma unroll
                for (int j = 0; j < 8; ++j) acc[j] += w[k][j] * x[j]; }
#pragma unroll
            for (int j = 0; j < 8; ++j) acc[j] = siluf_(acc[j]);
            *(u32x4*)(XC + (size_t)(tl0 + i) * 2048 + 8 * c) = pack8(acc);
        }
    }
}
__device__ __forceinline__ void compress_unit(const Ctx& F, int cu, const bf16_t* P, const bf16_t* W1t, const bf16_t* W2t, const float* b1, bf16_t* KC, bf16_t* VC) {
    const int kv = cu & 1, g = (cu >> 1) & 1, nb = (cu >> 2) & 7, bl = cu >> 5;
    const int lane = F.lane, w = F.wave, fr = lane & 15, fq = lane >> 4;
    LAS bf16_t* hid = (LAS bf16_t*)F.lds;
    const bf16_t* w1 = W1t + (size_t)kv * 128 * 2048 + (size_t)(16 * w + fr) * 2048 + 8 * fq;
    int n0 = nb * 16 + fr; if (n0 > 126) n0 = 126;
    const bf16_t* a0 = P + (size_t)(bl * SEQ + 16 * n0) * LDP + C_KV + kv * 128 + g * 64 + 8 * fq;
    f32x4 acc0 = {0.f, 0.f, 0.f, 0.f}, acc1 = {0.f, 0.f, 0.f, 0.f};
#pragma unroll 8
    for (int kk = 0; kk < 64; kk += 2) {
        const int l = kk >> 1;
        const bf16x8 bb0 = *(const bf16x8*)(w1 + kk * 32), bb1 = *(const bf16x8*)(w1 + kk * 32 + 32);
        const bf16x8 x0 = *(const bf16x8*)(a0 + (size_t)l * LDP), x1 = *(const bf16x8*)(a0 + (size_t)l * LDP + 32);
        acc0 = mfma16(x0, bb0, acc0); acc1 = mfma16(x1, bb1, acc1);
    }
    const float bias = b1[kv * 128 + 16 * w + fr];
#pragma unroll
    for (int r = 0; r < 4; ++r) { const float x = acc0[r] + acc1[r] + bias, u = 0.7978845608f * (x + 0.044715f * x * x * x); hid[(4 * fq + r) * 136 + 16 * w + fr] = f2bf(x * sigmoidf_(2.f * u)); }
    __syncthreads();
    if (w < 4) { f32x4 acc = {0.f, 0.f, 0.f, 0.f};
      const bf16_t* w2 = W2t + (size_t)kv * 64 * 128 + (size_t)(16 * w + fr) * 128 + 8 * fq;
#pragma unroll
      for (int ks = 0; ks < 4; ++ks) { const bf16x8 aa = *(const LAS bf16x8*)(hid + fr * 136 + ks * 32 + 8 * fq); const bf16x8 bb = *(const bf16x8*)(w2 + ks * 32); acc = mfma16(aa, bb, acc); }
      bf16_t* dst = kv ? VC : KC;
#pragma unroll
      for (int r = 0; r < 4; ++r) { const int n = nb * 16 + 4 * fq + r; if (n < 127) dst[(size_t)(bl * 128 + n) * 128 + g * 64 + 16 * w + fr] = f2bf(acc[r]); }
    }
    __syncthreads();
}

__device__ __forceinline__ void fin_phase(const Ctx& F, const bf16_t* P, bf16_t* R, bf16_t* Y, const float* normg) {
    { const int gt = blockIdx.x * 512 + F.tid, nthr = F.G * 512;
      for (int id = gt; id < TG * 64; id += nthr) {
          const int tl = id >> 6, c = id & 63, win = 2 << (c >> 4), s = tl & (SEQ - 1), cnt = (s + 1) < win ? (s + 1) : win;
          u32x4 raw[16];
#pragma unroll
          for (int j = 0; j < 16; ++j) raw[j] = *(const u32x4*)(P + (size_t)(tl - (j < cnt ? j : 0)) * LDP + C_POOL + 8 * c);
          float sum[8] = {0.f, 0.f, 0.f, 0.f, 0.f, 0.f, 0.f, 0.f}, u0[8];
          unpack8(raw[0], u0);
#pragma unroll
          for (int j = 0; j < 16; ++j) { float x[8]; unpack8(raw[j], x); const float m = (j < cnt) ? 1.f : 0.f;
#pragma unroll
              for (int i = 0; i < 8; ++i) sum[i] += m * x[i]; }
          const float inv = 1.f / (float)cnt;
#pragma unroll
          for (int i = 0; i < 8; ++i) sum[i] = sum[i] * inv - u0[i];
          *(u32x4*)(R + (size_t)tl * 512 + 8 * c) = pack8(sum);
      } }
    const int lane = F.lane;
    float ng[16];
#pragma unroll
    for (int i = 0; i < 16; ++i) ng[i] = normg[16 * lane + i];
    u32x4 nx[4];
#define FIN_LOAD(tl_) do { nx[0] = *(const u32x4*)(Y + (size_t)(tl_) * 1024 + 16 * lane); nx[1] = *(const u32x4*)(Y + (size_t)(tl_) * 1024 + 16 * lane + 8); \
        nx[2] = *(const u32x4*)(P + (size_t)(tl_) * LDP + C_Z + 16 * lane); nx[3] = *(const u32x4*)(P + (size_t)(tl_) * LDP + C_Z + 16 * lane + 8); } while (0)
    if (F.gw < TG) FIN_LOAD(F.gw);
    for (int tl = F.gw; tl < TG; tl += F.NGW) {
        const u32x4 c0 = nx[0], c1 = nx[1], c2 = nx[2], c3 = nx[3];
        if (tl + F.NGW < TG) FIN_LOAD(tl + F.NGW);
        float y[16], z[16];
        { float t[8]; unpack8(c0, t);
#pragma unroll
          for (int i = 0; i < 8; ++i) y[i] = t[i];
          unpack8(c1, t);
#pragma unroll
          for (int i = 0; i < 8; ++i) y[8 + i] = t[i];
          unpack8(c2, t);
#pragma unroll
          for (int i = 0; i < 8; ++i) z[i] = t[i];
          unpack8(c3, t);
#pragma unroll
          for (int i = 0; i < 8; ++i) z[8 + i] = t[i]; }
        float ss = 0.f;
#pragma unroll
        for (int i = 0; i < 16; ++i) { y[i] *= z[i]; ss += y[i] * y[i]; }
        ss += __shfl_xor(ss, 1); ss += __shfl_xor(ss, 2); ss += __shfl_xor(ss, 4); ss += __shfl_xor(ss, 8);
        const float rstd = 1.f / sqrtf(ss * (1.f / 256.f) + LN_EPS);
        float o[8];
#pragma unroll
        for (int i = 0; i < 8; ++i) o[i] = y[i] * rstd * ng[i];
        *(u32x4*)(Y + (size_t)tl * 1024 + 16 * lane) = pack8(o);
#pragma unroll
        for (int i = 0; i < 8; ++i) o[i] = y[8 + i] * rstd * ng[8 + i];
        *(u32x4*)(Y + (size_t)tl * 1024 + 16 * lane + 8) = pack8(o);
    }
#undef FIN_LOAD
}

#ifndef SSD_REP
#define SSD_REP 0
#endif
#ifndef NSA_REP
#define NSA_REP 0
#endif
constexpr int NL_KT = 0, NL_VT = 32768, NL_BIAS = 65536, NL_IMP = 67584, NL_SEL = 101376, NL_UNI = 101632;
__device__ __forceinline__ void glds16(const void* gsrc, unsigned lds_dst) { unsigned keep;
    asm volatile("s_mov_b32 %0, m0\n\ts_mov_b32 m0, %2\n\ts_nop 0\n\tglobal_load_lds_dwordx4 %1, off\n\ts_mov_b32 m0, %0" : "=&s"(keep) : "v"(gsrc), "s"(lds_dst) : "memory"); }
#define NSA_WAITBAR(N) asm volatile("s_waitcnt vmcnt(" #N ") lgkmcnt(0)\n\ts_barrier" ::: "memory")

#define NSA_STORE_TILE(buf) do { \
    *(LAS u32x4*)(lds + NL_KT + (buf) * 8192 + (tid >> 6) * 1024 + (tid & 63) * 16) = kreg; \
    *(LAS u32x4*)(lds + NL_VT + (buf) * 8192 + ((tid & 7) >> 2) * 4096 + (tid >> 3) * 64 + (tid & 3) * 16) = vreg; } while (0)

__device__ __forceinline__ void nsa_qk(const LAS unsigned char* Kt, const bf16x8 (&qB)[4], int r32, int hi, f32x16& p0, f32x16& p1) {
    p0 = (f32x16){0.f, 0.f, 0.f, 0.f, 0.f, 0.f, 0.f, 0.f, 0.f, 0.f, 0.f, 0.f, 0.f, 0.f, 0.f, 0.f}; p1 = p0;
#pragma unroll
    for (int d0 = 0; d0 < 4; ++d0) {
        const bf16x8 k0 = *(const LAS bf16x8*)(Kt + (2 * d0 + hi) * 1024 + r32 * 16);
        const bf16x8 k1 = *(const LAS bf16x8*)(Kt + (2 * d0 + hi) * 1024 + 512 + r32 * 16);
        p0 = mfma32(k0, qB[d0], p0); p1 = mfma32(k1, qB[d0], p1);
    }
}
__device__ __forceinline__ void nsa_pv(const LAS unsigned char* Vt, int lane, int hi, const f32x16& p0, const f32x16& p1, f32x16& o0, f32x16& o1) {
    bf16x8 pB[4];
    { u32x4 t; t.x = cvt_pk_bf16(p0[0], p0[1]); t.y = cvt_pk_bf16(p0[2], p0[3]); t.z = cvt_pk_bf16(p0[4], p0[5]); t.w = cvt_pk_bf16(p0[6], p0[7]); pB[0] = __builtin_bit_cast(bf16x8, t);
      t.x = cvt_pk_bf16(p0[8], p0[9]); t.y = cvt_pk_bf16(p0[10], p0[11]); t.z = cvt_pk_bf16(p0[12], p0[13]); t.w = cvt_pk_bf16(p0[14], p0[15]); pB[1] = __builtin_bit_cast(bf16x8, t);
      t.x = cvt_pk_bf16(p1[0], p1[1]); t.y = cvt_pk_bf16(p1[2], p1[3]); t.z = cvt_pk_bf16(p1[4], p1[5]); t.w = cvt_pk_bf16(p1[6], p1[7]); pB[2] = __builtin_bit_cast(bf16x8, t);
      t.x = cvt_pk_bf16(p1[8], p1[9]); t.y = cvt_pk_bf16(p1[10], p1[11]); t.z = cvt_pk_bf16(p1[12], p1[13]); t.w = cvt_pk_bf16(p1[14], p1[15]); pB[3] = __builtin_bit_cast(bf16x8, t); }
    const LAS unsigned char* vb = Vt + (4 * hi + ((lane & 15) >> 2)) * 64 + ((lane >> 4) & 1) * 32 + (lane & 3) * 8;
#pragma unroll
    for (int ks = 0; ks < 4; ++ks) {
        const bf16x8 va0 = cat8(trrd(vb + ks * 1024), trrd(vb + ks * 1024 + 512));
        const bf16x8 va1 = cat8(trrd(vb + 4096 + ks * 1024), trrd(vb + 4096 + ks * 1024 + 512));
        o0 = mfma32(va0, pB[ks], o0); o1 = mfma32(va1, pB[ks], o1);
    }
}

template <int MODE>
__device__ __forceinline__ void nsa_branch(const Ctx& F, const bf16_t* Kg, const bf16_t* Vg, unsigned tiles, int qt, int ql, unsigned mysel,
                                           const LAS float* biasH, const bf16_t* qptr, float gate, f32x16& out0, f32x16& out1) {
    LAS unsigned char* lds = F.lds; int tid_ = F.tid; asm volatile("" : "+v"(tid_)); const int tid = tid_, lane = tid & 63, r32 = lane & 31, hi = lane >> 5;
    bf16x8 qB[4];
#pragma unroll
    for (int d0 = 0; d0 < 4; ++d0) qB[d0] = *(const bf16x8*)(qptr + 16 * d0);
    float m = NEGBIG, l = 0.f;
    f32x16 o0 = (f32x16){0.f, 0.f, 0.f, 0.f, 0.f, 0.f, 0.f, 0.f, 0.f, 0.f, 0.f, 0.f, 0.f, 0.f, 0.f, 0.f}, o1 = o0;
    const int w = F.wave;
    const unsigned lbase = (unsigned)(size_t)lds;
    const bf16_t* ksrc = Kg + (size_t)lane * LDP + 8 * w;
    const bf16_t* vsrc = Vg + (size_t)(16 * (w & 3) + (lane >> 2)) * LDP + (w >> 2) * 32 + (lane & 3) * 8;
    const unsigned kdst = (unsigned)__builtin_amdgcn_readfirstlane((int)(lbase + NL_KT + w * 1024)), vdst = (unsigned)__builtin_amdgcn_readfirstlane((int)(lbase + NL_VT + (w >> 2) * 4096 + (w & 3) * 1024));
#define NSA_DMA(jj, slot) do { glds16(ksrc + (size_t)(jj) * 64 * LDP, kdst + (slot) * 8192); glds16(vsrc + (size_t)(jj) * 64 * LDP, vdst + (slot) * 8192); } while (0)
#define NSA_POP(dst) do { if (rem) { dst = (MODE == 1) ? (__ffs(rem) - 1) : (31 - __clz(rem)); rem &= ~(1u << dst); } else dst = -1; } while (0)
    unsigned rem = tiles; int j, q1, q2;
    NSA_POP(j); NSA_POP(q1); NSA_POP(q2);
    NSA_DMA(j, 0); if (q1 >= 0) NSA_DMA(q1, 1); if (q2 >= 0) NSA_DMA(q2, 2);
    int buf = 0;
    for (;;) {
        if (q2 >= 0) NSA_WAITBAR(4); else if (q1 >= 0) NSA_WAITBAR(2); else NSA_WAITBAR(0);
        int q3; NSA_POP(q3);
        if (q3 >= 0) NSA_DMA(q3, (buf + 3) & 3);
        const int dj = qt - j, dq = 64 * dj + ql - 4 * hi;
        const bool near = dj <= 2, edge = (MODE == 2) && (dj == 8);
        const bool selq = (MODE == 1) ? (((mysel >> j) & 1u) != 0u) : true;
        if (MODE != 1 || __any(selq)) {
        f32x16 p0, p1;
        nsa_qk(lds + NL_KT + buf * 8192, qB, r32, hi, p0, p1);
        if (near || edge) {
#pragma unroll
            for (int r = 0; r < 16; ++r) {
                const int d0 = dq - ((r & 3) + 8 * (r >> 2)), d1 = d0 - 32;
                const bool v0 = d0 >= 0 && (MODE == 1 || d0 < 512), v1 = d1 >= 0 && (MODE == 1 || d1 < 512);
                float b0 = 0.f, b1 = 0.f;
                if (near) { const int c0 = d0 < 0 ? 0 : (d0 > 127 ? 127 : d0), c1 = d1 < 0 ? 0 : (d1 > 127 ? 127 : d1); b0 = biasH[c0]; b1 = biasH[c1]; }
                p0[r] = v0 ? p0[r] + b0 : NEGBIG; p1[r] = v1 ? p1[r] + b1 : NEGBIG;
            }
        }
        float mx = fmaxf(p0[0], p1[0]);
#pragma unroll
        for (int r = 1; r < 16; ++r) mx = fmaxf(mx, fmaxf(p0[r], p1[r]));
        { auto rr = __builtin_amdgcn_permlane32_swap(__float_as_uint(mx), __float_as_uint(mx), false, false); mx = fmaxf(__uint_as_float(rr[0]), __uint_as_float(rr[1])); }
        mx = selq ? mx : NEGBIG;
        const float mn = fmaxf(m, mx), f = fexp2(m - mn), sub = selq ? mn : 3.0e38f; m = mn;
        float ls = 0.f;
#pragma unroll
        for (int r = 0; r < 16; ++r) { p0[r] = fexp2(p0[r] - sub); p1[r] = fexp2(p1[r] - sub); ls += p0[r] + p1[r]; }
        l = l * f + ls;
        if (!__all(f == 1.f)) {
#pragma unroll
            for (int r = 0; r < 16; ++r) { o0[r] *= f; o1[r] *= f; }
        }
        nsa_pv(lds + NL_VT + buf * 8192, lane, hi, p0, p1, o0, o1);
        }
        if (q1 < 0) break;
        j = q1; q1 = q2; q2 = q3; buf = (buf + 1) & 3;
    }
#undef NSA_DMA
#undef NSA_POP
    __syncthreads();
    const float lt = l + __shfl_xor(l, 32), sc = gate * frcp(lt);
#pragma unroll
    for (int r = 0; r < 16; ++r) { out0[r] += sc * o0[r]; out1[r] += sc * o1[r]; }
}

__device__ __forceinline__ void nsa_unit(const Ctx& F, int bl, int g, int qt, const bf16_t* P, const bf16_t* KC, const bf16_t* VC, const float* biasT, bf16_t* YB) {
    LAS unsigned char* lds = F.lds; int tid_ = F.tid; asm volatile("" : "+v"(tid_)); const int tid = tid_, lane = tid & 63, w = F.wave, r32 = lane & 31, hi = lane >> 5;
    const int h = w >> 1, ql = 32 * (w & 1) + r32, t = 64 * qt + ql;
    const size_t row = (size_t)bl * SEQ + t;
    ((LAS float*)(lds + NL_BIAS))[tid] = biasT[(g * 4 + (tid >> 7)) * 128 + (tid & 127)];
    if (tid == 0) *(LAS unsigned*)(lds + NL_UNI) = 0u;
    const bf16_t* qptr = P + row * LDP + C_Q + g * 256 + h * 64 + 8 * hi;
    const float g_c = sigmoidf_(bf1(P[row * LDP + C_NG + g * 4 + h])), g_s = sigmoidf_(bf1(P[row * LDP + C_NG + 8 + g * 4 + h])), g_w = sigmoidf_(bf1(P[row * LDP + C_NG + 16 + g * 4 + h]));
    const LAS float* biasH = (const LAS float*)(lds + NL_BIAS) + h * 128;
    f32x16 out0 = (f32x16){0.f, 0.f, 0.f, 0.f, 0.f, 0.f, 0.f, 0.f, 0.f, 0.f, 0.f, 0.f, 0.f, 0.f, 0.f, 0.f}, out1 = out0;

    const int ntile = (qt >= 16) ? 2 : 1;
    for (int tl = 0; tl < ntile; ++tl) {
        int nk = 64 * tl + (tid & 63); if (nk > 126) nk = 126;
        int nv = 64 * tl + (tid >> 3); if (nv > 126) nv = 126;
        const u32x4 kreg = *(const u32x4*)(KC + (size_t)(bl * 128 + nk) * 128 + g * 64 + 8 * (tid >> 6));
        const u32x4 vreg = *(const u32x4*)(VC + (size_t)(bl * 128 + nv) * 128 + g * 64 + 8 * (tid & 7));
        NSA_STORE_TILE(tl);
    }
    __syncthreads();
    {
        f32x16 s0, s1, s2, s3;
        { bf16x8 qB[4];
#pragma unroll
          for (int d0 = 0; d0 < 4; ++d0) qB[d0] = *(const bf16x8*)(qptr + 16 * d0);
          nsa_qk(lds + NL_KT, qB, r32, hi, s0, s1);
          if (ntile == 2) nsa_qk(lds + NL_KT + 8192, qB, r32, hi, s2, s3);
          else { s2 = (f32x16){0.f, 0.f, 0.f, 0.f, 0.f, 0.f, 0.f, 0.f, 0.f, 0.f, 0.f, 0.f, 0.f, 0.f, 0.f, 0.f}; s3 = s2; } }
        const int db = t - 31 - 64 * hi;
        float mx = NEGBIG;
#define CMP_MASK(S, V) _Pragma("unroll") for (int r = 0; r < 16; ++r) { const int d = db - 16 * (32 * (V) + (r & 3) + 8 * (r >> 2)); \
            const int c = d < 0 ? 0 : (d > 127 ? 127 : d); S[r] = (d >= 0) ? S[r] + biasH[c] : NEGBIG; mx = fmaxf(mx, S[r]); }
        CMP_MASK(s0, 0) CMP_MASK(s1, 1)
        if (ntile == 2) { CMP_MASK(s2, 2) CMP_MASK(s3, 3) }
#undef CMP_MASK
        mx = fmaxf(mx, __shfl_xor(mx, 32));
        float ls = 0.f;
#define CMP_EXP(S) _Pragma("unroll") for (int r = 0; r < 16; ++r) { S[r] = (S[r] > -1e29f) ? fexp2(S[r] - mx) : 0.f; ls += S[r]; }
        CMP_EXP(s0) CMP_EXP(s1)
        if (ntile == 2) { CMP_EXP(s2) CMP_EXP(s3) }
#undef CMP_EXP
        ls += __shfl_xor(ls, 32);
        const float inv = ls > 0.f ? 1.f / ls : 0.f;
#pragma unroll
        for (int r = 0; r < 16; ++r) { s0[r] *= inv; s1[r] *= inv; s2[r] *= inv; s3[r] *= inv; }
        LAS float* I = (LAS float*)(lds + NL_IMP) + (h * 64 + ql) * 33 + hi;
        float yprev = 0.f;
#define CMP_IMP(S, V) _Pragma("unroll") for (int a = 0; a < 4; ++a) { const float own = S[4 * a] + S[4 * a + 1] + S[4 * a + 2] + 0.5f * S[4 * a + 3]; \
            const float y = __shfl_xor(0.5f * S[4 * a + 3], 32); I[2 * (4 * (V) + a)] = own + (hi ? y : yprev); yprev = y; }
        CMP_IMP(s0, 0) CMP_IMP(s1, 1) CMP_IMP(s2, 2) CMP_IMP(s3, 3)
#undef CMP_IMP
        f32x16 o0 = (f32x16){0.f, 0.f, 0.f, 0.f, 0.f, 0.f, 0.f, 0.f, 0.f, 0.f, 0.f, 0.f, 0.f, 0.f, 0.f, 0.f}, o1 = o0;
        nsa_pv(lds + NL_VT, lane, hi, s0, s1, o0, o1);
        if (ntile == 2) nsa_pv(lds + NL_VT + 8192, lane, hi, s2, s3, o0, o1);
#pragma unroll
        for (int r = 0; r < 16; ++r) { out0[r] += g_c * o0[r]; out1[r] += g_c * o1[r]; }
    }
    __syncthreads();
    if (w == 0) {
        const LAS float* I = (const LAS float*)(lds + NL_IMP) + lane * 33;
        float v[32];
#pragma unroll
        for (int jj = 0; jj < 32; ++jj) v[jj] = (I[jj] + I[64 * 33 + jj]) + (I[128 * 33 + jj] + I[192 * 33 + jj]);
        unsigned sel = 1u | (1u << qt) | (qt >= 1 ? (1u << (qt - 1)) : 0u);
        const int need = 8 - __popc(sel);
#pragma unroll
        for (int it = 0; it < 5; ++it) {
            if (it < need) {
                int best = -1; float bv = -1e30f;
#pragma unroll
                for (int jj = 1; jj < 32; ++jj) { const bool ok = (jj <= qt - 2) && (((sel >> jj) & 1u) == 0u) && (v[jj] > bv); bv = ok ? v[jj] : bv; best = ok ? jj : best; }
                if (best >= 0) sel |= 1u << best;
            }
        }
        ((LAS unsigned*)(lds + NL_SEL))[lane] = sel;
        atomicOr((unsigned*)(lds + NL_UNI), sel);
    }
    __syncthreads();
    const unsigned uni = *(const LAS unsigned*)(lds + NL_UNI) & ((qt >= 31) ? 0xffffffffu : ((2u << qt) - 1u));
    const unsigned mysel = ((const LAS unsigned*)(lds + NL_SEL))[ql];
    const bf16_t* Pb = P + (size_t)bl * SEQ * LDP + C_KV + g * 64;
    nsa_branch<1>(F, Pb + 256, Pb + 384, uni, qt, ql, mysel, biasH, qptr, g_s, out0, out1);
    { const int lo = qt >= 8 ? qt - 8 : 0; const unsigned wm = (((qt >= 31) ? 0xffffffffu : ((2u << qt) - 1u)) >> lo) << lo;
      nsa_branch<2>(F, Pb + 512, Pb + 640, wm, qt, ql, 0u, biasH, qptr, g_w, out0, out1); }
    bf16_t* yo = YB + row * 512 + g * 256 + h * 64 + 4 * hi;
#pragma unroll
    for (int a = 0; a < 4; ++a) {
        u32x2 w0; w0.x = cvt_pk_bf16(out0[4 * a], out0[4 * a + 1]); w0.y = cvt_pk_bf16(out0[4 * a + 2], out0[4 * a + 3]); *(u32x2*)(yo + 8 * a) = w0;
        u32x2 w1; w1.x = cvt_pk_bf16(out1[4 * a], out1[4 * a + 1]); w1.y = cvt_pk_bf16(out1[4 * a + 2], out1[4 * a + 3]); *(u32x2*)(yo + 32 + 8 * a) = w1;
    }
    __syncthreads();
}

constexpr int SL_CT = 0, SL_BT = 34816, SL_XT = 69632, SL_XD = 77824, SL_XW = 86016, SL_HT = 94208, SL_YO = 102912, SL_ACS = 119296, SL_DTV = 119808;
__device__ __forceinline__ void ssd_unit(const Ctx& F, int bl, int hd, int ph, const bf16_t* P, const bf16_t* XC, float dtb, float Aneg, float Dh, bf16_t* YP) {
    LAS unsigned char* lds = F.lds; int tid_ = F.tid; asm volatile("" : "+v"(tid_)); const int tid = tid_, lane = tid & 63, w = F.wave, r32 = lane & 31, hi = lane >> 5;
    const int g = hd >> 2, p0 = 32 * ph; const size_t rowb = (size_t)bl * SEQ;
    const int q4 = (lane & 15) >> 2, p4 = lane & 3, g1 = (lane >> 4) & 1;
    LAS float* ACS = (LAS float*)(lds + SL_ACS); LAS float* DTV = (LAS float*)(lds + SL_DTV);
    u32x4 creg[4], breg[4], xreg; float dtraw = 0.f;
#define SSD_LOAD(ch) do { const bf16_t* xc = XC + (rowb + (size_t)(ch) * 128) * 2048; \
        _Pragma("unroll") for (int i = 0; i < 4; ++i) { const int r = (tid >> 4) + 32 * i; \
            creg[i] = *(const u32x4*)(xc + (size_t)r * 2048 + 1536 + g * 128 + 8 * (tid & 15)); breg[i] = *(const u32x4*)(xc + (size_t)r * 2048 + 1024 + g * 128 + 8 * (tid & 15)); } \
        xreg = *(const u32x4*)(xc + (size_t)(tid >> 2) * 2048 + hd * 64 + p0 + 8 * (tid & 3)); \
        if (tid < 128) dtraw = bf1(P[(rowb + (size_t)(ch) * 128 + tid) * LDP + C_DT + hd]); } while (0)
    f32x16 hs = (f32x16){0.f, 0.f, 0.f, 0.f, 0.f, 0.f, 0.f, 0.f, 0.f, 0.f, 0.f, 0.f, 0.f, 0.f, 0.f, 0.f};
    SSD_LOAD(0);
    for (int ch = 0; ch < 16; ++ch) {
#pragma unroll
        for (int i = 0; i < 4; ++i) { const int r = (tid >> 4) + 32 * i;
            *(LAS u32x4*)(lds + SL_CT + r * 272 + (tid & 15) * 16) = creg[i]; *(LAS u32x4*)(lds + SL_BT + r * 272 + (tid & 15) * 16) = breg[i]; }
        *(LAS u32x4*)(lds + SL_XT + (tid >> 2) * 64 + (tid & 3) * 16) = xreg;
        if (tid < 128) { const float x = dtraw + dtb; const float dtv = x > 20.f ? x : log1pf(__expf(x)); DTV[tid] = dtv; ACS[tid] = dtv * Aneg * LOG2E; }
        __syncthreads();
        if (w == 0) { const float a0 = ACS[2 * lane], a1 = ACS[2 * lane + 1]; float s = a0 + a1;
#pragma unroll
            for (int o = 1; o < 64; o <<= 1) { const float tt = __shfl_up(s, o); if (lane >= o) s += tt; }
            ACS[2 * lane] = s - a1; ACS[2 * lane + 1] = s; }
        __syncthreads();
        { const int lrow = tid >> 2; const float dl = DTV[lrow], wl = dl * fexp2(ACS[127] - ACS[lrow]);
          float x[8], xd[8], xw[8]; unpack8(xreg, x);
#pragma unroll
          for (int i = 0; i < 8; ++i) { xd[i] = x[i] * dl; xw[i] = x[i] * wl; }
          *(LAS u32x4*)(lds + SL_XD + lrow * 64 + (tid & 3) * 16) = pack8(xd); *(LAS u32x4*)(lds + SL_XW + lrow * 64 + (tid & 3) * 16) = pack8(xw); }
        if (w >= 4) {
#pragma unroll
            for (int a = 0; a < 4; ++a) { u32x2 t; t.x = cvt_pk_bf16(hs[4 * a], hs[4 * a + 1]); t.y = cvt_pk_bf16(hs[4 * a + 2], hs[4 * a + 3]);
                *(LAS u32x2*)(lds + SL_HT + r32 * 272 + (32 * (w - 4) + 8 * a + 4 * hi) * 2) = t; }
        }
        if (ch + 1 < 16) SSD_LOAD(ch + 1);
        __syncthreads();
        f32x16 y = (f32x16){0.f, 0.f, 0.f, 0.f, 0.f, 0.f, 0.f, 0.f, 0.f, 0.f, 0.f, 0.f, 0.f, 0.f, 0.f, 0.f};
        if (w < 4) {
            const int li = w, lidx = 32 * li + r32; const float acl = ACS[lidx];
            for (int si = 0; si <= li; ++si) {
                f32x16 s = (f32x16){0.f, 0.f, 0.f, 0.f, 0.f, 0.f, 0.f, 0.f, 0.f, 0.f, 0.f, 0.f, 0.f, 0.f, 0.f, 0.f};
#pragma unroll
                for (int kk = 0; kk < 8; ++kk) {
                    const bf16x8 aa = *(const LAS bf16x8*)(lds + SL_BT + (32 * si + r32) * 272 + (16 * kk + 8 * hi) * 2);
                    const bf16x8 bb = *(const LAS bf16x8*)(lds + SL_CT + lidx * 272 + (16 * kk + 8 * hi) * 2);
                    s = mfma32(aa, bb, s);
                }
#pragma unroll
                for (int r = 0; r < 16; ++r) { const int sidx = 32 * si + crow(r, hi); const float e = fexp2(acl - ACS[sidx]); s[r] = (sidx <= lidx) ? s[r] * e : 0.f; }
                u32x4 t0, t1;
                t0.x = cvt_pk_bf16(s[0], s[1]); t0.y = cvt_pk_bf16(s[2], s[3]); t0.z = cvt_pk_bf16(s[4], s[5]); t0.w = cvt_pk_bf16(s[6], s[7]);
                t1.x = cvt_pk_bf16(s[8], s[9]); t1.y = cvt_pk_bf16(s[10], s[11]); t1.z = cvt_pk_bf16(s[12], s[13]); t1.w = cvt_pk_bf16(s[14], s[15]);
                const LAS unsigned char* xb = lds + SL_XD + (32 * si + 4 * hi + q4) * 64 + g1 * 32 + p4 * 8;
                y = mfma32(cat8(trrd(xb), trrd(xb + 512)), __builtin_bit_cast(bf16x8, t0), y);
                y = mfma32(cat8(trrd(xb + 1024), trrd(xb + 1536)), __builtin_bit_cast(bf16x8, t1), y);
            }
        } else {
            const int wi = w - 4, lidx = 32 * wi + r32;
            f32x16 yo = (f32x16){0.f, 0.f, 0.f, 0.f, 0.f, 0.f, 0.f, 0.f, 0.f, 0.f, 0.f, 0.f, 0.f, 0.f, 0.f, 0.f};
#pragma unroll
            for (int kk = 0; kk < 8; ++kk) {
                const bf16x8 aa = *(const LAS bf16x8*)(lds + SL_HT + r32 * 272 + (16 * kk + 8 * hi) * 2);
                const bf16x8 bb = *(const LAS bf16x8*)(lds + SL_CT + lidx * 272 + (16 * kk + 8 * hi) * 2);
                yo = mfma32(aa, bb, yo);
            }
            const float el = fexp2(ACS[lidx]);
#pragma unroll
            for (int r = 0; r < 16; ++r) *(LAS float*)(lds + SL_YO + wi * 4096 + r * 256 + lane * 4) = yo[r] * el;
            const float dec = fexp2(ACS[127]);
#pragma unroll
            for (int r = 0; r < 16; ++r) hs[r] *= dec;
#pragma unroll
            for (int kk = 0; kk < 8; ++kk) {
                const LAS unsigned char* ab = lds + SL_BT + (16 * kk + 8 * hi + q4) * 272 + (32 * wi + 16 * g1 + 4 * p4) * 2;
                const LAS unsigned char* bb = lds + SL_XW + (16 * kk + 8 * hi + q4) * 64 + g1 * 32 + p4 * 8;
                hs = mfma32(cat8(trrd(ab), trrd(ab + 4 * 272)), cat8(trrd(bb), trrd(bb + 256)), hs);
            }
        }
        __syncthreads();
        if (w < 4) {
            const int li = w; bf16_t* yp = YP + (rowb + (size_t)ch * 128 + 32 * li + r32) * 1024 + hd * 64 + p0 + 4 * hi;
#pragma unroll
            for (int a = 0; a < 4; ++a) {
                const u32x2 xr = *(const LAS u32x2*)(lds + SL_XT + (32 * li + r32) * 64 + (8 * a + 4 * hi) * 2);
                const float x0 = bflo(xr.x), x1 = bfhi(xr.x), x2 = bflo(xr.y), x3 = bfhi(xr.y);
                const float v0 = y[4 * a] + *(const LAS float*)(lds + SL_YO + li * 4096 + (4 * a) * 256 + lane * 4) + Dh * x0;
                const float v1 = y[4 * a + 1] + *(const LAS float*)(lds + SL_YO + li * 4096 + (4 * a + 1) * 256 + lane * 4) + Dh * x1;
                const float v2 = y[4 * a + 2] + *(const LAS float*)(lds + SL_YO + li * 4096 + (4 * a + 2) * 256 + lane * 4) + Dh * x2;
                const float v3 = y[4 * a + 3] + *(const LAS float*)(lds + SL_YO + li * 4096 + (4 * a + 3) * 256 + lane * 4) + Dh * x3;
                u32x2 o; o.x = cvt_pk_bf16(v0, v1); o.y = cvt_pk_bf16(v2, v3); *(u32x2*)(yp + 8 * a) = o;
            }
        }
        __syncthreads();
    }
#undef SSD_LOAD
}

__device__ __forceinline__ void attn_phase(const Ctx& F, ArgsP a, int l, int gi) {
    LAS unsigned char* lds = F.lds;
    const bf16_t* P = (const bf16_t*)(a->ws + WS_ARENA + AR_P);
    const bf16_t* XC = (const bf16_t*)(F.dout + DO_XC);
    bf16_t* YP = (bf16_t*)(F.dout + DO_YC); bf16_t* YB = (bf16_t*)(F.dout + DO_YB);
    const bf16_t* KC = (const bf16_t*)(a->ws + WS_MISC + MI_KC); const bf16_t* VC = (const bf16_t*)(a->ws + WS_MISC + MI_VC);
    const float* biasT = (const float*)(a->ws + WS_MISC + MI_BIAS);
    unsigned* ctr = F.ctl + CW_WQ + 64 * (l * NG + gi);
    constexpr int NSSD = BG * 16 * 2, NNSA = BG * 2 * 32;
    for (int item = F.vcu; item < NSSD; item += F.G) {
        const int bl = item >> 5, hd = (item >> 1) & 15, ph = item & 1;
        for (int rr_ = 0; rr_ <= SSD_REP; ++rr_) ssd_unit(F, bl, hd, ph, P, XC, a->in[I_DTB][l * 16 + hd], -__expf(a->in[I_ALOG][l * 16 + hd]), a->in[I_DSKIP][l * 16 + hd], YP);
    }
    for (;;) {
        if (F.tid == 0) *(LAS int*)(lds + LDSX + LX_WQ) = (int)__hip_atomic_fetch_add(ctr, 1u, __ATOMIC_RELAXED, __HIP_MEMORY_SCOPE_AGENT);
        __syncthreads();
        const int idx = *(const LAS int*)(lds + LDSX + LX_WQ);
        __syncthreads();
        if (idx >= NNSA) break;
        const int qt = 31 - (idx >> 4), bg = idx & 15;
        for (int rr_ = 0; rr_ <= NSA_REP; ++rr_) nsa_unit(F, bg >> 1, bg & 1, qt, P, KC, VC, biasT, YB);
    }
}


__device__ __forceinline__ void ln1_route_phase(const Ctx& F, ArgsP a, int l) {
    LAS unsigned char* lds = F.lds; const int tid = F.tid, lane = F.lane, w = F.wave;
    LAS float* RWT = (LAS float*)lds;
    LAS int* lcnt = (LAS int*)(lds + LDSX + LX_CNTL); LAS int* lbase = (LAS int*)(lds + LDSX + LX_BASE); LAS int* rows = (LAS int*)(lds + LDSX + LX_ROWS);
    for (int i = tid; i < 16384; i += 512) RWT[(i & 15) * 1024 + (i >> 4)] = a->in[I_RW][i];
    bf16_t* H1 = (bf16_t*)(a->ws + WS_PRE1);
    const float* g = a->in[I_LN1G] + l * DM; const float* b = a->in[I_LN1B] + l * DM;
    float gg[16], bb[16], rb[16];
#pragma unroll
    for (int i = 0; i < 8; ++i) { gg[i] = g[8 * lane + i]; gg[8 + i] = g[512 + 8 * lane + i]; bb[i] = b[8 * lane + i]; bb[8 + i] = b[512 + 8 * lane + i]; }
#pragma unroll
    for (int e = 0; e < 16; ++e) rb[e] = a->in[I_RB][e];
    unsigned* gcnt = F.ctl + CW_CNT + 64 * l;
    int* route = (int*)(a->ws + WS_MISC + MI_ROUTE);
    for (int rb0 = blockIdx.x * 128; rb0 < T_; rb0 += F.G * 128) {
        if (tid < 16) lcnt[tid] = 0;
        __syncthreads();
        u32x4 nx0 = *(const u32x4*)(H1 + ((size_t)rb0 + w * 16) * DM + 8 * lane), nx1 = *(const u32x4*)(H1 + ((size_t)rb0 + w * 16) * DM + 512 + 8 * lane);
        for (int rr = 0; rr < 16; ++rr) {
            const int rl = w * 16 + rr; const size_t row = (size_t)rb0 + rl;
            float v[16];
            { const u32x4 c0 = nx0, c1 = nx1;
              if (rr + 1 < 16) { nx0 = *(const u32x4*)(H1 + (row + 1) * DM + 8 * lane); nx1 = *(const u32x4*)(H1 + (row + 1) * DM + 512 + 8 * lane); }
              float t[8]; unpack8(c0, t);
#pragma unroll
              for (int i = 0; i < 8; ++i) v[i] = t[i];
              unpack8(c1, t);
#pragma unroll
              for (int i = 0; i < 8; ++i) v[8 + i] = t[i]; }
            float s = 0.f;
#pragma unroll
            for (int i = 0; i < 16; ++i) s += v[i];
            const float mean = wave_sum(s) * (1.f / DM); float s2 = 0.f;
#pragma unroll
            for (int i = 0; i < 16; ++i) { v[i] -= mean; s2 += v[i] * v[i]; }
            const float rstd = 1.f / sqrtf(wave_sum(s2) * (1.f / DM) + LN_EPS);
#pragma unroll
            for (int i = 0; i < 16; ++i) v[i] = v[i] * rstd * gg[i] + bb[i];
            { float t[8];
#pragma unroll
              for (int i = 0; i < 8; ++i) t[i] = v[i];
              *(u32x4*)(H1 + row * DM + 8 * lane) = pack8(t);
#pragma unroll
              for (int i = 0; i < 8; ++i) t[i] = v[8 + i];
              *(u32x4*)(H1 + row * DM + 512 + 8 * lane) = pack8(t); }
            float lg[16];
#pragma unroll
            for (int e = 0; e < 16; ++e) {
                const f32x4 r0 = *(const LAS f32x4*)(RWT + e * 1024 + 8 * lane), r1 = *(const LAS f32x4*)(RWT + e * 1024 + 8 * lane + 4);
                const f32x4 r2 = *(const LAS f32x4*)(RWT + e * 1024 + 512 + 8 * lane), r3 = *(const LAS f32x4*)(RWT + e * 1024 + 512 + 8 * lane + 4);
                lg[e] = (v[0] * r0[0] + v[1] * r0[1] + v[2] * r0[2] + v[3] * r0[3]) + (v[4] * r1[0] + v[5] * r1[1] + v[6] * r1[2] + v[7] * r1[3])
                      + (v[8] * r2[0] + v[9] * r2[1] + v[10] * r2[2] + v[11] * r2[3]) + (v[12] * r3[0] + v[13] * r3[1] + v[14] * r3[2] + v[15] * r3[3]);
            }
#pragma unroll
            for (int e = 0; e < 16; ++e) lg[e] = wave_sum(lg[e]);
            float mx = lg[0];
#pragma unroll
            for (int e = 1; e < 16; ++e) mx = fmaxf(mx, lg[e]);
            float pr[16], ps = 0.f;
#pragma unroll
            for (int e = 0; e < 16; ++e) { pr[e] = __expf(lg[e] - mx); ps += pr[e]; }
            const float pinv = 1.f / ps;
            float sc[16];
#pragma unroll
            for (int e = 0; e < 16; ++e) { pr[e] *= pinv; sc[e] = pr[e] + rb[e]; }
            int grp = 0; float gbest = -1e30f;
#pragma unroll
            for (int q = 0; q < 4; ++q) {
                const float s0 = sc[4 * q], s1 = sc[4 * q + 1], s2_ = sc[4 * q + 2], s3 = sc[4 * q + 3];
                const float tot = (s0 + s1) + (s2_ + s3), mn1 = fminf(fminf(s0, s1), fminf(s2_, s3));
                const float m2 = fminf(fminf(fminf(fmaxf(s0, s1), fmaxf(s0, s2_)), fminf(fmaxf(s0, s3), fmaxf(s1, s2_))), fminf(fmaxf(s1, s3), fmaxf(s2_, s3)));
                const float top2 = tot - mn1 - m2;
                if (top2 > gbest) { gbest = top2; grp = q; }
            }
            float c0 = 0.f, c1 = 0.f, c2 = 0.f, c3 = 0.f, q0 = 0.f, q1 = 0.f, q2 = 0.f, q3 = 0.f;
#pragma unroll
            for (int q = 0; q < 4; ++q) if (grp == q) { c0 = sc[4 * q]; c1 = sc[4 * q + 1]; c2 = sc[4 * q + 2]; c3 = sc[4 * q + 3]; q0 = pr[4 * q]; q1 = pr[4 * q + 1]; q2 = pr[4 * q + 2]; q3 = pr[4 * q + 3]; }
            int i0 = 0; float b0 = c0; if (c1 > b0) { b0 = c1; i0 = 1; } if (c2 > b0) { b0 = c2; i0 = 2; } if (c3 > b0) { b0 = c3; i0 = 3; }
            int i1 = -1; float b1 = -1e30f;
            if (i0 != 0 && c0 > b1) { b1 = c0; i1 = 0; } if (i0 != 1 && c1 > b1) { b1 = c1; i1 = 1; } if (i0 != 2 && c2 > b1) { b1 = c2; i1 = 2; } if (i0 != 3 && c3 > b1) { b1 = c3; i1 = 3; }
            const float w0 = (i0 == 0) ? q0 : (i0 == 1) ? q1 : (i0 == 2) ? q2 : q3, w1 = (i1 == 0) ? q0 : (i1 == 1) ? q1 : (i1 == 2) ? q2 : q3;
            const float wn = 1.f / (w0 + w1);
            if (lane == 0) {
                const int e0 = 4 * grp + i0, e1 = 4 * grp + i1;
                const int pos0 = atomicAdd((int*)(lds + LDSX + LX_CNTL) + e0, 1), pos1 = atomicAdd((int*)(lds + LDSX + LX_CNTL) + e1, 1);
                rows[rl * 8 + 0] = e0; rows[rl * 8 + 1] = e1; rows[rl * 8 + 2] = pos0; rows[rl * 8 + 3] = pos1; rows[rl * 8 + 4] = __float_as_int(w0 * wn); rows[rl * 8 + 5] = __float_as_int(w1 * wn);
            }
        }
        __syncthreads();
        if (tid < 16) lbase[tid] = (int)__hip_atomic_fetch_add(gcnt + tid, (unsigned)lcnt[tid], __ATOMIC_RELAXED, __HIP_MEMORY_SCOPE_AGENT);
        __syncthreads();
        if (tid < 128) {
            const int e0 = rows[tid * 8], e1 = rows[tid * 8 + 1]; const int t = rb0 + tid;
            route[t] = e0 | (e1 << 8); route[T_ + t] = lbase[e0] + rows[tid * 8 + 2]; route[2 * T_ + t] = lbase[e1] + rows[tid * 8 + 3];
            route[3 * T_ + t] = rows[tid * 8 + 4]; route[4 * T_ + t] = rows[tid * 8 + 5];
        }
        __syncthreads();
    }
}

__device__ __forceinline__ int moe_tables(const Ctx& F, int l) {
    LAS int* off = (LAS int*)(F.lds + LDSX + LX_OFF); LAS int* tile_e = (LAS int*)(F.lds + LDSX + LX_TILE);
    __syncthreads();
    if (F.tid == 0) { int o = 0;
        for (int e = 0; e < 16; ++e) { off[e] = o; const int c = (int)__hip_atomic_load(F.ctl + CW_CNT + 64 * l + e, __ATOMIC_RELAXED, __HIP_MEMORY_SCOPE_AGENT); const int nt = (c + 255) >> 8;
            for (int k = 0; k < nt; ++k) tile_e[(o >> 8) + k] = e; o += nt << 8; }
        off[16] = o; }
    __syncthreads();
    return off[16] >> 8;
}
__device__ __forceinline__ void gather_phase(const Ctx& F, ArgsP a, int l) {
    const int nrt = moe_tables(F, l); (void)nrt;
    const LAS int* off = (const LAS int*)(F.lds + LDSX + LX_OFF);
    const bf16_t* H1 = (const bf16_t*)(a->ws + WS_PRE1); bf16_t* XS = (bf16_t*)(a->ws + WS_ARENA + AR_XS);
    const int* route = (const int*)(a->ws + WS_MISC + MI_ROUTE); int2* rinfo = (int2*)(a->ws + WS_MISC + MI_RINFO);
    u32x4 nx0 = *(const u32x4*)(H1 + (size_t)F.gw * DM + 8 * F.lane), nx1 = *(const u32x4*)(H1 + (size_t)F.gw * DM + 512 + 8 * F.lane);
    int nee = route[F.gw], np0 = route[T_ + F.gw], np1 = route[2 * T_ + F.gw];
    for (int t = F.gw; t < T_; t += F.NGW) {
        const int ee = nee, e0 = ee & 255, e1 = ee >> 8;
        const int r0 = off[e0] + np0, r1 = off[e1] + np1;
        const u32x4 v0 = nx0, v1 = nx1;
        if (t + F.NGW < T_) { const int tn = t + F.NGW; nx0 = *(const u32x4*)(H1 + (size_t)tn * DM + 8 * F.lane); nx1 = *(const u32x4*)(H1 + (size_t)tn * DM + 512 + 8 * F.lane);
            nee = route[tn]; np0 = route[T_ + tn]; np1 = route[2 * T_ + tn]; }
        *(u32x4*)(XS + (size_t)r0 * DM + 8 * F.lane) = v0; *(u32x4*)(XS + (size_t)r0 * DM + 512 + 8 * F.lane) = v1;
        *(u32x4*)(XS + (size_t)r1 * DM + 8 * F.lane) = v0; *(u32x4*)(XS + (size_t)r1 * DM + 512 + 8 * F.lane) = v1;
        if (F.lane == 0) { rinfo[r0] = make_int2(t, route[3 * T_ + t]); rinfo[r1] = make_int2(T_ + t, route[4 * T_ + t]); }
    }
    if (blockIdx.x == 0) {
        for (int e = 0; e < 16; ++e) { const int c = (int)__hip_atomic_load(F.ctl + CW_CNT + 64 * l + e, __ATOMIC_RELAXED, __HIP_MEMORY_SCOPE_AGENT);
            for (int r = off[e] + c + F.tid; r < off[e + 1]; r += 512) rinfo[r] = make_int2(-1, 0); }
    }
}

__device__ __forceinline__ void ln2_phase(const Ctx& F, ArgsP a, int l, bool last) {
    const bf16_t* H1 = (const bf16_t*)(a->ws + WS_PRE1); const bf16_t* YS = (const bf16_t*)(a->ws + WS_ARENA + AR_XS);
    bf16_t* H = (bf16_t*)(a->ws + WS_H); float* OUT = a->out;
    const float* g = a->in[I_LN2G] + l * DM; const float* b = a->in[I_LN2B] + l * DM; const int lane = F.lane;
    float gg[16], bb[16];
#pragma unroll
    for (int i = 0; i < 8; ++i) { gg[i] = g[8 * lane + i]; gg[8 + i] = g[512 + 8 * lane + i]; bb[i] = b[8 * lane + i]; bb[8 + i] = b[512 + 8 * lane + i]; }
    u32x4 nx[6];
#define LN2_LOAD(t_) do { _Pragma("unroll") for (int hf = 0; hf < 2; ++hf) { nx[3 * hf] = *(const u32x4*)(H1 + (size_t)(t_) * DM + 512 * hf + 8 * lane); \
        nx[3 * hf + 1] = *(const u32x4*)(YS + (size_t)(t_) * DM + 512 * hf + 8 * lane); nx[3 * hf + 2] = *(const u32x4*)(YS + (size_t)(T_ + (t_)) * DM + 512 * hf + 8 * lane); } } while (0)
    LN2_LOAD(F.gw);
    for (int t = F.gw; t < T_; t += F.NGW) {
        float v[16];
        u32x4 cur[6];
#pragma unroll
        for (int i = 0; i < 6; ++i) cur[i] = nx[i];
        if (t + F.NGW < T_) LN2_LOAD(t + F.NGW);
#pragma unroll
        for (int hf = 0; hf < 2; ++hf) { float x[8], y0[8], y1[8];
            unpack8(cur[3 * hf], x);
            unpack8(cur[3 * hf + 1], y0);
            unpack8(cur[3 * hf + 2], y1);
#pragma unroll
            for (int i = 0; i < 8; ++i) v[8 * hf + i] = DN_ALPHA * x[i] + (y0[i] + y1[i]); }
        float s = 0.f;
#pragma unroll
        for (int i = 0; i < 16; ++i) s += v[i];
        const float mean = wave_sum(s) * (1.f / DM); float s2 = 0.f;
#pragma unroll
        for (int i = 0; i < 16; ++i) { v[i] -= mean; s2 += v[i] * v[i]; }
        const float rstd = 1.f / sqrtf(wave_sum(s2) * (1.f / DM) + LN_EPS);
#pragma unroll
        for (int i = 0; i < 16; ++i) v[i] = v[i] * rstd * gg[i] + bb[i];
        if (last) {
#pragma unroll
            for (int hf = 0; hf < 2; ++hf) { float* o = OUT + (size_t)t * DM + 512 * hf + 8 * lane;
                *(f32x4*)o = (f32x4){v[8 * hf], v[8 * hf + 1], v[8 * hf + 2], v[8 * hf + 3]}; *(f32x4*)(o + 4) = (f32x4){v[8 * hf + 4], v[8 * hf + 5], v[8 * hf + 6], v[8 * hf + 7]}; }
        } else {
#pragma unroll
            for (int hf = 0; hf < 2; ++hf) { float tt[8];
#pragma unroll
                for (int i = 0; i < 8; ++i) tt[i] = v[8 * hf + i];
                *(u32x4*)(H + (size_t)t * DM + 512 * hf + 8 * lane) = pack8(tt); }
        }
    }
}

#ifndef REP_MASK
#define REP_MASK 0
#endif
#ifndef PH_MASK
#define PH_MASK 0xfff
#endif
constexpr int NSTEPS = 1 + DEPTH * (NG * 6 + 5);
__global__ void __launch_bounds__(512, 2) fwd_kernel(Args a_unused) {
    const ArgsP a = (ArgsP)__builtin_amdgcn_kernarg_segment_ptr();
    extern __shared__ __attribute__((aligned(16))) unsigned char smem[];
    const int wave0_ = __builtin_amdgcn_readfirstlane((int)threadIdx.x >> 6);
    Ctx F;
#define MKCTX do { int t_; asm volatile("v_mbcnt_lo_u32_b32 %0, -1, 0\n\tv_mbcnt_hi_u32_b32 %0, -1, %0" : "=v"(t_)); t_ += wave0_ * 64; F.lds = (LAS unsigned char*)smem; F.tid = t_; F.lane = t_ & 63; F.wave = wave0_; \
        F.G = gridDim.x; { const int bx = blockIdx.x; F.vcu = (F.G % 8 == 0) ? (bx % 8) * (F.G / 8) + bx / 8 : bx; } \
        F.gw = blockIdx.x * 8 + F.wave; F.NGW = F.G * 8; F.ws = a->ws; F.dout = (unsigned char*)a->out; F.ctl = (unsigned*)(a->ws + WS_CTL); } while (0)
    MKCTX;
    for (int u = F.tid; u < (LDS_TOTAL - LDSX) / 4; u += 512) ((LAS unsigned*)(F.lds + LDSX))[u] = 0u;
    __syncthreads();
    const bool multi = (a->hi - a->lo) > 1;
    XcdBarrier bar; bar.bar = F.ctl + CW_BAR; bar.x = 0; bar.st = (volatile LAS unsigned*)(F.lds + LDSX + LX_BAR);
    if (multi) bar = xcd_barrier_post(F.ctl + CW_BAR, (volatile LAS unsigned*)(F.lds + LDSX + LX_BAR), F.tid);
    int step = 0;
#define RUN_STEP (step >= a->lo && step < a->hi)
#define END_STEP do { if (RUN_STEP && step + 1 < a->hi) xcd_barrier(bar, F.tid); ++step; } while (0)

    if (RUN_STEP && ((PH_MASK >> 0) & 1)) for (int rep_ = 0; rep_ <= ((REP_MASK >> 0) & 1); ++rep_) { MKCTX; p0_prologue(F, a); }
    END_STEP;

    {
        unsigned char* wl = a->ws + WS_W + (size_t)0 * W_LAYER;
        bf16_t* Hb = (bf16_t*)(a->ws + WS_H);
        bf16_t* P = (bf16_t*)(a->ws + WS_ARENA + AR_P);
        {
            const bf16_t* Hg = Hb + (size_t)0 * TG * DM;
            if (RUN_STEP && ((PH_MASK >> 1) & 1)) for (int rep_ = 0; rep_ <= ((REP_MASK >> 1) & 1); ++rep_) { MKCTX;
                pg8::Gemm g{Hg, (const bf16_t*)(wl + WO_IN), DM, DM, DM}; pg8::StaticOrder S; S.init(TG, LDP, DM, DM, F.G, (int)blockIdx.x);
                pg8::Epi<pg8::EK_PROJ> E{P, LDP, nullptr, 0, nullptr, nullptr};
                pg8::gemm_phase(F.lds, F.tid, g, S, E);
            }
            END_STEP;
            if (RUN_STEP && ((PH_MASK >> 2) & 1)) for (int rep_ = 0; rep_ <= ((REP_MASK >> 2) & 1); ++rep_) { MKCTX;
                for (int cu = blockIdx.x; cu < BG * 32; cu += F.G)
                    compress_unit(F, cu, P, (const bf16_t*)(wl + WO_W1), (const bf16_t*)(wl + WO_W2), (const float*)(a->ws + WS_MISC + MI_B1) + 0 * 256,
                                  (bf16_t*)(a->ws + WS_MISC + MI_KC), (bf16_t*)(a->ws + WS_MISC + MI_VC));
                conv_phase(F, P, (bf16_t*)(F.dout + DO_XC), a->in[I_CONVW] + (size_t)0 * 4 * 2048, a->in[I_CONVB] + (size_t)0 * 2048);
            }
            END_STEP;
            if (RUN_STEP && ((PH_MASK >> 3) & 1)) for (int rep_ = 0; rep_ <= ((REP_MASK >> 3) & 1); ++rep_) { MKCTX; attn_phase(F, a, 0, 0 + 4 * rep_); }
            END_STEP;
            if (RUN_STEP && ((PH_MASK >> 4) & 1)) for (int rep_ = 0; rep_ <= ((REP_MASK >> 4) & 1); ++rep_) { MKCTX; fin_phase(F, P, (bf16_t*)(F.dout + DO_R), (bf16_t*)(F.dout + DO_YC), a->in[I_SNG] + (size_t)0 * DM); }
            END_STEP;
            if (RUN_STEP && ((PH_MASK >> 5) & 1)) for (int rep_ = 0; rep_ <= ((REP_MASK >> 5) & 1); ++rep_) { MKCTX;
                bf16_t* GT = (bf16_t*)(a->ws + WS_ARENA + AR_GATES); bf16_t* MX = (bf16_t*)(a->ws + WS_ARENA + AR_MIXIN); float* TMP = (float*)(F.dout + DO_TMP);
                { pg8::Gemm g{Hg, (const bf16_t*)(wl + WO_GATE), DM, DM, DM}; pg8::GateOrder S; S.so.init(TG, DM, DM, DM, F.G, (int)blockIdx.x);
                  pg8::Epi<pg8::EK_GATE> E{GT, 3072, nullptr, 0, nullptr, nullptr}; pg8::gemm_phase(F.lds, F.tid, g, S, E); }
                { pg8::Gemm g{(const bf16_t*)(F.dout + DO_R), (const bf16_t*)(wl + WO_C), 512, 512, 512}; pg8::StaticOrder S; S.init(TG, DM, 512, 512, F.G, (int)blockIdx.x);
                  pg8::Epi<pg8::EK_BR0> E{nullptr, 0, GT, 3072, TMP, nullptr}; pg8::gemm_phase(F.lds, F.tid, g, S, E); }
                { pg8::Gemm g{(const bf16_t*)(F.dout + DO_YB), (const bf16_t*)(wl + WO_NSA), 512, 512, 512}; pg8::StaticOrder S; S.init(TG, DM, 512, 512, F.G, (int)blockIdx.x);
                  pg8::Epi<pg8::EK_BR1> E{nullptr, 0, GT + 1024, 3072, TMP, nullptr}; pg8::gemm_phase(F.lds, F.tid, g, S, E); }
                { pg8::Gemm g{(const bf16_t*)(F.dout + DO_YC), (const bf16_t*)(wl + WO_SSD), DM, DM, DM}; pg8::StaticOrder S; S.init(TG, DM, DM, DM, F.G, (int)blockIdx.x);
                  pg8::Epi<pg8::EK_BR2> E{MX, DM, GT + 2048, 3072, TMP, nullptr}; pg8::gemm_phase(F.lds, F.tid, g, S, E); }
            }
            END_STEP;
            if (RUN_STEP && ((PH_MASK >> 6) & 1)) for (int rep_ = 0; rep_ <= ((REP_MASK >> 6) & 1); ++rep_) { MKCTX;
                pg8::Gemm g{(const bf16_t*)(a->ws + WS_ARENA + AR_MIXIN), (const bf16_t*)(wl + WO_OUT), DM, DM, DM}; pg8::StaticOrder S; S.init(TG, DM, DM, DM, F.G, (int)blockIdx.x);
                pg8::Epi<pg8::EK_WOUT> E{(bf16_t*)(a->ws + WS_PRE1) + (size_t)0 * TG * DM, DM, Hg, DM, nullptr, nullptr};
                pg8::gemm_phase(F.lds, F.tid, g, S, E);
            }
            END_STEP;
        }
        {
            const bf16_t* Hg = Hb + (size_t)1 * TG * DM;
            if (RUN_STEP && ((PH_MASK >> 1) & 1)) for (int rep_ = 0; rep_ <= ((REP_MASK >> 1) & 1); ++rep_) { MKCTX;
                pg8::Gemm g{Hg, (const bf16_t*)(wl + WO_IN), DM, DM, DM}; pg8::StaticOrder S; S.init(TG, LDP, DM, DM, F.G, (int)blockIdx.x);
                pg8::Epi<pg8::EK_PROJ> E{P, LDP, nullptr, 0, nullptr, nullptr};
                pg8::gemm_phase(F.lds, F.tid, g, S, E);
            }
            END_STEP;
            if (RUN_STEP && ((PH_MASK >> 2) & 1)) for (int rep_ = 0; rep_ <= ((REP_MASK >> 2) & 1); ++rep_) { MKCTX;
                for (int cu = blockIdx.x; cu < BG * 32; cu += F.G)
                    compress_unit(F, cu, P, (const bf16_t*)(wl + WO_W1), (const bf16_t*)(wl + WO_W2), (const float*)(a->ws + WS_MISC + MI_B1) + 0 * 256,
                                  (bf16_t*)(a->ws + WS_MISC + MI_KC), (bf16_t*)(a->ws + WS_MISC + MI_VC));
                conv_phase(F, P, (bf16_t*)(F.dout + DO_XC), a->in[I_CONVW] + (size_t)0 * 4 * 2048, a->in[I_CONVB] + (size_t)0 * 2048);
            }
            END_STEP;
            if (RUN_STEP && ((PH_MASK >> 3) & 1)) for (int rep_ = 0; rep_ <= ((REP_MASK >> 3) & 1); ++rep_) { MKCTX; attn_phase(F, a, 0, 1 + 4 * rep_); }
            END_STEP;
            if (RUN_STEP && ((PH_MASK >> 4) & 1)) for (int rep_ = 0; rep_ <= ((REP_MASK >> 4) & 1); ++rep_) { MKCTX; fin_phase(F, P, (bf16_t*)(F.dout + DO_R), (bf16_t*)(F.dout + DO_YC), a->in[I_SNG] + (size_t)0 * DM); }
            END_STEP;
            if (RUN_STEP && ((PH_MASK >> 5) & 1)) for (int rep_ = 0; rep_ <= ((REP_MASK >> 5) & 1); ++rep_) { MKCTX;
                bf16_t* GT = (bf16_t*)(a->ws + WS_ARENA + AR_GATES); bf16_t* MX = (bf16_t*)(a->ws + WS_ARENA + AR_MIXIN); float* TMP = (float*)(F.dout + DO_TMP);
                { pg8::Gemm g{Hg, (const bf16_t*)(wl + WO_GATE), DM, DM, DM}; pg8::GateOrder S; S.so.init(TG, DM, DM, DM, F.G, (int)blockIdx.x);
                  pg8::Epi<pg8::EK_GATE> E{GT, 3072, nullptr, 0, nullptr, nullptr}; pg8::gemm_phase(F.lds, F.tid, g, S, E); }
                { pg8::Gemm g{(const bf16_t*)(F.dout + DO_R), (const bf16_t*)(wl + WO_C), 512, 512, 512}; pg8::StaticOrder S; S.init(TG, DM, 512, 512, F.G, (int)blockIdx.x);
                  pg8::Epi<pg8::EK_BR0> E{nullptr, 0, GT, 3072, TMP, nullptr}; pg8::gemm_phase(F.lds, F.tid, g, S, E); }
                { pg8::Gemm g{(const bf16_t*)(F.dout + DO_YB), (const bf16_t*)(wl + WO_NSA), 512, 512, 512}; pg8::StaticOrder S; S.init(TG, DM, 512, 512, F.G, (int)blockIdx.x);
                  pg8::Epi<pg8::EK_BR1> E{nullptr, 0, GT + 1024, 3072, TMP, nullptr}; pg8::gemm_phase(F.lds, F.tid, g, S, E); }
                { pg8::Gemm g{(const bf16_t*)(F.dout + DO_YC), (const bf16_t*)(wl + WO_SSD), DM, DM, DM}; pg8::StaticOrder S; S.init(TG, DM, DM, DM, F.G, (int)blockIdx.x);
                  pg8::Epi<pg8::EK_BR2> E{MX, DM, GT + 2048, 3072, TMP, nullptr}; pg8::gemm_phase(F.lds, F.tid, g, S, E); }
            }
            END_STEP;
            if (RUN_STEP && ((PH_MASK >> 6) & 1)) for (int rep_ = 0; rep_ <= ((REP_MASK >> 6) & 1); ++rep_) { MKCTX;
                pg8::Gemm g{(const bf16_t*)(a->ws + WS_ARENA + AR_MIXIN), (const bf16_t*)(wl + WO_OUT), DM, DM, DM}; pg8::StaticOrder S; S.init(TG, DM, DM, DM, F.G, (int)blockIdx.x);
                pg8::Epi<pg8::EK_WOUT> E{(bf16_t*)(a->ws + WS_PRE1) + (size_t)1 * TG * DM, DM, Hg, DM, nullptr, nullptr};
                pg8::gemm_phase(F.lds, F.tid, g, S, E);
            }
            END_STEP;
        }
        if (RUN_STEP && ((PH_MASK >> 7) & 1)) for (int rep_ = 0; rep_ <= ((REP_MASK >> 7) & 1); ++rep_) { MKCTX; ln1_route_phase(F, a, 0); }
        END_STEP;
        if (RUN_STEP && ((PH_MASK >> 8) & 1)) for (int rep_ = 0; rep_ <= ((REP_MASK >> 8) & 1); ++rep_) { MKCTX; gather_phase(F, a, 0); }
        END_STEP;
        if (RUN_STEP && ((PH_MASK >> 9) & 1)) for (int rep_ = 0; rep_ <= ((REP_MASK >> 9) & 1); ++rep_) { MKCTX;
            const int nrt = moe_tables(F, 0);
            pg8::Gemm g{(const bf16_t*)(a->ws + WS_ARENA + AR_XS), (const bf16_t*)(wl + WO_UP), DM, DM, DM};
            pg8::MoeOrder S{(const LAS int*)(F.lds + LDSX + LX_TILE), nrt, F.G, F.vcu, (long)256 * DM * 2, (long)256 * DM * 2, (long)1024 * DM * 2};
            pg8::Epi<pg8::EK_GLU> E{(bf16_t*)(a->ws + WS_ARENA + AR_HID), 512, nullptr, 0, nullptr, nullptr};
            pg8::gemm_phase(F.lds, F.tid, g, S, E);
        }
        END_STEP;
        if (RUN_STEP && ((PH_MASK >> 10) & 1)) for (int rep_ = 0; rep_ <= ((REP_MASK >> 10) & 1); ++rep_) { MKCTX;
            const int nrt = moe_tables(F, 0);
            pg8::Gemm g{(const bf16_t*)(a->ws + WS_ARENA + AR_HID), (const bf16_t*)(wl + WO_DN), 512, 512, 512};
            pg8::MoeOrder S{(const LAS int*)(F.lds + LDSX + LX_TILE), nrt, F.G, F.vcu, (long)256 * 512 * 2, (long)256 * 512 * 2, (long)1024 * 512 * 2};
            pg8::Epi<pg8::EK_DOWN> E{(bf16_t*)(a->ws + WS_ARENA + AR_XS), DM, nullptr, 0, nullptr, (const int2*)(a->ws + WS_MISC + MI_RINFO)};
            pg8::gemm_phase(F.lds, F.tid, g, S, E);
        }
        END_STEP;
        if (RUN_STEP && ((PH_MASK >> 11) & 1)) for (int rep_ = 0; rep_ <= ((REP_MASK >> 11) & 1); ++rep_) { MKCTX; ln2_phase(F, a, 0, 0 == DEPTH - 1); }
        END_STEP;
    }
    {
        unsigned char* wl = a->ws + WS_W + (size_t)1 * W_LAYER;
        bf16_t* Hb = (bf16_t*)(a->ws + WS_H);
        bf16_t* P = (bf16_t*)(a->ws + WS_ARENA + AR_P);
        {
            const bf16_t* Hg = Hb + (size_t)0 * TG * DM;
            if (RUN_STEP && ((PH_MASK >> 1) & 1)) for (int rep_ = 0; rep_ <= ((REP_MASK >> 1) & 1); ++rep_) { MKCTX;
                pg8::Gemm g{Hg, (const bf16_t*)(wl + WO_IN), DM, DM, DM}; pg8::StaticOrder S; S.init(TG, LDP, DM, DM, F.G, (int)blockIdx.x);
                pg8::Epi<pg8::EK_PROJ> E{P, LDP, nullptr, 0, nullptr, nullptr};
                pg8::gemm_phase(F.lds, F.tid, g, S, E);
            }
            END_STEP;
            if (RUN_STEP && ((PH_MASK >> 2) & 1)) for (int rep_ = 0; rep_ <= ((REP_MASK >> 2) & 1); ++rep_) { MKCTX;
                for (int cu = blockIdx.x; cu < BG * 32; cu += F.G)
                    compress_unit(F, cu, P, (const bf16_t*)(wl + WO_W1), (const bf16_t*)(wl + WO_W2), (const float*)(a->ws + WS_MISC + MI_B1) + 1 * 256,
                                  (bf16_t*)(a->ws + WS_MISC + MI_KC), (bf16_t*)(a->ws + WS_MISC + MI_VC));
                conv_phase(F, P, (bf16_t*)(F.dout + DO_XC), a->in[I_CONVW] + (size_t)1 * 4 * 2048, a->in[I_CONVB] + (size_t)1 * 2048);
            }
            END_STEP;
            if (RUN_STEP && ((PH_MASK >> 3) & 1)) for (int rep_ = 0; rep_ <= ((REP_MASK >> 3) & 1); ++rep_) { MKCTX; attn_phase(F, a, 1, 0 + 4 * rep_); }
            END_STEP;
            if (RUN_STEP && ((PH_MASK >> 4) & 1)) for (int rep_ = 0; rep_ <= ((REP_MASK >> 4) & 1); ++rep_) { MKCTX; fin_phase(F, P, (bf16_t*)(F.dout + DO_R), (bf16_t*)(F.dout + DO_YC), a->in[I_SNG] + (size_t)1 * DM); }
            END_STEP;
            if (RUN_STEP && ((PH_MASK >> 5) & 1)) for (int rep_ = 0; rep_ <= ((REP_MASK >> 5) & 1); ++rep_) { MKCTX;
                bf16_t* GT = (bf16_t*)(a->ws + WS_ARENA + AR_GATES); bf16_t* MX = (bf16_t*)(a->ws + WS_ARENA + AR_MIXIN); float* TMP = (float*)(F.dout + DO_TMP);
                { pg8::Gemm g{Hg, (const bf16_t*)(wl + WO_GATE), DM, DM, DM}; pg8::GateOrder S; S.so.init(TG, DM, DM, DM, F.G, (int)blockIdx.x);
                  pg8::Epi<pg8::EK_GATE> E{GT, 3072, nullptr, 0, nullptr, nullptr}; pg8::gemm_phase(F.lds, F.tid, g, S, E); }
                { pg8::Gemm g{(const bf16_t*)(F.dout + DO_R), (const bf16_t*)(wl + WO_C), 512, 512, 512}; pg8::StaticOrder S; S.init(TG, DM, 512, 512, F.G, (int)blockIdx.x);
                  pg8::Epi<pg8::EK_BR0> E{nullptr, 0, GT, 3072, TMP, nullptr}; pg8::gemm_phase(F.lds, F.tid, g, S, E); }
                { pg8::Gemm g{(const bf16_t*)(F.dout + DO_YB), (const bf16_t*)(wl + WO_NSA), 512, 512, 512}; pg8::StaticOrder S; S.init(TG, DM, 512, 512, F.G, (int)blockIdx.x);
                  pg8::Epi<pg8::EK_BR1> E{nullptr, 0, GT + 1024, 3072, TMP, nullptr}; pg8::gemm_phase(F.lds, F.tid, g, S, E); }
                { pg8::Gemm g{(const bf16_t*)(F.dout + DO_YC), (const bf16_t*)(wl + WO_SSD), DM, DM, DM}; pg8::StaticOrder S; S.init(TG, DM, DM, DM, F.G, (int)blockIdx.x);
                  pg8::Epi<pg8::EK_BR2> E{MX, DM, GT + 2048, 3072, TMP, nullptr}; pg8::gemm_phase(F.lds, F.tid, g, S, E); }
            }
            END_STEP;
            if (RUN_STEP && ((PH_MASK >> 6) & 1)) for (int rep_ = 0; rep_ <= ((REP_MASK >> 6) & 1); ++rep_) { MKCTX;
                pg8::Gemm g{(const bf16_t*)(a->ws + WS_ARENA + AR_MIXIN), (const bf16_t*)(wl + WO_OUT), DM, DM, DM}; pg8::StaticOrder S; S.init(TG, DM, DM, DM, F.G, (int)blockIdx.x);
                pg8::Epi<pg8::EK_WOUT> E{(bf16_t*)(a->ws + WS_PRE1) + (size_t)0 * TG * DM, DM, Hg, DM, nullptr, nullptr};
                pg8::gemm_phase(F.lds, F.tid, g, S, E);
            }
            END_STEP;
        }
        {
            const bf16_t* Hg = Hb + (size_t)1 * TG * DM;
            if (RUN_STEP && ((PH_MASK >> 1) & 1)) for (int rep_ = 0; rep_ <= ((REP_MASK >> 1) & 1); ++rep_) { MKCTX;
                pg8::Gemm g{Hg, (const bf16_t*)(wl + WO_IN), DM, DM, DM}; pg8::StaticOrder S; S.init(TG, LDP, DM, DM, F.G, (int)blockIdx.x);
                pg8::Epi<pg8::EK_PROJ> E{P, LDP, nullptr, 0, nullptr, nullptr};
                pg8::gemm_phase(F.lds, F.tid, g, S, E);
            }
            END_STEP;
            if (RUN_STEP && ((PH_MASK >> 2) & 1)) for (int rep_ = 0; rep_ <= ((REP_MASK >> 2) & 1); ++rep_) { MKCTX;
                for (int cu = blockIdx.x; cu < BG * 32; cu += F.G)
                    compress_unit(F, cu, P, (const bf16_t*)(wl + WO_W1), (const bf16_t*)(wl + WO_W2), (const float*)(a->ws + WS_MISC + MI_B1) + 1 * 256,
                                  (bf16_t*)(a->ws + WS_MISC + MI_KC), (bf16_t*)(a->ws + WS_MISC + MI_VC));
                conv_phase(F, P, (bf16_t*)(F.dout + DO_XC), a->in[I_CONVW] + (size_t)1 * 4 * 2048, a->in[I_CONVB] + (size_t)1 * 2048);
            }
            END_STEP;
            if (RUN_STEP && ((PH_MASK >> 3) & 1)) for (int rep_ = 0; rep_ <= ((REP_MASK >> 3) & 1); ++rep_) { MKCTX; attn_phase(F, a, 1, 1 + 4 * rep_); }
            END_STEP;
            if (RUN_STEP && ((PH_MASK >> 4) & 1)) for (int rep_ = 0; rep_ <= ((REP_MASK >> 4) & 1); ++rep_) { MKCTX; fin_phase(F, P, (bf16_t*)(F.dout + DO_R), (bf16_t*)(F.dout + DO_YC), a->in[I_SNG] + (size_t)1 * DM); }
            END_STEP;
            if (RUN_STEP && ((PH_MASK >> 5) & 1)) for (int rep_ = 0; rep_ <= ((REP_MASK >> 5) & 1); ++rep_) { MKCTX;
                bf16_t* GT = (bf16_t*)(a->ws + WS_ARENA + AR_GATES); bf16_t* MX = (bf16_t*)(a->ws + WS_ARENA + AR_MIXIN); float* TMP = (float*)(F.dout + DO_TMP);
                { pg8::Gemm g{Hg, (const bf16_t*)(wl + WO_GATE), DM, DM, DM}; pg8::GateOrder S; S.so.init(TG, DM, DM, DM, F.G, (int)blockIdx.x);
                  pg8::Epi<pg8::EK_GATE> E{GT, 3072, nullptr, 0, nullptr, nullptr}; pg8::gemm_phase(F.lds, F.tid, g, S, E); }
                { pg8::Gemm g{(const bf16_t*)(F.dout + DO_R), (const bf16_t*)(wl + WO_C), 512, 512, 512}; pg8::StaticOrder S; S.init(TG, DM, 512, 512, F.G, (int)blockIdx.x);
                  pg8::Epi<pg8::EK_BR0> E{nullptr, 0, GT, 3072, TMP, nullptr}; pg8::gemm_phase(F.lds, F.tid, g, S, E); }
                { pg8::Gemm g{(const bf16_t*)(F.dout + DO_YB), (const bf16_t*)(wl + WO_NSA), 512, 512, 512}; pg8::StaticOrder S; S.init(TG, DM, 512, 512, F.G, (int)blockIdx.x);
                  pg8::Epi<pg8::EK_BR1> E{nullptr, 0, GT + 1024, 3072, TMP, nullptr}; pg8::gemm_phase(F.lds, F.tid, g, S, E); }
                { pg8::Gemm g{(const bf16_t*)(F.dout + DO_YC), (const bf16_t*)(wl + WO_SSD), DM, DM, DM}; pg8::StaticOrder S; S.init(TG, DM, DM, DM, F.G, (int)blockIdx.x);
                  pg8::Epi<pg8::EK_BR2> E{MX, DM, GT + 2048, 3072, TMP, nullptr}; pg8::gemm_phase(F.lds, F.tid, g, S, E); }
            }
            END_STEP;
            if (RUN_STEP && ((PH_MASK >> 6) & 1)) for (int rep_ = 0; rep_ <= ((REP_MASK >> 6) & 1); ++rep_) { MKCTX;
                pg8::Gemm g{(const bf16_t*)(a->ws + WS_ARENA + AR_MIXIN), (const bf16_t*)(wl + WO_OUT), DM, DM, DM}; pg8::StaticOrder S; S.init(TG, DM, DM, DM, F.G, (int)blockIdx.x);
                pg8::Epi<pg8::EK_WOUT> E{(bf16_t*)(a->ws + WS_PRE1) + (size_t)1 * TG * DM, DM, Hg, DM, nullptr, nullptr};
                pg8::gemm_phase(F.lds, F.tid, g, S, E);
            }
            END_STEP;
        }
        if (RUN_STEP && ((PH_MASK >> 7) & 1)) for (int rep_ = 0; rep_ <= ((REP_MASK >> 7) & 1); ++rep_) { MKCTX; ln1_route_phase(F, a, 1); }
        END_STEP;
        if (RUN_STEP && ((PH_MASK >> 8) & 1)) for (int rep_ = 0; rep_ <= ((REP_MASK >> 8) & 1); ++rep_) { MKCTX; gather_phase(F, a, 1); }
        END_STEP;
        if (RUN_STEP && ((PH_MASK >> 9) & 1)) for (int rep_ = 0; rep_ <= ((REP_MASK >> 9) & 1); ++rep_) { MKCTX;
            const int nrt = moe_tables(F, 1);
            pg8::Gemm g{(const bf16_t*)(a->ws + WS_ARENA + AR_XS), (const bf16_t*)(wl + WO_UP), DM, DM, DM};
            pg8::MoeOrder S{(const LAS int*)(F.lds + LDSX + LX_TILE), nrt, F.G, F.vcu, (long)256 * DM * 2, (long)256 * DM * 2, (long)1024 * DM * 2};
            pg8::Epi<pg8::EK_GLU> E{(bf16_t*)(a->ws + WS_ARENA + AR_HID), 512, nullptr, 0, nullptr, nullptr};
            pg8::gemm_phase(F.lds, F.tid, g, S, E);
        }
        END_STEP;
        if (RUN_STEP && ((PH_MASK >> 10) & 1)) for (int rep_ = 0; rep_ <= ((REP_MASK >> 10) & 1); ++rep_) { MKCTX;
            const int nrt = moe_tables(F, 1);
            pg8::Gemm g{(const bf16_t*)(a->ws + WS_ARENA + AR_HID), (const bf16_t*)(wl + WO_DN), 512, 512, 512};
            pg8::MoeOrder S{(const LAS int*)(F.lds + LDSX + LX_TILE), nrt, F.G, F.vcu, (long)256 * 512 * 2, (long)256 * 512 * 2, (long)1024 * 512 * 2};
            pg8::Epi<pg8::EK_DOWN> E{(bf16_t*)(a->ws + WS_ARENA + AR_XS), DM, nullptr, 0, nullptr, (const int2*)(a->ws + WS_MISC + MI_RINFO)};
            pg8::gemm_phase(F.lds, F.tid, g, S, E);
        }
        END_STEP;
        if (RUN_STEP && ((PH_MASK >> 11) & 1)) for (int rep_ = 0; rep_ <= ((REP_MASK >> 11) & 1); ++rep_) { MKCTX; ln2_phase(F, a, 1, 1 == DEPTH - 1); }
        END_STEP;
    }
#undef RUN_STEP
#undef END_STEP
}

__global__ void dump_bf16(const bf16_t* src, float* dst, size_t n) { for (size_t i = (size_t)blockIdx.x * blockDim.x + threadIdx.x; i < n; i += (size_t)gridDim.x * blockDim.x) dst[i] = bf1(src[i]); }
#ifndef N_LAUNCH_MODE
#define N_LAUNCH_MODE 0
#endif
extern "C" void kernel_launch(void* const* d_in, const int* in_sizes, int n_in, void* d_out, int out_size, void* d_ws, size_t ws_size, hipStream_t stream) {
    static int grid = 0;
    if (grid == 0) {
        if (n_in != 32 || out_size != T_ * DM || ws_size < WS_END) { fprintf(stderr, "kernel_launch: unexpected problem (n_in %d out %d ws %zu)\n", n_in, out_size, ws_size); grid = -1; return; }
        int dev = 0, cus = 0, per_cu = 0;
        if (hipGetDevice(&dev) != hipSuccess || hipDeviceGetAttribute(&cus, hipDeviceAttributeMultiprocessorCount, dev) != hipSuccess) { grid = -1; return; }
        if (hipFuncSetAttribute((const void*)fwd_kernel, hipFuncAttributeMaxDynamicSharedMemorySize, LDS_TOTAL) != hipSuccess) { fprintf(stderr, "kernel_launch: hipFuncSetAttribute failed\n"); grid = -1; return; }
        if (hipOccupancyMaxActiveBlocksPerMultiprocessor(&per_cu, (const void*)fwd_kernel, 512, LDS_TOTAL) != hipSuccess || per_cu < 1)
            fprintf(stderr, "kernel_launch: occupancy query reports %d workgroups per CU\n", per_cu);
        (void)hipGetLastError();
        grid = cus;
    }
    if (grid < 0) return;
    (void)hipMemsetAsync((char*)d_ws + WS_CTL, 0, CTL_ZERO_BYTES, stream);
    Args a{};
    for (int i = 0; i < 32; ++i) a.in[i] = (const float*)d_in[i];
    a.out = (float*)d_out; a.ws = (unsigned char*)d_ws;
#if N_LAUNCH_MODE == 1
    a.lo = 0; a.hi = NSTEPS;
    hipLaunchKernelGGL(fwd_kernel, dim3(grid), dim3(512), LDS_TOTAL, stream, a);
#else
#ifdef DBG_STOP
    for (int s = 0; s <= DBG_STOP; ++s) { a.lo = s; a.hi = s + 1; hipLaunchKernelGGL(fwd_kernel, dim3(grid), dim3(512), LDS_TOTAL, stream, a); }
    hipLaunchKernelGGL(dump_bf16, dim3(1024), dim3(256), 0, stream, (const bf16_t*)((char*)d_ws + DBG_SRC), (float*)d_out, (size_t)T_ * DM);
#else
    for (int s = 0; s < NSTEPS; ++s) { a.lo = s; a.hi = s + 1; hipLaunchKernelGGL(fwd_kernel, dim3(grid), dim3(512), LDS_TOTAL, stream, a); }
#endif
#endif
}
```

```cpp
#define N_LAUNCH_MODE 1
#include <hip/hip_runtime.h>
#include <cstdio>
#include <cstdint>

#define LAS __attribute__((address_space(3)))
#define GAS __attribute__((address_space(1)))
typedef unsigned short bf16_t;
typedef short bf16x8 __attribute__((ext_vector_type(8)));
typedef short s16x4 __attribute__((ext_vector_type(4)));
typedef float f32x2 __attribute__((ext_vector_type(2)));
typedef float f32x4 __attribute__((ext_vector_type(4)));
typedef float f32x16 __attribute__((ext_vector_type(16)));
typedef unsigned u32x2 __attribute__((ext_vector_type(2)));
typedef unsigned u32x4 __attribute__((ext_vector_type(4)));

constexpr int T_ = 32768, SEQ = 2048, DM = 1024, NBATCH = 16, DEPTH = 2;
constexpr int NG = 2, BG = NBATCH / NG, TG = T_ / NG;
constexpr int LDP = 5120;
constexpr int C_POOL = 0, C_Q = 512, C_KV = 1024, C_Z = 1792, C_XBC = 2816, C_NG = 4864, C_DT = 4888;
constexpr int D_IN = 7976;
constexpr float LN_EPS = 1e-5f, DN_ALPHA = 1.41421356237f, LOG2E = 1.4426950408889634f;
constexpr float QSCALE = 0.125f * LOG2E;
constexpr float NEGBIG = -1e30f;
constexpr int MOE_ROWS = 69632;

constexpr size_t MiB = 1ull << 20;
constexpr size_t WS_CTL = 0, CTL_ZERO_BYTES = 65536;
constexpr size_t WS_MISC = 1 * MiB;
constexpr size_t WS_W = 8 * MiB, W_LAYER = 72 * MiB;
constexpr size_t WO_IN = 0, WO_GATE = 10 * MiB, WO_C = 16 * MiB, WO_NSA = 17 * MiB, WO_SSD = 18 * MiB, WO_OUT = 20 * MiB, WO_W1 = 22 * MiB, WO_W2 = 23 * MiB, WO_UP = 24 * MiB, WO_DN = 56 * MiB;
constexpr size_t WS_H = 152 * MiB, WS_PRE1 = 216 * MiB, WS_ARENA = 280 * MiB;
constexpr size_t AR_P = 0, AR_GATES = 0, AR_MIXIN = 96 * MiB;
constexpr size_t AR_XS = 0, AR_HID = 136 * MiB;
constexpr size_t WS_END = 484 * MiB;
constexpr size_t DO_XC = 0, DO_TMP = 0, DO_YC = 64 * MiB, DO_R = 96 * MiB, DO_YB = 112 * MiB;
constexpr size_t MI_BIAS = 0, MI_B1 = 4096, MI_KC = 65536, MI_VC = MI_KC + 262144, MI_ROUTE = 1 * MiB, MI_RINFO = 2 * MiB;
constexpr int CW_BAR = 4096, CW_WQ = 8192, CW_CNT = 12288;
constexpr int LDS_TOTAL = 147456, LDSX = 131072;
constexpr int LX_BAR = 0, LX_WQ = 16, LX_OFF = 64, LX_TILE = 256, LX_CNTL = 1536, LX_BASE = 1600, LX_ROWS = 2048;

__device__ __forceinline__ float bflo(unsigned u) { return __uint_as_float(u << 16); }
__device__ __forceinline__ float bfhi(unsigned u) { return __uint_as_float(u & 0xffff0000u); }
__device__ __forceinline__ float bf1(bf16_t b) { return __uint_as_float(((unsigned)b) << 16); }
typedef __bf16 bf16x2_t __attribute__((ext_vector_type(2)));
__device__ __forceinline__ unsigned cvt_pk_bf16(float lo, float hi) { const f32x2 v = {lo, hi}; const bf16x2_t b = __builtin_convertvector(v, bf16x2_t); return __builtin_bit_cast(unsigned, b); }
__device__ __forceinline__ bf16_t f2bf(float f) { return (bf16_t)(cvt_pk_bf16(f, 0.f) & 0xffffu); }
__device__ __forceinline__ float fexp2(float x) { return __builtin_amdgcn_exp2f(x); }
__device__ __forceinline__ float frcp(float x) { return __builtin_amdgcn_rcpf(x); }
__device__ __forceinline__ float sigmoidf_(float x) { return frcp(1.f + fexp2(-x * LOG2E)); }
__device__ __forceinline__ float siluf_(float x) { return x * sigmoidf_(x); }
__device__ __forceinline__ float wave_sum(float v) {
#pragma unroll
    for (int o = 1; o < 64; o <<= 1) v += __shfl_xor(v, o);
    return v;
}
__device__ __forceinline__ void unpack8(const u32x4 v, float (&x)[8]) {
    x[0] = bflo(v.x); x[1] = bfhi(v.x); x[2] = bflo(v.y); x[3] = bfhi(v.y); x[4] = bflo(v.z); x[5] = bfhi(v.z); x[6] = bflo(v.w); x[7] = bfhi(v.w);
}
__device__ __forceinline__ u32x4 pack8(const float (&x)[8]) {
    u32x4 w; w.x = cvt_pk_bf16(x[0], x[1]); w.y = cvt_pk_bf16(x[2], x[3]); w.z = cvt_pk_bf16(x[4], x[5]); w.w = cvt_pk_bf16(x[6], x[7]); return w;
}
#define LDS_WAIT() asm volatile("s_waitcnt lgkmcnt(0)" ::: "memory")
__device__ __forceinline__ int crow(int r, int hi) { return (r & 3) + 8 * (r >> 2) + 4 * hi; }
__device__ __forceinline__ f32x16 mfma32(bf16x8 a, bf16x8 b, f32x16 c) { return __builtin_amdgcn_mfma_f32_32x32x16_bf16(a, b, c, 0, 0, 0); }
__device__ __forceinline__ f32x4 mfma16(bf16x8 a, bf16x8 b, f32x4 c) { return __builtin_amdgcn_mfma_f32_16x16x32_bf16(a, b, c, 0, 0, 0); }
typedef short v4i16_t __attribute__((ext_vector_type(4)));
__device__ __forceinline__ s16x4 trrd(const LAS unsigned char* p) { return __builtin_bit_cast(s16x4, __builtin_amdgcn_ds_read_tr16_b64_v4i16((LAS v4i16_t*)p)); }
__device__ __forceinline__ bf16x8 cat8(s16x4 lo, s16x4 hi) { return (bf16x8){lo[0], lo[1], lo[2], lo[3], hi[0], hi[1], hi[2], hi[3]}; }

namespace pg8 {
constexpr int BM = 256, BK = 64, HALF = 128, HTB = HALF * BK * 2, STAGE_BYTES = 8 * HTB, NXCD = 8, WGM = 8;
__host__ __device__ __forceinline__ int lds_byte(int r, int c) { const int st = (r >> 4) * 2 + (c >> 5), rr = r & 15, cc = c & 31, ob = rr * 64 + cc * 2; return st * 1024 + (ob ^ (((ob >> 9) & 1) << 5)); }
__host__ __device__ __forceinline__ void stage_rc(int b, int& R, int& C) { const int st = b / 1024, sb = b % 1024, swz = sb ^ (((sb >> 9) & 1) << 5); R = (st >> 1) * 16 + swz / 64; C = (st & 1) * 32 + (swz % 64) / 2; }
__host__ __device__ __forceinline__ int perm32(int rho) { const int n = rho >> 4, i = rho & 15; return 8 * (i >> 2) + 4 * n + (i & 3); }

struct Unit { int pm, pn, nt, kind; long ab, bb; };
struct Gemm { const bf16_t* A; const bf16_t* Bt; int lda, ldb, K; };

struct StaticOrder {
    int nM, nN, nwg, G, c, nt0; long tsA, tsB;
    __device__ void init(int M, int N, int lda, int ldb, int G_, int c_, int K_ = 1024) { nM = M / BM; nN = N / BM; nwg = nM * nN; G = G_; c = c_; nt0 = K_ / BK; tsA = (long)BM * lda * 2; tsB = (long)BM * ldb * 2; }
    __device__ bool next(int i, Unit& u) const {
        const long L = (long)i * G + c; if (L >= nwg) return false;
        int wgid = (int)L; { const int q = nwg / NXCD, r = nwg % NXCD, xcd = wgid % NXCD, off = wgid / NXCD; wgid = (xcd < r ? xcd * (q + 1) : r * (q + 1) + (xcd - r) * q) + off; }
        const int nig = WGM * nN, gid = wgid / nig, fm = gid * WGM, gsz = (nM - fm) < WGM ? (nM - fm) : WGM;
        u.pm = fm + ((wgid % nig) % gsz); u.pn = (wgid % nig) / gsz; u.ab = u.pm * tsA; u.bb = u.pn * tsB; u.nt = nt0; u.kind = 0; return true;
    }
};
struct S5Order {
    StaticOrder so; long aH, aRY, aYC, bG, bCN, bS;
    __device__ bool next(int i, Unit& u) const {
        const int base = i / 6, s = i - 6 * base, x = s >> 1;
        if (!so.next(base, u)) return false;
        const long ra = u.ab, rb = u.bb;
        if ((s & 1) == 0) { u.ab = aH + ra; u.bb = bG + rb + (long)x * 1024 * 2048; u.nt = 16; u.kind = 0; u.pn += 4 * x; }
        else if (x == 0) { u.ab = aRY + ra; u.bb = bCN + rb; u.nt = 8; u.kind = 1; }
        else if (x == 1) { u.ab = aRY + ra + 1024; u.bb = bCN + rb + 1024; u.nt = 8; u.kind = 2; }
        else { u.ab = aYC + ra; u.bb = bS + rb; u.nt = 16; u.kind = 3; }
        return true;
    }
};
struct MoeOrder {
    const LAS int* tile_e; int nrt, G, vcu, nt0; long tsA, tsB, eB;
    __device__ bool next(int i, Unit& u) const {
        const long L = (long)i * G + vcu; if (L >= (long)nrt * 4) return false;
        const int rt = (int)(L >> 2), pn = (int)(L & 3), e = tile_e[rt];
        u.pm = rt; u.pn = pn; u.ab = rt * tsA; u.bb = e * eB + pn * tsB; u.nt = nt0; u.kind = 0; return true;
    }
};

template <class Epi, class Sched>
__device__ __forceinline__ void gemm_phase(LAS unsigned char* lds, int tid_, const Gemm g, const Sched& S, const Epi& E) {
    asm volatile("" : "+v"(tid_));
    const int tid = tid_, wid = __builtin_amdgcn_readfirstlane(tid >> 6), lane = tid & 63, wr = wid >> 2, wc = wid & 3, fr = lane & 15, fq = lane >> 4;
    unsigned voffA[2], voffB[2];
#pragma unroll
    for (int i = 0; i < 2; ++i) { int R, C; stage_rc(tid * 16 + i * 8192, R, C); const int Rb = Epi::PERM ? ((R & ~31) + perm32(R & 31)) : R;
        voffA[i] = (unsigned)(R * g.lda + C) * 2u; voffB[i] = (unsigned)(Rb * g.ldb + C) * 2u; }
    const size_t kstep = (size_t)(BK * 2);
    const size_t hstepA = (size_t)HALF * g.lda * 2, hstepB = (size_t)HALF * g.ldb * 2;
    const unsigned ldsw = (unsigned)wid * 1024u;
    const int aoff = lds_byte(wr * 64 + fr, fq * 8), boff = lds_byte(wc * 32 + fr, fq * 8);
#define PG8_SA(b, h) (((b) * 2 + (h)) * HTB)
#define PG8_SB(b, h) ((4 + (b) * 2 + (h)) * HTB)
#define PG8_STAGE(bufoff, gbase, voff) do { _Pragma("unroll") for (int _i = 0; _i < 2; ++_i) \
        __builtin_amdgcn_global_load_lds((const unsigned*)((const char*)(gbase) + (voff)[_i]), (LAS unsigned*)(lds + (bufoff) + ldsw + _i * 8192), 16, 0, 0); } while (0)
#define PG8_LDA(dst, b, h) do { _Pragma("unroll") for (int m = 0; m < 4; ++m) _Pragma("unroll") for (int k = 0; k < 2; ++k) dst[m][k] = *(const LAS bf16x8*)(lds + PG8_SA(b, h) + aoff + m * 2048 + k * 1024); } while (0)
#define PG8_LDB(dst, b, h) do { _Pragma("unroll") for (int n = 0; n < 2; ++n) _Pragma("unroll") for (int k = 0; k < 2; ++k) dst[n][k] = *(const LAS bf16x8*)(lds + PG8_SB(b, h) + boff + n * 2048 + k * 1024); } while (0)
#define PG8_MMA(ai, bj, At, Bt) do { __builtin_amdgcn_s_setprio(1); _Pragma("unroll") for (int m = 0; m < 4; ++m) _Pragma("unroll") for (int n = 0; n < 2; ++n) _Pragma("unroll") for (int k = 0; k < 2; ++k) \
        acc[ai][bj][m][n] = __builtin_amdgcn_mfma_f32_16x16x32_bf16(Bt[n][k], At[m][k], acc[ai][bj][m][n], 0, 0, 0); __builtin_amdgcn_s_setprio(0); } while (0)
#define PG8_WAIT_V(n) asm volatile("s_waitcnt vmcnt(" #n ")" ::: "memory")
#define PG8_WAIT_L(n) asm volatile("s_waitcnt lgkmcnt(" #n ")" ::: "memory")
#define PG8_BAR __builtin_amdgcn_s_barrier()
#define PG8_SCHED __builtin_amdgcn_sched_barrier(0)
    Unit cur, nxt; int ui = 0;
    if (!S.next(0, cur)) return;
    f32x4 acc[2][2][4][2];
#pragma unroll
    for (int a = 0; a < 2; ++a)
#pragma unroll
        for (int b = 0; b < 2; ++b)
#pragma unroll
            for (int m = 0; m < 4; ++m)
#pragma unroll
                for (int n = 0; n < 2; ++n) acc[a][b][m][n] = (f32x4){0.f, 0.f, 0.f, 0.f};
    bf16x8 At[4][2], B0[2][2], B1[2][2];
    const char* cA = (const char*)g.A + cur.ab; const char* cB = (const char*)g.Bt + cur.bb;
    PG8_STAGE(PG8_SB(0, 0), cB, voffB); PG8_STAGE(PG8_SB(0, 1), cB + hstepB, voffB); PG8_STAGE(PG8_SA(0, 0), cA, voffA); PG8_STAGE(PG8_SA(0, 1), cA + hstepA, voffA);
    if (wr == 1) PG8_BAR;
    PG8_WAIT_V(2); PG8_BAR;
    PG8_STAGE(PG8_SB(1, 0), cB + kstep, voffB); PG8_STAGE(PG8_SA(1, 0), cA + kstep, voffA); PG8_STAGE(PG8_SB(1, 1), cB + hstepB + kstep, voffB);
    PG8_WAIT_V(6); PG8_BAR;
    for (;;) {
        const bool has_next = S.next(ui + 1, nxt);
        const char* nA = has_next ? (const char*)g.A + nxt.ab : cA; const char* nB = has_next ? (const char*)g.Bt + nxt.bb : cB;
        const int nt = cur.nt;
        for (int t = 0; t < nt; t += 2) {
            const bool last = (t == nt - 2);
            const char* a1 = cA + (size_t)(t + 1) * kstep;
            const char* a2 = last ? nA : cA + (size_t)(t + 2) * kstep; const char* b2 = last ? nB : cB + (size_t)(t + 2) * kstep;
            const char* a3 = a2 + kstep; const char* b3 = b2 + kstep;
            PG8_LDB(B0, 0, 0); PG8_LDB(B1, 0, 1); PG8_SCHED; PG8_LDA(At, 0, 0); PG8_STAGE(PG8_SA(1, 1), a1 + hstepA, voffA);
            PG8_WAIT_V(8); PG8_WAIT_L(0); PG8_BAR; PG8_MMA(0, 0, At, B0); PG8_MMA(0, 1, At, B1); PG8_BAR; PG8_SCHED;
            PG8_LDA(At, 0, 1); PG8_STAGE(PG8_SB(0, 0), b2, voffB); PG8_STAGE(PG8_SB(0, 1), b2 + hstepB, voffB); PG8_STAGE(PG8_SA(0, 0), a2, voffA);
            PG8_WAIT_V(8); PG8_WAIT_L(0); PG8_BAR; PG8_MMA(1, 0, At, B0); PG8_MMA(1, 1, At, B1); PG8_BAR; PG8_SCHED;
            PG8_LDB(B0, 1, 0); PG8_LDB(B1, 1, 1); PG8_SCHED; PG8_LDA(At, 1, 0); PG8_STAGE(PG8_SA(0, 1), a2 + hstepA, voffA);
            PG8_WAIT_V(8); PG8_WAIT_L(0); PG8_BAR; PG8_MMA(0, 0, At, B0); PG8_MMA(0, 1, At, B1); PG8_BAR; PG8_SCHED;
            PG8_LDA(At, 1, 1); PG8_STAGE(PG8_SB(1, 0), b3, voffB); PG8_STAGE(PG8_SB(1, 1), b3 + hstepB, voffB); PG8_STAGE(PG8_SA(1, 0), a3, voffA);
            PG8_WAIT_V(8); PG8_WAIT_L(0); PG8_BAR; PG8_MMA(1, 0, At, B0); PG8_MMA(1, 1, At, B1); PG8_BAR; PG8_SCHED;
        }
        if (wr == 0) PG8_BAR;
        E(acc, cur, wr, wc, fr, fq);
        if (!has_next) break;
#pragma unroll
        for (int a = 0; a < 2; ++a)
#pragma unroll
            for (int b = 0; b < 2; ++b)
#pragma unroll
                for (int m = 0; m < 4; ++m)
#pragma unroll
                    for (int n = 0; n < 2; ++n) acc[a][b][m][n] = (f32x4){0.f, 0.f, 0.f, 0.f};
        cur = nxt; cA = nA; cB = nB; ++ui;
        if (wr == 1) PG8_BAR;
    }
    PG8_WAIT_V(0);
    PG8_BAR;
#undef PG8_SA
#undef PG8_SB
#undef PG8_STAGE
#undef PG8_LDA
#undef PG8_LDB
#undef PG8_MMA
#undef PG8_WAIT_V
#undef PG8_WAIT_L
#undef PG8_BAR
#undef PG8_SCHED
}

enum { EK_PROJ = 0, EK_GATE, EK_BR0, EK_BR1, EK_BR2, EK_WOUT, EK_GLU, EK_DOWN, EK_S5 };
template <int KIND> struct Epi {
    static constexpr bool PERM = true;
    bf16_t* O; int ldo;
    const bf16_t* X; int ldx;
    float* F;
    const int2* RI;
    bf16_t* O2;
    __device__ __forceinline__ void operator()(const f32x4 (&acc)[2][2][4][2], const Unit& u, int wr, int wc, int fr, int fq) const {
        const int row0 = u.pm * BM + wr * 64 + fr, col0 = u.pn * BM + wc * 32 + 8 * fq;
        if constexpr (KIND == EK_GLU) {
            const int hc0 = u.pn * 128 + wc * 32 + 8 * fq;
#pragma unroll
            for (int ai = 0; ai < 2; ++ai)
#pragma unroll
                for (int m = 0; m < 4; ++m) {
                    const int row = row0 + ai * HALF + m * 16; float o[8];
#pragma unroll
                    for (int n = 0; n < 2; ++n)
#pragma unroll
                        for (int j = 0; j < 4; ++j) o[4 * n + j] = siluf_(acc[ai][0][m][n][j]) * acc[ai][1][m][n][j];
                    *(u32x4*)(O + (size_t)row * ldo + hc0) = pack8(o);
                    asm volatile("" ::: "memory");
                }
        } else if constexpr (KIND == EK_DOWN) {
#pragma unroll
            for (int ai = 0; ai < 2; ++ai)
#pragma unroll
                for (int m = 0; m < 4; ++m) {
                    const int row = row0 + ai * HALF + m * 16; const int2 ri = RI[row]; const float w = __int_as_float(ri.y);
                    if (ri.x >= 0) {
#pragma unroll
                        for (int bj = 0; bj < 2; ++bj) { float o[8];
#pragma unroll
                            for (int n = 0; n < 2; ++n)
#pragma unroll
                                for (int j = 0; j < 4; ++j) o[4 * n + j] = w * acc[ai][bj][m][n][j];
                            *(u32x4*)(O + (size_t)ri.x * ldo + col0 + bj * HALF) = pack8(o); }
                    }
                    asm volatile("" ::: "memory");
                }
        } else if constexpr (KIND == EK_S5) {
            if (u.kind == 0) { Epi<EK_GATE> e{O, ldo, nullptr, 0, nullptr, nullptr, nullptr}; e(acc, u, wr, wc, fr, fq); }
            else if (u.kind == 1) { Epi<EK_BR0> e{nullptr, 0, O, ldo, F, nullptr, nullptr}; e(acc, u, wr, wc, fr, fq); }
            else if (u.kind == 2) { Epi<EK_BR1> e{nullptr, 0, O + 1024, ldo, F, nullptr, nullptr}; e(acc, u, wr, wc, fr, fq); }
            else { Epi<EK_BR2> e{O2, 1024, O + 2048, ldo, F, nullptr, nullptr}; e(acc, u, wr, wc, fr, fq); }
        } else {
            int act = 0;
            if constexpr (KIND == EK_PROJ) act = (u.pn == 2 || u.pn == 3) ? 1 : ((u.pn >= 7 && u.pn <= 10) ? 2 : 0);
#pragma unroll
            for (int ai = 0; ai < 2; ++ai)
#pragma unroll
                for (int m = 0; m < 4; ++m) {
                    const int row = row0 + ai * HALF + m * 16;
#pragma unroll
                    for (int bj = 0; bj < 2; ++bj) {
                        const int col = col0 + bj * HALF; float v[8];
#pragma unroll
                        for (int n = 0; n < 2; ++n)
#pragma unroll
                            for (int j = 0; j < 4; ++j) v[4 * n + j] = acc[ai][bj][m][n][j];
                        if constexpr (KIND == EK_PROJ) {
                            if (act == 1) {
#pragma unroll
                                for (int j = 0; j < 8; ++j) v[j] *= QSCALE;
                            } else if (act == 2) {
#pragma unroll
                                for (int j = 0; j < 8; ++j) v[j] = siluf_(v[j]);
                            }
                            *(u32x4*)(O + (size_t)row * ldo + col) = pack8(v);
                        } else if constexpr (KIND == EK_GATE) {
#pragma unroll
                            for (int j = 0; j < 8; ++j) v[j] = sigmoidf_(v[j]);
                            *(u32x4*)(O + (size_t)row * ldo + col) = pack8(v);
                        } else if constexpr (KIND == EK_BR0 || KIND == EK_BR1 || KIND == EK_BR2) {
                            float gt[8]; unpack8(*(const u32x4*)(X + (size_t)row * ldx + col), gt);
                            float* fp = F + (size_t)row * 1024 + col;
                            if constexpr (KIND == EK_BR0) {
                                *(f32x4*)fp = (f32x4){gt[0] * v[0], gt[1] * v[1], gt[2] * v[2], gt[3] * v[3]};
                                *(f32x4*)(fp + 4) = (f32x4){gt[4] * v[4], gt[5] * v[5], gt[6] * v[6], gt[7] * v[7]};
                            } else {
                                const f32x4 t0 = *(const f32x4*)fp, t1 = *(const f32x4*)(fp + 4);
                                float s[8];
#pragma unroll
                                for (int j = 0; j < 4; ++j) { s[j] = t0[j] + gt[j] * v[j]; s[4 + j] = t1[j] + gt[4 + j] * v[4 + j]; }
                                if constexpr (KIND == EK_BR1) { *(f32x4*)fp = (f32x4){s[0], s[1], s[2], s[3]}; *(f32x4*)(fp + 4) = (f32x4){s[4], s[5], s[6], s[7]}; }
                                else *(u32x4*)(O + (size_t)row * ldo + col) = pack8(s);
                            }
                        } else if constexpr (KIND == EK_WOUT) {
                            float hv[8]; unpack8(*(const u32x4*)(X + (size_t)row * ldx + col), hv);
#pragma unroll
                            for (int j = 0; j < 8; ++j) v[j] += DN_ALPHA * hv[j];
                            *(u32x4*)(O + (size_t)row * ldo + col) = pack8(v);
                        }
                        asm volatile("" ::: "memory");
                    }
                }
        }
    }
};
}

#define XB_TMO      128
#define XB_XCNT(j)  (256  + 64 * (j))
#define XB_XSUB(j)  (1280 + 64 * (j))
#define XB_XGEN(j)  (2304 + 64 * (j))
#define XB_TOP      3328
#define XB_TOPGEN   3392
#define XCD_BAR_WORDS 3456
#define XB_SPIN_CAP (1u << 20)
__device__ __forceinline__ unsigned xb_ld(unsigned* p)              { return __hip_atomic_load(p, __ATOMIC_RELAXED, __HIP_MEMORY_SCOPE_AGENT); }
__device__ __forceinline__ unsigned xb_add(unsigned* p, unsigned v) { return __hip_atomic_fetch_add(p, v, __ATOMIC_RELAXED, __HIP_MEMORY_SCOPE_AGENT); }
__device__ __forceinline__ unsigned xb_xcc_id() { return (unsigned)__builtin_amdgcn_s_getreg((3 << 11) | 20) & 0xFu; }
#define XB_SPIN(cond, bar) do { unsigned _sp = 0; while (cond) { __builtin_amdgcn_s_sleep(1); \
    if ((++_sp & 255u) == 0u) { if (xb_ld(&(bar)[XB_TMO])) break; if (_sp > XB_SPIN_CAP) { atomicAdd(&(bar)[XB_TMO], 1u); break; } } } } while (0)
struct XcdBarrier { unsigned* bar; unsigned x; volatile LAS unsigned* st; };
__device__ __forceinline__ XcdBarrier xcd_barrier_post(unsigned* bar, volatile LAS unsigned* st, int tid) {
    XcdBarrier b; b.bar = bar; b.x = xb_xcc_id(); b.st = st;
    if (tid == 0) (void)xb_add(&bar[XB_XCNT(b.x)], 1u);
    return b;
}
__device__ __forceinline__ void xcd_barrier_complete(unsigned* bar, unsigned x, unsigned& nloc, unsigned& nx) {
    const unsigned G = gridDim.x * gridDim.y * gridDim.z;
    unsigned sum, cnt, mine, sp = 0u;
    for (;;) {
        sum = 0u; cnt = 0u; mine = 0u;
#pragma unroll
        for (unsigned j = 0; j < 16; ++j) { const unsigned c = xb_ld(&bar[XB_XCNT(j)]); sum += c; cnt += (c > 0u) ? 1u : 0u; mine = (j == x) ? c : mine; }
        if (sum == G) break;
        __builtin_amdgcn_s_sleep(1);
        if ((++sp & 255u) == 0u) { if (xb_ld(&bar[XB_TMO])) break; if (sp > XB_SPIN_CAP) { atomicAdd(&bar[XB_TMO], 1u); break; } }
    }
    nloc = mine > 0u ? mine : 1u; nx = cnt > 0u ? cnt : 1u;
}
__device__ __forceinline__ void xcd_barrier(const XcdBarrier& b, int tid) {
    asm volatile("s_waitcnt vmcnt(0)" ::: "memory");
    __syncthreads();
    if (tid == 0) {
        unsigned* bar = b.bar;
        __builtin_amdgcn_s_waitcnt(0);
        unsigned nloc = b.st[0], nx = b.st[1];
        if (nloc == 0u) { xcd_barrier_complete(bar, b.x, nloc, nx); b.st[0] = nloc; b.st[1] = nx; }
        const unsigned old = xb_add(&bar[XB_XSUB(b.x)], 1u);
        const unsigned gen = old / nloc;
        if (old + 1u == (gen + 1u) * nloc) {
            __builtin_amdgcn_fence(__ATOMIC_RELEASE, "agent");
            asm volatile("s_waitcnt vmcnt(0)" ::: "memory");
            const unsigned og = xb_add(&bar[XB_TOP], 1u);
            const unsigned tg = og / nx;
            if (og + 1u == (tg + 1u) * nx) xb_add(&bar[XB_TOPGEN], 1u);
            else XB_SPIN(xb_ld(&bar[XB_TOPGEN]) == tg, bar);
            __builtin_amdgcn_fence(__ATOMIC_ACQUIRE, "agent");
            xb_add(&bar[XB_XGEN(b.x)], 1u);
            asm volatile("s_waitcnt vmcnt(0)" ::: "memory");
        } else {
            XB_SPIN(xb_ld(&bar[XB_XGEN(b.x)]) == gen, bar);
            __builtin_amdgcn_fence(__ATOMIC_ACQUIRE, "agent");
            asm volatile("s_waitcnt vmcnt(0)" ::: "memory");
        }
    }
    __syncthreads();
}

struct Args { const float* in[32]; float* out; unsigned char* ws; int lo, hi; };
typedef const __attribute__((address_space(4))) Args* ArgsP;
enum { I_X = 0, I_LN0G, I_LN0B, I_WIN, I_POOLW, I_POOLS, I_CKPE, I_CKW1, I_CKW2, I_CVPE, I_CVW1, I_CVW2, I_RELB, I_CONVW, I_CONVB, I_DTB, I_ALOG, I_DSKIP, I_SNG,
       I_WBP, I_WBN, I_WBS, I_WOUT, I_LN1G, I_LN1B, I_RW, I_RB, I_EW1, I_EW3, I_EW2, I_LN2G, I_LN2B };


struct Ctx {
    LAS unsigned char* lds;
    unsigned* ctl;
    unsigned char* ws; unsigned char* dout;
    int tid, lane, wave, G, vcu, gw, NGW;
};

struct Job { const float* src; size_t sbatch; int ldw, K, c0, ncols; bf16_t* dst; int dbatch_rows, ldt, drow0, mode, nbatch; };
constexpr int NJOBS = 15;
__device__ __forceinline__ Job get_job(ArgsP a, int l, int j) {
    unsigned char* wl = a->ws + WS_W + (size_t)l * W_LAYER;
    bf16_t* win = (bf16_t*)(wl + WO_IN); bf16_t* wg = (bf16_t*)(wl + WO_GATE);
    const float* w_in = a->in[I_WIN] + (size_t)l * DM * D_IN;
    Job J; J.sbatch = 0; J.dbatch_rows = 0; J.mode = 0; J.nbatch = 1; J.c0 = 0; J.drow0 = 0;
    switch (j) {
    case 0:  J.src = w_in; J.ldw = D_IN; J.K = 1024; J.c0 = 0;    J.ncols = 1792; J.dst = win; J.ldt = 1024; J.drow0 = 0; break;
    case 1:  J.src = w_in; J.ldw = D_IN; J.K = 1024; J.c0 = 1792; J.ncols = 24;   J.dst = win; J.ldt = 1024; J.drow0 = C_NG; break;
    case 2:  J.src = w_in; J.ldw = D_IN; J.K = 1024; J.c0 = 1816; J.ncols = 3072; J.dst = win; J.ldt = 1024; J.drow0 = C_Z; break;
    case 3:  J.src = w_in; J.ldw = D_IN; J.K = 1024; J.c0 = 4888; J.ncols = 16;   J.dst = win; J.ldt = 1024; J.drow0 = C_DT; break;
    case 4:  J.src = w_in; J.ldw = D_IN; J.K = 1024; J.c0 = 4904; J.ncols = 3072; J.dst = wg;  J.ldt = 1024; J.drow0 = 0; break;
    case 5:  J.src = a->in[I_WBN] + (size_t)l * 512 * 1024;  J.ldw = 1024; J.K = 512;  J.ncols = 1024; J.dst = (bf16_t*)(wl + WO_C) + 512; J.ldt = 1024; break;
    case 6:  J.src = a->in[I_WBS] + (size_t)l * 1024 * 1024; J.ldw = 1024; J.K = 1024; J.ncols = 1024; J.dst = (bf16_t*)(wl + WO_SSD); J.ldt = 1024; break;
    case 7:  J.src = a->in[I_WOUT] + (size_t)l * 1024 * 1024; J.ldw = 1024; J.K = 1024; J.ncols = 1024; J.dst = (bf16_t*)(wl + WO_OUT); J.ldt = 1024; break;
    case 8:  J.src = a->in[I_CKW1] + (size_t)l * 2048 * 128; J.ldw = 128; J.K = 2048; J.ncols = 128; J.dst = (bf16_t*)(wl + WO_W1); J.ldt = 2048; break;
    case 9:  J.src = a->in[I_CVW1] + (size_t)l * 2048 * 128; J.ldw = 128; J.K = 2048; J.ncols = 128; J.dst = (bf16_t*)(wl + WO_W1) + 128 * 2048; J.ldt = 2048; break;
    case 10: J.src = a->in[I_CKW2] + (size_t)l * 128 * 64; J.ldw = 64; J.K = 128; J.ncols = 64; J.dst = (bf16_t*)(wl + WO_W2); J.ldt = 128; break;
    case 11: J.src = a->in[I_CVW2] + (size_t)l * 128 * 64; J.ldw = 64; J.K = 128; J.ncols = 64; J.dst = (bf16_t*)(wl + WO_W2) + 64 * 128; J.ldt = 128; break;
    case 12: J.src = a->in[I_EW1] + (size_t)l * 16 * 1024 * 512; J.sbatch = (size_t)1024 * 512; J.ldw = 512; J.K = 1024; J.ncols = 512; J.dst = (bf16_t*)(wl + WO_UP); J.dbatch_rows = 1024; J.ldt = 1024; J.drow0 = 0;   J.mode = 1; J.nbatch = 16; break;
    case 13: J.src = a->in[I_EW3] + (size_t)l * 16 * 1024 * 512; J.sbatch = (size_t)1024 * 512; J.ldw = 512; J.K = 1024; J.ncols = 512; J.dst = (bf16_t*)(wl + WO_UP); J.dbatch_rows = 1024; J.ldt = 1024; J.drow0 = 128; J.mode = 1; J.nbatch = 16; break;
    default: J.src = a->in[I_EW2] + (size_t)l * 16 * 512 * 1024; J.sbatch = (size_t)512 * 1024; J.ldw = 1024; J.K = 512; J.ncols = 1024; J.dst = (bf16_t*)(wl + WO_DN); J.dbatch_rows = 1024; J.ldt = 512; J.nbatch = 16; break;
    }
    return J;
}
__device__ __forceinline__ void tr_item(const Job& J, int item, LAS float* scr, int lane) {
    const int nblk = (J.ncols + 31) >> 5, kblk = J.K >> 6, per = nblk * kblk;
    const int bt = item / per, r = item - bt * per, kb = r / nblk, nb = r - kb * nblk, k0 = 64 * kb, n0 = 32 * nb;
    const int nv = (J.ncols - n0) < 32 ? (J.ncols - n0) : 32;
    const float* W = J.src + (size_t)bt * J.sbatch;
    { const int nn = lane & 31; const float* wp = W + (size_t)(k0 + (lane >> 5)) * J.ldw + J.c0 + n0 + nn; float v[32];
#pragma unroll
      for (int i = 0; i < 32; ++i) v[i] = (nn < nv) ? wp[(size_t)(2 * i) * J.ldw] : 0.f;
#pragma unroll
      for (int i = 0; i < 32; ++i) scr[(2 * i + (lane >> 5)) * 33 + nn] = v[i]; }
    LDS_WAIT();
    const int c = lane & 7;
#pragma unroll
    for (int j = 0; j < 4; ++j) { const int n = (lane >> 3) + 8 * j;
        if (n < nv) {
            const LAS float* s = scr + (8 * c) * 33 + n; const int nn = n0 + n;
            const int drow = bt * J.dbatch_rows + J.drow0 + (J.mode == 1 ? ((nn >> 7) * 256 + (nn & 127)) : nn);
            u32x4 o; o.x = cvt_pk_bf16(s[0 * 33], s[1 * 33]); o.y = cvt_pk_bf16(s[2 * 33], s[3 * 33]); o.z = cvt_pk_bf16(s[4 * 33], s[5 * 33]); o.w = cvt_pk_bf16(s[6 * 33], s[7 * 33]);
            *(u32x4*)(J.dst + (size_t)drow * J.ldt + k0 + 8 * c) = o; } }
    LDS_WAIT();
}
__device__ __forceinline__ void ln_row_f32(const float* xrow, const float* g, const float* b, bf16_t* orow, int lane) {
    const f32x4* xr = (const f32x4*)xrow + lane; f32x4 v[4]; float s = 0.f;
#pragma unroll
    for (int j = 0; j < 4; ++j) { v[j] = xr[64 * j]; s += (v[j].x + v[j].y) + (v[j].z + v[j].w); }
    const float mean = wave_sum(s) * (1.f / DM); float s2 = 0.f;
#pragma unroll
    for (int j = 0; j < 4; ++j) { v[j] = v[j] - mean; s2 += (v[j].x * v[j].x + v[j].y * v[j].y) + (v[j].z * v[j].z + v[j].w * v[j].w); }
    const float rstd = 1.f / sqrtf(wave_sum(s2) * (1.f / DM) + LN_EPS);
    u32x2* o8 = (u32x2*)orow + lane;
#pragma unroll
    for (int j = 0; j < 4; ++j) { const f32x4 gg = ((const f32x4*)g + lane)[64 * j], bb = ((const f32x4*)b + lane)[64 * j];
        u32x2 w; w.x = cvt_pk_bf16(v[j].x * rstd * gg.x + bb.x, v[j].y * rstd * gg.y + bb.y); w.y = cvt_pk_bf16(v[j].z * rstd * gg.z + bb.z, v[j].w * rstd * gg.w + bb.w); o8[64 * j] = w; }
}
__device__ __forceinline__ int rel_bucket_dev(int n) {
    if (n < 16) return n;
    int b = 16;
    b += (n >= 19) + (n >= 21) + (n >= 24) + (n >= 27) + (n >= 31) + (n >= 35) + (n >= 40) + (n >= 46) + (n >= 52) + (n >= 59) + (n >= 67) + (n >= 77) + (n >= 87) + (n >= 99) + (n >= 113);
    return b;
}
__device__ __forceinline__ void p0_prologue(const Ctx& F, ArgsP a) {
    LAS float* scr = (LAS float*)(F.lds + F.wave * 16384);
    int base = 0;
    for (int l = 0; l < DEPTH; ++l)
        for (int j = 0; j < NJOBS; ++j) {
            const Job J = get_job(a, l, j);
            const int nitems = J.nbatch * (J.K >> 6) * ((J.ncols + 31) >> 5);
            int first = (F.gw - base) % F.NGW; if (first < 0) first += F.NGW;
            for (int it = first; it < nitems; it += F.NGW) tr_item(J, it, scr, F.lane);
            base = (base + nitems) % F.NGW;
        }
    { bf16_t* H = (bf16_t*)(a->ws + WS_H);
      for (int m = F.gw; m < T_; m += F.NGW) ln_row_f32(a->in[I_X] + (size_t)m * DM, a->in[I_LN0G], a->in[I_LN0B], H + (size_t)m * DM, F.lane); }
    { const int gt = blockIdx.x * 512 + F.tid, nthr = F.G * 512;
      for (int id = gt; id < DEPTH * 65536; id += nthr) {
          const int l = id >> 16, r = id & 65535, n = r & 1023, k8 = r >> 10, g = k8 >> 4, c0 = (k8 & 15) * 8;
          const float* pw = a->in[I_POOLW] + (size_t)l * 4 * 128 * 128 + (size_t)(g * 128 + c0) * 128;
          const float* sc = a->in[I_POOLS] + l * 512 + g * 128;
          const float* wb = a->in[I_WBP] + (size_t)l * 512 * 1024 + (size_t)(g * 128) * 1024 + n;
          float acc[8] = {0.f, 0.f, 0.f, 0.f, 0.f, 0.f, 0.f, 0.f};
          for (int d = 0; d < 128; ++d) { const float w = wb[(size_t)d * 1024] * sc[d];
#pragma unroll
              for (int i = 0; i < 8; ++i) acc[i] += pw[i * 128 + d] * w; }
          bf16_t* dst = (bf16_t*)(a->ws + WS_W + (size_t)l * W_LAYER + WO_C) + (size_t)n * 1024 + g * 128 + c0;
          *(u32x4*)dst = pack8(acc);
      } }
    for (int o = F.gw; o < DEPTH * 2 * 128; o += F.NGW) {
        const int l = o >> 8, kv = (o >> 7) & 1, col = o & 127;
        const float* pe = a->in[kv ? I_CVPE : I_CKPE] + (size_t)l * 2048; const float* w1 = a->in[kv ? I_CVW1 : I_CKW1] + (size_t)l * 2048 * 128 + col;
        float s = 0.f;
        for (int k = F.lane; k < 2048; k += 64) s += pe[k] * w1[(size_t)k * 128];
        s = wave_sum(s);
        if (F.lane == 0) ((float*)(a->ws + WS_MISC + MI_B1))[o] = s;
    }
    if (blockIdx.x == 0) {
        float* bt = (float*)(a->ws + WS_MISC + MI_BIAS);
        for (int i = F.tid; i < 8 * 128; i += 512) { const int hd = i >> 7, d = i & 127;
            bt[i] = (a->in[I_RELB][rel_bucket_dev(d) * 8 + hd] - a->in[I_RELB][31 * 8 + hd]) * LOG2E; }
    }
}

__device__ __forceinline__ void conv_phase(const Ctx& F, const bf16_t* P, bf16_t* XC, const float* cw, const float* cb) {
    const int gt = blockIdx.x * 512 + F.tid, nthr = F.G * 512;
    const int c = gt & 255;
    float w[4][8], b[8];
#pragma unroll
    for (int k = 0; k < 4; ++k)
#pragma unroll
        for (int i = 0; i < 8; ++i) w[k][i] = cw[k * 2048 + 8 * c + i];
#pragma unroll
    for (int i = 0; i < 8; ++i) b[i] = cb[8 * c + i];
    for (int id = gt; id < (TG / 16) * 256; id += nthr) {
        const int tl0 = (id >> 8) * 16, s0 = tl0 & (SEQ - 1);
        u32x4 raw[19];
#pragma unroll
        for (int r = 0; r < 19; ++r) raw[r] = (s0 + r - 3 >= 0) ? *(const u32x4*)(P + (size_t)(tl0 + r - 3) * LDP + C_XBC + 8 * c) : (u32x4){0u, 0u, 0u, 0u};
#pragma unroll
        for (int i = 0; i < 16; ++i) {
            float acc[8];
#pragma unroll
            for (int j = 0; j < 8; ++j) acc[j] = b[j];
#pragma unroll
            for (int k = 0; k < 4; ++k) { float x[8]; unpack8(raw[i + k], x);
#pragma unroll
                for (int j = 0; j < 8; ++j) acc[j] += w[k][j] * x[j]; }
#pragma unroll
            for (int j = 0; j < 8; ++j) acc[j] = siluf_(acc[j]);
            *(u32x4*)(XC + (size_t)(tl0 + i) * 2048 + 8 * c) = pack8(acc);
        }
    }
}
__device__ __forceinline__ void compress_unit(const Ctx& F, int cu, const bf16_t* P, const bf16_t* W1t, const bf16_t* W2t, const float* b1, bf16_t* KC, bf16_t* VC) {
    const int kv = cu & 1, g = (cu >> 1) & 1, nb = (cu >> 2) & 7, bl = cu >> 5;
    const int lane = F.lane, w = F.wave, fr = lane & 15, fq = lane >> 4;
    LAS bf16_t* hid = (LAS bf16_t*)F.lds;
    const bf16_t* w1 = W1t + (size_t)kv * 128 * 2048 + (size_t)(16 * w + fr) * 2048 + 8 * fq;
    int n0 = nb * 16 + fr; if (n0 > 126) n0 = 126;
    const bf16_t* a0 = P + (size_t)(bl * SEQ + 16 * n0) * LDP + C_KV + kv * 128 + g * 64 + 8 * fq;
    f32x4 acc0 = {0.f, 0.f, 0.f, 0.f}, acc1 = {0.f, 0.f, 0.f, 0.f};
#pragma unroll 8
    for (int kk = 0; kk < 64; kk += 2) {
        const int l = kk >> 1;
        const bf16x8 bb0 = *(const bf16x8*)(w1 + kk * 32), bb1 = *(const bf16x8*)(w1 + kk * 32 + 32);
        const bf16x8 x0 = *(const bf16x8*)(a0 + (size_t)l * LDP), x1 = *(const bf16x8*)(a0 + (size_t)l * LDP + 32);
        acc0 = mfma16(x0, bb0, acc0); acc1 = mfma16(x1, bb1, acc1);
    }
    const float bias = b1[kv * 128 + 16 * w + fr];
#pragma unroll
    for (int r = 0; r < 4; ++r) { const float x = acc0[r] + acc1[r] + bias, u = 0.7978845608f * (x + 0.044715f * x * x * x); hid[(4 * fq + r) * 136 + 16 * w + fr] = f2bf(x * sigmoidf_(2.f * u)); }
    __syncthreads();
    if (w < 4) { f32x4 acc = {0.f, 0.f, 0.f, 0.f};
      const bf16_t* w2 = W2t + (size_t)kv * 64 * 128 + (size_t)(16 * w + fr) * 128 + 8 * fq;
#pragma unroll
      for (int ks = 0; ks < 4; ++ks) { const bf16x8 aa = *(const LAS bf16x8*)(hid + fr * 136 + ks * 32 + 8 * fq); const bf16x8 bb = *(const bf16x8*)(w2 + ks * 32); acc = mfma16(aa, bb, acc); }
      bf16_t* dst = kv ? VC : KC;
#pragma unroll
      for (int r = 0; r < 4; ++r) { const int n = nb * 16 + 4 * fq + r; if (n < 127) dst[(size_t)(bl * 128 + n) * 128 + g * 64 + 16 * w + fr] = f2bf(acc[r]); }
    }
    __syncthreads();
}

template <int WIN>
__device__ __forceinline__ void pool_item(const bf16_t* P, bf16_t* R, int grp, int rq, int lane) {
    const int c = 16 * grp + (lane & 15), tl0 = (4 * rq + (lane >> 4)) * 8, s0 = tl0 & (SEQ - 1);
    constexpr int NROW = 7 + WIN;
    u32x4 raw[NROW];
#pragma unroll
    for (int k = 0; k < NROW; ++k) { const int sp = s0 - (WIN - 1) + k; raw[k] = (sp >= 0) ? *(const u32x4*)(P + (size_t)(tl0 - (WIN - 1) + k) * LDP + C_POOL + 8 * c) : (u32x4){0u, 0u, 0u, 0u}; }
#pragma unroll
    for (int i = 0; i < 8; ++i) {
        float sum[8] = {0.f, 0.f, 0.f, 0.f, 0.f, 0.f, 0.f, 0.f}, u0[8];
#pragma unroll
        for (int j = 0; j < WIN; ++j) { float x[8]; unpack8(raw[i + (WIN - 1) - j], x);
#pragma unroll
            for (int q = 0; q < 8; ++q) sum[q] += x[q]; }
        unpack8(raw[i + WIN - 1], u0);
        const int s = s0 + i, cnt = (s + 1) < WIN ? (s + 1) : WIN; const float inv = 1.f / (float)cnt;
#pragma unroll
        for (int q = 0; q < 8; ++q) sum[q] = sum[q] * inv - u0[q];
        *(u32x4*)(R + (size_t)(tl0 + i) * 1024 + 8 * c) = pack8(sum);
    }
}
__device__ __forceinline__ void fin_phase(const Ctx& F, const bf16_t* P, bf16_t* R, bf16_t* Y, const float* normg) {
    for (int wi = F.gw; wi < 4 * (TG / 32); wi += F.NGW) {
        const int grp = wi & 3, rq = wi >> 2;
        if (grp == 0) pool_item<2>(P, R, 0, rq, F.lane); else if (grp == 1) pool_item<4>(P, R, 1, rq, F.lane); else if (grp == 2) pool_item<8>(P, R, 2, rq, F.lane); else pool_item<16>(P, R, 3, rq, F.lane);
    }
    const int lane = F.lane;
    float ng[16];
#pragma unroll
    for (int i = 0; i < 16; ++i) ng[i] = normg[16 * lane + i];
    u32x4 nx[4];
#define FIN_LOAD(tl_) do { nx[0] = *(const u32x4*)(Y + (size_t)(tl_) * 1024 + 16 * lane); nx[1] = *(const u32x4*)(Y + (size_t)(tl_) * 1024 + 16 * lane + 8); \
        nx[2] = *(const u32x4*)(P + (size_t)(tl_) * LDP + C_Z + 16 * lane); nx[3] = *(const u32x4*)(P + (size_t)(tl_) * LDP + C_Z + 16 * lane + 8); } while (0)
    if (F.gw < TG) FIN_LOAD(F.gw);
    for (int tl = F.gw; tl < TG; tl += F.NGW) {
        const u32x4 c0 = nx[0], c1 = nx[1], c2 = nx[2], c3 = nx[3];
        if (tl + F.NGW < TG) FIN_LOAD(tl + F.NGW);
        float y[16], z[16];
        { float t[8]; unpack8(c0, t);
#pragma unroll
          for (int i = 0; i < 8; ++i) y[i] = t[i];
          unpack8(c1, t);
#pragma unroll
          for (int i = 0; i < 8; ++i) y[8 + i] = t[i];
          unpack8(c2, t);
#pragma unroll
          for (int i = 0; i < 8; ++i) z[i] = t[i];
          unpack8(c3, t);
#pragma unroll
          for (int i = 0; i < 8; ++i) z[8 + i] = t[i]; }
        float ss = 0.f;
#pragma unroll
        for (int i = 0; i < 16; ++i) { y[i] *= z[i]; ss += y[i] * y[i]; }
        ss += __shfl_xor(ss, 1); ss += __shfl_xor(ss, 2); ss += __shfl_xor(ss, 4); ss += __shfl_xor(ss, 8);
        const float rstd = 1.f / sqrtf(ss * (1.f / 256.f) + LN_EPS);
        float o[8];
#pragma unroll
        for (int i = 0; i < 8; ++i) o[i] = y[i] * rstd * ng[i];
        *(u32x4*)(Y + (size_t)tl * 1024 + 16 * lane) = pack8(o);
#pragma unroll
        for (int i = 0; i < 8; ++i) o[i] = y[8 + i] * rstd * ng[8 + i];
        *(u32x4*)(Y + (size_t)tl * 1024 + 16 * lane + 8) = pack8(o);
    }
#undef FIN_LOAD
}

#ifndef NSA_X1
#define NSA_X1 0
#endif
#ifndef NSA_X2
#define NSA_X2 0
#endif
#ifndef SSD_REP
#define SSD_REP 0
#endif
#ifndef NSA_REP
#define NSA_REP 0
#endif
constexpr int NL_KT = 0, NL_VT = 32768, NL_BIAS = 65536, NL_IMP = 67584, NL_SEL = 101376, NL_UNI = 101632;
__device__ __forceinline__ void glds16(const void* gsrc, unsigned lds_dst) { unsigned keep;
    asm volatile("s_mov_b32 %0, m0\n\ts_mov_b32 m0, %2\n\ts_nop 0\n\tglobal_load_lds_dwordx4 %1, off\n\ts_mov_b32 m0, %0" : "=&s"(keep) : "v"(gsrc), "s"(lds_dst) : "memory"); }
#define NSA_WAITBAR(N) asm volatile("s_waitcnt vmcnt(" #N ") lgkmcnt(0)\n\ts_barrier" ::: "memory")

#define NSA_STORE_TILE(buf) do { \
    *(LAS u32x4*)(lds + NL_KT + (buf) * 8192 + (tid >> 6) * 1024 + (tid & 63) * 16) = kreg; \
    *(LAS u32x4*)(lds + NL_VT + (buf) * 8192 + ((tid & 7) >> 2) * 4096 + (tid >> 3) * 64 + (tid & 3) * 16) = vreg; } while (0)

__device__ __forceinline__ void nsa_qk(const LAS unsigned char* Kt, const bf16x8 (&qB)[4], int r32, int hi, f32x16& p0, f32x16& p1) {
    p0 = (f32x16){0.f, 0.f, 0.f, 0.f, 0.f, 0.f, 0.f, 0.f, 0.f, 0.f, 0.f, 0.f, 0.f, 0.f, 0.f, 0.f}; p1 = p0;
#pragma unroll
    for (int d0 = 0; d0 < 4; ++d0) {
        const bf16x8 k0 = *(const LAS bf16x8*)(Kt + (2 * d0 + hi) * 1024 + r32 * 16);
        const bf16x8 k1 = *(const LAS bf16x8*)(Kt + (2 * d0 + hi) * 1024 + 512 + r32 * 16);
        p0 = mfma32(k0, qB[d0], p0); p1 = mfma32(k1, qB[d0], p1);
    }
#if NSA_X1
    { f32x16 t0 = (f32x16){0.f, 0.f, 0.f, 0.f, 0.f, 0.f, 0.f, 0.f, 0.f, 0.f, 0.f, 0.f, 0.f, 0.f, 0.f, 0.f}, t1 = t0; asm volatile("" ::: "memory");
#pragma unroll
      for (int d0 = 0; d0 < 4; ++d0) {
        const bf16x8 k0 = *(const volatile LAS bf16x8*)(Kt + (2 * d0 + hi) * 1024 + r32 * 16);
        const bf16x8 k1 = *(const volatile LAS bf16x8*)(Kt + (2 * d0 + hi) * 1024 + 512 + r32 * 16);
        t0 = mfma32(k0, qB[d0], t0); t1 = mfma32(k1, qB[d0], t1); }
#pragma unroll
      for (int r = 0; r < 16; ++r) { p0[r] = 0.5f * (p0[r] + t0[r]); p1[r] = 0.5f * (p1[r] + t1[r]); } }
#endif
}
__device__ __forceinline__ void nsa_pv(const LAS unsigned char* Vt, int lane, int hi, const f32x16& p0, const f32x16& p1, f32x16& o0, f32x16& o1) {
    bf16x8 pB[4];
    { u32x4 t; t.x = cvt_pk_bf16(p0[0], p0[1]); t.y = cvt_pk_bf16(p0[2], p0[3]); t.z = cvt_pk_bf16(p0[4], p0[5]); t.w = cvt_pk_bf16(p0[6], p0[7]); pB[0] = __builtin_bit_cast(bf16x8, t);
      t.x = cvt_pk_bf16(p0[8], p0[9]); t.y = cvt_pk_bf16(p0[10], p0[11]); t.z = cvt_pk_bf16(p0[12], p0[13]); t.w = cvt_pk_bf16(p0[14], p0[15]); pB[1] = __builtin_bit_cast(bf16x8, t);
      t.x = cvt_pk_bf16(p1[0], p1[1]); t.y = cvt_pk_bf16(p1[2], p1[3]); t.z = cvt_pk_bf16(p1[4], p1[5]); t.w = cvt_pk_bf16(p1[6], p1[7]); pB[2] = __builtin_bit_cast(bf16x8, t);
      t.x = cvt_pk_bf16(p1[8], p1[9]); t.y = cvt_pk_bf16(p1[10], p1[11]); t.z = cvt_pk_bf16(p1[12], p1[13]); t.w = cvt_pk_bf16(p1[14], p1[15]); pB[3] = __builtin_bit_cast(bf16x8, t); }
    const LAS unsigned char* vb = Vt + (4 * hi + ((lane & 15) >> 2)) * 64 + ((lane >> 4) & 1) * 32 + (lane & 3) * 8;
#pragma unroll
    for (int ks = 0; ks < 4; ++ks) {
        const bf16x8 va0 = cat8(trrd(vb + ks * 1024), trrd(vb + ks * 1024 + 512));
        const bf16x8 va1 = cat8(trrd(vb + 4096 + ks * 1024), trrd(vb + 4096 + ks * 1024 + 512));
        o0 = mfma32(va0, pB[ks], o0); o1 = mfma32(va1, pB[ks], o1);
    }
}

template <int MODE>
__device__ __forceinline__ void nsa_smpv(LAS unsigned char* lds, int j, int buf, f32x16& p0, f32x16& p1, int qt, int ql, bool selq, const LAS float* biasH, int lane, int hi,
                                         float& m, float& l, f32x16& o0, f32x16& o1) {
    const int dj = qt - j, dq = 64 * dj + ql - 4 * hi;
    const bool near = dj <= 2, edge = (MODE == 2) && (dj == 8);
    if (near || edge) {
#pragma unroll
        for (int r = 0; r < 16; ++r) {
            const int d0 = dq - ((r & 3) + 8 * (r >> 2)), d1 = d0 - 32;
            const bool v0 = d0 >= 0 && (MODE == 1 || d0 < 512), v1 = d1 >= 0 && (MODE == 1 || d1 < 512);
            float b0 = 0.f, b1 = 0.f;
            if (near) { const int c0 = d0 < 0 ? 0 : (d0 > 127 ? 127 : d0), c1 = d1 < 0 ? 0 : (d1 > 127 ? 127 : d1); b0 = biasH[c0]; b1 = biasH[c1]; }
            p0[r] = v0 ? p0[r] + b0 : NEGBIG; p1[r] = v1 ? p1[r] + b1 : NEGBIG;
        }
    }
    float mx = fmaxf(p0[0], p1[0]);
#pragma unroll
    for (int r = 1; r < 16; ++r) mx = fmaxf(mx, fmaxf(p0[r], p1[r]));
    { auto rr = __builtin_amdgcn_permlane32_swap(__float_as_uint(mx), __float_as_uint(mx), false, false); mx = fmaxf(__uint_as_float(rr[0]), __uint_as_float(rr[1])); }
    mx = selq ? mx : NEGBIG;
    const float mn = fmaxf(m, mx), f = fexp2(m - mn), sub = selq ? mn : 3.0e38f; m = mn;
    float ls = 0.f;
#pragma unroll
    for (int r = 0; r < 16; ++r) {
#if NSA_X2
        float a0 = p0[r] - sub, a1 = p1[r] - sub; asm volatile("" : "+v"(a0), "+v"(a1)); const float e0 = fexp2(a0), e1 = fexp2(a1); a0 = p0[r] - sub; a1 = p1[r] - sub; asm volatile("" : "+v"(a0), "+v"(a1));
        p0[r] = 0.5f * (e0 + fexp2(a0)); p1[r] = 0.5f * (e1 + fexp2(a1)); ls += p0[r] + p1[r];
#else
        p0[r] = fexp2(p0[r] - sub); p1[r] = fexp2(p1[r] - sub); ls += p0[r] + p1[r];
#endif
    }
    l = l * f + ls;
    if (!__all(f == 1.f)) {
#pragma unroll
        for (int r = 0; r < 16; ++r) { o0[r] *= f; o1[r] *= f; }
    }
    nsa_pv(lds + NL_VT + buf * 8192, lane, hi, p0, p1, o0, o1);
}

template <int MODE>
__device__ __forceinline__ void nsa_branch(const Ctx& F, const bf16_t* Kg, const bf16_t* Vg, unsigned tiles, int qt, int ql, unsigned mysel,
                                           const LAS float* biasH, const bf16_t* qptr, float gate, f32x16& out0, f32x16& out1) {
    LAS unsigned char* lds = F.lds; int tid_ = F.tid; asm volatile("" : "+v"(tid_)); const int tid = tid_, lane = tid & 63, r32 = lane & 31, hi = lane >> 5;
    bf16x8 qB[4];
#pragma unroll
    for (int d0 = 0; d0 < 4; ++d0) qB[d0] = *(const bf16x8*)(qptr + 16 * d0);
    float m = NEGBIG, l = 0.f;
    f32x16 o0 = (f32x16){0.f, 0.f, 0.f, 0.f, 0.f, 0.f, 0.f, 0.f, 0.f, 0.f, 0.f, 0.f, 0.f, 0.f, 0.f, 0.f}, o1 = o0;
    const int w = F.wave; const bool grpA = w < 4;
    const unsigned lbase = (unsigned)(size_t)lds;
    const bf16_t* ksrc = Kg + (size_t)lane * LDP + 8 * w;
    const bf16_t* vsrc = Vg + (size_t)(16 * (w & 3) + (lane >> 2)) * LDP + (w >> 2) * 32 + (lane & 3) * 8;
    const unsigned kdst = (unsigned)__builtin_amdgcn_readfirstlane((int)(lbase + NL_KT + w * 1024)), vdst = (unsigned)__builtin_amdgcn_readfirstlane((int)(lbase + NL_VT + (w >> 2) * 4096 + (w & 3) * 1024));
#define NSA_DMA(jj, slot) do { glds16(ksrc + (size_t)(jj) * 64 * LDP, kdst + (slot) * 8192); glds16(vsrc + (size_t)(jj) * 64 * LDP, vdst + (slot) * 8192); } while (0)
#define NSA_POP(dst) do { if (rem) { dst = (MODE == 1) ? (__ffs(rem) - 1) : (31 - __clz(rem)); rem &= ~(1u << dst); } else dst = -1; } while (0)
    unsigned rem = tiles; int j, q1;
    NSA_POP(j); NSA_POP(q1);
    NSA_DMA(j, 0); if (q1 >= 0) NSA_DMA(q1, 1);
    int buf = 0, jp = -1, bufp = 0; bool selp = true, done = false, selq = true, act = false;
    f32x16 pp0 = o0, pp1 = o0;
    for (;;) {
        if (!done) {
            if (q1 >= 0) NSA_WAITBAR(2); else NSA_WAITBAR(0);
            int q2; NSA_POP(q2);
            if (q2 >= 0) NSA_DMA(q2, (buf + 2) & 3);
            selq = (MODE == 1) ? (((mysel >> j) & 1u) != 0u) : true;
            act = (MODE != 1) || __any(selq);
            if (grpA && act) { nsa_qk(lds + NL_KT + buf * 8192, qB, r32, hi, pp0, pp1); jp = j; bufp = buf; selp = selq; }
            if (jp >= 0) { nsa_smpv<MODE>(lds, jp, bufp, pp0, pp1, qt, ql, selp, biasH, lane, hi, m, l, o0, o1); jp = -1; }
            if (!grpA && act) { nsa_qk(lds + NL_KT + buf * 8192, qB, r32, hi, pp0, pp1); jp = j; bufp = buf; selp = selq; }
            if (q1 < 0) done = true; else { j = q1; q1 = q2; buf = (buf + 1) & 3; }
        } else {
            if (jp >= 0) nsa_smpv<MODE>(lds, jp, bufp, pp0, pp1, qt, ql, selp, biasH, lane, hi, m, l, o0, o1);
            break;
        }
    }
#undef NSA_DMA
#undef NSA_POP
    __syncthreads();
    const float lt = l + __shfl_xor(l, 32), sc = gate * frcp(lt);
#pragma unroll
    for (int r = 0; r < 16; ++r) { out0[r] += sc * o0[r]; out1[r] += sc * o1[r]; }
}

__device__ __forceinline__ void nsa_unit(const Ctx& F, int bl, int g, int qt, const bf16_t* P, const bf16_t* KC, const bf16_t* VC, const float* biasT, bf16_t* YB) {
    LAS unsigned char* lds = F.lds; int tid_ = F.tid; asm volatile("" : "+v"(tid_)); const int tid = tid_, lane = tid & 63, w = F.wave, r32 = lane & 31, hi = lane >> 5;
    const int h = w >> 1, ql = 32 * (w & 1) + r32, t = 64 * qt + ql;
    const size_t row = (size_t)bl * SEQ + t;
    ((LAS float*)(lds + NL_BIAS))[tid] = biasT[(g * 4 + (tid >> 7)) * 128 + (tid & 127)];
    if (tid == 0) *(LAS unsigned*)(lds + NL_UNI) = 0u;
    const bf16_t* qptr = P + row * LDP + C_Q + g * 256 + h * 64 + 8 * hi;
    const float g_c = sigmoidf_(bf1(P[row * LDP + C_NG + g * 4 + h])), g_s = sigmoidf_(bf1(P[row * LDP + C_NG + 8 + g * 4 + h])), g_w = sigmoidf_(bf1(P[row * LDP + C_NG + 16 + g * 4 + h]));
    const LAS float* biasH = (const LAS float*)(lds + NL_BIAS) + h * 128;
    f32x16 out0 = (f32x16){0.f, 0.f, 0.f, 0.f, 0.f, 0.f, 0.f, 0.f, 0.f, 0.f, 0.f, 0.f, 0.f, 0.f, 0.f, 0.f}, out1 = out0;

    const int ntile = (qt >= 16) ? 2 : 1;
    for (int tl = 0; tl < ntile; ++tl) {
        int nk = 64 * tl + (tid & 63); if (nk > 126) nk = 126;
        int nv = 64 * tl + (tid >> 3); if (nv > 126) nv = 126;
        const u32x4 kreg = *(const u32x4*)(KC + (size_t)(bl * 128 + nk) * 128 + g * 64 + 8 * (tid >> 6));
        const u32x4 vreg = *(const u32x4*)(VC + (size_t)(bl * 128 + nv) * 128 + g * 64 + 8 * (tid & 7));
        NSA_STORE_TILE(tl);
    }
    __syncthreads();
    {
        f32x16 s0, s1, s2, s3;
        { bf16x8 qB[4];
#pragma unroll
          for (int d0 = 0; d0 < 4; ++d0) qB[d0] = *(const bf16x8*)(qptr + 16 * d0);
          nsa_qk(lds + NL_KT, qB, r32, hi, s0, s1);
          if (ntile == 2) nsa_qk(lds + NL_KT + 8192, qB, r32, hi, s2, s3);
          else { s2 = (f32x16){0.f, 0.f, 0.f, 0.f, 0.f, 0.f, 0.f, 0.f, 0.f, 0.f, 0.f, 0.f, 0.f, 0.f, 0.f, 0.f}; s3 = s2; } }
        const int db = t - 31 - 64 * hi;
        float mx = NEGBIG;
#define CMP_MASK(S, V) _Pragma("unroll") for (int r = 0; r < 16; ++r) { const int d = db - 16 * (32 * (V) + (r & 3) + 8 * (r >> 2)); \
            const int c = d < 0 ? 0 : (d > 127 ? 127 : d); S[r] = (d >= 0) ? S[r] + biasH[c] : NEGBIG; mx = fmaxf(mx, S[r]); }
        CMP_MASK(s0, 0) CMP_MASK(s1, 1)
        if (ntile == 2) { CMP_MASK(s2, 2) CMP_MASK(s3, 3) }
#undef CMP_MASK
        mx = fmaxf(mx, __shfl_xor(mx, 32));
        float ls = 0.f;
#define CMP_EXP(S) _Pragma("unroll") for (int r = 0; r < 16; ++r) { S[r] = (S[r] > -1e29f) ? fexp2(S[r] - mx) : 0.f; ls += S[r]; }
        CMP_EXP(s0) CMP_EXP(s1)
        if (ntile == 2) { CMP_EXP(s2) CMP_EXP(s3) }
#undef CMP_EXP
        ls += __shfl_xor(ls, 32);
        const float inv = ls > 0.f ? 1.f / ls : 0.f;
#pragma unroll
        for (int r = 0; r < 16; ++r) { s0[r] *= inv; s1[r] *= inv; s2[r] *= inv; s3[r] *= inv; }
        LAS float* I = (LAS float*)(lds + NL_IMP) + (h * 64 + ql) * 33 + hi;
        float yprev = 0.f;
#define CMP_IMP(S, V) _Pragma("unroll") for (int a = 0; a < 4; ++a) { const float own = S[4 * a] + S[4 * a + 1] + S[4 * a + 2] + 0.5f * S[4 * a + 3]; \
            const float y = __shfl_xor(0.5f * S[4 * a + 3], 32); I[2 * (4 * (V) + a)] = own + (hi ? y : yprev); yprev = y; }
        CMP_IMP(s0, 0) CMP_IMP(s1, 1) CMP_IMP(s2, 2) CMP_IMP(s3, 3)
#undef CMP_IMP
        f32x16 o0 = (f32x16){0.f, 0.f, 0.f, 0.f, 0.f, 0.f, 0.f, 0.f, 0.f, 0.f, 0.f, 0.f, 0.f, 0.f, 0.f, 0.f}, o1 = o0;
        nsa_pv(lds + NL_VT, lane, hi, s0, s1, o0, o1);
        if (ntile == 2) nsa_pv(lds + NL_VT + 8192, lane, hi, s2, s3, o0, o1);
#pragma unroll
        for (int r = 0; r < 16; ++r) { out0[r] += g_c * o0[r]; out1[r] += g_c * o1[r]; }
    }
    __syncthreads();
    if (w == 0) {
        const LAS float* I = (const LAS float*)(lds + NL_IMP) + lane * 33;
        float v[32];
#pragma unroll
        for (int jj = 0; jj < 32; ++jj) v[jj] = (I[jj] + I[64 * 33 + jj]) + (I[128 * 33 + jj] + I[192 * 33 + jj]);
        unsigned sel = 1u | (1u << qt) | (qt >= 1 ? (1u << (qt - 1)) : 0u);
        const int need = 8 - __popc(sel);
#pragma unroll
        for (int it = 0; it < 5; ++it) {
            if (it < need) {
                int best = -1; float bv = -1e30f;
#pragma unroll
                for (int jj = 1; jj < 32; ++jj) { const bool ok = (jj <= qt - 2) && (((sel >> jj) & 1u) == 0u) && (v[jj] > bv); bv = ok ? v[jj] : bv; best = ok ? jj : best; }
                if (best >= 0) sel |= 1u << best;
            }
        }
        ((LAS unsigned*)(lds + NL_SEL))[lane] = sel;
        atomicOr((unsigned*)(lds + NL_UNI), sel);
    }
    __syncthreads();
    const unsigned uni = *(const LAS unsigned*)(lds + NL_UNI) & ((qt >= 31) ? 0xffffffffu : ((2u << qt) - 1u));
    const unsigned mysel = ((const LAS unsigned*)(lds + NL_SEL))[ql];
    const bf16_t* Pb = P + (size_t)bl * SEQ * LDP + C_KV + g * 64;
    nsa_branch<1>(F, Pb + 256, Pb + 384, uni, qt, ql, mysel, biasH, qptr, g_s, out0, out1);
    { const int lo = qt >= 8 ? qt - 8 : 0; const unsigned wm = (((qt >= 31) ? 0xffffffffu : ((2u << qt) - 1u)) >> lo) << lo;
      nsa_branch<2>(F, Pb + 512, Pb + 640, wm, qt, ql, 0u, biasH, qptr, g_w, out0, out1); }
    bf16_t* yo = YB + row * 1024 + 512 + g * 256 + h * 64 + 4 * hi;
#pragma unroll
    for (int a = 0; a < 4; ++a) {
        u32x2 w0; w0.x = cvt_pk_bf16(out0[4 * a], out0[4 * a + 1]); w0.y = cvt_pk_bf16(out0[4 * a + 2], out0[4 * a + 3]); *(u32x2*)(yo + 8 * a) = w0;
        u32x2 w1; w1.x = cvt_pk_bf16(out1[4 * a], out1[4 * a + 1]); w1.y = cvt_pk_bf16(out1[4 * a + 2], out1[4 * a + 3]); *(u32x2*)(yo + 32 + 8 * a) = w1;
    }
    __syncthreads();
}

#define LDS_BARRIER() asm volatile("s_waitcnt lgkmcnt(0)\n\ts_barrier" ::: "memory")
constexpr int SL_CT = 0, SL_BT = 34816, SL_XT = 69632, SL_XD = 77824, SL_XW = 86016, SL_HT = 94208, SL_YO = 102912, SL_AW = 119296, SL_DW = 123392;
__device__ __forceinline__ void ssd_diag(const LAS unsigned char* lds, const LAS float* A_, int si, int li, int r32, int hi, int q4, int p4, int g1, f32x16& y) {
    const int lidx = 32 * li + r32; const float acl = A_[lidx];
    f32x16 s = (f32x16){0.f, 0.f, 0.f, 0.f, 0.f, 0.f, 0.f, 0.f, 0.f, 0.f, 0.f, 0.f, 0.f, 0.f, 0.f, 0.f};
#pragma unroll
    for (int kk = 0; kk < 8; ++kk) {
        const bf16x8 aa = *(const LAS bf16x8*)(lds + SL_BT + (32 * si + r32) * 272 + (16 * kk + 8 * hi) * 2);
        const bf16x8 bb = *(const LAS bf16x8*)(lds + SL_CT + lidx * 272 + (16 * kk + 8 * hi) * 2);
        s = mfma32(aa, bb, s);
    }
#pragma unroll
    for (int r = 0; r < 16; ++r) { const int sidx = 32 * si + crow(r, hi); const float e = fexp2(acl - A_[sidx]); s[r] = (sidx <= lidx) ? s[r] * e : 0.f; }
    u32x4 t0, t1;
    t0.x = cvt_pk_bf16(s[0], s[1]); t0.y = cvt_pk_bf16(s[2], s[3]); t0.z = cvt_pk_bf16(s[4], s[5]); t0.w = cvt_pk_bf16(s[6], s[7]);
    t1.x = cvt_pk_bf16(s[8], s[9]); t1.y = cvt_pk_bf16(s[10], s[11]); t1.z = cvt_pk_bf16(s[12], s[13]); t1.w = cvt_pk_bf16(s[14], s[15]);
    const LAS unsigned char* xb = lds + SL_XD + (32 * si + 4 * hi + q4) * 64 + g1 * 32 + p4 * 8;
    y = mfma32(cat8(trrd(xb), trrd(xb + 512)), __builtin_bit_cast(bf16x8, t0), y);
    y = mfma32(cat8(trrd(xb + 1024), trrd(xb + 1536)), __builtin_bit_cast(bf16x8, t1), y);
}
__device__ __forceinline__ void ssd_yoff(const LAS unsigned char* lds, const LAS float* A_, int li, int r32, int hi, f32x16& y) {
    const int lidx = 32 * li + r32;
#pragma unroll
    for (int kk = 0; kk < 8; ++kk) {
        const bf16x8 aa = *(const LAS bf16x8*)(lds + SL_HT + r32 * 272 + (16 * kk + 8 * hi) * 2);
        const bf16x8 bb = *(const LAS bf16x8*)(lds + SL_CT + lidx * 272 + (16 * kk + 8 * hi) * 2);
        y = mfma32(aa, bb, y);
    }
    const float el = fexp2(A_[lidx]);
#pragma unroll
    for (int r = 0; r < 16; ++r) y[r] *= el;
}
__device__ __forceinline__ void ssd_unit(const Ctx& F, int bl, int hd, int ph, const bf16_t* P, const bf16_t* XC, float dtb, float Aneg, float Dh, bf16_t* YP) {
    LAS unsigned char* lds = F.lds; int tid_ = F.tid; asm volatile("" : "+v"(tid_)); const int tid = tid_, lane = tid & 63, w = F.wave, r32 = lane & 31, hi = lane >> 5;
    const int g = hd >> 2, p0 = 32 * ph; const size_t rowb = (size_t)bl * SEQ;
    const int q4 = (lane & 15) >> 2, p4 = lane & 3, g1 = (lane >> 4) & 1;
    LAS float* A_ = (LAS float*)(lds + SL_AW) + w * 128; LAS float* D_ = (LAS float*)(lds + SL_DW) + w * 128;
    u32x4 creg[4], breg[4], xreg; float dt0 = 0.f, dt1 = 0.f;
#define SSD_LOAD(ch) do { const bf16_t* xc = XC + (rowb + (size_t)(ch) * 128) * 2048; \
        _Pragma("unroll") for (int i = 0; i < 4; ++i) { const int r = (tid >> 4) + 32 * i; \
            creg[i] = *(const u32x4*)(xc + (size_t)r * 2048 + 1536 + g * 128 + 8 * (tid & 15)); breg[i] = *(const u32x4*)(xc + (size_t)r * 2048 + 1024 + g * 128 + 8 * (tid & 15)); } \
        xreg = *(const u32x4*)(xc + (size_t)(tid >> 2) * 2048 + hd * 64 + p0 + 8 * (tid & 3)); \
        dt0 = bf1(P[(rowb + (size_t)(ch) * 128 + 2 * lane) * LDP + C_DT + hd]); dt1 = bf1(P[(rowb + (size_t)(ch) * 128 + 2 * lane + 1) * LDP + C_DT + hd]); } while (0)
    f32x16 hs = (f32x16){0.f, 0.f, 0.f, 0.f, 0.f, 0.f, 0.f, 0.f, 0.f, 0.f, 0.f, 0.f, 0.f, 0.f, 0.f, 0.f};
    SSD_LOAD(0);
    for (int ch = 0; ch < 16; ++ch) {
        { float x0 = dt0 + dtb, x1 = dt1 + dtb; const float v0 = x0 > 15.f ? x0 : __logf(1.f + __expf(x0)), v1 = x1 > 15.f ? x1 : __logf(1.f + __expf(x1));
          const float a0 = v0 * Aneg * LOG2E, a1 = v1 * Aneg * LOG2E; float sc = a0 + a1;
#pragma unroll
          for (int o = 1; o < 64; o <<= 1) { const float tt = __shfl_up(sc, o); if (lane >= o) sc += tt; }
          A_[2 * lane] = sc - a1; A_[2 * lane + 1] = sc; D_[2 * lane] = v0; D_[2 * lane + 1] = v1; }
#pragma unroll
        for (int i = 0; i < 4; ++i) { const int r = (tid >> 4) + 32 * i;
            *(LAS u32x4*)(lds + SL_CT + r * 272 + (tid & 15) * 16) = creg[i]; *(LAS u32x4*)(lds + SL_BT + r * 272 + (tid & 15) * 16) = breg[i]; }
        *(LAS u32x4*)(lds + SL_XT + (tid >> 2) * 64 + (tid & 3) * 16) = xreg;
        { const int lrow = tid >> 2; const float dl = D_[lrow], wl = dl * fexp2(A_[127] - A_[lrow]);
          float x[8], xd[8], xw[8]; unpack8(xreg, x);
#pragma unroll
          for (int i = 0; i < 8; ++i) { xd[i] = x[i] * dl; xw[i] = x[i] * wl; }
          *(LAS u32x4*)(lds + SL_XD + lrow * 64 + (tid & 3) * 16) = pack8(xd); *(LAS u32x4*)(lds + SL_XW + lrow * 64 + (tid & 3) * 16) = pack8(xw); }
        if (w >= 4) {
#pragma unroll
            for (int a = 0; a < 4; ++a) { u32x2 t; t.x = cvt_pk_bf16(hs[4 * a], hs[4 * a + 1]); t.y = cvt_pk_bf16(hs[4 * a + 2], hs[4 * a + 3]);
                *(LAS u32x2*)(lds + SL_HT + r32 * 272 + (32 * (w - 4) + 8 * a + 4 * hi) * 2) = t; }
        }
        if (ch + 1 < 16) SSD_LOAD(ch + 1);
        LDS_BARRIER();
        f32x16 y = (f32x16){0.f, 0.f, 0.f, 0.f, 0.f, 0.f, 0.f, 0.f, 0.f, 0.f, 0.f, 0.f, 0.f, 0.f, 0.f, 0.f};
        {
            const int li_ = (w == 0) ? 0 : (w == 1 || w == 7) ? 1 : (w == 2 || w == 5) ? 2 : 3;
            const int si0 = (w == 4 || w == 5) ? 2 : (w == 6) ? 3 : 0;
            const int nd = (w == 7) ? 0 : (w >= 1 && w <= 3) ? 2 : 1;
            const int yo = (w == 0) ? 0 : (w == 4) ? 3 : (w == 5) ? 2 : (w == 7) ? 1 : -1;
            if (yo >= 0) ssd_yoff(lds, A_, yo, r32, hi, y);
#pragma unroll 1
            for (int d = 0; d < nd; ++d) ssd_diag(lds, A_, si0 + d, li_, r32, hi, q4, p4, g1, y);
        }
        if (w >= 4) {
            const int wi = w - 4;
            { const int slot = (w == 7) ? 0 : (w == 5) ? 1 : (w == 4) ? 2 : 3;
#pragma unroll
              for (int r = 0; r < 16; ++r) *(LAS float*)(lds + SL_YO + slot * 4096 + r * 256 + lane * 4) = y[r]; }
            const float dec = fexp2(A_[127]);
#pragma unroll
            for (int r = 0; r < 16; ++r) hs[r] *= dec;
#pragma unroll
            for (int kk = 0; kk < 8; ++kk) {
                const LAS unsigned char* ab = lds + SL_BT + (16 * kk + 8 * hi + q4) * 272 + (32 * wi + 16 * g1 + 4 * p4) * 2;
                const LAS unsigned char* bb = lds + SL_XW + (16 * kk + 8 * hi + q4) * 64 + g1 * 32 + p4 * 8;
                hs = mfma32(cat8(trrd(ab), trrd(ab + 4 * 272)), cat8(trrd(bb), trrd(bb + 256)), hs);
            }
        }
        LDS_BARRIER();
        if (w < 4) {
            const int li = w; bf16_t* yp = YP + (rowb + (size_t)ch * 128 + 32 * li + r32) * 1024 + hd * 64 + p0 + 4 * hi;
#pragma unroll
            for (int a = 0; a < 4; ++a) {
                const u32x2 xr = *(const LAS u32x2*)(lds + SL_XT + (32 * li + r32) * 64 + (8 * a + 4 * hi) * 2);
                float v[4] = {y[4 * a] + Dh * bflo(xr.x), y[4 * a + 1] + Dh * bfhi(xr.x), y[4 * a + 2] + Dh * bflo(xr.y), y[4 * a + 3] + Dh * bfhi(xr.y)};
                if (li >= 1) {
#pragma unroll
                    for (int i = 0; i < 4; ++i) v[i] += *(const LAS float*)(lds + SL_YO + (li - 1) * 4096 + (4 * a + i) * 256 + lane * 4);
                }
                if (li == 3) {
#pragma unroll
                    for (int i = 0; i < 4; ++i) v[i] += *(const LAS float*)(lds + SL_YO + 3 * 4096 + (4 * a + i) * 256 + lane * 4);
                }
                u32x2 o; o.x = cvt_pk_bf16(v[0], v[1]); o.y = cvt_pk_bf16(v[2], v[3]); *(u32x2*)(yp + 8 * a) = o;
            }
        }
        LDS_BARRIER();
    }
#undef SSD_LOAD
}

__device__ __forceinline__ void attn_phase(const Ctx& F, ArgsP a, int l, int gi) {
    LAS unsigned char* lds = F.lds;
    const bf16_t* P = (const bf16_t*)(a->ws + WS_ARENA + AR_P);
    const bf16_t* XC = (const bf16_t*)(F.dout + DO_XC);
    bf16_t* YP = (bf16_t*)(F.dout + DO_YC); bf16_t* YB = (bf16_t*)(F.dout + DO_R);
    const bf16_t* KC = (const bf16_t*)(a->ws + WS_MISC + MI_KC); const bf16_t* VC = (const bf16_t*)(a->ws + WS_MISC + MI_VC);
    const float* biasT = (const float*)(a->ws + WS_MISC + MI_BIAS);
    unsigned* ctr = F.ctl + CW_WQ + 64 * (l * NG + gi);
    constexpr int NSSD = BG * 16 * 2, NNSA = BG * 2 * 32;
    for (int item = F.vcu; item < NSSD; item += F.G) {
        const int bl = item >> 5, hd = (item >> 1) & 15, ph = item & 1;
        for (int rr_ = 0; rr_ <= SSD_REP; ++rr_) ssd_unit(F, bl, hd, ph, P, XC, a->in[I_DTB][l * 16 + hd], -__expf(a->in[I_ALOG][l * 16 + hd]), a->in[I_DSKIP][l * 16 + hd], YP);
    }
    for (;;) {
        if (F.tid == 0) *(LAS int*)(lds + LDSX + LX_WQ) = (int)__hip_atomic_fetch_add(ctr, 1u, __ATOMIC_RELAXED, __HIP_MEMORY_SCOPE_AGENT);
        __syncthreads();
        const int idx = *(const LAS int*)(lds + LDSX + LX_WQ);
        __syncthreads();
        if (idx >= NNSA) break;
        const int qt = 31 - (idx >> 4), bg = idx & 15;
        for (int rr_ = 0; rr_ <= NSA_REP; ++rr_) nsa_unit(F, bg >> 1, bg & 1, qt, P, KC, VC, biasT, YB);
    }
}


constexpr int RL_HI = 0, RL_LO = 33024, RL_GB = 66048, RL_LG = 74240, RL_ROWSTRIDE = 2064;
__device__ __forceinline__ void ln1_route_phase(const Ctx& F, ArgsP a, int l) {
    LAS unsigned char* lds = F.lds; const int tid = F.tid, lane = F.lane, w = F.wave, fr = lane & 15, q = lane >> 4;
    LAS int* lcnt = (LAS int*)(lds + LDSX + LX_CNTL); LAS int* lbase = (LAS int*)(lds + LDSX + LX_BASE); LAS int* rows = (LAS int*)(lds + LDSX + LX_ROWS);
    for (int i = tid; i < 16384; i += 512) { const float x = a->in[I_RW][i]; const bf16_t hi = f2bf(x); const bf16_t lo = f2bf(x - bf1(hi)); const int d = i >> 4, e = i & 15;
        *(LAS bf16_t*)(lds + RL_HI + e * RL_ROWSTRIDE + d * 2) = hi; *(LAS bf16_t*)(lds + RL_LO + e * RL_ROWSTRIDE + d * 2) = lo; }
    { LAS float* GB = (LAS float*)(lds + RL_GB); for (int i = tid; i < 1024; i += 512) { GB[i] = a->in[I_LN1G][l * DM + i]; GB[1024 + i] = a->in[I_LN1B][l * DM + i]; } }
    bf16_t* H1 = (bf16_t*)(a->ws + WS_PRE1);
    float rb[16];
#pragma unroll
    for (int e = 0; e < 16; ++e) rb[e] = a->in[I_RB][e];
    unsigned* gcnt = F.ctl + CW_CNT + 64 * l;
    int* route = (int*)(a->ws + WS_MISC + MI_ROUTE);
    for (int rb0 = blockIdx.x * 128; rb0 < T_; rb0 += F.G * 128) {
        if (tid < 16) lcnt[tid] = 0;
        __syncthreads();
        {
            bf16_t* rowp = H1 + ((size_t)rb0 + w * 16 + fr) * DM + 8 * q;
            float s = 0.f, ss = 0.f;
#pragma unroll 8
            for (int kk = 0; kk < 32; ++kk) { float x[8]; unpack8(*(const u32x4*)(rowp + 32 * kk), x);
#pragma unroll
                for (int j = 0; j < 8; ++j) { s += x[j]; ss += x[j] * x[j]; } }
            s += __shfl_xor(s, 16); s += __shfl_xor(s, 32); ss += __shfl_xor(ss, 16); ss += __shfl_xor(ss, 32);
            const float mean = s * (1.f / DM), rstd = 1.f / sqrtf(fmaxf(ss * (1.f / DM) - mean * mean, 0.f) + LN_EPS);
            f32x4 acc = {0.f, 0.f, 0.f, 0.f};
            const LAS float* GB = (const LAS float*)(lds + RL_GB);
#pragma unroll 2
            for (int kk = 0; kk < 32; ++kk) {
                float x[8], lo[8]; unpack8(*(const u32x4*)(rowp + 32 * kk), x);
                const f32x4 g0 = *(const LAS f32x4*)(GB + 32 * kk + 8 * q), g1 = *(const LAS f32x4*)(GB + 32 * kk + 8 * q + 4);
                const f32x4 b0 = *(const LAS f32x4*)(GB + 1024 + 32 * kk + 8 * q), b1 = *(const LAS f32x4*)(GB + 1024 + 32 * kk + 8 * q + 4);
#pragma unroll
                for (int j = 0; j < 4; ++j) { x[j] = (x[j] - mean) * rstd * g0[j] + b0[j]; x[4 + j] = (x[4 + j] - mean) * rstd * g1[j] + b1[j]; }
                const u32x4 hp = pack8(x);
                *(u32x4*)(rowp + 32 * kk) = hp;
                { float hf[8]; unpack8(hp, hf);
#pragma unroll
                  for (int j = 0; j < 8; ++j) lo[j] = x[j] - hf[j]; }
                const bf16x8 ahi = __builtin_bit_cast(bf16x8, hp), alo = __builtin_bit_cast(bf16x8, pack8(lo));
                const bf16x8 bhi = *(const LAS bf16x8*)(lds + RL_HI + fr * RL_ROWSTRIDE + (32 * kk + 8 * q) * 2), blo = *(const LAS bf16x8*)(lds + RL_LO + fr * RL_ROWSTRIDE + (32 * kk + 8 * q) * 2);
                acc = mfma16(ahi, bhi, acc); acc = mfma16(ahi, blo, acc); acc = mfma16(alo, bhi, acc);
                asm volatile("" ::: "memory");
            }
            LAS float* LG = (LAS float*)(lds + RL_LG) + w * 256;
#pragma unroll
            for (int r = 0; r < 4; ++r) LG[(4 * q + r) * 16 + fr] = acc[r];
        }
        LDS_WAIT();
        if (lane < 16) {
            const LAS float* LG = (const LAS float*)(lds + RL_LG) + w * 256 + lane * 16;
            float lg[16];
#pragma unroll
            for (int e4 = 0; e4 < 4; ++e4) { const f32x4 t = *(const LAS f32x4*)(LG + 4 * e4); lg[4 * e4] = t[0]; lg[4 * e4 + 1] = t[1]; lg[4 * e4 + 2] = t[2]; lg[4 * e4 + 3] = t[3]; }
            float mx = lg[0];
#pragma unroll
            for (int e = 1; e < 16; ++e) mx = fmaxf(mx, lg[e]);
            float pr[16], ps = 0.f;
#pragma unroll
            for (int e = 0; e < 16; ++e) { pr[e] = __expf(lg[e] - mx); ps += pr[e]; }
            const float pinv = 1.f / ps;
            float sc[16];
#pragma unroll
            for (int e = 0; e < 16; ++e) { pr[e] *= pinv; sc[e] = pr[e] + rb[e]; }
            int grp = 0; float gbest = -1e30f;
#pragma unroll
            for (int qq = 0; qq < 4; ++qq) {
                const float s0 = sc[4 * qq], s1 = sc[4 * qq + 1], s2_ = sc[4 * qq + 2], s3 = sc[4 * qq + 3];
                const float tot = (s0 + s1) + (s2_ + s3), mn1 = fminf(fminf(s0, s1), fminf(s2_, s3));
                const float m2 = fminf(fminf(fminf(fmaxf(s0, s1), fmaxf(s0, s2_)), fminf(fmaxf(s0, s3), fmaxf(s1, s2_))), fminf(fmaxf(s1, s3), fmaxf(s2_, s3)));
                const float top2 = tot - mn1 - m2;
                if (top2 > gbest) { gbest = top2; grp = qq; }
            }
            float c0 = 0.f, c1 = 0.f, c2 = 0.f, c3 = 0.f, q0 = 0.f, q1 = 0.f, q2 = 0.f, q3 = 0.f;
#pragma unroll
            for (int qq = 0; qq < 4; ++qq) if (grp == qq) { c0 = sc[4 * qq]; c1 = sc[4 * qq + 1]; c2 = sc[4 * qq + 2]; c3 = sc[4 * qq + 3]; q0 = pr[4 * qq]; q1 = pr[4 * qq + 1]; q2 = pr[4 * qq + 2]; q3 = pr[4 * qq + 3]; }
            int i0 = 0; float b0 = c0; if (c1 > b0) { b0 = c1; i0 = 1; } if (c2 > b0) { b0 = c2; i0 = 2; } if (c3 > b0) { b0 = c3; i0 = 3; }
            int i1 = -1; float b1 = -1e30f;
            if (i0 != 0 && c0 > b1) { b1 = c0; i1 = 0; } if (i0 != 1 && c1 > b1) { b1 = c1; i1 = 1; } if (i0 != 2 && c2 > b1) { b1 = c2; i1 = 2; } if (i0 != 3 && c3 > b1) { b1 = c3; i1 = 3; }
            const float w0 = (i0 == 0) ? q0 : (i0 == 1) ? q1 : (i0 == 2) ? q2 : q3, w1 = (i1 == 0) ? q0 : (i1 == 1) ? q1 : (i1 == 2) ? q2 : q3;
            const float wn = 1.f / (w0 + w1);
            const int e0 = 4 * grp + i0, e1 = 4 * grp + i1, rl = w * 16 + lane;
            const int pos0 = atomicAdd((int*)(lds + LDSX + LX_CNTL) + e0, 1), pos1 = atomicAdd((int*)(lds + LDSX + LX_CNTL) + e1, 1);
            rows[rl * 8 + 0] = e0; rows[rl * 8 + 1] = e1; rows[rl * 8 + 2] = pos0; rows[rl * 8 + 3] = pos1; rows[rl * 8 + 4] = __float_as_int(w0 * wn); rows[rl * 8 + 5] = __float_as_int(w1 * wn);
        }
        __syncthreads();
        if (tid < 16) lbase[tid] = (int)__hip_atomic_fetch_add(gcnt + tid, (unsigned)lcnt[tid], __ATOMIC_RELAXED, __HIP_MEMORY_SCOPE_AGENT);
        __syncthreads();
        if (tid < 128) {
            const int e0 = rows[tid * 8], e1 = rows[tid * 8 + 1]; const int t = rb0 + tid;
            route[t] = e0 | (e1 << 8); route[T_ + t] = lbase[e0] + rows[tid * 8 + 2]; route[2 * T_ + t] = lbase[e1] + rows[tid * 8 + 3];
            route[3 * T_ + t] = rows[tid * 8 + 4]; route[4 * T_ + t] = rows[tid * 8 + 5];
        }
        __syncthreads();
    }
}

__device__ __forceinline__ int moe_tables(const Ctx& F, int l) {
    LAS int* off = (LAS int*)(F.lds + LDSX + LX_OFF); LAS int* tile_e = (LAS int*)(F.lds + LDSX + LX_TILE);
    __syncthreads();
    if (F.tid == 0) { int o = 0;
        for (int e = 0; e < 16; ++e) { off[e] = o; const int c = (int)__hip_atomic_load(F.ctl + CW_CNT + 64 * l + e, __ATOMIC_RELAXED, __HIP_MEMORY_SCOPE_AGENT); const int nt = (c + 255) >> 8;
            for (int k = 0; k < nt; ++k) tile_e[(o >> 8) + k] = e; o += nt << 8; }
        off[16] = o; }
    __syncthreads();
    return off[16] >> 8;
}
__device__ __forceinline__ void gather_phase(const Ctx& F, ArgsP a, int l) {
    const int nrt = moe_tables(F, l); (void)nrt;
    const LAS int* off = (const LAS int*)(F.lds + LDSX + LX_OFF);
    const bf16_t* H1 = (const bf16_t*)(a->ws + WS_PRE1); bf16_t* XS = (bf16_t*)(a->ws + WS_ARENA + AR_XS);
    const int* route = (const int*)(a->ws + WS_MISC + MI_ROUTE); int2* rinfo = (int2*)(a->ws + WS_MISC + MI_RINFO);
    u32x4 nx0 = *(const u32x4*)(H1 + (size_t)F.gw * DM + 8 * F.lane), nx1 = *(const u32x4*)(H1 + (size_t)F.gw * DM + 512 + 8 * F.lane);
    int nee = route[F.gw], np0 = route[T_ + F.gw], np1 = route[2 * T_ + F.gw];
    for (int t = F.gw; t < T_; t += F.NGW) {
        const int ee = nee, e0 = ee & 255, e1 = ee >> 8;
        const int r0 = off[e0] + np0, r1 = off[e1] + np1;
        const u32x4 v0 = nx0, v1 = nx1;
        if (t + F.NGW < T_) { const int tn = t + F.NGW; nx0 = *(const u32x4*)(H1 + (size_t)tn * DM + 8 * F.lane); nx1 = *(const u32x4*)(H1 + (size_t)tn * DM + 512 + 8 * F.lane);
            nee = route[tn]; np0 = route[T_ + tn]; np1 = route[2 * T_ + tn]; }
        *(u32x4*)(XS + (size_t)r0 * DM + 8 * F.lane) = v0; *(u32x4*)(XS + (size_t)r0 * DM + 512 + 8 * F.lane) = v1;
        *(u32x4*)(XS + (size_t)r1 * DM + 8 * F.lane) = v0; *(u32x4*)(XS + (size_t)r1 * DM + 512 + 8 * F.lane) = v1;
        if (F.lane == 0) { rinfo[r0] = make_int2(t, route[3 * T_ + t]); rinfo[r1] = make_int2(T_ + t, route[4 * T_ + t]); }
    }
    if (blockIdx.x == 0) {
        for (int e = 0; e < 16; ++e) { const int c = (int)__hip_atomic_load(F.ctl + CW_CNT + 64 * l + e, __ATOMIC_RELAXED, __HIP_MEMORY_SCOPE_AGENT);
            for (int r = off[e] + c + F.tid; r < off[e + 1]; r += 512) rinfo[r] = make_int2(-1, 0); }
    }
}

__device__ __forceinline__ void ln2_phase(const Ctx& F, ArgsP a, int l, bool last) {
    const bf16_t* H1 = (const bf16_t*)(a->ws + WS_PRE1); const bf16_t* YS = (const bf16_t*)(a->ws + WS_ARENA + AR_XS);
    bf16_t* H = (bf16_t*)(a->ws + WS_H); float* OUT = a->out;
    const float* g = a->in[I_LN2G] + l * DM; const float* b = a->in[I_LN2B] + l * DM; const int lane = F.lane;
    float gg[16], bb[16];
#pragma unroll
    for (int i = 0; i < 8; ++i) { gg[i] = g[8 * lane + i]; gg[8 + i] = g[512 + 8 * lane + i]; bb[i] = b[8 * lane + i]; bb[8 + i] = b[512 + 8 * lane + i]; }
    u32x4 nx[6];
#define LN2_LOAD(t_) do { _Pragma("unroll") for (int hf = 0; hf < 2; ++hf) { nx[3 * hf] = *(const u32x4*)(H1 + (size_t)(t_) * DM + 512 * hf + 8 * lane); \
        nx[3 * hf + 1] = *(const u32x4*)(YS + (size_t)(t_) * DM + 512 * hf + 8 * lane); nx[3 * hf + 2] = *(const u32x4*)(YS + (size_t)(T_ + (t_)) * DM + 512 * hf + 8 * lane); } } while (0)
    LN2_LOAD(F.gw);
    for (int t = F.gw; t < T_; t += F.NGW) {
        float v[16];
        u32x4 cur[6];
#pragma unroll
        for (int i = 0; i < 6; ++i) cur[i] = nx[i];
        if (t + F.NGW < T_) LN2_LOAD(t + F.NGW);
#pragma unroll
        for (int hf = 0; hf < 2; ++hf) { float x[8], y0[8], y1[8];
            unpack8(cur[3 * hf], x);
            unpack8(cur[3 * hf + 1], y0);
            unpack8(cur[3 * hf + 2], y1);
#pragma unroll
            for (int i = 0; i < 8; ++i) v[8 * hf + i] = DN_ALPHA * x[i] + (y0[i] + y1[i]); }
        float s = 0.f;
#pragma unroll
        for (int i = 0; i < 16; ++i) s += v[i];
        const float mean = wave_sum(s) * (1.f / DM); float s2 = 0.f;
#pragma unroll
        for (int i = 0; i < 16; ++i) { v[i] -= mean; s2 += v[i] * v[i]; }
        const float rstd = 1.f / sqrtf(wave_sum(s2) * (1.f / DM) + LN_EPS);
#pragma unroll
        for (int i = 0; i < 16; ++i) v[i] = v[i] * rstd * gg[i] + bb[i];
        if (last) {
#pragma unroll
            for (int hf = 0; hf < 2; ++hf) { float* o = OUT + (size_t)t * DM + 512 * hf + 8 * lane;
                *(f32x4*)o = (f32x4){v[8 * hf], v[8 * hf + 1], v[8 * hf + 2], v[8 * hf + 3]}; *(f32x4*)(o + 4) = (f32x4){v[8 * hf + 4], v[8 * hf + 5], v[8 * hf + 6], v[8 * hf + 7]}; }
        } else {
#pragma unroll
            for (int hf = 0; hf < 2; ++hf) { float tt[8];
#pragma unroll
                for (int i = 0; i < 8; ++i) tt[i] = v[8 * hf + i];
                *(u32x4*)(H + (size_t)t * DM + 512 * hf + 8 * lane) = pack8(tt); }
        }
    }
}

#ifndef REP_MASK
#define REP_MASK 0
#endif
#ifndef PH_MASK
#define PH_MASK 0xfff
#endif
constexpr int NSTEPS = 1 + DEPTH * (NG * 6 + 5);
__global__ void __launch_bounds__(512, 2) fwd_kernel(Args a_unused) {
    const ArgsP a = (ArgsP)__builtin_amdgcn_kernarg_segment_ptr();
    extern __shared__ __attribute__((aligned(16))) unsigned char smem[];
    const int wave0_ = __builtin_amdgcn_readfirstlane((int)threadIdx.x >> 6);
    Ctx F;
#define MKCTX do { int t_; asm volatile("v_mbcnt_lo_u32_b32 %0, -1, 0\n\tv_mbcnt_hi_u32_b32 %0, -1, %0" : "=v"(t_)); t_ += wave0_ * 64; F.lds = (LAS unsigned char*)smem; F.tid = t_; F.lane = t_ & 63; F.wave = wave0_; \
        F.G = gridDim.x; { const int bx = blockIdx.x; F.vcu = (F.G % 8 == 0) ? (bx % 8) * (F.G / 8) + bx / 8 : bx; } \
        F.gw = blockIdx.x * 8 + F.wave; F.NGW = F.G * 8; F.ws = a->ws; F.dout = (unsigned char*)a->out; F.ctl = (unsigned*)(a->ws + WS_CTL); } while (0)
    MKCTX;
    for (int u = F.tid; u < (LDS_TOTAL - LDSX) / 4; u += 512) ((LAS unsigned*)(F.lds + LDSX))[u] = 0u;
    __syncthreads();
    const bool multi = (a->hi - a->lo) > 1;
    XcdBarrier bar; bar.bar = F.ctl + CW_BAR; bar.x = 0; bar.st = (volatile LAS unsigned*)(F.lds + LDSX + LX_BAR);
    if (multi) bar = xcd_barrier_post(F.ctl + CW_BAR, (volatile LAS unsigned*)(F.lds + LDSX + LX_BAR), F.tid);
    int step = 0;
#define RUN_STEP (step >= a->lo && step < a->hi)
#ifndef BAR_REP
#define BAR_REP 0
#endif
#define END_STEP do { if (RUN_STEP && step + 1 < a->hi) { xcd_barrier(bar, F.tid); if (BAR_REP) xcd_barrier(bar, F.tid); } ++step; } while (0)

    if (RUN_STEP && ((PH_MASK >> 0) & 1)) for (int rep_ = 0; rep_ <= ((REP_MASK >> 0) & 1); ++rep_) { MKCTX; p0_prologue(F, a); }
    END_STEP;

    {
        unsigned char* wl = a->ws + WS_W + (size_t)0 * W_LAYER;
        bf16_t* Hb = (bf16_t*)(a->ws + WS_H);
        bf16_t* P = (bf16_t*)(a->ws + WS_ARENA + AR_P);
        {
            const bf16_t* Hg = Hb + (size_t)0 * TG * DM;
            if (RUN_STEP && ((PH_MASK >> 1) & 1)) for (int rep_ = 0; rep_ <= ((REP_MASK >> 1) & 1); ++rep_) { MKCTX;
                pg8::Gemm g{Hg, (const bf16_t*)(wl + WO_IN), DM, DM, DM}; pg8::StaticOrder S; S.init(TG, LDP, DM, DM, F.G, (int)blockIdx.x);
                pg8::Epi<pg8::EK_PROJ> E{P, LDP, nullptr, 0, nullptr, nullptr, nullptr};
                pg8::gemm_phase(F.lds, F.tid, g, S, E);
            }
            END_STEP;
            if (RUN_STEP && ((PH_MASK >> 2) & 1)) for (int rep_ = 0; rep_ <= ((REP_MASK >> 2) & 1); ++rep_) { MKCTX;
                for (int cu = blockIdx.x; cu < BG * 32; cu += F.G)
                    compress_unit(F, cu, P, (const bf16_t*)(wl + WO_W1), (const bf16_t*)(wl + WO_W2), (const float*)(a->ws + WS_MISC + MI_B1) + 0 * 256,
                                  (bf16_t*)(a->ws + WS_MISC + MI_KC), (bf16_t*)(a->ws + WS_MISC + MI_VC));
                conv_phase(F, P, (bf16_t*)(F.dout + DO_XC), a->in[I_CONVW] + (size_t)0 * 4 * 2048, a->in[I_CONVB] + (size_t)0 * 2048);
            }
            END_STEP;
            if (RUN_STEP && ((PH_MASK >> 3) & 1)) for (int rep_ = 0; rep_ <= ((REP_MASK >> 3) & 1); ++rep_) { MKCTX; attn_phase(F, a, 0, 0 + 4 * rep_); }
            END_STEP;
            if (RUN_STEP && ((PH_MASK >> 4) & 1)) for (int rep_ = 0; rep_ <= ((REP_MASK >> 4) & 1); ++rep_) { MKCTX; fin_phase(F, P, (bf16_t*)(F.dout + DO_R), (bf16_t*)(F.dout + DO_YC), a->in[I_SNG] + (size_t)0 * DM); }
            END_STEP;
            if (RUN_STEP && ((PH_MASK >> 5) & 1)) for (int rep_ = 0; rep_ <= ((REP_MASK >> 5) & 1); ++rep_) { MKCTX;
                bf16_t* GT = (bf16_t*)(a->ws + WS_ARENA + AR_GATES); bf16_t* MX = (bf16_t*)(a->ws + WS_ARENA + AR_MIXIN); float* TMP = (float*)(F.dout + DO_TMP);
                pg8::Gemm g{nullptr, nullptr, DM, DM, DM};
                pg8::S5Order S; S.so.init(TG, DM, DM, DM, F.G, (int)blockIdx.x);
                S.aH = (long)(size_t)Hg; S.aRY = (long)(size_t)(F.dout + DO_R); S.aYC = (long)(size_t)(F.dout + DO_YC);
                S.bG = (long)(size_t)(wl + WO_GATE); S.bCN = (long)(size_t)(wl + WO_C); S.bS = (long)(size_t)(wl + WO_SSD);
                pg8::Epi<pg8::EK_S5> E{GT, 3072, nullptr, 0, TMP, nullptr, MX};
                pg8::gemm_phase(F.lds, F.tid, g, S, E);
            }
            END_STEP;
            if (RUN_STEP && ((PH_MASK >> 6) & 1)) for (int rep_ = 0; rep_ <= ((REP_MASK >> 6) & 1); ++rep_) { MKCTX;
                pg8::Gemm g{(const bf16_t*)(a->ws + WS_ARENA + AR_MIXIN), (const bf16_t*)(wl + WO_OUT), DM, DM, DM}; pg8::StaticOrder S; S.init(TG, DM, DM, DM, F.G, (int)blockIdx.x);
                pg8::Epi<pg8::EK_WOUT> E{(bf16_t*)(a->ws + WS_PRE1) + (size_t)0 * TG * DM, DM, Hg, DM, nullptr, nullptr, nullptr};
                pg8::gemm_phase(F.lds, F.tid, g, S, E);
            }
            END_STEP;
        }
        {
            const bf16_t* Hg = Hb + (size_t)1 * TG * DM;
            if (RUN_STEP && ((PH_MASK >> 1) & 1)) for (int rep_ = 0; rep_ <= ((REP_MASK >> 1) & 1); ++rep_) { MKCTX;
                pg8::Gemm g{Hg, (const bf16_t*)(wl + WO_IN), DM, DM, DM}; pg8::StaticOrder S; S.init(TG, LDP, DM, DM, F.G, (int)blockIdx.x);
                pg8::Epi<pg8::EK_PROJ> E{P, LDP, nullptr, 0, nullptr, nullptr, nullptr};
                pg8::gemm_phase(F.lds, F.tid, g, S, E);
            }
            END_STEP;
            if (RUN_STEP && ((PH_MASK >> 2) & 1)) for (int rep_ = 0; rep_ <= ((REP_MASK >> 2) & 1); ++rep_) { MKCTX;
                for (int cu = blockIdx.x; cu < BG * 32; cu += F.G)
                    compress_unit(F, cu, P, (const bf16_t*)(wl + WO_W1), (const bf16_t*)(wl + WO_W2), (const float*)(a->ws + WS_MISC + MI_B1) + 0 * 256,
                                  (bf16_t*)(a->ws + WS_MISC + MI_KC), (bf16_t*)(a->ws + WS_MISC + MI_VC));
                conv_phase(F, P, (bf16_t*)(F.dout + DO_XC), a->in[I_CONVW] + (size_t)0 * 4 * 2048, a->in[I_CONVB] + (size_t)0 * 2048);
            }
            END_STEP;
            if (RUN_STEP && ((PH_MASK >> 3) & 1)) for (int rep_ = 0; rep_ <= ((REP_MASK >> 3) & 1); ++rep_) { MKCTX; attn_phase(F, a, 0, 1 + 4 * rep_); }
            END_STEP;
            if (RUN_STEP && ((PH_MASK >> 4) & 1)) for (int rep_ = 0; rep_ <= ((REP_MASK >> 4) & 1); ++rep_) { MKCTX; fin_phase(F, P, (bf16_t*)(F.dout + DO_R), (bf16_t*)(F.dout + DO_YC), a->in[I_SNG] + (size_t)0 * DM); }
            END_STEP;
            if (RUN_STEP && ((PH_MASK >> 5) & 1)) for (int rep_ = 0; rep_ <= ((REP_MASK >> 5) & 1); ++rep_) { MKCTX;
                bf16_t* GT = (bf16_t*)(a->ws + WS_ARENA + AR_GATES); bf16_t* MX = (bf16_t*)(a->ws + WS_ARENA + AR_MIXIN); float* TMP = (float*)(F.dout + DO_TMP);
                pg8::Gemm g{nullptr, nullptr, DM, DM, DM};
                pg8::S5Order S; S.so.init(TG, DM, DM, DM, F.G, (int)blockIdx.x);
                S.aH = (long)(size_t)Hg; S.aRY = (long)(size_t)(F.dout + DO_R); S.aYC = (long)(size_t)(F.dout + DO_YC);
                S.bG = (long)(size_t)(wl + WO_GATE); S.bCN = (long)(size_t)(wl + WO_C); S.bS = (long)(size_t)(wl + WO_SSD);
                pg8::Epi<pg8::EK_S5> E{GT, 3072, nullptr, 0, TMP, nullptr, MX};
                pg8::gemm_phase(F.lds, F.tid, g, S, E);
            }
            END_STEP;
            if (RUN_STEP && ((PH_MASK >> 6) & 1)) for (int rep_ = 0; rep_ <= ((REP_MASK >> 6) & 1); ++rep_) { MKCTX;
                pg8::Gemm g{(const bf16_t*)(a->ws + WS_ARENA + AR_MIXIN), (const bf16_t*)(wl + WO_OUT), DM, DM, DM}; pg8::StaticOrder S; S.init(TG, DM, DM, DM, F.G, (int)blockIdx.x);
                pg8::Epi<pg8::EK_WOUT> E{(bf16_t*)(a->ws + WS_PRE1) + (size_t)1 * TG * DM, DM, Hg, DM, nullptr, nullptr, nullptr};
                pg8::gemm_phase(F.lds, F.tid, g, S, E);
            }
            END_STEP;
        }
        if (RUN_STEP && ((PH_MASK >> 7) & 1)) for (int rep_ = 0; rep_ <= ((REP_MASK >> 7) & 1); ++rep_) { MKCTX; ln1_route_phase(F, a, 0); }
        END_STEP;
        if (RUN_STEP && ((PH_MASK >> 8) & 1)) for (int rep_ = 0; rep_ <= ((REP_MASK >> 8) & 1); ++rep_) { MKCTX; gather_phase(F, a, 0); }
        END_STEP;
        if (RUN_STEP && ((PH_MASK >> 9) & 1)) for (int rep_ = 0; rep_ <= ((REP_MASK >> 9) & 1); ++rep_) { MKCTX;
            const int nrt = moe_tables(F, 0);
            pg8::Gemm g{(const bf16_t*)(a->ws + WS_ARENA + AR_XS), (const bf16_t*)(wl + WO_UP), DM, DM, DM};
            pg8::MoeOrder S{(const LAS int*)(F.lds + LDSX + LX_TILE), nrt, F.G, F.vcu, 16, (long)256 * DM * 2, (long)256 * DM * 2, (long)1024 * DM * 2};
            pg8::Epi<pg8::EK_GLU> E{(bf16_t*)(a->ws + WS_ARENA + AR_HID), 512, nullptr, 0, nullptr, nullptr, nullptr};
            pg8::gemm_phase(F.lds, F.tid, g, S, E);
        }
        END_STEP;
        if (RUN_STEP && ((PH_MASK >> 10) & 1)) for (int rep_ = 0; rep_ <= ((REP_MASK >> 10) & 1); ++rep_) { MKCTX;
            const int nrt = moe_tables(F, 0);
            pg8::Gemm g{(const bf16_t*)(a->ws + WS_ARENA + AR_HID), (const bf16_t*)(wl + WO_DN), 512, 512, 512};
            pg8::MoeOrder S{(const LAS int*)(F.lds + LDSX + LX_TILE), nrt, F.G, F.vcu, 8, (long)256 * 512 * 2, (long)256 * 512 * 2, (long)1024 * 512 * 2};
            pg8::Epi<pg8::EK_DOWN> E{(bf16_t*)(a->ws + WS_ARENA + AR_XS), DM, nullptr, 0, nullptr, (const int2*)(a->ws + WS_MISC + MI_RINFO), nullptr};
            pg8::gemm_phase(F.lds, F.tid, g, S, E);
        }
        END_STEP;
        if (RUN_STEP && ((PH_MASK >> 11) & 1)) for (int rep_ = 0; rep_ <= ((REP_MASK >> 11) & 1); ++rep_) { MKCTX; ln2_phase(F, a, 0, 0 == DEPTH - 1); }
        END_STEP;
    }
    {
        unsigned char* wl = a->ws + WS_W + (size_t)1 * W_LAYER;
        bf16_t* Hb = (bf16_t*)(a->ws + WS_H);
        bf16_t* P = (bf16_t*)(a->ws + WS_ARENA + AR_P);
        {
            const bf16_t* Hg = Hb + (size_t)0 * TG * DM;
            if (RUN_STEP && ((PH_MASK >> 1) & 1)) for (int rep_ = 0; rep_ <= ((REP_MASK >> 1) & 1); ++rep_) { MKCTX;
                pg8::Gemm g{Hg, (const bf16_t*)(wl + WO_IN), DM, DM, DM}; pg8::StaticOrder S; S.init(TG, LDP, DM, DM, F.G, (int)blockIdx.x);
                pg8::Epi<pg8::EK_PROJ> E{P, LDP, nullptr, 0, nullptr, nullptr, nullptr};
                pg8::gemm_phase(F.lds, F.tid, g, S, E);
            }
            END_STEP;
            if (RUN_STEP && ((PH_MASK >> 2) & 1)) for (int rep_ = 0; rep_ <= ((REP_MASK >> 2) & 1); ++rep_) { MKCTX;
                for (int cu = blockIdx.x; cu < BG * 32; cu += F.G)
                    compress_unit(F, cu, P, (const bf16_t*)(wl + WO_W1), (const bf16_t*)(wl + WO_W2), (const float*)(a->ws + WS_MISC + MI_B1) + 1 * 256,
                                  (bf16_t*)(a->ws + WS_MISC + MI_KC), (bf16_t*)(a->ws + WS_MISC + MI_VC));
                conv_phase(F, P, (bf16_t*)(F.dout + DO_XC), a->in[I_CONVW] + (size_t)1 * 4 * 2048, a->in[I_CONVB] + (size_t)1 * 2048);
            }
            END_STEP;
            if (RUN_STEP && ((PH_MASK >> 3) & 1)) for (int rep_ = 0; rep_ <= ((REP_MASK >> 3) & 1); ++rep_) { MKCTX; attn_phase(F, a, 1, 0 + 4 * rep_); }
            END_STEP;
            if (RUN_STEP && ((PH_MASK >> 4) & 1)) for (int rep_ = 0; rep_ <= ((REP_MASK >> 4) & 1); ++rep_) { MKCTX; fin_phase(F, P, (bf16_t*)(F.dout + DO_R), (bf16_t*)(F.dout + DO_YC), a->in[I_SNG] + (size_t)1 * DM); }
            END_STEP;
            if (RUN_STEP && ((PH_MASK >> 5) & 1)) for (int rep_ = 0; rep_ <= ((REP_MASK >> 5) & 1); ++rep_) { MKCTX;
                bf16_t* GT = (bf16_t*)(a->ws + WS_ARENA + AR_GATES); bf16_t* MX = (bf16_t*)(a->ws + WS_ARENA + AR_MIXIN); float* TMP = (float*)(F.dout + DO_TMP);
                pg8::Gemm g{nullptr, nullptr, DM, DM, DM};
                pg8::S5Order S; S.so.init(TG, DM, DM, DM, F.G, (int)blockIdx.x);
                S.aH = (long)(size_t)Hg; S.aRY = (long)(size_t)(F.dout + DO_R); S.aYC = (long)(size_t)(F.dout + DO_YC);
                S.bG = (long)(size_t)(wl + WO_GATE); S.bCN = (long)(size_t)(wl + WO_C); S.bS = (long)(size_t)(wl + WO_SSD);
                pg8::Epi<pg8::EK_S5> E{GT, 3072, nullptr, 0, TMP, nullptr, MX};
                pg8::gemm_phase(F.lds, F.tid, g, S, E);
            }
            END_STEP;
            if (RUN_STEP && ((PH_MASK >> 6) & 1)) for (int rep_ = 0; rep_ <= ((REP_MASK >> 6) & 1); ++rep_) { MKCTX;
                pg8::Gemm g{(const bf16_t*)(a->ws + WS_ARENA + AR_MIXIN), (const bf16_t*)(wl + WO_OUT), DM, DM, DM}; pg8::StaticOrder S; S.init(TG, DM, DM, DM, F.G, (int)blockIdx.x);
                pg8::Epi<pg8::EK_WOUT> E{(bf16_t*)(a->ws + WS_PRE1) + (size_t)0 * TG * DM, DM, Hg, DM, nullptr, nullptr, nullptr};
                pg8::gemm_phase(F.lds, F.tid, g, S, E);
            }
            END_STEP;
        }
        {
            const bf16_t* Hg = Hb + (size_t)1 * TG * DM;
            if (RUN_STEP && ((PH_MASK >> 1) & 1)) for (int rep_ = 0; rep_ <= ((REP_MASK >> 1) & 1); ++rep_) { MKCTX;
                pg8::Gemm g{Hg, (const bf16_t*)(wl + WO_IN), DM, DM, DM}; pg8::StaticOrder S; S.init(TG, LDP, DM, DM, F.G, (int)blockIdx.x);
                pg8::Epi<pg8::EK_PROJ> E{P, LDP, nullptr, 0, nullptr, nullptr, nullptr};
                pg8::gemm_phase(F.lds, F.tid, g, S, E);
            }
            END_STEP;
            if (RUN_STEP && ((PH_MASK >> 2) & 1)) for (int rep_ = 0; rep_ <= ((REP_MASK >> 2) & 1); ++rep_) { MKCTX;
                for (int cu = blockIdx.x; cu < BG * 32; cu += F.G)
                    compress_unit(F, cu, P, (const bf16_t*)(wl + WO_W1), (const bf16_t*)(wl + WO_W2), (const float*)(a->ws + WS_MISC + MI_B1) + 1 * 256,
                                  (bf16_t*)(a->ws + WS_MISC + MI_KC), (bf16_t*)(a->ws + WS_MISC + MI_VC));
                conv_phase(F, P, (bf16_t*)(F.dout + DO_XC), a->in[I_CONVW] + (size_t)1 * 4 * 2048, a->in[I_CONVB] + (size_t)1 * 2048);
            }
            END_STEP;
            if (RUN_STEP && ((PH_MASK >> 3) & 1)) for (int rep_ = 0; rep_ <= ((REP_MASK >> 3) & 1); ++rep_) { MKCTX; attn_phase(F, a, 1, 1 + 4 * rep_); }
            END_STEP;
            if (RUN_STEP && ((PH_MASK >> 4) & 1)) for (int rep_ = 0; rep_ <= ((REP_MASK >> 4) & 1); ++rep_) { MKCTX; fin_phase(F, P, (bf16_t*)(F.dout + DO_R), (bf16_t*)(F.dout + DO_YC), a->in[I_SNG] + (size_t)1 * DM); }
            END_STEP;
            if (RUN_STEP && ((PH_MASK >> 5) & 1)) for (int rep_ = 0; rep_ <= ((REP_MASK >> 5) & 1); ++rep_) { MKCTX;
                bf16_t* GT = (bf16_t*)(a->ws + WS_ARENA + AR_GATES); bf16_t* MX = (bf16_t*)(a->ws + WS_ARENA + AR_MIXIN); float* TMP = (float*)(F.dout + DO_TMP);
                pg8::Gemm g{nullptr, nullptr, DM, DM, DM};
                pg8::S5Order S; S.so.init(TG, DM, DM, DM, F.G, (int)blockIdx.x);
                S.aH = (long)(size_t)Hg; S.aRY = (long)(size_t)(F.dout + DO_R); S.aYC = (long)(size_t)(F.dout + DO_YC);
                S.bG = (long)(size_t)(wl + WO_GATE); S.bCN = (long)(size_t)(wl + WO_C); S.bS = (long)(size_t)(wl + WO_SSD);
                pg8::Epi<pg8::EK_S5> E{GT, 3072, nullptr, 0, TMP, nullptr, MX};
                pg8::gemm_phase(F.lds, F.tid, g, S, E);
            }
            END_STEP;
            if (RUN_STEP && ((PH_MASK >> 6) & 1)) for (int rep_ = 0; rep_ <= ((REP_MASK >> 6) & 1); ++rep_) { MKCTX;
                pg8::Gemm g{(const bf16_t*)(a->ws + WS_ARENA + AR_MIXIN), (const bf16_t*)(wl + WO_OUT), DM, DM, DM}; pg8::StaticOrder S; S.init(TG, DM, DM, DM, F.G, (int)blockIdx.x);
                pg8::Epi<pg8::EK_WOUT> E{(bf16_t*)(a->ws + WS_PRE1) + (size_t)1 * TG * DM, DM, Hg, DM, nullptr, nullptr, nullptr};
                pg8::gemm_phase(F.lds, F.tid, g, S, E);
            }
            END_STEP;
        }
        if (RUN_STEP && ((PH_MASK >> 7) & 1)) for (int rep_ = 0; rep_ <= ((REP_MASK >> 7) & 1); ++rep_) { MKCTX; ln1_route_phase(F, a, 1); }
        END_STEP;
        if (RUN_STEP && ((PH_MASK >> 8) & 1)) for (int rep_ = 0; rep_ <= ((REP_MASK >> 8) & 1); ++rep_) { MKCTX; gather_phase(F, a, 1); }
        END_STEP;
        if (RUN_STEP && ((PH_MASK >> 9) & 1)) for (int rep_ = 0; rep_ <= ((REP_MASK >> 9) & 1); ++rep_) { MKCTX;
            const int nrt = moe_tables(F, 1);
            pg8::Gemm g{(const bf16_t*)(a->ws + WS_ARENA + AR_XS), (const bf16_t*)(wl + WO_UP), DM, DM, DM};
            pg8::MoeOrder S{(const LAS int*)(F.lds + LDSX + LX_TILE), nrt, F.G, F.vcu, 16, (long)256 * DM * 2, (long)256 * DM * 2, (long)1024 * DM * 2};
            pg8::Epi<pg8::EK_GLU> E{(bf16_t*)(a->ws + WS_ARENA + AR_HID), 512, nullptr, 0, nullptr, nullptr, nullptr};
            pg8::gemm_phase(F.lds, F.tid, g, S, E);
        }
        END_STEP;
        if (RUN_STEP && ((PH_MASK >> 10) & 1)) for (int rep_ = 0; rep_ <= ((REP_MASK >> 10) & 1); ++rep_) { MKCTX;
            const int nrt = moe_tables(F, 1);
            pg8::Gemm g{(const bf16_t*)(a->ws + WS_ARENA + AR_HID), (const bf16_t*)(wl + WO_DN), 512, 512, 512};
            pg8::MoeOrder S{(const LAS int*)(F.lds + LDSX + LX_TILE), nrt, F.G, F.vcu, 8, (long)256 * 512 * 2, (long)256 * 512 * 2, (long)1024 * 512 * 2};
            pg8::Epi<pg8::EK_DOWN> E{(bf16_t*)(a->ws + WS_ARENA + AR_XS), DM, nullptr, 0, nullptr, (const int2*)(a->ws + WS_MISC + MI_RINFO), nullptr};
            pg8::gemm_phase(F.lds, F.tid, g, S, E);
        }
        END_STEP;
        if (RUN_STEP && ((PH_MASK >> 11) & 1)) for (int rep_ = 0; rep_ <= ((REP_MASK >> 11) & 1); ++rep_) { MKCTX; ln2_phase(F, a, 1, 1 == DEPTH - 1); }
        END_STEP;
    }
#undef RUN_STEP
#undef END_STEP
}

__global__ void dump_bf16(const bf16_t* src, float* dst, size_t n) { for (size_t i = (size_t)blockIdx.x * blockDim.x + threadIdx.x; i < n; i += (size_t)gridDim.x * blockDim.x) dst[i] = bf1(src[i]); }
#ifndef N_LAUNCH_MODE
#define N_LAUNCH_MODE 0
#endif
extern "C" void kernel_launch(void* const* d_in, const int* in_sizes, int n_in, void* d_out, int out_size, void* d_ws, size_t ws_size, hipStream_t stream) {
    static int grid = 0;
    if (grid == 0) {
        if (n_in != 32 || out_size != T_ * DM || ws_size < WS_END) { fprintf(stderr, "kernel_launch: unexpected problem (n_in %d out %d ws %zu)\n", n_in, out_size, ws_size); grid = -1; return; }
        int dev = 0, cus = 0, per_cu = 0;
        if (hipGetDevice(&dev) != hipSuccess || hipDeviceGetAttribute(&cus, hipDeviceAttributeMultiprocessorCount, dev) != hipSuccess) { grid = -1; return; }
        if (hipFuncSetAttribute((const void*)fwd_kernel, hipFuncAttributeMaxDynamicSharedMemorySize, LDS_TOTAL) != hipSuccess) { fprintf(stderr, "kernel_launch: hipFuncSetAttribute failed\n"); grid = -1; return; }
        if (hipOccupancyMaxActiveBlocksPerMultiprocessor(&per_cu, (const void*)fwd_kernel, 512, LDS_TOTAL) != hipSuccess || per_cu < 1)
            fprintf(stderr, "kernel_launch: occupancy query reports %d workgroups per CU\n", per_cu);
        (void)hipGetLastError();
        grid = cus;
    }
    if (grid < 0) return;
    (void)hipMemsetAsync((char*)d_ws + WS_CTL, 0, CTL_ZERO_BYTES, stream);
    Args a{};
    for (int i = 0; i < 32; ++i) a.in[i] = (const float*)d_in[i];
    a.out = (float*)d_out; a.ws = (unsigned char*)d_ws;
#if N_LAUNCH_MODE == 1
    a.lo = 0; a.hi = NSTEPS;
    hipLaunchKernelGGL(fwd_kernel, dim3(grid), dim3(512), LDS_TOTAL, stream, a);
#else
#ifdef DBG_STOP
    for (int s = 0; s <= DBG_STOP; ++s) { a.lo = s; a.hi = s + 1; hipLaunchKernelGGL(fwd_kernel, dim3(grid), dim3(512), LDS_TOTAL, stream, a); }
    hipLaunchKernelGGL(dump_bf16, dim3(1024), dim3(256), 0, stream, (const bf16_t*)((char*)d_ws + DBG_SRC), (float*)d_out, (size_t)T_ * DM);
#else
    for (int s = 0; s < NSTEPS; ++s) { a.lo = s; a.hi = s + 1; hipLaunchKernelGGL(fwd_kernel, dim3(grid), dim3(512), LDS_TOTAL, stream, a); }
#endif
#endif
}
```

```cpp
#define N_LAUNCH_MODE 1
#include <hip/hip_runtime.h>
#include <cstdio>
#include <cstdint>

#define LAS __attribute__((address_space(3)))
#define GAS __attribute__((address_space(1)))
typedef unsigned short bf16_t;
typedef short bf16x8 __attribute__((ext_vector_type(8)));
typedef short s16x4 __attribute__((ext_vector_type(4)));
typedef float f32x2 __attribute__((ext_vector_type(2)));
typedef float f32x4 __attribute__((ext_vector_type(4)));
typedef float f32x16 __attribute__((ext_vector_type(16)));
typedef unsigned u32x2 __attribute__((ext_vector_type(2)));
typedef unsigned u32x4 __attribute__((ext_vector_type(4)));

constexpr int T_ = 32768, SEQ = 2048, DM = 1024, NBATCH = 16, DEPTH = 2;
constexpr int NG = 2, BG = NBATCH / NG, TG = T_ / NG;
constexpr int LDP = 5120;
constexpr int C_POOL = 0, C_Q = 512, C_KV = 1024, C_Z = 1792, C_XBC = 2816, C_NG = 4864, C_DT = 4888;
constexpr int D_IN = 7976;
constexpr float LN_EPS = 1e-5f, DN_ALPHA = 1.41421356237f, LOG2E = 1.4426950408889634f;
constexpr float QSCALE = 0.125f * LOG2E;
constexpr float NEGBIG = -1e30f;
constexpr int MOE_ROWS = 69632;

constexpr size_t MiB = 1ull << 20;
constexpr size_t WS_CTL = 0, CTL_ZERO_BYTES = 65536;
constexpr size_t WS_MISC = 1 * MiB;
constexpr size_t WS_W = 2 * MiB, W_LAYER = 52 * MiB;
constexpr size_t WO_IN = 0, WO_GATE = 5 * MiB, WO_C = 11 * MiB, WO_NSA = 12 * MiB, WO_SSD = 13 * MiB, WO_OUT = 15 * MiB, WO_W1 = 17 * MiB, WO_W2 = 18 * MiB, WO_UP = 19 * MiB, WO_DN = 35 * MiB;
constexpr size_t WS_H = 106 * MiB, WS_PRE1 = 170 * MiB, WS_H8 = 234 * MiB, WS_H18 = 266 * MiB, WS_ARENA = 298 * MiB;
constexpr float WSCALE = 640.f, ASCALE = 16.f;
constexpr size_t AR_P = 0, AR_GATES = 0, AR_MIXIN = 96 * MiB;
constexpr size_t AR_XS = 0, AR_RTOK = 128 * MiB, AR_RINFO = 132 * MiB, AR_HID = 140 * MiB;
constexpr size_t WS_END = 506 * MiB;
constexpr int ECAP = 65536;
constexpr size_t DO_XC = 0, DO_TMP = 0, DO_YC = 64 * MiB, DO_R = 96 * MiB, DO_YB = 112 * MiB;
constexpr size_t MI_BIAS = 0, MI_B1 = 4096, MI_KC = 65536, MI_VC = MI_KC + 262144, MI_ROUTE = 1 * MiB, MI_RINFO = 2 * MiB;
constexpr int CW_BAR = 4096, CW_WQ = 8192, CW_CNT = 12288;
constexpr int LDS_TOTAL = 147456, LDSX = 131072;
constexpr int LX_BAR = 0, LX_WQ = 16, LX_OFF = 64, LX_ECNT = 160, LX_TILE = 256, LX_CNTL = 1536, LX_BASE = 1600, LX_ROWS = 2048, LX_GIDX = 6144;

__device__ __forceinline__ float bflo(unsigned u) { return __uint_as_float(u << 16); }
__device__ __forceinline__ float bfhi(unsigned u) { return __uint_as_float(u & 0xffff0000u); }
__device__ __forceinline__ float bf1(bf16_t b) { return __uint_as_float(((unsigned)b) << 16); }
typedef __bf16 bf16x2_t __attribute__((ext_vector_type(2)));
__device__ __forceinline__ unsigned cvt_pk_bf16(float lo, float hi) { const f32x2 v = {lo, hi}; const bf16x2_t b = __builtin_convertvector(v, bf16x2_t); return __builtin_bit_cast(unsigned, b); }
__device__ __forceinline__ bf16_t f2bf(float f) { return (bf16_t)(cvt_pk_bf16(f, 0.f) & 0xffffu); }
__device__ __forceinline__ float fexp2(float x) { return __builtin_amdgcn_exp2f(x); }
__device__ __forceinline__ float frcp(float x) { return __builtin_amdgcn_rcpf(x); }
__device__ __forceinline__ float sigmoidf_(float x) { return frcp(1.f + fexp2(-x * LOG2E)); }
__device__ __forceinline__ float siluf_(float x) { return x * sigmoidf_(x); }
__device__ __forceinline__ float wave_sum(float v) {
#pragma unroll
    for (int o = 1; o < 64; o <<= 1) v += __shfl_xor(v, o);
    return v;
}
__device__ __forceinline__ void unpack8(const u32x4 v, float (&x)[8]) {
    x[0] = bflo(v.x); x[1] = bfhi(v.x); x[2] = bflo(v.y); x[3] = bfhi(v.y); x[4] = bflo(v.z); x[5] = bfhi(v.z); x[6] = bflo(v.w); x[7] = bfhi(v.w);
}
__device__ __forceinline__ u32x4 pack8(const float (&x)[8]) {
    u32x4 w; w.x = cvt_pk_bf16(x[0], x[1]); w.y = cvt_pk_bf16(x[2], x[3]); w.z = cvt_pk_bf16(x[4], x[5]); w.w = cvt_pk_bf16(x[6], x[7]); return w;
}
typedef int v4i __attribute__((ext_vector_type(4)));
__device__ __forceinline__ unsigned q1_i8(float x) { int q = __float2int_rn(x); q = q < -127 ? -127 : (q > 127 ? 127 : q); return (unsigned)q & 255u; }
__device__ __forceinline__ unsigned cvt4_i8(float a, float b, float c, float d) { return q1_i8(a) | (q1_i8(b) << 8) | (q1_i8(c) << 16) | (q1_i8(d) << 24); }
__device__ __forceinline__ u32x2 pack8_i8(const float (&x)[8], float sc) { u32x2 w; w.x = cvt4_i8(x[0] * sc, x[1] * sc, x[2] * sc, x[3] * sc); w.y = cvt4_i8(x[4] * sc, x[5] * sc, x[6] * sc, x[7] * sc); return w; }
#define LDS_WAIT() asm volatile("s_waitcnt lgkmcnt(0)" ::: "memory")
__device__ __forceinline__ int crow(int r, int hi) { return (r & 3) + 8 * (r >> 2) + 4 * hi; }
__device__ __forceinline__ f32x16 mfma32(bf16x8 a, bf16x8 b, f32x16 c) { return __builtin_amdgcn_mfma_f32_32x32x16_bf16(a, b, c, 0, 0, 0); }
__device__ __forceinline__ f32x4 mfma16(bf16x8 a, bf16x8 b, f32x4 c) { return __builtin_amdgcn_mfma_f32_16x16x32_bf16(a, b, c, 0, 0, 0); }
typedef short v4i16_t __attribute__((ext_vector_type(4)));
__device__ __forceinline__ s16x4 trrd(const LAS unsigned char* p) { return __builtin_bit_cast(s16x4, __builtin_amdgcn_ds_read_tr16_b64_v4i16((LAS v4i16_t*)p)); }
__device__ __forceinline__ bf16x8 cat8(s16x4 lo, s16x4 hi) { return (bf16x8){lo[0], lo[1], lo[2], lo[3], hi[0], hi[1], hi[2], hi[3]}; }

namespace pg8 {
constexpr int BM = 256, BK = 64, HALF = 128, HTB = HALF * BK * 2, STAGE_BYTES = 8 * HTB, NXCD = 8, WGM = 8;
__host__ __device__ __forceinline__ int lds_byte(int r, int c) { const int st = (r >> 4) * 2 + (c >> 5), rr = r & 15, cc = c & 31, ob = rr * 64 + cc * 2; return st * 1024 + (ob ^ (((ob >> 9) & 1) << 5)); }
__host__ __device__ __forceinline__ void stage_rc(int b, int& R, int& C) { const int st = b / 1024, sb = b % 1024, swz = sb ^ (((sb >> 9) & 1) << 5); R = (st >> 1) * 16 + swz / 64; C = (st & 1) * 32 + (swz % 64) / 2; }
__host__ __device__ __forceinline__ int perm32(int rho) { const int n = rho >> 4, i = rho & 15; return 8 * (i >> 2) + 4 * n + (i & 3); }

struct Unit { int pm, pn, nt, kind, gx, nv, gi; long ab, bb; };
struct Gemm { const bf16_t* A; const bf16_t* Bt; int lda, ldb, K; };

struct StaticOrder {
    int nM, nN, nwg, G, c, nt0; long tsA, tsB;
    __device__ void init(int M, int N, int lda, int ldb, int G_, int c_, int K_ = 1024) { nM = M / BM; nN = N / BM; nwg = nM * nN; G = G_; c = c_; nt0 = K_ / BK; tsA = (long)BM * lda * 2; tsB = (long)BM * ldb * 2; }
    __device__ bool next(int i, Unit& u) const {
        const long L = (long)i * G + c; if (L >= nwg) return false;
        int wgid = (int)L; { const int q = nwg / NXCD, r = nwg % NXCD, xcd = wgid % NXCD, off = wgid / NXCD; wgid = (xcd < r ? xcd * (q + 1) : r * (q + 1) + (xcd - r) * q) + off; }
        const int nig = WGM * nN, gid = wgid / nig, fm = gid * WGM, gsz = (nM - fm) < WGM ? (nM - fm) : WGM;
        u.pm = fm + ((wgid % nig) % gsz); u.pn = (wgid % nig) / gsz; u.ab = u.pm * tsA; u.bb = u.pn * tsB; u.nt = nt0; u.kind = 0; u.gx = 0; u.nv = 0; u.gi = 0; return true;
    }
};
struct S5Order {
    StaticOrder so; long aH, aRY, aYC, bG, bCN, bS;
    __device__ bool next(int i, Unit& u) const {
        const int base = i / 6, s = i - 6 * base, x = s >> 1;
        if (!so.next(base, u)) return false;
        const long ra = u.ab, rb = u.bb;
        if ((s & 1) == 0) { u.ab = aH + ra; u.bb = bG + rb + (long)x * 1024 * 2048; u.nt = 16; u.kind = 0; u.pn += 4 * x; }
        else if (x == 0) { u.ab = aRY + ra; u.bb = bCN + rb; u.nt = 8; u.kind = 1; }
        else if (x == 1) { u.ab = aRY + ra + 1024; u.bb = bCN + rb + 1024; u.nt = 8; u.kind = 2; }
        else { u.ab = aYC + ra; u.bb = bS + rb; u.nt = 16; u.kind = 3; }
        return true;
    }
};
struct MoeOrder {
    const LAS int* tile_e; const LAS int* off; const LAS int* cnt; int nrt, G, vcu, nt0; long tsA, tsB, eB;
    __device__ bool next(int i, Unit& u) const {
        const long L = (long)i * G + vcu; if (L >= (long)nrt * 4) return false;
        const int rt = (int)(L >> 2), pn = (int)(L & 3), e = __builtin_amdgcn_readfirstlane(tile_e[rt]), k0 = rt * 256 - __builtin_amdgcn_readfirstlane(off[e]), c = __builtin_amdgcn_readfirstlane(cnt[e]);
        u.pm = rt; u.pn = pn; u.ab = rt * tsA; u.bb = e * eB + pn * tsB; u.nt = nt0; u.kind = 0; u.gx = e * ECAP + k0; u.nv = (c - k0) < 256 ? (c - k0) : 256; u.gi = i; return true;
    }
};

template <class Epi, class Sched, bool GATHER = false, bool FP8 = false>
__device__ __forceinline__ void gemm_phase(LAS unsigned char* lds, int tid_, const Gemm g, const Sched& S, const Epi& E, const LAS int* gidx = nullptr) {
    asm volatile("" : "+v"(tid_));
    const int tid = tid_, wid = __builtin_amdgcn_readfirstlane(tid >> 6), lane = tid & 63, wr = wid >> 2, wc = wid & 3, fr = lane & 15, fq = lane >> 4;
    unsigned voffA0[2], voffA1[2], nvA0[2], nvA1[2], voffB[2]; int RA[2], CA[2];
#pragma unroll
    for (int i = 0; i < 2; ++i) { int R, C; stage_rc(tid * 16 + i * 8192, R, C); const int Rb = Epi::PERM ? ((R & ~31) + perm32(R & 31)) : R; RA[i] = R; CA[i] = C;
        voffA0[i] = (unsigned)(R * g.lda + C) * 2u; voffA1[i] = (unsigned)((R + HALF) * g.lda + C) * 2u; nvA0[i] = voffA0[i]; nvA1[i] = voffA1[i]; voffB[i] = (unsigned)(Rb * g.ldb + C) * 2u; }
#define PG8_GATHER(dst0, dst1, u_) do { _Pragma("unroll") for (int _i = 0; _i < 2; ++_i) { \
        dst0[_i] = (unsigned)(gidx[((u_).gi & 7) * 256 + RA[_i]] * g.lda + CA[_i]) * 2u; dst1[_i] = (unsigned)(gidx[((u_).gi & 7) * 256 + HALF + RA[_i]] * g.lda + CA[_i]) * 2u; } } while (0)
    const size_t kstep = (size_t)(BK * 2);
    const size_t hstepB = (size_t)HALF * g.ldb * 2;
    const unsigned ldsw = (unsigned)wid * 1024u;
    const int aoff = lds_byte(wr * 64 + fr, fq * 8), boff = lds_byte(wc * 32 + fr, fq * 8);
#define PG8_SA(b, h) (((b) * 2 + (h)) * HTB)
#define PG8_SB(b, h) ((4 + (b) * 2 + (h)) * HTB)
#define PG8_STAGE(bufoff, gbase, voff) do { _Pragma("unroll") for (int _i = 0; _i < 2; ++_i) \
        __builtin_amdgcn_global_load_lds((const unsigned*)((const char*)(gbase) + (voff)[_i]), (LAS unsigned*)(lds + (bufoff) + ldsw + _i * 8192), 16, 0, 0); } while (0)
#define PG8_LDA(dst, b, h) do { _Pragma("unroll") for (int m = 0; m < 4; ++m) _Pragma("unroll") for (int k = 0; k < 2; ++k) dst[m][k] = *(const LAS bf16x8*)(lds + PG8_SA(b, h) + aoff + m * 2048 + k * 1024); } while (0)
#define PG8_LDB(dst, b, h) do { _Pragma("unroll") for (int n = 0; n < 2; ++n) _Pragma("unroll") for (int k = 0; k < 2; ++k) dst[n][k] = *(const LAS bf16x8*)(lds + PG8_SB(b, h) + boff + n * 2048 + k * 1024); } while (0)
#define PG8_MMA(ai, bj, At, Bt) do { __builtin_amdgcn_s_setprio(1); _Pragma("unroll") for (int m = 0; m < 4; ++m) _Pragma("unroll") for (int n = 0; n < 2; ++n) _Pragma("unroll") for (int k = 0; k < 2; ++k) { \
        if constexpr (FP8) acc[ai][bj][m][n] = __builtin_bit_cast(f32x4, __builtin_amdgcn_mfma_i32_16x16x64_i8(__builtin_bit_cast(v4i, Bt[n][k]), __builtin_bit_cast(v4i, At[m][k]), __builtin_bit_cast(v4i, acc[ai][bj][m][n]), 0, 0, 0)); \
        else acc[ai][bj][m][n] = __builtin_amdgcn_mfma_f32_16x16x32_bf16(Bt[n][k], At[m][k], acc[ai][bj][m][n], 0, 0, 0); } __builtin_amdgcn_s_setprio(0); } while (0)
#define PG8_WAIT_V(n) asm volatile("s_waitcnt vmcnt(" #n ")" ::: "memory")
#define PG8_WAIT_L(n) asm volatile("s_waitcnt lgkmcnt(" #n ")" ::: "memory")
#define PG8_BAR __builtin_amdgcn_s_barrier()
#define PG8_SCHED __builtin_amdgcn_sched_barrier(0)
    Unit cur, nxt; int ui = 0;
    if (!S.next(0, cur)) return;
    f32x4 acc[2][2][4][2];
#pragma unroll
    for (int a = 0; a < 2; ++a)
#pragma unroll
        for (int b = 0; b < 2; ++b)
#pragma unroll
            for (int m = 0; m < 4; ++m)
#pragma unroll
                for (int n = 0; n < 2; ++n) acc[a][b][m][n] = (f32x4){0.f, 0.f, 0.f, 0.f};
    bf16x8 At[4][2], B0[2][2], B1[2][2];
    const char* cA = (const char*)g.A + (GATHER ? 0 : cur.ab); const char* cB = (const char*)g.Bt + cur.bb;
    if constexpr (GATHER) PG8_GATHER(voffA0, voffA1, cur);
    PG8_STAGE(PG8_SB(0, 0), cB, voffB); PG8_STAGE(PG8_SB(0, 1), cB + hstepB, voffB); PG8_STAGE(PG8_SA(0, 0), cA, voffA0); PG8_STAGE(PG8_SA(0, 1), cA, voffA1);
    if (wr == 1) PG8_BAR;
    PG8_WAIT_V(2); PG8_BAR;
    PG8_STAGE(PG8_SB(1, 0), cB + kstep, voffB); PG8_STAGE(PG8_SA(1, 0), cA + kstep, voffA0); PG8_STAGE(PG8_SB(1, 1), cB + hstepB + kstep, voffB);
    PG8_WAIT_V(6); PG8_BAR;
    for (;;) {
        const bool has_next = S.next(ui + 1, nxt);
        const char* nA = (has_next && !GATHER) ? (const char*)g.A + nxt.ab : cA; const char* nB = has_next ? (const char*)g.Bt + nxt.bb : cB;
        if constexpr (GATHER) { if (has_next) PG8_GATHER(nvA0, nvA1, nxt); else { nvA0[0] = voffA0[0]; nvA0[1] = voffA0[1]; nvA1[0] = voffA1[0]; nvA1[1] = voffA1[1]; } }
        const int nt = cur.nt;
        for (int t = 0; t < nt; t += 2) {
            const bool last = (t == nt - 2);
            const char* a1 = cA + (size_t)(t + 1) * kstep;
            const char* a2 = last ? nA : cA + (size_t)(t + 2) * kstep; const char* b2 = last ? nB : cB + (size_t)(t + 2) * kstep;
            const char* a3 = a2 + kstep; const char* b3 = b2 + kstep;
            unsigned xA0[2], xA1[2];
            xA0[0] = (GATHER && last) ? nvA0[0] : voffA0[0]; xA0[1] = (GATHER && last) ? nvA0[1] : voffA0[1]; xA1[0] = (GATHER && last) ? nvA1[0] : voffA1[0]; xA1[1] = (GATHER && last) ? nvA1[1] : voffA1[1];
            PG8_LDB(B0, 0, 0); PG8_LDB(B1, 0, 1); PG8_SCHED; PG8_LDA(At, 0, 0); PG8_STAGE(PG8_SA(1, 1), a1, voffA1);
            PG8_WAIT_V(8); PG8_WAIT_L(0); PG8_BAR; PG8_MMA(0, 0, At, B0); PG8_MMA(0, 1, At, B1); PG8_BAR; PG8_SCHED;
            PG8_LDA(At, 0, 1); PG8_STAGE(PG8_SB(0, 0), b2, voffB); PG8_STAGE(PG8_SB(0, 1), b2 + hstepB, voffB); PG8_STAGE(PG8_SA(0, 0), a2, xA0);
            PG8_WAIT_V(8); PG8_WAIT_L(0); PG8_BAR; PG8_MMA(1, 0, At, B0); PG8_MMA(1, 1, At, B1); PG8_BAR; PG8_SCHED;
            PG8_LDB(B0, 1, 0); PG8_LDB(B1, 1, 1); PG8_SCHED; PG8_LDA(At, 1, 0); PG8_STAGE(PG8_SA(0, 1), a2, xA1);
            PG8_WAIT_V(8); PG8_WAIT_L(0); PG8_BAR; PG8_MMA(0, 0, At, B0); PG8_MMA(0, 1, At, B1); PG8_BAR; PG8_SCHED;
            PG8_LDA(At, 1, 1); PG8_STAGE(PG8_SB(1, 0), b3, voffB); PG8_STAGE(PG8_SB(1, 1), b3 + hstepB, voffB); PG8_STAGE(PG8_SA(1, 0), a3, xA0);
            PG8_WAIT_V(8); PG8_WAIT_L(0); PG8_BAR; PG8_MMA(1, 0, At, B0); PG8_MMA(1, 1, At, B1); PG8_BAR; PG8_SCHED;
        }
        if (wr == 0) PG8_BAR;
        if constexpr (FP8) {
#pragma unroll
            for (int a = 0; a < 2; ++a)
#pragma unroll
                for (int b = 0; b < 2; ++b)
#pragma unroll
                    for (int m = 0; m < 4; ++m)
#pragma unroll
                        for (int n = 0; n < 2; ++n)
#pragma unroll
                            for (int j = 0; j < 4; ++j) acc[a][b][m][n][j] = (float)__float_as_int(acc[a][b][m][n][j]);
        }
        E(acc, cur, wr, wc, fr, fq);
        if (!has_next) break;
#pragma unroll
        for (int a = 0; a < 2; ++a)
#pragma unroll
            for (int b = 0; b < 2; ++b)
#pragma unroll
                for (int m = 0; m < 4; ++m)
#pragma unroll
                    for (int n = 0; n < 2; ++n) acc[a][b][m][n] = (f32x4){0.f, 0.f, 0.f, 0.f};
        cur = nxt; cA = nA; cB = nB; ++ui;
        if constexpr (GATHER) { voffA0[0] = nvA0[0]; voffA0[1] = nvA0[1]; voffA1[0] = nvA1[0]; voffA1[1] = nvA1[1]; }
        if (wr == 1) PG8_BAR;
    }
    PG8_WAIT_V(0);
    PG8_BAR;
#undef PG8_GATHER
#undef PG8_SA
#undef PG8_SB
#undef PG8_STAGE
#undef PG8_LDA
#undef PG8_LDB
#undef PG8_MMA
#undef PG8_WAIT_V
#undef PG8_WAIT_L
#undef PG8_BAR
#undef PG8_SCHED
}

enum { EK_PROJ = 0, EK_GATE, EK_BR0, EK_BR1, EK_BR2, EK_WOUT, EK_GLU, EK_DOWN, EK_S5 };
template <int KIND> struct Epi {
    static constexpr bool PERM = true;
    bf16_t* O; int ldo;
    const bf16_t* X; int ldx;
    float* F;
    const int2* RI;
    bf16_t* O2;
    float osc;
    __device__ __forceinline__ void operator()(const f32x4 (&acc)[2][2][4][2], const Unit& u, int wr, int wc, int fr, int fq) const {
        const int row0 = u.pm * BM + wr * 64 + fr, col0 = u.pn * BM + wc * 32 + 8 * fq;
        if constexpr (KIND == EK_GLU) {
            const int hc0 = u.pn * 128 + wc * 32 + 8 * fq;
#pragma unroll
            for (int ai = 0; ai < 2; ++ai)
#pragma unroll
                for (int m = 0; m < 4; ++m) {
                    const int row = row0 + ai * HALF + m * 16; float o[8];
#pragma unroll
                    for (int n = 0; n < 2; ++n)
#pragma unroll
                        for (int j = 0; j < 4; ++j) o[4 * n + j] = siluf_(acc[ai][0][m][n][j] * osc) * (acc[ai][1][m][n][j] * osc);
                    *(u32x4*)(O + (size_t)row * ldo + hc0) = pack8(o);
                    asm volatile("" ::: "memory");
                }
        } else if constexpr (KIND == EK_DOWN) {
#pragma unroll
            for (int ai = 0; ai < 2; ++ai)
#pragma unroll
                for (int m = 0; m < 4; ++m) {
                    const int lr = ai * HALF + wr * 64 + m * 16 + fr; const bool ok = lr < u.nv; const int2 ri = RI[u.gx + (ok ? lr : 0)]; const float w = __int_as_float(ri.y) * osc;
                    if (ok) {
#pragma unroll
                        for (int bj = 0; bj < 2; ++bj) { float o[8];
#pragma unroll
                            for (int n = 0; n < 2; ++n)
#pragma unroll
                                for (int j = 0; j < 4; ++j) o[4 * n + j] = w * acc[ai][bj][m][n][j];
                            *(u32x4*)(O + (size_t)ri.x * ldo + col0 + bj * HALF) = pack8(o); }
                    }
                    asm volatile("" ::: "memory");
                }
        } else if constexpr (KIND == EK_S5) {
            if (u.kind == 0) { Epi<EK_GATE> e{O, ldo, nullptr, 0, nullptr, nullptr, nullptr, 1.f}; e(acc, u, wr, wc, fr, fq); }
            else if (u.kind == 1) { Epi<EK_BR0> e{nullptr, 0, O, ldo, F, nullptr, nullptr, 1.f}; e(acc, u, wr, wc, fr, fq); }
            else if (u.kind == 2) { Epi<EK_BR1> e{nullptr, 0, O + 1024, ldo, F, nullptr, nullptr, 1.f}; e(acc, u, wr, wc, fr, fq); }
            else { Epi<EK_BR2> e{O2, 1024, O + 2048, ldo, F, nullptr, nullptr, 1.f}; e(acc, u, wr, wc, fr, fq); }
        } else {
            int act = 0;
            if constexpr (KIND == EK_PROJ) act = (u.pn == 2 || u.pn == 3) ? 1 : ((u.pn >= 7 && u.pn <= 10) ? 2 : 0);
#pragma unroll
            for (int ai = 0; ai < 2; ++ai)
#pragma unroll
                for (int m = 0; m < 4; ++m) {
                    const int row = row0 + ai * HALF + m * 16;
#pragma unroll
                    for (int bj = 0; bj < 2; ++bj) {
                        const int col = col0 + bj * HALF; float v[8];
#pragma unroll
                        for (int n = 0; n < 2; ++n)
#pragma unroll
                            for (int j = 0; j < 4; ++j) v[4 * n + j] = acc[ai][bj][m][n][j];
                        if constexpr (KIND == EK_PROJ) {
#pragma unroll
                            for (int j = 0; j < 8; ++j) v[j] *= osc;
                            if (act == 1) {
#pragma unroll
                                for (int j = 0; j < 8; ++j) v[j] *= QSCALE;
                            } else if (act == 2) {
#pragma unroll
                                for (int j = 0; j < 8; ++j) v[j] = siluf_(v[j]);
                            }
                            *(u32x4*)(O + (size_t)row * ldo + col) = pack8(v);
                        } else if constexpr (KIND == EK_GATE) {
#pragma unroll
                            for (int j = 0; j < 8; ++j) v[j] = sigmoidf_(v[j]);
                            *(u32x4*)(O + (size_t)row * ldo + col) = pack8(v);
                        } else if constexpr (KIND == EK_BR0 || KIND == EK_BR1 || KIND == EK_BR2) {
                            float gt[8]; unpack8(*(const u32x4*)(X + (size_t)row * ldx + col), gt);
                            float* fp = F + (size_t)row * 1024 + col;
                            if constexpr (KIND == EK_BR0) {
                                *(f32x4*)fp = (f32x4){gt[0] * v[0], gt[1] * v[1], gt[2] * v[2], gt[3] * v[3]};
                                *(f32x4*)(fp + 4) = (f32x4){gt[4] * v[4], gt[5] * v[5], gt[6] * v[6], gt[7] * v[7]};
                            } else {
                                const f32x4 t0 = *(const f32x4*)fp, t1 = *(const f32x4*)(fp + 4);
                                float s[8];
#pragma unroll
                                for (int j = 0; j < 4; ++j) { s[j] = t0[j] + gt[j] * v[j]; s[4 + j] = t1[j] + gt[4 + j] * v[4 + j]; }
                                if constexpr (KIND == EK_BR1) { *(f32x4*)fp = (f32x4){s[0], s[1], s[2], s[3]}; *(f32x4*)(fp + 4) = (f32x4){s[4], s[5], s[6], s[7]}; }
                                else *(u32x4*)(O + (size_t)row * ldo + col) = pack8(s);
                            }
                        } else if constexpr (KIND == EK_WOUT) {
                            float hv[8]; unpack8(*(const u32x4*)(X + (size_t)row * ldx + col), hv);
#pragma unroll
                            for (int j = 0; j < 8; ++j) v[j] += DN_ALPHA * hv[j];
                            *(u32x4*)(O + (size_t)row * ldo + col) = pack8(v);
                        }
                        asm volatile("" ::: "memory");
                    }
                }
        }
    }
};
}

#define XB_TMO      128
#define XB_XCNT(j)  (256  + 64 * (j))
#define XB_XSUB(j)  (1280 + 64 * (j))
#define XB_XGEN(j)  (2304 + 64 * (j))
#define XB_TOP      3328
#define XB_TOPGEN   3392
#define XCD_BAR_WORDS 3456
#define XB_SPIN_CAP (1u << 20)
__device__ __forceinline__ unsigned xb_ld(unsigned* p)              { return __hip_atomic_load(p, __ATOMIC_RELAXED, __HIP_MEMORY_SCOPE_AGENT); }
__device__ __forceinline__ unsigned xb_add(unsigned* p, unsigned v) { return __hip_atomic_fetch_add(p, v, __ATOMIC_RELAXED, __HIP_MEMORY_SCOPE_AGENT); }
__device__ __forceinline__ unsigned xb_xcc_id() { return (unsigned)__builtin_amdgcn_s_getreg((3 << 11) | 20) & 0xFu; }
#define XB_SPIN(cond, bar) do { unsigned _sp = 0; while (cond) { __builtin_amdgcn_s_sleep(1); \
    if ((++_sp & 255u) == 0u) { if (xb_ld(&(bar)[XB_TMO])) break; if (_sp > XB_SPIN_CAP) { atomicAdd(&(bar)[XB_TMO], 1u); break; } } } } while (0)
struct XcdBarrier { unsigned* bar; unsigned x; volatile LAS unsigned* st; };
__device__ __forceinline__ XcdBarrier xcd_barrier_post(unsigned* bar, volatile LAS unsigned* st, int tid) {
    XcdBarrier b; b.bar = bar; b.x = xb_xcc_id(); b.st = st;
    if (tid == 0) (void)xb_add(&bar[XB_XCNT(b.x)], 1u);
    return b;
}
__device__ __forceinline__ void xcd_barrier_complete(unsigned* bar, unsigned x, unsigned& nloc, unsigned& nx) {
    const unsigned G = gridDim.x * gridDim.y * gridDim.z;
    unsigned sum, cnt, mine, sp = 0u;
    for (;;) {
        sum = 0u; cnt = 0u; mine = 0u;
#pragma unroll
        for (unsigned j = 0; j < 16; ++j) { const unsigned c = xb_ld(&bar[XB_XCNT(j)]); sum += c; cnt += (c > 0u) ? 1u : 0u; mine = (j == x) ? c : mine; }
        if (sum == G) break;
        __builtin_amdgcn_s_sleep(1);
        if ((++sp & 255u) == 0u) { if (xb_ld(&bar[XB_TMO])) break; if (sp > XB_SPIN_CAP) { atomicAdd(&bar[XB_TMO], 1u); break; } }
    }
    nloc = mine > 0u ? mine : 1u; nx = cnt > 0u ? cnt : 1u;
}
__device__ __forceinline__ void xcd_barrier(const XcdBarrier& b, int tid) {
    asm volatile("s_waitcnt vmcnt(0)" ::: "memory");
    __syncthreads();
    if (tid == 0) {
        unsigned* bar = b.bar;
        __builtin_amdgcn_s_waitcnt(0);
        unsigned nloc = b.st[0], nx = b.st[1];
        if (nloc == 0u) { xcd_barrier_complete(bar, b.x, nloc, nx); b.st[0] = nloc; b.st[1] = nx; }
        const unsigned old = xb_add(&bar[XB_XSUB(b.x)], 1u);
        const unsigned gen = old / nloc;
        if (old + 1u == (gen + 1u) * nloc) {
            __builtin_amdgcn_fence(__ATOMIC_RELEASE, "agent");
            asm volatile("s_waitcnt vmcnt(0)" ::: "memory");
            const unsigned og = xb_add(&bar[XB_TOP], 1u);
            const unsigned tg = og / nx;
            if (og + 1u == (tg + 1u) * nx) xb_add(&bar[XB_TOPGEN], 1u);
            else XB_SPIN(xb_ld(&bar[XB_TOPGEN]) == tg, bar);
            __builtin_amdgcn_fence(__ATOMIC_ACQUIRE, "agent");
            xb_add(&bar[XB_XGEN(b.x)], 1u);
            asm volatile("s_waitcnt vmcnt(0)" ::: "memory");
        } else {
            XB_SPIN(xb_ld(&bar[XB_XGEN(b.x)]) == gen, bar);
            __builtin_amdgcn_fence(__ATOMIC_ACQUIRE, "agent");
            asm volatile("s_waitcnt vmcnt(0)" ::: "memory");
        }
    }
    __syncthreads();
}

struct Args { const float* in[32]; float* out; unsigned char* ws; int lo, hi; };
typedef const __attribute__((address_space(4))) Args* ArgsP;
enum { I_X = 0, I_LN0G, I_LN0B, I_WIN, I_POOLW, I_POOLS, I_CKPE, I_CKW1, I_CKW2, I_CVPE, I_CVW1, I_CVW2, I_RELB, I_CONVW, I_CONVB, I_DTB, I_ALOG, I_DSKIP, I_SNG,
       I_WBP, I_WBN, I_WBS, I_WOUT, I_LN1G, I_LN1B, I_RW, I_RB, I_EW1, I_EW3, I_EW2, I_LN2G, I_LN2B };


struct Ctx {
    LAS unsigned char* lds;
    unsigned* ctl;
    unsigned char* ws; unsigned char* dout;
    int tid, lane, wave, G, vcu, gw, NGW;
};

struct Job { const float* src; size_t sbatch; int ldw, K, c0, ncols; bf16_t* dst; int dbatch_rows, ldt, drow0, mode, nbatch, fp8; };
constexpr int NJOBS = 15;
__device__ __forceinline__ Job get_job(ArgsP a, int l, int j) {
    unsigned char* wl = a->ws + WS_W + (size_t)l * W_LAYER;
    bf16_t* win = (bf16_t*)(wl + WO_IN); bf16_t* wg = (bf16_t*)(wl + WO_GATE);
    const float* w_in = a->in[I_WIN] + (size_t)l * DM * D_IN;
    Job J; J.sbatch = 0; J.dbatch_rows = 0; J.mode = 0; J.nbatch = 1; J.c0 = 0; J.drow0 = 0; J.fp8 = 0;
    switch (j) {
    case 0:  J.src = w_in; J.ldw = D_IN; J.K = 1024; J.c0 = 0;    J.ncols = 1792; J.dst = win; J.ldt = 1024; J.drow0 = 0; J.fp8 = 1; break;
    case 1:  J.src = w_in; J.ldw = D_IN; J.K = 1024; J.c0 = 1792; J.ncols = 24;   J.dst = win; J.ldt = 1024; J.drow0 = C_NG; J.fp8 = 1; break;
    case 2:  J.src = w_in; J.ldw = D_IN; J.K = 1024; J.c0 = 1816; J.ncols = 3072; J.dst = win; J.ldt = 1024; J.drow0 = C_Z; J.fp8 = 1; break;
    case 3:  J.src = w_in; J.ldw = D_IN; J.K = 1024; J.c0 = 4888; J.ncols = 16;   J.dst = win; J.ldt = 1024; J.drow0 = C_DT; J.fp8 = 1; break;
    case 4:  J.src = w_in; J.ldw = D_IN; J.K = 1024; J.c0 = 4904; J.ncols = 3072; J.dst = wg;  J.ldt = 1024; J.drow0 = 0; break;
    case 5:  J.src = a->in[I_WBN] + (size_t)l * 512 * 1024;  J.ldw = 1024; J.K = 512;  J.ncols = 1024; J.dst = (bf16_t*)(wl + WO_C) + 512; J.ldt = 1024; break;
    case 6:  J.src = a->in[I_WBS] + (size_t)l * 1024 * 1024; J.ldw = 1024; J.K = 1024; J.ncols = 1024; J.dst = (bf16_t*)(wl + WO_SSD); J.ldt = 1024; break;
    case 7:  J.src = a->in[I_WOUT] + (size_t)l * 1024 * 1024; J.ldw = 1024; J.K = 1024; J.ncols = 1024; J.dst = (bf16_t*)(wl + WO_OUT); J.ldt = 1024; break;
    case 8:  J.src = a->in[I_CKW1] + (size_t)l * 2048 * 128; J.ldw = 128; J.K = 2048; J.ncols = 128; J.dst = (bf16_t*)(wl + WO_W1); J.ldt = 2048; break;
    case 9:  J.src = a->in[I_CVW1] + (size_t)l * 2048 * 128; J.ldw = 128; J.K = 2048; J.ncols = 128; J.dst = (bf16_t*)(wl + WO_W1) + 128 * 2048; J.ldt = 2048; break;
    case 10: J.src = a->in[I_CKW2] + (size_t)l * 128 * 64; J.ldw = 64; J.K = 128; J.ncols = 64; J.dst = (bf16_t*)(wl + WO_W2); J.ldt = 128; break;
    case 11: J.src = a->in[I_CVW2] + (size_t)l * 128 * 64; J.ldw = 64; J.K = 128; J.ncols = 64; J.dst = (bf16_t*)(wl + WO_W2) + 64 * 128; J.ldt = 128; break;
    case 12: J.src = a->in[I_EW1] + (size_t)l * 16 * 1024 * 512; J.sbatch = (size_t)1024 * 512; J.ldw = 512; J.K = 1024; J.ncols = 512; J.dst = (bf16_t*)(wl + WO_UP); J.dbatch_rows = 1024; J.ldt = 1024; J.drow0 = 0;   J.mode = 1; J.nbatch = 16; J.fp8 = 1; break;
    case 13: J.src = a->in[I_EW3] + (size_t)l * 16 * 1024 * 512; J.sbatch = (size_t)1024 * 512; J.ldw = 512; J.K = 1024; J.ncols = 512; J.dst = (bf16_t*)(wl + WO_UP); J.dbatch_rows = 1024; J.ldt = 1024; J.drow0 = 128; J.mode = 1; J.nbatch = 16; J.fp8 = 1; break;
    default: J.src = a->in[I_EW2] + (size_t)l * 16 * 512 * 1024; J.sbatch = (size_t)512 * 1024; J.ldw = 1024; J.K = 512; J.ncols = 1024; J.dst = (bf16_t*)(wl + WO_DN); J.dbatch_rows = 1024; J.ldt = 512; J.nbatch = 16; break;
    }
    return J;
}
__device__ __forceinline__ void tr_item(const Job& J, int item, LAS float* scr, int lane) {
    const int nblk = (J.ncols + 31) >> 5, kblk = J.K >> 6, per = nblk * kblk;
    const int bt = item / per, r = item - bt * per, kb = r / nblk, nb = r - kb * nblk, k0 = 64 * kb, n0 = 32 * nb;
    const int nv = (J.ncols - n0) < 32 ? (J.ncols - n0) : 32;
    const float* W = J.src + (size_t)bt * J.sbatch;
    { const int nn = lane & 31; const float* wp = W + (size_t)(k0 + (lane >> 5)) * J.ldw + J.c0 + n0 + nn; float v[32];
#pragma unroll
      for (int i = 0; i < 32; ++i) v[i] = (nn < nv) ? wp[(size_t)(2 * i) * J.ldw] : 0.f;
#pragma unroll
      for (int i = 0; i < 32; ++i) scr[(2 * i + (lane >> 5)) * 33 + nn] = v[i]; }
    LDS_WAIT();
    const int c = lane & 7;
#pragma unroll
    for (int j = 0; j < 4; ++j) { const int n = (lane >> 3) + 8 * j;
        if (n < nv) {
            const LAS float* s = scr + (8 * c) * 33 + n; const int nn = n0 + n;
            const int drow = bt * J.dbatch_rows + J.drow0 + (J.mode == 1 ? ((nn >> 7) * 256 + (nn & 127)) : nn);
            if (J.fp8) { u32x2 o; o.x = cvt4_i8(s[0 * 33] * WSCALE, s[1 * 33] * WSCALE, s[2 * 33] * WSCALE, s[3 * 33] * WSCALE); o.y = cvt4_i8(s[4 * 33] * WSCALE, s[5 * 33] * WSCALE, s[6 * 33] * WSCALE, s[7 * 33] * WSCALE);
                *(u32x2*)((unsigned char*)J.dst + (size_t)drow * J.ldt + k0 + 8 * c) = o; }
            else { u32x4 o; o.x = cvt_pk_bf16(s[0 * 33], s[1 * 33]); o.y = cvt_pk_bf16(s[2 * 33], s[3 * 33]); o.z = cvt_pk_bf16(s[4 * 33], s[5 * 33]); o.w = cvt_pk_bf16(s[6 * 33], s[7 * 33]);
                *(u32x4*)(J.dst + (size_t)drow * J.ldt + k0 + 8 * c) = o; } } }
    LDS_WAIT();
}
__device__ __forceinline__ void ln_row_f32(const float* xrow, const float* g, const float* b, bf16_t* orow, unsigned char* orow8, int lane) {
    const f32x4* xr = (const f32x4*)xrow + lane; f32x4 v[4]; float s = 0.f;
#pragma unroll
    for (int j = 0; j < 4; ++j) { v[j] = xr[64 * j]; s += (v[j].x + v[j].y) + (v[j].z + v[j].w); }
    const float mean = wave_sum(s) * (1.f / DM); float s2 = 0.f;
#pragma unroll
    for (int j = 0; j < 4; ++j) { v[j] = v[j] - mean; s2 += (v[j].x * v[j].x + v[j].y * v[j].y) + (v[j].z * v[j].z + v[j].w * v[j].w); }
    const float rstd = 1.f / sqrtf(wave_sum(s2) * (1.f / DM) + LN_EPS);
    u32x2* o8 = (u32x2*)orow + lane;
#pragma unroll
    for (int j = 0; j < 4; ++j) { const f32x4 gg = ((const f32x4*)g + lane)[64 * j], bb = ((const f32x4*)b + lane)[64 * j];
        const float y0 = v[j].x * rstd * gg.x + bb.x, y1 = v[j].y * rstd * gg.y + bb.y, y2 = v[j].z * rstd * gg.z + bb.z, y3 = v[j].w * rstd * gg.w + bb.w;
        u32x2 w; w.x = cvt_pk_bf16(y0, y1); w.y = cvt_pk_bf16(y2, y3); o8[64 * j] = w;
        ((unsigned*)orow8 + lane)[64 * j] = cvt4_i8(y0 * ASCALE, y1 * ASCALE, y2 * ASCALE, y3 * ASCALE); }
}
__device__ __forceinline__ int rel_bucket_dev(int n) {
    if (n < 16) return n;
    int b = 16;
    b += (n >= 19) + (n >= 21) + (n >= 24) + (n >= 27) + (n >= 31) + (n >= 35) + (n >= 40) + (n >= 46) + (n >= 52) + (n >= 59) + (n >= 67) + (n >= 77) + (n >= 87) + (n >= 99) + (n >= 113);
    return b;
}
__device__ __forceinline__ void p0_prologue(const Ctx& F, ArgsP a) {
    LAS float* scr = (LAS float*)(F.lds + F.wave * 16384);
    int base = 0;
    for (int l = 0; l < DEPTH; ++l)
        for (int j = 0; j < NJOBS; ++j) {
            const Job J = get_job(a, l, j);
            const int nitems = J.nbatch * (J.K >> 6) * ((J.ncols + 31) >> 5);
            int first = (F.gw - base) % F.NGW; if (first < 0) first += F.NGW;
            for (int it = first; it < nitems; it += F.NGW) tr_item(J, it, scr, F.lane);
            base = (base + nitems) % F.NGW;
        }
    { bf16_t* H = (bf16_t*)(a->ws + WS_H);
      for (int m = F.gw; m < T_; m += F.NGW) ln_row_f32(a->in[I_X] + (size_t)m * DM, a->in[I_LN0G], a->in[I_LN0B], H + (size_t)m * DM, a->ws + WS_H8 + (size_t)m * DM, F.lane); }
    { const int gt = blockIdx.x * 512 + F.tid, nthr = F.G * 512;
      for (int id = gt; id < DEPTH * 65536; id += nthr) {
          const int l = id >> 16, r = id & 65535, n = r & 1023, k8 = r >> 10, g = k8 >> 4, c0 = (k8 & 15) * 8;
          const float* pw = a->in[I_POOLW] + (size_t)l * 4 * 128 * 128 + (size_t)(g * 128 + c0) * 128;
          const float* sc = a->in[I_POOLS] + l * 512 + g * 128;
          const float* wb = a->in[I_WBP] + (size_t)l * 512 * 1024 + (size_t)(g * 128) * 1024 + n;
          float acc[8] = {0.f, 0.f, 0.f, 0.f, 0.f, 0.f, 0.f, 0.f};
          for (int d = 0; d < 128; ++d) { const float w = wb[(size_t)d * 1024] * sc[d];
#pragma unroll
              for (int i = 0; i < 8; ++i) acc[i] += pw[i * 128 + d] * w; }
          bf16_t* dst = (bf16_t*)(a->ws + WS_W + (size_t)l * W_LAYER + WO_C) + (size_t)n * 1024 + g * 128 + c0;
          *(u32x4*)dst = pack8(acc);
      } }
    for (int o = F.gw; o < DEPTH * 2 * 128; o += F.NGW) {
        const int l = o >> 8, kv = (o >> 7) & 1, col = o & 127;
        const float* pe = a->in[kv ? I_CVPE : I_CKPE] + (size_t)l * 2048; const float* w1 = a->in[kv ? I_CVW1 : I_CKW1] + (size_t)l * 2048 * 128 + col;
        float s = 0.f;
        for (int k = F.lane; k < 2048; k += 64) s += pe[k] * w1[(size_t)k * 128];
        s = wave_sum(s);
        if (F.lane == 0) ((float*)(a->ws + WS_MISC + MI_B1))[o] = s;
    }
    if (blockIdx.x == 0) {
        float* bt = (float*)(a->ws + WS_MISC + MI_BIAS);
        for (int i = F.tid; i < 8 * 128; i += 512) { const int hd = i >> 7, d = i & 127;
            bt[i] = (a->in[I_RELB][rel_bucket_dev(d) * 8 + hd] - a->in[I_RELB][31 * 8 + hd]) * LOG2E; }
    }
}

__device__ __forceinline__ void conv_phase(const Ctx& F, const bf16_t* P, bf16_t* XC, const float* cw, const float* cb) {
    const int gt = blockIdx.x * 512 + F.tid, nthr = F.G * 512;
    const int c = gt & 255;
    float w[4][8], b[8];
#pragma unroll
    for (int k = 0; k < 4; ++k)
#pragma unroll
        for (int i = 0; i < 8; ++i) w[k][i] = cw[k * 2048 + 8 * c + i];
#pragma unroll
    for (int i = 0; i < 8; ++i) b[i] = cb[8 * c + i];
    for (int id = gt; id < (TG / 16) * 256; id += nthr) {
        const int tl0 = (id >> 8) * 16, s0 = tl0 & (SEQ - 1);
        u32x4 raw[19];
#pragma unroll
        for (int r = 0; r < 19; ++r) raw[r] = (s0 + r - 3 >= 0) ? *(const u32x4*)(P + (size_t)(tl0 + r - 3) * LDP + C_XBC + 8 * c) : (u32x4){0u, 0u, 0u, 0u};
#pragma unroll
        for (int i = 0; i < 16; ++i) {
            float acc[8];
#pragma unroll
            for (int j = 0; j < 8; ++j) acc[j] = b[j];
#pragma unroll
            for (int k = 0; k < 4; ++k) { float x[8]; unpack8(raw[i + k], x);
#pragma unroll
                for (int j = 0; j < 8; ++j) acc[j] += w[k][j] * x[j]; }
#pragma unroll
            for (int j = 0; j < 8; ++j) acc[j] = siluf_(acc[j]);
            *(u32x4*)(XC + (size_t)(tl0 + i) * 2048 + 8 * c) = pack8(acc);
        }
    }
}
__device__ __forceinline__ void compress_unit(const Ctx& F, int cu, const bf16_t* P, const bf16_t* W1t, const bf16_t* W2t, const float* b1, bf16_t* KC, bf16_t* VC) {
    const int kv = cu & 1, g = (cu >> 1) & 1, nb = (cu >> 2) & 7, bl = cu >> 5;
    const int lane = F.lane, w = F.wave, fr = lane & 15, fq = lane >> 4;
    LAS bf16_t* hid = (LAS bf16_t*)F.lds;
    const bf16_t* w1 = W1t + (size_t)kv * 128 * 2048 + (size_t)(16 * w + fr) * 2048 + 8 * fq;
    int n0 = nb * 16 + fr; if (n0 > 126) n0 = 126;
    const bf16_t* a0 = P + (size_t)(bl * SEQ + 16 * n0) * LDP + C_KV + kv * 128 + g * 64 + 8 * fq;
    f32x4 acc0 = {0.f, 0.f, 0.f, 0.f}, acc1 = {0.f, 0.f, 0.f, 0.f};
#pragma unroll 8
    for (int kk = 0; kk < 64; kk += 2) {
        const int l = kk >> 1;
        const bf16x8 bb0 = *(const bf16x8*)(w1 + kk * 32), bb1 = *(const bf16x8*)(w1 + kk * 32 + 32);
        const bf16x8 x0 = *(const bf16x8*)(a0 + (size_t)l * LDP), x1 = *(const bf16x8*)(a0 + (size_t)l * LDP + 32);
        acc0 = mfma16(x0, bb0, acc0); acc1 = mfma16(x1, bb1, acc1);
    }
    const float bias = b1[kv * 128 + 16 * w + fr];
#pragma unroll
    for (int r = 0; r < 4; ++r) { const float x = acc0[r] + acc1[r] + bias, u = 0.7978845608f * (x + 0.044715f * x * x * x); hid[(4 * fq + r) * 136 + 16 * w + fr] = f2bf(x * sigmoidf_(2.f * u)); }
    __syncthreads();
    if (w < 4) { f32x4 acc = {0.f, 0.f, 0.f, 0.f};
      const bf16_t* w2 = W2t + (size_t)kv * 64 * 128 + (size_t)(16 * w + fr) * 128 + 8 * fq;
#pragma unroll
      for (int ks = 0; ks < 4; ++ks) { const bf16x8 aa = *(const LAS bf16x8*)(hid + fr * 136 + ks * 32 + 8 * fq); const bf16x8 bb = *(const bf16x8*)(w2 + ks * 32); acc = mfma16(aa, bb, acc); }
      bf16_t* dst = kv ? VC : KC;
#pragma unroll
      for (int r = 0; r < 4; ++r) { const int n = nb * 16 + 4 * fq + r; if (n < 127) dst[(size_t)(bl * 128 + n) * 128 + g * 64 + 16 * w + fr] = f2bf(acc[r]); }
    }
    __syncthreads();
}

template <int WIN>
__device__ __forceinline__ void pool_item(const bf16_t* P, bf16_t* R, int grp, int rq, int lane) {
    const int c = 16 * grp + (lane & 15), tl0 = (4 * rq + (lane >> 4)) * 8, s0 = tl0 & (SEQ - 1);
    constexpr int NROW = 7 + WIN;
    u32x4 raw[NROW];
#pragma unroll
    for (int k = 0; k < NROW; ++k) { const int sp = s0 - (WIN - 1) + k; raw[k] = (sp >= 0) ? *(const u32x4*)(P + (size_t)(tl0 - (WIN - 1) + k) * LDP + C_POOL + 8 * c) : (u32x4){0u, 0u, 0u, 0u}; }
#pragma unroll
    for (int i = 0; i < 8; ++i) {
        float sum[8] = {0.f, 0.f, 0.f, 0.f, 0.f, 0.f, 0.f, 0.f}, u0[8];
#pragma unroll
        for (int j = 0; j < WIN; ++j) { float x[8]; unpack8(raw[i + (WIN - 1) - j], x);
#pragma unroll
            for (int q = 0; q < 8; ++q) sum[q] += x[q]; }
        unpack8(raw[i + WIN - 1], u0);
        const int s = s0 + i, cnt = (s + 1) < WIN ? (s + 1) : WIN; const float inv = 1.f / (float)cnt;
#pragma unroll
        for (int q = 0; q < 8; ++q) sum[q] = sum[q] * inv - u0[q];
        *(u32x4*)(R + (size_t)(tl0 + i) * 1024 + 8 * c) = pack8(sum);
    }
}
__device__ __forceinline__ void fin_phase(const Ctx& F, const bf16_t* P, bf16_t* R, bf16_t* Y, const float* normg) {
    for (int wi = F.gw; wi < 4 * (TG / 32); wi += F.NGW) {
        const int grp = wi & 3, rq = wi >> 2;
        if (grp == 0) pool_item<2>(P, R, 0, rq, F.lane); else if (grp == 1) pool_item<4>(P, R, 1, rq, F.lane); else if (grp == 2) pool_item<8>(P, R, 2, rq, F.lane); else pool_item<16>(P, R, 3, rq, F.lane);
    }
    const int lane = F.lane;
    float ng[16];
#pragma unroll
    for (int i = 0; i < 16; ++i) ng[i] = normg[16 * lane + i];
    u32x4 nx[4];
#define FIN_LOAD(tl_) do { nx[0] = *(const u32x4*)(Y + (size_t)(tl_) * 1024 + 16 * lane); nx[1] = *(const u32x4*)(Y + (size_t)(tl_) * 1024 + 16 * lane + 8); \
        nx[2] = *(const u32x4*)(P + (size_t)(tl_) * LDP + C_Z + 16 * lane); nx[3] = *(const u32x4*)(P + (size_t)(tl_) * LDP + C_Z + 16 * lane + 8); } while (0)
    if (F.gw < TG) FIN_LOAD(F.gw);
    for (int tl = F.gw; tl < TG; tl += F.NGW) {
        const u32x4 c0 = nx[0], c1 = nx[1], c2 = nx[2], c3 = nx[3];
        if (tl + F.NGW < TG) FIN_LOAD(tl + F.NGW);
        float y[16], z[16];
        { float t[8]; unpack8(c0, t);
#pragma unroll
          for (int i = 0; i < 8; ++i) y[i] = t[i];
          unpack8(c1, t);
#pragma unroll
          for (int i = 0; i < 8; ++i) y[8 + i] = t[i];
          unpack8(c2, t);
#pragma unroll
          for (int i = 0; i < 8; ++i) z[i] = t[i];
          unpack8(c3, t);
#pragma unroll
          for (int i = 0; i < 8; ++i) z[8 + i] = t[i]; }
        float ss = 0.f;
#pragma unroll
        for (int i = 0; i < 16; ++i) { y[i] *= z[i]; ss += y[i] * y[i]; }
        ss += __shfl_xor(ss, 1); ss += __shfl_xor(ss, 2); ss += __shfl_xor(ss, 4); ss += __shfl_xor(ss, 8);
        const float rstd = 1.f / sqrtf(ss * (1.f / 256.f) + LN_EPS);
        float o[8];
#pragma unroll
        for (int i = 0; i < 8; ++i) o[i] = y[i] * rstd * ng[i];
        *(u32x4*)(Y + (size_t)tl * 1024 + 16 * lane) = pack8(o);
#pragma unroll
        for (int i = 0; i < 8; ++i) o[i] = y[8 + i] * rstd * ng[8 + i];
        *(u32x4*)(Y + (size_t)tl * 1024 + 16 * lane + 8) = pack8(o);
    }
#undef FIN_LOAD
}

#ifndef NSA_X1
#define NSA_X1 0
#endif
#ifndef NSA_X2
#define NSA_X2 0
#endif
#ifndef SSD_REP
#define SSD_REP 0
#endif
#ifndef NSA_REP
#define NSA_REP 0
#endif
constexpr int NL_KT = 0, NL_VT = 32768, NL_BIAS = 65536, NL_IMP = 67584, NL_SEL = 101376, NL_UNI = 101632;
__device__ __forceinline__ void glds16(const void* gsrc, unsigned lds_dst) { unsigned keep;
    asm volatile("s_mov_b32 %0, m0\n\ts_mov_b32 m0, %2\n\ts_nop 0\n\tglobal_load_lds_dwordx4 %1, off\n\ts_mov_b32 m0, %0" : "=&s"(keep) : "v"(gsrc), "s"(lds_dst) : "memory"); }
#define NSA_WAITBAR(N) asm volatile("s_waitcnt vmcnt(" #N ") lgkmcnt(0)\n\ts_barrier" ::: "memory")

#define NSA_STORE_TILE(buf) do { \
    *(LAS u32x4*)(lds + NL_KT + (buf) * 8192 + (tid >> 6) * 1024 + (tid & 63) * 16) = kreg; \
    *(LAS u32x4*)(lds + NL_VT + (buf) * 8192 + ((tid & 7) >> 2) * 4096 + (tid >> 3) * 64 + (tid & 3) * 16) = vreg; } while (0)

__device__ __forceinline__ void nsa_qk(const LAS unsigned char* Kt, const bf16x8 (&qB)[4], int r32, int hi, f32x16& p0, f32x16& p1) {
    p0 = (f32x16){0.f, 0.f, 0.f, 0.f, 0.f, 0.f, 0.f, 0.f, 0.f, 0.f, 0.f, 0.f, 0.f, 0.f, 0.f, 0.f}; p1 = p0;
#pragma unroll
    for (int d0 = 0; d0 < 4; ++d0) {
        const bf16x8 k0 = *(const LAS bf16x8*)(Kt + (2 * d0 + hi) * 1024 + r32 * 16);
        const bf16x8 k1 = *(const LAS bf16x8*)(Kt + (2 * d0 + hi) * 1024 + 512 + r32 * 16);
        p0 = mfma32(k0, qB[d0], p0); p1 = mfma32(k1, qB[d0], p1);
    }
#if NSA_X1
    { f32x16 t0 = (f32x16){0.f, 0.f, 0.f, 0.f, 0.f, 0.f, 0.f, 0.f, 0.f, 0.f, 0.f, 0.f, 0.f, 0.f, 0.f, 0.f}, t1 = t0; asm volatile("" ::: "memory");
#pragma unroll
      for (int d0 = 0; d0 < 4; ++d0) {
        const bf16x8 k0 = *(const volatile LAS bf16x8*)(Kt + (2 * d0 + hi) * 1024 + r32 * 16);
        const bf16x8 k1 = *(const volatile LAS bf16x8*)(Kt + (2 * d0 + hi) * 1024 + 512 + r32 * 16);
        t0 = mfma32(k0, qB[d0], t0); t1 = mfma32(k1, qB[d0], t1); }
#pragma unroll
      for (int r = 0; r < 16; ++r) { p0[r] = 0.5f * (p0[r] + t0[r]); p1[r] = 0.5f * (p1[r] + t1[r]); } }
#endif
}
__device__ __forceinline__ void nsa_pv(const LAS unsigned char* Vt, int lane, int hi, const f32x16& p0, const f32x16& p1, f32x16& o0, f32x16& o1) {
    bf16x8 pB[4];
    { u32x4 t; t.x = cvt_pk_bf16(p0[0], p0[1]); t.y = cvt_pk_bf16(p0[2], p0[3]); t.z = cvt_pk_bf16(p0[4], p0[5]); t.w = cvt_pk_bf16(p0[6], p0[7]); pB[0] = __builtin_bit_cast(bf16x8, t);
      t.x = cvt_pk_bf16(p0[8], p0[9]); t.y = cvt_pk_bf16(p0[10], p0[11]); t.z = cvt_pk_bf16(p0[12], p0[13]); t.w = cvt_pk_bf16(p0[14], p0[15]); pB[1] = __builtin_bit_cast(bf16x8, t);
      t.x = cvt_pk_bf16(p1[0], p1[1]); t.y = cvt_pk_bf16(p1[2], p1[3]); t.z = cvt_pk_bf16(p1[4], p1[5]); t.w = cvt_pk_bf16(p1[6], p1[7]); pB[2] = __builtin_bit_cast(bf16x8, t);
      t.x = cvt_pk_bf16(p1[8], p1[9]); t.y = cvt_pk_bf16(p1[10], p1[11]); t.z = cvt_pk_bf16(p1[12], p1[13]); t.w = cvt_pk_bf16(p1[14], p1[15]); pB[3] = __builtin_bit_cast(bf16x8, t); }
    const LAS unsigned char* vb = Vt + (4 * hi + ((lane & 15) >> 2)) * 64 + ((lane >> 4) & 1) * 32 + (lane & 3) * 8;
#pragma unroll
    for (int ks = 0; ks < 4; ++ks) {
        const bf16x8 va0 = cat8(trrd(vb + ks * 1024), trrd(vb + ks * 1024 + 512));
        const bf16x8 va1 = cat8(trrd(vb + 4096 + ks * 1024), trrd(vb + 4096 + ks * 1024 + 512));
        o0 = mfma32(va0, pB[ks], o0); o1 = mfma32(va1, pB[ks], o1);
    }
}

template <int MODE>
__device__ __forceinline__ void nsa_smpv(LAS unsigned char* lds, int j, int buf, f32x16& p0, f32x16& p1, int qt, int ql, bool selq, const LAS float* biasH, int lane, int hi,
                                         float& m, float& l, f32x16& o0, f32x16& o1) {
    const int dj = qt - j, dq = 64 * dj + ql - 4 * hi;
    const bool near = dj <= 2, edge = (MODE == 2) && (dj == 8);
    if (near || edge) {
#pragma unroll
        for (int r = 0; r < 16; ++r) {
            const int d0 = dq - ((r & 3) + 8 * (r >> 2)), d1 = d0 - 32;
            const bool v0 = d0 >= 0 && (MODE == 1 || d0 < 512), v1 = d1 >= 0 && (MODE == 1 || d1 < 512);
            float b0 = 0.f, b1 = 0.f;
            if (near) { const int c0 = d0 < 0 ? 0 : (d0 > 127 ? 127 : d0), c1 = d1 < 0 ? 0 : (d1 > 127 ? 127 : d1); b0 = biasH[c0]; b1 = biasH[c1]; }
            p0[r] = v0 ? p0[r] + b0 : NEGBIG; p1[r] = v1 ? p1[r] + b1 : NEGBIG;
        }
    }
    float mx = fmaxf(p0[0], p1[0]);
#pragma unroll
    for (int r = 1; r < 16; ++r) mx = fmaxf(mx, fmaxf(p0[r], p1[r]));
    { auto rr = __builtin_amdgcn_permlane32_swap(__float_as_uint(mx), __float_as_uint(mx), false, false); mx = fmaxf(__uint_as_float(rr[0]), __uint_as_float(rr[1])); }
    mx = selq ? mx : NEGBIG;
    const float mn = fmaxf(m, mx), f = fexp2(m - mn), sub = selq ? mn : 3.0e38f; m = mn;
    float ls = 0.f;
#pragma unroll
    for (int r = 0; r < 16; ++r) {
#if NSA_X2
        float a0 = p0[r] - sub, a1 = p1[r] - sub; asm volatile("" : "+v"(a0), "+v"(a1)); const float e0 = fexp2(a0), e1 = fexp2(a1); a0 = p0[r] - sub; a1 = p1[r] - sub; asm volatile("" : "+v"(a0), "+v"(a1));
        p0[r] = 0.5f * (e0 + fexp2(a0)); p1[r] = 0.5f * (e1 + fexp2(a1)); ls += p0[r] + p1[r];
#else
        p0[r] = fexp2(p0[r] - sub); p1[r] = fexp2(p1[r] - sub); ls += p0[r] + p1[r];
#endif
    }
    l = l * f + ls;
    if (!__all(f == 1.f)) {
#pragma unroll
        for (int r = 0; r < 16; ++r) { o0[r] *= f; o1[r] *= f; }
    }
    nsa_pv(lds + NL_VT + buf * 8192, lane, hi, p0, p1, o0, o1);
}

template <int MODE>
__device__ __forceinline__ void nsa_branch(const Ctx& F, const bf16_t* Kg, const bf16_t* Vg, unsigned tiles, int qt, int ql, unsigned mysel,
                                           const LAS float* biasH, const bf16_t* qptr, float gate, f32x16& out0, f32x16& out1) {
    LAS unsigned char* lds = F.lds; int tid_ = F.tid; asm volatile("" : "+v"(tid_)); const int tid = tid_, lane = tid & 63, r32 = lane & 31, hi = lane >> 5;
    bf16x8 qB[4];
#pragma unroll
    for (int d0 = 0; d0 < 4; ++d0) qB[d0] = *(const bf16x8*)(qptr + 16 * d0);
    float m = NEGBIG, l = 0.f;
    f32x16 o0 = (f32x16){0.f, 0.f, 0.f, 0.f, 0.f, 0.f, 0.f, 0.f, 0.f, 0.f, 0.f, 0.f, 0.f, 0.f, 0.f, 0.f}, o1 = o0;
    const int w = F.wave; const bool grpA = w < 4;
    const unsigned lbase = (unsigned)(size_t)lds;
    const bf16_t* ksrc = Kg + (size_t)lane * LDP + 8 * w;
    const bf16_t* vsrc = Vg + (size_t)(16 * (w & 3) + (lane >> 2)) * LDP + (w >> 2) * 32 + (lane & 3) * 8;
    const unsigned kdst = (unsigned)__builtin_amdgcn_readfirstlane((int)(lbase + NL_KT + w * 1024)), vdst = (unsigned)__builtin_amdgcn_readfirstlane((int)(lbase + NL_VT + (w >> 2) * 4096 + (w & 3) * 1024));
#define NSA_DMA(jj, slot) do { glds16(ksrc + (size_t)(jj) * 64 * LDP, kdst + (slot) * 8192); glds16(vsrc + (size_t)(jj) * 64 * LDP, vdst + (slot) * 8192); } while (0)
#define NSA_POP(dst) do { if (rem) { dst = (MODE == 1) ? (__ffs(rem) - 1) : (31 - __clz(rem)); rem &= ~(1u << dst); } else dst = -1; } while (0)
    unsigned rem = tiles; int j, q1;
    NSA_POP(j); NSA_POP(q1);
    NSA_DMA(j, 0); if (q1 >= 0) NSA_DMA(q1, 1);
    int buf = 0, jp = -1, bufp = 0; bool selp = true, done = false, selq = true, act = false;
    f32x16 pp0 = o0, pp1 = o0;
    for (;;) {
        if (!done) {
            if (q1 >= 0) NSA_WAITBAR(2); else NSA_WAITBAR(0);
            int q2; NSA_POP(q2);
            if (q2 >= 0) NSA_DMA(q2, (buf + 2) & 3);
            selq = (MODE == 1) ? (((mysel >> j) & 1u) != 0u) : true;
            act = (MODE != 1) || __any(selq);
            if (grpA && act) { nsa_qk(lds + NL_KT + buf * 8192, qB, r32, hi, pp0, pp1); jp = j; bufp = buf; selp = selq; }
            if (jp >= 0) { nsa_smpv<MODE>(lds, jp, bufp, pp0, pp1, qt, ql, selp, biasH, lane, hi, m, l, o0, o1); jp = -1; }
            if (!grpA && act) { nsa_qk(lds + NL_KT + buf * 8192, qB, r32, hi, pp0, pp1); jp = j; bufp = buf; selp = selq; }
            if (q1 < 0) done = true; else { j = q1; q1 = q2; buf = (buf + 1) & 3; }
        } else {
            if (jp >= 0) nsa_smpv<MODE>(lds, jp, bufp, pp0, pp1, qt, ql, selp, biasH, lane, hi, m, l, o0, o1);
            break;
        }
    }
#undef NSA_DMA
#undef NSA_POP
    __syncthreads();
    const float lt = l + __shfl_xor(l, 32), sc = gate * frcp(lt);
#pragma unroll
    for (int r = 0; r < 16; ++r) { out0[r] += sc * o0[r]; out1[r] += sc * o1[r]; }
}

__device__ __forceinline__ void nsa_unit(const Ctx& F, int bl, int g, int qt, const bf16_t* P, const bf16_t* KC, const bf16_t* VC, const float* biasT, bf16_t* YB) {
    LAS unsigned char* lds = F.lds; int tid_ = F.tid; asm volatile("" : "+v"(tid_)); const int tid = tid_, lane = tid & 63, w = F.wave, r32 = lane & 31, hi = lane >> 5;
    const int h = w >> 1, ql = 32 * (w & 1) + r32, t = 64 * qt + ql;
    const size_t row = (size_t)bl * SEQ + t;
    ((LAS float*)(lds + NL_BIAS))[tid] = biasT[(g * 4 + (tid >> 7)) * 128 + (tid & 127)];
    if (tid == 0) *(LAS unsigned*)(lds + NL_UNI) = 0u;
    const bf16_t* qptr = P + row * LDP + C_Q + g * 256 + h * 64 + 8 * hi;
    const float g_c = sigmoidf_(bf1(P[row * LDP + C_NG + g * 4 + h])), g_s = sigmoidf_(bf1(P[row * LDP + C_NG + 8 + g * 4 + h])), g_w = sigmoidf_(bf1(P[row * LDP + C_NG + 16 + g * 4 + h]));
    const LAS float* biasH = (const LAS float*)(lds + NL_BIAS) + h * 128;
    f32x16 out0 = (f32x16){0.f, 0.f, 0.f, 0.f, 0.f, 0.f, 0.f, 0.f, 0.f, 0.f, 0.f, 0.f, 0.f, 0.f, 0.f, 0.f}, out1 = out0;

    const int ntile = (qt >= 16) ? 2 : 1;
    for (int tl = 0; tl < ntile; ++tl) {
        int nk = 64 * tl + (tid & 63); if (nk > 126) nk = 126;
        int nv = 64 * tl + (tid >> 3); if (nv > 126) nv = 126;
        const u32x4 kreg = *(const u32x4*)(KC + (size_t)(bl * 128 + nk) * 128 + g * 64 + 8 * (tid >> 6));
        const u32x4 vreg = *(const u32x4*)(VC + (size_t)(bl * 128 + nv) * 128 + g * 64 + 8 * (tid & 7));
        NSA_STORE_TILE(tl);
    }
    __syncthreads();
    {
        f32x16 s0, s1, s2, s3;
        { bf16x8 qB[4];
#pragma unroll
          for (int d0 = 0; d0 < 4; ++d0) qB[d0] = *(const bf16x8*)(qptr + 16 * d0);
          nsa_qk(lds + NL_KT, qB, r32, hi, s0, s1);
          if (ntile == 2) nsa_qk(lds + NL_KT + 8192, qB, r32, hi, s2, s3);
          else { s2 = (f32x16){0.f, 0.f, 0.f, 0.f, 0.f, 0.f, 0.f, 0.f, 0.f, 0.f, 0.f, 0.f, 0.f, 0.f, 0.f, 0.f}; s3 = s2; } }
        const int db = t - 31 - 64 * hi;
        float mx = NEGBIG;
#define CMP_MASK(S, V) _Pragma("unroll") for (int r = 0; r < 16; ++r) { const int d = db - 16 * (32 * (V) + (r & 3) + 8 * (r >> 2)); \
            const int c = d < 0 ? 0 : (d > 127 ? 127 : d); S[r] = (d >= 0) ? S[r] + biasH[c] : NEGBIG; mx = fmaxf(mx, S[r]); }
        CMP_MASK(s0, 0) CMP_MASK(s1, 1)
        if (ntile == 2) { CMP_MASK(s2, 2) CMP_MASK(s3, 3) }
#undef CMP_MASK
        mx = fmaxf(mx, __shfl_xor(mx, 32));
        float ls = 0.f;
#define CMP_EXP(S) _Pragma("unroll") for (int r = 0; r < 16; ++r) { S[r] = (S[r] > -1e29f) ? fexp2(S[r] - mx) : 0.f; ls += S[r]; }
        CMP_EXP(s0) CMP_EXP(s1)
        if (ntile == 2) { CMP_EXP(s2) CMP_EXP(s3) }
#undef CMP_EXP
        ls += __shfl_xor(ls, 32);
        const float inv = ls > 0.f ? 1.f / ls : 0.f;
#pragma unroll
        for (int r = 0; r < 16; ++r) { s0[r] *= inv; s1[r] *= inv; s2[r] *= inv; s3[r] *= inv; }
        LAS float* I = (LAS float*)(lds + NL_IMP) + (h * 64 + ql) * 33 + hi;
        float yprev = 0.f;
#define CMP_IMP(S, V) _Pragma("unroll") for (int a = 0; a < 4; ++a) { const float own = S[4 * a] + S[4 * a + 1] + S[4 * a + 2] + 0.5f * S[4 * a + 3]; \
            const float y = __shfl_xor(0.5f * S[4 * a + 3], 32); I[2 * (4 * (V) + a)] = own + (hi ? y : yprev); yprev = y; }
        CMP_IMP(s0, 0) CMP_IMP(s1, 1) CMP_IMP(s2, 2) CMP_IMP(s3, 3)
#undef CMP_IMP
        f32x16 o0 = (f32x16){0.f, 0.f, 0.f, 0.f, 0.f, 0.f, 0.f, 0.f, 0.f, 0.f, 0.f, 0.f, 0.f, 0.f, 0.f, 0.f}, o1 = o0;
        nsa_pv(lds + NL_VT, lane, hi, s0, s1, o0, o1);
        if (ntile == 2) nsa_pv(lds + NL_VT + 8192, lane, hi, s2, s3, o0, o1);
#pragma unroll
        for (int r = 0; r < 16; ++r) { out0[r] += g_c * o0[r]; out1[r] += g_c * o1[r]; }
    }
    __syncthreads();
    if (w == 0) {
        const LAS float* I = (const LAS float*)(lds + NL_IMP) + lane * 33;
        float v[32];
#pragma unroll
        for (int jj = 0; jj < 32; ++jj) v[jj] = (I[jj] + I[64 * 33 + jj]) + (I[128 * 33 + jj] + I[192 * 33 + jj]);
        unsigned sel = 1u | (1u << qt) | (qt >= 1 ? (1u << (qt - 1)) : 0u);
        const int need = 8 - __popc(sel);
#pragma unroll
        for (int it = 0; it < 5; ++it) {
            if (it < need) {
                int best = -1; float bv = -1e30f;
#pragma unroll
                for (int jj = 1; jj < 32; ++jj) { const bool ok = (jj <= qt - 2) && (((sel >> jj) & 1u) == 0u) && (v[jj] > bv); bv = ok ? v[jj] : bv; best = ok ? jj : best; }
                if (best >= 0) sel |= 1u << best;
            }
        }
        ((LAS unsigned*)(lds + NL_SEL))[lane] = sel;
        atomicOr((unsigned*)(lds + NL_UNI), sel);
    }
    __syncthreads();
    const unsigned uni = *(const LAS unsigned*)(lds + NL_UNI) & ((qt >= 31) ? 0xffffffffu : ((2u << qt) - 1u));
    const unsigned mysel = ((const LAS unsigned*)(lds + NL_SEL))[ql];
    const bf16_t* Pb = P + (size_t)bl * SEQ * LDP + C_KV + g * 64;
    nsa_branch<1>(F, Pb + 256, Pb + 384, uni, qt, ql, mysel, biasH, qptr, g_s, out0, out1);
    { const int lo = qt >= 8 ? qt - 8 : 0; const unsigned wm = (((qt >= 31) ? 0xffffffffu : ((2u << qt) - 1u)) >> lo) << lo;
      nsa_branch<2>(F, Pb + 512, Pb + 640, wm, qt, ql, 0u, biasH, qptr, g_w, out0, out1); }
    bf16_t* yo = YB + row * 1024 + 512 + g * 256 + h * 64 + 4 * hi;
#pragma unroll
    for (int a = 0; a < 4; ++a) {
        u32x2 w0; w0.x = cvt_pk_bf16(out0[4 * a], out0[4 * a + 1]); w0.y = cvt_pk_bf16(out0[4 * a + 2], out0[4 * a + 3]); *(u32x2*)(yo + 8 * a) = w0;
        u32x2 w1; w1.x = cvt_pk_bf16(out1[4 * a], out1[4 * a + 1]); w1.y = cvt_pk_bf16(out1[4 * a + 2], out1[4 * a + 3]); *(u32x2*)(yo + 32 + 8 * a) = w1;
    }
    __syncthreads();
}

#define LDS_BARRIER() asm volatile("s_waitcnt lgkmcnt(0)\n\ts_barrier" ::: "memory")
constexpr int SL_CT = 0, SL_BT = 34816, SL_XT = 69632, SL_XD = 77824, SL_XW = 86016, SL_HT = 94208, SL_YO = 102912, SL_AW = 119296, SL_DW = 123392;
__device__ __forceinline__ void ssd_diag(const LAS unsigned char* lds, const LAS float* A_, int si, int li, int r32, int hi, int q4, int p4, int g1, f32x16& y) {
    const int lidx = 32 * li + r32; const float acl = A_[lidx];
    f32x16 s = (f32x16){0.f, 0.f, 0.f, 0.f, 0.f, 0.f, 0.f, 0.f, 0.f, 0.f, 0.f, 0.f, 0.f, 0.f, 0.f, 0.f};
#pragma unroll
    for (int kk = 0; kk < 8; ++kk) {
        const bf16x8 aa = *(const LAS bf16x8*)(lds + SL_BT + (32 * si + r32) * 272 + (16 * kk + 8 * hi) * 2);
        const bf16x8 bb = *(const LAS bf16x8*)(lds + SL_CT + lidx * 272 + (16 * kk + 8 * hi) * 2);
        s = mfma32(aa, bb, s);
    }
#pragma unroll
    for (int r = 0; r < 16; ++r) { const int sidx = 32 * si + crow(r, hi); const float e = fexp2(acl - A_[sidx]); s[r] = (sidx <= lidx) ? s[r] * e : 0.f; }
    u32x4 t0, t1;
    t0.x = cvt_pk_bf16(s[0], s[1]); t0.y = cvt_pk_bf16(s[2], s[3]); t0.z = cvt_pk_bf16(s[4], s[5]); t0.w = cvt_pk_bf16(s[6], s[7]);
    t1.x = cvt_pk_bf16(s[8], s[9]); t1.y = cvt_pk_bf16(s[10], s[11]); t1.z = cvt_pk_bf16(s[12], s[13]); t1.w = cvt_pk_bf16(s[14], s[15]);
    const LAS unsigned char* xb = lds + SL_XD + (32 * si + 4 * hi + q4) * 64 + g1 * 32 + p4 * 8;
    y = mfma32(cat8(trrd(xb), trrd(xb + 512)), __builtin_bit_cast(bf16x8, t0), y);
    y = mfma32(cat8(trrd(xb + 1024), trrd(xb + 1536)), __builtin_bit_cast(bf16x8, t1), y);
}
__device__ __forceinline__ void ssd_yoff(const LAS unsigned char* lds, const LAS float* A_, int li, int r32, int hi, f32x16& y) {
    const int lidx = 32 * li + r32;
#pragma unroll
    for (int kk = 0; kk < 8; ++kk) {
        const bf16x8 aa = *(const LAS bf16x8*)(lds + SL_HT + r32 * 272 + (16 * kk + 8 * hi) * 2);
        const bf16x8 bb = *(const LAS bf16x8*)(lds + SL_CT + lidx * 272 + (16 * kk + 8 * hi) * 2);
        y = mfma32(aa, bb, y);
    }
    const float el = fexp2(A_[lidx]);
#pragma unroll
    for (int r = 0; r < 16; ++r) y[r] *= el;
}
__device__ __forceinline__ void ssd_unit(const Ctx& F, int bl, int hd, int ph, const bf16_t* P, const bf16_t* XC, float dtb, float Aneg, float Dh, bf16_t* YP) {
    LAS unsigned char* lds = F.lds; int tid_ = F.tid; asm volatile("" : "+v"(tid_)); const int tid = tid_, lane = tid & 63, w = F.wave, r32 = lane & 31, hi = lane >> 5;
    const int g = hd >> 2, p0 = 32 * ph; const size_t rowb = (size_t)bl * SEQ;
    const int q4 = (lane & 15) >> 2, p4 = lane & 3, g1 = (lane >> 4) & 1;
    LAS float* A_ = (LAS float*)(lds + SL_AW) + w * 128; LAS float* D_ = (LAS float*)(lds + SL_DW) + w * 128;
    u32x4 creg[4], breg[4], xreg; float dt0 = 0.f, dt1 = 0.f;
#define SSD_LOAD(ch) do { const bf16_t* xc = XC + (rowb + (size_t)(ch) * 128) * 2048; \
        _Pragma("unroll") for (int i = 0; i < 4; ++i) { const int r = (tid >> 4) + 32 * i; \
            creg[i] = *(const u32x4*)(xc + (size_t)r * 2048 + 1536 + g * 128 + 8 * (tid & 15)); breg[i] = *(const u32x4*)(xc + (size_t)r * 2048 + 1024 + g * 128 + 8 * (tid & 15)); } \
        xreg = *(const u32x4*)(xc + (size_t)(tid >> 2) * 2048 + hd * 64 + p0 + 8 * (tid & 3)); \
        dt0 = bf1(P[(rowb + (size_t)(ch) * 128 + 2 * lane) * LDP + C_DT + hd]); dt1 = bf1(P[(rowb + (size_t)(ch) * 128 + 2 * lane + 1) * LDP + C_DT + hd]); } while (0)
    f32x16 hs = (f32x16){0.f, 0.f, 0.f, 0.f, 0.f, 0.f, 0.f, 0.f, 0.f, 0.f, 0.f, 0.f, 0.f, 0.f, 0.f, 0.f};
    SSD_LOAD(0);
    for (int ch = 0; ch < 16; ++ch) {
        { float x0 = dt0 + dtb, x1 = dt1 + dtb; const float v0 = x0 > 15.f ? x0 : __logf(1.f + __expf(x0)), v1 = x1 > 15.f ? x1 : __logf(1.f + __expf(x1));
          const float a0 = v0 * Aneg * LOG2E, a1 = v1 * Aneg * LOG2E; float sc = a0 + a1;
#pragma unroll
          for (int o = 1; o < 64; o <<= 1) { const float tt = __shfl_up(sc, o); if (lane >= o) sc += tt; }
          A_[2 * lane] = sc - a1; A_[2 * lane + 1] = sc; D_[2 * lane] = v0; D_[2 * lane + 1] = v1; }
#pragma unroll
        for (int i = 0; i < 4; ++i) { const int r = (tid >> 4) + 32 * i;
            *(LAS u32x4*)(lds + SL_CT + r * 272 + (tid & 15) * 16) = creg[i]; *(LAS u32x4*)(lds + SL_BT + r * 272 + (tid & 15) * 16) = breg[i]; }
        *(LAS u32x4*)(lds + SL_XT + (tid >> 2) * 64 + (tid & 3) * 16) = xreg;
        { const int lrow = tid >> 2; const float dl = D_[lrow], wl = dl * fexp2(A_[127] - A_[lrow]);
          float x[8], xd[8], xw[8]; unpack8(xreg, x);
#pragma unroll
          for (int i = 0; i < 8; ++i) { xd[i] = x[i] * dl; xw[i] = x[i] * wl; }
          *(LAS u32x4*)(lds + SL_XD + lrow * 64 + (tid & 3) * 16) = pack8(xd); *(LAS u32x4*)(lds + SL_XW + lrow * 64 + (tid & 3) * 16) = pack8(xw); }
        if (w >= 4) {
#pragma unroll
            for (int a = 0; a < 4; ++a) { u32x2 t; t.x = cvt_pk_bf16(hs[4 * a], hs[4 * a + 1]); t.y = cvt_pk_bf16(hs[4 * a + 2], hs[4 * a + 3]);
                *(LAS u32x2*)(lds + SL_HT + r32 * 272 + (32 * (w - 4) + 8 * a + 4 * hi) * 2) = t; }
        }
        if (ch + 1 < 16) SSD_LOAD(ch + 1);
        LDS_BARRIER();
        f32x16 y = (f32x16){0.f, 0.f, 0.f, 0.f, 0.f, 0.f, 0.f, 0.f, 0.f, 0.f, 0.f, 0.f, 0.f, 0.f, 0.f, 0.f};
        {
            const int li_ = (w == 0) ? 0 : (w == 1 || w == 7) ? 1 : (w == 2 || w == 5) ? 2 : 3;
            const int si0 = (w == 4 || w == 5) ? 2 : (w == 6) ? 3 : 0;
            const int nd = (w == 7) ? 0 : (w >= 1 && w <= 3) ? 2 : 1;
            const int yo = (w == 0) ? 0 : (w == 4) ? 3 : (w == 5) ? 2 : (w == 7) ? 1 : -1;
            if (yo >= 0) ssd_yoff(lds, A_, yo, r32, hi, y);
#pragma unroll 1
            for (int d = 0; d < nd; ++d) ssd_diag(lds, A_, si0 + d, li_, r32, hi, q4, p4, g1, y);
        }
        if (w >= 4) {
            const int wi = w - 4;
            { const int slot = (w == 7) ? 0 : (w == 5) ? 1 : (w == 4) ? 2 : 3;
#pragma unroll
              for (int r = 0; r < 16; ++r) *(LAS float*)(lds + SL_YO + slot * 4096 + r * 256 + lane * 4) = y[r]; }
            const float dec = fexp2(A_[127]);
#pragma unroll
            for (int r = 0; r < 16; ++r) hs[r] *= dec;
#pragma unroll
            for (int kk = 0; kk < 8; ++kk) {
                const LAS unsigned char* ab = lds + SL_BT + (16 * kk + 8 * hi + q4) * 272 + (32 * wi + 16 * g1 + 4 * p4) * 2;
                const LAS unsigned char* bb = lds + SL_XW + (16 * kk + 8 * hi + q4) * 64 + g1 * 32 + p4 * 8;
                hs = mfma32(cat8(trrd(ab), trrd(ab + 4 * 272)), cat8(trrd(bb), trrd(bb + 256)), hs);
            }
        }
        LDS_BARRIER();
        if (w < 4) {
            const int li = w; bf16_t* yp = YP + (rowb + (size_t)ch * 128 + 32 * li + r32) * 1024 + hd * 64 + p0 + 4 * hi;
#pragma unroll
            for (int a = 0; a < 4; ++a) {
                const u32x2 xr = *(const LAS u32x2*)(lds + SL_XT + (32 * li + r32) * 64 + (8 * a + 4 * hi) * 2);
                float v[4] = {y[4 * a] + Dh * bflo(xr.x), y[4 * a + 1] + Dh * bfhi(xr.x), y[4 * a + 2] + Dh * bflo(xr.y), y[4 * a + 3] + Dh * bfhi(xr.y)};
                if (li >= 1) {
#pragma unroll
                    for (int i = 0; i < 4; ++i) v[i] += *(const LAS float*)(lds + SL_YO + (li - 1) * 4096 + (4 * a + i) * 256 + lane * 4);
                }
                if (li == 3) {
#pragma unroll
                    for (int i = 0; i < 4; ++i) v[i] += *(const LAS float*)(lds + SL_YO + 3 * 4096 + (4 * a + i) * 256 + lane * 4);
                }
                u32x2 o; o.x = cvt_pk_bf16(v[0], v[1]); o.y = cvt_pk_bf16(v[2], v[3]); *(u32x2*)(yp + 8 * a) = o;
            }
        }
        LDS_BARRIER();
    }
#undef SSD_LOAD
}

__device__ __forceinline__ void attn_phase(const Ctx& F, ArgsP a, int l, int gi) {
    LAS unsigned char* lds = F.lds;
    const bf16_t* P = (const bf16_t*)(a->ws + WS_ARENA + AR_P);
    const bf16_t* XC = (const bf16_t*)(F.dout + DO_XC);
    bf16_t* YP = (bf16_t*)(F.dout + DO_YC); bf16_t* YB = (bf16_t*)(F.dout + DO_R);
    const bf16_t* KC = (const bf16_t*)(a->ws + WS_MISC + MI_KC); const bf16_t* VC = (const bf16_t*)(a->ws + WS_MISC + MI_VC);
    const float* biasT = (const float*)(a->ws + WS_MISC + MI_BIAS);
    unsigned* ctr = F.ctl + CW_WQ + 64 * (l * NG + gi);
    constexpr int NSSD = BG * 16 * 2, NNSA = BG * 2 * 32;
    for (int item = F.vcu; item < NSSD; item += F.G) {
        const int bl = item >> 5, hd = (item >> 1) & 15, ph = item & 1;
        for (int rr_ = 0; rr_ <= SSD_REP; ++rr_) ssd_unit(F, bl, hd, ph, P, XC, a->in[I_DTB][l * 16 + hd], -__expf(a->in[I_ALOG][l * 16 + hd]), a->in[I_DSKIP][l * 16 + hd], YP);
    }
    for (;;) {
        if (F.tid == 0) *(LAS int*)(lds + LDSX + LX_WQ) = (int)__hip_atomic_fetch_add(ctr, 1u, __ATOMIC_RELAXED, __HIP_MEMORY_SCOPE_AGENT);
        __syncthreads();
        const int idx = *(const LAS int*)(lds + LDSX + LX_WQ);
        __syncthreads();
        if (idx >= NNSA) break;
        const int qt = 31 - (idx >> 4), bg = idx & 15;
        for (int rr_ = 0; rr_ <= NSA_REP; ++rr_) nsa_unit(F, bg >> 1, bg & 1, qt, P, KC, VC, biasT, YB);
    }
}


constexpr int RL_HI = 0, RL_LO = 33024, RL_GB = 66048, RL_LG = 74240, RL_ROWSTRIDE = 2064;
__device__ __forceinline__ void ln1_route_phase(const Ctx& F, ArgsP a, int l) {
    LAS unsigned char* lds = F.lds; const int tid = F.tid, lane = F.lane, w = F.wave, fr = lane & 15, q = lane >> 4;
    LAS int* lcnt = (LAS int*)(lds + LDSX + LX_CNTL); LAS int* lbase = (LAS int*)(lds + LDSX + LX_BASE); LAS int* rows = (LAS int*)(lds + LDSX + LX_ROWS);
    for (int i = tid; i < 16384; i += 512) { const float x = a->in[I_RW][i]; const bf16_t hi = f2bf(x); const bf16_t lo = f2bf(x - bf1(hi)); const int d = i >> 4, e = i & 15;
        *(LAS bf16_t*)(lds + RL_HI + e * RL_ROWSTRIDE + d * 2) = hi; *(LAS bf16_t*)(lds + RL_LO + e * RL_ROWSTRIDE + d * 2) = lo; }
    { LAS float* GB = (LAS float*)(lds + RL_GB); for (int i = tid; i < 1024; i += 512) { GB[i] = a->in[I_LN1G][l * DM + i]; GB[1024 + i] = a->in[I_LN1B][l * DM + i]; } }
    bf16_t* H1 = (bf16_t*)(a->ws + WS_PRE1);
    float rb[16];
#pragma unroll
    for (int e = 0; e < 16; ++e) rb[e] = a->in[I_RB][e];
    unsigned* gcnt = F.ctl + CW_CNT + 64 * l;
    int* rtok = (int*)(a->ws + WS_ARENA + AR_RTOK); int2* rinfo = (int2*)(a->ws + WS_ARENA + AR_RINFO);
    for (int rb0 = blockIdx.x * 128; rb0 < T_; rb0 += F.G * 128) {
        if (tid < 16) lcnt[tid] = 0;
        __syncthreads();
        {
            bf16_t* rowp = H1 + ((size_t)rb0 + w * 16 + fr) * DM + 8 * q;
            float s = 0.f, ss = 0.f;
#pragma unroll 8
            for (int kk = 0; kk < 32; ++kk) { float x[8]; unpack8(*(const u32x4*)(rowp + 32 * kk), x);
#pragma unroll
                for (int j = 0; j < 8; ++j) { s += x[j]; ss += x[j] * x[j]; } }
            s += __shfl_xor(s, 16); s += __shfl_xor(s, 32); ss += __shfl_xor(ss, 16); ss += __shfl_xor(ss, 32);
            const float mean = s * (1.f / DM), rstd = 1.f / sqrtf(fmaxf(ss * (1.f / DM) - mean * mean, 0.f) + LN_EPS);
            f32x4 acc = {0.f, 0.f, 0.f, 0.f};
            const LAS float* GB = (const LAS float*)(lds + RL_GB);
#pragma unroll 2
            for (int kk = 0; kk < 32; ++kk) {
                float x[8], lo[8]; unpack8(*(const u32x4*)(rowp + 32 * kk), x);
                const f32x4 g0 = *(const LAS f32x4*)(GB + 32 * kk + 8 * q), g1 = *(const LAS f32x4*)(GB + 32 * kk + 8 * q + 4);
                const f32x4 b0 = *(const LAS f32x4*)(GB + 1024 + 32 * kk + 8 * q), b1 = *(const LAS f32x4*)(GB + 1024 + 32 * kk + 8 * q + 4);
#pragma unroll
                for (int j = 0; j < 4; ++j) { x[j] = (x[j] - mean) * rstd * g0[j] + b0[j]; x[4 + j] = (x[4 + j] - mean) * rstd * g1[j] + b1[j]; }
                const u32x4 hp = pack8(x);
                *(u32x4*)(rowp + 32 * kk) = hp;
                *(u32x2*)(a->ws + WS_H18 + ((size_t)rb0 + w * 16 + fr) * DM + 8 * q + 32 * kk) = pack8_i8(x, ASCALE);
                { float hf[8]; unpack8(hp, hf);
#pragma unroll
                  for (int j = 0; j < 8; ++j) lo[j] = x[j] - hf[j]; }
                const bf16x8 ahi = __builtin_bit_cast(bf16x8, hp), alo = __builtin_bit_cast(bf16x8, pack8(lo));
                const bf16x8 bhi = *(const LAS bf16x8*)(lds + RL_HI + fr * RL_ROWSTRIDE + (32 * kk + 8 * q) * 2), blo = *(const LAS bf16x8*)(lds + RL_LO + fr * RL_ROWSTRIDE + (32 * kk + 8 * q) * 2);
                acc = mfma16(ahi, bhi, acc); acc = mfma16(ahi, blo, acc); acc = mfma16(alo, bhi, acc);
                asm volatile("" ::: "memory");
            }
            LAS float* LG = (LAS float*)(lds + RL_LG) + w * 256;
#pragma unroll
            for (int r = 0; r < 4; ++r) LG[(4 * q + r) * 16 + fr] = acc[r];
        }
        LDS_WAIT();
        if (lane < 16) {
            const LAS float* LG = (const LAS float*)(lds + RL_LG) + w * 256 + lane * 16;
            float lg[16];
#pragma unroll
            for (int e4 = 0; e4 < 4; ++e4) { const f32x4 t = *(const LAS f32x4*)(LG + 4 * e4); lg[4 * e4] = t[0]; lg[4 * e4 + 1] = t[1]; lg[4 * e4 + 2] = t[2]; lg[4 * e4 + 3] = t[3]; }
            float mx = lg[0];
#pragma unroll
            for (int e = 1; e < 16; ++e) mx = fmaxf(mx, lg[e]);
            float pr[16], ps = 0.f;
#pragma unroll
            for (int e = 0; e < 16; ++e) { pr[e] = __expf(lg[e] - mx); ps += pr[e]; }
            const float pinv = 1.f / ps;
            float sc[16];
#pragma unroll
            for (int e = 0; e < 16; ++e) { pr[e] *= pinv; sc[e] = pr[e] + rb[e]; }
            int grp = 0; float gbest = -1e30f;
#pragma unroll
            for (int qq = 0; qq < 4; ++qq) {
                const float s0 = sc[4 * qq], s1 = sc[4 * qq + 1], s2_ = sc[4 * qq + 2], s3 = sc[4 * qq + 3];
                const float tot = (s0 + s1) + (s2_ + s3), mn1 = fminf(fminf(s0, s1), fminf(s2_, s3));
                const float m2 = fminf(fminf(fminf(fmaxf(s0, s1), fmaxf(s0, s2_)), fminf(fmaxf(s0, s3), fmaxf(s1, s2_))), fminf(fmaxf(s1, s3), fmaxf(s2_, s3)));
                const float top2 = tot - mn1 - m2;
                if (top2 > gbest) { gbest = top2; grp = qq; }
            }
            float c0 = 0.f, c1 = 0.f, c2 = 0.f, c3 = 0.f, q0 = 0.f, q1 = 0.f, q2 = 0.f, q3 = 0.f;
#pragma unroll
            for (int qq = 0; qq < 4; ++qq) if (grp == qq) { c0 = sc[4 * qq]; c1 = sc[4 * qq + 1]; c2 = sc[4 * qq + 2]; c3 = sc[4 * qq + 3]; q0 = pr[4 * qq]; q1 = pr[4 * qq + 1]; q2 = pr[4 * qq + 2]; q3 = pr[4 * qq + 3]; }
            int i0 = 0; float b0 = c0; if (c1 > b0) { b0 = c1; i0 = 1; } if (c2 > b0) { b0 = c2; i0 = 2; } if (c3 > b0) { b0 = c3; i0 = 3; }
            int i1 = -1; float b1 = -1e30f;
            if (i0 != 0 && c0 > b1) { b1 = c0; i1 = 0; } if (i0 != 1 && c1 > b1) { b1 = c1; i1 = 1; } if (i0 != 2 && c2 > b1) { b1 = c2; i1 = 2; } if (i0 != 3 && c3 > b1) { b1 = c3; i1 = 3; }
            const float w0 = (i0 == 0) ? q0 : (i0 == 1) ? q1 : (i0 == 2) ? q2 : q3, w1 = (i1 == 0) ? q0 : (i1 == 1) ? q1 : (i1 == 2) ? q2 : q3;
            const float wn = 1.f / (w0 + w1);
            const int e0 = 4 * grp + i0, e1 = 4 * grp + i1, rl = w * 16 + lane;
            const int pos0 = atomicAdd((int*)(lds + LDSX + LX_CNTL) + e0, 1), pos1 = atomicAdd((int*)(lds + LDSX + LX_CNTL) + e1, 1);
            rows[rl * 8 + 0] = e0; rows[rl * 8 + 1] = e1; rows[rl * 8 + 2] = pos0; rows[rl * 8 + 3] = pos1; rows[rl * 8 + 4] = __float_as_int(w0 * wn); rows[rl * 8 + 5] = __float_as_int(w1 * wn);
        }
        __syncthreads();
        if (tid < 16) lbase[tid] = (int)__hip_atomic_fetch_add(gcnt + tid, (unsigned)lcnt[tid], __ATOMIC_RELAXED, __HIP_MEMORY_SCOPE_AGENT);
        __syncthreads();
        if (tid < 128) {
            const int e0 = rows[tid * 8], e1 = rows[tid * 8 + 1]; const int t = rb0 + tid;
            const int p0 = e0 * ECAP + lbase[e0] + rows[tid * 8 + 2], p1 = e1 * ECAP + lbase[e1] + rows[tid * 8 + 3];
            rtok[p0] = t; rinfo[p0] = make_int2(t, rows[tid * 8 + 4]); rtok[p1] = t; rinfo[p1] = make_int2(T_ + t, rows[tid * 8 + 5]);
        }
        __syncthreads();
    }
}

__device__ __forceinline__ int moe_tables(const Ctx& F, int l, const int* rtok) {
    LAS int* off = (LAS int*)(F.lds + LDSX + LX_OFF); LAS int* ecnt = (LAS int*)(F.lds + LDSX + LX_ECNT); LAS int* tile_e = (LAS int*)(F.lds + LDSX + LX_TILE); LAS int* gidx = (LAS int*)(F.lds + LDSX + LX_GIDX);
    __syncthreads();
    if (F.tid == 0) { int o = 0;
        for (int e = 0; e < 16; ++e) { off[e] = o; const int c = (int)__hip_atomic_load(F.ctl + CW_CNT + 64 * l + e, __ATOMIC_RELAXED, __HIP_MEMORY_SCOPE_AGENT); ecnt[e] = c; const int nt = (c + 255) >> 8;
            for (int k = 0; k < nt; ++k) tile_e[(o >> 8) + k] = e; o += nt << 8; }
        off[16] = o; }
    __syncthreads();
    const int nrt = off[16] >> 8;
    if (rtok) {
        for (int i = 0; i < 8; ++i) { const long L = (long)i * F.G + F.vcu; if (L >= (long)nrt * 4) break;
            const int rt = (int)(L >> 2), e = tile_e[rt], k0 = rt * 256 - off[e], c = ecnt[e];
            if (F.tid < 256) gidx[i * 256 + F.tid] = (k0 + F.tid < c) ? rtok[e * ECAP + k0 + F.tid] : 0; }
        __syncthreads();
    }
    return nrt;
}
__device__ __forceinline__ void ln2_phase(const Ctx& F, ArgsP a, int l, bool last) {
    const bf16_t* H1 = (const bf16_t*)(a->ws + WS_PRE1); const bf16_t* YS = (const bf16_t*)(a->ws + WS_ARENA + AR_XS);
    bf16_t* H = (bf16_t*)(a->ws + WS_H); float* OUT = a->out;
    const float* g = a->in[I_LN2G] + l * DM; const float* b = a->in[I_LN2B] + l * DM; const int lane = F.lane;
    float gg[16], bb[16];
#pragma unroll
    for (int i = 0; i < 8; ++i) { gg[i] = g[8 * lane + i]; gg[8 + i] = g[512 + 8 * lane + i]; bb[i] = b[8 * lane + i]; bb[8 + i] = b[512 + 8 * lane + i]; }
    u32x4 nx[6];
#define LN2_LOAD(t_) do { _Pragma("unroll") for (int hf = 0; hf < 2; ++hf) { nx[3 * hf] = *(const u32x4*)(H1 + (size_t)(t_) * DM + 512 * hf + 8 * lane); \
        nx[3 * hf + 1] = *(const u32x4*)(YS + (size_t)(t_) * DM + 512 * hf + 8 * lane); nx[3 * hf + 2] = *(const u32x4*)(YS + (size_t)(T_ + (t_)) * DM + 512 * hf + 8 * lane); } } while (0)
    LN2_LOAD(F.gw);
    for (int t = F.gw; t < T_; t += F.NGW) {
        float v[16];
        u32x4 cur[6];
#pragma unroll
        for (int i = 0; i < 6; ++i) cur[i] = nx[i];
        if (t + F.NGW < T_) LN2_LOAD(t + F.NGW);
#pragma unroll
        for (int hf = 0; hf < 2; ++hf) { float x[8], y0[8], y1[8];
            unpack8(cur[3 * hf], x);
            unpack8(cur[3 * hf + 1], y0);
            unpack8(cur[3 * hf + 2], y1);
#pragma unroll
            for (int i = 0; i < 8; ++i) v[8 * hf + i] = DN_ALPHA * x[i] + (y0[i] + y1[i]); }
        float s = 0.f;
#pragma unroll
        for (int i = 0; i < 16; ++i) s += v[i];
        const float mean = wave_sum(s) * (1.f / DM); float s2 = 0.f;
#pragma unroll
        for (int i = 0; i < 16; ++i) { v[i] -= mean; s2 += v[i] * v[i]; }
        const float rstd = 1.f / sqrtf(wave_sum(s2) * (1.f / DM) + LN_EPS);
#pragma unroll
        for (int i = 0; i < 16; ++i) v[i] = v[i] * rstd * gg[i] + bb[i];
        if (last) {
#pragma unroll
            for (int hf = 0; hf < 2; ++hf) { float* o = OUT + (size_t)t * DM + 512 * hf + 8 * lane;
                *(f32x4*)o = (f32x4){v[8 * hf], v[8 * hf + 1], v[8 * hf + 2], v[8 * hf + 3]}; *(f32x4*)(o + 4) = (f32x4){v[8 * hf + 4], v[8 * hf + 5], v[8 * hf + 6], v[8 * hf + 7]}; }
        } else {
#pragma unroll
            for (int hf = 0; hf < 2; ++hf) { float tt[8];
#pragma unroll
                for (int i = 0; i < 8; ++i) tt[i] = v[8 * hf + i];
                *(u32x4*)(H + (size_t)t * DM + 512 * hf + 8 * lane) = pack8(tt);
                *(u32x2*)(a->ws + WS_H8 + (size_t)t * DM + 512 * hf + 8 * lane) = pack8_i8(tt, ASCALE); }
        }
    }
}

#ifndef REP_MASK
#define REP_MASK 0
#endif
#ifndef PH_MASK
#define PH_MASK 0xfff
#endif
constexpr int NSTEPS = 1 + DEPTH * (NG * 6 + 4);
__global__ void __launch_bounds__(512, 2) fwd_kernel(Args a_unused) {
    const ArgsP a = (ArgsP)__builtin_amdgcn_kernarg_segment_ptr();
    extern __shared__ __attribute__((aligned(16))) unsigned char smem[];
    const int wave0_ = __builtin_amdgcn_readfirstlane((int)threadIdx.x >> 6);
    Ctx F;
#define MKCTX do { int t_; asm volatile("v_mbcnt_lo_u32_b32 %0, -1, 0\n\tv_mbcnt_hi_u32_b32 %0, -1, %0" : "=v"(t_)); t_ += wave0_ * 64; F.lds = (LAS unsigned char*)smem; F.tid = t_; F.lane = t_ & 63; F.wave = wave0_; \
        F.G = gridDim.x; { const int bx = blockIdx.x; F.vcu = (F.G % 8 == 0) ? (bx % 8) * (F.G / 8) + bx / 8 : bx; } \
        F.gw = blockIdx.x * 8 + F.wave; F.NGW = F.G * 8; F.ws = a->ws; F.dout = (unsigned char*)a->out; F.ctl = (unsigned*)(a->ws + WS_CTL); } while (0)
    MKCTX;
    for (int u = F.tid; u < (LDS_TOTAL - LDSX) / 4; u += 512) ((LAS unsigned*)(F.lds + LDSX))[u] = 0u;
    __syncthreads();
    const bool multi = (a->hi - a->lo) > 1;
    XcdBarrier bar; bar.bar = F.ctl + CW_BAR; bar.x = 0; bar.st = (volatile LAS unsigned*)(F.lds + LDSX + LX_BAR);
    if (multi) bar = xcd_barrier_post(F.ctl + CW_BAR, (volatile LAS unsigned*)(F.lds + LDSX + LX_BAR), F.tid);
    int step = 0;
#define RUN_STEP (step >= a->lo && step < a->hi)
#ifndef BAR_REP
#define BAR_REP 0
#endif
#define END_STEP do { if (RUN_STEP && step + 1 < a->hi) { xcd_barrier(bar, F.tid); if (BAR_REP) xcd_barrier(bar, F.tid); } ++step; } while (0)

    if (RUN_STEP && ((PH_MASK >> 0) & 1)) for (int rep_ = 0; rep_ <= ((REP_MASK >> 0) & 1); ++rep_) { MKCTX; p0_prologue(F, a); }
    END_STEP;

    {
        unsigned char* wl = a->ws + WS_W + (size_t)0 * W_LAYER;
        bf16_t* Hb = (bf16_t*)(a->ws + WS_H);
        bf16_t* P = (bf16_t*)(a->ws + WS_ARENA + AR_P);
        {
            const bf16_t* Hg = Hb + (size_t)0 * TG * DM;
            if (RUN_STEP && ((PH_MASK >> 1) & 1)) for (int rep_ = 0; rep_ <= ((REP_MASK >> 1) & 1); ++rep_) { MKCTX;
                pg8::Gemm g{(const bf16_t*)(a->ws + WS_H8 + (size_t)0 * TG * DM), (const bf16_t*)(wl + WO_IN), 512, 512, 512}; pg8::StaticOrder S; S.init(TG, LDP, 512, 512, F.G, (int)blockIdx.x, 512);
                pg8::Epi<pg8::EK_PROJ> E{P, LDP, nullptr, 0, nullptr, nullptr, nullptr, 1.f / (WSCALE * ASCALE)};
                pg8::gemm_phase<pg8::Epi<pg8::EK_PROJ>, pg8::StaticOrder, false, true>(F.lds, F.tid, g, S, E);
            }
            END_STEP;
            if (RUN_STEP && ((PH_MASK >> 2) & 1)) for (int rep_ = 0; rep_ <= ((REP_MASK >> 2) & 1); ++rep_) { MKCTX;
                for (int cu = blockIdx.x; cu < BG * 32; cu += F.G)
                    compress_unit(F, cu, P, (const bf16_t*)(wl + WO_W1), (const bf16_t*)(wl + WO_W2), (const float*)(a->ws + WS_MISC + MI_B1) + 0 * 256,
                                  (bf16_t*)(a->ws + WS_MISC + MI_KC), (bf16_t*)(a->ws + WS_MISC + MI_VC));
                conv_phase(F, P, (bf16_t*)(F.dout + DO_XC), a->in[I_CONVW] + (size_t)0 * 4 * 2048, a->in[I_CONVB] + (size_t)0 * 2048);
            }
            END_STEP;
            if (RUN_STEP && ((PH_MASK >> 3) & 1)) for (int rep_ = 0; rep_ <= ((REP_MASK >> 3) & 1); ++rep_) { MKCTX; attn_phase(F, a, 0, 0 + 4 * rep_); }
            END_STEP;
            if (RUN_STEP && ((PH_MASK >> 4) & 1)) for (int rep_ = 0; rep_ <= ((REP_MASK >> 4) & 1); ++rep_) { MKCTX; fin_phase(F, P, (bf16_t*)(F.dout + DO_R), (bf16_t*)(F.dout + DO_YC), a->in[I_SNG] + (size_t)0 * DM); }
            END_STEP;
            if (RUN_STEP && ((PH_MASK >> 5) & 1)) for (int rep_ = 0; rep_ <= ((REP_MASK >> 5) & 1); ++rep_) { MKCTX;
                bf16_t* GT = (bf16_t*)(a->ws + WS_ARENA + AR_GATES); bf16_t* MX = (bf16_t*)(a->ws + WS_ARENA + AR_MIXIN); float* TMP = (float*)(F.dout + DO_TMP);
                pg8::Gemm g{nullptr, nullptr, DM, DM, DM};
                pg8::S5Order S; S.so.init(TG, DM, DM, DM, F.G, (int)blockIdx.x);
                S.aH = (long)(size_t)Hg; S.aRY = (long)(size_t)(F.dout + DO_R); S.aYC = (long)(size_t)(F.dout + DO_YC);
                S.bG = (long)(size_t)(wl + WO_GATE); S.bCN = (long)(size_t)(wl + WO_C); S.bS = (long)(size_t)(wl + WO_SSD);
                pg8::Epi<pg8::EK_S5> E{GT, 3072, nullptr, 0, TMP, nullptr, MX, 1.f};
                pg8::gemm_phase(F.lds, F.tid, g, S, E);
            }
            END_STEP;
            if (RUN_STEP && ((PH_MASK >> 6) & 1)) for (int rep_ = 0; rep_ <= ((REP_MASK >> 6) & 1); ++rep_) { MKCTX;
                pg8::Gemm g{(const bf16_t*)(a->ws + WS_ARENA + AR_MIXIN), (const bf16_t*)(wl + WO_OUT), DM, DM, DM}; pg8::StaticOrder S; S.init(TG, DM, DM, DM, F.G, (int)blockIdx.x);
                pg8::Epi<pg8::EK_WOUT> E{(bf16_t*)(a->ws + WS_PRE1) + (size_t)0 * TG * DM, DM, Hg, DM, nullptr, nullptr, nullptr, 1.f};
                pg8::gemm_phase(F.lds, F.tid, g, S, E);
            }
            END_STEP;
        }
        {
            const bf16_t* Hg = Hb + (size_t)1 * TG * DM;
            if (RUN_STEP && ((PH_MASK >> 1) & 1)) for (int rep_ = 0; rep_ <= ((REP_MASK >> 1) & 1); ++rep_) { MKCTX;
                pg8::Gemm g{(const bf16_t*)(a->ws + WS_H8 + (size_t)1 * TG * DM), (const bf16_t*)(wl + WO_IN), 512, 512, 512}; pg8::StaticOrder S; S.init(TG, LDP, 512, 512, F.G, (int)blockIdx.x, 512);
                pg8::Epi<pg8::EK_PROJ> E{P, LDP, nullptr, 0, nullptr, nullptr, nullptr, 1.f / (WSCALE * ASCALE)};
                pg8::gemm_phase<pg8::Epi<pg8::EK_PROJ>, pg8::StaticOrder, false, true>(F.lds, F.tid, g, S, E);
            }
            END_STEP;
            if (RUN_STEP && ((PH_MASK >> 2) & 1)) for (int rep_ = 0; rep_ <= ((REP_MASK >> 2) & 1); ++rep_) { MKCTX;
                for (int cu = blockIdx.x; cu < BG * 32; cu += F.G)
                    compress_unit(F, cu, P, (const bf16_t*)(wl + WO_W1), (const bf16_t*)(wl + WO_W2), (const float*)(a->ws + WS_MISC + MI_B1) + 0 * 256,
                                  (bf16_t*)(a->ws + WS_MISC + MI_KC), (bf16_t*)(a->ws + WS_MISC + MI_VC));
                conv_phase(F, P, (bf16_t*)(F.dout + DO_XC), a->in[I_CONVW] + (size_t)0 * 4 * 2048, a->in[I_CONVB] + (size_t)0 * 2048);
            }
            END_STEP;
            if (RUN_STEP && ((PH_MASK >> 3) & 1)) for (int rep_ = 0; rep_ <= ((REP_MASK >> 3) & 1); ++rep_) { MKCTX; attn_phase(F, a, 0, 1 + 4 * rep_); }
            END_STEP;
            if (RUN_STEP && ((PH_MASK >> 4) & 1)) for (int rep_ = 0; rep_ <= ((REP_MASK >> 4) & 1); ++rep_) { MKCTX; fin_phase(F, P, (bf16_t*)(F.dout + DO_R), (bf16_t*)(F.dout + DO_YC), a->in[I_SNG] + (size_t)0 * DM); }
            END_STEP;
            if (RUN_STEP && ((PH_MASK >> 5) & 1)) for (int rep_ = 0; rep_ <= ((REP_MASK >> 5) & 1); ++rep_) { MKCTX;
                bf16_t* GT = (bf16_t*)(a->ws + WS_ARENA + AR_GATES); bf16_t* MX = (bf16_t*)(a->ws + WS_ARENA + AR_MIXIN); float* TMP = (float*)(F.dout + DO_TMP);
                pg8::Gemm g{nullptr, nullptr, DM, DM, DM};
                pg8::S5Order S; S.so.init(TG, DM, DM, DM, F.G, (int)blockIdx.x);
                S.aH = (long)(size_t)Hg; S.aRY = (long)(size_t)(F.dout + DO_R); S.aYC = (long)(size_t)(F.dout + DO_YC);
                S.bG = (long)(size_t)(wl + WO_GATE); S.bCN = (long)(size_t)(wl + WO_C); S.bS = (long)(size_t)(wl + WO_SSD);
                pg8::Epi<pg8::EK_S5> E{GT, 3072, nullptr, 0, TMP, nullptr, MX, 1.f};
                pg8::gemm_phase(F.lds, F.tid, g, S, E);
            }
            END_STEP;
            if (RUN_STEP && ((PH_MASK >> 6) & 1)) for (int rep_ = 0; rep_ <= ((REP_MASK >> 6) & 1); ++rep_) { MKCTX;
                pg8::Gemm g{(const bf16_t*)(a->ws + WS_ARENA + AR_MIXIN), (const bf16_t*)(wl + WO_OUT), DM, DM, DM}; pg8::StaticOrder S; S.init(TG, DM, DM, DM, F.G, (int)blockIdx.x);
                pg8::Epi<pg8::EK_WOUT> E{(bf16_t*)(a->ws + WS_PRE1) + (size_t)1 * TG * DM, DM, Hg, DM, nullptr, nullptr, nullptr, 1.f};
                pg8::gemm_phase(F.lds, F.tid, g, S, E);
            }
            END_STEP;
        }
        if (RUN_STEP && ((PH_MASK >> 7) & 1)) for (int rep_ = 0; rep_ <= ((REP_MASK >> 7) & 1); ++rep_) { MKCTX; ln1_route_phase(F, a, 0); }
        END_STEP;
        if (RUN_STEP && ((PH_MASK >> 9) & 1)) for (int rep_ = 0; rep_ <= ((REP_MASK >> 9) & 1); ++rep_) { MKCTX;
            const int nrt = moe_tables(F, 0, (const int*)(a->ws + WS_ARENA + AR_RTOK));
            pg8::Gemm g{(const bf16_t*)(a->ws + WS_H18), (const bf16_t*)(wl + WO_UP), 512, 512, 512};
            pg8::MoeOrder S{(const LAS int*)(F.lds + LDSX + LX_TILE), (const LAS int*)(F.lds + LDSX + LX_OFF), (const LAS int*)(F.lds + LDSX + LX_ECNT), nrt, F.G, F.vcu, 8, (long)256 * DM, (long)256 * DM, (long)1024 * DM};
            pg8::Epi<pg8::EK_GLU> E{(bf16_t*)(a->ws + WS_ARENA + AR_HID), 512, nullptr, 0, nullptr, nullptr, nullptr, 1.f / (WSCALE * ASCALE)};
            pg8::gemm_phase<pg8::Epi<pg8::EK_GLU>, pg8::MoeOrder, true, true>(F.lds, F.tid, g, S, E, (const LAS int*)(F.lds + LDSX + LX_GIDX));
        }
        END_STEP;
        if (RUN_STEP && ((PH_MASK >> 10) & 1)) for (int rep_ = 0; rep_ <= ((REP_MASK >> 10) & 1); ++rep_) { MKCTX;
            const int nrt = moe_tables(F, 0, nullptr);
            pg8::Gemm g{(const bf16_t*)(a->ws + WS_ARENA + AR_HID), (const bf16_t*)(wl + WO_DN), 512, 512, 512};
            pg8::MoeOrder S{(const LAS int*)(F.lds + LDSX + LX_TILE), (const LAS int*)(F.lds + LDSX + LX_OFF), (const LAS int*)(F.lds + LDSX + LX_ECNT), nrt, F.G, F.vcu, 8, (long)256 * 512 * 2, (long)256 * 512 * 2, (long)1024 * 512 * 2};
            pg8::Epi<pg8::EK_DOWN> E{(bf16_t*)(a->ws + WS_ARENA + AR_XS), DM, nullptr, 0, nullptr, (const int2*)(a->ws + WS_ARENA + AR_RINFO), nullptr, 1.f};
            pg8::gemm_phase(F.lds, F.tid, g, S, E);
        }
        END_STEP;
        if (RUN_STEP && ((PH_MASK >> 11) & 1)) for (int rep_ = 0; rep_ <= ((REP_MASK >> 11) & 1); ++rep_) { MKCTX; ln2_phase(F, a, 0, 0 == DEPTH - 1); }
        END_STEP;
    }
    {
        unsigned char* wl = a->ws + WS_W + (size_t)1 * W_LAYER;
        bf16_t* Hb = (bf16_t*)(a->ws + WS_H);
        bf16_t* P = (bf16_t*)(a->ws + WS_ARENA + AR_P);
        {
            const bf16_t* Hg = Hb + (size_t)0 * TG * DM;
            if (RUN_STEP && ((PH_MASK >> 1) & 1)) for (int rep_ = 0; rep_ <= ((REP_MASK >> 1) & 1); ++rep_) { MKCTX;
                pg8::Gemm g{(const bf16_t*)(a->ws + WS_H8 + (size_t)0 * TG * DM), (const bf16_t*)(wl + WO_IN), 512, 512, 512}; pg8::StaticOrder S; S.init(TG, LDP, 512, 512, F.G, (int)blockIdx.x, 512);
                pg8::Epi<pg8::EK_PROJ> E{P, LDP, nullptr, 0, nullptr, nullptr, nullptr, 1.f / (WSCALE * ASCALE)};
                pg8::gemm_phase<pg8::Epi<pg8::EK_PROJ>, pg8::StaticOrder, false, true>(F.lds, F.tid, g, S, E);
            }
            END_STEP;
            if (RUN_STEP && ((PH_MASK >> 2) & 1)) for (int rep_ = 0; rep_ <= ((REP_MASK >> 2) & 1); ++rep_) { MKCTX;
                for (int cu = blockIdx.x; cu < BG * 32; cu += F.G)
                    compress_unit(F, cu, P, (const bf16_t*)(wl + WO_W1), (const bf16_t*)(wl + WO_W2), (const float*)(a->ws + WS_MISC + MI_B1) + 1 * 256,
                                  (bf16_t*)(a->ws + WS_MISC + MI_KC), (bf16_t*)(a->ws + WS_MISC + MI_VC));
                conv_phase(F, P, (bf16_t*)(F.dout + DO_XC), a->in[I_CONVW] + (size_t)1 * 4 * 2048, a->in[I_CONVB] + (size_t)1 * 2048);
            }
            END_STEP;
            if (RUN_STEP && ((PH_MASK >> 3) & 1)) for (int rep_ = 0; rep_ <= ((REP_MASK >> 3) & 1); ++rep_) { MKCTX; attn_phase(F, a, 1, 0 + 4 * rep_); }
            END_STEP;
            if (RUN_STEP && ((PH_MASK >> 4) & 1)) for (int rep_ = 0; rep_ <= ((REP_MASK >> 4) & 1); ++rep_) { MKCTX; fin_phase(F, P, (bf16_t*)(F.dout + DO_R), (bf16_t*)(F.dout + DO_YC), a->in[I_SNG] + (size_t)1 * DM); }
            END_STEP;
            if (RUN_STEP && ((PH_MASK >> 5) & 1)) for (int rep_ = 0; rep_ <= ((REP_MASK >> 5) & 1); ++rep_) { MKCTX;
                bf16_t* GT = (bf16_t*)(a->ws + WS_ARENA + AR_GATES); bf16_t* MX = (bf16_t*)(a->ws + WS_ARENA + AR_MIXIN); float* TMP = (float*)(F.dout + DO_TMP);
                pg8::Gemm g{nullptr, nullptr, DM, DM, DM};
                pg8::S5Order S; S.so.init(TG, DM, DM, DM, F.G, (int)blockIdx.x);
                S.aH = (long)(size_t)Hg; S.aRY = (long)(size_t)(F.dout + DO_R); S.aYC = (long)(size_t)(F.dout + DO_YC);
                S.bG = (long)(size_t)(wl + WO_GATE); S.bCN = (long)(size_t)(wl + WO_C); S.bS = (long)(size_t)(wl + WO_SSD);
                pg8::Epi<pg8::EK_S5> E{GT, 3072, nullptr, 0, TMP, nullptr, MX, 1.f};
                pg8::gemm_phase(F.lds, F.tid, g, S, E);
            }
            END_STEP;
            if (RUN_STEP && ((PH_MASK >> 6) & 1)) for (int rep_ = 0; rep_ <= ((REP_MASK >> 6) & 1); ++rep_) { MKCTX;
                pg8::Gemm g{(const bf16_t*)(a->ws + WS_ARENA + AR_MIXIN), (const bf16_t*)(wl + WO_OUT), DM, DM, DM}; pg8::StaticOrder S; S.init(TG, DM, DM, DM, F.G, (int)blockIdx.x);
                pg8::Epi<pg8::EK_WOUT> E{(bf16_t*)(a->ws + WS_PRE1) + (size_t)0 * TG * DM, DM, Hg, DM, nullptr, nullptr, nullptr, 1.f};
                pg8::gemm_phase(F.lds, F.tid, g, S, E);
            }
            END_STEP;
        }
        {
            const bf16_t* Hg = Hb + (size_t)1 * TG * DM;
            if (RUN_STEP && ((PH_MASK >> 1) & 1)) for (int rep_ = 0; rep_ <= ((REP_MASK >> 1) & 1); ++rep_) { MKCTX;
                pg8::Gemm g{(const bf16_t*)(a->ws + WS_H8 + (size_t)1 * TG * DM), (const bf16_t*)(wl + WO_IN), 512, 512, 512}; pg8::StaticOrder S; S.init(TG, LDP, 512, 512, F.G, (int)blockIdx.x, 512);
                pg8::Epi<pg8::EK_PROJ> E{P, LDP, nullptr, 0, nullptr, nullptr, nullptr, 1.f / (WSCALE * ASCALE)};
                pg8::gemm_phase<pg8::Epi<pg8::EK_PROJ>, pg8::StaticOrder, false, true>(F.lds, F.tid, g, S, E);
            }
            END_STEP;
            if (RUN_STEP && ((PH_MASK >> 2) & 1)) for (int rep_ = 0; rep_ <= ((REP_MASK >> 2) & 1); ++rep_) { MKCTX;
                for (int cu = blockIdx.x; cu < BG * 32; cu += F.G)
                    compress_unit(F, cu, P, (const bf16_t*)(wl + WO_W1), (const bf16_t*)(wl + WO_W2), (const float*)(a->ws + WS_MISC + MI_B1) + 1 * 256,
                                  (bf16_t*)(a->ws + WS_MISC + MI_KC), (bf16_t*)(a->ws + WS_MISC + MI_VC));
                conv_phase(F, P, (bf16_t*)(F.dout + DO_XC), a->in[I_CONVW] + (size_t)1 * 4 * 2048, a->in[I_CONVB] + (size_t)1 * 2048);
            }
            END_STEP;
            if (RUN_STEP && ((PH_MASK >> 3) & 1)) for (int rep_ = 0; rep_ <= ((REP_MASK >> 3) & 1); ++rep_) { MKCTX; attn_phase(F, a, 1, 1 + 4 * rep_); }
            END_STEP;
            if (RUN_STEP && ((PH_MASK >> 4) & 1)) for (int rep_ = 0; rep_ <= ((REP_MASK >> 4) & 1); ++rep_) { MKCTX; fin_phase(F, P, (bf16_t*)(F.dout + DO_R), (bf16_t*)(F.dout + DO_YC), a->in[I_SNG] + (size_t)1 * DM); }
            END_STEP;
            if (RUN_STEP && ((PH_MASK >> 5) & 1)) for (int rep_ = 0; rep_ <= ((REP_MASK >> 5) & 1); ++rep_) { MKCTX;
                bf16_t* GT = (bf16_t*)(a->ws + WS_ARENA + AR_GATES); bf16_t* MX = (bf16_t*)(a->ws + WS_ARENA + AR_MIXIN); float* TMP = (float*)(F.dout + DO_TMP);
                pg8::Gemm g{nullptr, nullptr, DM, DM, DM};
                pg8::S5Order S; S.so.init(TG, DM, DM, DM, F.G, (int)blockIdx.x);
                S.aH = (long)(size_t)Hg; S.aRY = (long)(size_t)(F.dout + DO_R); S.aYC = (long)(size_t)(F.dout + DO_YC);
                S.bG = (long)(size_t)(wl + WO_GATE); S.bCN = (long)(size_t)(wl + WO_C); S.bS = (long)(size_t)(wl + WO_SSD);
                pg8::Epi<pg8::EK_S5> E{GT, 3072, nullptr, 0, TMP, nullptr, MX, 1.f};
                pg8::gemm_phase(F.lds, F.tid, g, S, E);
            }
            END_STEP;
            if (RUN_STEP && ((PH_MASK >> 6) & 1)) for (int rep_ = 0; rep_ <= ((REP_MASK >> 6) & 1); ++rep_) { MKCTX;
                pg8::Gemm g{(const bf16_t*)(a->ws + WS_ARENA + AR_MIXIN), (const bf16_t*)(wl + WO_OUT), DM, DM, DM}; pg8::StaticOrder S; S.init(TG, DM, DM, DM, F.G, (int)blockIdx.x);
                pg8::Epi<pg8::EK_WOUT> E{(bf16_t*)(a->ws + WS_PRE1) + (size_t)1 * TG * DM, DM, Hg, DM, nullptr, nullptr, nullptr, 1.f};
                pg8::gemm_phase(F.lds, F.tid, g, S, E);
            }
            END_STEP;
        }
        if (RUN_STEP && ((PH_MASK >> 7) & 1)) for (int rep_ = 0; rep_ <= ((REP_MASK >> 7) & 1); ++rep_) { MKCTX; ln1_route_phase(F, a, 1); }
        END_STEP;
        if (RUN_STEP && ((PH_MASK >> 9) & 1)) for (int rep_ = 0; rep_ <= ((REP_MASK >> 9) & 1); ++rep_) { MKCTX;
            const int nrt = moe_tables(F, 1, (const int*)(a->ws + WS_ARENA + AR_RTOK));
            pg8::Gemm g{(const bf16_t*)(a->ws + WS_H18), (const bf16_t*)(wl + WO_UP), 512, 512, 512};
            pg8::MoeOrder S{(const LAS int*)(F.lds + LDSX + LX_TILE), (const LAS int*)(F.lds + LDSX + LX_OFF), (const LAS int*)(F.lds + LDSX + LX_ECNT), nrt, F.G, F.vcu, 8, (long)256 * DM, (long)256 * DM, (long)1024 * DM};
            pg8::Epi<pg8::EK_GLU> E{(bf16_t*)(a->ws + WS_ARENA + AR_HID), 512, nullptr, 0, nullptr, nullptr, nullptr, 1.f / (WSCALE * ASCALE)};
            pg8::gemm_phase<pg8::Epi<pg8::EK_GLU>, pg8::MoeOrder, true, true>(F.lds, F.tid, g, S, E, (const LAS int*)(F.lds + LDSX + LX_GIDX));
        }
        END_STEP;
        if (RUN_STEP && ((PH_MASK >> 10) & 1)) for (int rep_ = 0; rep_ <= ((REP_MASK >> 10) & 1); ++rep_) { MKCTX;
            const int nrt = moe_tables(F, 1, nullptr);
            pg8::Gemm g{(const bf16_t*)(a->ws + WS_ARENA + AR_HID), (const bf16_t*)(wl + WO_DN), 512, 512, 512};
            pg8::MoeOrder S{(const LAS int*)(F.lds + LDSX + LX_TILE), (const LAS int*)(F.lds + LDSX + LX_OFF), (const LAS int*)(F.lds + LDSX + LX_ECNT), nrt, F.G, F.vcu, 8, (long)256 * 512 * 2, (long)256 * 512 * 2, (long)1024 * 512 * 2};
            pg8::Epi<pg8::EK_DOWN> E{(bf16_t*)(a->ws + WS_ARENA + AR_XS), DM, nullptr, 0, nullptr, (const int2*)(a->ws + WS_ARENA + AR_RINFO), nullptr, 1.f};
            pg8::gemm_phase(F.lds, F.tid, g, S, E);
        }
        END_STEP;
        if (RUN_STEP && ((PH_MASK >> 11) & 1)) for (int rep_ = 0; rep_ <= ((REP_MASK >> 11) & 1); ++rep_) { MKCTX; ln2_phase(F, a, 1, 1 == DEPTH - 1); }
        END_STEP;
    }
#undef RUN_STEP
#undef END_STEP
}

__global__ void dump_bf16(const bf16_t* src, float* dst, size_t n) { for (size_t i = (size_t)blockIdx.x * blockDim.x + threadIdx.x; i < n; i += (size_t)gridDim.x * blockDim.x) dst[i] = bf1(src[i]); }
#ifndef N_LAUNCH_MODE
#define N_LAUNCH_MODE 0
#endif
extern "C" void kernel_launch(void* const* d_in, const int* in_sizes, int n_in, void* d_out, int out_size, void* d_ws, size_t ws_size, hipStream_t stream) {
    static int grid = 0;
    if (grid == 0) {
        if (n_in != 32 || out_size != T_ * DM || ws_size < WS_END) { fprintf(stderr, "kernel_launch: unexpected problem (n_in %d out %d ws %zu)\n", n_in, out_size, ws_size); grid = -1; return; }
        int dev = 0, cus = 0, per_cu = 0;
        if (hipGetDevice(&dev) != hipSuccess || hipDeviceGetAttribute(&cus, hipDeviceAttributeMultiprocessorCount, dev) != hipSuccess) { grid = -1; return; }
        if (hipFuncSetAttribute((const void*)fwd_kernel, hipFuncAttributeMaxDynamicSharedMemorySize, LDS_TOTAL) != hipSuccess) { fprintf(stderr, "kernel_launch: hipFuncSetAttribute failed\n"); grid = -1; return; }
        if (hipOccupancyMaxActiveBlocksPerMultiprocessor(&per_cu, (const void*)fwd_kernel, 512, LDS_TOTAL) != hipSuccess || per_cu < 1)
            fprintf(stderr, "kernel_launch: occupancy query reports %d workgroups per CU\n", per_cu);
        (void)hipGetLastError();
        grid = cus;
    }
    if (grid < 0) return;
    (void)hipMemsetAsync((char*)d_ws + WS_CTL, 0, CTL_ZERO_BYTES, stream);
    Args a{};
    for (int i = 0; i < 32; ++i) a.in[i] = (const float*)d_in[i];
    a.out = (float*)d_out; a.ws = (unsigned char*)d_ws;
#if N_LAUNCH_MODE == 1
    a.lo = 0; a.hi = NSTEPS;
    hipLaunchKernelGGL(fwd_kernel, dim3(grid), dim3(512), LDS_TOTAL, stream, a);
#else
#ifdef DBG_STOP
    for (int s = 0; s <= DBG_STOP; ++s) { a.lo = s; a.hi = s + 1; hipLaunchKernelGGL(fwd_kernel, dim3(grid), dim3(512), LDS_TOTAL, stream, a); }
    hipLaunchKernelGGL(dump_bf16, dim3(1024), dim3(256), 0, stream, (const bf16_t*)((char*)d_ws + DBG_SRC), (float*)d_out, (size_t)T_ * DM);
#else
    for (int s = 0; s < NSTEPS; ++s) { a.lo = s; a.hi = s + 1; hipLaunchKernelGGL(fwd_kernel, dim3(grid), dim3(512), LDS_TOTAL, stream, a); }
#endif
#endif
}
```

```cpp
#define N_LAUNCH_MODE 1
#include <hip/hip_runtime.h>
#include <cstdio>
#include <cstdint>

#define LAS __attribute__((address_space(3)))
#define GAS __attribute__((address_space(1)))
typedef unsigned short bf16_t;
typedef short bf16x8 __attribute__((ext_vector_type(8)));
typedef short s16x4 __attribute__((ext_vector_type(4)));
typedef float f32x2 __attribute__((ext_vector_type(2)));
typedef float f32x4 __attribute__((ext_vector_type(4)));
typedef float f32x16 __attribute__((ext_vector_type(16)));
typedef unsigned u32x2 __attribute__((ext_vector_type(2)));
typedef unsigned u32x4 __attribute__((ext_vector_type(4)));

constexpr int T_ = 32768, SEQ = 2048, DM = 1024, NBATCH = 16, DEPTH = 2;
constexpr int NG = 2, BG = NBATCH / NG, TG = T_ / NG;
constexpr int LDP = 5120;
constexpr int C_POOL = 0, C_Q = 512, C_KV = 1024, C_Z = 1792, C_XBC = 2816, C_NG = 4864, C_DT = 4888;
constexpr int D_IN = 7976;
constexpr float LN_EPS = 1e-5f, DN_ALPHA = 1.41421356237f, LOG2E = 1.4426950408889634f;
constexpr float QSCALE = 0.125f * LOG2E;
constexpr float NEGBIG = -1e30f;
constexpr int MOE_ROWS = 69632;

constexpr size_t MiB = 1ull << 20;
constexpr size_t WS_CTL = 0, CTL_ZERO_BYTES = 65536;
constexpr size_t WS_MISC = 1 * MiB;
constexpr size_t WS_W = 2 * MiB, W_LAYER = 52 * MiB;
constexpr size_t WO_IN = 0, WO_GATE = 5 * MiB, WO_C = 11 * MiB, WO_NSA = 12 * MiB, WO_SSD = 13 * MiB, WO_OUT = 15 * MiB, WO_W1 = 17 * MiB, WO_W2 = 18 * MiB, WO_UP = 19 * MiB, WO_DN = 35 * MiB;
constexpr size_t WS_H = 106 * MiB, WS_PRE1 = 170 * MiB, WS_H8 = 234 * MiB, WS_H18 = 266 * MiB, WS_ARENA = 298 * MiB;
constexpr float RSCALE = 16.f, BSCALE = 16.f, YSCALE = 8.f, WSCALE_CN = 480.f;
constexpr float WSCALE = 704.f, ASCALE = 24.f, MSCALE = 32.f, HSCALE = 16.f, WSCALE_OUT = 1408.f, WSCALE_DN = 992.f;
constexpr size_t AR_P = 0, AR_GATES = 0, AR_MIXIN = 96 * MiB;
constexpr size_t AR_XS = 0, AR_RTOK = 128 * MiB, AR_RINFO = 132 * MiB, AR_HID = 140 * MiB;
constexpr size_t WS_END = 506 * MiB;
constexpr int ECAP = 65536;
constexpr size_t DO_XC = 0, DO_TMP = 0, DO_YC = 64 * MiB, DO_R = 96 * MiB, DO_YC8 = 112 * MiB;
constexpr size_t MI_BIAS = 0, MI_B1 = 4096, MI_KC = 65536, MI_VC = MI_KC + 262144, MI_ROUTE = 1 * MiB, MI_RINFO = 2 * MiB;
constexpr int CW_BAR = 4096, CW_WQ = 8192, CW_CNT = 12288;
constexpr int LDS_TOTAL = 147456, LDSX = 131072;
constexpr int LX_BAR = 0, LX_WQ = 16, LX_OFF = 64, LX_ECNT = 160, LX_TILE = 256, LX_CNTL = 1536, LX_BASE = 1600, LX_ROWS = 2048, LX_GIDX = 6144;

__device__ __forceinline__ float bflo(unsigned u) { return __uint_as_float(u << 16); }
__device__ __forceinline__ float bfhi(unsigned u) { return __uint_as_float(u & 0xffff0000u); }
__device__ __forceinline__ float bf1(bf16_t b) { return __uint_as_float(((unsigned)b) << 16); }
typedef __bf16 bf16x2_t __attribute__((ext_vector_type(2)));
__device__ __forceinline__ unsigned cvt_pk_bf16(float lo, float hi) { const f32x2 v = {lo, hi}; const bf16x2_t b = __builtin_convertvector(v, bf16x2_t); return __builtin_bit_cast(unsigned, b); }
__device__ __forceinline__ bf16_t f2bf(float f) { return (bf16_t)(cvt_pk_bf16(f, 0.f) & 0xffffu); }
__device__ __forceinline__ float fexp2(float x) { return __builtin_amdgcn_exp2f(x); }
__device__ __forceinline__ float frcp(float x) { return __builtin_amdgcn_rcpf(x); }
__device__ __forceinline__ float sigmoidf_(float x) { return frcp(1.f + fexp2(-x * LOG2E)); }
__device__ __forceinline__ float siluf_(float x) { return x * sigmoidf_(x); }
__device__ __forceinline__ float wave_sum(float v) {
#pragma unroll
    for (int o = 1; o < 64; o <<= 1) v += __shfl_xor(v, o);
    return v;
}
__device__ __forceinline__ void unpack8(const u32x4 v, float (&x)[8]) {
    x[0] = bflo(v.x); x[1] = bfhi(v.x); x[2] = bflo(v.y); x[3] = bfhi(v.y); x[4] = bflo(v.z); x[5] = bfhi(v.z); x[6] = bflo(v.w); x[7] = bfhi(v.w);
}
__device__ __forceinline__ u32x4 pack8(const float (&x)[8]) {
    u32x4 w; w.x = cvt_pk_bf16(x[0], x[1]); w.y = cvt_pk_bf16(x[2], x[3]); w.z = cvt_pk_bf16(x[4], x[5]); w.w = cvt_pk_bf16(x[6], x[7]); return w;
}
typedef int v4i __attribute__((ext_vector_type(4)));
__device__ __forceinline__ unsigned q1_i8(float x) { int q = __float2int_rn(x); q = q < -127 ? -127 : (q > 127 ? 127 : q); return (unsigned)q & 255u; }
__device__ __forceinline__ unsigned cvt4_i8(float a, float b, float c, float d) { return q1_i8(a) | (q1_i8(b) << 8) | (q1_i8(c) << 16) | (q1_i8(d) << 24); }
__device__ __forceinline__ u32x2 pack8_i8(const float (&x)[8], float sc) { u32x2 w; w.x = cvt4_i8(x[0] * sc, x[1] * sc, x[2] * sc, x[3] * sc); w.y = cvt4_i8(x[4] * sc, x[5] * sc, x[6] * sc, x[7] * sc); return w; }
#define LDS_WAIT() asm volatile("s_waitcnt lgkmcnt(0)" ::: "memory")
__device__ __forceinline__ int crow(int r, int hi) { return (r & 3) + 8 * (r >> 2) + 4 * hi; }
__device__ __forceinline__ f32x16 mfma32(bf16x8 a, bf16x8 b, f32x16 c) { return __builtin_amdgcn_mfma_f32_32x32x16_bf16(a, b, c, 0, 0, 0); }
__device__ __forceinline__ f32x4 mfma16(bf16x8 a, bf16x8 b, f32x4 c) { return __builtin_amdgcn_mfma_f32_16x16x32_bf16(a, b, c, 0, 0, 0); }
typedef short v4i16_t __attribute__((ext_vector_type(4)));
__device__ __forceinline__ s16x4 trrd(const LAS unsigned char* p) { return __builtin_bit_cast(s16x4, __builtin_amdgcn_ds_read_tr16_b64_v4i16((LAS v4i16_t*)p)); }
__device__ __forceinline__ bf16x8 cat8(s16x4 lo, s16x4 hi) { return (bf16x8){lo[0], lo[1], lo[2], lo[3], hi[0], hi[1], hi[2], hi[3]}; }

namespace pg8 {
constexpr int BM = 256, BK = 64, HALF = 128, HTB = HALF * BK * 2, STAGE_BYTES = 8 * HTB, NXCD = 8, WGM = 8;
__host__ __device__ __forceinline__ int lds_byte(int r, int c) { const int st = (r >> 4) * 2 + (c >> 5), rr = r & 15, cc = c & 31, ob = rr * 64 + cc * 2; return st * 1024 + (ob ^ (((ob >> 9) & 1) << 5)); }
__host__ __device__ __forceinline__ void stage_rc(int b, int& R, int& C) { const int st = b / 1024, sb = b % 1024, swz = sb ^ (((sb >> 9) & 1) << 5); R = (st >> 1) * 16 + swz / 64; C = (st & 1) * 32 + (swz % 64) / 2; }
__host__ __device__ __forceinline__ int perm32(int rho) { const int n = rho >> 4, i = rho & 15; return 8 * (i >> 2) + 4 * n + (i & 3); }

struct Unit { int pm, pn, nt, kind, gx, nv, gi; long ab, bb; };
struct Gemm { const bf16_t* A; const bf16_t* Bt; int lda, ldb, K; };

struct StaticOrder {
    int nM, nN, nwg, G, c, nt0; long tsA, tsB;
    __device__ void init(int M, int N, int lda, int ldb, int G_, int c_, int K_ = 1024) { nM = M / BM; nN = N / BM; nwg = nM * nN; G = G_; c = c_; nt0 = K_ / BK; tsA = (long)BM * lda * 2; tsB = (long)BM * ldb * 2; }
    __device__ bool next(int i, Unit& u) const {
        const long L = (long)i * G + c; if (L >= nwg) return false;
        int wgid = (int)L; { const int q = nwg / NXCD, r = nwg % NXCD, xcd = wgid % NXCD, off = wgid / NXCD; wgid = (xcd < r ? xcd * (q + 1) : r * (q + 1) + (xcd - r) * q) + off; }
        const int nig = WGM * nN, gid = wgid / nig, fm = gid * WGM, gsz = (nM - fm) < WGM ? (nM - fm) : WGM;
        u.pm = fm + ((wgid % nig) % gsz); u.pn = (wgid % nig) / gsz; u.ab = u.pm * tsA; u.bb = u.pn * tsB; u.nt = nt0; u.kind = 0; u.gx = 0; u.nv = 0; u.gi = 0; return true;
    }
};
struct S5Order {
    StaticOrder so; long aH, aRY, aYC, bG, bCN, bS;
    __device__ bool next(int i, Unit& u) const {
        const int base = i / 6, s = i - 6 * base, x = s >> 1;
        if (!so.next(base, u)) return false;
        const long ra = u.ab, rb = u.bb;
        if ((s & 1) == 0) { u.ab = aH + ra; u.bb = bG + rb + (long)x * 1024 * 1024; u.nt = 8; u.kind = 0; u.pn += 4 * x; }
        else if (x == 0) { u.ab = aRY + ra; u.bb = bCN + rb; u.nt = 4; u.kind = 1; }
        else if (x == 1) { u.ab = aRY + ra + 512; u.bb = bCN + rb + 512; u.nt = 4; u.kind = 2; }
        else { u.ab = aYC + ra; u.bb = bS + rb; u.nt = 8; u.kind = 3; }
        return true;
    }
};
struct MoeOrder {
    const LAS int* tile_e; const LAS int* off; const LAS int* cnt; int nrt, G, vcu, nt0; long tsA, tsB, eB;
    __device__ bool next(int i, Unit& u) const {
        const long L = (long)i * G + vcu; if (L >= (long)nrt * 4) return false;
        const int rt = (int)(L >> 2), pn = (int)(L & 3), e = __builtin_amdgcn_readfirstlane(tile_e[rt]), k0 = rt * 256 - __builtin_amdgcn_readfirstlane(off[e]), c = __builtin_amdgcn_readfirstlane(cnt[e]);
        u.pm = rt; u.pn = pn; u.ab = rt * tsA; u.bb = e * eB + pn * tsB; u.nt = nt0; u.kind = 0; u.gx = e * ECAP + k0; u.nv = (c - k0) < 256 ? (c - k0) : 256; u.gi = i; return true;
    }
};

template <class Epi, class Sched, bool GATHER = false, bool FP8 = false>
__device__ __forceinline__ void gemm_phase(LAS unsigned char* lds, int tid_, const Gemm g, const Sched& S, const Epi& E, const LAS int* gidx = nullptr) {
    asm volatile("" : "+v"(tid_));
    const int tid = tid_, wid = __builtin_amdgcn_readfirstlane(tid >> 6), lane = tid & 63, wr = wid >> 2, wc = wid & 3, fr = lane & 15, fq = lane >> 4;
    unsigned voffA0[2], voffA1[2], nvA0[2], nvA1[2], voffB[2]; int RA[2], CA[2];
#pragma unroll
    for (int i = 0; i < 2; ++i) { int R, C; stage_rc(tid * 16 + i * 8192, R, C); const int Rb = Epi::PERM ? ((R & ~31) + perm32(R & 31)) : R; RA[i] = R; CA[i] = C;
        voffA0[i] = (unsigned)(R * g.lda + C) * 2u; voffA1[i] = (unsigned)((R + HALF) * g.lda + C) * 2u; nvA0[i] = voffA0[i]; nvA1[i] = voffA1[i]; voffB[i] = (unsigned)(Rb * g.ldb + C) * 2u; }
#define PG8_GATHER(dst0, dst1, u_) do { _Pragma("unroll") for (int _i = 0; _i < 2; ++_i) { \
        dst0[_i] = (unsigned)(gidx[((u_).gi & 7) * 256 + RA[_i]] * g.lda + CA[_i]) * 2u; dst1[_i] = (unsigned)(gidx[((u_).gi & 7) * 256 + HALF + RA[_i]] * g.lda + CA[_i]) * 2u; } } while (0)
    const size_t kstep = (size_t)(BK * 2);
    const size_t hstepB = (size_t)HALF * g.ldb * 2;
    const unsigned ldsw = (unsigned)wid * 1024u;
    const int aoff = lds_byte(wr * 64 + fr, fq * 8), boff = lds_byte(wc * 32 + fr, fq * 8);
#define PG8_SA(b, h) (((b) * 2 + (h)) * HTB)
#define PG8_SB(b, h) ((4 + (b) * 2 + (h)) * HTB)
#define PG8_STAGE(bufoff, gbase, voff) do { _Pragma("unroll") for (int _i = 0; _i < 2; ++_i) \
        __builtin_amdgcn_global_load_lds((const unsigned*)((const char*)(gbase) + (voff)[_i]), (LAS unsigned*)(lds + (bufoff) + ldsw + _i * 8192), 16, 0, 0); } while (0)
#define PG8_LDA(dst, b, h) do { _Pragma("unroll") for (int m = 0; m < 4; ++m) _Pragma("unroll") for (int k = 0; k < 2; ++k) dst[m][k] = *(const LAS bf16x8*)(lds + PG8_SA(b, h) + aoff + m * 2048 + k * 1024); } while (0)
#define PG8_LDB(dst, b, h) do { _Pragma("unroll") for (int n = 0; n < 2; ++n) _Pragma("unroll") for (int k = 0; k < 2; ++k) dst[n][k] = *(const LAS bf16x8*)(lds + PG8_SB(b, h) + boff + n * 2048 + k * 1024); } while (0)
#define PG8_MMA(ai, bj, At, Bt) do { __builtin_amdgcn_s_setprio(1); _Pragma("unroll") for (int m = 0; m < 4; ++m) _Pragma("unroll") for (int n = 0; n < 2; ++n) _Pragma("unroll") for (int k = 0; k < 2; ++k) { \
        if constexpr (FP8) acc[ai][bj][m][n] = __builtin_bit_cast(f32x4, __builtin_amdgcn_mfma_i32_16x16x64_i8(__builtin_bit_cast(v4i, Bt[n][k]), __builtin_bit_cast(v4i, At[m][k]), __builtin_bit_cast(v4i, acc[ai][bj][m][n]), 0, 0, 0)); \
        else acc[ai][bj][m][n] = __builtin_amdgcn_mfma_f32_16x16x32_bf16(Bt[n][k], At[m][k], acc[ai][bj][m][n], 0, 0, 0); } __builtin_amdgcn_s_setprio(0); } while (0)
#define PG8_WAIT_V(n) asm volatile("s_waitcnt vmcnt(" #n ")" ::: "memory")
#define PG8_WAIT_L(n) asm volatile("s_waitcnt lgkmcnt(" #n ")" ::: "memory")
#define PG8_BAR __builtin_amdgcn_s_barrier()
#define PG8_SCHED __builtin_amdgcn_sched_barrier(0)
    Unit cur, nxt; int ui = 0;
    if (!S.next(0, cur)) return;
    f32x4 acc[2][2][4][2];
#pragma unroll
    for (int a = 0; a < 2; ++a)
#pragma unroll
        for (int b = 0; b < 2; ++b)
#pragma unroll
            for (int m = 0; m < 4; ++m)
#pragma unroll
                for (int n = 0; n < 2; ++n) acc[a][b][m][n] = (f32x4){0.f, 0.f, 0.f, 0.f};
    bf16x8 At[4][2], B0[2][2], B1[2][2];
    const char* cA = (const char*)g.A + (GATHER ? 0 : cur.ab); const char* cB = (const char*)g.Bt + cur.bb;
    if constexpr (GATHER) PG8_GATHER(voffA0, voffA1, cur);
    PG8_STAGE(PG8_SB(0, 0), cB, voffB); PG8_STAGE(PG8_SB(0, 1), cB + hstepB, voffB); PG8_STAGE(PG8_SA(0, 0), cA, voffA0); PG8_STAGE(PG8_SA(0, 1), cA, voffA1);
    if (wr == 1) PG8_BAR;
    PG8_WAIT_V(2); PG8_BAR;
    PG8_STAGE(PG8_SB(1, 0), cB + kstep, voffB); PG8_STAGE(PG8_SA(1, 0), cA + kstep, voffA0); PG8_STAGE(PG8_SB(1, 1), cB + hstepB + kstep, voffB);
    PG8_WAIT_V(6); PG8_BAR;
    for (;;) {
        const bool has_next = S.next(ui + 1, nxt);
        const char* nA = (has_next && !GATHER) ? (const char*)g.A + nxt.ab : cA; const char* nB = has_next ? (const char*)g.Bt + nxt.bb : cB;
        if constexpr (GATHER) { if (has_next) PG8_GATHER(nvA0, nvA1, nxt); else { nvA0[0] = voffA0[0]; nvA0[1] = voffA0[1]; nvA1[0] = voffA1[0]; nvA1[1] = voffA1[1]; } }
        const int nt = cur.nt;
        for (int t = 0; t < nt; t += 2) {
            const bool last = (t == nt - 2);
            const char* a1 = cA + (size_t)(t + 1) * kstep;
            const char* a2 = last ? nA : cA + (size_t)(t + 2) * kstep; const char* b2 = last ? nB : cB + (size_t)(t + 2) * kstep;
            const char* a3 = a2 + kstep; const char* b3 = b2 + kstep;
            unsigned xA0[2], xA1[2];
            xA0[0] = (GATHER && last) ? nvA0[0] : voffA0[0]; xA0[1] = (GATHER && last) ? nvA0[1] : voffA0[1]; xA1[0] = (GATHER && last) ? nvA1[0] : voffA1[0]; xA1[1] = (GATHER && last) ? nvA1[1] : voffA1[1];
            PG8_LDB(B0, 0, 0); PG8_LDB(B1, 0, 1); PG8_SCHED; PG8_LDA(At, 0, 0); PG8_STAGE(PG8_SA(1, 1), a1, voffA1);
            PG8_WAIT_V(8); PG8_WAIT_L(0); PG8_BAR; PG8_MMA(0, 0, At, B0); PG8_MMA(0, 1, At, B1); PG8_BAR; PG8_SCHED;
            PG8_LDA(At, 0, 1); PG8_STAGE(PG8_SB(0, 0), b2, voffB); PG8_STAGE(PG8_SB(0, 1), b2 + hstepB, voffB); PG8_STAGE(PG8_SA(0, 0), a2, xA0);
            PG8_WAIT_V(8); PG8_WAIT_L(0); PG8_BAR; PG8_MMA(1, 0, At, B0); PG8_MMA(1, 1, At, B1); PG8_BAR; PG8_SCHED;
            PG8_LDB(B0, 1, 0); PG8_LDB(B1, 1, 1); PG8_SCHED; PG8_LDA(At, 1, 0); PG8_STAGE(PG8_SA(0, 1), a2, xA1);
            PG8_WAIT_V(8); PG8_WAIT_L(0); PG8_BAR; PG8_MMA(0, 0, At, B0); PG8_MMA(0, 1, At, B1); PG8_BAR; PG8_SCHED;
            PG8_LDA(At, 1, 1); PG8_STAGE(PG8_SB(1, 0), b3, voffB); PG8_STAGE(PG8_SB(1, 1), b3 + hstepB, voffB); PG8_STAGE(PG8_SA(1, 0), a3, xA0);
            PG8_WAIT_V(8); PG8_WAIT_L(0); PG8_BAR; PG8_MMA(1, 0, At, B0); PG8_MMA(1, 1, At, B1); PG8_BAR; PG8_SCHED;
        }
        if (wr == 0) PG8_BAR;
        if constexpr (FP8) {
#pragma unroll
            for (int a = 0; a < 2; ++a)
#pragma unroll
                for (int b = 0; b < 2; ++b)
#pragma unroll
                    for (int m = 0; m < 4; ++m)
#pragma unroll
                        for (int n = 0; n < 2; ++n)
#pragma unroll
                            for (int j = 0; j < 4; ++j) acc[a][b][m][n][j] = (float)__float_as_int(acc[a][b][m][n][j]);
        }
        E(acc, cur, wr, wc, fr, fq);
        if (!has_next) break;
#pragma unroll
        for (int a = 0; a < 2; ++a)
#pragma unroll
            for (int b = 0; b < 2; ++b)
#pragma unroll
                for (int m = 0; m < 4; ++m)
#pragma unroll
                    for (int n = 0; n < 2; ++n) acc[a][b][m][n] = (f32x4){0.f, 0.f, 0.f, 0.f};
        cur = nxt; cA = nA; cB = nB; ++ui;
        if constexpr (GATHER) { voffA0[0] = nvA0[0]; voffA0[1] = nvA0[1]; voffA1[0] = nvA1[0]; voffA1[1] = nvA1[1]; }
        if (wr == 1) PG8_BAR;
    }
    PG8_WAIT_V(0);
    PG8_BAR;
#undef PG8_GATHER
#undef PG8_SA
#undef PG8_SB
#undef PG8_STAGE
#undef PG8_LDA
#undef PG8_LDB
#undef PG8_MMA
#undef PG8_WAIT_V
#undef PG8_WAIT_L
#undef PG8_BAR
#undef PG8_SCHED
}

enum { EK_PROJ = 0, EK_GATE, EK_BR0, EK_BR1, EK_BR2, EK_WOUT, EK_GLU, EK_DOWN, EK_S5 };
template <int KIND> struct Epi {
    static constexpr bool PERM = true;
    bf16_t* O; int ldo;
    const bf16_t* X; int ldx;
    float* F;
    const int2* RI;
    bf16_t* O2;
    float osc;
    __device__ __forceinline__ void operator()(const f32x4 (&acc)[2][2][4][2], const Unit& u, int wr, int wc, int fr, int fq) const {
        const int row0 = u.pm * BM + wr * 64 + fr, col0 = u.pn * BM + wc * 32 + 8 * fq;
        if constexpr (KIND == EK_GLU) {
            const int hc0 = u.pn * 128 + wc * 32 + 8 * fq;
#pragma unroll
            for (int ai = 0; ai < 2; ++ai)
#pragma unroll
                for (int m = 0; m < 4; ++m) {
                    const int row = row0 + ai * HALF + m * 16; float o[8];
#pragma unroll
                    for (int n = 0; n < 2; ++n)
#pragma unroll
                        for (int j = 0; j < 4; ++j) o[4 * n + j] = siluf_(acc[ai][0][m][n][j] * osc) * (acc[ai][1][m][n][j] * osc);
                    *(u32x2*)((unsigned char*)O + (size_t)row * ldo + hc0) = pack8_i8(o, HSCALE);
                    asm volatile("" ::: "memory");
                }
        } else if constexpr (KIND == EK_DOWN) {
#pragma unroll
            for (int ai = 0; ai < 2; ++ai)
#pragma unroll
                for (int m = 0; m < 4; ++m) {
                    const int lr = ai * HALF + wr * 64 + m * 16 + fr; const bool ok = lr < u.nv; const int2 ri = RI[u.gx + (ok ? lr : 0)]; const float w = __int_as_float(ri.y) * osc;
                    if (ok) {
#pragma unroll
                        for (int bj = 0; bj < 2; ++bj) { float o[8];
#pragma unroll
                            for (int n = 0; n < 2; ++n)
#pragma unroll
                                for (int j = 0; j < 4; ++j) o[4 * n + j] = w * acc[ai][bj][m][n][j];
                            *(u32x4*)(O + (size_t)ri.x * ldo + col0 + bj * HALF) = pack8(o); }
                    }
                    asm volatile("" ::: "memory");
                }
        } else if constexpr (KIND == EK_S5) {
            if (u.kind == 0) { Epi<EK_GATE> e{O, ldo, nullptr, 0, nullptr, nullptr, nullptr, 1.f / (WSCALE * ASCALE)}; e(acc, u, wr, wc, fr, fq); }
            else if (u.kind == 1) { Epi<EK_BR0> e{nullptr, 0, O, ldo, F, nullptr, nullptr, 1.f / (RSCALE * WSCALE_CN)}; e(acc, u, wr, wc, fr, fq); }
            else if (u.kind == 2) { Epi<EK_BR1> e{nullptr, 0, O + 1024, ldo, F, nullptr, nullptr, 1.f / (BSCALE * WSCALE_CN)}; e(acc, u, wr, wc, fr, fq); }
            else { Epi<EK_BR2> e{O2, 1024, O + 2048, ldo, F, nullptr, nullptr, 1.f / (YSCALE * WSCALE)}; e(acc, u, wr, wc, fr, fq); }
        } else {
            int act = 0;
            if constexpr (KIND == EK_PROJ) act = (u.pn == 2 || u.pn == 3) ? 1 : ((u.pn >= 7 && u.pn <= 10) ? 2 : 0);
#pragma unroll
            for (int ai = 0; ai < 2; ++ai)
#pragma unroll
                for (int m = 0; m < 4; ++m) {
                    const int row = row0 + ai * HALF + m * 16;
#pragma unroll
                    for (int bj = 0; bj < 2; ++bj) {
                        const int col = col0 + bj * HALF; float v[8];
#pragma unroll
                        for (int n = 0; n < 2; ++n)
#pragma unroll
                            for (int j = 0; j < 4; ++j) v[4 * n + j] = acc[ai][bj][m][n][j];
                        if constexpr (KIND == EK_PROJ) {
#pragma unroll
                            for (int j = 0; j < 8; ++j) v[j] *= osc;
                            if (act == 1) {
#pragma unroll
                                for (int j = 0; j < 8; ++j) v[j] *= QSCALE;
                            } else if (act == 2) {
#pragma unroll
                                for (int j = 0; j < 8; ++j) v[j] = siluf_(v[j]);
                            }
                            *(u32x4*)(O + (size_t)row * ldo + col) = pack8(v);
                        } else if constexpr (KIND == EK_GATE) {
#pragma unroll
                            for (int j = 0; j < 8; ++j) v[j] = sigmoidf_(v[j] * osc);
                            *(u32x4*)(O + (size_t)row * ldo + col) = pack8(v);
                        } else if constexpr (KIND == EK_BR0 || KIND == EK_BR1 || KIND == EK_BR2) {
                            float gt[8]; unpack8(*(const u32x4*)(X + (size_t)row * ldx + col), gt);
#pragma unroll
                            for (int j = 0; j < 8; ++j) v[j] *= osc;
                            float* fp = F + (size_t)row * 1024 + col;
                            if constexpr (KIND == EK_BR0) {
                                *(f32x4*)fp = (f32x4){gt[0] * v[0], gt[1] * v[1], gt[2] * v[2], gt[3] * v[3]};
                                *(f32x4*)(fp + 4) = (f32x4){gt[4] * v[4], gt[5] * v[5], gt[6] * v[6], gt[7] * v[7]};
                            } else {
                                const f32x4 t0 = *(const f32x4*)fp, t1 = *(const f32x4*)(fp + 4);
                                float s[8];
#pragma unroll
                                for (int j = 0; j < 4; ++j) { s[j] = t0[j] + gt[j] * v[j]; s[4 + j] = t1[j] + gt[4 + j] * v[4 + j]; }
                                if constexpr (KIND == EK_BR1) { *(f32x4*)fp = (f32x4){s[0], s[1], s[2], s[3]}; *(f32x4*)(fp + 4) = (f32x4){s[4], s[5], s[6], s[7]}; }
                                else *(u32x2*)((unsigned char*)O + (size_t)row * ldo + col) = pack8_i8(s, MSCALE);
                            }
                        } else if constexpr (KIND == EK_WOUT) {
                            float hv[8]; unpack8(*(const u32x4*)(X + (size_t)row * ldx + col), hv);
#pragma unroll
                            for (int j = 0; j < 8; ++j) v[j] = v[j] * osc + DN_ALPHA * hv[j];
                            *(u32x4*)(O + (size_t)row * ldo + col) = pack8(v);
                        }
                        asm volatile("" ::: "memory");
                    }
                }
        }
    }
};
}

#define XB_TMO      128
#define XB_XCNT(j)  (256  + 64 * (j))
#define XB_XSUB(j)  (1280 + 64 * (j))
#define XB_XGEN(j)  (2304 + 64 * (j))
#define XB_TOP      3328
#define XB_TOPGEN   3392
#define XCD_BAR_WORDS 3456
#define XB_SPIN_CAP (1u << 20)
__device__ __forceinline__ unsigned xb_ld(unsigned* p)              { return __hip_atomic_load(p, __ATOMIC_RELAXED, __HIP_MEMORY_SCOPE_AGENT); }
__device__ __forceinline__ unsigned xb_add(unsigned* p, unsigned v) { return __hip_atomic_fetch_add(p, v, __ATOMIC_RELAXED, __HIP_MEMORY_SCOPE_AGENT); }
__device__ __forceinline__ unsigned xb_xcc_id() { return (unsigned)__builtin_amdgcn_s_getreg((3 << 11) | 20) & 0xFu; }
#define XB_SPIN(cond, bar) do { unsigned _sp = 0; while (cond) { __builtin_amdgcn_s_sleep(1); \
    if ((++_sp & 255u) == 0u) { if (xb_ld(&(bar)[XB_TMO])) break; if (_sp > XB_SPIN_CAP) { atomicAdd(&(bar)[XB_TMO], 1u); break; } } } } while (0)
struct XcdBarrier { unsigned* bar; unsigned x; volatile LAS unsigned* st; };
__device__ __forceinline__ XcdBarrier xcd_barrier_post(unsigned* bar, volatile LAS unsigned* st, int tid) {
    XcdBarrier b; b.bar = bar; b.x = xb_xcc_id(); b.st = st;
    if (tid == 0) (void)xb_add(&bar[XB_XCNT(b.x)], 1u);
    return b;
}
__device__ __forceinline__ void xcd_barrier_complete(unsigned* bar, unsigned x, unsigned& nloc, unsigned& nx) {
    const unsigned G = gridDim.x * gridDim.y * gridDim.z;
    unsigned sum, cnt, mine, sp = 0u;
    for (;;) {
        sum = 0u; cnt = 0u; mine = 0u;
#pragma unroll
        for (unsigned j = 0; j < 16; ++j) { const unsigned c = xb_ld(&bar[XB_XCNT(j)]); sum += c; cnt += (c > 0u) ? 1u : 0u; mine = (j == x) ? c : mine; }
        if (sum == G) break;
        __builtin_amdgcn_s_sleep(1);
        if ((++sp & 255u) == 0u) { if (xb_ld(&bar[XB_TMO])) break; if (sp > XB_SPIN_CAP) { atomicAdd(&bar[XB_TMO], 1u); break; } }
    }
    nloc = mine > 0u ? mine : 1u; nx = cnt > 0u ? cnt : 1u;
}
__device__ __forceinline__ void xcd_barrier(const XcdBarrier& b, int tid) {
    asm volatile("s_waitcnt vmcnt(0)" ::: "memory");
    __syncthreads();
    if (tid == 0) {
        unsigned* bar = b.bar;
        __builtin_amdgcn_s_waitcnt(0);
        unsigned nloc = b.st[0], nx = b.st[1];
        if (nloc == 0u) { xcd_barrier_complete(bar, b.x, nloc, nx); b.st[0] = nloc; b.st[1] = nx; }
        const unsigned old = xb_add(&bar[XB_XSUB(b.x)], 1u);
        const unsigned gen = old / nloc;
        if (old + 1u == (gen + 1u) * nloc) {
            __builtin_amdgcn_fence(__ATOMIC_RELEASE, "agent");
            asm volatile("s_waitcnt vmcnt(0)" ::: "memory");
            const unsigned og = xb_add(&bar[XB_TOP], 1u);
            const unsigned tg = og / nx;
            if (og + 1u == (tg + 1u) * nx) xb_add(&bar[XB_TOPGEN], 1u);
            else XB_SPIN(xb_ld(&bar[XB_TOPGEN]) == tg, bar);
            __builtin_amdgcn_fence(__ATOMIC_ACQUIRE, "agent");
            xb_add(&bar[XB_XGEN(b.x)], 1u);
            asm volatile("s_waitcnt vmcnt(0)" ::: "memory");
        } else {
            XB_SPIN(xb_ld(&bar[XB_XGEN(b.x)]) == gen, bar);
            __builtin_amdgcn_fence(__ATOMIC_ACQUIRE, "agent");
            asm volatile("s_waitcnt vmcnt(0)" ::: "memory");
        }
    }
    __syncthreads();
}

struct Args { const float* in[32]; float* out; unsigned char* ws; int lo, hi; };
typedef const __attribute__((address_space(4))) Args* ArgsP;
enum { I_X = 0, I_LN0G, I_LN0B, I_WIN, I_POOLW, I_POOLS, I_CKPE, I_CKW1, I_CKW2, I_CVPE, I_CVW1, I_CVW2, I_RELB, I_CONVW, I_CONVB, I_DTB, I_ALOG, I_DSKIP, I_SNG,
       I_WBP, I_WBN, I_WBS, I_WOUT, I_LN1G, I_LN1B, I_RW, I_RB, I_EW1, I_EW3, I_EW2, I_LN2G, I_LN2B };


struct Ctx {
    LAS unsigned char* lds;
    unsigned* ctl;
    unsigned char* ws; unsigned char* dout;
    int tid, lane, wave, G, vcu, gw, NGW;
};

struct Job { const float* src; size_t sbatch; int ldw, K, c0, ncols; bf16_t* dst; int dbatch_rows, ldt, drow0, mode, nbatch, fp8; float wsc; };
constexpr int NJOBS = 15;
__device__ __forceinline__ Job get_job(ArgsP a, int l, int j) {
    unsigned char* wl = a->ws + WS_W + (size_t)l * W_LAYER;
    bf16_t* win = (bf16_t*)(wl + WO_IN); bf16_t* wg = (bf16_t*)(wl + WO_GATE);
    const float* w_in = a->in[I_WIN] + (size_t)l * DM * D_IN;
    Job J; J.sbatch = 0; J.dbatch_rows = 0; J.mode = 0; J.nbatch = 1; J.c0 = 0; J.drow0 = 0; J.fp8 = 0; J.wsc = WSCALE;
    switch (j) {
    case 0:  J.src = w_in; J.ldw = D_IN; J.K = 1024; J.c0 = 0;    J.ncols = 1792; J.dst = win; J.ldt = 1024; J.drow0 = 0; J.fp8 = 1; break;
    case 1:  J.src = w_in; J.ldw = D_IN; J.K = 1024; J.c0 = 1792; J.ncols = 24;   J.dst = win; J.ldt = 1024; J.drow0 = C_NG; J.fp8 = 1; break;
    case 2:  J.src = w_in; J.ldw = D_IN; J.K = 1024; J.c0 = 1816; J.ncols = 3072; J.dst = win; J.ldt = 1024; J.drow0 = C_Z; J.fp8 = 1; break;
    case 3:  J.src = w_in; J.ldw = D_IN; J.K = 1024; J.c0 = 4888; J.ncols = 16;   J.dst = win; J.ldt = 1024; J.drow0 = C_DT; J.fp8 = 1; break;
    case 4:  J.src = w_in; J.ldw = D_IN; J.K = 1024; J.c0 = 4904; J.ncols = 3072; J.dst = wg;  J.ldt = 1024; J.drow0 = 0; J.fp8 = 1; break;
    case 5:  J.src = a->in[I_WBN] + (size_t)l * 512 * 1024;  J.ldw = 1024; J.K = 512;  J.ncols = 1024; J.dst = (bf16_t*)(wl + WO_C + 512); J.ldt = 1024; J.fp8 = 1; J.wsc = WSCALE_CN; break;
    case 6:  J.src = a->in[I_WBS] + (size_t)l * 1024 * 1024; J.ldw = 1024; J.K = 1024; J.ncols = 1024; J.dst = (bf16_t*)(wl + WO_SSD); J.ldt = 1024; J.fp8 = 1; break;
    case 7:  J.src = a->in[I_WOUT] + (size_t)l * 1024 * 1024; J.ldw = 1024; J.K = 1024; J.ncols = 1024; J.dst = (bf16_t*)(wl + WO_OUT); J.ldt = 1024; J.fp8 = 1; J.wsc = WSCALE_OUT; break;
    case 8:  J.src = a->in[I_CKW1] + (size_t)l * 2048 * 128; J.ldw = 128; J.K = 2048; J.ncols = 128; J.dst = (bf16_t*)(wl + WO_W1); J.ldt = 2048; break;
    case 9:  J.src = a->in[I_CVW1] + (size_t)l * 2048 * 128; J.ldw = 128; J.K = 2048; J.ncols = 128; J.dst = (bf16_t*)(wl + WO_W1) + 128 * 2048; J.ldt = 2048; break;
    case 10: J.src = a->in[I_CKW2] + (size_t)l * 128 * 64; J.ldw = 64; J.K = 128; J.ncols = 64; J.dst = (bf16_t*)(wl + WO_W2); J.ldt = 128; break;
    case 11: J.src = a->in[I_CVW2] + (size_t)l * 128 * 64; J.ldw = 64; J.K = 128; J.ncols = 64; J.dst = (bf16_t*)(wl + WO_W2) + 64 * 128; J.ldt = 128; break;
    case 12: J.src = a->in[I_EW1] + (size_t)l * 16 * 1024 * 512; J.sbatch = (size_t)1024 * 512; J.ldw = 512; J.K = 1024; J.ncols = 512; J.dst = (bf16_t*)(wl + WO_UP); J.dbatch_rows = 1024; J.ldt = 1024; J.drow0 = 0;   J.mode = 1; J.nbatch = 16; J.fp8 = 1; break;
    case 13: J.src = a->in[I_EW3] + (size_t)l * 16 * 1024 * 512; J.sbatch = (size_t)1024 * 512; J.ldw = 512; J.K = 1024; J.ncols = 512; J.dst = (bf16_t*)(wl + WO_UP); J.dbatch_rows = 1024; J.ldt = 1024; J.drow0 = 128; J.mode = 1; J.nbatch = 16; J.fp8 = 1; break;
    default: J.src = a->in[I_EW2] + (size_t)l * 16 * 512 * 1024; J.sbatch = (size_t)512 * 1024; J.ldw = 1024; J.K = 512; J.ncols = 1024; J.dst = (bf16_t*)(wl + WO_DN); J.dbatch_rows = 1024; J.ldt = 512; J.nbatch = 16; J.fp8 = 1; J.wsc = WSCALE_DN; break;
    }
    return J;
}
__device__ __forceinline__ void tr_item(const Job& J, int item, LAS float* scr, int lane) {
    const int nblk = (J.ncols + 31) >> 5, kblk = J.K >> 6, per = nblk * kblk;
    const int bt = item / per, r = item - bt * per, kb = r / nblk, nb = r - kb * nblk, k0 = 64 * kb, n0 = 32 * nb;
    const int nv = (J.ncols - n0) < 32 ? (J.ncols - n0) : 32;
    const float* W = J.src + (size_t)bt * J.sbatch;
    { const int nn = lane & 31; const float* wp = W + (size_t)(k0 + (lane >> 5)) * J.ldw + J.c0 + n0 + nn; float v[32];
#pragma unroll
      for (int i = 0; i < 32; ++i) v[i] = (nn < nv) ? wp[(size_t)(2 * i) * J.ldw] : 0.f;
#pragma unroll
      for (int i = 0; i < 32; ++i) scr[(2 * i + (lane >> 5)) * 33 + nn] = v[i]; }
    LDS_WAIT();
    const int c = lane & 7;
#pragma unroll
    for (int j = 0; j < 4; ++j) { const int n = (lane >> 3) + 8 * j;
        if (n < nv) {
            const LAS float* s = scr + (8 * c) * 33 + n; const int nn = n0 + n;
            const int drow = bt * J.dbatch_rows + J.drow0 + (J.mode == 1 ? ((nn >> 7) * 256 + (nn & 127)) : nn);
            if (J.fp8) { u32x2 o; o.x = cvt4_i8(s[0 * 33] * J.wsc, s[1 * 33] * J.wsc, s[2 * 33] * J.wsc, s[3 * 33] * J.wsc); o.y = cvt4_i8(s[4 * 33] * J.wsc, s[5 * 33] * J.wsc, s[6 * 33] * J.wsc, s[7 * 33] * J.wsc);
                *(u32x2*)((unsigned char*)J.dst + (size_t)drow * J.ldt + k0 + 8 * c) = o; }
            else { u32x4 o; o.x = cvt_pk_bf16(s[0 * 33], s[1 * 33]); o.y = cvt_pk_bf16(s[2 * 33], s[3 * 33]); o.z = cvt_pk_bf16(s[4 * 33], s[5 * 33]); o.w = cvt_pk_bf16(s[6 * 33], s[7 * 33]);
                *(u32x4*)(J.dst + (size_t)drow * J.ldt + k0 + 8 * c) = o; } } }
    LDS_WAIT();
}
__device__ __forceinline__ void ln_row_f32(const float* xrow, const float* g, const float* b, bf16_t* orow, unsigned char* orow8, int lane) {
    const f32x4* xr = (const f32x4*)xrow + lane; f32x4 v[4]; float s = 0.f;
#pragma unroll
    for (int j = 0; j < 4; ++j) { v[j] = xr[64 * j]; s += (v[j].x + v[j].y) + (v[j].z + v[j].w); }
    const float mean = wave_sum(s) * (1.f / DM); float s2 = 0.f;
#pragma unroll
    for (int j = 0; j < 4; ++j) { v[j] = v[j] - mean; s2 += (v[j].x * v[j].x + v[j].y * v[j].y) + (v[j].z * v[j].z + v[j].w * v[j].w); }
    const float rstd = 1.f / sqrtf(wave_sum(s2) * (1.f / DM) + LN_EPS);
    u32x2* o8 = (u32x2*)orow + lane;
#pragma unroll
    for (int j = 0; j < 4; ++j) { const f32x4 gg = ((const f32x4*)g + lane)[64 * j], bb = ((const f32x4*)b + lane)[64 * j];
        const float y0 = v[j].x * rstd * gg.x + bb.x, y1 = v[j].y * rstd * gg.y + bb.y, y2 = v[j].z * rstd * gg.z + bb.z, y3 = v[j].w * rstd * gg.w + bb.w;
        u32x2 w; w.x = cvt_pk_bf16(y0, y1); w.y = cvt_pk_bf16(y2, y3); o8[64 * j] = w;
        ((unsigned*)orow8 + lane)[64 * j] = cvt4_i8(y0 * ASCALE, y1 * ASCALE, y2 * ASCALE, y3 * ASCALE); }
}
__device__ __forceinline__ int rel_bucket_dev(int n) {
    if (n < 16) return n;
    int b = 16;
    b += (n >= 19) + (n >= 21) + (n >= 24) + (n >= 27) + (n >= 31) + (n >= 35) + (n >= 40) + (n >= 46) + (n >= 52) + (n >= 59) + (n >= 67) + (n >= 77) + (n >= 87) + (n >= 99) + (n >= 113);
    return b;
}
__device__ __forceinline__ void p0_prologue(const Ctx& F, ArgsP a) {
    LAS float* scr = (LAS float*)(F.lds + F.wave * 16384);
    int base = 0;
    for (int l = 0; l < DEPTH; ++l)
        for (int j = 0; j < NJOBS; ++j) {
            const Job J = get_job(a, l, j);
            const int nitems = J.nbatch * (J.K >> 6) * ((J.ncols + 31) >> 5);
            int first = (F.gw - base) % F.NGW; if (first < 0) first += F.NGW;
            for (int it = first; it < nitems; it += F.NGW) tr_item(J, it, scr, F.lane);
            base = (base + nitems) % F.NGW;
        }
    { bf16_t* H = (bf16_t*)(a->ws + WS_H);
      for (int m = F.gw; m < T_; m += F.NGW) ln_row_f32(a->in[I_X] + (size_t)m * DM, a->in[I_LN0G], a->in[I_LN0B], H + (size_t)m * DM, a->ws + WS_H8 + (size_t)m * DM, F.lane); }
    { const int gt = blockIdx.x * 512 + F.tid, nthr = F.G * 512;
      for (int id = gt; id < DEPTH * 65536; id += nthr) {
          const int l = id >> 16, r = id & 65535, n = r & 1023, k8 = r >> 10, g = k8 >> 4, c0 = (k8 & 15) * 8;
          const float* pw = a->in[I_POOLW] + (size_t)l * 4 * 128 * 128 + (size_t)(g * 128 + c0) * 128;
          const float* sc = a->in[I_POOLS] + l * 512 + g * 128;
          const float* wb = a->in[I_WBP] + (size_t)l * 512 * 1024 + (size_t)(g * 128) * 1024 + n;
          float acc[8] = {0.f, 0.f, 0.f, 0.f, 0.f, 0.f, 0.f, 0.f};
          for (int d = 0; d < 128; ++d) { const float w = wb[(size_t)d * 1024] * sc[d];
#pragma unroll
              for (int i = 0; i < 8; ++i) acc[i] += pw[i * 128 + d] * w; }
          unsigned char* dst = a->ws + WS_W + (size_t)l * W_LAYER + WO_C + (size_t)n * 1024 + g * 128 + c0;
          *(u32x2*)dst = pack8_i8(acc, WSCALE_CN);
      } }
    for (int o = F.gw; o < DEPTH * 2 * 128; o += F.NGW) {
        const int l = o >> 8, kv = (o >> 7) & 1, col = o & 127;
        const float* pe = a->in[kv ? I_CVPE : I_CKPE] + (size_t)l * 2048; const float* w1 = a->in[kv ? I_CVW1 : I_CKW1] + (size_t)l * 2048 * 128 + col;
        float s = 0.f;
        for (int k = F.lane; k < 2048; k += 64) s += pe[k] * w1[(size_t)k * 128];
        s = wave_sum(s);
        if (F.lane == 0) ((float*)(a->ws + WS_MISC + MI_B1))[o] = s;
    }
    if (blockIdx.x == 0) {
        float* bt = (float*)(a->ws + WS_MISC + MI_BIAS);
        for (int i = F.tid; i < 8 * 128; i += 512) { const int hd = i >> 7, d = i & 127;
            bt[i] = (a->in[I_RELB][rel_bucket_dev(d) * 8 + hd] - a->in[I_RELB][31 * 8 + hd]) * LOG2E; }
    }
}

__device__ __forceinline__ void conv_phase(const Ctx& F, const bf16_t* P, bf16_t* XC, const float* cw, const float* cb) {
    const int gt = blockIdx.x * 512 + F.tid, nthr = F.G * 512;
    const int c = gt & 255;
    float w[4][8], b[8];
#pragma unroll
    for (int k = 0; k < 4; ++k)
#pragma unroll
        for (int i = 0; i < 8; ++i) w[k][i] = cw[k * 2048 + 8 * c + i];
#pragma unroll
    for (int i = 0; i < 8; ++i) b[i] = cb[8 * c + i];
    for (int id = gt; id < (TG / 16) * 256; id += nthr) {
        const int tl0 = (id >> 8) * 16, s0 = tl0 & (SEQ - 1);
        u32x4 raw[19];
#pragma unroll
        for (int r = 0; r < 19; ++r) raw[r] = (s0 + r - 3 >= 0) ? *(const u32x4*)(P + (size_t)(tl0 + r - 3) * LDP + C_XBC + 8 * c) : (u32x4){0u, 0u, 0u, 0u};
#pragma unroll
        for (int i = 0; i < 16; ++i) {
            float acc[8];
#pragma unroll
            for (int j = 0; j < 8; ++j) acc[j] = b[j];
#pragma unroll
            for (int k = 0; k < 4; ++k) { float x[8]; unpack8(raw[i + k], x);
#pragma unroll
                for (int j = 0; j < 8; ++j) acc[j] += w[k][j] * x[j]; }
#pragma unroll
            for (int j = 0; j < 8; ++j) acc[j] = siluf_(acc[j]);
            *(u32x4*)(XC + (size_t)(tl0 + i) * 2048 + 8 * c) = pack8(acc);
        }
    }
}
__device__ __forceinline__ void compress_unit(const Ctx& F, int cu, const bf16_t* P, const bf16_t* W1t, const bf16_t* W2t, const float* b1, bf16_t* KC, bf16_t* VC) {
    const int kv = cu & 1, g = (cu >> 1) & 1, nb = (cu >> 2) & 7, bl = cu >> 5;
    const int lane = F.lane, w = F.wave, fr = lane & 15, fq = lane >> 4;
    LAS bf16_t* hid = (LAS bf16_t*)F.lds;
    const bf16_t* w1 = W1t + (size_t)kv * 128 * 2048 + (size_t)(16 * w + fr) * 2048 + 8 * fq;
    int n0 = nb * 16 + fr; if (n0 > 126) n0 = 126;
    const bf16_t* a0 = P + (size_t)(bl * SEQ + 16 * n0) * LDP + C_KV + kv * 128 + g * 64 + 8 * fq;
    f32x4 acc0 = {0.f, 0.f, 0.f, 0.f}, acc1 = {0.f, 0.f, 0.f, 0.f};
#pragma unroll 8
    for (int kk = 0; kk < 64; kk += 2) {
        const int l = kk >> 1;
        const bf16x8 bb0 = *(const bf16x8*)(w1 + kk * 32), bb1 = *(const bf16x8*)(w1 + kk * 32 + 32);
        const bf16x8 x0 = *(const bf16x8*)(a0 + (size_t)l * LDP), x1 = *(const bf16x8*)(a0 + (size_t)l * LDP + 32);
        acc0 = mfma16(x0, bb0, acc0); acc1 = mfma16(x1, bb1, acc1);
    }
    const float bias = b1[kv * 128 + 16 * w + fr];
#pragma unroll
    for (int r = 0; r < 4; ++r) { const float x = acc0[r] + acc1[r] + bias, u = 0.7978845608f * (x + 0.044715f * x * x * x); hid[(4 * fq + r) * 136 + 16 * w + fr] = f2bf(x * sigmoidf_(2.f * u)); }
    __syncthreads();
    if (w < 4) { f32x4 acc = {0.f, 0.f, 0.f, 0.f};
      const bf16_t* w2 = W2t + (size_t)kv * 64 * 128 + (size_t)(16 * w + fr) * 128 + 8 * fq;
#pragma unroll
      for (int ks = 0; ks < 4; ++ks) { const bf16x8 aa = *(const LAS bf16x8*)(hid + fr * 136 + ks * 32 + 8 * fq); const bf16x8 bb = *(const bf16x8*)(w2 + ks * 32); acc = mfma16(aa, bb, acc); }
      bf16_t* dst = kv ? VC : KC;
#pragma unroll
      for (int r = 0; r < 4; ++r) { const int n = nb * 16 + 4 * fq + r; if (n < 127) dst[(size_t)(bl * 128 + n) * 128 + g * 64 + 16 * w + fr] = f2bf(acc[r]); }
    }
    __syncthreads();
}

template <int WIN>
__device__ __forceinline__ void pool_item(const bf16_t* P, bf16_t* R, int grp, int rq, int lane) {
    const int c = 16 * grp + (lane & 15), tl0 = (4 * rq + (lane >> 4)) * 8, s0 = tl0 & (SEQ - 1);
    constexpr int NROW = 7 + WIN;
    u32x4 raw[NROW];
#pragma unroll
    for (int k = 0; k < NROW; ++k) { const int sp = s0 - (WIN - 1) + k; raw[k] = (sp >= 0) ? *(const u32x4*)(P + (size_t)(tl0 - (WIN - 1) + k) * LDP + C_POOL + 8 * c) : (u32x4){0u, 0u, 0u, 0u}; }
#pragma unroll
    for (int i = 0; i < 8; ++i) {
        float sum[8] = {0.f, 0.f, 0.f, 0.f, 0.f, 0.f, 0.f, 0.f}, u0[8];
#pragma unroll
        for (int j = 0; j < WIN; ++j) { float x[8]; unpack8(raw[i + (WIN - 1) - j], x);
#pragma unroll
            for (int q = 0; q < 8; ++q) sum[q] += x[q]; }
        unpack8(raw[i + WIN - 1], u0);
        const int s = s0 + i, cnt = (s + 1) < WIN ? (s + 1) : WIN; const float inv = 1.f / (float)cnt;
#pragma unroll
        for (int q = 0; q < 8; ++q) sum[q] = sum[q] * inv - u0[q];
        *(u32x2*)((unsigned char*)R + (size_t)(tl0 + i) * 1024 + 8 * c) = pack8_i8(sum, RSCALE);
    }
}
__device__ __forceinline__ void fin_phase(const Ctx& F, const bf16_t* P, bf16_t* R, const bf16_t* Y, unsigned char* Y8, const float* normg) {
    for (int wi = F.gw; wi < 4 * (TG / 32); wi += F.NGW) {
        const int grp = wi & 3, rq = wi >> 2;
        if (grp == 0) pool_item<2>(P, R, 0, rq, F.lane); else if (grp == 1) pool_item<4>(P, R, 1, rq, F.lane); else if (grp == 2) pool_item<8>(P, R, 2, rq, F.lane); else pool_item<16>(P, R, 3, rq, F.lane);
    }
    const int lane = F.lane;
    float ng[16];
#pragma unroll
    for (int i = 0; i < 16; ++i) ng[i] = normg[16 * lane + i];
    u32x4 nx[4];
#define FIN_LOAD(tl_) do { nx[0] = *(const u32x4*)(Y + (size_t)(tl_) * 1024 + 16 * lane); nx[1] = *(const u32x4*)(Y + (size_t)(tl_) * 1024 + 16 * lane + 8); \
        nx[2] = *(const u32x4*)(P + (size_t)(tl_) * LDP + C_Z + 16 * lane); nx[3] = *(const u32x4*)(P + (size_t)(tl_) * LDP + C_Z + 16 * lane + 8); } while (0)
    if (F.gw < TG) FIN_LOAD(F.gw);
    for (int tl = F.gw; tl < TG; tl += F.NGW) {
        const u32x4 c0 = nx[0], c1 = nx[1], c2 = nx[2], c3 = nx[3];
        if (tl + F.NGW < TG) FIN_LOAD(tl + F.NGW);
        float y[16], z[16];
        { float t[8]; unpack8(c0, t);
#pragma unroll
          for (int i = 0; i < 8; ++i) y[i] = t[i];
          unpack8(c1, t);
#pragma unroll
          for (int i = 0; i < 8; ++i) y[8 + i] = t[i];
          unpack8(c2, t);
#pragma unroll
          for (int i = 0; i < 8; ++i) z[i] = t[i];
          unpack8(c3, t);
#pragma unroll
          for (int i = 0; i < 8; ++i) z[8 + i] = t[i]; }
        float ss = 0.f;
#pragma unroll
        for (int i = 0; i < 16; ++i) { y[i] *= z[i]; ss += y[i] * y[i]; }
        ss += __shfl_xor(ss, 1); ss += __shfl_xor(ss, 2); ss += __shfl_xor(ss, 4); ss += __shfl_xor(ss, 8);
        const float rstd = 1.f / sqrtf(ss * (1.f / 256.f) + LN_EPS);
        float o[8];
#pragma unroll
        for (int i = 0; i < 8; ++i) o[i] = y[i] * rstd * ng[i];
        *(u32x2*)(Y8 + (size_t)tl * 1024 + 16 * lane) = pack8_i8(o, YSCALE);
#pragma unroll
        for (int i = 0; i < 8; ++i) o[i] = y[8 + i] * rstd * ng[8 + i];
        *(u32x2*)(Y8 + (size_t)tl * 1024 + 16 * lane + 8) = pack8_i8(o, YSCALE);
    }
#undef FIN_LOAD
}

#ifndef NSA_X1
#define NSA_X1 0
#endif
#ifndef NSA_X2
#define NSA_X2 0
#endif
#ifndef SSD_REP
#define SSD_REP 0
#endif
#ifndef NSA_REP
#define NSA_REP 0
#endif
constexpr int NL_KT = 0, NL_VT = 32768, NL_BIAS = 65536, NL_IMP = 67584, NL_SEL = 101376, NL_UNI = 101632;
__device__ __forceinline__ void glds16(const void* gsrc, unsigned lds_dst) { unsigned keep;
    asm volatile("s_mov_b32 %0, m0\n\ts_mov_b32 m0, %2\n\ts_nop 0\n\tglobal_load_lds_dwordx4 %1, off\n\ts_mov_b32 m0, %0" : "=&s"(keep) : "v"(gsrc), "s"(lds_dst) : "memory"); }
#define NSA_WAITBAR(N) asm volatile("s_waitcnt vmcnt(" #N ") lgkmcnt(0)\n\ts_barrier" ::: "memory")

#define NSA_STORE_TILE(buf) do { \
    *(LAS u32x4*)(lds + NL_KT + (buf) * 8192 + (tid >> 6) * 1024 + (tid & 63) * 16) = kreg; \
    *(LAS u32x4*)(lds + NL_VT + (buf) * 8192 + ((tid & 7) >> 2) * 4096 + (tid >> 3) * 64 + (tid & 3) * 16) = vreg; } while (0)

__device__ __forceinline__ void nsa_qk(const LAS unsigned char* Kt, const bf16x8 (&qB)[4], int r32, int hi, f32x16& p0, f32x16& p1) {
    p0 = (f32x16){0.f, 0.f, 0.f, 0.f, 0.f, 0.f, 0.f, 0.f, 0.f, 0.f, 0.f, 0.f, 0.f, 0.f, 0.f, 0.f}; p1 = p0;
#pragma unroll
    for (int d0 = 0; d0 < 4; ++d0) {
        const bf16x8 k0 = *(const LAS bf16x8*)(Kt + (2 * d0 + hi) * 1024 + r32 * 16);
        const bf16x8 k1 = *(const LAS bf16x8*)(Kt + (2 * d0 + hi) * 1024 + 512 + r32 * 16);
        p0 = mfma32(k0, qB[d0], p0); p1 = mfma32(k1, qB[d0], p1);
    }
#if NSA_X1
    { f32x16 t0 = (f32x16){0.f, 0.f, 0.f, 0.f, 0.f, 0.f, 0.f, 0.f, 0.f, 0.f, 0.f, 0.f, 0.f, 0.f, 0.f, 0.f}, t1 = t0; asm volatile("" ::: "memory");
#pragma unroll
      for (int d0 = 0; d0 < 4; ++d0) {
        const bf16x8 k0 = *(const volatile LAS bf16x8*)(Kt + (2 * d0 + hi) * 1024 + r32 * 16);
        const bf16x8 k1 = *(const volatile LAS bf16x8*)(Kt + (2 * d0 + hi) * 1024 + 512 + r32 * 16);
        t0 = mfma32(k0, qB[d0], t0); t1 = mfma32(k1, qB[d0], t1); }
#pragma unroll
      for (int r = 0; r < 16; ++r) { p0[r] = 0.5f * (p0[r] + t0[r]); p1[r] = 0.5f * (p1[r] + t1[r]); } }
#endif
}
__device__ __forceinline__ void nsa_pv(const LAS unsigned char* Vt, int lane, int hi, const f32x16& p0, const f32x16& p1, f32x16& o0, f32x16& o1) {
    bf16x8 pB[4];
    { u32x4 t; t.x = cvt_pk_bf16(p0[0], p0[1]); t.y = cvt_pk_bf16(p0[2], p0[3]); t.z = cvt_pk_bf16(p0[4], p0[5]); t.w = cvt_pk_bf16(p0[6], p0[7]); pB[0] = __builtin_bit_cast(bf16x8, t);
      t.x = cvt_pk_bf16(p0[8], p0[9]); t.y = cvt_pk_bf16(p0[10], p0[11]); t.z = cvt_pk_bf16(p0[12], p0[13]); t.w = cvt_pk_bf16(p0[14], p0[15]); pB[1] = __builtin_bit_cast(bf16x8, t);
      t.x = cvt_pk_bf16(p1[0], p1[1]); t.y = cvt_pk_bf16(p1[2], p1[3]); t.z = cvt_pk_bf16(p1[4], p1[5]); t.w = cvt_pk_bf16(p1[6], p1[7]); pB[2] = __builtin_bit_cast(bf16x8, t);
      t.x = cvt_pk_bf16(p1[8], p1[9]); t.y = cvt_pk_bf16(p1[10], p1[11]); t.z = cvt_pk_bf16(p1[12], p1[13]); t.w = cvt_pk_bf16(p1[14], p1[15]); pB[3] = __builtin_bit_cast(bf16x8, t); }
    const LAS unsigned char* vb = Vt + (4 * hi + ((lane & 15) >> 2)) * 64 + ((lane >> 4) & 1) * 32 + (lane & 3) * 8;
#pragma unroll
    for (int ks = 0; ks < 4; ++ks) {
        const bf16x8 va0 = cat8(trrd(vb + ks * 1024), trrd(vb + ks * 1024 + 512));
        const bf16x8 va1 = cat8(trrd(vb + 4096 + ks * 1024), trrd(vb + 4096 + ks * 1024 + 512));
        o0 = mfma32(va0, pB[ks], o0); o1 = mfma32(va1, pB[ks], o1);
    }
}

template <int MODE>
__device__ __forceinline__ void nsa_smpv(LAS unsigned char* lds, int j, int buf, f32x16& p0, f32x16& p1, int qt, int ql, bool selq, const LAS float* biasH, int lane, int hi,
                                         float& m, float& l, f32x16& o0, f32x16& o1) {
    const int dj = qt - j, dq = 64 * dj + ql - 4 * hi;
    const bool near = dj <= 2, edge = (MODE == 2) && (dj == 8);
    if (near || edge) {
#pragma unroll
        for (int r = 0; r < 16; ++r) {
            const int d0 = dq - ((r & 3) + 8 * (r >> 2)), d1 = d0 - 32;
            const bool v0 = d0 >= 0 && (MODE == 1 || d0 < 512), v1 = d1 >= 0 && (MODE == 1 || d1 < 512);
            float b0 = 0.f, b1 = 0.f;
            if (near) { const int c0 = d0 < 0 ? 0 : (d0 > 127 ? 127 : d0), c1 = d1 < 0 ? 0 : (d1 > 127 ? 127 : d1); b0 = biasH[c0]; b1 = biasH[c1]; }
            p0[r] = v0 ? p0[r] + b0 : NEGBIG; p1[r] = v1 ? p1[r] + b1 : NEGBIG;
        }
    }
    float mx = fmaxf(p0[0], p1[0]);
#pragma unroll
    for (int r = 1; r < 16; ++r) mx = fmaxf(mx, fmaxf(p0[r], p1[r]));
    { auto rr = __builtin_amdgcn_permlane32_swap(__float_as_uint(mx), __float_as_uint(mx), false, false); mx = fmaxf(__uint_as_float(rr[0]), __uint_as_float(rr[1])); }
    mx = selq ? mx : NEGBIG;
    const float mn = fmaxf(m, mx), f = fexp2(m - mn), sub = selq ? mn : 3.0e38f; m = mn;
    float ls = 0.f;
#pragma unroll
    for (int r = 0; r < 16; ++r) {
#if NSA_X2
        float a0 = p0[r] - sub, a1 = p1[r] - sub; asm volatile("" : "+v"(a0), "+v"(a1)); const float e0 = fexp2(a0), e1 = fexp2(a1); a0 = p0[r] - sub; a1 = p1[r] - sub; asm volatile("" : "+v"(a0), "+v"(a1));
        p0[r] = 0.5f * (e0 + fexp2(a0)); p1[r] = 0.5f * (e1 + fexp2(a1)); ls += p0[r] + p1[r];
#else
        p0[r] = fexp2(p0[r] - sub); p1[r] = fexp2(p1[r] - sub); ls += p0[r] + p1[r];
#endif
    }
    l = l * f + ls;
    if (!__all(f == 1.f)) {
#pragma unroll
        for (int r = 0; r < 16; ++r) { o0[r] *= f; o1[r] *= f; }
    }
    nsa_pv(lds + NL_VT + buf * 8192, lane, hi, p0, p1, o0, o1);
}

template <int MODE>
__device__ __forceinline__ void nsa_branch(const Ctx& F, const bf16_t* Kg, const bf16_t* Vg, unsigned tiles, int qt, int ql, unsigned mysel,
                                           const LAS float* biasH, const bf16_t* qptr, float gate, f32x16& out0, f32x16& out1) {
    LAS unsigned char* lds = F.lds; int tid_ = F.tid; asm volatile("" : "+v"(tid_)); const int tid = tid_, lane = tid & 63, r32 = lane & 31, hi = lane >> 5;
    bf16x8 qB[4];
#pragma unroll
    for (int d0 = 0; d0 < 4; ++d0) qB[d0] = *(const bf16x8*)(qptr + 16 * d0);
    float m = NEGBIG, l = 0.f;
    f32x16 o0 = (f32x16){0.f, 0.f, 0.f, 0.f, 0.f, 0.f, 0.f, 0.f, 0.f, 0.f, 0.f, 0.f, 0.f, 0.f, 0.f, 0.f}, o1 = o0;
    const int w = F.wave; const bool grpA = w < 4;
    const unsigned lbase = (unsigned)(size_t)lds;
    const bf16_t* ksrc = Kg + (size_t)lane * LDP + 8 * w;
    const bf16_t* vsrc = Vg + (size_t)(16 * (w & 3) + (lane >> 2)) * LDP + (w >> 2) * 32 + (lane & 3) * 8;
    const unsigned kdst = (unsigned)__builtin_amdgcn_readfirstlane((int)(lbase + NL_KT + w * 1024)), vdst = (unsigned)__builtin_amdgcn_readfirstlane((int)(lbase + NL_VT + (w >> 2) * 4096 + (w & 3) * 1024));
#define NSA_DMA(jj, slot) do { glds16(ksrc + (size_t)(jj) * 64 * LDP, kdst + (slot) * 8192); glds16(vsrc + (size_t)(jj) * 64 * LDP, vdst + (slot) * 8192); } while (0)
#define NSA_POP(dst) do { if (rem) { dst = (MODE == 1) ? (__ffs(rem) - 1) : (31 - __clz(rem)); rem &= ~(1u << dst); } else dst = -1; } while (0)
    unsigned rem = tiles; int j, q1;
    NSA_POP(j); NSA_POP(q1);
    NSA_DMA(j, 0); if (q1 >= 0) NSA_DMA(q1, 1);
    int buf = 0, jp = -1, bufp = 0; bool selp = true, done = false, selq = true, act = false;
    f32x16 pp0 = o0, pp1 = o0;
    for (;;) {
        if (!done) {
            if (q1 >= 0) NSA_WAITBAR(2); else NSA_WAITBAR(0);
            int q2; NSA_POP(q2);
            if (q2 >= 0) NSA_DMA(q2, (buf + 2) & 3);
            selq = (MODE == 1) ? (((mysel >> j) & 1u) != 0u) : true;
            act = (MODE != 1) || __any(selq);
            if (grpA && act) { nsa_qk(lds + NL_KT + buf * 8192, qB, r32, hi, pp0, pp1); jp = j; bufp = buf; selp = selq; }
            if (jp >= 0) { nsa_smpv<MODE>(lds, jp, bufp, pp0, pp1, qt, ql, selp, biasH, lane, hi, m, l, o0, o1); jp = -1; }
            if (!grpA && act) { nsa_qk(lds + NL_KT + buf * 8192, qB, r32, hi, pp0, pp1); jp = j; bufp = buf; selp = selq; }
            if (q1 < 0) done = true; else { j = q1; q1 = q2; buf = (buf + 1) & 3; }
        } else {
            if (jp >= 0) nsa_smpv<MODE>(lds, jp, bufp, pp0, pp1, qt, ql, selp, biasH, lane, hi, m, l, o0, o1);
            break;
        }
    }
#undef NSA_DMA
#undef NSA_POP
    __syncthreads();
    const float lt = l + __shfl_xor(l, 32), sc = gate * frcp(lt);
#pragma unroll
    for (int r = 0; r < 16; ++r) { out0[r] += sc * o0[r]; out1[r] += sc * o1[r]; }
}

__device__ __forceinline__ void nsa_unit(const Ctx& F, int bl, int g, int qt, const bf16_t* P, const bf16_t* KC, const bf16_t* VC, const float* biasT, bf16_t* YB) {
    LAS unsigned char* lds = F.lds; int tid_ = F.tid; asm volatile("" : "+v"(tid_)); const int tid = tid_, lane = tid & 63, w = F.wave, r32 = lane & 31, hi = lane >> 5;
    const int h = w >> 1, ql = 32 * (w & 1) + r32, t = 64 * qt + ql;
    const size_t row = (size_t)bl * SEQ + t;
    ((LAS float*)(lds + NL_BIAS))[tid] = biasT[(g * 4 + (tid >> 7)) * 128 + (tid & 127)];
    if (tid == 0) *(LAS unsigned*)(lds + NL_UNI) = 0u;
    const bf16_t* qptr = P + row * LDP + C_Q + g * 256 + h * 64 + 8 * hi;
    const float g_c = sigmoidf_(bf1(P[row * LDP + C_NG + g * 4 + h])), g_s = sigmoidf_(bf1(P[row * LDP + C_NG + 8 + g * 4 + h])), g_w = sigmoidf_(bf1(P[row * LDP + C_NG + 16 + g * 4 + h]));
    const LAS float* biasH = (const LAS float*)(lds + NL_BIAS) + h * 128;
    f32x16 out0 = (f32x16){0.f, 0.f, 0.f, 0.f, 0.f, 0.f, 0.f, 0.f, 0.f, 0.f, 0.f, 0.f, 0.f, 0.f, 0.f, 0.f}, out1 = out0;

    const int ntile = (qt >= 16) ? 2 : 1;
    for (int tl = 0; tl < ntile; ++tl) {
        int nk = 64 * tl + (tid & 63); if (nk > 126) nk = 126;
        int nv = 64 * tl + (tid >> 3); if (nv > 126) nv = 126;
        const u32x4 kreg = *(const u32x4*)(KC + (size_t)(bl * 128 + nk) * 128 + g * 64 + 8 * (tid >> 6));
        const u32x4 vreg = *(const u32x4*)(VC + (size_t)(bl * 128 + nv) * 128 + g * 64 + 8 * (tid & 7));
        NSA_STORE_TILE(tl);
    }
    __syncthreads();
    {
        f32x16 s0, s1, s2, s3;
        { bf16x8 qB[4];
#pragma unroll
          for (int d0 = 0; d0 < 4; ++d0) qB[d0] = *(const bf16x8*)(qptr + 16 * d0);
          nsa_qk(lds + NL_KT, qB, r32, hi, s0, s1);
          if (ntile == 2) nsa_qk(lds + NL_KT + 8192, qB, r32, hi, s2, s3);
          else { s2 = (f32x16){0.f, 0.f, 0.f, 0.f, 0.f, 0.f, 0.f, 0.f, 0.f, 0.f, 0.f, 0.f, 0.f, 0.f, 0.f, 0.f}; s3 = s2; } }
        const int db = t - 31 - 64 * hi;
        float mx = NEGBIG;
#define CMP_MASK(S, V) _Pragma("unroll") for (int r = 0; r < 16; ++r) { const int d = db - 16 * (32 * (V) + (r & 3) + 8 * (r >> 2)); \
            const int c = d < 0 ? 0 : (d > 127 ? 127 : d); S[r] = (d >= 0) ? S[r] + biasH[c] : NEGBIG; mx = fmaxf(mx, S[r]); }
        CMP_MASK(s0, 0) CMP_MASK(s1, 1)
        if (ntile == 2) { CMP_MASK(s2, 2) CMP_MASK(s3, 3) }
#undef CMP_MASK
        mx = fmaxf(mx, __shfl_xor(mx, 32));
        float ls = 0.f;
#define CMP_EXP(S) _Pragma("unroll") for (int r = 0; r < 16; ++r) { S[r] = (S[r] > -1e29f) ? fexp2(S[r] - mx) : 0.f; ls += S[r]; }
        CMP_EXP(s0) CMP_EXP(s1)
        if (ntile == 2) { CMP_EXP(s2) CMP_EXP(s3) }
#undef CMP_EXP
        ls += __shfl_xor(ls, 32);
        const float inv = ls > 0.f ? 1.f / ls : 0.f;
#pragma unroll
        for (int r = 0; r < 16; ++r) { s0[r] *= inv; s1[r] *= inv; s2[r] *= inv; s3[r] *= inv; }
        LAS float* I = (LAS float*)(lds + NL_IMP) + (h * 64 + ql) * 33 + hi;
        float yprev = 0.f;
#define CMP_IMP(S, V) _Pragma("unroll") for (int a = 0; a < 4; ++a) { const float own = S[4 * a] + S[4 * a + 1] + S[4 * a + 2] + 0.5f * S[4 * a + 3]; \
            const float y = __shfl_xor(0.5f * S[4 * a + 3], 32); I[2 * (4 * (V) + a)] = own + (hi ? y : yprev); yprev = y; }
        CMP_IMP(s0, 0) CMP_IMP(s1, 1) CMP_IMP(s2, 2) CMP_IMP(s3, 3)
#undef CMP_IMP
        f32x16 o0 = (f32x16){0.f, 0.f, 0.f, 0.f, 0.f, 0.f, 0.f, 0.f, 0.f, 0.f, 0.f, 0.f, 0.f, 0.f, 0.f, 0.f}, o1 = o0;
        nsa_pv(lds + NL_VT, lane, hi, s0, s1, o0, o1);
        if (ntile == 2) nsa_pv(lds + NL_VT + 8192, lane, hi, s2, s3, o0, o1);
#pragma unroll
        for (int r = 0; r < 16; ++r) { out0[r] += g_c * o0[r]; out1[r] += g_c * o1[r]; }
    }
    __syncthreads();
    if (w == 0) {
        const LAS float* I = (const LAS float*)(lds + NL_IMP) + lane * 33;
        float v[32];
#pragma unroll
        for (int jj = 0; jj < 32; ++jj) v[jj] = (I[jj] + I[64 * 33 + jj]) + (I[128 * 33 + jj] + I[192 * 33 + jj]);
        unsigned sel = 1u | (1u << qt) | (qt >= 1 ? (1u << (qt - 1)) : 0u);
        const int need = 8 - __popc(sel);
#pragma unroll
        for (int it = 0; it < 5; ++it) {
            if (it < need) {
                int best = -1; float bv = -1e30f;
#pragma unroll
                for (int jj = 1; jj < 32; ++jj) { const bool ok = (jj <= qt - 2) && (((sel >> jj) & 1u) == 0u) && (v[jj] > bv); bv = ok ? v[jj] : bv; best = ok ? jj : best; }
                if (best >= 0) sel |= 1u << best;
            }
        }
        ((LAS unsigned*)(lds + NL_SEL))[lane] = sel;
        atomicOr((unsigned*)(lds + NL_UNI), sel);
    }
    __syncthreads();
    const unsigned uni = *(const LAS unsigned*)(lds + NL_UNI) & ((qt >= 31) ? 0xffffffffu : ((2u << qt) - 1u));
    const unsigned mysel = ((const LAS unsigned*)(lds + NL_SEL))[ql];
    const bf16_t* Pb = P + (size_t)bl * SEQ * LDP + C_KV + g * 64;
    nsa_branch<1>(F, Pb + 256, Pb + 384, uni, qt, ql, mysel, biasH, qptr, g_s, out0, out1);
    { const int lo = qt >= 8 ? qt - 8 : 0; const unsigned wm = (((qt >= 31) ? 0xffffffffu : ((2u << qt) - 1u)) >> lo) << lo;
      nsa_branch<2>(F, Pb + 512, Pb + 640, wm, qt, ql, 0u, biasH, qptr, g_w, out0, out1); }
    unsigned char* yo = (unsigned char*)YB + row * 1024 + 512 + g * 256 + h * 64 + 4 * hi;
#pragma unroll
    for (int a = 0; a < 4; ++a) {
        *(unsigned*)(yo + 8 * a) = cvt4_i8(out0[4 * a] * BSCALE, out0[4 * a + 1] * BSCALE, out0[4 * a + 2] * BSCALE, out0[4 * a + 3] * BSCALE);
        *(unsigned*)(yo + 32 + 8 * a) = cvt4_i8(out1[4 * a] * BSCALE, out1[4 * a + 1] * BSCALE, out1[4 * a + 2] * BSCALE, out1[4 * a + 3] * BSCALE);
    }
    __syncthreads();
}

#define LDS_BARRIER() asm volatile("s_waitcnt lgkmcnt(0)\n\ts_barrier" ::: "memory")
constexpr int SL_CT = 0, SL_BT = 34816, SL_XT = 69632, SL_XD = 77824, SL_XW = 86016, SL_HT = 94208, SL_YO = 102912, SL_AW = 119296, SL_DW = 123392;
__device__ __forceinline__ void ssd_diag(const LAS unsigned char* lds, const LAS float* A_, int si, int li, int r32, int hi, int q4, int p4, int g1, f32x16& y) {
    const int lidx = 32 * li + r32; const float acl = A_[lidx];
    f32x16 s = (f32x16){0.f, 0.f, 0.f, 0.f, 0.f, 0.f, 0.f, 0.f, 0.f, 0.f, 0.f, 0.f, 0.f, 0.f, 0.f, 0.f};
#pragma unroll
    for (int kk = 0; kk < 8; ++kk) {
        const bf16x8 aa = *(const LAS bf16x8*)(lds + SL_BT + (32 * si + r32) * 272 + (16 * kk + 8 * hi) * 2);
        const bf16x8 bb = *(const LAS bf16x8*)(lds + SL_CT + lidx * 272 + (16 * kk + 8 * hi) * 2);
        s = mfma32(aa, bb, s);
    }
#pragma unroll
    for (int r = 0; r < 16; ++r) { const int sidx = 32 * si + crow(r, hi); const float e = fexp2(acl - A_[sidx]); s[r] = (sidx <= lidx) ? s[r] * e : 0.f; }
    u32x4 t0, t1;
    t0.x = cvt_pk_bf16(s[0], s[1]); t0.y = cvt_pk_bf16(s[2], s[3]); t0.z = cvt_pk_bf16(s[4], s[5]); t0.w = cvt_pk_bf16(s[6], s[7]);
    t1.x = cvt_pk_bf16(s[8], s[9]); t1.y = cvt_pk_bf16(s[10], s[11]); t1.z = cvt_pk_bf16(s[12], s[13]); t1.w = cvt_pk_bf16(s[14], s[15]);
    const LAS unsigned char* xb = lds + SL_XD + (32 * si + 4 * hi + q4) * 64 + g1 * 32 + p4 * 8;
    y = mfma32(cat8(trrd(xb), trrd(xb + 512)), __builtin_bit_cast(bf16x8, t0), y);
    y = mfma32(cat8(trrd(xb + 1024), trrd(xb + 1536)), __builtin_bit_cast(bf16x8, t1), y);
}
__device__ __forceinline__ void ssd_yoff(const LAS unsigned char* lds, const LAS float* A_, int li, int r32, int hi, f32x16& y) {
    const int lidx = 32 * li + r32;
#pragma unroll
    for (int kk = 0; kk < 8; ++kk) {
        const bf16x8 aa = *(const LAS bf16x8*)(lds + SL_HT + r32 * 272 + (16 * kk + 8 * hi) * 2);
        const bf16x8 bb = *(const LAS bf16x8*)(lds + SL_CT + lidx * 272 + (16 * kk + 8 * hi) * 2);
        y = mfma32(aa, bb, y);
    }
    const float el = fexp2(A_[lidx]);
#pragma unroll
    for (int r = 0; r < 16; ++r) y[r] *= el;
}
__device__ __forceinline__ void ssd_unit(const Ctx& F, int bl, int hd, int ph, const bf16_t* P, const bf16_t* XC, float dtb, float Aneg, float Dh, bf16_t* YP) {
    LAS unsigned char* lds = F.lds; int tid_ = F.tid; asm volatile("" : "+v"(tid_)); const int tid = tid_, lane = tid & 63, w = F.wave, r32 = lane & 31, hi = lane >> 5;
    const int g = hd >> 2, p0 = 32 * ph; const size_t rowb = (size_t)bl * SEQ;
    const int q4 = (lane & 15) >> 2, p4 = lane & 3, g1 = (lane >> 4) & 1;
    LAS float* A_ = (LAS float*)(lds + SL_AW) + w * 128; LAS float* D_ = (LAS float*)(lds + SL_DW) + w * 128;
    u32x4 creg[4], breg[4], xreg; float dt0 = 0.f, dt1 = 0.f;
#define SSD_LOAD(ch) do { const bf16_t* xc = XC + (rowb + (size_t)(ch) * 128) * 2048; \
        _Pragma("unroll") for (int i = 0; i < 4; ++i) { const int r = (tid >> 4) + 32 * i; \
            creg[i] = *(const u32x4*)(xc + (size_t)r * 2048 + 1536 + g * 128 + 8 * (tid & 15)); breg[i] = *(const u32x4*)(xc + (size_t)r * 2048 + 1024 + g * 128 + 8 * (tid & 15)); } \
        xreg = *(const u32x4*)(xc + (size_t)(tid >> 2) * 2048 + hd * 64 + p0 + 8 * (tid & 3)); \
        dt0 = bf1(P[(rowb + (size_t)(ch) * 128 + 2 * lane) * LDP + C_DT + hd]); dt1 = bf1(P[(rowb + (size_t)(ch) * 128 + 2 * lane + 1) * LDP + C_DT + hd]); } while (0)
    f32x16 hs = (f32x16){0.f, 0.f, 0.f, 0.f, 0.f, 0.f, 0.f, 0.f, 0.f, 0.f, 0.f, 0.f, 0.f, 0.f, 0.f, 0.f};
    SSD_LOAD(0);
    for (int ch = 0; ch < 16; ++ch) {
        { float x0 = dt0 + dtb, x1 = dt1 + dtb; const float v0 = x0 > 15.f ? x0 : __logf(1.f + __expf(x0)), v1 = x1 > 15.f ? x1 : __logf(1.f + __expf(x1));
          const float a0 = v0 * Aneg * LOG2E, a1 = v1 * Aneg * LOG2E; float sc = a0 + a1;
#pragma unroll
          for (int o = 1; o < 64; o <<= 1) { const float tt = __shfl_up(sc, o); if (lane >= o) sc += tt; }
          A_[2 * lane] = sc - a1; A_[2 * lane + 1] = sc; D_[2 * lane] = v0; D_[2 * lane + 1] = v1; }
#pragma unroll
        for (int i = 0; i < 4; ++i) { const int r = (tid >> 4) + 32 * i;
            *(LAS u32x4*)(lds + SL_CT + r * 272 + (tid & 15) * 16) = creg[i]; *(LAS u32x4*)(lds + SL_BT + r * 272 + (tid & 15) * 16) = breg[i]; }
        *(LAS u32x4*)(lds + SL_XT + (tid >> 2) * 64 + (tid & 3) * 16) = xreg;
        { const int lrow = tid >> 2; const float dl = D_[lrow], wl = dl * fexp2(A_[127] - A_[lrow]);
          float x[8], xd[8], xw[8]; unpack8(xreg, x);
#pragma unroll
          for (int i = 0; i < 8; ++i) { xd[i] = x[i] * dl; xw[i] = x[i] * wl; }
          *(LAS u32x4*)(lds + SL_XD + lrow * 64 + (tid & 3) * 16) = pack8(xd); *(LAS u32x4*)(lds + SL_XW + lrow * 64 + (tid & 3) * 16) = pack8(xw); }
        if (w >= 4) {
#pragma unroll
            for (int a = 0; a < 4; ++a) { u32x2 t; t.x = cvt_pk_bf16(hs[4 * a], hs[4 * a + 1]); t.y = cvt_pk_bf16(hs[4 * a + 2], hs[4 * a + 3]);
                *(LAS u32x2*)(lds + SL_HT + r32 * 272 + (32 * (w - 4) + 8 * a + 4 * hi) * 2) = t; }
        }
        if (ch + 1 < 16) SSD_LOAD(ch + 1);
        LDS_BARRIER();
        f32x16 y = (f32x16){0.f, 0.f, 0.f, 0.f, 0.f, 0.f, 0.f, 0.f, 0.f, 0.f, 0.f, 0.f, 0.f, 0.f, 0.f, 0.f};
        {
            const int li_ = (w == 0) ? 0 : (w == 1 || w == 7) ? 1 : (w == 2 || w == 5) ? 2 : 3;
            const int si0 = (w == 4 || w == 5) ? 2 : (w == 6) ? 3 : 0;
            const int nd = (w == 7) ? 0 : (w >= 1 && w <= 3) ? 2 : 1;
            const int yo = (w == 0) ? 0 : (w == 4) ? 3 : (w == 5) ? 2 : (w == 7) ? 1 : -1;
            if (yo >= 0) ssd_yoff(lds, A_, yo, r32, hi, y);
#pragma unroll 1
            for (int d = 0; d < nd; ++d) ssd_diag(lds, A_, si0 + d, li_, r32, hi, q4, p4, g1, y);
        }
        if (w >= 4) {
            const int wi = w - 4;
            { const int slot = (w == 7) ? 0 : (w == 5) ? 1 : (w == 4) ? 2 : 3;
#pragma unroll
              for (int r = 0; r < 16; ++r) *(LAS float*)(lds + SL_YO + slot * 4096 + r * 256 + lane * 4) = y[r]; }
            const float dec = fexp2(A_[127]);
#pragma unroll
            for (int r = 0; r < 16; ++r) hs[r] *= dec;
#pragma unroll
            for (int kk = 0; kk < 8; ++kk) {
                const LAS unsigned char* ab = lds + SL_BT + (16 * kk + 8 * hi + q4) * 272 + (32 * wi + 16 * g1 + 4 * p4) * 2;
                const LAS unsigned char* bb = lds + SL_XW + (16 * kk + 8 * hi + q4) * 64 + g1 * 32 + p4 * 8;
                hs = mfma32(cat8(trrd(ab), trrd(ab + 4 * 272)), cat8(trrd(bb), trrd(bb + 256)), hs);
            }
        }
        LDS_BARRIER();
        if (w < 4) {
            const int li = w; bf16_t* yp = YP + (rowb + (size_t)ch * 128 + 32 * li + r32) * 1024 + hd * 64 + p0 + 4 * hi;
#pragma unroll
            for (int a = 0; a < 4; ++a) {
                const u32x2 xr = *(const LAS u32x2*)(lds + SL_XT + (32 * li + r32) * 64 + (8 * a + 4 * hi) * 2);
                float v[4] = {y[4 * a] + Dh * bflo(xr.x), y[4 * a + 1] + Dh * bfhi(xr.x), y[4 * a + 2] + Dh * bflo(xr.y), y[4 * a + 3] + Dh * bfhi(xr.y)};
                if (li >= 1) {
#pragma unroll
                    for (int i = 0; i < 4; ++i) v[i] += *(const LAS float*)(lds + SL_YO + (li - 1) * 4096 + (4 * a + i) * 256 + lane * 4);
                }
                if (li == 3) {
#pragma unroll
                    for (int i = 0; i < 4; ++i) v[i] += *(const LAS float*)(lds + SL_YO + 3 * 4096 + (4 * a + i) * 256 + lane * 4);
                }
                u32x2 o; o.x = cvt_pk_bf16(v[0], v[1]); o.y = cvt_pk_bf16(v[2], v[3]); *(u32x2*)(yp + 8 * a) = o;
            }
        }
        LDS_BARRIER();
    }
#undef SSD_LOAD
}

__device__ __forceinline__ void attn_phase(const Ctx& F, ArgsP a, int l, int gi) {
    LAS unsigned char* lds = F.lds;
    const bf16_t* P = (const bf16_t*)(a->ws + WS_ARENA + AR_P);
    const bf16_t* XC = (const bf16_t*)(F.dout + DO_XC);
    bf16_t* YP = (bf16_t*)(F.dout + DO_YC); bf16_t* YB = (bf16_t*)(F.dout + DO_R);
    const bf16_t* KC = (const bf16_t*)(a->ws + WS_MISC + MI_KC); const bf16_t* VC = (const bf16_t*)(a->ws + WS_MISC + MI_VC);
    const float* biasT = (const float*)(a->ws + WS_MISC + MI_BIAS);
    unsigned* ctr = F.ctl + CW_WQ + 64 * (l * NG + gi);
    constexpr int NSSD = BG * 16 * 2, NNSA = BG * 2 * 32;
    for (int item = F.vcu; item < NSSD; item += F.G) {
        const int bl = item >> 5, hd = (item >> 1) & 15, ph = item & 1;
        for (int rr_ = 0; rr_ <= SSD_REP; ++rr_) ssd_unit(F, bl, hd, ph, P, XC, a->in[I_DTB][l * 16 + hd], -__expf(a->in[I_ALOG][l * 16 + hd]), a->in[I_DSKIP][l * 16 + hd], YP);
    }
    for (;;) {
        if (F.tid == 0) *(LAS int*)(lds + LDSX + LX_WQ) = (int)__hip_atomic_fetch_add(ctr, 1u, __ATOMIC_RELAXED, __HIP_MEMORY_SCOPE_AGENT);
        __syncthreads();
        const int idx = *(const LAS int*)(lds + LDSX + LX_WQ);
        __syncthreads();
        if (idx >= NNSA) break;
        const int qt = 31 - (idx >> 4), bg = idx & 15;
        for (int rr_ = 0; rr_ <= NSA_REP; ++rr_) nsa_unit(F, bg >> 1, bg & 1, qt, P, KC, VC, biasT, YB);
    }
}


constexpr int RL_HI = 0, RL_LO = 33024, RL_GB = 66048, RL_LG = 74240, RL_ROWSTRIDE = 2064;
__device__ __forceinline__ void ln1_route_phase(const Ctx& F, ArgsP a, int l) {
    LAS unsigned char* lds = F.lds; const int tid = F.tid, lane = F.lane, w = F.wave, fr = lane & 15, q = lane >> 4;
    LAS int* lcnt = (LAS int*)(lds + LDSX + LX_CNTL); LAS int* lbase = (LAS int*)(lds + LDSX + LX_BASE); LAS int* rows = (LAS int*)(lds + LDSX + LX_ROWS);
    for (int i = tid; i < 16384; i += 512) { const float x = a->in[I_RW][i]; const bf16_t hi = f2bf(x); const bf16_t lo = f2bf(x - bf1(hi)); const int d = i >> 4, e = i & 15;
        *(LAS bf16_t*)(lds + RL_HI + e * RL_ROWSTRIDE + d * 2) = hi; *(LAS bf16_t*)(lds + RL_LO + e * RL_ROWSTRIDE + d * 2) = lo; }
    { LAS float* GB = (LAS float*)(lds + RL_GB); for (int i = tid; i < 1024; i += 512) { GB[i] = a->in[I_LN1G][l * DM + i]; GB[1024 + i] = a->in[I_LN1B][l * DM + i]; } }
    bf16_t* H1 = (bf16_t*)(a->ws + WS_PRE1);
    float rb[16];
#pragma unroll
    for (int e = 0; e < 16; ++e) rb[e] = a->in[I_RB][e];
    unsigned* gcnt = F.ctl + CW_CNT + 64 * l;
    int* rtok = (int*)(a->ws + WS_ARENA + AR_RTOK); int2* rinfo = (int2*)(a->ws + WS_ARENA + AR_RINFO);
    for (int rb0 = blockIdx.x * 128; rb0 < T_; rb0 += F.G * 128) {
        if (tid < 16) lcnt[tid] = 0;
        __syncthreads();
        {
            bf16_t* rowp = H1 + ((size_t)rb0 + w * 16 + fr) * DM + 8 * q;
            float s = 0.f, ss = 0.f;
#pragma unroll 8
            for (int kk = 0; kk < 32; ++kk) { float x[8]; unpack8(*(const u32x4*)(rowp + 32 * kk), x);
#pragma unroll
                for (int j = 0; j < 8; ++j) { s += x[j]; ss += x[j] * x[j]; } }
            s += __shfl_xor(s, 16); s += __shfl_xor(s, 32); ss += __shfl_xor(ss, 16); ss += __shfl_xor(ss, 32);
            const float mean = s * (1.f / DM), rstd = 1.f / sqrtf(fmaxf(ss * (1.f / DM) - mean * mean, 0.f) + LN_EPS);
            f32x4 acc = {0.f, 0.f, 0.f, 0.f};
            const LAS float* GB = (const LAS float*)(lds + RL_GB);
#pragma unroll 2
            for (int kk = 0; kk < 32; ++kk) {
                float x[8], lo[8]; unpack8(*(const u32x4*)(rowp + 32 * kk), x);
                const f32x4 g0 = *(const LAS f32x4*)(GB + 32 * kk + 8 * q), g1 = *(const LAS f32x4*)(GB + 32 * kk + 8 * q + 4);
                const f32x4 b0 = *(const LAS f32x4*)(GB + 1024 + 32 * kk + 8 * q), b1 = *(const LAS f32x4*)(GB + 1024 + 32 * kk + 8 * q + 4);
#pragma unroll
                for (int j = 0; j < 4; ++j) { x[j] = (x[j] - mean) * rstd * g0[j] + b0[j]; x[4 + j] = (x[4 + j] - mean) * rstd * g1[j] + b1[j]; }
                const u32x4 hp = pack8(x);
                *(u32x4*)(rowp + 32 * kk) = hp;
                *(u32x2*)(a->ws + WS_H18 + ((size_t)rb0 + w * 16 + fr) * DM + 8 * q + 32 * kk) = pack8_i8(x, ASCALE);
                { float hf[8]; unpack8(hp, hf);
#pragma unroll
                  for (int j = 0; j < 8; ++j) lo[j] = x[j] - hf[j]; }
                const bf16x8 ahi = __builtin_bit_cast(bf16x8, hp), alo = __builtin_bit_cast(bf16x8, pack8(lo));
                const bf16x8 bhi = *(const LAS bf16x8*)(lds + RL_HI + fr * RL_ROWSTRIDE + (32 * kk + 8 * q) * 2), blo = *(const LAS bf16x8*)(lds + RL_LO + fr * RL_ROWSTRIDE + (32 * kk + 8 * q) * 2);
                acc = mfma16(ahi, bhi, acc); acc = mfma16(ahi, blo, acc); acc = mfma16(alo, bhi, acc);
                asm volatile("" ::: "memory");
            }
            LAS float* LG = (LAS float*)(lds + RL_LG) + w * 256;
#pragma unroll
            for (int r = 0; r < 4; ++r) LG[(4 * q + r) * 16 + fr] = acc[r];
        }
        LDS_WAIT();
        if (lane < 16) {
            const LAS float* LG = (const LAS float*)(lds + RL_LG) + w * 256 + lane * 16;
            float lg[16];
#pragma unroll
            for (int e4 = 0; e4 < 4; ++e4) { const f32x4 t = *(const LAS f32x4*)(LG + 4 * e4); lg[4 * e4] = t[0]; lg[4 * e4 + 1] = t[1]; lg[4 * e4 + 2] = t[2]; lg[4 * e4 + 3] = t[3]; }
            float mx = lg[0];
#pragma unroll
            for (int e = 1; e < 16; ++e) mx = fmaxf(mx, lg[e]);
            float pr[16], ps = 0.f;
#pragma unroll
            for (int e = 0; e < 16; ++e) { pr[e] = __expf(lg[e] - mx); ps += pr[e]; }
            const float pinv = 1.f / ps;
            float sc[16];
#pragma unroll
            for (int e = 0; e < 16; ++e) { pr[e] *= pinv; sc[e] = pr[e] + rb[e]; }
            int grp = 0; float gbest = -1e30f;
#pragma unroll
            for (int qq = 0; qq < 4; ++qq) {
                const float s0 = sc[4 * qq], s1 = sc[4 * qq + 1], s2_ = sc[4 * qq + 2], s3 = sc[4 * qq + 3];
                const float tot = (s0 + s1) + (s2_ + s3), mn1 = fminf(fminf(s0, s1), fminf(s2_, s3));
                const float m2 = fminf(fminf(fminf(fmaxf(s0, s1), fmaxf(s0, s2_)), fminf(fmaxf(s0, s3), fmaxf(s1, s2_))), fminf(fmaxf(s1, s3), fmaxf(s2_, s3)));
                const float top2 = tot - mn1 - m2;
                if (top2 > gbest) { gbest = top2; grp = qq; }
            }
            float c0 = 0.f, c1 = 0.f, c2 = 0.f, c3 = 0.f, q0 = 0.f, q1 = 0.f, q2 = 0.f, q3 = 0.f;
#pragma unroll
            for (int qq = 0; qq < 4; ++qq) if (grp == qq) { c0 = sc[4 * qq]; c1 = sc[4 * qq + 1]; c2 = sc[4 * qq + 2]; c3 = sc[4 * qq + 3]; q0 = pr[4 * qq]; q1 = pr[4 * qq + 1]; q2 = pr[4 * qq + 2]; q3 = pr[4 * qq + 3]; }
            int i0 = 0; float b0 = c0; if (c1 > b0) { b0 = c1; i0 = 1; } if (c2 > b0) { b0 = c2; i0 = 2; } if (c3 > b0) { b0 = c3; i0 = 3; }
            int i1 = -1; float b1 = -1e30f;
            if (i0 != 0 && c0 > b1) { b1 = c0; i1 = 0; } if (i0 != 1 && c1 > b1) { b1 = c1; i1 = 1; } if (i0 != 2 && c2 > b1) { b1 = c2; i1 = 2; } if (i0 != 3 && c3 > b1) { b1 = c3; i1 = 3; }
            const float w0 = (i0 == 0) ? q0 : (i0 == 1) ? q1 : (i0 == 2) ? q2 : q3, w1 = (i1 == 0) ? q0 : (i1 == 1) ? q1 : (i1 == 2) ? q2 : q3;
            const float wn = 1.f / (w0 + w1);
            const int e0 = 4 * grp + i0, e1 = 4 * grp + i1, rl = w * 16 + lane;
            const int pos0 = atomicAdd((int*)(lds + LDSX + LX_CNTL) + e0, 1), pos1 = atomicAdd((int*)(lds + LDSX + LX_CNTL) + e1, 1);
            rows[rl * 8 + 0] = e0; rows[rl * 8 + 1] = e1; rows[rl * 8 + 2] = pos0; rows[rl * 8 + 3] = pos1; rows[rl * 8 + 4] = __float_as_int(w0 * wn); rows[rl * 8 + 5] = __float_as_int(w1 * wn);
        }
        __syncthreads();
        if (tid < 16) lbase[tid] = (int)__hip_atomic_fetch_add(gcnt + tid, (unsigned)lcnt[tid], __ATOMIC_RELAXED, __HIP_MEMORY_SCOPE_AGENT);
        __syncthreads();
        if (tid < 128) {
            const int e0 = rows[tid * 8], e1 = rows[tid * 8 + 1]; const int t = rb0 + tid;
            const int p0 = e0 * ECAP + lbase[e0] + rows[tid * 8 + 2], p1 = e1 * ECAP + lbase[e1] + rows[tid * 8 + 3];
            rtok[p0] = t; rinfo[p0] = make_int2(t, rows[tid * 8 + 4]); rtok[p1] = t; rinfo[p1] = make_int2(T_ + t, rows[tid * 8 + 5]);
        }
        __syncthreads();
    }
}

__device__ __forceinline__ int moe_tables(const Ctx& F, int l, const int* rtok) {
    LAS int* off = (LAS int*)(F.lds + LDSX + LX_OFF); LAS int* ecnt = (LAS int*)(F.lds + LDSX + LX_ECNT); LAS int* tile_e = (LAS int*)(F.lds + LDSX + LX_TILE); LAS int* gidx = (LAS int*)(F.lds + LDSX + LX_GIDX);
    __syncthreads();
    if (F.tid == 0) { int o = 0;
        for (int e = 0; e < 16; ++e) { off[e] = o; const int c = (int)__hip_atomic_load(F.ctl + CW_CNT + 64 * l + e, __ATOMIC_RELAXED, __HIP_MEMORY_SCOPE_AGENT); ecnt[e] = c; const int nt = (c + 255) >> 8;
            for (int k = 0; k < nt; ++k) tile_e[(o >> 8) + k] = e; o += nt << 8; }
        off[16] = o; }
    __syncthreads();
    const int nrt = off[16] >> 8;
    if (rtok) {
        for (int i = 0; i < 8; ++i) { const long L = (long)i * F.G + F.vcu; if (L >= (long)nrt * 4) break;
            const int rt = (int)(L >> 2), e = tile_e[rt], k0 = rt * 256 - off[e], c = ecnt[e];
            if (F.tid < 256) gidx[i * 256 + F.tid] = (k0 + F.tid < c) ? rtok[e * ECAP + k0 + F.tid] : 0; }
        __syncthreads();
    }
    return nrt;
}
__device__ __forceinline__ void ln2_phase(const Ctx& F, ArgsP a, int l, bool last) {
    const bf16_t* H1 = (const bf16_t*)(a->ws + WS_PRE1); const bf16_t* YS = (const bf16_t*)(a->ws + WS_ARENA + AR_XS);
    bf16_t* H = (bf16_t*)(a->ws + WS_H); float* OUT = a->out;
    const float* g = a->in[I_LN2G] + l * DM; const float* b = a->in[I_LN2B] + l * DM; const int lane = F.lane;
    float gg[16], bb[16];
#pragma unroll
    for (int i = 0; i < 8; ++i) { gg[i] = g[8 * lane + i]; gg[8 + i] = g[512 + 8 * lane + i]; bb[i] = b[8 * lane + i]; bb[8 + i] = b[512 + 8 * lane + i]; }
    u32x4 nx[6];
#define LN2_LOAD(t_) do { _Pragma("unroll") for (int hf = 0; hf < 2; ++hf) { nx[3 * hf] = *(const u32x4*)(H1 + (size_t)(t_) * DM + 512 * hf + 8 * lane); \
        nx[3 * hf + 1] = *(const u32x4*)(YS + (size_t)(t_) * DM + 512 * hf + 8 * lane); nx[3 * hf + 2] = *(const u32x4*)(YS + (size_t)(T_ + (t_)) * DM + 512 * hf + 8 * lane); } } while (0)
    LN2_LOAD(F.gw);
    for (int t = F.gw; t < T_; t += F.NGW) {
        float v[16];
        u32x4 cur[6];
#pragma unroll
        for (int i = 0; i < 6; ++i) cur[i] = nx[i];
        if (t + F.NGW < T_) LN2_LOAD(t + F.NGW);
#pragma unroll
        for (int hf = 0; hf < 2; ++hf) { float x[8], y0[8], y1[8];
            unpack8(cur[3 * hf], x);
            unpack8(cur[3 * hf + 1], y0);
            unpack8(cur[3 * hf + 2], y1);
#pragma unroll
            for (int i = 0; i < 8; ++i) v[8 * hf + i] = DN_ALPHA * x[i] + (y0[i] + y1[i]); }
        float s = 0.f;
#pragma unroll
        for (int i = 0; i < 16; ++i) s += v[i];
        const float mean = wave_sum(s) * (1.f / DM); float s2 = 0.f;
#pragma unroll
        for (int i = 0; i < 16; ++i) { v[i] -= mean; s2 += v[i] * v[i]; }
        const float rstd = 1.f / sqrtf(wave_sum(s2) * (1.f / DM) + LN_EPS);
#pragma unroll
        for (int i = 0; i < 16; ++i) v[i] = v[i] * rstd * gg[i] + bb[i];
        if (last) {
#pragma unroll
            for (int hf = 0; hf < 2; ++hf) { float* o = OUT + (size_t)t * DM + 512 * hf + 8 * lane;
                *(f32x4*)o = (f32x4){v[8 * hf], v[8 * hf + 1], v[8 * hf + 2], v[8 * hf + 3]}; *(f32x4*)(o + 4) = (f32x4){v[8 * hf + 4], v[8 * hf + 5], v[8 * hf + 6], v[8 * hf + 7]}; }
        } else {
#pragma unroll
            for (int hf = 0; hf < 2; ++hf) { float tt[8];
#pragma unroll
                for (int i = 0; i < 8; ++i) tt[i] = v[8 * hf + i];
                *(u32x4*)(H + (size_t)t * DM + 512 * hf + 8 * lane) = pack8(tt);
                *(u32x2*)(a->ws + WS_H8 + (size_t)t * DM + 512 * hf + 8 * lane) = pack8_i8(tt, ASCALE); }
        }
    }
}

#ifndef REP_MASK
#define REP_MASK 0
#endif
#ifndef PH_MASK
#define PH_MASK 0xfff
#endif
constexpr int NSTEPS = 1 + DEPTH * (NG * 6 + 4);
__global__ void __launch_bounds__(512, 2) fwd_kernel(Args a_unused) {
    const ArgsP a = (ArgsP)__builtin_amdgcn_kernarg_segment_ptr();
    extern __shared__ __attribute__((aligned(16))) unsigned char smem[];
    const int wave0_ = __builtin_amdgcn_readfirstlane((int)threadIdx.x >> 6);
    Ctx F;
#define MKCTX do { int t_; asm volatile("v_mbcnt_lo_u32_b32 %0, -1, 0\n\tv_mbcnt_hi_u32_b32 %0, -1, %0" : "=v"(t_)); t_ += wave0_ * 64; F.lds = (LAS unsigned char*)smem; F.tid = t_; F.lane = t_ & 63; F.wave = wave0_; \
        F.G = gridDim.x; { const int bx = blockIdx.x; F.vcu = (F.G % 8 == 0) ? (bx % 8) * (F.G / 8) + bx / 8 : bx; } \
        F.gw = blockIdx.x * 8 + F.wave; F.NGW = F.G * 8; F.ws = a->ws; F.dout = (unsigned char*)a->out; F.ctl = (unsigned*)(a->ws + WS_CTL); } while (0)
    MKCTX;
    for (int u = F.tid; u < (LDS_TOTAL - LDSX) / 4; u += 512) ((LAS unsigned*)(F.lds + LDSX))[u] = 0u;
    __syncthreads();
    const bool multi = (a->hi - a->lo) > 1;
    XcdBarrier bar; bar.bar = F.ctl + CW_BAR; bar.x = 0; bar.st = (volatile LAS unsigned*)(F.lds + LDSX + LX_BAR);
    if (multi) bar = xcd_barrier_post(F.ctl + CW_BAR, (volatile LAS unsigned*)(F.lds + LDSX + LX_BAR), F.tid);
    int step = 0;
#define RUN_STEP (step >= a->lo && step < a->hi)
#ifndef BAR_REP
#define BAR_REP 0
#endif
#define END_STEP do { if (RUN_STEP && step + 1 < a->hi) { xcd_barrier(bar, F.tid); if (BAR_REP) xcd_barrier(bar, F.tid); } ++step; } while (0)

    if (RUN_STEP && ((PH_MASK >> 0) & 1)) for (int rep_ = 0; rep_ <= ((REP_MASK >> 0) & 1); ++rep_) { MKCTX; p0_prologue(F, a); }
    END_STEP;

    {
        unsigned char* wl = a->ws + WS_W + (size_t)0 * W_LAYER;
        bf16_t* Hb = (bf16_t*)(a->ws + WS_H);
        bf16_t* P = (bf16_t*)(a->ws + WS_ARENA + AR_P);
        {
            const bf16_t* Hg = Hb + (size_t)0 * TG * DM;
            if (RUN_STEP && ((PH_MASK >> 1) & 1)) for (int rep_ = 0; rep_ <= ((REP_MASK >> 1) & 1); ++rep_) { MKCTX;
                pg8::Gemm g{(const bf16_t*)(a->ws + WS_H8 + (size_t)0 * TG * DM), (const bf16_t*)(wl + WO_IN), 512, 512, 512}; pg8::StaticOrder S; S.init(TG, LDP, 512, 512, F.G, (int)blockIdx.x, 512);
                pg8::Epi<pg8::EK_PROJ> E{P, LDP, nullptr, 0, nullptr, nullptr, nullptr, 1.f / (WSCALE * ASCALE)};
                pg8::gemm_phase<pg8::Epi<pg8::EK_PROJ>, pg8::StaticOrder, false, true>(F.lds, F.tid, g, S, E);
            }
            END_STEP;
            if (RUN_STEP && ((PH_MASK >> 2) & 1)) for (int rep_ = 0; rep_ <= ((REP_MASK >> 2) & 1); ++rep_) { MKCTX;
                for (int cu = blockIdx.x; cu < BG * 32; cu += F.G)
                    compress_unit(F, cu, P, (const bf16_t*)(wl + WO_W1), (const bf16_t*)(wl + WO_W2), (const float*)(a->ws + WS_MISC + MI_B1) + 0 * 256,
                                  (bf16_t*)(a->ws + WS_MISC + MI_KC), (bf16_t*)(a->ws + WS_MISC + MI_VC));
                conv_phase(F, P, (bf16_t*)(F.dout + DO_XC), a->in[I_CONVW] + (size_t)0 * 4 * 2048, a->in[I_CONVB] + (size_t)0 * 2048);
            }
            END_STEP;
            if (RUN_STEP && ((PH_MASK >> 3) & 1)) for (int rep_ = 0; rep_ <= ((REP_MASK >> 3) & 1); ++rep_) { MKCTX; attn_phase(F, a, 0, 0 + 4 * rep_); }
            END_STEP;
            if (RUN_STEP && ((PH_MASK >> 4) & 1)) for (int rep_ = 0; rep_ <= ((REP_MASK >> 4) & 1); ++rep_) { MKCTX; fin_phase(F, P, (bf16_t*)(F.dout + DO_R), (const bf16_t*)(F.dout + DO_YC), F.dout + DO_YC8, a->in[I_SNG] + (size_t)0 * DM); }
            END_STEP;
            if (RUN_STEP && ((PH_MASK >> 5) & 1)) for (int rep_ = 0; rep_ <= ((REP_MASK >> 5) & 1); ++rep_) { MKCTX;
                bf16_t* GT = (bf16_t*)(a->ws + WS_ARENA + AR_GATES); bf16_t* MX = (bf16_t*)(a->ws + WS_ARENA + AR_MIXIN); float* TMP = (float*)(F.dout + DO_TMP);
                pg8::Gemm g{nullptr, nullptr, 512, 512, 512};
                pg8::S5Order S; S.so.init(TG, DM, 512, 512, F.G, (int)blockIdx.x, 512);
                S.aH = (long)(size_t)(a->ws + WS_H8 + (size_t)0 * TG * DM); S.aRY = (long)(size_t)(F.dout + DO_R); S.aYC = (long)(size_t)(F.dout + DO_YC8);
                S.bG = (long)(size_t)(wl + WO_GATE); S.bCN = (long)(size_t)(wl + WO_C); S.bS = (long)(size_t)(wl + WO_SSD);
                pg8::Epi<pg8::EK_S5> E{GT, 3072, nullptr, 0, TMP, nullptr, MX, 1.f};
                pg8::gemm_phase<pg8::Epi<pg8::EK_S5>, pg8::S5Order, false, true>(F.lds, F.tid, g, S, E);
            }
            END_STEP;
            if (RUN_STEP && ((PH_MASK >> 6) & 1)) for (int rep_ = 0; rep_ <= ((REP_MASK >> 6) & 1); ++rep_) { MKCTX;
                pg8::Gemm g{(const bf16_t*)(a->ws + WS_ARENA + AR_MIXIN), (const bf16_t*)(wl + WO_OUT), 512, 512, 512}; pg8::StaticOrder S; S.init(TG, DM, 512, 512, F.G, (int)blockIdx.x, 512);
                pg8::Epi<pg8::EK_WOUT> E{(bf16_t*)(a->ws + WS_PRE1) + (size_t)0 * TG * DM, DM, Hg, DM, nullptr, nullptr, nullptr, 1.f / (WSCALE_OUT * MSCALE)};
                pg8::gemm_phase<pg8::Epi<pg8::EK_WOUT>, pg8::StaticOrder, false, true>(F.lds, F.tid, g, S, E);
            }
            END_STEP;
        }
        {
            const bf16_t* Hg = Hb + (size_t)1 * TG * DM;
            if (RUN_STEP && ((PH_MASK >> 1) & 1)) for (int rep_ = 0; rep_ <= ((REP_MASK >> 1) & 1); ++rep_) { MKCTX;
                pg8::Gemm g{(const bf16_t*)(a->ws + WS_H8 + (size_t)1 * TG * DM), (const bf16_t*)(wl + WO_IN), 512, 512, 512}; pg8::StaticOrder S; S.init(TG, LDP, 512, 512, F.G, (int)blockIdx.x, 512);
                pg8::Epi<pg8::EK_PROJ> E{P, LDP, nullptr, 0, nullptr, nullptr, nullptr, 1.f / (WSCALE * ASCALE)};
                pg8::gemm_phase<pg8::Epi<pg8::EK_PROJ>, pg8::StaticOrder, false, true>(F.lds, F.tid, g, S, E);
            }
            END_STEP;
            if (RUN_STEP && ((PH_MASK >> 2) & 1)) for (int rep_ = 0; rep_ <= ((REP_MASK >> 2) & 1); ++rep_) { MKCTX;
                for (int cu = blockIdx.x; cu < BG * 32; cu += F.G)
                    compress_unit(F, cu, P, (const bf16_t*)(wl + WO_W1), (const bf16_t*)(wl + WO_W2), (const float*)(a->ws + WS_MISC + MI_B1) + 0 * 256,
                                  (bf16_t*)(a->ws + WS_MISC + MI_KC), (bf16_t*)(a->ws + WS_MISC + MI_VC));
                conv_phase(F, P, (bf16_t*)(F.dout + DO_XC), a->in[I_CONVW] + (size_t)0 * 4 * 2048, a->in[I_CONVB] + (size_t)0 * 2048);
            }
            END_STEP;
            if (RUN_STEP && ((PH_MASK >> 3) & 1)) for (int rep_ = 0; rep_ <= ((REP_MASK >> 3) & 1); ++rep_) { MKCTX; attn_phase(F, a, 0, 1 + 4 * rep_); }
            END_STEP;
            if (RUN_STEP && ((PH_MASK >> 4) & 1)) for (int rep_ = 0; rep_ <= ((REP_MASK >> 4) & 1); ++rep_) { MKCTX; fin_phase(F, P, (bf16_t*)(F.dout + DO_R), (const bf16_t*)(F.dout + DO_YC), F.dout + DO_YC8, a->in[I_SNG] + (size_t)0 * DM); }
            END_STEP;
            if (RUN_STEP && ((PH_MASK >> 5) & 1)) for (int rep_ = 0; rep_ <= ((REP_MASK >> 5) & 1); ++rep_) { MKCTX;
                bf16_t* GT = (bf16_t*)(a->ws + WS_ARENA + AR_GATES); bf16_t* MX = (bf16_t*)(a->ws + WS_ARENA + AR_MIXIN); float* TMP = (float*)(F.dout + DO_TMP);
                pg8::Gemm g{nullptr, nullptr, 512, 512, 512};
                pg8::S5Order S; S.so.init(TG, DM, 512, 512, F.G, (int)blockIdx.x, 512);
                S.aH = (long)(size_t)(a->ws + WS_H8 + (size_t)1 * TG * DM); S.aRY = (long)(size_t)(F.dout + DO_R); S.aYC = (long)(size_t)(F.dout + DO_YC8);
                S.bG = (long)(size_t)(wl + WO_GATE); S.bCN = (long)(size_t)(wl + WO_C); S.bS = (long)(size_t)(wl + WO_SSD);
                pg8::Epi<pg8::EK_S5> E{GT, 3072, nullptr, 0, TMP, nullptr, MX, 1.f};
                pg8::gemm_phase<pg8::Epi<pg8::EK_S5>, pg8::S5Order, false, true>(F.lds, F.tid, g, S, E);
            }
            END_STEP;
            if (RUN_STEP && ((PH_MASK >> 6) & 1)) for (int rep_ = 0; rep_ <= ((REP_MASK >> 6) & 1); ++rep_) { MKCTX;
                pg8::Gemm g{(const bf16_t*)(a->ws + WS_ARENA + AR_MIXIN), (const bf16_t*)(wl + WO_OUT), 512, 512, 512}; pg8::StaticOrder S; S.init(TG, DM, 512, 512, F.G, (int)blockIdx.x, 512);
                pg8::Epi<pg8::EK_WOUT> E{(bf16_t*)(a->ws + WS_PRE1) + (size_t)1 * TG * DM, DM, Hg, DM, nullptr, nullptr, nullptr, 1.f / (WSCALE_OUT * MSCALE)};
                pg8::gemm_phase<pg8::Epi<pg8::EK_WOUT>, pg8::StaticOrder, false, true>(F.lds, F.tid, g, S, E);
            }
            END_STEP;
        }
        if (RUN_STEP && ((PH_MASK >> 7) & 1)) for (int rep_ = 0; rep_ <= ((REP_MASK >> 7) & 1); ++rep_) { MKCTX; ln1_route_phase(F, a, 0); }
        END_STEP;
        if (RUN_STEP && ((PH_MASK >> 9) & 1)) for (int rep_ = 0; rep_ <= ((REP_MASK >> 9) & 1); ++rep_) { MKCTX;
            const int nrt = moe_tables(F, 0, (const int*)(a->ws + WS_ARENA + AR_RTOK));
            pg8::Gemm g{(const bf16_t*)(a->ws + WS_H18), (const bf16_t*)(wl + WO_UP), 512, 512, 512};
            pg8::MoeOrder S{(const LAS int*)(F.lds + LDSX + LX_TILE), (const LAS int*)(F.lds + LDSX + LX_OFF), (const LAS int*)(F.lds + LDSX + LX_ECNT), nrt, F.G, F.vcu, 8, (long)256 * DM, (long)256 * DM, (long)1024 * DM};
            pg8::Epi<pg8::EK_GLU> E{(bf16_t*)(a->ws + WS_ARENA + AR_HID), 512, nullptr, 0, nullptr, nullptr, nullptr, 1.f / (WSCALE * ASCALE)};
            pg8::gemm_phase<pg8::Epi<pg8::EK_GLU>, pg8::MoeOrder, true, true>(F.lds, F.tid, g, S, E, (const LAS int*)(F.lds + LDSX + LX_GIDX));
        }
        END_STEP;
        if (RUN_STEP && ((PH_MASK >> 10) & 1)) for (int rep_ = 0; rep_ <= ((REP_MASK >> 10) & 1); ++rep_) { MKCTX;
            const int nrt = moe_tables(F, 0, nullptr);
            pg8::Gemm g{(const bf16_t*)(a->ws + WS_ARENA + AR_HID), (const bf16_t*)(wl + WO_DN), 256, 256, 256};
            pg8::MoeOrder S{(const LAS int*)(F.lds + LDSX + LX_TILE), (const LAS int*)(F.lds + LDSX + LX_OFF), (const LAS int*)(F.lds + LDSX + LX_ECNT), nrt, F.G, F.vcu, 4, (long)256 * 512, (long)256 * 512, (long)1024 * 512};
            pg8::Epi<pg8::EK_DOWN> E{(bf16_t*)(a->ws + WS_ARENA + AR_XS), DM, nullptr, 0, nullptr, (const int2*)(a->ws + WS_ARENA + AR_RINFO), nullptr, 1.f / (WSCALE_DN * HSCALE)};
            pg8::gemm_phase<pg8::Epi<pg8::EK_DOWN>, pg8::MoeOrder, false, true>(F.lds, F.tid, g, S, E);
        }
        END_STEP;
        if (RUN_STEP && ((PH_MASK >> 11) & 1)) for (int rep_ = 0; rep_ <= ((REP_MASK >> 11) & 1); ++rep_) { MKCTX; ln2_phase(F, a, 0, 0 == DEPTH - 1); }
        END_STEP;
    }
    {
        unsigned char* wl = a->ws + WS_W + (size_t)1 * W_LAYER;
        bf16_t* Hb = (bf16_t*)(a->ws + WS_H);
        bf16_t* P = (bf16_t*)(a->ws + WS_ARENA + AR_P);
        {
            const bf16_t* Hg = Hb + (size_t)0 * TG * DM;
            if (RUN_STEP && ((PH_MASK >> 1) & 1)) for (int rep_ = 0; rep_ <= ((REP_MASK >> 1) & 1); ++rep_) { MKCTX;
                pg8::Gemm g{(const bf16_t*)(a->ws + WS_H8 + (size_t)0 * TG * DM), (const bf16_t*)(wl + WO_IN), 512, 512, 512}; pg8::StaticOrder S; S.init(TG, LDP, 512, 512, F.G, (int)blockIdx.x, 512);
                pg8::Epi<pg8::EK_PROJ> E{P, LDP, nullptr, 0, nullptr, nullptr, nullptr, 1.f / (WSCALE * ASCALE)};
                pg8::gemm_phase<pg8::Epi<pg8::EK_PROJ>, pg8::StaticOrder, false, true>(F.lds, F.tid, g, S, E);
            }
            END_STEP;
            if (RUN_STEP && ((PH_MASK >> 2) & 1)) for (int rep_ = 0; rep_ <= ((REP_MASK >> 2) & 1); ++rep_) { MKCTX;
                for (int cu = blockIdx.x; cu < BG * 32; cu += F.G)
                    compress_unit(F, cu, P, (const bf16_t*)(wl + WO_W1), (const bf16_t*)(wl + WO_W2), (const float*)(a->ws + WS_MISC + MI_B1) + 1 * 256,
                                  (bf16_t*)(a->ws + WS_MISC + MI_KC), (bf16_t*)(a->ws + WS_MISC + MI_VC));
                conv_phase(F, P, (bf16_t*)(F.dout + DO_XC), a->in[I_CONVW] + (size_t)1 * 4 * 2048, a->in[I_CONVB] + (size_t)1 * 2048);
            }
            END_STEP;
            if (RUN_STEP && ((PH_MASK >> 3) & 1)) for (int rep_ = 0; rep_ <= ((REP_MASK >> 3) & 1); ++rep_) { MKCTX; attn_phase(F, a, 1, 0 + 4 * rep_); }
            END_STEP;
            if (RUN_STEP && ((PH_MASK >> 4) & 1)) for (int rep_ = 0; rep_ <= ((REP_MASK >> 4) & 1); ++rep_) { MKCTX; fin_phase(F, P, (bf16_t*)(F.dout + DO_R), (const bf16_t*)(F.dout + DO_YC), F.dout + DO_YC8, a->in[I_SNG] + (size_t)1 * DM); }
            END_STEP;
            if (RUN_STEP && ((PH_MASK >> 5) & 1)) for (int rep_ = 0; rep_ <= ((REP_MASK >> 5) & 1); ++rep_) { MKCTX;
                bf16_t* GT = (bf16_t*)(a->ws + WS_ARENA + AR_GATES); bf16_t* MX = (bf16_t*)(a->ws + WS_ARENA + AR_MIXIN); float* TMP = (float*)(F.dout + DO_TMP);
                pg8::Gemm g{nullptr, nullptr, 512, 512, 512};
                pg8::S5Order S; S.so.init(TG, DM, 512, 512, F.G, (int)blockIdx.x, 512);
                S.aH = (long)(size_t)(a->ws + WS_H8 + (size_t)0 * TG * DM); S.aRY = (long)(size_t)(F.dout + DO_R); S.aYC = (long)(size_t)(F.dout + DO_YC8);
                S.bG = (long)(size_t)(wl + WO_GATE); S.bCN = (long)(size_t)(wl + WO_C); S.bS = (long)(size_t)(wl + WO_SSD);
                pg8::Epi<pg8::EK_S5> E{GT, 3072, nullptr, 0, TMP, nullptr, MX, 1.f};
                pg8::gemm_phase<pg8::Epi<pg8::EK_S5>, pg8::S5Order, false, true>(F.lds, F.tid, g, S, E);
            }
            END_STEP;
            if (RUN_STEP && ((PH_MASK >> 6) & 1)) for (int rep_ = 0; rep_ <= ((REP_MASK >> 6) & 1); ++rep_) { MKCTX;
                pg8::Gemm g{(const bf16_t*)(a->ws + WS_ARENA + AR_MIXIN), (const bf16_t*)(wl + WO_OUT), 512, 512, 512}; pg8::StaticOrder S; S.init(TG, DM, 512, 512, F.G, (int)blockIdx.x, 512);
                pg8::Epi<pg8::EK_WOUT> E{(bf16_t*)(a->ws + WS_PRE1) + (size_t)0 * TG * DM, DM, Hg, DM, nullptr, nullptr, nullptr, 1.f / (WSCALE_OUT * MSCALE)};
                pg8::gemm_phase<pg8::Epi<pg8::EK_WOUT>, pg8::StaticOrder, false, true>(F.lds, F.tid, g, S, E);
            }
            END_STEP;
        }
        {
            const bf16_t* Hg = Hb + (size_t)1 * TG * DM;
            if (RUN_STEP && ((PH_MASK >> 1) & 1)) for (int rep_ = 0; rep_ <= ((REP_MASK >> 1) & 1); ++rep_) { MKCTX;
                pg8::Gemm g{(const bf16_t*)(a->ws + WS_H8 + (size_t)1 * TG * DM), (const bf16_t*)(wl + WO_IN), 512, 512, 512}; pg8::StaticOrder S; S.init(TG, LDP, 512, 512, F.G, (int)blockIdx.x, 512);
                pg8::Epi<pg8::EK_PROJ> E{P, LDP, nullptr, 0, nullptr, nullptr, nullptr, 1.f / (WSCALE * ASCALE)};
                pg8::gemm_phase<pg8::Epi<pg8::EK_PROJ>, pg8::StaticOrder, false, true>(F.lds, F.tid, g, S, E);
            }
            END_STEP;
            if (RUN_STEP && ((PH_MASK >> 2) & 1)) for (int rep_ = 0; rep_ <= ((REP_MASK >> 2) & 1); ++rep_) { MKCTX;
                for (int cu = blockIdx.x; cu < BG * 32; cu += F.G)
                    compress_unit(F, cu, P, (const bf16_t*)(wl + WO_W1), (const bf16_t*)(wl + WO_W2), (const float*)(a->ws + WS_MISC + MI_B1) + 1 * 256,
                                  (bf16_t*)(a->ws + WS_MISC + MI_KC), (bf16_t*)(a->ws + WS_MISC + MI_VC));
                conv_phase(F, P, (bf16_t*)(F.dout + DO_XC), a->in[I_CONVW] + (size_t)1 * 4 * 2048, a->in[I_CONVB] + (size_t)1 * 2048);
            }
            END_STEP;
            if (RUN_STEP && ((PH_MASK >> 3) & 1)) for (int rep_ = 0; rep_ <= ((REP_MASK >> 3) & 1); ++rep_) { MKCTX; attn_phase(F, a, 1, 1 + 4 * rep_); }
            END_STEP;
            if (RUN_STEP && ((PH_MASK >> 4) & 1)) for (int rep_ = 0; rep_ <= ((REP_MASK >> 4) & 1); ++rep_) { MKCTX; fin_phase(F, P, (bf16_t*)(F.dout + DO_R), (const bf16_t*)(F.dout + DO_YC), F.dout + DO_YC8, a->in[I_SNG] + (size_t)1 * DM); }
            END_STEP;
            if (RUN_STEP && ((PH_MASK >> 5) & 1)) for (int rep_ = 0; rep_ <= ((REP_MASK >> 5) & 1); ++rep_) { MKCTX;
                bf16_t* GT = (bf16_t*)(a->ws + WS_ARENA + AR_GATES); bf16_t* MX = (bf16_t*)(a->ws + WS_ARENA + AR_MIXIN); float* TMP = (float*)(F.dout + DO_TMP);
                pg8::Gemm g{nullptr, nullptr, 512, 512, 512};
                pg8::S5Order S; S.so.init(TG, DM, 512, 512, F.G, (int)blockIdx.x, 512);
                S.aH = (long)(size_t)(a->ws + WS_H8 + (size_t)1 * TG * DM); S.aRY = (long)(size_t)(F.dout + DO_R); S.aYC = (long)(size_t)(F.dout + DO_YC8);
                S.bG = (long)(size_t)(wl + WO_GATE); S.bCN = (long)(size_t)(wl + WO_C); S.bS = (long)(size_t)(wl + WO_SSD);
                pg8::Epi<pg8::EK_S5> E{GT, 3072, nullptr, 0, TMP, nullptr, MX, 1.f};
                pg8::gemm_phase<pg8::Epi<pg8::EK_S5>, pg8::S5Order, false, true>(F.lds, F.tid, g, S, E);
            }
            END_STEP;
            if (RUN_STEP && ((PH_MASK >> 6) & 1)) for (int rep_ = 0; rep_ <= ((REP_MASK >> 6) & 1); ++rep_) { MKCTX;
                pg8::Gemm g{(const bf16_t*)(a->ws + WS_ARENA + AR_MIXIN), (const bf16_t*)(wl + WO_OUT), 512, 512, 512}; pg8::StaticOrder S; S.init(TG, DM, 512, 512, F.G, (int)blockIdx.x, 512);
                pg8::Epi<pg8::EK_WOUT> E{(bf16_t*)(a->ws + WS_PRE1) + (size_t)1 * TG * DM, DM, Hg, DM, nullptr, nullptr, nullptr, 1.f / (WSCALE_OUT * MSCALE)};
                pg8::gemm_phase<pg8::Epi<pg8::EK_WOUT>, pg8::StaticOrder, false, true>(F.lds, F.tid, g, S, E);
            }
            END_STEP;
        }
        if (RUN_STEP && ((PH_MASK >> 7) & 1)) for (int rep_ = 0; rep_ <= ((REP_MASK >> 7) & 1); ++rep_) { MKCTX; ln1_route_phase(F, a, 1); }
        END_STEP;
        if (RUN_STEP && ((PH_MASK >> 9) & 1)) for (int rep_ = 0; rep_ <= ((REP_MASK >> 9) & 1); ++rep_) { MKCTX;
            const int nrt = moe_tables(F, 1, (const int*)(a->ws + WS_ARENA + AR_RTOK));
            pg8::Gemm g{(const bf16_t*)(a->ws + WS_H18), (const bf16_t*)(wl + WO_UP), 512, 512, 512};
            pg8::MoeOrder S{(const LAS int*)(F.lds + LDSX + LX_TILE), (const LAS int*)(F.lds + LDSX + LX_OFF), (const LAS int*)(F.lds + LDSX + LX_ECNT), nrt, F.G, F.vcu, 8, (long)256 * DM, (long)256 * DM, (long)1024 * DM};
            pg8::Epi<pg8::EK_GLU> E{(bf16_t*)(a->ws + WS_ARENA + AR_HID), 512, nullptr, 0, nullptr, nullptr, nullptr, 1.f / (WSCALE * ASCALE)};
            pg8::gemm_phase<pg8::Epi<pg8::EK_GLU>, pg8::MoeOrder, true, true>(F.lds, F.tid, g, S, E, (const LAS int*)(F.lds + LDSX + LX_GIDX));
        }
        END_STEP;
        if (RUN_STEP && ((PH_MASK >> 10) & 1)) for (int rep_ = 0; rep_ <= ((REP_MASK >> 10) & 1); ++rep_) { MKCTX;
            const int nrt = moe_tables(F, 1, nullptr);
            pg8::Gemm g{(const bf16_t*)(a->ws + WS_ARENA + AR_HID), (const bf16_t*)(wl + WO_DN), 256, 256, 256};
            pg8::MoeOrder S{(const LAS int*)(F.lds + LDSX + LX_TILE), (const LAS int*)(F.lds + LDSX + LX_OFF), (const LAS int*)(F.lds + LDSX + LX_ECNT), nrt, F.G, F.vcu, 4, (long)256 * 512, (long)256 * 512, (long)1024 * 512};
            pg8::Epi<pg8::EK_DOWN> E{(bf16_t*)(a->ws + WS_ARENA + AR_XS), DM, nullptr, 0, nullptr, (const int2*)(a->ws + WS_ARENA + AR_RINFO), nullptr, 1.f / (WSCALE_DN * HSCALE)};
            pg8::gemm_phase<pg8::Epi<pg8::EK_DOWN>, pg8::MoeOrder, false, true>(F.lds, F.tid, g, S, E);
        }
        END_STEP;
        if (RUN_STEP && ((PH_MASK >> 11) & 1)) for (int rep_ = 0; rep_ <= ((REP_MASK >> 11) & 1); ++rep_) { MKCTX; ln2_phase(F, a, 1, 1 == DEPTH - 1); }
        END_STEP;
    }
#undef RUN_STEP
#undef END_STEP
}

__global__ void dump_bf16(const bf16_t* src, float* dst, size_t n) { for (size_t i = (size_t)blockIdx.x * blockDim.x + threadIdx.x; i < n; i += (size_t)gridDim.x * blockDim.x) dst[i] = bf1(src[i]); }
#ifndef N_LAUNCH_MODE
#define N_LAUNCH_MODE 0
#endif
extern "C" void kernel_launch(void* const* d_in, const int* in_sizes, int n_in, void* d_out, int out_size, void* d_ws, size_t ws_size, hipStream_t stream) {
    static int grid = 0;
    if (grid == 0) {
        if (n_in != 32 || out_size != T_ * DM || ws_size < WS_END) { fprintf(stderr, "kernel_launch: unexpected problem (n_in %d out %d ws %zu)\n", n_in, out_size, ws_size); grid = -1; return; }
        int dev = 0, cus = 0, per_cu = 0;
        if (hipGetDevice(&dev) != hipSuccess || hipDeviceGetAttribute(&cus, hipDeviceAttributeMultiprocessorCount, dev) != hipSuccess) { grid = -1; return; }
        if (hipFuncSetAttribute((const void*)fwd_kernel, hipFuncAttributeMaxDynamicSharedMemorySize, LDS_TOTAL) != hipSuccess) { fprintf(stderr, "kernel_launch: hipFuncSetAttribute failed\n"); grid = -1; return; }
        if (hipOccupancyMaxActiveBlocksPerMultiprocessor(&per_cu, (const void*)fwd_kernel, 512, LDS_TOTAL) != hipSuccess || per_cu < 1)
            fprintf(stderr, "kernel_launch: occupancy query reports %d workgroups per CU\n", per_cu);
        (void)hipGetLastError();
        grid = cus;
    }
    if (grid < 0) return;
    (void)hipMemsetAsync((char*)d_ws + WS_CTL, 0, CTL_ZERO_BYTES, stream);
    Args a{};
    for (int i = 0; i < 32; ++i) a.in[i] = (const float*)d_in[i];
    a.out = (float*)d_out; a.ws = (unsigned char*)d_ws;
#if N_LAUNCH_MODE == 1
    a.lo = 0; a.hi = NSTEPS;
    hipLaunchKernelGGL(fwd_kernel, dim3(grid), dim3(512), LDS_TOTAL, stream, a);
#else
#ifdef DBG_STOP
    for (int s = 0; s <= DBG_STOP; ++s) { a.lo = s; a.hi = s + 1; hipLaunchKernelGGL(fwd_kernel, dim3(grid), dim3(512), LDS_TOTAL, stream, a); }
    hipLaunchKernelGGL(dump_bf16, dim3(1024), dim3(256), 0, stream, (const bf16_t*)((char*)d_ws + DBG_SRC), (float*)d_out, (size_t)T_ * DM);
#else
    for (int s = 0; s < NSTEPS; ++s) { a.lo = s; a.hi = s + 1; hipLaunchKernelGGL(fwd_kernel, dim3(grid), dim3(512), LDS_TOTAL, stream, a); }
#endif
#endif
}
```

```cpp
#define N_LAUNCH_MODE 1
#include <hip/hip_runtime.h>
#include <cstdio>
#include <cstdint>

#define LAS __attribute__((address_space(3)))
#define GAS __attribute__((address_space(1)))
typedef unsigned short bf16_t;
typedef short bf16x8 __attribute__((ext_vector_type(8)));
typedef short s16x4 __attribute__((ext_vector_type(4)));
typedef float f32x2 __attribute__((ext_vector_type(2)));
typedef float f32x4 __attribute__((ext_vector_type(4)));
typedef float f32x16 __attribute__((ext_vector_type(16)));
typedef unsigned u32x2 __attribute__((ext_vector_type(2)));
typedef unsigned u32x4 __attribute__((ext_vector_type(4)));

constexpr int T_ = 32768, SEQ = 2048, DM = 1024, NBATCH = 16, DEPTH = 2;
constexpr int NG = 2, BG = NBATCH / NG, TG = T_ / NG;
constexpr int LDP = 5120;
constexpr int C_POOL = 0, C_Q = 512, C_KV = 1024, C_Z = 1792, C_XBC = 2816, C_NG = 4864, C_DT = 4888;
constexpr int D_IN = 7976;
constexpr float LN_EPS = 1e-5f, DN_ALPHA = 1.41421356237f, LOG2E = 1.4426950408889634f;
constexpr float QSCALE = 0.125f * LOG2E;
constexpr float NEGBIG = -1e30f;
constexpr int MOE_ROWS = 69632;

constexpr size_t MiB = 1ull << 20;
constexpr size_t WS_CTL = 0, CTL_ZERO_BYTES = 65536;
constexpr size_t WS_MISC = 1 * MiB;
constexpr size_t WS_W = 2 * MiB, W_LAYER = 52 * MiB;
constexpr size_t WO_IN = 0, WO_GATE = 5 * MiB, WO_C = 11 * MiB, WO_NSA = 12 * MiB, WO_SSD = 13 * MiB, WO_OUT = 15 * MiB, WO_W1 = 17 * MiB, WO_W2 = 18 * MiB, WO_UP = 19 * MiB, WO_DN = 35 * MiB;
constexpr size_t WS_H = 106 * MiB, WS_PRE1 = 170 * MiB, WS_H8 = 234 * MiB, WS_H18 = 266 * MiB, WS_ARENA = 298 * MiB;
constexpr float RSCALE = 16.f, BSCALE = 16.f, YSCALE = 8.f, WSCALE_CN = 480.f;
constexpr float WSCALE = 704.f, ASCALE = 24.f, MSCALE = 32.f, HSCALE = 16.f, WSCALE_OUT = 1408.f, WSCALE_DN = 992.f;
constexpr size_t AR_P = 0, AR_GATES = 0, AR_MIXIN = 96 * MiB;
constexpr size_t AR_XS = 0, AR_RTOK = 128 * MiB, AR_RINFO = 132 * MiB, AR_HID = 140 * MiB;
constexpr size_t WS_END = 506 * MiB;
constexpr int ECAP = 65536;
constexpr size_t DO_XC = 0, DO_TMP = 0, DO_YC = 64 * MiB, DO_R = 96 * MiB, DO_YC8 = 112 * MiB;
constexpr size_t MI_BIAS = 0, MI_B1 = 4096, MI_KC = 65536, MI_VC = MI_KC + 262144, MI_ROUTE = 1 * MiB, MI_RINFO = 2 * MiB;
constexpr int CW_BAR = 4096, CW_WQ = 8192, CW_CNT = 12288;
constexpr int LDS_TOTAL = 147456, LDSX = 131072;
constexpr int LX_BAR = 0, LX_WQ = 16, LX_OFF = 64, LX_ECNT = 160, LX_TILE = 256, LX_CNTL = 1536, LX_BASE = 1600, LX_ROWS = 2048, LX_GIDX = 6144;

__device__ __forceinline__ float bflo(unsigned u) { return __uint_as_float(u << 16); }
__device__ __forceinline__ float bfhi(unsigned u) { return __uint_as_float(u & 0xffff0000u); }
__device__ __forceinline__ float bf1(bf16_t b) { return __uint_as_float(((unsigned)b) << 16); }
typedef __bf16 bf16x2_t __attribute__((ext_vector_type(2)));
__device__ __forceinline__ unsigned cvt_pk_bf16(float lo, float hi) { const f32x2 v = {lo, hi}; const bf16x2_t b = __builtin_convertvector(v, bf16x2_t); return __builtin_bit_cast(unsigned, b); }
__device__ __forceinline__ bf16_t f2bf(float f) { return (bf16_t)(cvt_pk_bf16(f, 0.f) & 0xffffu); }
__device__ __forceinline__ float fexp2(float x) { return __builtin_amdgcn_exp2f(x); }
__device__ __forceinline__ float frcp(float x) { return __builtin_amdgcn_rcpf(x); }
__device__ __forceinline__ float sigmoidf_(float x) { return frcp(1.f + fexp2(-x * LOG2E)); }
__device__ __forceinline__ float siluf_(float x) { return x * sigmoidf_(x); }
__device__ __forceinline__ float wave_sum(float v) {
#pragma unroll
    for (int o = 1; o < 64; o <<= 1) v += __shfl_xor(v, o);
    return v;
}
__device__ __forceinline__ void unpack8(const u32x4 v, float (&x)[8]) {
    x[0] = bflo(v.x); x[1] = bfhi(v.x); x[2] = bflo(v.y); x[3] = bfhi(v.y); x[4] = bflo(v.z); x[5] = bfhi(v.z); x[6] = bflo(v.w); x[7] = bfhi(v.w);
}
__device__ __forceinline__ u32x4 pack8(const float (&x)[8]) {
    u32x4 w; w.x = cvt_pk_bf16(x[0], x[1]); w.y = cvt_pk_bf16(x[2], x[3]); w.z = cvt_pk_bf16(x[4], x[5]); w.w = cvt_pk_bf16(x[6], x[7]); return w;
}
typedef int v4i __attribute__((ext_vector_type(4)));
__device__ __forceinline__ unsigned q1_i8(float x) { int q = __float2int_rn(x); q = q < -127 ? -127 : (q > 127 ? 127 : q); return (unsigned)q & 255u; }
__device__ __forceinline__ unsigned cvt4_i8(float a, float b, float c, float d) { return q1_i8(a) | (q1_i8(b) << 8) | (q1_i8(c) << 16) | (q1_i8(d) << 24); }
__device__ __forceinline__ u32x2 pack8_i8(const float (&x)[8], float sc) { u32x2 w; w.x = cvt4_i8(x[0] * sc, x[1] * sc, x[2] * sc, x[3] * sc); w.y = cvt4_i8(x[4] * sc, x[5] * sc, x[6] * sc, x[7] * sc); return w; }
#define LDS_WAIT() asm volatile("s_waitcnt lgkmcnt(0)" ::: "memory")
__device__ __forceinline__ int crow(int r, int hi) { return (r & 3) + 8 * (r >> 2) + 4 * hi; }
__device__ __forceinline__ f32x16 mfma32(bf16x8 a, bf16x8 b, f32x16 c) { return __builtin_amdgcn_mfma_f32_32x32x16_bf16(a, b, c, 0, 0, 0); }
__device__ __forceinline__ f32x4 mfma16(bf16x8 a, bf16x8 b, f32x4 c) { return __builtin_amdgcn_mfma_f32_16x16x32_bf16(a, b, c, 0, 0, 0); }
typedef short v4i16_t __attribute__((ext_vector_type(4)));
__device__ __forceinline__ s16x4 trrd(const LAS unsigned char* p) { return __builtin_bit_cast(s16x4, __builtin_amdgcn_ds_read_tr16_b64_v4i16((LAS v4i16_t*)p)); }
__device__ __forceinline__ bf16x8 cat8(s16x4 lo, s16x4 hi) { return (bf16x8){lo[0], lo[1], lo[2], lo[3], hi[0], hi[1], hi[2], hi[3]}; }

namespace pg8 {
constexpr int BM = 256, BK = 64, HALF = 128, HTB = HALF * BK * 2, STAGE_BYTES = 8 * HTB, NXCD = 8, WGM = 8;
__host__ __device__ __forceinline__ int lds_byte(int r, int c) { const int st = (r >> 4) * 2 + (c >> 5), rr = r & 15, cc = c & 31, ob = rr * 64 + cc * 2; return st * 1024 + (ob ^ (((ob >> 9) & 1) << 5)); }
__host__ __device__ __forceinline__ void stage_rc(int b, int& R, int& C) { const int st = b / 1024, sb = b % 1024, swz = sb ^ (((sb >> 9) & 1) << 5); R = (st >> 1) * 16 + swz / 64; C = (st & 1) * 32 + (swz % 64) / 2; }
__host__ __device__ __forceinline__ int perm32(int rho) { const int n = rho >> 4, i = rho & 15; return 8 * (i >> 2) + 4 * n + (i & 3); }

struct Unit { int pm, pn, nt, kind, gx, nv, gi; long ab, bb; };
struct Gemm { const bf16_t* A; const bf16_t* Bt; int lda, ldb, K; };

struct StaticOrder {
    int nM, nN, nwg, G, c, nt0; long tsA, tsB;
    __device__ void init(int M, int N, int lda, int ldb, int G_, int c_, int K_ = 1024) { nM = M / BM; nN = N / BM; nwg = nM * nN; G = G_; c = c_; nt0 = K_ / BK; tsA = (long)BM * lda * 2; tsB = (long)BM * ldb * 2; }
    __device__ bool next(int i, Unit& u) const {
        const long L = (long)i * G + c; if (L >= nwg) return false;
        int wgid = (int)L; { const int q = nwg / NXCD, r = nwg % NXCD, xcd = wgid % NXCD, off = wgid / NXCD; wgid = (xcd < r ? xcd * (q + 1) : r * (q + 1) + (xcd - r) * q) + off; }
        const int nig = WGM * nN, gid = wgid / nig, fm = gid * WGM, gsz = (nM - fm) < WGM ? (nM - fm) : WGM;
        u.pm = fm + ((wgid % nig) % gsz); u.pn = (wgid % nig) / gsz; u.ab = u.pm * tsA; u.bb = u.pn * tsB; u.nt = nt0; u.kind = 0; u.gx = 0; u.nv = 0; u.gi = 0; return true;
    }
};
struct S5Order {
    StaticOrder so; long aH, aRY, aYC, bG, bCN, bS;
    __device__ bool next(int i, Unit& u) const {
        const int base = i / 6, s = i - 6 * base, x = s >> 1;
        if (!so.next(base, u)) return false;
        const long ra = u.ab, rb = u.bb;
        if ((s & 1) == 0) { u.ab = aH + ra; u.bb = bG + rb + (long)x * 1024 * 1024; u.nt = 8; u.kind = 0; u.pn += 4 * x; }
        else if (x == 0) { u.ab = aRY + ra; u.bb = bCN + rb; u.nt = 4; u.kind = 1; }
        else if (x == 1) { u.ab = aRY + ra + 512; u.bb = bCN + rb + 512; u.nt = 4; u.kind = 2; }
        else { u.ab = aYC + ra; u.bb = bS + rb; u.nt = 8; u.kind = 3; }
        return true;
    }
};
struct MoeOrder {
    const LAS int* tile_e; const LAS int* off; const LAS int* cnt; int nrt, G, vcu, nt0; long tsA, tsB, eB;
    __device__ bool next(int i, Unit& u) const {
        const long L = (long)i * G + vcu; if (L >= (long)nrt * 4) return false;
        const int rt = (int)(L >> 2), pn = (int)(L & 3), e = __builtin_amdgcn_readfirstlane(tile_e[rt]), k0 = rt * 256 - __builtin_amdgcn_readfirstlane(off[e]), c = __builtin_amdgcn_readfirstlane(cnt[e]);
        u.pm = rt; u.pn = pn; u.ab = rt * tsA; u.bb = e * eB + pn * tsB; u.nt = nt0; u.kind = 0; u.gx = e * ECAP + k0; u.nv = (c - k0) < 256 ? (c - k0) : 256; u.gi = i; return true;
    }
};

template <class Epi, class Sched, bool GATHER = false, bool FP8 = false>
__device__ __forceinline__ void gemm_phase(LAS unsigned char* lds, int tid_, const Gemm g, const Sched& S, const Epi& E, const LAS int* gidx = nullptr) {
    asm volatile("" : "+v"(tid_));
    const int tid = tid_, wid = __builtin_amdgcn_readfirstlane(tid >> 6), lane = tid & 63, wr = wid >> 2, wc = wid & 3, fr = lane & 15, fq = lane >> 4;
    unsigned voffA0[2], voffA1[2], nvA0[2], nvA1[2], voffB[2]; int RA[2], CA[2];
#pragma unroll
    for (int i = 0; i < 2; ++i) { int R, C; stage_rc(tid * 16 + i * 8192, R, C); const int Rb = Epi::PERM ? ((R & ~31) + perm32(R & 31)) : R; RA[i] = R; CA[i] = C;
        voffA0[i] = (unsigned)(R * g.lda + C) * 2u; voffA1[i] = (unsigned)((R + HALF) * g.lda + C) * 2u; nvA0[i] = voffA0[i]; nvA1[i] = voffA1[i]; voffB[i] = (unsigned)(Rb * g.ldb + C) * 2u; }
#define PG8_GATHER(dst0, dst1, u_) do { _Pragma("unroll") for (int _i = 0; _i < 2; ++_i) { \
        dst0[_i] = (unsigned)(gidx[((u_).gi & 7) * 256 + RA[_i]] * g.lda + CA[_i]) * 2u; dst1[_i] = (unsigned)(gidx[((u_).gi & 7) * 256 + HALF + RA[_i]] * g.lda + CA[_i]) * 2u; } } while (0)
    const size_t kstep = (size_t)(BK * 2);
    const size_t hstepB = (size_t)HALF * g.ldb * 2;
    const unsigned ldsw = (unsigned)wid * 1024u;
    const int aoff = lds_byte(wr * 64 + fr, fq * 8), boff = lds_byte(wc * 32 + fr, fq * 8);
#define PG8_SA(b, h) (((b) * 2 + (h)) * HTB)
#define PG8_SB(b, h) ((4 + (b) * 2 + (h)) * HTB)
#define PG8_STAGE(bufoff, gbase, voff) do { _Pragma("unroll") for (int _i = 0; _i < 2; ++_i) \
        __builtin_amdgcn_global_load_lds((const unsigned*)((const char*)(gbase) + (voff)[_i]), (LAS unsigned*)(lds + (bufoff) + ldsw + _i * 8192), 16, 0, 0); } while (0)
#define PG8_LDA(dst, b, h) do { _Pragma("unroll") for (int m = 0; m < 4; ++m) _Pragma("unroll") for (int k = 0; k < 2; ++k) dst[m][k] = *(const LAS bf16x8*)(lds + PG8_SA(b, h) + aoff + m * 2048 + k * 1024); } while (0)
#define PG8_LDB(dst, b, h) do { _Pragma("unroll") for (int n = 0; n < 2; ++n) _Pragma("unroll") for (int k = 0; k < 2; ++k) dst[n][k] = *(const LAS bf16x8*)(lds + PG8_SB(b, h) + boff + n * 2048 + k * 1024); } while (0)
#define PG8_MMA(ai, bj, At, Bt) do { __builtin_amdgcn_s_setprio(1); _Pragma("unroll") for (int m = 0; m < 4; ++m) _Pragma("unroll") for (int n = 0; n < 2; ++n) _Pragma("unroll") for (int k = 0; k < 2; ++k) { \
        if constexpr (FP8) acc[ai][bj][m][n] = __builtin_bit_cast(f32x4, __builtin_amdgcn_mfma_i32_16x16x64_i8(__builtin_bit_cast(v4i, Bt[n][k]), __builtin_bit_cast(v4i, At[m][k]), __builtin_bit_cast(v4i, acc[ai][bj][m][n]), 0, 0, 0)); \
        else acc[ai][bj][m][n] = __builtin_amdgcn_mfma_f32_16x16x32_bf16(Bt[n][k], At[m][k], acc[ai][bj][m][n], 0, 0, 0); } __builtin_amdgcn_s_setprio(0); } while (0)
#define PG8_WAIT_V(n) asm volatile("s_waitcnt vmcnt(" #n ")" ::: "memory")
#define PG8_WAIT_L(n) asm volatile("s_waitcnt lgkmcnt(" #n ")" ::: "memory")
#define PG8_BAR __builtin_amdgcn_s_barrier()
#define PG8_SCHED __builtin_amdgcn_sched_barrier(0)
    Unit cur, nxt; int ui = 0;
    if (!S.next(0, cur)) return;
    f32x4 acc[2][2][4][2];
#pragma unroll
    for (int a = 0; a < 2; ++a)
#pragma unroll
        for (int b = 0; b < 2; ++b)
#pragma unroll
            for (int m = 0; m < 4; ++m)
#pragma unroll
                for (int n = 0; n < 2; ++n) acc[a][b][m][n] = (f32x4){0.f, 0.f, 0.f, 0.f};
    bf16x8 At[4][2], B0[2][2], B1[2][2];
    const char* cA = (const char*)g.A + (GATHER ? 0 : cur.ab); const char* cB = (const char*)g.Bt + cur.bb;
    if constexpr (GATHER) PG8_GATHER(voffA0, voffA1, cur);
    PG8_STAGE(PG8_SB(0, 0), cB, voffB); PG8_STAGE(PG8_SB(0, 1), cB + hstepB, voffB); PG8_STAGE(PG8_SA(0, 0), cA, voffA0); PG8_STAGE(PG8_SA(0, 1), cA, voffA1);
    if (wr == 1) PG8_BAR;
    PG8_WAIT_V(2); PG8_BAR;
    PG8_STAGE(PG8_SB(1, 0), cB + kstep, voffB); PG8_STAGE(PG8_SA(1, 0), cA + kstep, voffA0); PG8_STAGE(PG8_SB(1, 1), cB + hstepB + kstep, voffB);
    PG8_WAIT_V(6); PG8_BAR;
    for (;;) {
        const bool has_next = S.next(ui + 1, nxt);
        const char* nA = (has_next && !GATHER) ? (const char*)g.A + nxt.ab : cA; const char* nB = has_next ? (const char*)g.Bt + nxt.bb : cB;
        if constexpr (GATHER) { if (has_next) PG8_GATHER(nvA0, nvA1, nxt); else { nvA0[0] = voffA0[0]; nvA0[1] = voffA0[1]; nvA1[0] = voffA1[0]; nvA1[1] = voffA1[1]; } }
        const int nt = cur.nt;
        for (int t = 0; t < nt; t += 2) {
            const bool last = (t == nt - 2);
            const char* a1 = cA + (size_t)(t + 1) * kstep;
            const char* a2 = last ? nA : cA + (size_t)(t + 2) * kstep; const char* b2 = last ? nB : cB + (size_t)(t + 2) * kstep;
            const char* a3 = a2 + kstep; const char* b3 = b2 + kstep;
            unsigned xA0[2], xA1[2];
            xA0[0] = (GATHER && last) ? nvA0[0] : voffA0[0]; xA0[1] = (GATHER && last) ? nvA0[1] : voffA0[1]; xA1[0] = (GATHER && last) ? nvA1[0] : voffA1[0]; xA1[1] = (GATHER && last) ? nvA1[1] : voffA1[1];
            PG8_LDB(B0, 0, 0); PG8_LDB(B1, 0, 1); PG8_SCHED; PG8_LDA(At, 0, 0); PG8_STAGE(PG8_SA(1, 1), a1, voffA1);
            PG8_WAIT_V(8); PG8_WAIT_L(0); PG8_BAR; PG8_MMA(0, 0, At, B0); PG8_MMA(0, 1, At, B1); PG8_BAR; PG8_SCHED;
            PG8_LDA(At, 0, 1); PG8_STAGE(PG8_SB(0, 0), b2, voffB); PG8_STAGE(PG8_SB(0, 1), b2 + hstepB, voffB); PG8_STAGE(PG8_SA(0, 0), a2, xA0);
            PG8_WAIT_V(8); PG8_WAIT_L(0); PG8_BAR; PG8_MMA(1, 0, At, B0); PG8_MMA(1, 1, At, B1); PG8_BAR; PG8_SCHED;
            PG8_LDB(B0, 1, 0); PG8_LDB(B1, 1, 1); PG8_SCHED; PG8_LDA(At, 1, 0); PG8_STAGE(PG8_SA(0, 1), a2, xA1);
            PG8_WAIT_V(8); PG8_WAIT_L(0); PG8_BAR; PG8_MMA(0, 0, At, B0); PG8_MMA(0, 1, At, B1); PG8_BAR; PG8_SCHED;
            PG8_LDA(At, 1, 1); PG8_STAGE(PG8_SB(1, 0), b3, voffB); PG8_STAGE(PG8_SB(1, 1), b3 + hstepB, voffB); PG8_STAGE(PG8_SA(1, 0), a3, xA0);
            PG8_WAIT_V(8); PG8_WAIT_L(0); PG8_BAR; PG8_MMA(1, 0, At, B0); PG8_MMA(1, 1, At, B1); PG8_BAR; PG8_SCHED;
        }
        if (wr == 0) PG8_BAR;
        if constexpr (FP8) {
#pragma unroll
            for (int a = 0; a < 2; ++a)
#pragma unroll
                for (int b = 0; b < 2; ++b)
#pragma unroll
                    for (int m = 0; m < 4; ++m)
#pragma unroll
                        for (int n = 0; n < 2; ++n)
#pragma unroll
                            for (int j = 0; j < 4; ++j) acc[a][b][m][n][j] = (float)__float_as_int(acc[a][b][m][n][j]);
        }
        E(acc, cur, wr, wc, fr, fq);
        if (!has_next) break;
#pragma unroll
        for (int a = 0; a < 2; ++a)
#pragma unroll
            for (int b = 0; b < 2; ++b)
#pragma unroll
                for (int m = 0; m < 4; ++m)
#pragma unroll
                    for (int n = 0; n < 2; ++n) acc[a][b][m][n] = (f32x4){0.f, 0.f, 0.f, 0.f};
        cur = nxt; cA = nA; cB = nB; ++ui;
        if constexpr (GATHER) { voffA0[0] = nvA0[0]; voffA0[1] = nvA0[1]; voffA1[0] = nvA1[0]; voffA1[1] = nvA1[1]; }
        if (wr == 1) PG8_BAR;
    }
    PG8_WAIT_V(0);
    PG8_BAR;
#undef PG8_GATHER
#undef PG8_SA
#undef PG8_SB
#undef PG8_STAGE
#undef PG8_LDA
#undef PG8_LDB
#undef PG8_MMA
#undef PG8_WAIT_V
#undef PG8_WAIT_L
#undef PG8_BAR
#undef PG8_SCHED
}

enum { EK_PROJ = 0, EK_GATE, EK_BR0, EK_BR1, EK_BR2, EK_WOUT, EK_GLU, EK_DOWN, EK_S5 };
template <int KIND> struct Epi {
    static constexpr bool PERM = true;
    bf16_t* O; int ldo;
    const bf16_t* X; int ldx;
    float* F;
    const int2* RI;
    bf16_t* O2;
    float osc;
    __device__ __forceinline__ void operator()(const f32x4 (&acc)[2][2][4][2], const Unit& u, int wr, int wc, int fr, int fq) const {
        const int row0 = u.pm * BM + wr * 64 + fr, col0 = u.pn * BM + wc * 32 + 8 * fq;
        if constexpr (KIND == EK_GLU) {
            const int hc0 = u.pn * 128 + wc * 32 + 8 * fq;
#pragma unroll
            for (int ai = 0; ai < 2; ++ai)
#pragma unroll
                for (int m = 0; m < 4; ++m) {
                    const int row = row0 + ai * HALF + m * 16; float o[8];
#pragma unroll
                    for (int n = 0; n < 2; ++n)
#pragma unroll
                        for (int j = 0; j < 4; ++j) o[4 * n + j] = siluf_(acc[ai][0][m][n][j] * osc) * (acc[ai][1][m][n][j] * osc);
                    *(u32x2*)((unsigned char*)O + (size_t)row * ldo + hc0) = pack8_i8(o, HSCALE);
                    asm volatile("" ::: "memory");
                }
        } else if constexpr (KIND == EK_DOWN) {
#pragma unroll
            for (int ai = 0; ai < 2; ++ai)
#pragma unroll
                for (int m = 0; m < 4; ++m) {
                    const int lr = ai * HALF + wr * 64 + m * 16 + fr; const bool ok = lr < u.nv; const int2 ri = RI[u.gx + (ok ? lr : 0)]; const float w = __int_as_float(ri.y) * osc;
                    if (ok) {
#pragma unroll
                        for (int bj = 0; bj < 2; ++bj) { float o[8];
#pragma unroll
                            for (int n = 0; n < 2; ++n)
#pragma unroll
                                for (int j = 0; j < 4; ++j) o[4 * n + j] = w * acc[ai][bj][m][n][j];
                            *(u32x4*)(O + (size_t)ri.x * ldo + col0 + bj * HALF) = pack8(o); }
                    }
                    asm volatile("" ::: "memory");
                }
        } else if constexpr (KIND == EK_S5) {
            if (u.kind == 0) { Epi<EK_GATE> e{O, ldo, nullptr, 0, nullptr, nullptr, nullptr, 1.f / (WSCALE * ASCALE)}; e(acc, u, wr, wc, fr, fq); }
            else if (u.kind == 1) { Epi<EK_BR0> e{nullptr, 0, O, ldo, F, nullptr, nullptr, 1.f / (RSCALE * WSCALE_CN)}; e(acc, u, wr, wc, fr, fq); }
            else if (u.kind == 2) { Epi<EK_BR1> e{nullptr, 0, (const bf16_t*)((const unsigned char*)O + 1024), ldo, F, nullptr, nullptr, 1.f / (BSCALE * WSCALE_CN)}; e(acc, u, wr, wc, fr, fq); }
            else { Epi<EK_BR2> e{O2, 1024, (const bf16_t*)((const unsigned char*)O + 2048), ldo, F, nullptr, nullptr, 1.f / (YSCALE * WSCALE)}; e(acc, u, wr, wc, fr, fq); }
        } else {
            int act = 0;
            if constexpr (KIND == EK_PROJ) act = (u.pn == 2 || u.pn == 3) ? 1 : ((u.pn >= 7 && u.pn <= 10) ? 2 : 0);
#pragma unroll
            for (int ai = 0; ai < 2; ++ai)
#pragma unroll
                for (int m = 0; m < 4; ++m) {
                    const int row = row0 + ai * HALF + m * 16;
#pragma unroll
                    for (int bj = 0; bj < 2; ++bj) {
                        const int col = col0 + bj * HALF; float v[8];
#pragma unroll
                        for (int n = 0; n < 2; ++n)
#pragma unroll
                            for (int j = 0; j < 4; ++j) v[4 * n + j] = acc[ai][bj][m][n][j];
                        if constexpr (KIND == EK_PROJ) {
#pragma unroll
                            for (int j = 0; j < 8; ++j) v[j] *= osc;
                            if (act == 1) {
#pragma unroll
                                for (int j = 0; j < 8; ++j) v[j] *= QSCALE;
                            } else if (act == 2) {
#pragma unroll
                                for (int j = 0; j < 8; ++j) v[j] = siluf_(v[j]);
                            }
                            *(u32x4*)(O + (size_t)row * ldo + col) = pack8(v);
                        } else if constexpr (KIND == EK_GATE) {
#pragma unroll
                            for (int j = 0; j < 8; ++j) v[j] = sigmoidf_(v[j] * osc);
                            *(u32x2*)((unsigned char*)O + (size_t)row * ldo + col) = pack8_i8(v, 127.f);
                        } else if constexpr (KIND == EK_BR0 || KIND == EK_BR1 || KIND == EK_BR2) {
                            float gt[8]; { const u32x2 gw = *(const u32x2*)((const unsigned char*)X + (size_t)row * ldx + col);
#pragma unroll
                              for (int j = 0; j < 4; ++j) { gt[j] = (float)((gw.x >> (8 * j)) & 255u) * (1.f / 127.f); gt[4 + j] = (float)((gw.y >> (8 * j)) & 255u) * (1.f / 127.f); } }
#pragma unroll
                            for (int j = 0; j < 8; ++j) v[j] *= osc;
                            bf16_t* fp = (bf16_t*)F + (size_t)row * 1024 + col;
                            if constexpr (KIND == EK_BR0) {
                                float s[8];
#pragma unroll
                                for (int j = 0; j < 8; ++j) s[j] = gt[j] * v[j];
                                *(u32x4*)fp = pack8(s);
                            } else {
                                float s[8]; unpack8(*(const u32x4*)fp, s);
#pragma unroll
                                for (int j = 0; j < 8; ++j) s[j] += gt[j] * v[j];
                                if constexpr (KIND == EK_BR1) *(u32x4*)fp = pack8(s);
                                else *(u32x2*)((unsigned char*)O + (size_t)row * ldo + col) = pack8_i8(s, MSCALE);
                            }
                        } else if constexpr (KIND == EK_WOUT) {
                            float hv[8]; unpack8(*(const u32x4*)(X + (size_t)row * ldx + col), hv);
#pragma unroll
                            for (int j = 0; j < 8; ++j) v[j] = v[j] * osc + DN_ALPHA * hv[j];
                            *(u32x4*)(O + (size_t)row * ldo + col) = pack8(v);
                        }
                        asm volatile("" ::: "memory");
                    }
                }
        }
    }
};
}

#define XB_TMO      128
#define XB_XCNT(j)  (256  + 64 * (j))
#define XB_XSUB(j)  (1280 + 64 * (j))
#define XB_XGEN(j)  (2304 + 64 * (j))
#define XB_TOP      3328
#define XB_TOPGEN   3392
#define XCD_BAR_WORDS 3456
#define XB_SPIN_CAP (1u << 20)
__device__ __forceinline__ unsigned xb_ld(unsigned* p)              { return __hip_atomic_load(p, __ATOMIC_RELAXED, __HIP_MEMORY_SCOPE_AGENT); }
__device__ __forceinline__ unsigned xb_add(unsigned* p, unsigned v) { return __hip_atomic_fetch_add(p, v, __ATOMIC_RELAXED, __HIP_MEMORY_SCOPE_AGENT); }
__device__ __forceinline__ unsigned xb_xcc_id() { return (unsigned)__builtin_amdgcn_s_getreg((3 << 11) | 20) & 0xFu; }
#define XB_SPIN(cond, bar) do { unsigned _sp = 0; while (cond) { __builtin_amdgcn_s_sleep(1); \
    if ((++_sp & 255u) == 0u) { if (xb_ld(&(bar)[XB_TMO])) break; if (_sp > XB_SPIN_CAP) { atomicAdd(&(bar)[XB_TMO], 1u); break; } } } } while (0)
struct XcdBarrier { unsigned* bar; unsigned x; volatile LAS unsigned* st; };
__device__ __forceinline__ XcdBarrier xcd_barrier_post(unsigned* bar, volatile LAS unsigned* st, int tid) {
    XcdBarrier b; b.bar = bar; b.x = xb_xcc_id(); b.st = st;
    if (tid == 0) (void)xb_add(&bar[XB_XCNT(b.x)], 1u);
    return b;
}
__device__ __forceinline__ void xcd_barrier_complete(unsigned* bar, unsigned x, unsigned& nloc, unsigned& nx) {
    const unsigned G = gridDim.x * gridDim.y * gridDim.z;
    unsigned sum, cnt, mine, sp = 0u;
    for (;;) {
        sum = 0u; cnt = 0u; mine = 0u;
#pragma unroll
        for (unsigned j = 0; j < 16; ++j) { const unsigned c = xb_ld(&bar[XB_XCNT(j)]); sum += c; cnt += (c > 0u) ? 1u : 0u; mine = (j == x) ? c : mine; }
        if (sum == G) break;
        __builtin_amdgcn_s_sleep(1);
        if ((++sp & 255u) == 0u) { if (xb_ld(&bar[XB_TMO])) break; if (sp > XB_SPIN_CAP) { atomicAdd(&bar[XB_TMO], 1u); break; } }
    }
    nloc = mine > 0u ? mine : 1u; nx = cnt > 0u ? cnt : 1u;
}
__device__ __forceinline__ void xcd_barrier(const XcdBarrier& b, int tid) {
    asm volatile("s_waitcnt vmcnt(0)" ::: "memory");
    __syncthreads();
    if (tid == 0) {
        unsigned* bar = b.bar;
        __builtin_amdgcn_s_waitcnt(0);
        unsigned nloc = b.st[0], nx = b.st[1];
        if (nloc == 0u) { xcd_barrier_complete(bar, b.x, nloc, nx); b.st[0] = nloc; b.st[1] = nx; }
        const unsigned old = xb_add(&bar[XB_XSUB(b.x)], 1u);
        const unsigned gen = old / nloc;
        if (old + 1u == (gen + 1u) * nloc) {
            __builtin_amdgcn_fence(__ATOMIC_RELEASE, "agent");
            asm volatile("s_waitcnt vmcnt(0)" ::: "memory");
            const unsigned og = xb_add(&bar[XB_TOP], 1u);
            const unsigned tg = og / nx;
            if (og + 1u == (tg + 1u) * nx) xb_add(&bar[XB_TOPGEN], 1u);
            else XB_SPIN(xb_ld(&bar[XB_TOPGEN]) == tg, bar);
            __builtin_amdgcn_fence(__ATOMIC_ACQUIRE, "agent");
            xb_add(&bar[XB_XGEN(b.x)], 1u);
            asm volatile("s_waitcnt vmcnt(0)" ::: "memory");
        } else {
            XB_SPIN(xb_ld(&bar[XB_XGEN(b.x)]) == gen, bar);
            __builtin_amdgcn_fence(__ATOMIC_ACQUIRE, "agent");
            asm volatile("s_waitcnt vmcnt(0)" ::: "memory");
        }
    }
    __syncthreads();
}

struct Args { const float* in[32]; float* out; unsigned char* ws; int lo, hi; };
typedef const __attribute__((address_space(4))) Args* ArgsP;
enum { I_X = 0, I_LN0G, I_LN0B, I_WIN, I_POOLW, I_POOLS, I_CKPE, I_CKW1, I_CKW2, I_CVPE, I_CVW1, I_CVW2, I_RELB, I_CONVW, I_CONVB, I_DTB, I_ALOG, I_DSKIP, I_SNG,
       I_WBP, I_WBN, I_WBS, I_WOUT, I_LN1G, I_LN1B, I_RW, I_RB, I_EW1, I_EW3, I_EW2, I_LN2G, I_LN2B };


struct Ctx {
    LAS unsigned char* lds;
    unsigned* ctl;
    unsigned char* ws; unsigned char* dout;
    int tid, lane, wave, G, vcu, gw, NGW;
};

struct Job { const float* src; size_t sbatch; int ldw, K, c0, ncols; bf16_t* dst; int dbatch_rows, ldt, drow0, mode, nbatch, fp8; float wsc; };
constexpr int NJOBS = 15;
__device__ __forceinline__ Job get_job(ArgsP a, int l, int j) {
    unsigned char* wl = a->ws + WS_W + (size_t)l * W_LAYER;
    bf16_t* win = (bf16_t*)(wl + WO_IN); bf16_t* wg = (bf16_t*)(wl + WO_GATE);
    const float* w_in = a->in[I_WIN] + (size_t)l * DM * D_IN;
    Job J; J.sbatch = 0; J.dbatch_rows = 0; J.mode = 0; J.nbatch = 1; J.c0 = 0; J.drow0 = 0; J.fp8 = 0; J.wsc = WSCALE;
    switch (j) {
    case 0:  J.src = w_in; J.ldw = D_IN; J.K = 1024; J.c0 = 0;    J.ncols = 1792; J.dst = win; J.ldt = 1024; J.drow0 = 0; J.fp8 = 1; break;
    case 1:  J.src = w_in; J.ldw = D_IN; J.K = 1024; J.c0 = 1792; J.ncols = 24;   J.dst = win; J.ldt = 1024; J.drow0 = C_NG; J.fp8 = 1; break;
    case 2:  J.src = w_in; J.ldw = D_IN; J.K = 1024; J.c0 = 1816; J.ncols = 3072; J.dst = win; J.ldt = 1024; J.drow0 = C_Z; J.fp8 = 1; break;
    case 3:  J.src = w_in; J.ldw = D_IN; J.K = 1024; J.c0 = 4888; J.ncols = 16;   J.dst = win; J.ldt = 1024; J.drow0 = C_DT; J.fp8 = 1; break;
    case 4:  J.src = w_in; J.ldw = D_IN; J.K = 1024; J.c0 = 4904; J.ncols = 3072; J.dst = wg;  J.ldt = 1024; J.drow0 = 0; J.fp8 = 1; break;
    case 5:  J.src = a->in[I_WBN] + (size_t)l * 512 * 1024;  J.ldw = 1024; J.K = 512;  J.ncols = 1024; J.dst = (bf16_t*)(wl + WO_C + 512); J.ldt = 1024; J.fp8 = 1; J.wsc = WSCALE_CN; break;
    case 6:  J.src = a->in[I_WBS] + (size_t)l * 1024 * 1024; J.ldw = 1024; J.K = 1024; J.ncols = 1024; J.dst = (bf16_t*)(wl + WO_SSD); J.ldt = 1024; J.fp8 = 1; break;
    case 7:  J.src = a->in[I_WOUT] + (size_t)l * 1024 * 1024; J.ldw = 1024; J.K = 1024; J.ncols = 1024; J.dst = (bf16_t*)(wl + WO_OUT); J.ldt = 1024; J.fp8 = 1; J.wsc = WSCALE_OUT; break;
    case 8:  J.src = a->in[I_CKW1] + (size_t)l * 2048 * 128; J.ldw = 128; J.K = 2048; J.ncols = 128; J.dst = (bf16_t*)(wl + WO_W1); J.ldt = 2048; break;
    case 9:  J.src = a->in[I_CVW1] + (size_t)l * 2048 * 128; J.ldw = 128; J.K = 2048; J.ncols = 128; J.dst = (bf16_t*)(wl + WO_W1) + 128 * 2048; J.ldt = 2048; break;
    case 10: J.src = a->in[I_CKW2] + (size_t)l * 128 * 64; J.ldw = 64; J.K = 128; J.ncols = 64; J.dst = (bf16_t*)(wl + WO_W2); J.ldt = 128; break;
    case 11: J.src = a->in[I_CVW2] + (size_t)l * 128 * 64; J.ldw = 64; J.K = 128; J.ncols = 64; J.dst = (bf16_t*)(wl + WO_W2) + 64 * 128; J.ldt = 128; break;
    case 12: J.src = a->in[I_EW1] + (size_t)l * 16 * 1024 * 512; J.sbatch = (size_t)1024 * 512; J.ldw = 512; J.K = 1024; J.ncols = 512; J.dst = (bf16_t*)(wl + WO_UP); J.dbatch_rows = 1024; J.ldt = 1024; J.drow0 = 0;   J.mode = 1; J.nbatch = 16; J.fp8 = 1; break;
    case 13: J.src = a->in[I_EW3] + (size_t)l * 16 * 1024 * 512; J.sbatch = (size_t)1024 * 512; J.ldw = 512; J.K = 1024; J.ncols = 512; J.dst = (bf16_t*)(wl + WO_UP); J.dbatch_rows = 1024; J.ldt = 1024; J.drow0 = 128; J.mode = 1; J.nbatch = 16; J.fp8 = 1; break;
    default: J.src = a->in[I_EW2] + (size_t)l * 16 * 512 * 1024; J.sbatch = (size_t)512 * 1024; J.ldw = 1024; J.K = 512; J.ncols = 1024; J.dst = (bf16_t*)(wl + WO_DN); J.dbatch_rows = 1024; J.ldt = 512; J.nbatch = 16; J.fp8 = 1; J.wsc = WSCALE_DN; break;
    }
    return J;
}
__device__ __forceinline__ void tr_item(const Job& J, int item, LAS float* scr, int lane) {
    const int nblk = (J.ncols + 31) >> 5, kblk = J.K >> 6, per = nblk * kblk;
    const int bt = item / per, r = item - bt * per, kb = r / nblk, nb = r - kb * nblk, k0 = 64 * kb, n0 = 32 * nb;
    const int nv = (J.ncols - n0) < 32 ? (J.ncols - n0) : 32;
    const float* W = J.src + (size_t)bt * J.sbatch;
    { const int nn = lane & 31; const float* wp = W + (size_t)(k0 + (lane >> 5)) * J.ldw + J.c0 + n0 + nn; float v[32];
#pragma unroll
      for (int i = 0; i < 32; ++i) v[i] = (nn < nv) ? wp[(size_t)(2 * i) * J.ldw] : 0.f;
#pragma unroll
      for (int i = 0; i < 32; ++i) scr[(2 * i + (lane >> 5)) * 33 + nn] = v[i]; }
    LDS_WAIT();
    const int c = lane & 7;
#pragma unroll
    for (int j = 0; j < 4; ++j) { const int n = (lane >> 3) + 8 * j;
        if (n < nv) {
            const LAS float* s = scr + (8 * c) * 33 + n; const int nn = n0 + n;
            const int drow = bt * J.dbatch_rows + J.drow0 + (J.mode == 1 ? ((nn >> 7) * 256 + (nn & 127)) : nn);
            if (J.fp8) { u32x2 o; o.x = cvt4_i8(s[0 * 33] * J.wsc, s[1 * 33] * J.wsc, s[2 * 33] * J.wsc, s[3 * 33] * J.wsc); o.y = cvt4_i8(s[4 * 33] * J.wsc, s[5 * 33] * J.wsc, s[6 * 33] * J.wsc, s[7 * 33] * J.wsc);
                *(u32x2*)((unsigned char*)J.dst + (size_t)drow * J.ldt + k0 + 8 * c) = o; }
            else { u32x4 o; o.x = cvt_pk_bf16(s[0 * 33], s[1 * 33]); o.y = cvt_pk_bf16(s[2 * 33], s[3 * 33]); o.z = cvt_pk_bf16(s[4 * 33], s[5 * 33]); o.w = cvt_pk_bf16(s[6 * 33], s[7 * 33]);
                *(u32x4*)(J.dst + (size_t)drow * J.ldt + k0 + 8 * c) = o; } } }
    LDS_WAIT();
}
__device__ __forceinline__ void ln_row_f32(const float* xrow, const float* g, const float* b, bf16_t* orow, unsigned char* orow8, int lane) {
    const f32x4* xr = (const f32x4*)xrow + lane; f32x4 v[4]; float s = 0.f;
#pragma unroll
    for (int j = 0; j < 4; ++j) { v[j] = xr[64 * j]; s += (v[j].x + v[j].y) + (v[j].z + v[j].w); }
    const float mean = wave_sum(s) * (1.f / DM); float s2 = 0.f;
#pragma unroll
    for (int j = 0; j < 4; ++j) { v[j] = v[j] - mean; s2 += (v[j].x * v[j].x + v[j].y * v[j].y) + (v[j].z * v[j].z + v[j].w * v[j].w); }
    const float rstd = 1.f / sqrtf(wave_sum(s2) * (1.f / DM) + LN_EPS);
    u32x2* o8 = (u32x2*)orow + lane;
#pragma unroll
    for (int j = 0; j < 4; ++j) { const f32x4 gg = ((const f32x4*)g + lane)[64 * j], bb = ((const f32x4*)b + lane)[64 * j];
        const float y0 = v[j].x * rstd * gg.x + bb.x, y1 = v[j].y * rstd * gg.y + bb.y, y2 = v[j].z * rstd * gg.z + bb.z, y3 = v[j].w * rstd * gg.w + bb.w;
        u32x2 w; w.x = cvt_pk_bf16(y0, y1); w.y = cvt_pk_bf16(y2, y3); o8[64 * j] = w;
        ((unsigned*)orow8 + lane)[64 * j] = cvt4_i8(y0 * ASCALE, y1 * ASCALE, y2 * ASCALE, y3 * ASCALE); }
}
__device__ __forceinline__ int rel_bucket_dev(int n) {
    if (n < 16) return n;
    int b = 16;
    b += (n >= 19) + (n >= 21) + (n >= 24) + (n >= 27) + (n >= 31) + (n >= 35) + (n >= 40) + (n >= 46) + (n >= 52) + (n >= 59) + (n >= 67) + (n >= 77) + (n >= 87) + (n >= 99) + (n >= 113);
    return b;
}
__device__ __forceinline__ void p0_prologue(const Ctx& F, ArgsP a) {
    LAS float* scr = (LAS float*)(F.lds + F.wave * 16384);
    int base = 0;
    for (int l = 0; l < DEPTH; ++l)
        for (int j = 0; j < NJOBS; ++j) {
            const Job J = get_job(a, l, j);
            const int nitems = J.nbatch * (J.K >> 6) * ((J.ncols + 31) >> 5);
            int first = (F.gw - base) % F.NGW; if (first < 0) first += F.NGW;
            for (int it = first; it < nitems; it += F.NGW) tr_item(J, it, scr, F.lane);
            base = (base + nitems) % F.NGW;
        }
    { bf16_t* H = (bf16_t*)(a->ws + WS_H);
      for (int m = F.gw; m < T_; m += F.NGW) ln_row_f32(a->in[I_X] + (size_t)m * DM, a->in[I_LN0G], a->in[I_LN0B], H + (size_t)m * DM, a->ws + WS_H8 + (size_t)m * DM, F.lane); }
    { const int gt = blockIdx.x * 512 + F.tid, nthr = F.G * 512;
      for (int id = gt; id < DEPTH * 65536; id += nthr) {
          const int l = id >> 16, r = id & 65535, n = r & 1023, k8 = r >> 10, g = k8 >> 4, c0 = (k8 & 15) * 8;
          const float* pw = a->in[I_POOLW] + (size_t)l * 4 * 128 * 128 + (size_t)(g * 128 + c0) * 128;
          const float* sc = a->in[I_POOLS] + l * 512 + g * 128;
          const float* wb = a->in[I_WBP] + (size_t)l * 512 * 1024 + (size_t)(g * 128) * 1024 + n;
          float acc[8] = {0.f, 0.f, 0.f, 0.f, 0.f, 0.f, 0.f, 0.f};
          for (int d = 0; d < 128; ++d) { const float w = wb[(size_t)d * 1024] * sc[d];
#pragma unroll
              for (int i = 0; i < 8; ++i) acc[i] += pw[i * 128 + d] * w; }
          unsigned char* dst = a->ws + WS_W + (size_t)l * W_LAYER + WO_C + (size_t)n * 1024 + g * 128 + c0;
          *(u32x2*)dst = pack8_i8(acc, WSCALE_CN);
      } }
    for (int o = F.gw; o < DEPTH * 2 * 128; o += F.NGW) {
        const int l = o >> 8, kv = (o >> 7) & 1, col = o & 127;
        const float* pe = a->in[kv ? I_CVPE : I_CKPE] + (size_t)l * 2048; const float* w1 = a->in[kv ? I_CVW1 : I_CKW1] + (size_t)l * 2048 * 128 + col;
        float s = 0.f;
        for (int k = F.lane; k < 2048; k += 64) s += pe[k] * w1[(size_t)k * 128];
        s = wave_sum(s);
        if (F.lane == 0) ((float*)(a->ws + WS_MISC + MI_B1))[o] = s;
    }
    if (blockIdx.x == 0) {
        float* bt = (float*)(a->ws + WS_MISC + MI_BIAS);
        for (int i = F.tid; i < 8 * 128; i += 512) { const int hd = i >> 7, d = i & 127;
            bt[i] = (a->in[I_RELB][rel_bucket_dev(d) * 8 + hd] - a->in[I_RELB][31 * 8 + hd]) * LOG2E; }
    }
}

__device__ __forceinline__ void conv_phase(const Ctx& F, const bf16_t* P, bf16_t* XC, const float* cw, const float* cb) {
    const int gt = blockIdx.x * 512 + F.tid, nthr = F.G * 512;
    const int c = gt & 255;
    float w[4][8], b[8];
#pragma unroll
    for (int k = 0; k < 4; ++k)
#pragma unroll
        for (int i = 0; i < 8; ++i) w[k][i] = cw[k * 2048 + 8 * c + i];
#pragma unroll
    for (int i = 0; i < 8; ++i) b[i] = cb[8 * c + i];
    for (int id = gt; id < (TG / 16) * 256; id += nthr) {
        const int tl0 = (id >> 8) * 16, s0 = tl0 & (SEQ - 1);
        u32x4 raw[19];
#pragma unroll
        for (int r = 0; r < 19; ++r) raw[r] = (s0 + r - 3 >= 0) ? *(const u32x4*)(P + (size_t)(tl0 + r - 3) * LDP + C_XBC + 8 * c) : (u32x4){0u, 0u, 0u, 0u};
#pragma unroll
        for (int i = 0; i < 16; ++i) {
            float acc[8];
#pragma unroll
            for (int j = 0; j < 8; ++j) acc[j] = b[j];
#pragma unroll
            for (int k = 0; k < 4; ++k) { float x[8]; unpack8(raw[i + k], x);
#pragma unroll
                for (int j = 0; j < 8; ++j) acc[j] += w[k][j] * x[j]; }
#pragma unroll
            for (int j = 0; j < 8; ++j) acc[j] = siluf_(acc[j]);
            *(u32x4*)(XC + (size_t)(tl0 + i) * 2048 + 8 * c) = pack8(acc);
        }
    }
}
__device__ __forceinline__ void compress_unit(const Ctx& F, int cu, const bf16_t* P, const bf16_t* W1t, const bf16_t* W2t, const float* b1, bf16_t* KC, bf16_t* VC) {
    const int kv = cu & 1, g = (cu >> 1) & 1, nb = (cu >> 2) & 7, bl = cu >> 5;
    const int lane = F.lane, w = F.wave, fr = lane & 15, fq = lane >> 4;
    LAS bf16_t* hid = (LAS bf16_t*)F.lds;
    const bf16_t* w1 = W1t + (size_t)kv * 128 * 2048 + (size_t)(16 * w + fr) * 2048 + 8 * fq;
    int n0 = nb * 16 + fr; if (n0 > 126) n0 = 126;
    const bf16_t* a0 = P + (size_t)(bl * SEQ + 16 * n0) * LDP + C_KV + kv * 128 + g * 64 + 8 * fq;
    f32x4 acc0 = {0.f, 0.f, 0.f, 0.f}, acc1 = {0.f, 0.f, 0.f, 0.f};
#pragma unroll 8
    for (int kk = 0; kk < 64; kk += 2) {
        const int l = kk >> 1;
        const bf16x8 bb0 = *(const bf16x8*)(w1 + kk * 32), bb1 = *(const bf16x8*)(w1 + kk * 32 + 32);
        const bf16x8 x0 = *(const bf16x8*)(a0 + (size_t)l * LDP), x1 = *(const bf16x8*)(a0 + (size_t)l * LDP + 32);
        acc0 = mfma16(x0, bb0, acc0); acc1 = mfma16(x1, bb1, acc1);
    }
    const float bias = b1[kv * 128 + 16 * w + fr];
#pragma unroll
    for (int r = 0; r < 4; ++r) { const float x = acc0[r] + acc1[r] + bias, u = 0.7978845608f * (x + 0.044715f * x * x * x); hid[(4 * fq + r) * 136 + 16 * w + fr] = f2bf(x * sigmoidf_(2.f * u)); }
    __syncthreads();
    if (w < 4) { f32x4 acc = {0.f, 0.f, 0.f, 0.f};
      const bf16_t* w2 = W2t + (size_t)kv * 64 * 128 + (size_t)(16 * w + fr) * 128 + 8 * fq;
#pragma unroll
      for (int ks = 0; ks < 4; ++ks) { const bf16x8 aa = *(const LAS bf16x8*)(hid + fr * 136 + ks * 32 + 8 * fq); const bf16x8 bb = *(const bf16x8*)(w2 + ks * 32); acc = mfma16(aa, bb, acc); }
      bf16_t* dst = kv ? VC : KC;
#pragma unroll
      for (int r = 0; r < 4; ++r) { const int n = nb * 16 + 4 * fq + r; if (n < 127) dst[(size_t)(bl * 128 + n) * 128 + g * 64 + 16 * w + fr] = f2bf(acc[r]); }
    }
    __syncthreads();
}

template <int WIN>
__device__ __forceinline__ void pool_item(const bf16_t* P, bf16_t* R, int grp, int rq, int lane) {
    const int c = 16 * grp + (lane & 15), tl0 = (4 * rq + (lane >> 4)) * 8, s0 = tl0 & (SEQ - 1);
    constexpr int NROW = 7 + WIN;
    u32x4 raw[NROW];
#pragma unroll
    for (int k = 0; k < NROW; ++k) { const int sp = s0 - (WIN - 1) + k; raw[k] = (sp >= 0) ? *(const u32x4*)(P + (size_t)(tl0 - (WIN - 1) + k) * LDP + C_POOL + 8 * c) : (u32x4){0u, 0u, 0u, 0u}; }
#pragma unroll
    for (int i = 0; i < 8; ++i) {
        float sum[8] = {0.f, 0.f, 0.f, 0.f, 0.f, 0.f, 0.f, 0.f}, u0[8];
#pragma unroll
        for (int j = 0; j < WIN; ++j) { float x[8]; unpack8(raw[i + (WIN - 1) - j], x);
#pragma unroll
            for (int q = 0; q < 8; ++q) sum[q] += x[q]; }
        unpack8(raw[i + WIN - 1], u0);
        const int s = s0 + i, cnt = (s + 1) < WIN ? (s + 1) : WIN; const float inv = 1.f / (float)cnt;
#pragma unroll
        for (int q = 0; q < 8; ++q) sum[q] = sum[q] * inv - u0[q];
        *(u32x2*)((unsigned char*)R + (size_t)(tl0 + i) * 1024 + 8 * c) = pack8_i8(sum, RSCALE);
    }
}
__device__ __forceinline__ void fin_phase(const Ctx& F, const bf16_t* P, bf16_t* R, const bf16_t* Y, unsigned char* Y8, const float* normg) {
    for (int wi = F.gw; wi < 4 * (TG / 32); wi += F.NGW) {
        const int grp = wi & 3, rq = wi >> 2;
        if (grp == 0) pool_item<2>(P, R, 0, rq, F.lane); else if (grp == 1) pool_item<4>(P, R, 1, rq, F.lane); else if (grp == 2) pool_item<8>(P, R, 2, rq, F.lane); else pool_item<16>(P, R, 3, rq, F.lane);
    }
    const int lane = F.lane;
    float ng[16];
#pragma unroll
    for (int i = 0; i < 16; ++i) ng[i] = normg[16 * lane + i];
    u32x4 nx[4];
#define FIN_LOAD(tl_) do { nx[0] = *(const u32x4*)(Y + (size_t)(tl_) * 1024 + 16 * lane); nx[1] = *(const u32x4*)(Y + (size_t)(tl_) * 1024 + 16 * lane + 8); \
        nx[2] = *(const u32x4*)(P + (size_t)(tl_) * LDP + C_Z + 16 * lane); nx[3] = *(const u32x4*)(P + (size_t)(tl_) * LDP + C_Z + 16 * lane + 8); } while (0)
    if (F.gw < TG) FIN_LOAD(F.gw);
    for (int tl = F.gw; tl < TG; tl += F.NGW) {
        const u32x4 c0 = nx[0], c1 = nx[1], c2 = nx[2], c3 = nx[3];
        if (tl + F.NGW < TG) FIN_LOAD(tl + F.NGW);
        float y[16], z[16];
        { float t[8]; unpack8(c0, t);
#pragma unroll
          for (int i = 0; i < 8; ++i) y[i] = t[i];
          unpack8(c1, t);
#pragma unroll
          for (int i = 0; i < 8; ++i) y[8 + i] = t[i];
          unpack8(c2, t);
#pragma unroll
          for (int i = 0; i < 8; ++i) z[i] = t[i];
          unpack8(c3, t);
#pragma unroll
          for (int i = 0; i < 8; ++i) z[8 + i] = t[i]; }
        float ss = 0.f;
#pragma unroll
        for (int i = 0; i < 16; ++i) { y[i] *= z[i]; ss += y[i] * y[i]; }
        ss += __shfl_xor(ss, 1); ss += __shfl_xor(ss, 2); ss += __shfl_xor(ss, 4); ss += __shfl_xor(ss, 8);
        const float rstd = 1.f / sqrtf(ss * (1.f / 256.f) + LN_EPS);
        float o[8];
#pragma unroll
        for (int i = 0; i < 8; ++i) o[i] = y[i] * rstd * ng[i];
        *(u32x2*)(Y8 + (size_t)tl * 1024 + 16 * lane) = pack8_i8(o, YSCALE);
#pragma unroll
        for (int i = 0; i < 8; ++i) o[i] = y[8 + i] * rstd * ng[8 + i];
        *(u32x2*)(Y8 + (size_t)tl * 1024 + 16 * lane + 8) = pack8_i8(o, YSCALE);
    }
#undef FIN_LOAD
}

#ifndef NSA_X1
#define NSA_X1 0
#endif
#ifndef NSA_X2
#define NSA_X2 0
#endif
#ifndef SSD_REP
#define SSD_REP 0
#endif
#ifndef NSA_REP
#define NSA_REP 0
#endif
constexpr int NL_KT = 0, NL_VT = 32768, NL_BIAS = 65536, NL_IMP = 73728, NL_SEL = 107520, NL_UNI = 107776;
__device__ __forceinline__ void glds16(const void* gsrc, unsigned lds_dst) { unsigned keep;
    asm volatile("s_mov_b32 %0, m0\n\ts_mov_b32 m0, %2\n\ts_nop 0\n\tglobal_load_lds_dwordx4 %1, off\n\ts_mov_b32 m0, %0" : "=&s"(keep) : "v"(gsrc), "s"(lds_dst) : "memory"); }
#define NSA_WAITBAR(N) asm volatile("s_waitcnt vmcnt(" #N ") lgkmcnt(0)\n\ts_barrier" ::: "memory")

#define NSA_STORE_TILE(buf) do { \
    *(LAS u32x4*)(lds + NL_KT + (buf) * 8192 + (tid >> 6) * 1024 + (tid & 63) * 16) = kreg; \
    *(LAS u32x4*)(lds + NL_VT + (buf) * 8192 + ((tid & 7) >> 2) * 4096 + (tid >> 3) * 64 + (tid & 3) * 16) = vreg; } while (0)

__device__ __forceinline__ void nsa_kload(const LAS unsigned char* Kt, int r32, int hi, bf16x8 (&kf)[8]) {
#pragma unroll
    for (int d0 = 0; d0 < 4; ++d0) { kf[2 * d0] = *(const LAS bf16x8*)(Kt + (2 * d0 + hi) * 1024 + r32 * 16); kf[2 * d0 + 1] = *(const LAS bf16x8*)(Kt + (2 * d0 + hi) * 1024 + 512 + r32 * 16); }
}
__device__ __forceinline__ void nsa_qk_f(const bf16x8 (&kf)[8], const bf16x8 (&qB)[4], f32x16& p0, f32x16& p1) {
    p0 = (f32x16){0.f, 0.f, 0.f, 0.f, 0.f, 0.f, 0.f, 0.f, 0.f, 0.f, 0.f, 0.f, 0.f, 0.f, 0.f, 0.f}; p1 = p0;
#pragma unroll
    for (int d0 = 0; d0 < 4; ++d0) { p0 = mfma32(kf[2 * d0], qB[d0], p0); p1 = mfma32(kf[2 * d0 + 1], qB[d0], p1); }
}
__device__ __forceinline__ void nsa_qk(const LAS unsigned char* Kt, const bf16x8 (&qB)[4], int r32, int hi, f32x16& p0, f32x16& p1) {
    bf16x8 kf[8]; nsa_kload(Kt, r32, hi, kf); nsa_qk_f(kf, qB, p0, p1);
}
__device__ __forceinline__ void nsa_vload(const LAS unsigned char* Vt, int lane, int hi, bf16x8 (&vf)[8]) {
    const LAS unsigned char* vb = Vt + (4 * hi + ((lane & 15) >> 2)) * 64 + ((lane >> 4) & 1) * 32 + (lane & 3) * 8;
#pragma unroll
    for (int ks = 0; ks < 4; ++ks) { vf[2 * ks] = cat8(trrd(vb + ks * 1024), trrd(vb + ks * 1024 + 512)); vf[2 * ks + 1] = cat8(trrd(vb + 4096 + ks * 1024), trrd(vb + 4096 + ks * 1024 + 512)); }
}
__device__ __forceinline__ void nsa_pack(const f32x16& p0, const f32x16& p1, bool keep, bf16x8 (&pB)[4]) {
    { u32x4 t; t.x = cvt_pk_bf16(p0[0], p0[1]); t.y = cvt_pk_bf16(p0[2], p0[3]); t.z = cvt_pk_bf16(p0[4], p0[5]); t.w = cvt_pk_bf16(p0[6], p0[7]); pB[0] = __builtin_bit_cast(bf16x8, t);
      t.x = cvt_pk_bf16(p0[8], p0[9]); t.y = cvt_pk_bf16(p0[10], p0[11]); t.z = cvt_pk_bf16(p0[12], p0[13]); t.w = cvt_pk_bf16(p0[14], p0[15]); pB[1] = __builtin_bit_cast(bf16x8, t);
      t.x = cvt_pk_bf16(p1[0], p1[1]); t.y = cvt_pk_bf16(p1[2], p1[3]); t.z = cvt_pk_bf16(p1[4], p1[5]); t.w = cvt_pk_bf16(p1[6], p1[7]); pB[2] = __builtin_bit_cast(bf16x8, t);
      t.x = cvt_pk_bf16(p1[8], p1[9]); t.y = cvt_pk_bf16(p1[10], p1[11]); t.z = cvt_pk_bf16(p1[12], p1[13]); t.w = cvt_pk_bf16(p1[14], p1[15]); pB[3] = __builtin_bit_cast(bf16x8, t); }
    if (!keep) { const bf16x8 z = {0, 0, 0, 0, 0, 0, 0, 0}; pB[0] = z; pB[1] = z; pB[2] = z; pB[3] = z; }
}
__device__ __forceinline__ void nsa_pv_f(const bf16x8 (&vf)[8], const bf16x8 (&pB)[4], f32x16& o0, f32x16& o1) {
#pragma unroll
    for (int ks = 0; ks < 4; ++ks) { o0 = mfma32(vf[2 * ks], pB[ks], o0); o1 = mfma32(vf[2 * ks + 1], pB[ks], o1); }
}
__device__ __forceinline__ void nsa_pv(const LAS unsigned char* Vt, int lane, int hi, const f32x16& p0, const f32x16& p1, f32x16& o0, f32x16& o1, bool keep = true) {
    bf16x8 vf[8], pB[4]; nsa_vload(Vt, lane, hi, vf); nsa_pack(p0, p1, keep, pB); nsa_pv_f(vf, pB, o0, o1);
}

template <int MODE>
__device__ __forceinline__ void nsa_smp(int j, f32x16& p0, f32x16& p1, int qt, int ql, unsigned mysel, const LAS float* biasH, int hi, float& l, bf16x8 (&pB)[4]) {
    const int dj = qt - j;
    const bool selq = (MODE == 1) ? (((mysel >> j) & 1u) != 0u) : true;
    if (dj <= 2) {
        const LAS float* tb = biasH + (64 * dj + ql - 4 * hi + 64);
#pragma unroll
        for (int r = 0; r < 16; ++r) { p0[r] += tb[-((r & 3) + 8 * (r >> 2))]; p1[r] += tb[-((r & 3) + 8 * (r >> 2)) - 32]; }
    } else if (MODE == 2 && dj == 8) {
        const int dq = 512 + ql - 4 * hi;
#pragma unroll
        for (int r = 0; r < 16; ++r) { const int d0 = dq - ((r & 3) + 8 * (r >> 2)); p0[r] = (d0 < 512) ? p0[r] : NEGBIG; p1[r] = (d0 - 32 < 512) ? p1[r] : NEGBIG; }
    }
    f32x2 ls2 = {0.f, 0.f};
#pragma unroll
    for (int r = 0; r < 16; ++r) { p0[r] = fexp2(p0[r]); p1[r] = fexp2(p1[r]); ls2 += (f32x2){p0[r], p1[r]}; }
    l += selq ? (ls2.x + ls2.y) : 0.f;
    nsa_pack(p0, p1, selq, pB);
}

template <int MODE>
__device__ __forceinline__ void nsa_branch(const Ctx& F, const bf16_t* Kg, const bf16_t* Vg, unsigned tiles, int qt, int ql, unsigned mysel,
                                           const LAS float* biasH, const bf16_t* qptr, float gate, f32x16& out0, f32x16& out1) {
    LAS unsigned char* lds = F.lds; int tid_ = F.tid; asm volatile("" : "+v"(tid_)); const int tid = tid_, lane = tid & 63, r32 = lane & 31, hi = lane >> 5;
    bf16x8 qB[4];
#pragma unroll
    for (int d0 = 0; d0 < 4; ++d0) qB[d0] = *(const bf16x8*)(qptr + 16 * d0);
    float l = 0.f;
    f32x16 o0 = (f32x16){0.f, 0.f, 0.f, 0.f, 0.f, 0.f, 0.f, 0.f, 0.f, 0.f, 0.f, 0.f, 0.f, 0.f, 0.f, 0.f}, o1 = o0;
    const int w = F.wave;
    const unsigned lbase = (unsigned)(size_t)lds;
    const bf16_t* ksrc = Kg + (size_t)lane * LDP + 8 * w;
    const bf16_t* vsrc = Vg + (size_t)(16 * (w & 3) + (lane >> 2)) * LDP + (w >> 2) * 32 + (lane & 3) * 8;
    const unsigned kdst = (unsigned)__builtin_amdgcn_readfirstlane((int)(lbase + NL_KT + w * 1024)), vdst = (unsigned)__builtin_amdgcn_readfirstlane((int)(lbase + NL_VT + (w >> 2) * 4096 + (w & 3) * 1024));
#define NSA_DMA(jj, slot) do { glds16(ksrc + (size_t)(jj) * 64 * LDP, kdst + (slot) * 8192); glds16(vsrc + (size_t)(jj) * 64 * LDP, vdst + (slot) * 8192); } while (0)
#define NSA_POP(dst) do { if (rem) { dst = (MODE == 1) ? (__ffs(rem) - 1) : (31 - __clz(rem)); rem &= ~(1u << dst); } else dst = -1; } while (0)
    unsigned rem = tiles; int jp, cur, nxt;
    NSA_POP(jp); NSA_POP(cur);
    NSA_DMA(jp, 0); if (cur >= 0) NSA_DMA(cur, 1);
    f32x16 pp0, pp1;
    if (cur >= 0) NSA_WAITBAR(2); else NSA_WAITBAR(0);
    NSA_POP(nxt); if (nxt >= 0) NSA_DMA(nxt, 2);
    nsa_qk(lds + NL_KT, qB, r32, hi, pp0, pp1);
    int bufp = 0, buf = 1;
    while (cur >= 0) {
        if (nxt >= 0) NSA_WAITBAR(2); else NSA_WAITBAR(0);
        int q; NSA_POP(q);
        if (q >= 0) NSA_DMA(q, (buf + 2) & 3);
        { bf16x8 kf[8], vf[8], pB[4];
          nsa_vload(lds + NL_VT + bufp * 8192, lane, hi, vf);
          nsa_smp<MODE>(jp, pp0, pp1, qt, ql, mysel, biasH, hi, l, pB);
          nsa_kload(lds + NL_KT + buf * 8192, r32, hi, kf);
          nsa_pv_f(vf, pB, o0, o1);
          nsa_qk_f(kf, qB, pp0, pp1); }
        jp = cur; bufp = buf; cur = nxt; nxt = q; buf = (buf + 1) & 3;
    }
    { bf16x8 vf[8], pB[4]; nsa_vload(lds + NL_VT + bufp * 8192, lane, hi, vf); nsa_smp<MODE>(jp, pp0, pp1, qt, ql, mysel, biasH, hi, l, pB); nsa_pv_f(vf, pB, o0, o1); }
#undef NSA_DMA
#undef NSA_POP
    __syncthreads();
    const float lt = l + __shfl_xor(l, 32), sc = gate * frcp(lt);
#pragma unroll
    for (int r = 0; r < 16; ++r) { out0[r] += sc * o0[r]; out1[r] += sc * o1[r]; }
}

__device__ __forceinline__ void nsa_unit(const Ctx& F, int bl, int g, int qt, const bf16_t* P, const bf16_t* KC, const bf16_t* VC, const float* biasT, bf16_t* YB) {
    LAS unsigned char* lds = F.lds; int tid_ = F.tid; asm volatile("" : "+v"(tid_)); const int tid = tid_, lane = tid & 63, w = F.wave, r32 = lane & 31, hi = lane >> 5;
    const int h = w >> 1, ql = 32 * (w & 1) + r32, t = 64 * qt + ql;
    const size_t row = (size_t)bl * SEQ + t;
    if (tid == 0) *(LAS unsigned*)(lds + NL_UNI) = 0u;
    const bf16_t* qptr = P + row * LDP + C_Q + g * 256 + h * 64 + 8 * hi;
    const float g_c = sigmoidf_(bf1(P[row * LDP + C_NG + g * 4 + h])), g_s = sigmoidf_(bf1(P[row * LDP + C_NG + 8 + g * 4 + h])), g_w = sigmoidf_(bf1(P[row * LDP + C_NG + 16 + g * 4 + h]));
    const LAS float* biasH = (const LAS float*)(lds + NL_BIAS) + (g * 4 + h) * 256;
    f32x16 out0 = (f32x16){0.f, 0.f, 0.f, 0.f, 0.f, 0.f, 0.f, 0.f, 0.f, 0.f, 0.f, 0.f, 0.f, 0.f, 0.f, 0.f}, out1 = out0;

    const int ntile = (qt >= 16) ? 2 : 1;
    for (int tl = 0; tl < ntile; ++tl) {
        int nk = 64 * tl + (tid & 63); if (nk > 126) nk = 126;
        int nv = 64 * tl + (tid >> 3); if (nv > 126) nv = 126;
        const u32x4 kreg = *(const u32x4*)(KC + (size_t)(bl * 128 + nk) * 128 + g * 64 + 8 * (tid >> 6));
        const u32x4 vreg = *(const u32x4*)(VC + (size_t)(bl * 128 + nv) * 128 + g * 64 + 8 * (tid & 7));
        NSA_STORE_TILE(tl);
    }
    __syncthreads();
    {
        f32x16 s0, s1, s2, s3;
        { bf16x8 qB[4];
#pragma unroll
          for (int d0 = 0; d0 < 4; ++d0) qB[d0] = *(const bf16x8*)(qptr + 16 * d0);
          nsa_qk(lds + NL_KT, qB, r32, hi, s0, s1);
          if (ntile == 2) nsa_qk(lds + NL_KT + 8192, qB, r32, hi, s2, s3);
          else { s2 = (f32x16){0.f, 0.f, 0.f, 0.f, 0.f, 0.f, 0.f, 0.f, 0.f, 0.f, 0.f, 0.f, 0.f, 0.f, 0.f, 0.f}; s3 = s2; } }
        const int db = t - 31 - 64 * hi;
        float mx = NEGBIG;
#define CMP_MASK(S, V) _Pragma("unroll") for (int r = 0; r < 16; ++r) { const int d = db - 16 * (32 * (V) + (r & 3) + 8 * (r >> 2)); \
            const int c = d < 0 ? 0 : (d > 127 ? 127 : d); S[r] = (d >= 0) ? S[r] + biasH[64 + c] : NEGBIG; mx = fmaxf(mx, S[r]); }
        CMP_MASK(s0, 0) CMP_MASK(s1, 1)
        if (ntile == 2) { CMP_MASK(s2, 2) CMP_MASK(s3, 3) }
#undef CMP_MASK
        mx = fmaxf(mx, __shfl_xor(mx, 32));
        float ls = 0.f;
#define CMP_EXP(S) _Pragma("unroll") for (int r = 0; r < 16; ++r) { S[r] = (S[r] > -1e29f) ? fexp2(S[r] - mx) : 0.f; ls += S[r]; }
        CMP_EXP(s0) CMP_EXP(s1)
        if (ntile == 2) { CMP_EXP(s2) CMP_EXP(s3) }
#undef CMP_EXP
        ls += __shfl_xor(ls, 32);
        const float inv = ls > 0.f ? 1.f / ls : 0.f;
#pragma unroll
        for (int r = 0; r < 16; ++r) { s0[r] *= inv; s1[r] *= inv; s2[r] *= inv; s3[r] *= inv; }
        LAS float* I = (LAS float*)(lds + NL_IMP) + (h * 64 + ql) * 33 + hi;
        float yprev = 0.f;
#define CMP_IMP(S, V) _Pragma("unroll") for (int a = 0; a < 4; ++a) { const float own = S[4 * a] + S[4 * a + 1] + S[4 * a + 2] + 0.5f * S[4 * a + 3]; \
            const float y = __shfl_xor(0.5f * S[4 * a + 3], 32); I[2 * (4 * (V) + a)] = own + (hi ? y : yprev); yprev = y; }
        CMP_IMP(s0, 0) CMP_IMP(s1, 1) CMP_IMP(s2, 2) CMP_IMP(s3, 3)
#undef CMP_IMP
        f32x16 o0 = (f32x16){0.f, 0.f, 0.f, 0.f, 0.f, 0.f, 0.f, 0.f, 0.f, 0.f, 0.f, 0.f, 0.f, 0.f, 0.f, 0.f}, o1 = o0;
        nsa_pv(lds + NL_VT, lane, hi, s0, s1, o0, o1);
        if (ntile == 2) nsa_pv(lds + NL_VT + 8192, lane, hi, s2, s3, o0, o1);
#pragma unroll
        for (int r = 0; r < 16; ++r) { out0[r] += g_c * o0[r]; out1[r] += g_c * o1[r]; }
    }
    __syncthreads();
    if (w == 0) {
        const LAS float* I = (const LAS float*)(lds + NL_IMP) + lane * 33;
        float v[32];
#pragma unroll
        for (int jj = 0; jj < 32; ++jj) v[jj] = (I[jj] + I[64 * 33 + jj]) + (I[128 * 33 + jj] + I[192 * 33 + jj]);
        unsigned sel = 1u | (1u << qt) | (qt >= 1 ? (1u << (qt - 1)) : 0u);
        const int need = 8 - __popc(sel);
#pragma unroll
        for (int it = 0; it < 5; ++it) {
            if (it < need) {
                int best = -1; float bv = -1e30f;
#pragma unroll
                for (int jj = 1; jj < 32; ++jj) { const bool ok = (jj <= qt - 2) && (((sel >> jj) & 1u) == 0u) && (v[jj] > bv); bv = ok ? v[jj] : bv; best = ok ? jj : best; }
                if (best >= 0) sel |= 1u << best;
            }
        }
        ((LAS unsigned*)(lds + NL_SEL))[lane] = sel;
        atomicOr((unsigned*)(lds + NL_UNI), sel);
    }
    __syncthreads();
    const unsigned uni = *(const LAS unsigned*)(lds + NL_UNI) & ((qt >= 31) ? 0xffffffffu : ((2u << qt) - 1u));
    const unsigned mysel = ((const LAS unsigned*)(lds + NL_SEL))[ql];
    const bf16_t* Pb = P + (size_t)bl * SEQ * LDP + C_KV + g * 64;
    nsa_branch<1>(F, Pb + 256, Pb + 384, uni, qt, ql, mysel, biasH, qptr, g_s, out0, out1);
    { const int lo = qt >= 8 ? qt - 8 : 0; const unsigned wm = (((qt >= 31) ? 0xffffffffu : ((2u << qt) - 1u)) >> lo) << lo;
      nsa_branch<2>(F, Pb + 512, Pb + 640, wm, qt, ql, 0u, biasH, qptr, g_w, out0, out1); }
    unsigned char* yo = (unsigned char*)YB + row * 1024 + 512 + g * 256 + h * 64 + 4 * hi;
#pragma unroll
    for (int a = 0; a < 4; ++a) {
        *(unsigned*)(yo + 8 * a) = cvt4_i8(out0[4 * a] * BSCALE, out0[4 * a + 1] * BSCALE, out0[4 * a + 2] * BSCALE, out0[4 * a + 3] * BSCALE);
        *(unsigned*)(yo + 32 + 8 * a) = cvt4_i8(out1[4 * a] * BSCALE, out1[4 * a + 1] * BSCALE, out1[4 * a + 2] * BSCALE, out1[4 * a + 3] * BSCALE);
    }
    __syncthreads();
}

#define LDS_BARRIER() asm volatile("s_waitcnt lgkmcnt(0)\n\ts_barrier" ::: "memory")
constexpr int SL_CT = 0, SL_BT = 34816, SL_XT = 69632, SL_XD = 77824, SL_XW = 86016, SL_HT = 94208, SL_YO = 102912, SL_AW = 119296, SL_DW = 123392;
__device__ __forceinline__ void ssd_diag(const LAS unsigned char* lds, const LAS float* A_, int si, int li, int r32, int hi, int q4, int p4, int g1, f32x16& y) {
    const int lidx = 32 * li + r32; const float acl = A_[lidx];
    f32x16 s = (f32x16){0.f, 0.f, 0.f, 0.f, 0.f, 0.f, 0.f, 0.f, 0.f, 0.f, 0.f, 0.f, 0.f, 0.f, 0.f, 0.f};
#pragma unroll
    for (int kk = 0; kk < 8; ++kk) {
        const bf16x8 aa = *(const LAS bf16x8*)(lds + SL_BT + (32 * si + r32) * 272 + (16 * kk + 8 * hi) * 2);
        const bf16x8 bb = *(const LAS bf16x8*)(lds + SL_CT + lidx * 272 + (16 * kk + 8 * hi) * 2);
        s = mfma32(aa, bb, s);
    }
#pragma unroll
    for (int r = 0; r < 16; ++r) { const int sidx = 32 * si + crow(r, hi); const float e = fexp2(acl - A_[sidx]); s[r] = (sidx <= lidx) ? s[r] * e : 0.f; }
    u32x4 t0, t1;
    t0.x = cvt_pk_bf16(s[0], s[1]); t0.y = cvt_pk_bf16(s[2], s[3]); t0.z = cvt_pk_bf16(s[4], s[5]); t0.w = cvt_pk_bf16(s[6], s[7]);
    t1.x = cvt_pk_bf16(s[8], s[9]); t1.y = cvt_pk_bf16(s[10], s[11]); t1.z = cvt_pk_bf16(s[12], s[13]); t1.w = cvt_pk_bf16(s[14], s[15]);
    const LAS unsigned char* xb = lds + SL_XD + (32 * si + 4 * hi + q4) * 64 + g1 * 32 + p4 * 8;
    y = mfma32(cat8(trrd(xb), trrd(xb + 512)), __builtin_bit_cast(bf16x8, t0), y);
    y = mfma32(cat8(trrd(xb + 1024), trrd(xb + 1536)), __builtin_bit_cast(bf16x8, t1), y);
}
__device__ __forceinline__ void ssd_yoff(const LAS unsigned char* lds, const LAS float* A_, int li, int r32, int hi, f32x16& y) {
    const int lidx = 32 * li + r32;
#pragma unroll
    for (int kk = 0; kk < 8; ++kk) {
        const bf16x8 aa = *(const LAS bf16x8*)(lds + SL_HT + r32 * 272 + (16 * kk + 8 * hi) * 2);
        const bf16x8 bb = *(const LAS bf16x8*)(lds + SL_CT + lidx * 272 + (16 * kk + 8 * hi) * 2);
        y = mfma32(aa, bb, y);
    }
    const float el = fexp2(A_[lidx]);
#pragma unroll
    for (int r = 0; r < 16; ++r) y[r] *= el;
}
__device__ __forceinline__ void ssd_unit(const Ctx& F, int bl, int hd, int ph, const bf16_t* P, const bf16_t* XC, float dtb, float Aneg, float Dh, bf16_t* YP) {
    LAS unsigned char* lds = F.lds; int tid_ = F.tid; asm volatile("" : "+v"(tid_)); const int tid = tid_, lane = tid & 63, w = F.wave, r32 = lane & 31, hi = lane >> 5;
    const int g = hd >> 2, p0 = 32 * ph; const size_t rowb = (size_t)bl * SEQ;
    const int q4 = (lane & 15) >> 2, p4 = lane & 3, g1 = (lane >> 4) & 1;
    LAS float* A_ = (LAS float*)(lds + SL_AW) + w * 128; LAS float* D_ = (LAS float*)(lds + SL_DW) + w * 128;
    u32x4 creg[4], breg[4], xreg; float dt0 = 0.f, dt1 = 0.f;
#define SSD_LOAD(ch) do { const bf16_t* xc = XC + (rowb + (size_t)(ch) * 128) * 2048; \
        _Pragma("unroll") for (int i = 0; i < 4; ++i) { const int r = (tid >> 4) + 32 * i; \
            creg[i] = *(const u32x4*)(xc + (size_t)r * 2048 + 1536 + g * 128 + 8 * (tid & 15)); breg[i] = *(const u32x4*)(xc + (size_t)r * 2048 + 1024 + g * 128 + 8 * (tid & 15)); } \
        xreg = *(const u32x4*)(xc + (size_t)(tid >> 2) * 2048 + hd * 64 + p0 + 8 * (tid & 3)); \
        dt0 = bf1(P[(rowb + (size_t)(ch) * 128 + 2 * lane) * LDP + C_DT + hd]); dt1 = bf1(P[(rowb + (size_t)(ch) * 128 + 2 * lane + 1) * LDP + C_DT + hd]); } while (0)
    f32x16 hs = (f32x16){0.f, 0.f, 0.f, 0.f, 0.f, 0.f, 0.f, 0.f, 0.f, 0.f, 0.f, 0.f, 0.f, 0.f, 0.f, 0.f};
    SSD_LOAD(0);
    for (int ch = 0; ch < 16; ++ch) {
        { float x0 = dt0 + dtb, x1 = dt1 + dtb; const float v0 = x0 > 15.f ? x0 : __logf(1.f + __expf(x0)), v1 = x1 > 15.f ? x1 : __logf(1.f + __expf(x1));
          const float a0 = v0 * Aneg * LOG2E, a1 = v1 * Aneg * LOG2E; float sc = a0 + a1;
#pragma unroll
          for (int o = 1; o < 64; o <<= 1) { const float tt = __shfl_up(sc, o); if (lane >= o) sc += tt; }
          A_[2 * lane] = sc - a1; A_[2 * lane + 1] = sc; D_[2 * lane] = v0; D_[2 * lane + 1] = v1; }
#pragma unroll
        for (int i = 0; i < 4; ++i) { const int r = (tid >> 4) + 32 * i;
            *(LAS u32x4*)(lds + SL_CT + r * 272 + (tid & 15) * 16) = creg[i]; *(LAS u32x4*)(lds + SL_BT + r * 272 + (tid & 15) * 16) = breg[i]; }
        *(LAS u32x4*)(lds + SL_XT + (tid >> 2) * 64 + (tid & 3) * 16) = xreg;
        { const int lrow = tid >> 2; const float dl = D_[lrow], wl = dl * fexp2(A_[127] - A_[lrow]);
          float x[8], xd[8], xw[8]; unpack8(xreg, x);
#pragma unroll
          for (int i = 0; i < 8; ++i) { xd[i] = x[i] * dl; xw[i] = x[i] * wl; }
          *(LAS u32x4*)(lds + SL_XD + lrow * 64 + (tid & 3) * 16) = pack8(xd); *(LAS u32x4*)(lds + SL_XW + lrow * 64 + (tid & 3) * 16) = pack8(xw); }
        if (w >= 4) {
#pragma unroll
            for (int a = 0; a < 4; ++a) { u32x2 t; t.x = cvt_pk_bf16(hs[4 * a], hs[4 * a + 1]); t.y = cvt_pk_bf16(hs[4 * a + 2], hs[4 * a + 3]);
                *(LAS u32x2*)(lds + SL_HT + r32 * 272 + (32 * (w - 4) + 8 * a + 4 * hi) * 2) = t; }
        }
        if (ch + 1 < 16) SSD_LOAD(ch + 1);
        LDS_BARRIER();
        f32x16 y = (f32x16){0.f, 0.f, 0.f, 0.f, 0.f, 0.f, 0.f, 0.f, 0.f, 0.f, 0.f, 0.f, 0.f, 0.f, 0.f, 0.f};
        {
            const int li_ = (w == 0) ? 0 : (w == 1 || w == 7) ? 1 : (w == 2 || w == 5) ? 2 : 3;
            const int si0 = (w == 4 || w == 5) ? 2 : (w == 6) ? 3 : 0;
            const int nd = (w == 7) ? 0 : (w >= 1 && w <= 3) ? 2 : 1;
            const int yo = (w == 0) ? 0 : (w == 4) ? 3 : (w == 5) ? 2 : (w == 7) ? 1 : -1;
            if (yo >= 0) ssd_yoff(lds, A_, yo, r32, hi, y);
#pragma unroll 1
            for (int d = 0; d < nd; ++d) ssd_diag(lds, A_, si0 + d, li_, r32, hi, q4, p4, g1, y);
        }
        if (w >= 4) {
            const int wi = w - 4;
            { const int slot = (w == 7) ? 0 : (w == 5) ? 1 : (w == 4) ? 2 : 3;
#pragma unroll
              for (int r = 0; r < 16; ++r) *(LAS float*)(lds + SL_YO + slot * 4096 + r * 256 + lane * 4) = y[r]; }
            const float dec = fexp2(A_[127]);
#pragma unroll
            for (int r = 0; r < 16; ++r) hs[r] *= dec;
#pragma unroll
            for (int kk = 0; kk < 8; ++kk) {
                const LAS unsigned char* ab = lds + SL_BT + (16 * kk + 8 * hi + q4) * 272 + (32 * wi + 16 * g1 + 4 * p4) * 2;
                const LAS unsigned char* bb = lds + SL_XW + (16 * kk + 8 * hi + q4) * 64 + g1 * 32 + p4 * 8;
                hs = mfma32(cat8(trrd(ab), trrd(ab + 4 * 272)), cat8(trrd(bb), trrd(bb + 256)), hs);
            }
        }
        LDS_BARRIER();
        if (w < 4) {
            const int li = w; bf16_t* yp = YP + (rowb + (size_t)ch * 128 + 32 * li + r32) * 1024 + hd * 64 + p0 + 4 * hi;
#pragma unroll
            for (int a = 0; a < 4; ++a) {
                const u32x2 xr = *(const LAS u32x2*)(lds + SL_XT + (32 * li + r32) * 64 + (8 * a + 4 * hi) * 2);
                float v[4] = {y[4 * a] + Dh * bflo(xr.x), y[4 * a + 1] + Dh * bfhi(xr.x), y[4 * a + 2] + Dh * bflo(xr.y), y[4 * a + 3] + Dh * bfhi(xr.y)};
                if (li >= 1) {
#pragma unroll
                    for (int i = 0; i < 4; ++i) v[i] += *(const LAS float*)(lds + SL_YO + (li - 1) * 4096 + (4 * a + i) * 256 + lane * 4);
                }
                if (li == 3) {
#pragma unroll
                    for (int i = 0; i < 4; ++i) v[i] += *(const LAS float*)(lds + SL_YO + 3 * 4096 + (4 * a + i) * 256 + lane * 4);
                }
                u32x2 o; o.x = cvt_pk_bf16(v[0], v[1]); o.y = cvt_pk_bf16(v[2], v[3]); *(u32x2*)(yp + 8 * a) = o;
            }
        }
        LDS_BARRIER();
    }
#undef SSD_LOAD
}

__device__ __forceinline__ void attn_phase(const Ctx& F, ArgsP a, int l, int gi) {
    LAS unsigned char* lds = F.lds;
    const bf16_t* P = (const bf16_t*)(a->ws + WS_ARENA + AR_P);
    const bf16_t* XC = (const bf16_t*)(F.dout + DO_XC);
    bf16_t* YP = (bf16_t*)(F.dout + DO_YC); bf16_t* YB = (bf16_t*)(F.dout + DO_R);
    const bf16_t* KC = (const bf16_t*)(a->ws + WS_MISC + MI_KC); const bf16_t* VC = (const bf16_t*)(a->ws + WS_MISC + MI_VC);
    const float* biasT = (const float*)(a->ws + WS_MISC + MI_BIAS);
    unsigned* ctr = F.ctl + CW_WQ + 64 * (l * NG + gi);
    constexpr int NSSD = BG * 16 * 2, NNSA = BG * 2 * 32;
    for (int item = F.vcu; item < NSSD; item += F.G) {
        const int bl = item >> 5, hd = (item >> 1) & 15, ph = item & 1;
        for (int rr_ = 0; rr_ <= SSD_REP; ++rr_) ssd_unit(F, bl, hd, ph, P, XC, a->in[I_DTB][l * 16 + hd], -__expf(a->in[I_ALOG][l * 16 + hd]), a->in[I_DSKIP][l * 16 + hd], YP);
    }
    __syncthreads();
    for (int i = F.tid; i < 8 * 256; i += 512) { const int hd = i >> 8, d = (i & 255) - 64; ((LAS float*)(lds + NL_BIAS))[i] = d < 0 ? NEGBIG : (d < 128 ? biasT[hd * 128 + d] : 0.f); }
    __syncthreads();
    for (;;) {
        if (F.tid == 0) *(LAS int*)(lds + LDSX + LX_WQ) = (int)__hip_atomic_fetch_add(ctr, 1u, __ATOMIC_RELAXED, __HIP_MEMORY_SCOPE_AGENT);
        __syncthreads();
        const int idx = *(const LAS int*)(lds + LDSX + LX_WQ);
        __syncthreads();
        if (idx >= NNSA) break;
        const int qt = 31 - (idx >> 4), bg = idx & 15;
        for (int rr_ = 0; rr_ <= NSA_REP; ++rr_) nsa_unit(F, bg >> 1, bg & 1, qt, P, KC, VC, biasT, YB);
    }
}


constexpr int RL_HI = 0, RL_LO = 33024, RL_GB = 66048, RL_LG = 74240, RL_ROWSTRIDE = 2064;
__device__ __forceinline__ void ln1_route_phase(const Ctx& F, ArgsP a, int l) {
    LAS unsigned char* lds = F.lds; const int tid = F.tid, lane = F.lane, w = F.wave, fr = lane & 15, q = lane >> 4;
    LAS int* lcnt = (LAS int*)(lds + LDSX + LX_CNTL); LAS int* lbase = (LAS int*)(lds + LDSX + LX_BASE); LAS int* rows = (LAS int*)(lds + LDSX + LX_ROWS);
    for (int i = tid; i < 16384; i += 512) { const float x = a->in[I_RW][i]; const bf16_t hi = f2bf(x); const bf16_t lo = f2bf(x - bf1(hi)); const int d = i >> 4, e = i & 15;
        *(LAS bf16_t*)(lds + RL_HI + e * RL_ROWSTRIDE + d * 2) = hi; *(LAS bf16_t*)(lds + RL_LO + e * RL_ROWSTRIDE + d * 2) = lo; }
    { LAS float* GB = (LAS float*)(lds + RL_GB); for (int i = tid; i < 1024; i += 512) { GB[i] = a->in[I_LN1G][l * DM + i]; GB[1024 + i] = a->in[I_LN1B][l * DM + i]; } }
    bf16_t* H1 = (bf16_t*)(a->ws + WS_PRE1);
    float rb[16];
#pragma unroll
    for (int e = 0; e < 16; ++e) rb[e] = a->in[I_RB][e];
    unsigned* gcnt = F.ctl + CW_CNT + 64 * l;
    int* rtok = (int*)(a->ws + WS_ARENA + AR_RTOK); int2* rinfo = (int2*)(a->ws + WS_ARENA + AR_RINFO);
    for (int rb0 = blockIdx.x * 128; rb0 < T_; rb0 += F.G * 128) {
        if (tid < 16) lcnt[tid] = 0;
        __syncthreads();
        {
            bf16_t* rowp = H1 + ((size_t)rb0 + w * 16 + fr) * DM + 8 * q;
            float s = 0.f, ss = 0.f;
#pragma unroll 8
            for (int kk = 0; kk < 32; ++kk) { float x[8]; unpack8(*(const u32x4*)(rowp + 32 * kk), x);
#pragma unroll
                for (int j = 0; j < 8; ++j) { s += x[j]; ss += x[j] * x[j]; } }
            s += __shfl_xor(s, 16); s += __shfl_xor(s, 32); ss += __shfl_xor(ss, 16); ss += __shfl_xor(ss, 32);
            const float mean = s * (1.f / DM), rstd = 1.f / sqrtf(fmaxf(ss * (1.f / DM) - mean * mean, 0.f) + LN_EPS);
            f32x4 acc = {0.f, 0.f, 0.f, 0.f};
            const LAS float* GB = (const LAS float*)(lds + RL_GB);
#pragma unroll 2
            for (int kk = 0; kk < 32; ++kk) {
                float x[8], lo[8]; unpack8(*(const u32x4*)(rowp + 32 * kk), x);
                const f32x4 g0 = *(const LAS f32x4*)(GB + 32 * kk + 8 * q), g1 = *(const LAS f32x4*)(GB + 32 * kk + 8 * q + 4);
                const f32x4 b0 = *(const LAS f32x4*)(GB + 1024 + 32 * kk + 8 * q), b1 = *(const LAS f32x4*)(GB + 1024 + 32 * kk + 8 * q + 4);
#pragma unroll
                for (int j = 0; j < 4; ++j) { x[j] = (x[j] - mean) * rstd * g0[j] + b0[j]; x[4 + j] = (x[4 + j] - mean) * rstd * g1[j] + b1[j]; }
                const u32x4 hp = pack8(x);
                *(u32x4*)(rowp + 32 * kk) = hp;
                *(u32x2*)(a->ws + WS_H18 + ((size_t)rb0 + w * 16 + fr) * DM + 8 * q + 32 * kk) = pack8_i8(x, ASCALE);
                { float hf[8]; unpack8(hp, hf);
#pragma unroll
                  for (int j = 0; j < 8; ++j) lo[j] = x[j] - hf[j]; }
                const bf16x8 ahi = __builtin_bit_cast(bf16x8, hp), alo = __builtin_bit_cast(bf16x8, pack8(lo));
                const bf16x8 bhi = *(const LAS bf16x8*)(lds + RL_HI + fr * RL_ROWSTRIDE + (32 * kk + 8 * q) * 2), blo = *(const LAS bf16x8*)(lds + RL_LO + fr * RL_ROWSTRIDE + (32 * kk + 8 * q) * 2);
                acc = mfma16(ahi, bhi, acc); acc = mfma16(ahi, blo, acc); acc = mfma16(alo, bhi, acc);
                asm volatile("" ::: "memory");
            }
            LAS float* LG = (LAS float*)(lds + RL_LG) + w * 256;
#pragma unroll
            for (int r = 0; r < 4; ++r) LG[(4 * q + r) * 16 + fr] = acc[r];
        }
        LDS_WAIT();
        if (lane < 16) {
            const LAS float* LG = (const LAS float*)(lds + RL_LG) + w * 256 + lane * 16;
            float lg[16];
#pragma unroll
            for (int e4 = 0; e4 < 4; ++e4) { const f32x4 t = *(const LAS f32x4*)(LG + 4 * e4); lg[4 * e4] = t[0]; lg[4 * e4 + 1] = t[1]; lg[4 * e4 + 2] = t[2]; lg[4 * e4 + 3] = t[3]; }
            float mx = lg[0];
#pragma unroll
            for (int e = 1; e < 16; ++e) mx = fmaxf(mx, lg[e]);
            float pr[16], ps = 0.f;
#pragma unroll
            for (int e = 0; e < 16; ++e) { pr[e] = __expf(lg[e] - mx); ps += pr[e]; }
            const float pinv = 1.f / ps;
            float sc[16];
#pragma unroll
            for (int e = 0; e < 16; ++e) { pr[e] *= pinv; sc[e] = pr[e] + rb[e]; }
            int grp = 0; float gbest = -1e30f;
#pragma unroll
            for (int qq = 0; qq < 4; ++qq) {
                const float s0 = sc[4 * qq], s1 = sc[4 * qq + 1], s2_ = sc[4 * qq + 2], s3 = sc[4 * qq + 3];
                const float tot = (s0 + s1) + (s2_ + s3), mn1 = fminf(fminf(s0, s1), fminf(s2_, s3));
                const float m2 = fminf(fminf(fminf(fmaxf(s0, s1), fmaxf(s0, s2_)), fminf(fmaxf(s0, s3), fmaxf(s1, s2_))), fminf(fmaxf(s1, s3), fmaxf(s2_, s3)));
                const float top2 = tot - mn1 - m2;
                if (top2 > gbest) { gbest = top2; grp = qq; }
            }
            float c0 = 0.f, c1 = 0.f, c2 = 0.f, c3 = 0.f, q0 = 0.f, q1 = 0.f, q2 = 0.f, q3 = 0.f;
#pragma unroll
            for (int qq = 0; qq < 4; ++qq) if (grp == qq) { c0 = sc[4 * qq]; c1 = sc[4 * qq + 1]; c2 = sc[4 * qq + 2]; c3 = sc[4 * qq + 3]; q0 = pr[4 * qq]; q1 = pr[4 * qq + 1]; q2 = pr[4 * qq + 2]; q3 = pr[4 * qq + 3]; }
            int i0 = 0; float b0 = c0; if (c1 > b0) { b0 = c1; i0 = 1; } if (c2 > b0) { b0 = c2; i0 = 2; } if (c3 > b0) { b0 = c3; i0 = 3; }
            int i1 = -1; float b1 = -1e30f;
            if (i0 != 0 && c0 > b1) { b1 = c0; i1 = 0; } if (i0 != 1 && c1 > b1) { b1 = c1; i1 = 1; } if (i0 != 2 && c2 > b1) { b1 = c2; i1 = 2; } if (i0 != 3 && c3 > b1) { b1 = c3; i1 = 3; }
            const float w0 = (i0 == 0) ? q0 : (i0 == 1) ? q1 : (i0 == 2) ? q2 : q3, w1 = (i1 == 0) ? q0 : (i1 == 1) ? q1 : (i1 == 2) ? q2 : q3;
            const float wn = 1.f / (w0 + w1);
            const int e0 = 4 * grp + i0, e1 = 4 * grp + i1, rl = w * 16 + lane;
            const int pos0 = atomicAdd((int*)(lds + LDSX + LX_CNTL) + e0, 1), pos1 = atomicAdd((int*)(lds + LDSX + LX_CNTL) + e1, 1);
            rows[rl * 8 + 0] = e0; rows[rl * 8 + 1] = e1; rows[rl * 8 + 2] = pos0; rows[rl * 8 + 3] = pos1; rows[rl * 8 + 4] = __float_as_int(w0 * wn); rows[rl * 8 + 5] = __float_as_int(w1 * wn);
        }
        __syncthreads();
        if (tid < 16) lbase[tid] = (int)__hip_atomic_fetch_add(gcnt + tid, (unsigned)lcnt[tid], __ATOMIC_RELAXED, __HIP_MEMORY_SCOPE_AGENT);
        __syncthreads();
        if (tid < 128) {
            const int e0 = rows[tid * 8], e1 = rows[tid * 8 + 1]; const int t = rb0 + tid;
            const int p0 = e0 * ECAP + lbase[e0] + rows[tid * 8 + 2], p1 = e1 * ECAP + lbase[e1] + rows[tid * 8 + 3];
            rtok[p0] = t; rinfo[p0] = make_int2(t, rows[tid * 8 + 4]); rtok[p1] = t; rinfo[p1] = make_int2(T_ + t, rows[tid * 8 + 5]);
        }
        __syncthreads();
    }
}

__device__ __forceinline__ int moe_tables(const Ctx& F, int l, const int* rtok) {
    LAS int* off = (LAS int*)(F.lds + LDSX + LX_OFF); LAS int* ecnt = (LAS int*)(F.lds + LDSX + LX_ECNT); LAS int* tile_e = (LAS int*)(F.lds + LDSX + LX_TILE); LAS int* gidx = (LAS int*)(F.lds + LDSX + LX_GIDX);
    __syncthreads();
    if (F.tid == 0) { int o = 0;
        for (int e = 0; e < 16; ++e) { off[e] = o; const int c = (int)__hip_atomic_load(F.ctl + CW_CNT + 64 * l + e, __ATOMIC_RELAXED, __HIP_MEMORY_SCOPE_AGENT); ecnt[e] = c; const int nt = (c + 255) >> 8;
            for (int k = 0; k < nt; ++k) tile_e[(o >> 8) + k] = e; o += nt << 8; }
        off[16] = o; }
    __syncthreads();
    const int nrt = off[16] >> 8;
    if (rtok) {
        for (int i = 0; i < 8; ++i) { const long L = (long)i * F.G + F.vcu; if (L >= (long)nrt * 4) break;
            const int rt = (int)(L >> 2), e = tile_e[rt], k0 = rt * 256 - off[e], c = ecnt[e];
            if (F.tid < 256) gidx[i * 256 + F.tid] = (k0 + F.tid < c) ? rtok[e * ECAP + k0 + F.tid] : 0; }
        __syncthreads();
    }
    return nrt;
}
__device__ __forceinline__ void ln2_phase(const Ctx& F, ArgsP a, int l, bool last) {
    const bf16_t* H1 = (const bf16_t*)(a->ws + WS_PRE1); const bf16_t* YS = (const bf16_t*)(a->ws + WS_ARENA + AR_XS);
    bf16_t* H = (bf16_t*)(a->ws + WS_H); float* OUT = a->out;
    const float* g = a->in[I_LN2G] + l * DM; const float* b = a->in[I_LN2B] + l * DM; const int lane = F.lane;
    float gg[16], bb[16];
#pragma unroll
    for (int i = 0; i < 8; ++i) { gg[i] = g[8 * lane + i]; gg[8 + i] = g[512 + 8 * lane + i]; bb[i] = b[8 * lane + i]; bb[8 + i] = b[512 + 8 * lane + i]; }
    u32x4 nx[6];
#define LN2_LOAD(t_) do { _Pragma("unroll") for (int hf = 0; hf < 2; ++hf) { nx[3 * hf] = *(const u32x4*)(H1 + (size_t)(t_) * DM + 512 * hf + 8 * lane); \
        nx[3 * hf + 1] = *(const u32x4*)(YS + (size_t)(t_) * DM + 512 * hf + 8 * lane); nx[3 * hf + 2] = *(const u32x4*)(YS + (size_t)(T_ + (t_)) * DM + 512 * hf + 8 * lane); } } while (0)
    LN2_LOAD(F.gw);
    for (int t = F.gw; t < T_; t += F.NGW) {
        float v[16];
        u32x4 cur[6];
#pragma unroll
        for (int i = 0; i < 6; ++i) cur[i] = nx[i];
        if (t + F.NGW < T_) LN2_LOAD(t + F.NGW);
#pragma unroll
        for (int hf = 0; hf < 2; ++hf) { float x[8], y0[8], y1[8];
            unpack8(cur[3 * hf], x);
            unpack8(cur[3 * hf + 1], y0);
            unpack8(cur[3 * hf + 2], y1);
#pragma unroll
            for (int i = 0; i < 8; ++i) v[8 * hf + i] = DN_ALPHA * x[i] + (y0[i] + y1[i]); }
        float s = 0.f;
#pragma unroll
        for (int i = 0; i < 16; ++i) s += v[i];
        const float mean = wave_sum(s) * (1.f / DM); float s2 = 0.f;
#pragma unroll
        for (int i = 0; i < 16; ++i) { v[i] -= mean; s2 += v[i] * v[i]; }
        const float rstd = 1.f / sqrtf(wave_sum(s2) * (1.f / DM) + LN_EPS);
#pragma unroll
        for (int i = 0; i < 16; ++i) v[i] = v[i] * rstd * gg[i] + bb[i];
        if (last) {
#pragma unroll
            for (int hf = 0; hf < 2; ++hf) { float* o = OUT + (size_t)t * DM + 512 * hf + 8 * lane;
                *(f32x4*)o = (f32x4){v[8 * hf], v[8 * hf + 1], v[8 * hf + 2], v[8 * hf + 3]}; *(f32x4*)(o + 4) = (f32x4){v[8 * hf + 4], v[8 * hf + 5], v[8 * hf + 6], v[8 * hf + 7]}; }
        } else {
#pragma unroll
            for (int hf = 0; hf < 2; ++hf) { float tt[8];
#pragma unroll
                for (int i = 0; i < 8; ++i) tt[i] = v[8 * hf + i];
                *(u32x4*)(H + (size_t)t * DM + 512 * hf + 8 * lane) = pack8(tt);
                *(u32x2*)(a->ws + WS_H8 + (size_t)t * DM + 512 * hf + 8 * lane) = pack8_i8(tt, ASCALE); }
        }
    }
}

#ifndef REP_MASK
#define REP_MASK 0
#endif
#ifndef PH_MASK
#define PH_MASK 0xfff
#endif
constexpr int NSTEPS = 1 + DEPTH * (NG * 6 + 4);
__global__ void __launch_bounds__(512, 2) fwd_kernel(Args a_unused) {
    const ArgsP a = (ArgsP)__builtin_amdgcn_kernarg_segment_ptr();
    extern __shared__ __attribute__((aligned(16))) unsigned char smem[];
    const int wave0_ = __builtin_amdgcn_readfirstlane((int)threadIdx.x >> 6);
    Ctx F;
#define MKCTX do { int t_; asm volatile("v_mbcnt_lo_u32_b32 %0, -1, 0\n\tv_mbcnt_hi_u32_b32 %0, -1, %0" : "=v"(t_)); t_ += wave0_ * 64; F.lds = (LAS unsigned char*)smem; F.tid = t_; F.lane = t_ & 63; F.wave = wave0_; \
        F.G = gridDim.x; { const int bx = blockIdx.x; F.vcu = (F.G % 8 == 0) ? (bx % 8) * (F.G / 8) + bx / 8 : bx; } \
        F.gw = blockIdx.x * 8 + F.wave; F.NGW = F.G * 8; F.ws = a->ws; F.dout = (unsigned char*)a->out; F.ctl = (unsigned*)(a->ws + WS_CTL); } while (0)
    MKCTX;
    for (int u = F.tid; u < (LDS_TOTAL - LDSX) / 4; u += 512) ((LAS unsigned*)(F.lds + LDSX))[u] = 0u;
    __syncthreads();
    const bool multi = (a->hi - a->lo) > 1;
    XcdBarrier bar; bar.bar = F.ctl + CW_BAR; bar.x = 0; bar.st = (volatile LAS unsigned*)(F.lds + LDSX + LX_BAR);
    if (multi) bar = xcd_barrier_post(F.ctl + CW_BAR, (volatile LAS unsigned*)(F.lds + LDSX + LX_BAR), F.tid);
    int step = 0;
#define RUN_STEP (step >= a->lo && step < a->hi)
#ifndef BAR_REP
#define BAR_REP 0
#endif
#define END_STEP do { if (RUN_STEP && step + 1 < a->hi) { xcd_barrier(bar, F.tid); if (BAR_REP) xcd_barrier(bar, F.tid); } ++step; } while (0)

    if (RUN_STEP && ((PH_MASK >> 0) & 1)) for (int rep_ = 0; rep_ <= ((REP_MASK >> 0) & 1); ++rep_) { MKCTX; p0_prologue(F, a); }
    END_STEP;

    {
        unsigned char* wl = a->ws + WS_W + (size_t)0 * W_LAYER;
        bf16_t* Hb = (bf16_t*)(a->ws + WS_H);
        bf16_t* P = (bf16_t*)(a->ws + WS_ARENA + AR_P);
        {
            const bf16_t* Hg = Hb + (size_t)0 * TG * DM;
            if (RUN_STEP && ((PH_MASK >> 1) & 1)) for (int rep_ = 0; rep_ <= ((REP_MASK >> 1) & 1); ++rep_) { MKCTX;
                pg8::Gemm g{(const bf16_t*)(a->ws + WS_H8 + (size_t)0 * TG * DM), (const bf16_t*)(wl + WO_IN), 512, 512, 512}; pg8::StaticOrder S; S.init(TG, LDP, 512, 512, F.G, (int)blockIdx.x, 512);
                pg8::Epi<pg8::EK_PROJ> E{P, LDP, nullptr, 0, nullptr, nullptr, nullptr, 1.f / (WSCALE * ASCALE)};
                pg8::gemm_phase<pg8::Epi<pg8::EK_PROJ>, pg8::StaticOrder, false, true>(F.lds, F.tid, g, S, E);
            }
            END_STEP;
            if (RUN_STEP && ((PH_MASK >> 2) & 1)) for (int rep_ = 0; rep_ <= ((REP_MASK >> 2) & 1); ++rep_) { MKCTX;
                for (int cu = blockIdx.x; cu < BG * 32; cu += F.G)
                    compress_unit(F, cu, P, (const bf16_t*)(wl + WO_W1), (const bf16_t*)(wl + WO_W2), (const float*)(a->ws + WS_MISC + MI_B1) + 0 * 256,
                                  (bf16_t*)(a->ws + WS_MISC + MI_KC), (bf16_t*)(a->ws + WS_MISC + MI_VC));
                conv_phase(F, P, (bf16_t*)(F.dout + DO_XC), a->in[I_CONVW] + (size_t)0 * 4 * 2048, a->in[I_CONVB] + (size_t)0 * 2048);
            }
            END_STEP;
            if (RUN_STEP && ((PH_MASK >> 3) & 1)) for (int rep_ = 0; rep_ <= ((REP_MASK >> 3) & 1); ++rep_) { MKCTX; attn_phase(F, a, 0, 0 + 4 * rep_); }
            END_STEP;
            if (RUN_STEP && ((PH_MASK >> 4) & 1)) for (int rep_ = 0; rep_ <= ((REP_MASK >> 4) & 1); ++rep_) { MKCTX; fin_phase(F, P, (bf16_t*)(F.dout + DO_R), (const bf16_t*)(F.dout + DO_YC), F.dout + DO_YC8, a->in[I_SNG] + (size_t)0 * DM); }
            END_STEP;
            if (RUN_STEP && ((PH_MASK >> 5) & 1)) for (int rep_ = 0; rep_ <= ((REP_MASK >> 5) & 1); ++rep_) { MKCTX;
                bf16_t* GT = (bf16_t*)(a->ws + WS_ARENA + AR_GATES); bf16_t* MX = (bf16_t*)(a->ws + WS_ARENA + AR_MIXIN); float* TMP = (float*)(F.dout + DO_TMP);
                pg8::Gemm g{nullptr, nullptr, 512, 512, 512};
                pg8::S5Order S; S.so.init(TG, DM, 512, 512, F.G, (int)blockIdx.x, 512);
                S.aH = (long)(size_t)(a->ws + WS_H8 + (size_t)0 * TG * DM); S.aRY = (long)(size_t)(F.dout + DO_R); S.aYC = (long)(size_t)(F.dout + DO_YC8);
                S.bG = (long)(size_t)(wl + WO_GATE); S.bCN = (long)(size_t)(wl + WO_C); S.bS = (long)(size_t)(wl + WO_SSD);
                pg8::Epi<pg8::EK_S5> E{GT, 3072, nullptr, 0, TMP, nullptr, MX, 1.f};
                pg8::gemm_phase<pg8::Epi<pg8::EK_S5>, pg8::S5Order, false, true>(F.lds, F.tid, g, S, E);
            }
            END_STEP;
            if (RUN_STEP && ((PH_MASK >> 6) & 1)) for (int rep_ = 0; rep_ <= ((REP_MASK >> 6) & 1); ++rep_) { MKCTX;
                pg8::Gemm g{(const bf16_t*)(a->ws + WS_ARENA + AR_MIXIN), (const bf16_t*)(wl + WO_OUT), 512, 512, 512}; pg8::StaticOrder S; S.init(TG, DM, 512, 512, F.G, (int)blockIdx.x, 512);
                pg8::Epi<pg8::EK_WOUT> E{(bf16_t*)(a->ws + WS_PRE1) + (size_t)0 * TG * DM, DM, Hg, DM, nullptr, nullptr, nullptr, 1.f / (WSCALE_OUT * MSCALE)};
                pg8::gemm_phase<pg8::Epi<pg8::EK_WOUT>, pg8::StaticOrder, false, true>(F.lds, F.tid, g, S, E);
            }
            END_STEP;
        }
        {
            const bf16_t* Hg = Hb + (size_t)1 * TG * DM;
            if (RUN_STEP && ((PH_MASK >> 1) & 1)) for (int rep_ = 0; rep_ <= ((REP_MASK >> 1) & 1); ++rep_) { MKCTX;
                pg8::Gemm g{(const bf16_t*)(a->ws + WS_H8 + (size_t)1 * TG * DM), (const bf16_t*)(wl + WO_IN), 512, 512, 512}; pg8::StaticOrder S; S.init(TG, LDP, 512, 512, F.G, (int)blockIdx.x, 512);
                pg8::Epi<pg8::EK_PROJ> E{P, LDP, nullptr, 0, nullptr, nullptr, nullptr, 1.f / (WSCALE * ASCALE)};
                pg8::gemm_phase<pg8::Epi<pg8::EK_PROJ>, pg8::StaticOrder, false, true>(F.lds, F.tid, g, S, E);
            }
            END_STEP;
            if (RUN_STEP && ((PH_MASK >> 2) & 1)) for (int rep_ = 0; rep_ <= ((REP_MASK >> 2) & 1); ++rep_) { MKCTX;
                for (int cu = blockIdx.x; cu < BG * 32; cu += F.G)
                    compress_unit(F, cu, P, (const bf16_t*)(wl + WO_W1), (const bf16_t*)(wl + WO_W2), (const float*)(a->ws + WS_MISC + MI_B1) + 0 * 256,
                                  (bf16_t*)(a->ws + WS_MISC + MI_KC), (bf16_t*)(a->ws + WS_MISC + MI_VC));
                conv_phase(F, P, (bf16_t*)(F.dout + DO_XC), a->in[I_CONVW] + (size_t)0 * 4 * 2048, a->in[I_CONVB] + (size_t)0 * 2048);
            }
            END_STEP;
            if (RUN_STEP && ((PH_MASK >> 3) & 1)) for (int rep_ = 0; rep_ <= ((REP_MASK >> 3) & 1); ++rep_) { MKCTX; attn_phase(F, a, 0, 1 + 4 * rep_); }
            END_STEP;
            if (RUN_STEP && ((PH_MASK >> 4) & 1)) for (int rep_ = 0; rep_ <= ((REP_MASK >> 4) & 1); ++rep_) { MKCTX; fin_phase(F, P, (bf16_t*)(F.dout + DO_R), (const bf16_t*)(F.dout + DO_YC), F.dout + DO_YC8, a->in[I_SNG] + (size_t)0 * DM); }
            END_STEP;
            if (RUN_STEP && ((PH_MASK >> 5) & 1)) for (int rep_ = 0; rep_ <= ((REP_MASK >> 5) & 1); ++rep_) { MKCTX;
                bf16_t* GT = (bf16_t*)(a->ws + WS_ARENA + AR_GATES); bf16_t* MX = (bf16_t*)(a->ws + WS_ARENA + AR_MIXIN); float* TMP = (float*)(F.dout + DO_TMP);
                pg8::Gemm g{nullptr, nullptr, 512, 512, 512};
                pg8::S5Order S; S.so.init(TG, DM, 512, 512, F.G, (int)blockIdx.x, 512);
                S.aH = (long)(size_t)(a->ws + WS_H8 + (size_t)1 * TG * DM); S.aRY = (long)(size_t)(F.dout + DO_R); S.aYC = (long)(size_t)(F.dout + DO_YC8);
                S.bG = (long)(size_t)(wl + WO_GATE); S.bCN = (long)(size_t)(wl + WO_C); S.bS = (long)(size_t)(wl + WO_SSD);
                pg8::Epi<pg8::EK_S5> E{GT, 3072, nullptr, 0, TMP, nullptr, MX, 1.f};
                pg8::gemm_phase<pg8::Epi<pg8::EK_S5>, pg8::S5Order, false, true>(F.lds, F.tid, g, S, E);
            }
            END_STEP;
            if (RUN_STEP && ((PH_MASK >> 6) & 1)) for (int rep_ = 0; rep_ <= ((REP_MASK >> 6) & 1); ++rep_) { MKCTX;
                pg8::Gemm g{(const bf16_t*)(a->ws + WS_ARENA + AR_MIXIN), (const bf16_t*)(wl + WO_OUT), 512, 512, 512}; pg8::StaticOrder S; S.init(TG, DM, 512, 512, F.G, (int)blockIdx.x, 512);
                pg8::Epi<pg8::EK_WOUT> E{(bf16_t*)(a->ws + WS_PRE1) + (size_t)1 * TG * DM, DM, Hg, DM, nullptr, nullptr, nullptr, 1.f / (WSCALE_OUT * MSCALE)};
                pg8::gemm_phase<pg8::Epi<pg8::EK_WOUT>, pg8::StaticOrder, false, true>(F.lds, F.tid, g, S, E);
            }
            END_STEP;
        }
        if (RUN_STEP && ((PH_MASK >> 7) & 1)) for (int rep_ = 0; rep_ <= ((REP_MASK >> 7) & 1); ++rep_) { MKCTX; ln1_route_phase(F, a, 0); }
        END_STEP;
        if (RUN_STEP && ((PH_MASK >> 9) & 1)) for (int rep_ = 0; rep_ <= ((REP_MASK >> 9) & 1); ++rep_) { MKCTX;
            const int nrt = moe_tables(F, 0, (const int*)(a->ws + WS_ARENA + AR_RTOK));
            pg8::Gemm g{(const bf16_t*)(a->ws + WS_H18), (const bf16_t*)(wl + WO_UP), 512, 512, 512};
            pg8::MoeOrder S{(const LAS int*)(F.lds + LDSX + LX_TILE), (const LAS int*)(F.lds + LDSX + LX_OFF), (const LAS int*)(F.lds + LDSX + LX_ECNT), nrt, F.G, F.vcu, 8, (long)256 * DM, (long)256 * DM, (long)1024 * DM};
            pg8::Epi<pg8::EK_GLU> E{(bf16_t*)(a->ws + WS_ARENA + AR_HID), 512, nullptr, 0, nullptr, nullptr, nullptr, 1.f / (WSCALE * ASCALE)};
            pg8::gemm_phase<pg8::Epi<pg8::EK_GLU>, pg8::MoeOrder, true, true>(F.lds, F.tid, g, S, E, (const LAS int*)(F.lds + LDSX + LX_GIDX));
        }
        END_STEP;
        if (RUN_STEP && ((PH_MASK >> 10) & 1)) for (int rep_ = 0; rep_ <= ((REP_MASK >> 10) & 1); ++rep_) { MKCTX;
            const int nrt = moe_tables(F, 0, nullptr);
            pg8::Gemm g{(const bf16_t*)(a->ws + WS_ARENA + AR_HID), (const bf16_t*)(wl + WO_DN), 256, 256, 256};
            pg8::MoeOrder S{(const LAS int*)(F.lds + LDSX + LX_TILE), (const LAS int*)(F.lds + LDSX + LX_OFF), (const LAS int*)(F.lds + LDSX + LX_ECNT), nrt, F.G, F.vcu, 4, (long)256 * 512, (long)256 * 512, (long)1024 * 512};
            pg8::Epi<pg8::EK_DOWN> E{(bf16_t*)(a->ws + WS_ARENA + AR_XS), DM, nullptr, 0, nullptr, (const int2*)(a->ws + WS_ARENA + AR_RINFO), nullptr, 1.f / (WSCALE_DN * HSCALE)};
            pg8::gemm_phase<pg8::Epi<pg8::EK_DOWN>, pg8::MoeOrder, false, true>(F.lds, F.tid, g, S, E);
        }
        END_STEP;
        if (RUN_STEP && ((PH_MASK >> 11) & 1)) for (int rep_ = 0; rep_ <= ((REP_MASK >> 11) & 1); ++rep_) { MKCTX; ln2_phase(F, a, 0, 0 == DEPTH - 1); }
        END_STEP;
    }
    {
        unsigned char* wl = a->ws + WS_W + (size_t)1 * W_LAYER;
        bf16_t* Hb = (bf16_t*)(a->ws + WS_H);
        bf16_t* P = (bf16_t*)(a->ws + WS_ARENA + AR_P);
        {
            const bf16_t* Hg = Hb + (size_t)0 * TG * DM;
            if (RUN_STEP && ((PH_MASK >> 1) & 1)) for (int rep_ = 0; rep_ <= ((REP_MASK >> 1) & 1); ++rep_) { MKCTX;
                pg8::Gemm g{(const bf16_t*)(a->ws + WS_H8 + (size_t)0 * TG * DM), (const bf16_t*)(wl + WO_IN), 512, 512, 512}; pg8::StaticOrder S; S.init(TG, LDP, 512, 512, F.G, (int)blockIdx.x, 512);
                pg8::Epi<pg8::EK_PROJ> E{P, LDP, nullptr, 0, nullptr, nullptr, nullptr, 1.f / (WSCALE * ASCALE)};
                pg8::gemm_phase<pg8::Epi<pg8::EK_PROJ>, pg8::StaticOrder, false, true>(F.lds, F.tid, g, S, E);
            }
            END_STEP;
            if (RUN_STEP && ((PH_MASK >> 2) & 1)) for (int rep_ = 0; rep_ <= ((REP_MASK >> 2) & 1); ++rep_) { MKCTX;
                for (int cu = blockIdx.x; cu < BG * 32; cu += F.G)
                    compress_unit(F, cu, P, (const bf16_t*)(wl + WO_W1), (const bf16_t*)(wl + WO_W2), (const float*)(a->ws + WS_MISC + MI_B1) + 1 * 256,
                                  (bf16_t*)(a->ws + WS_MISC + MI_KC), (bf16_t*)(a->ws + WS_MISC + MI_VC));
                conv_phase(F, P, (bf16_t*)(F.dout + DO_XC), a->in[I_CONVW] + (size_t)1 * 4 * 2048, a->in[I_CONVB] + (size_t)1 * 2048);
            }
            END_STEP;
            if (RUN_STEP && ((PH_MASK >> 3) & 1)) for (int rep_ = 0; rep_ <= ((REP_MASK >> 3) & 1); ++rep_) { MKCTX; attn_phase(F, a, 1, 0 + 4 * rep_); }
            END_STEP;
            if (RUN_STEP && ((PH_MASK >> 4) & 1)) for (int rep_ = 0; rep_ <= ((REP_MASK >> 4) & 1); ++rep_) { MKCTX; fin_phase(F, P, (bf16_t*)(F.dout + DO_R), (const bf16_t*)(F.dout + DO_YC), F.dout + DO_YC8, a->in[I_SNG] + (size_t)1 * DM); }
            END_STEP;
            if (RUN_STEP && ((PH_MASK >> 5) & 1)) for (int rep_ = 0; rep_ <= ((REP_MASK >> 5) & 1); ++rep_) { MKCTX;
                bf16_t* GT = (bf16_t*)(a->ws + WS_ARENA + AR_GATES); bf16_t* MX = (bf16_t*)(a->ws + WS_ARENA + AR_MIXIN); float* TMP = (float*)(F.dout + DO_TMP);
                pg8::Gemm g{nullptr, nullptr, 512, 512, 512};
                pg8::S5Order S; S.so.init(TG, DM, 512, 512, F.G, (int)blockIdx.x, 512);
                S.aH = (long)(size_t)(a->ws + WS_H8 + (size_t)0 * TG * DM); S.aRY = (long)(size_t)(F.dout + DO_R); S.aYC = (long)(size_t)(F.dout + DO_YC8);
                S.bG = (long)(size_t)(wl + WO_GATE); S.bCN = (long)(size_t)(wl + WO_C); S.bS = (long)(size_t)(wl + WO_SSD);
                pg8::Epi<pg8::EK_S5> E{GT, 3072, nullptr, 0, TMP, nullptr, MX, 1.f};
                pg8::gemm_phase<pg8::Epi<pg8::EK_S5>, pg8::S5Order, false, true>(F.lds, F.tid, g, S, E);
            }
            END_STEP;
            if (RUN_STEP && ((PH_MASK >> 6) & 1)) for (int rep_ = 0; rep_ <= ((REP_MASK >> 6) & 1); ++rep_) { MKCTX;
                pg8::Gemm g{(const bf16_t*)(a->ws + WS_ARENA + AR_MIXIN), (const bf16_t*)(wl + WO_OUT), 512, 512, 512}; pg8::StaticOrder S; S.init(TG, DM, 512, 512, F.G, (int)blockIdx.x, 512);
                pg8::Epi<pg8::EK_WOUT> E{(bf16_t*)(a->ws + WS_PRE1) + (size_t)0 * TG * DM, DM, Hg, DM, nullptr, nullptr, nullptr, 1.f / (WSCALE_OUT * MSCALE)};
                pg8::gemm_phase<pg8::Epi<pg8::EK_WOUT>, pg8::StaticOrder, false, true>(F.lds, F.tid, g, S, E);
            }
            END_STEP;
        }
        {
            const bf16_t* Hg = Hb + (size_t)1 * TG * DM;
            if (RUN_STEP && ((PH_MASK >> 1) & 1)) for (int rep_ = 0; rep_ <= ((REP_MASK >> 1) & 1); ++rep_) { MKCTX;
                pg8::Gemm g{(const bf16_t*)(a->ws + WS_H8 + (size_t)1 * TG * DM), (const bf16_t*)(wl + WO_IN), 512, 512, 512}; pg8::StaticOrder S; S.init(TG, LDP, 512, 512, F.G, (int)blockIdx.x, 512);
                pg8::Epi<pg8::EK_PROJ> E{P, LDP, nullptr, 0, nullptr, nullptr, nullptr, 1.f / (WSCALE * ASCALE)};
                pg8::gemm_phase<pg8::Epi<pg8::EK_PROJ>, pg8::StaticOrder, false, true>(F.lds, F.tid, g, S, E);
            }
            END_STEP;
            if (RUN_STEP && ((PH_MASK >> 2) & 1)) for (int rep_ = 0; rep_ <= ((REP_MASK >> 2) & 1); ++rep_) { MKCTX;
                for (int cu = blockIdx.x; cu < BG * 32; cu += F.G)
                    compress_unit(F, cu, P, (const bf16_t*)(wl + WO_W1), (const bf16_t*)(wl + WO_W2), (const float*)(a->ws + WS_MISC + MI_B1) + 1 * 256,
                                  (bf16_t*)(a->ws + WS_MISC + MI_KC), (bf16_t*)(a->ws + WS_MISC + MI_VC));
                conv_phase(F, P, (bf16_t*)(F.dout + DO_XC), a->in[I_CONVW] + (size_t)1 * 4 * 2048, a->in[I_CONVB] + (size_t)1 * 2048);
            }
            END_STEP;
            if (RUN_STEP && ((PH_MASK >> 3) & 1)) for (int rep_ = 0; rep_ <= ((REP_MASK >> 3) & 1); ++rep_) { MKCTX; attn_phase(F, a, 1, 1 + 4 * rep_); }
            END_STEP;
            if (RUN_STEP && ((PH_MASK >> 4) & 1)) for (int rep_ = 0; rep_ <= ((REP_MASK >> 4) & 1); ++rep_) { MKCTX; fin_phase(F, P, (bf16_t*)(F.dout + DO_R), (const bf16_t*)(F.dout + DO_YC), F.dout + DO_YC8, a->in[I_SNG] + (size_t)1 * DM); }
            END_STEP;
            if (RUN_STEP && ((PH_MASK >> 5) & 1)) for (int rep_ = 0; rep_ <= ((REP_MASK >> 5) & 1); ++rep_) { MKCTX;
                bf16_t* GT = (bf16_t*)(a->ws + WS_ARENA + AR_GATES); bf16_t* MX = (bf16_t*)(a->ws + WS_ARENA + AR_MIXIN); float* TMP = (float*)(F.dout + DO_TMP);
                pg8::Gemm g{nullptr, nullptr, 512, 512, 512};
                pg8::S5Order S; S.so.init(TG, DM, 512, 512, F.G, (int)blockIdx.x, 512);
                S.aH = (long)(size_t)(a->ws + WS_H8 + (size_t)1 * TG * DM); S.aRY = (long)(size_t)(F.dout + DO_R); S.aYC = (long)(size_t)(F.dout + DO_YC8);
                S.bG = (long)(size_t)(wl + WO_GATE); S.bCN = (long)(size_t)(wl + WO_C); S.bS = (long)(size_t)(wl + WO_SSD);
                pg8::Epi<pg8::EK_S5> E{GT, 3072, nullptr, 0, TMP, nullptr, MX, 1.f};
                pg8::gemm_phase<pg8::Epi<pg8::EK_S5>, pg8::S5Order, false, true>(F.lds, F.tid, g, S, E);
            }
            END_STEP;
            if (RUN_STEP && ((PH_MASK >> 6) & 1)) for (int rep_ = 0; rep_ <= ((REP_MASK >> 6) & 1); ++rep_) { MKCTX;
                pg8::Gemm g{(const bf16_t*)(a->ws + WS_ARENA + AR_MIXIN), (const bf16_t*)(wl + WO_OUT), 512, 512, 512}; pg8::StaticOrder S; S.init(TG, DM, 512, 512, F.G, (int)blockIdx.x, 512);
                pg8::Epi<pg8::EK_WOUT> E{(bf16_t*)(a->ws + WS_PRE1) + (size_t)1 * TG * DM, DM, Hg, DM, nullptr, nullptr, nullptr, 1.f / (WSCALE_OUT * MSCALE)};
                pg8::gemm_phase<pg8::Epi<pg8::EK_WOUT>, pg8::StaticOrder, false, true>(F.lds, F.tid, g, S, E);
            }
            END_STEP;
        }
        if (RUN_STEP && ((PH_MASK >> 7) & 1)) for (int rep_ = 0; rep_ <= ((REP_MASK >> 7) & 1); ++rep_) { MKCTX; ln1_route_phase(F, a, 1); }
        END_STEP;
        if (RUN_STEP && ((PH_MASK >> 9) & 1)) for (int rep_ = 0; rep_ <= ((REP_MASK >> 9) & 1); ++rep_) { MKCTX;
            const int nrt = moe_tables(F, 1, (const int*)(a->ws + WS_ARENA + AR_RTOK));
            pg8::Gemm g{(const bf16_t*)(a->ws + WS_H18), (const bf16_t*)(wl + WO_UP), 512, 512, 512};
            pg8::MoeOrder S{(const LAS int*)(F.lds + LDSX + LX_TILE), (const LAS int*)(F.lds + LDSX + LX_OFF), (const LAS int*)(F.lds + LDSX + LX_ECNT), nrt, F.G, F.vcu, 8, (long)256 * DM, (long)256 * DM, (long)1024 * DM};
            pg8::Epi<pg8::EK_GLU> E{(bf16_t*)(a->ws + WS_ARENA + AR_HID), 512, nullptr, 0, nullptr, nullptr, nullptr, 1.f / (WSCALE * ASCALE)};
            pg8::gemm_phase<pg8::Epi<pg8::EK_GLU>, pg8::MoeOrder, true, true>(F.lds, F.tid, g, S, E, (const LAS int*)(F.lds + LDSX + LX_GIDX));
        }
        END_STEP;
        if (RUN_STEP && ((PH_MASK >> 10) & 1)) for (int rep_ = 0; rep_ <= ((REP_MASK >> 10) & 1); ++rep_) { MKCTX;
            const int nrt = moe_tables(F, 1, nullptr);
            pg8::Gemm g{(const bf16_t*)(a->ws + WS_ARENA + AR_HID), (const bf16_t*)(wl + WO_DN), 256, 256, 256};
            pg8::MoeOrder S{(const LAS int*)(F.lds + LDSX + LX_TILE), (const LAS int*)(F.lds + LDSX + LX_OFF), (const LAS int*)(F.lds + LDSX + LX_ECNT), nrt, F.G, F.vcu, 4, (long)256 * 512, (long)256 * 512, (long)1024 * 512};
            pg8::Epi<pg8::EK_DOWN> E{(bf16_t*)(a->ws + WS_ARENA + AR_XS), DM, nullptr, 0, nullptr, (const int2*)(a->ws + WS_ARENA + AR_RINFO), nullptr, 1.f / (WSCALE_DN * HSCALE)};
            pg8::gemm_phase<pg8::Epi<pg8::EK_DOWN>, pg8::MoeOrder, false, true>(F.lds, F.tid, g, S, E);
        }
        END_STEP;
        if (RUN_STEP && ((PH_MASK >> 11) & 1)) for (int rep_ = 0; rep_ <= ((REP_MASK >> 11) & 1); ++rep_) { MKCTX; ln2_phase(F, a, 1, 1 == DEPTH - 1); }
        END_STEP;
    }
#undef RUN_STEP
#undef END_STEP
}

__global__ void dump_bf16(const bf16_t* src, float* dst, size_t n) { for (size_t i = (size_t)blockIdx.x * blockDim.x + threadIdx.x; i < n; i += (size_t)gridDim.x * blockDim.x) dst[i] = bf1(src[i]); }
#ifndef N_LAUNCH_MODE
#define N_LAUNCH_MODE 0
#endif
extern "C" void kernel_launch(void* const* d_in, const int* in_sizes, int n_in, void* d_out, int out_size, void* d_ws, size_t ws_size, hipStream_t stream) {
    static int grid = 0;
    if (grid == 0) {
        if (n_in != 32 || out_size != T_ * DM || ws_size < WS_END) { fprintf(stderr, "kernel_launch: unexpected problem (n_in %d out %d ws %zu)\n", n_in, out_size, ws_size); grid = -1; return; }
        int dev = 0, cus = 0, per_cu = 0;
        if (hipGetDevice(&dev) != hipSuccess || hipDeviceGetAttribute(&cus, hipDeviceAttributeMultiprocessorCount, dev) != hipSuccess) { grid = -1; return; }
        if (hipFuncSetAttribute((const void*)fwd_kernel, hipFuncAttributeMaxDynamicSharedMemorySize, LDS_TOTAL) != hipSuccess) { fprintf(stderr, "kernel_launch: hipFuncSetAttribute failed\n"); grid = -1; return; }
        if (hipOccupancyMaxActiveBlocksPerMultiprocessor(&per_cu, (const void*)fwd_kernel, 512, LDS_TOTAL) != hipSuccess || per_cu < 1)
            fprintf(stderr, "kernel_launch: occupancy query reports %d workgroups per CU\n", per_cu);
        (void)hipGetLastError();
        grid = cus;
    }
    if (grid < 0) return;
    (void)hipMemsetAsync((char*)d_ws + WS_CTL, 0, CTL_ZERO_BYTES, stream);
    Args a{};
    for (int i = 0; i < 32; ++i) a.in[i] = (const float*)d_in[i];
    a.out = (float*)d_out; a.ws = (unsigned char*)d_ws;
#if N_LAUNCH_MODE == 1
    a.lo = 0; a.hi = NSTEPS;
    hipLaunchKernelGGL(fwd_kernel, dim3(grid), dim3(512), LDS_TOTAL, stream, a);
#else
#ifdef DBG_STOP
    for (int s = 0; s <= DBG_STOP; ++s) { a.lo = s; a.hi = s + 1; hipLaunchKernelGGL(fwd_kernel, dim3(grid), dim3(512), LDS_TOTAL, stream, a); }
    hipLaunchKernelGGL(dump_bf16, dim3(1024), dim3(256), 0, stream, (const bf16_t*)((char*)d_ws + DBG_SRC), (float*)d_out, (size_t)T_ * DM);
#else
    for (int s = 0; s < NSTEPS; ++s) { a.lo = s; a.hi = s + 1; hipLaunchKernelGGL(fwd_kernel, dim3(grid), dim3(512), LDS_TOTAL, stream, a); }
#endif
#endif
}
```

```cpp
#define N_LAUNCH_MODE 1
#include <hip/hip_runtime.h>
#include <cstdio>
#include <cstdint>

#define LAS __attribute__((address_space(3)))
#define GAS __attribute__((address_space(1)))
typedef unsigned short bf16_t;
typedef short bf16x8 __attribute__((ext_vector_type(8)));
typedef short s16x4 __attribute__((ext_vector_type(4)));
typedef float f32x2 __attribute__((ext_vector_type(2)));
typedef float f32x4 __attribute__((ext_vector_type(4)));
typedef float f32x16 __attribute__((ext_vector_type(16)));
typedef unsigned u32x2 __attribute__((ext_vector_type(2)));
typedef unsigned u32x4 __attribute__((ext_vector_type(4)));

constexpr int T_ = 32768, SEQ = 2048, DM = 1024, NBATCH = 16, DEPTH = 2;
constexpr int NG = 2, BG = NBATCH / NG, TG = T_ / NG;
constexpr int LDP = 5120;
constexpr int C_POOL = 0, C_Q = 512, C_KV = 1024, C_Z = 1792, C_XBC = 2816, C_NG = 4864, C_DT = 4888;
constexpr int D_IN = 7976;
constexpr float LN_EPS = 1e-5f, DN_ALPHA = 1.41421356237f, LOG2E = 1.4426950408889634f;
constexpr float QSCALE = 0.125f * LOG2E;
constexpr float NEGBIG = -1e30f;
constexpr int MOE_ROWS = 69632;

constexpr size_t MiB = 1ull << 20;
constexpr size_t WS_CTL = 0, CTL_ZERO_BYTES = 65536;
constexpr size_t WS_MISC = 1 * MiB;
constexpr size_t WS_W = 2 * MiB, W_LAYER = 52 * MiB;
constexpr size_t WO_IN = 0, WO_GATE = 5 * MiB, WO_C = 11 * MiB, WO_NSA = 12 * MiB, WO_SSD = 13 * MiB, WO_OUT = 15 * MiB, WO_W1 = 17 * MiB, WO_W2 = 18 * MiB, WO_UP = 19 * MiB, WO_DN = 35 * MiB;
constexpr size_t WS_H = 106 * MiB, WS_PRE1 = 170 * MiB, WS_H8 = 234 * MiB, WS_H18 = 266 * MiB, WS_ARENA = 298 * MiB;
constexpr float P8SCALE = 24.f;
constexpr float RSCALE = 16.f, BSCALE = 16.f, YSCALE = 8.f, WSCALE_CN = 480.f;
constexpr float WSCALE = 704.f, ASCALE = 24.f, MSCALE = 32.f, HSCALE = 16.f, WSCALE_OUT = 1408.f, WSCALE_DN = 992.f;
constexpr size_t AR_P = 0, AR_GATES = 0, AR_YC8 = 160 * MiB;
constexpr size_t AR_XS = 0, AR_RTOK = 128 * MiB, AR_RINFO = 132 * MiB, AR_HID = 140 * MiB;
constexpr size_t WS_END = 506 * MiB;
constexpr int ECAP = 65536;
constexpr size_t DO_XC = 0, DO_TMP = 0, DO_YC = 64 * MiB, DO_R = 96 * MiB, DO_YC8 = 112 * MiB;
constexpr size_t MI_BIAS = 0, MI_B1 = 4096, MI_KC = 65536, MI_VC = MI_KC + 262144, MI_ROUTE = 1 * MiB, MI_RINFO = 2 * MiB;
constexpr int CW_BAR = 4096, CW_WQ = 8192, CW_CNT = 12288;
constexpr int LDS_TOTAL = 147456, LDSX = 131072;
constexpr int LX_BAR = 0, LX_WQ = 16, LX_OFF = 64, LX_ECNT = 160, LX_TILE = 256, LX_CNTL = 1536, LX_BASE = 1600, LX_ROWS = 2048, LX_GIDX = 6144, LX_LUT = 14336;

__device__ __forceinline__ float bflo(unsigned u) { return __uint_as_float(u << 16); }
__device__ __forceinline__ float bfhi(unsigned u) { return __uint_as_float(u & 0xffff0000u); }
__device__ __forceinline__ float bf1(bf16_t b) { return __uint_as_float(((unsigned)b) << 16); }
typedef __bf16 bf16x2_t __attribute__((ext_vector_type(2)));
__device__ __forceinline__ unsigned cvt_pk_bf16(float lo, float hi) { const f32x2 v = {lo, hi}; const bf16x2_t b = __builtin_convertvector(v, bf16x2_t); return __builtin_bit_cast(unsigned, b); }
__device__ __forceinline__ bf16_t f2bf(float f) { return (bf16_t)(cvt_pk_bf16(f, 0.f) & 0xffffu); }
__device__ __forceinline__ float fexp2(float x) { return __builtin_amdgcn_exp2f(x); }
__device__ __forceinline__ float frcp(float x) { return __builtin_amdgcn_rcpf(x); }
__device__ __forceinline__ float sigmoidf_(float x) { return frcp(1.f + fexp2(-x * LOG2E)); }
__device__ __forceinline__ float siluf_(float x) { return x * sigmoidf_(x); }
__device__ __forceinline__ float wave_sum(float v) {
#pragma unroll
    for (int o = 1; o < 64; o <<= 1) v += __shfl_xor(v, o);
    return v;
}
__device__ __forceinline__ float wave_scan_incl(float v) {
#define WS_DPP(ctrl, rmask) __int_as_float(__builtin_amdgcn_update_dpp(0, __float_as_int(v), ctrl, rmask, 0xf, false))
    v += WS_DPP(0x111, 0xf); v += WS_DPP(0x112, 0xf); v += WS_DPP(0x114, 0xf); v += WS_DPP(0x118, 0xf);
    v += WS_DPP(0x142, 0xa); v += WS_DPP(0x143, 0xc);
#undef WS_DPP
    return v;
}
__device__ __forceinline__ void unpack8(const u32x4 v, float (&x)[8]) {
    x[0] = bflo(v.x); x[1] = bfhi(v.x); x[2] = bflo(v.y); x[3] = bfhi(v.y); x[4] = bflo(v.z); x[5] = bfhi(v.z); x[6] = bflo(v.w); x[7] = bfhi(v.w);
}
__device__ __forceinline__ u32x4 pack8(const float (&x)[8]) {
    u32x4 w; w.x = cvt_pk_bf16(x[0], x[1]); w.y = cvt_pk_bf16(x[2], x[3]); w.z = cvt_pk_bf16(x[4], x[5]); w.w = cvt_pk_bf16(x[6], x[7]); return w;
}
typedef int v4i __attribute__((ext_vector_type(4)));
__device__ __forceinline__ unsigned q1_i8(float x) { int q = __float2int_rn(x); q = q < -127 ? -127 : (q > 127 ? 127 : q); return (unsigned)q & 255u; }
__device__ __forceinline__ unsigned cvt4_i8s(float a, float b, float c, float d, float sc) {
    const float M = 12582912.f;
    const unsigned ua = __float_as_uint(__builtin_amdgcn_fmed3f(fmaf(a, sc, M), M - 127.f, M + 127.f)), ub = __float_as_uint(__builtin_amdgcn_fmed3f(fmaf(b, sc, M), M - 127.f, M + 127.f));
    const unsigned uc = __float_as_uint(__builtin_amdgcn_fmed3f(fmaf(c, sc, M), M - 127.f, M + 127.f)), ud = __float_as_uint(__builtin_amdgcn_fmed3f(fmaf(d, sc, M), M - 127.f, M + 127.f));
    const unsigned lo = __builtin_amdgcn_perm(ub, ua, 0x0c0c0400u), hi = __builtin_amdgcn_perm(ud, uc, 0x04000c0cu);
    return lo | hi;
}
__device__ __forceinline__ unsigned cvt4_i8(float a, float b, float c, float d) { return cvt4_i8s(a, b, c, d, 1.f); }
__device__ __forceinline__ u32x2 pack8_i8(const float (&x)[8], float sc) { u32x2 w; w.x = cvt4_i8s(x[0], x[1], x[2], x[3], sc); w.y = cvt4_i8s(x[4], x[5], x[6], x[7], sc); return w; }
__device__ __forceinline__ void unpack4_i8(unsigned w, float* x) { const unsigned u = w ^ 0x80808080u;
    x[0] = (float)(u & 255u) - 128.f; x[1] = (float)((u >> 8) & 255u) - 128.f; x[2] = (float)((u >> 16) & 255u) - 128.f; x[3] = (float)(u >> 24) - 128.f; }
__device__ __forceinline__ void unpack8_i8(const u32x2 w, float (&x)[8]) { unpack4_i8(w.x, x); unpack4_i8(w.y, x + 4); }
#define LDS_WAIT() asm volatile("s_waitcnt lgkmcnt(0)" ::: "memory")
__device__ __forceinline__ int crow(int r, int hi) { return (r & 3) + 8 * (r >> 2) + 4 * hi; }
__device__ __forceinline__ f32x16 mfma32(bf16x8 a, bf16x8 b, f32x16 c) { return __builtin_amdgcn_mfma_f32_32x32x16_bf16(a, b, c, 0, 0, 0); }
__device__ __forceinline__ f32x4 mfma16(bf16x8 a, bf16x8 b, f32x4 c) { return __builtin_amdgcn_mfma_f32_16x16x32_bf16(a, b, c, 0, 0, 0); }
typedef short v4i16_t __attribute__((ext_vector_type(4)));
__device__ __forceinline__ s16x4 trrd(const LAS unsigned char* p) { return __builtin_bit_cast(s16x4, __builtin_amdgcn_ds_read_tr16_b64_v4i16((LAS v4i16_t*)p)); }
__device__ __forceinline__ bf16x8 cat8(s16x4 lo, s16x4 hi) { return (bf16x8){lo[0], lo[1], lo[2], lo[3], hi[0], hi[1], hi[2], hi[3]}; }

namespace pg8 {
constexpr int BM = 256, BK = 64, HALF = 128, HTB = HALF * BK * 2, STAGE_BYTES = 8 * HTB, NXCD = 8, WGM = 8;
__host__ __device__ __forceinline__ int lds_byte(int r, int c) { const int st = (r >> 4) * 2 + (c >> 5), rr = r & 15, cc = c & 31, ob = rr * 64 + cc * 2; return st * 1024 + (ob ^ (((ob >> 9) & 1) << 5)); }
__host__ __device__ __forceinline__ void stage_rc(int b, int& R, int& C) { const int st = b / 1024, sb = b % 1024, swz = sb ^ (((sb >> 9) & 1) << 5); R = (st >> 1) * 16 + swz / 64; C = (st & 1) * 32 + (swz % 64) / 2; }
__host__ __device__ __forceinline__ int perm32(int rho) { const int n = rho >> 4, i = rho & 15; return 8 * (i >> 2) + 4 * n + (i & 3); }

struct Unit { int pm, pn, nt, kind, gx, nv, gi; long ab, bb; };
struct Gemm { const bf16_t* A; const bf16_t* Bt; int lda, ldb, K; };

struct StaticOrder {
    int nM, nN, nwg, G, c, nt0; long tsA, tsB;
    __device__ void init(int M, int N, int lda, int ldb, int G_, int c_, int K_ = 1024) { nM = M / BM; nN = N / BM; nwg = nM * nN; G = G_; c = c_; nt0 = K_ / BK; tsA = (long)BM * lda * 2; tsB = (long)BM * ldb * 2; }
    __device__ bool next(int i, Unit& u) const {
        const long L = (long)i * G + c; if (L >= nwg) return false;
        int wgid = (int)L; { const int q = nwg / NXCD, r = nwg % NXCD, xcd = wgid % NXCD, off = wgid / NXCD; wgid = (xcd < r ? xcd * (q + 1) : r * (q + 1) + (xcd - r) * q) + off; }
        const int nig = WGM * nN, gid = wgid / nig, fm = gid * WGM, gsz = (nM - fm) < WGM ? (nM - fm) : WGM;
        u.pm = fm + ((wgid % nig) % gsz); u.pn = (wgid % nig) / gsz; u.ab = u.pm * tsA; u.bb = u.pn * tsB; u.nt = nt0; u.kind = 0; u.gx = 0; u.nv = 0; u.gi = 0; return true;
    }
};
struct S5Order {
    StaticOrder so; long aH, aRY, aYC, bG, bCN, bS;
    __device__ bool next(int i, Unit& u) const {
        const int base = i / 6, s = i - 6 * base, x = s >> 1;
        if (!so.next(base, u)) return false;
        const long ra = u.ab, rb = u.bb;
        if ((s & 1) == 0) { u.ab = aH + ra; u.bb = bG + rb + (long)x * 1024 * 1024; u.nt = 8; u.kind = 0; u.pn += 4 * x; }
        else if (x == 0) { u.ab = aRY + ra; u.bb = bCN + rb; u.nt = 4; u.kind = 1; }
        else if (x == 1) { u.ab = aRY + ra + 512; u.bb = bCN + rb + 512; u.nt = 4; u.kind = 2; }
        else { u.ab = aYC + ra; u.bb = bS + rb; u.nt = 8; u.kind = 3; }
        return true;
    }
};
struct MoeOrder {
    const LAS int* tile_e; const LAS int* off; const LAS int* cnt; int nrt, G, vcu, nt0; long tsA, tsB, eB;
    __device__ bool next(int i, Unit& u) const {
        const long L = (long)i * G + vcu; if (L >= (long)nrt * 4) return false;
        const int rt = (int)(L >> 2), pn = (int)(L & 3), e = __builtin_amdgcn_readfirstlane(tile_e[rt]), k0 = rt * 256 - __builtin_amdgcn_readfirstlane(off[e]), c = __builtin_amdgcn_readfirstlane(cnt[e]);
        u.pm = rt; u.pn = pn; u.ab = rt * tsA; u.bb = e * eB + pn * tsB; u.nt = nt0; u.kind = 0; u.gx = e * ECAP + k0; u.nv = (c - k0) < 256 ? (c - k0) : 256; u.gi = i; return true;
    }
};

template <class Epi, class Sched, bool GATHER = false, bool FP8 = false>
__device__ __forceinline__ void gemm_phase(LAS unsigned char* lds, int tid_, const Gemm g, const Sched& S, const Epi& E, const LAS int* gidx = nullptr) {
    asm volatile("" : "+v"(tid_));
    const int tid = tid_, wid = __builtin_amdgcn_readfirstlane(tid >> 6), lane = tid & 63, wr = wid >> 2, wc = wid & 3, fr = lane & 15, fq = lane >> 4;
    unsigned voffA0[2], voffA1[2], nvA0[2], nvA1[2], voffB[2]; int RA[2], CA[2];
#pragma unroll
    for (int i = 0; i < 2; ++i) { int R, C; stage_rc(tid * 16 + i * 8192, R, C); const int Rb = Epi::PERM ? ((R & ~31) + perm32(R & 31)) : R; RA[i] = R; CA[i] = C;
        voffA0[i] = (unsigned)(R * g.lda + C) * 2u; voffA1[i] = (unsigned)((R + HALF) * g.lda + C) * 2u; nvA0[i] = voffA0[i]; nvA1[i] = voffA1[i]; voffB[i] = (unsigned)(Rb * g.ldb + C) * 2u; }
#define PG8_GATHER(dst0, dst1, u_) do { _Pragma("unroll") for (int _i = 0; _i < 2; ++_i) { \
        dst0[_i] = (unsigned)(gidx[((u_).gi & 7) * 256 + RA[_i]] * g.lda + CA[_i]) * 2u; dst1[_i] = (unsigned)(gidx[((u_).gi & 7) * 256 + HALF + RA[_i]] * g.lda + CA[_i]) * 2u; } } while (0)
    const size_t kstep = (size_t)(BK * 2);
    const size_t hstepB = (size_t)HALF * g.ldb * 2;
    const unsigned ldsw = (unsigned)wid * 1024u;
    const int aoff = lds_byte(wr * 64 + fr, fq * 8), boff = lds_byte(wc * 32 + fr, fq * 8);
#define PG8_SA(b, h) (((b) * 2 + (h)) * HTB)
#define PG8_SB(b, h) ((4 + (b) * 2 + (h)) * HTB)
#define PG8_STAGE(bufoff, gbase, voff) do { _Pragma("unroll") for (int _i = 0; _i < 2; ++_i) \
        __builtin_amdgcn_global_load_lds((const unsigned*)((const char*)(gbase) + (voff)[_i]), (LAS unsigned*)(lds + (bufoff) + ldsw + _i * 8192), 16, 0, 0); } while (0)
#define PG8_LDA(dst, b, h) do { _Pragma("unroll") for (int m = 0; m < 4; ++m) _Pragma("unroll") for (int k = 0; k < 2; ++k) dst[m][k] = *(const LAS bf16x8*)(lds + PG8_SA(b, h) + aoff + m * 2048 + k * 1024); } while (0)
#define PG8_LDB(dst, b, h) do { _Pragma("unroll") for (int n = 0; n < 2; ++n) _Pragma("unroll") for (int k = 0; k < 2; ++k) dst[n][k] = *(const LAS bf16x8*)(lds + PG8_SB(b, h) + boff + n * 2048 + k * 1024); } while (0)
#define PG8_MMA(ai, bj, At, Bt) do { __builtin_amdgcn_s_setprio(1); _Pragma("unroll") for (int m = 0; m < 4; ++m) _Pragma("unroll") for (int n = 0; n < 2; ++n) _Pragma("unroll") for (int k = 0; k < 2; ++k) { \
        if constexpr (FP8) acc[ai][bj][m][n] = __builtin_bit_cast(f32x4, __builtin_amdgcn_mfma_i32_16x16x64_i8(__builtin_bit_cast(v4i, Bt[n][k]), __builtin_bit_cast(v4i, At[m][k]), __builtin_bit_cast(v4i, acc[ai][bj][m][n]), 0, 0, 0)); \
        else acc[ai][bj][m][n] = __builtin_amdgcn_mfma_f32_16x16x32_bf16(Bt[n][k], At[m][k], acc[ai][bj][m][n], 0, 0, 0); } __builtin_amdgcn_s_setprio(0); } while (0)
#define PG8_WAIT_V(n) asm volatile("s_waitcnt vmcnt(" #n ")" ::: "memory")
#define PG8_WAIT_L(n) asm volatile("s_waitcnt lgkmcnt(" #n ")" ::: "memory")
#define PG8_WAIT_V8R(sel) asm volatile("s_cmp_eq_u32 %0, 0\n\ts_cbranch_scc1 .Lpg8rx%=\n\ts_waitcnt vmcnt(8)\n.Lpg8rx%=:\n\ts_waitcnt vmcnt(%1)" :: "s"(__builtin_amdgcn_readfirstlane(sel)), "n"(8 + Epi::NST) : "memory", "scc")
#define PG8_BAR __builtin_amdgcn_s_barrier()
#define PG8_SCHED __builtin_amdgcn_sched_barrier(0)
    Unit cur, nxt; int ui = 0;
    if (!S.next(0, cur)) return;
    f32x4 acc[2][2][4][2];
#pragma unroll
    for (int a = 0; a < 2; ++a)
#pragma unroll
        for (int b = 0; b < 2; ++b)
#pragma unroll
            for (int m = 0; m < 4; ++m)
#pragma unroll
                for (int n = 0; n < 2; ++n) acc[a][b][m][n] = (f32x4){0.f, 0.f, 0.f, 0.f};
    bf16x8 At[4][2], B0[2][2], B1[2][2];
    const char* cA = (const char*)g.A + (GATHER ? 0 : cur.ab); const char* cB = (const char*)g.Bt + cur.bb;
    if constexpr (GATHER) PG8_GATHER(voffA0, voffA1, cur);
    PG8_STAGE(PG8_SB(0, 0), cB, voffB); PG8_STAGE(PG8_SB(0, 1), cB + hstepB, voffB); PG8_STAGE(PG8_SA(0, 0), cA, voffA0); PG8_STAGE(PG8_SA(0, 1), cA, voffA1);
    if (wr == 1) PG8_BAR;
    PG8_WAIT_V(2); PG8_BAR;
    PG8_STAGE(PG8_SB(1, 0), cB + kstep, voffB); PG8_STAGE(PG8_SA(1, 0), cA + kstep, voffA0); PG8_STAGE(PG8_SB(1, 1), cB + hstepB + kstep, voffB);
    PG8_WAIT_V(6); PG8_BAR;
    for (;;) {
        const bool has_next = S.next(ui + 1, nxt);
        const char* nA = (has_next && !GATHER) ? (const char*)g.A + nxt.ab : cA; const char* nB = has_next ? (const char*)g.Bt + nxt.bb : cB;
        if constexpr (GATHER) { if (has_next) PG8_GATHER(nvA0, nvA1, nxt); else { nvA0[0] = voffA0[0]; nvA0[1] = voffA0[1]; nvA1[0] = voffA1[0]; nvA1[1] = voffA1[1]; } }
        const int nt = cur.nt; const int tf = (ui == 0) ? 1 : 0;
        for (int t = 0; t < nt; t += 2) {
            const bool last = (t == nt - 2);
            const char* a1 = cA + (size_t)(t + 1) * kstep;
            const char* a2 = last ? nA : cA + (size_t)(t + 2) * kstep; const char* b2 = last ? nB : cB + (size_t)(t + 2) * kstep;
            const char* a3 = a2 + kstep; const char* b3 = b2 + kstep;
            unsigned xA0[2], xA1[2];
            xA0[0] = (GATHER && last) ? nvA0[0] : voffA0[0]; xA0[1] = (GATHER && last) ? nvA0[1] : voffA0[1]; xA1[0] = (GATHER && last) ? nvA1[0] : voffA1[0]; xA1[1] = (GATHER && last) ? nvA1[1] : voffA1[1];
            PG8_LDB(B0, 0, 0); PG8_LDB(B1, 0, 1); PG8_SCHED; PG8_LDA(At, 0, 0); PG8_STAGE(PG8_SA(1, 1), a1, voffA1);
            PG8_WAIT_V8R(t + tf); PG8_WAIT_L(0); PG8_BAR; PG8_MMA(0, 0, At, B0); PG8_MMA(0, 1, At, B1); PG8_BAR; PG8_SCHED;
            PG8_LDA(At, 0, 1); PG8_STAGE(PG8_SB(0, 0), b2, voffB); PG8_STAGE(PG8_SB(0, 1), b2 + hstepB, voffB); PG8_STAGE(PG8_SA(0, 0), a2, xA0);
            PG8_WAIT_V8R(t + tf); PG8_WAIT_L(0); PG8_BAR; PG8_MMA(1, 0, At, B0); PG8_MMA(1, 1, At, B1); PG8_BAR; PG8_SCHED;
            PG8_LDB(B0, 1, 0); PG8_LDB(B1, 1, 1); PG8_SCHED; PG8_LDA(At, 1, 0); PG8_STAGE(PG8_SA(0, 1), a2, xA1);
            PG8_WAIT_V(8); PG8_WAIT_L(0); PG8_BAR; PG8_MMA(0, 0, At, B0); PG8_MMA(0, 1, At, B1); PG8_BAR; PG8_SCHED;
            PG8_LDA(At, 1, 1); PG8_STAGE(PG8_SB(1, 0), b3, voffB); PG8_STAGE(PG8_SB(1, 1), b3 + hstepB, voffB); PG8_STAGE(PG8_SA(1, 0), a3, xA0);
            PG8_WAIT_V(8); PG8_WAIT_L(0); PG8_BAR; PG8_MMA(1, 0, At, B0); PG8_MMA(1, 1, At, B1); PG8_BAR; PG8_SCHED;
        }
        if (wr == 0) PG8_BAR;
        if constexpr (FP8) {
#pragma unroll
            for (int a = 0; a < 2; ++a)
#pragma unroll
                for (int b = 0; b < 2; ++b)
#pragma unroll
                    for (int m = 0; m < 4; ++m)
#pragma unroll
                        for (int n = 0; n < 2; ++n)
#pragma unroll
                            for (int j = 0; j < 4; ++j) acc[a][b][m][n][j] = (float)__float_as_int(acc[a][b][m][n][j]);
        }
        E(acc, cur, wr, wc, fr, fq);
        if (!has_next) break;
#pragma unroll
        for (int a = 0; a < 2; ++a)
#pragma unroll
            for (int b = 0; b < 2; ++b)
#pragma unroll
                for (int m = 0; m < 4; ++m)
#pragma unroll
                    for (int n = 0; n < 2; ++n) acc[a][b][m][n] = (f32x4){0.f, 0.f, 0.f, 0.f};
        cur = nxt; cA = nA; cB = nB; ++ui;
        if constexpr (GATHER) { voffA0[0] = nvA0[0]; voffA0[1] = nvA0[1]; voffA1[0] = nvA1[0]; voffA1[1] = nvA1[1]; }
        if (wr == 1) PG8_BAR;
    }
    PG8_WAIT_V(0);
    PG8_BAR;
#undef PG8_GATHER
#undef PG8_SA
#undef PG8_SB
#undef PG8_STAGE
#undef PG8_LDA
#undef PG8_LDB
#undef PG8_MMA
#undef PG8_WAIT_V
#undef PG8_WAIT_V8R
#undef PG8_WAIT_L
#undef PG8_BAR
#undef PG8_SCHED
}

enum { EK_PROJ = 0, EK_GATE, EK_BR0, EK_BR1, EK_BR2, EK_WOUT, EK_GLU, EK_DOWN, EK_S5 };
template <int KIND> struct Epi {
    static constexpr int NST = (KIND == EK_DOWN) ? 0 : ((KIND == EK_GLU) ? 8 : 16);
    static constexpr bool PERM = true;
    bf16_t* O; int ldo;
    const bf16_t* X; int ldx;
    float* F;
    const int2* RI;
    bf16_t* O2;
    float osc;
    unsigned lut;
    template <int MODE> __device__ __forceinline__ void proj_tiles(const f32x4 (&acc)[2][2][4][2], int row0, int col0, int segb) const {
        const float mul = (MODE == 1) ? osc * QSCALE : ((MODE == 3) ? osc * P8SCALE : osc);
#pragma unroll
        for (int ai = 0; ai < 2; ++ai)
#pragma unroll
            for (int m = 0; m < 4; ++m) {
                const int row = row0 + ai * HALF + m * 16;
#pragma unroll
                for (int bj = 0; bj < 2; ++bj) {
                    const int col = col0 + bj * HALF; float v[8];
#pragma unroll
                    for (int n = 0; n < 2; ++n)
#pragma unroll
                        for (int j = 0; j < 4; ++j) v[4 * n + j] = acc[ai][bj][m][n][j] * mul;
                    if constexpr (MODE == 2) {
#pragma unroll
                        for (int j = 0; j < 8; ++j) v[j] = siluf_(v[j]) * P8SCALE;
                    }
                    if constexpr (MODE >= 2) *(u32x2*)((unsigned char*)O + (size_t)row * ldo * 2 + col + segb) = pack8_i8(v, 1.f);
                    else *(u32x4*)(O + (size_t)row * ldo + col) = pack8(v);
                    asm volatile("" ::: "memory");
                }
            }
    }
    __device__ __forceinline__ void operator()(const f32x4 (&acc)[2][2][4][2], const Unit& u, int wr, int wc, int fr, int fq) const {
        const int row0 = u.pm * BM + wr * 64 + fr, col0 = u.pn * BM + wc * 32 + 8 * fq;
        if constexpr (KIND == EK_GLU) {
            const int hc0 = u.pn * 128 + wc * 32 + 8 * fq;
#pragma unroll
            for (int ai = 0; ai < 2; ++ai)
#pragma unroll
                for (int m = 0; m < 4; ++m) {
                    const int row = row0 + ai * HALF + m * 16; float o[8];
#pragma unroll
                    for (int n = 0; n < 2; ++n)
#pragma unroll
                        for (int j = 0; j < 4; ++j) o[4 * n + j] = siluf_(acc[ai][0][m][n][j] * osc) * (acc[ai][1][m][n][j] * osc);
                    *(u32x2*)((unsigned char*)O + (size_t)row * ldo + hc0) = pack8_i8(o, HSCALE);
                    asm volatile("" ::: "memory");
                }
        } else if constexpr (KIND == EK_DOWN) {
#pragma unroll
            for (int ai = 0; ai < 2; ++ai)
#pragma unroll
                for (int m = 0; m < 4; ++m) {
                    const int lr = ai * HALF + wr * 64 + m * 16 + fr; const bool ok = lr < u.nv; const int2 ri = RI[u.gx + (ok ? lr : 0)]; const float w = __int_as_float(ri.y) * osc;
                    if (ok) {
#pragma unroll
                        for (int bj = 0; bj < 2; ++bj) { float o[8];
#pragma unroll
                            for (int n = 0; n < 2; ++n)
#pragma unroll
                                for (int j = 0; j < 4; ++j) o[4 * n + j] = w * acc[ai][bj][m][n][j];
                            *(u32x4*)(O + (size_t)ri.x * ldo + col0 + bj * HALF) = pack8(o); }
                    }
                    asm volatile("" ::: "memory");
                }
        } else if constexpr (KIND == EK_PROJ) {
            const int pn = u.pn;
            if (pn == 2 || pn == 3) proj_tiles<1>(acc, row0, col0, 0);
            else if (pn >= 7 && pn <= 10) proj_tiles<2>(acc, row0, col0, C_Z);
            else if (pn < 2) proj_tiles<3>(acc, row0, col0, C_POOL);
            else if (pn >= 11 && pn <= 18) proj_tiles<3>(acc, row0, col0, C_XBC);
            else proj_tiles<0>(acc, row0, col0, 0);
        } else if constexpr (KIND == EK_S5) {
            if (u.kind == 0) { Epi<EK_GATE> e{O, ldo, nullptr, 0, nullptr, nullptr, nullptr, 1.f / (WSCALE * ASCALE), lut}; e(acc, u, wr, wc, fr, fq); }
            else if (u.kind == 1) { Epi<EK_BR0> e{nullptr, 0, O, ldo, F, nullptr, nullptr, 1.f / (RSCALE * WSCALE_CN)}; e(acc, u, wr, wc, fr, fq); }
            else if (u.kind == 2) { Epi<EK_BR1> e{nullptr, 0, (const bf16_t*)((const unsigned char*)O + 1024), ldo, F, nullptr, nullptr, 1.f / (BSCALE * WSCALE_CN)}; e(acc, u, wr, wc, fr, fq); }
            else { Epi<EK_BR2> e{O2, 1024, (const bf16_t*)((const unsigned char*)O + 2048), ldo, F, nullptr, nullptr, 1.f / (YSCALE * WSCALE)}; e(acc, u, wr, wc, fr, fq); }
        } else {
            constexpr bool HAS_G = (KIND == EK_BR0 || KIND == EK_BR1 || KIND == EK_BR2), HAS_S = (KIND == EK_BR1 || KIND == EK_BR2 || KIND == EK_WOUT);
#pragma unroll
            for (int ai = 0; ai < 2; ++ai) {
                u32x2 gq[8]; u32x4 sq[8];
                if constexpr (HAS_G || HAS_S) {
#pragma unroll
                    for (int m = 0; m < 4; ++m)
#pragma unroll
                        for (int bj = 0; bj < 2; ++bj) {
                            const int row = row0 + ai * HALF + m * 16, col = col0 + bj * HALF;
                            if constexpr (HAS_G) gq[m * 2 + bj] = *(const u32x2*)((const unsigned char*)X + (size_t)row * ldx + col);
                            if constexpr (KIND == EK_BR1 || KIND == EK_BR2) sq[m * 2 + bj] = *(const u32x4*)((const bf16_t*)F + (size_t)row * 1024 + col);
                            if constexpr (KIND == EK_WOUT) sq[m * 2 + bj] = *(const u32x4*)(X + (size_t)row * ldx + col);
                        }
                    __builtin_amdgcn_sched_barrier(0);
                }
#pragma unroll
                for (int m = 0; m < 4; ++m) {
                    const int row = row0 + ai * HALF + m * 16;
#pragma unroll
                    for (int bj = 0; bj < 2; ++bj) {
                        const int col = col0 + bj * HALF; float v[8];
#pragma unroll
                        for (int n = 0; n < 2; ++n)
#pragma unroll
                            for (int j = 0; j < 4; ++j) v[4 * n + j] = acc[ai][bj][m][n][j];
                        if constexpr (KIND == EK_GATE) {
                            unsigned gb[8];
#pragma unroll
                            for (int j = 0; j < 8; ++j) { const float t = __builtin_amdgcn_fmed3f(fmaf(v[j], osc * 64.f, 512.5f), 0.f, 1023.f);
                                gb[j] = *(const LAS unsigned char*)(size_t)(lut + (unsigned)(int)t); }
                            u32x2 gw; gw.x = gb[0] | (gb[1] << 8) | (gb[2] << 16) | (gb[3] << 24); gw.y = gb[4] | (gb[5] << 8) | (gb[6] << 16) | (gb[7] << 24);
                            *(u32x2*)((unsigned char*)O + (size_t)row * ldo + col) = gw;
                        } else if constexpr (HAS_G) {
                            const u32x2 gw = gq[m * 2 + bj]; float gt[8];
#pragma unroll
                            for (int j = 0; j < 4; ++j) { gt[j] = (float)((gw.x >> (8 * j)) & 255u) * (osc * (1.f / 127.f)); gt[4 + j] = (float)((gw.y >> (8 * j)) & 255u) * (osc * (1.f / 127.f)); }
                            bf16_t* fp = (bf16_t*)F + (size_t)row * 1024 + col;
                            if constexpr (KIND == EK_BR0) {
                                float s[8];
#pragma unroll
                                for (int j = 0; j < 8; ++j) s[j] = gt[j] * v[j];
                                *(u32x4*)fp = pack8(s);
                            } else {
                                float s[8]; unpack8(sq[m * 2 + bj], s);
#pragma unroll
                                for (int j = 0; j < 8; ++j) s[j] += gt[j] * v[j];
                                if constexpr (KIND == EK_BR1) *(u32x4*)fp = pack8(s);
                                else *(u32x2*)((unsigned char*)O + (size_t)row * ldo + col) = pack8_i8(s, MSCALE);
                            }
                        } else if constexpr (KIND == EK_WOUT) {
                            float hv[8]; unpack8(sq[m * 2 + bj], hv);
#pragma unroll
                            for (int j = 0; j < 8; ++j) v[j] = v[j] * osc + DN_ALPHA * hv[j];
                            *(u32x4*)(O + (size_t)row * ldo + col) = pack8(v);
                        }
                    }
                }
                asm volatile("" ::: "memory");
            }
        }
    }
};
}

#define XB_TMO      128
#define XB_XCNT(j)  (256  + 64 * (j))
#define XB_XSUB(j)  (1280 + 64 * (j))
#define XB_XGEN(j)  (2304 + 64 * (j))
#define XB_TOP      3328
#define XB_TOPGEN   3392
#define XCD_BAR_WORDS 3456
#define XB_SPIN_CAP (1u << 20)
__device__ __forceinline__ unsigned xb_ld(unsigned* p)              { return __hip_atomic_load(p, __ATOMIC_RELAXED, __HIP_MEMORY_SCOPE_AGENT); }
__device__ __forceinline__ unsigned xb_add(unsigned* p, unsigned v) { return __hip_atomic_fetch_add(p, v, __ATOMIC_RELAXED, __HIP_MEMORY_SCOPE_AGENT); }
__device__ __forceinline__ unsigned xb_xcc_id() { return (unsigned)__builtin_amdgcn_s_getreg((3 << 11) | 20) & 0xFu; }
#define XB_SPIN(cond, bar) do { unsigned _sp = 0; while (cond) { __builtin_amdgcn_s_sleep(1); \
    if ((++_sp & 255u) == 0u) { if (xb_ld(&(bar)[XB_TMO])) break; if (_sp > XB_SPIN_CAP) { atomicAdd(&(bar)[XB_TMO], 1u); break; } } } } while (0)
struct XcdBarrier { unsigned* bar; unsigned x; volatile LAS unsigned* st; };
__device__ __forceinline__ XcdBarrier xcd_barrier_post(unsigned* bar, volatile LAS unsigned* st, int tid) {
    XcdBarrier b; b.bar = bar; b.x = xb_xcc_id(); b.st = st;
    if (tid == 0) (void)xb_add(&bar[XB_XCNT(b.x)], 1u);
    return b;
}
__device__ __forceinline__ void xcd_barrier_complete(unsigned* bar, unsigned x, unsigned& nloc, unsigned& nx) {
    const unsigned G = gridDim.x * gridDim.y * gridDim.z;
    unsigned sum, cnt, mine, sp = 0u;
    for (;;) {
        sum = 0u; cnt = 0u; mine = 0u;
#pragma unroll
        for (unsigned j = 0; j < 16; ++j) { const unsigned c = xb_ld(&bar[XB_XCNT(j)]); sum += c; cnt += (c > 0u) ? 1u : 0u; mine = (j == x) ? c : mine; }
        if (sum == G) break;
        __builtin_amdgcn_s_sleep(1);
        if ((++sp & 255u) == 0u) { if (xb_ld(&bar[XB_TMO])) break; if (sp > XB_SPIN_CAP) { atomicAdd(&bar[XB_TMO], 1u); break; } }
    }
    nloc = mine > 0u ? mine : 1u; nx = cnt > 0u ? cnt : 1u;
}
__device__ __forceinline__ void xcd_barrier(const XcdBarrier& b, int tid) {
    asm volatile("s_waitcnt vmcnt(0)" ::: "memory");
    __syncthreads();
    if (tid == 0) {
        unsigned* bar = b.bar;
        __builtin_amdgcn_s_waitcnt(0);
        unsigned nloc = b.st[0], nx = b.st[1];
        if (nloc == 0u) { xcd_barrier_complete(bar, b.x, nloc, nx); b.st[0] = nloc; b.st[1] = nx; }
        const unsigned old = xb_add(&bar[XB_XSUB(b.x)], 1u);
        const unsigned gen = old / nloc;
        if (old + 1u == (gen + 1u) * nloc) {
            __builtin_amdgcn_fence(__ATOMIC_RELEASE, "agent");
            asm volatile("s_waitcnt vmcnt(0)" ::: "memory");
            const unsigned og = xb_add(&bar[XB_TOP], 1u);
            const unsigned tg = og / nx;
            if (og + 1u == (tg + 1u) * nx) xb_add(&bar[XB_TOPGEN], 1u);
            else XB_SPIN(xb_ld(&bar[XB_TOPGEN]) == tg, bar);
            __builtin_amdgcn_fence(__ATOMIC_ACQUIRE, "agent");
            xb_add(&bar[XB_XGEN(b.x)], 1u);
            asm volatile("s_waitcnt vmcnt(0)" ::: "memory");
        } else {
            XB_SPIN(xb_ld(&bar[XB_XGEN(b.x)]) == gen, bar);
            __builtin_amdgcn_fence(__ATOMIC_ACQUIRE, "agent");
            asm volatile("s_waitcnt vmcnt(0)" ::: "memory");
        }
    }
    __syncthreads();
}

struct Args { const float* in[32]; float* out; unsigned char* ws; int lo, hi; };
typedef const __attribute__((address_space(4))) Args* ArgsP;
enum { I_X = 0, I_LN0G, I_LN0B, I_WIN, I_POOLW, I_POOLS, I_CKPE, I_CKW1, I_CKW2, I_CVPE, I_CVW1, I_CVW2, I_RELB, I_CONVW, I_CONVB, I_DTB, I_ALOG, I_DSKIP, I_SNG,
       I_WBP, I_WBN, I_WBS, I_WOUT, I_LN1G, I_LN1B, I_RW, I_RB, I_EW1, I_EW3, I_EW2, I_LN2G, I_LN2B };


struct Ctx {
    LAS unsigned char* lds;
    unsigned* ctl;
    unsigned char* ws; unsigned char* dout;
    int tid, lane, wave, G, vcu, gw, NGW;
};

struct Job { const float* src; size_t sbatch; int ldw, K, c0, ncols; bf16_t* dst; int dbatch_rows, ldt, drow0, mode, nbatch, fp8; float wsc; };
constexpr int NJOBS = 15;
__device__ __forceinline__ Job get_job(ArgsP a, int l, int j) {
    unsigned char* wl = a->ws + WS_W + (size_t)l * W_LAYER;
    bf16_t* win = (bf16_t*)(wl + WO_IN); bf16_t* wg = (bf16_t*)(wl + WO_GATE);
    const float* w_in = a->in[I_WIN] + (size_t)l * DM * D_IN;
    Job J; J.sbatch = 0; J.dbatch_rows = 0; J.mode = 0; J.nbatch = 1; J.c0 = 0; J.drow0 = 0; J.fp8 = 0; J.wsc = WSCALE;
    switch (j) {
    case 0:  J.src = w_in; J.ldw = D_IN; J.K = 1024; J.c0 = 0;    J.ncols = 1792; J.dst = win; J.ldt = 1024; J.drow0 = 0; J.fp8 = 1; break;
    case 1:  J.src = w_in; J.ldw = D_IN; J.K = 1024; J.c0 = 1792; J.ncols = 24;   J.dst = win; J.ldt = 1024; J.drow0 = C_NG; J.fp8 = 1; break;
    case 2:  J.src = w_in; J.ldw = D_IN; J.K = 1024; J.c0 = 1816; J.ncols = 3072; J.dst = win; J.ldt = 1024; J.drow0 = C_Z; J.fp8 = 1; break;
    case 3:  J.src = w_in; J.ldw = D_IN; J.K = 1024; J.c0 = 4888; J.ncols = 16;   J.dst = win; J.ldt = 1024; J.drow0 = C_DT; J.fp8 = 1; break;
    case 4:  J.src = w_in; J.ldw = D_IN; J.K = 1024; J.c0 = 4904; J.ncols = 3072; J.dst = wg;  J.ldt = 1024; J.drow0 = 0; J.fp8 = 1; break;
    case 5:  J.src = a->in[I_WBN] + (size_t)l * 512 * 1024;  J.ldw = 1024; J.K = 512;  J.ncols = 1024; J.dst = (bf16_t*)(wl + WO_C + 512); J.ldt = 1024; J.fp8 = 1; J.wsc = WSCALE_CN; break;
    case 6:  J.src = a->in[I_WBS] + (size_t)l * 1024 * 1024; J.ldw = 1024; J.K = 1024; J.ncols = 1024; J.dst = (bf16_t*)(wl + WO_SSD); J.ldt = 1024; J.fp8 = 1; break;
    case 7:  J.src = a->in[I_WOUT] + (size_t)l * 1024 * 1024; J.ldw = 1024; J.K = 1024; J.ncols = 1024; J.dst = (bf16_t*)(wl + WO_OUT); J.ldt = 1024; J.fp8 = 1; J.wsc = WSCALE_OUT; break;
    case 8:  J.src = a->in[I_CKW1] + (size_t)l * 2048 * 128; J.ldw = 128; J.K = 2048; J.ncols = 128; J.dst = (bf16_t*)(wl + WO_W1); J.ldt = 2048; break;
    case 9:  J.src = a->in[I_CVW1] + (size_t)l * 2048 * 128; J.ldw = 128; J.K = 2048; J.ncols = 128; J.dst = (bf16_t*)(wl + WO_W1) + 128 * 2048; J.ldt = 2048; break;
    case 10: J.src = a->in[I_CKW2] + (size_t)l * 128 * 64; J.ldw = 64; J.K = 128; J.ncols = 64; J.dst = (bf16_t*)(wl + WO_W2); J.ldt = 128; break;
    case 11: J.src = a->in[I_CVW2] + (size_t)l * 128 * 64; J.ldw = 64; J.K = 128; J.ncols = 64; J.dst = (bf16_t*)(wl + WO_W2) + 64 * 128; J.ldt = 128; break;
    case 12: J.src = a->in[I_EW1] + (size_t)l * 16 * 1024 * 512; J.sbatch = (size_t)1024 * 512; J.ldw = 512; J.K = 1024; J.ncols = 512; J.dst = (bf16_t*)(wl + WO_UP); J.dbatch_rows = 1024; J.ldt = 1024; J.drow0 = 0;   J.mode = 1; J.nbatch = 16; J.fp8 = 1; break;
    case 13: J.src = a->in[I_EW3] + (size_t)l * 16 * 1024 * 512; J.sbatch = (size_t)1024 * 512; J.ldw = 512; J.K = 1024; J.ncols = 512; J.dst = (bf16_t*)(wl + WO_UP); J.dbatch_rows = 1024; J.ldt = 1024; J.drow0 = 128; J.mode = 1; J.nbatch = 16; J.fp8 = 1; break;
    default: J.src = a->in[I_EW2] + (size_t)l * 16 * 512 * 1024; J.sbatch = (size_t)512 * 1024; J.ldw = 1024; J.K = 512; J.ncols = 1024; J.dst = (bf16_t*)(wl + WO_DN); J.dbatch_rows = 1024; J.ldt = 512; J.nbatch = 16; J.fp8 = 1; J.wsc = WSCALE_DN; break;
    }
    return J;
}
__device__ __forceinline__ void tr_item(const Job& J, int item, LAS float* scr, int lane) {
    const int nblk = (J.ncols + 31) >> 5, kblk = J.K >> 6, per = nblk * kblk;
    const int bt = item / per, r = item - bt * per, kb = r / nblk, nb = r - kb * nblk, k0 = 64 * kb, n0 = 32 * nb;
    const int nv = (J.ncols - n0) < 32 ? (J.ncols - n0) : 32;
    const float* W = J.src + (size_t)bt * J.sbatch;
    { const int nn = lane & 31; const float* wp = W + (size_t)(k0 + (lane >> 5)) * J.ldw + J.c0 + n0 + nn; float v[32];
#pragma unroll
      for (int i = 0; i < 32; ++i) v[i] = (nn < nv) ? wp[(size_t)(2 * i) * J.ldw] : 0.f;
#pragma unroll
      for (int i = 0; i < 32; ++i) scr[(2 * i + (lane >> 5)) * 33 + nn] = v[i]; }
    LDS_WAIT();
    const int c = lane & 7;
#pragma unroll
    for (int j = 0; j < 4; ++j) { const int n = (lane >> 3) + 8 * j;
        if (n < nv) {
            const LAS float* s = scr + (8 * c) * 33 + n; const int nn = n0 + n;
            const int drow = bt * J.dbatch_rows + J.drow0 + (J.mode == 1 ? ((nn >> 7) * 256 + (nn & 127)) : nn);
            if (J.fp8) { u32x2 o; o.x = cvt4_i8s(s[0 * 33], s[1 * 33], s[2 * 33], s[3 * 33], J.wsc); o.y = cvt4_i8s(s[4 * 33], s[5 * 33], s[6 * 33], s[7 * 33], J.wsc);
                *(u32x2*)((unsigned char*)J.dst + (size_t)drow * J.ldt + k0 + 8 * c) = o; }
            else { u32x4 o; o.x = cvt_pk_bf16(s[0 * 33], s[1 * 33]); o.y = cvt_pk_bf16(s[2 * 33], s[3 * 33]); o.z = cvt_pk_bf16(s[4 * 33], s[5 * 33]); o.w = cvt_pk_bf16(s[6 * 33], s[7 * 33]);
                *(u32x4*)(J.dst + (size_t)drow * J.ldt + k0 + 8 * c) = o; } } }
    LDS_WAIT();
}
__device__ __forceinline__ void ln_row_f32(const float* xrow, const float* g, const float* b, bf16_t* orow, unsigned char* orow8, int lane) {
    const f32x4* xr = (const f32x4*)xrow + lane; f32x4 v[4]; float s = 0.f;
#pragma unroll
    for (int j = 0; j < 4; ++j) { v[j] = xr[64 * j]; s += (v[j].x + v[j].y) + (v[j].z + v[j].w); }
    const float mean = wave_sum(s) * (1.f / DM); float s2 = 0.f;
#pragma unroll
    for (int j = 0; j < 4; ++j) { v[j] = v[j] - mean; s2 += (v[j].x * v[j].x + v[j].y * v[j].y) + (v[j].z * v[j].z + v[j].w * v[j].w); }
    const float rstd = 1.f / sqrtf(wave_sum(s2) * (1.f / DM) + LN_EPS);
    u32x2* o8 = (u32x2*)orow + lane;
#pragma unroll
    for (int j = 0; j < 4; ++j) { const f32x4 gg = ((const f32x4*)g + lane)[64 * j], bb = ((const f32x4*)b + lane)[64 * j];
        const float y0 = v[j].x * rstd * gg.x + bb.x, y1 = v[j].y * rstd * gg.y + bb.y, y2 = v[j].z * rstd * gg.z + bb.z, y3 = v[j].w * rstd * gg.w + bb.w;
        u32x2 w; w.x = cvt_pk_bf16(y0, y1); w.y = cvt_pk_bf16(y2, y3); o8[64 * j] = w;
        ((unsigned*)orow8 + lane)[64 * j] = cvt4_i8s(y0, y1, y2, y3, ASCALE); }
}
__device__ __forceinline__ int rel_bucket_dev(int n) {
    if (n < 16) return n;
    int b = 16;
    b += (n >= 19) + (n >= 21) + (n >= 24) + (n >= 27) + (n >= 31) + (n >= 35) + (n >= 40) + (n >= 46) + (n >= 52) + (n >= 59) + (n >= 67) + (n >= 77) + (n >= 87) + (n >= 99) + (n >= 113);
    return b;
}
__device__ __forceinline__ void p0_prologue(const Ctx& F, ArgsP a) {
    LAS float* scr = (LAS float*)(F.lds + F.wave * 16384);
    int base = 0;
    for (int l = 0; l < DEPTH; ++l)
        for (int j = 0; j < NJOBS; ++j) {
            const Job J = get_job(a, l, j);
            const int nitems = J.nbatch * (J.K >> 6) * ((J.ncols + 31) >> 5);
            int first = (F.gw - base) % F.NGW; if (first < 0) first += F.NGW;
            for (int it = first; it < nitems; it += F.NGW) tr_item(J, it, scr, F.lane);
            base = (base + nitems) % F.NGW;
        }
    { bf16_t* H = (bf16_t*)(a->ws + WS_H);
      for (int m = F.gw; m < T_; m += F.NGW) ln_row_f32(a->in[I_X] + (size_t)m * DM, a->in[I_LN0G], a->in[I_LN0B], H + (size_t)m * DM, a->ws + WS_H8 + (size_t)m * DM, F.lane); }
    { const int gt = blockIdx.x * 512 + F.tid, nthr = F.G * 512;
      for (int id = gt; id < DEPTH * 65536; id += nthr) {
          const int l = id >> 16, r = id & 65535, n = r & 1023, k8 = r >> 10, g = k8 >> 4, c0 = (k8 & 15) * 8;
          const float* pw = a->in[I_POOLW] + (size_t)l * 4 * 128 * 128 + (size_t)(g * 128 + c0) * 128;
          const float* sc = a->in[I_POOLS] + l * 512 + g * 128;
          const float* wb = a->in[I_WBP] + (size_t)l * 512 * 1024 + (size_t)(g * 128) * 1024 + n;
          float pwr[8][2], scr2[2];
#pragma unroll
          for (int i = 0; i < 8; ++i) { pwr[i][0] = pw[i * 128 + F.lane]; pwr[i][1] = pw[i * 128 + 64 + F.lane]; }
          scr2[0] = sc[F.lane]; scr2[1] = sc[64 + F.lane];
          float acc[8] = {0.f, 0.f, 0.f, 0.f, 0.f, 0.f, 0.f, 0.f};
#pragma unroll
          for (int hf = 0; hf < 2; ++hf)
#pragma unroll 16
              for (int dd = 0; dd < 64; ++dd) { const int d = 64 * hf + dd;
                  const float w = wb[(size_t)d * 1024] * __int_as_float(__builtin_amdgcn_readlane(__float_as_int(scr2[hf]), dd));
#pragma unroll
                  for (int i = 0; i < 8; ++i) acc[i] += __int_as_float(__builtin_amdgcn_readlane(__float_as_int(pwr[i][hf]), dd)) * w; }
          unsigned char* dst = a->ws + WS_W + (size_t)l * W_LAYER + WO_C + (size_t)n * 1024 + g * 128 + c0;
          *(u32x2*)dst = pack8_i8(acc, WSCALE_CN);
      } }
    for (int o = F.gw; o < DEPTH * 2 * 128; o += F.NGW) {
        const int l = o >> 8, kv = (o >> 7) & 1, col = o & 127;
        const float* pe = a->in[kv ? I_CVPE : I_CKPE] + (size_t)l * 2048; const float* w1 = a->in[kv ? I_CVW1 : I_CKW1] + (size_t)l * 2048 * 128 + col;
        float s = 0.f;
        for (int k = F.lane; k < 2048; k += 64) s += pe[k] * w1[(size_t)k * 128];
        s = wave_sum(s);
        if (F.lane == 0) ((float*)(a->ws + WS_MISC + MI_B1))[o] = s;
    }
    if (blockIdx.x == 0) {
        float* bt = (float*)(a->ws + WS_MISC + MI_BIAS);
        for (int i = F.tid; i < 8 * 128; i += 512) { const int hd = i >> 7, d = i & 127;
            bt[i] = (a->in[I_RELB][rel_bucket_dev(d) * 8 + hd] - a->in[I_RELB][31 * 8 + hd]) * LOG2E; }
    }
}

__device__ __forceinline__ void conv_phase(const Ctx& F, const bf16_t* P, bf16_t* XC, const float* cw, const float* cb) {
    const int gt = blockIdx.x * 512 + F.tid, nthr = F.G * 512;
    const int c = gt & 255;
    float w[4][8], b[8];
#pragma unroll
    for (int k = 0; k < 4; ++k)
#pragma unroll
        for (int i = 0; i < 8; ++i) w[k][i] = cw[k * 2048 + 8 * c + i] * (1.f / P8SCALE);
#pragma unroll
    for (int i = 0; i < 8; ++i) b[i] = cb[8 * c + i];
    for (int id = gt; id < (TG / 16) * 256; id += nthr) {
        const int tl0 = (id >> 8) * 16, s0 = tl0 & (SEQ - 1);
        u32x2 raw[19];
#pragma unroll
        for (int r = 0; r < 19; ++r) raw[r] = (s0 + r - 3 >= 0) ? *(const u32x2*)((const unsigned char*)P + (size_t)(tl0 + r - 3) * LDP * 2 + 2 * C_XBC + 8 * c) : (u32x2){0u, 0u};
#pragma unroll
        for (int i = 0; i < 16; ++i) {
            float acc[8];
#pragma unroll
            for (int j = 0; j < 8; ++j) acc[j] = b[j];
#pragma unroll
            for (int k = 0; k < 4; ++k) { float x[8]; unpack8_i8(raw[i + k], x);
#pragma unroll
                for (int j = 0; j < 8; ++j) acc[j] += w[k][j] * x[j]; }
#pragma unroll
            for (int j = 0; j < 8; ++j) acc[j] = siluf_(acc[j]);
            *(u32x4*)(XC + (size_t)(tl0 + i) * 2048 + 8 * c) = pack8(acc);
        }
    }
}
__device__ __forceinline__ void compress_unit(const Ctx& F, int cu, const bf16_t* P, const bf16_t* W1t, const bf16_t* W2t, const float* b1, bf16_t* KC, bf16_t* VC) {
    const int kv = cu & 1, g = (cu >> 1) & 1, nb = (cu >> 2) & 7, bl = cu >> 5;
    const int lane = F.lane, w = F.wave, fr = lane & 15, fq = lane >> 4;
    LAS bf16_t* hid = (LAS bf16_t*)F.lds;
    const bf16_t* w1 = W1t + (size_t)kv * 128 * 2048 + (size_t)(16 * w + fr) * 2048 + 8 * fq;
    int n0 = nb * 16 + fr; if (n0 > 126) n0 = 126;
    const bf16_t* a0 = P + (size_t)(bl * SEQ + 16 * n0) * LDP + C_KV + kv * 128 + g * 64 + 8 * fq;
    f32x4 acc0 = {0.f, 0.f, 0.f, 0.f}, acc1 = {0.f, 0.f, 0.f, 0.f};
#pragma unroll 8
    for (int kk = 0; kk < 64; kk += 2) {
        const int l = kk >> 1;
        const bf16x8 bb0 = *(const bf16x8*)(w1 + kk * 32), bb1 = *(const bf16x8*)(w1 + kk * 32 + 32);
        const bf16x8 x0 = *(const bf16x8*)(a0 + (size_t)l * LDP), x1 = *(const bf16x8*)(a0 + (size_t)l * LDP + 32);
        acc0 = mfma16(x0, bb0, acc0); acc1 = mfma16(x1, bb1, acc1);
    }
    const float bias = b1[kv * 128 + 16 * w + fr];
#pragma unroll
    for (int r = 0; r < 4; ++r) { const float x = acc0[r] + acc1[r] + bias, u = 0.7978845608f * (x + 0.044715f * x * x * x); hid[(4 * fq + r) * 136 + 16 * w + fr] = f2bf(x * sigmoidf_(2.f * u)); }
    __syncthreads();
    if (w < 4) { f32x4 acc = {0.f, 0.f, 0.f, 0.f};
      const bf16_t* w2 = W2t + (size_t)kv * 64 * 128 + (size_t)(16 * w + fr) * 128 + 8 * fq;
#pragma unroll
      for (int ks = 0; ks < 4; ++ks) { const bf16x8 aa = *(const LAS bf16x8*)(hid + fr * 136 + ks * 32 + 8 * fq); const bf16x8 bb = *(const bf16x8*)(w2 + ks * 32); acc = mfma16(aa, bb, acc); }
      bf16_t* dst = kv ? VC : KC;
#pragma unroll
      for (int r = 0; r < 4; ++r) { const int n = nb * 16 + 4 * fq + r; if (n < 127) dst[(size_t)(bl * 128 + n) * 128 + g * 64 + 16 * w + fr] = f2bf(acc[r]); }
    }
    __syncthreads();
}

template <int WIN>
__device__ __forceinline__ void pool_item(const bf16_t* P, bf16_t* R, int grp, int rq, int lane) {
    const int c = 16 * grp + (lane & 15), tl0 = (4 * rq + (lane >> 4)) * 8, s0 = tl0 & (SEQ - 1);
    constexpr int NROW = 7 + WIN;
    u32x2 raw[NROW];
#pragma unroll
    for (int k = 0; k < NROW; ++k) { const int sp = s0 - (WIN - 1) + k; raw[k] = (sp >= 0) ? *(const u32x2*)((const unsigned char*)P + (size_t)(tl0 - (WIN - 1) + k) * LDP * 2 + 2 * C_POOL + 8 * c) : (u32x2){0u, 0u}; }
    float sum[8] = {0.f, 0.f, 0.f, 0.f, 0.f, 0.f, 0.f, 0.f};
#pragma unroll
    for (int k = 0; k < WIN - 1; ++k) { float x[8]; unpack8_i8(raw[k], x);
#pragma unroll
        for (int q = 0; q < 8; ++q) sum[q] += x[q]; }
#pragma unroll
    for (int i = 0; i < 8; ++i) {
        float u0[8], o[8]; unpack8_i8(raw[i + WIN - 1], u0);
#pragma unroll
        for (int q = 0; q < 8; ++q) sum[q] += u0[q];
        const int s = s0 + i, cnt = (s + 1) < WIN ? (s + 1) : WIN; const float inv = 1.f / (float)cnt;
#pragma unroll
        for (int q = 0; q < 8; ++q) o[q] = sum[q] * inv - u0[q];
        *(u32x2*)((unsigned char*)R + (size_t)(tl0 + i) * 1024 + 8 * c) = pack8_i8(o, RSCALE / P8SCALE);
        { u32x2 lv = raw[i]; asm volatile("" : "+v"(lv.x), "+v"(lv.y)); float x[8]; unpack8_i8(lv, x);
#pragma unroll
          for (int q = 0; q < 8; ++q) sum[q] -= x[q]; }
    }
}
__device__ __forceinline__ void fin_phase(const Ctx& F, const bf16_t* P, bf16_t* R, const bf16_t* Y, unsigned char* Y8, const float* normg) {
    for (int wi = F.gw; wi < 4 * (TG / 32); wi += F.NGW) {
        const int grp = wi & 3, rq = wi >> 2;
        if (grp == 0) pool_item<2>(P, R, 0, rq, F.lane); else if (grp == 1) pool_item<4>(P, R, 1, rq, F.lane); else if (grp == 2) pool_item<8>(P, R, 2, rq, F.lane); else pool_item<16>(P, R, 3, rq, F.lane);
    }
    const int lane = F.lane;
    float ng[16];
#pragma unroll
    for (int i = 0; i < 16; ++i) ng[i] = normg[16 * lane + i];
    u32x4 nx[3];
#define FIN_LOAD(tl_) do { nx[0] = *(const u32x4*)(Y + (size_t)(tl_) * 1024 + 16 * lane); nx[1] = *(const u32x4*)(Y + (size_t)(tl_) * 1024 + 16 * lane + 8); \
        nx[2] = *(const u32x4*)((const unsigned char*)P + (size_t)(tl_) * LDP * 2 + 2 * C_Z + 16 * lane); } while (0)
    if (F.gw < TG) FIN_LOAD(F.gw);
    for (int tl = F.gw; tl < TG; tl += F.NGW) {
        const u32x4 c0 = nx[0], c1 = nx[1], c2 = nx[2];
        if (tl + F.NGW < TG) FIN_LOAD(tl + F.NGW);
        float y[16], z[16];
        { float t[8]; unpack8(c0, t);
#pragma unroll
          for (int i = 0; i < 8; ++i) y[i] = t[i];
          unpack8(c1, t);
#pragma unroll
          for (int i = 0; i < 8; ++i) y[8 + i] = t[i];
          unpack4_i8(c2.x, z); unpack4_i8(c2.y, z + 4); unpack4_i8(c2.z, z + 8); unpack4_i8(c2.w, z + 12);
#pragma unroll
          for (int i = 0; i < 16; ++i) z[i] *= (1.f / P8SCALE); }
        float ss = 0.f;
#pragma unroll
        for (int i = 0; i < 16; ++i) { y[i] *= z[i]; ss += y[i] * y[i]; }
        ss += __shfl_xor(ss, 1); ss += __shfl_xor(ss, 2); ss += __shfl_xor(ss, 4); ss += __shfl_xor(ss, 8);
        const float rstd = 1.f / sqrtf(ss * (1.f / 256.f) + LN_EPS);
        float o[8];
#pragma unroll
        for (int i = 0; i < 8; ++i) o[i] = y[i] * rstd * ng[i];
        *(u32x2*)(Y8 + (size_t)tl * 1024 + 16 * lane) = pack8_i8(o, YSCALE);
#pragma unroll
        for (int i = 0; i < 8; ++i) o[i] = y[8 + i] * rstd * ng[8 + i];
        *(u32x2*)(Y8 + (size_t)tl * 1024 + 16 * lane + 8) = pack8_i8(o, YSCALE);
    }
#undef FIN_LOAD
}

#ifndef NSA_X1
#define NSA_X1 0
#endif
#ifndef NSA_X2
#define NSA_X2 0
#endif
#ifndef SSD_REP
#define SSD_REP 0
#endif
#ifndef NSA_REP
#define NSA_REP 0
#endif
constexpr int NL_KT = 0, NL_VT = 32768, NL_BIAS = 65536, NL_IMP = 73728, NL_SEL = 107520, NL_UNI = 107776;
__device__ __forceinline__ void glds16(const void* gsrc, unsigned lds_dst) { unsigned keep;
    asm volatile("s_mov_b32 %0, m0\n\ts_mov_b32 m0, %2\n\ts_nop 0\n\tglobal_load_lds_dwordx4 %1, off\n\ts_mov_b32 m0, %0" : "=&s"(keep) : "v"(gsrc), "s"(lds_dst) : "memory"); }
#define NSA_WAITBAR(N) asm volatile("s_waitcnt vmcnt(" #N ") lgkmcnt(0)\n\ts_barrier" ::: "memory")

#define NSA_STORE_TILE(buf) do { \
    *(LAS u32x4*)(lds + NL_KT + (buf) * 8192 + (tid >> 6) * 1024 + (tid & 63) * 16) = kreg; \
    *(LAS u32x4*)(lds + NL_VT + (buf) * 8192 + ((tid & 7) >> 2) * 4096 + (tid >> 3) * 64 + (tid & 3) * 16) = vreg; } while (0)

__device__ __forceinline__ void nsa_kload(const LAS unsigned char* Kt, int r32, int hi, bf16x8 (&kf)[8]) {
#pragma unroll
    for (int d0 = 0; d0 < 4; ++d0) { kf[2 * d0] = *(const LAS bf16x8*)(Kt + (2 * d0 + hi) * 1024 + r32 * 16); kf[2 * d0 + 1] = *(const LAS bf16x8*)(Kt + (2 * d0 + hi) * 1024 + 512 + r32 * 16); }
}
__device__ __forceinline__ void nsa_qk_f(const bf16x8 (&kf)[8], const bf16x8 (&qB)[4], f32x16& p0, f32x16& p1) {
    p0 = (f32x16){0.f, 0.f, 0.f, 0.f, 0.f, 0.f, 0.f, 0.f, 0.f, 0.f, 0.f, 0.f, 0.f, 0.f, 0.f, 0.f}; p1 = p0;
#pragma unroll
    for (int d0 = 0; d0 < 4; ++d0) { p0 = mfma32(kf[2 * d0], qB[d0], p0); p1 = mfma32(kf[2 * d0 + 1], qB[d0], p1); }
}
__device__ __forceinline__ void nsa_qk(const LAS unsigned char* Kt, const bf16x8 (&qB)[4], int r32, int hi, f32x16& p0, f32x16& p1) {
    bf16x8 kf[8]; nsa_kload(Kt, r32, hi, kf); nsa_qk_f(kf, qB, p0, p1);
}
__device__ __forceinline__ void nsa_vload(const LAS unsigned char* Vt, int lane, int hi, bf16x8 (&vf)[8]) {
    const LAS unsigned char* vb = Vt + (4 * hi + ((lane & 15) >> 2)) * 64 + ((lane >> 4) & 1) * 32 + (lane & 3) * 8;
#pragma unroll
    for (int ks = 0; ks < 4; ++ks) { vf[2 * ks] = cat8(trrd(vb + ks * 1024), trrd(vb + ks * 1024 + 512)); vf[2 * ks + 1] = cat8(trrd(vb + 4096 + ks * 1024), trrd(vb + 4096 + ks * 1024 + 512)); }
}
__device__ __forceinline__ void nsa_pack(const f32x16& p0, const f32x16& p1, bool keep, bf16x8 (&pB)[4]) {
    { u32x4 t; t.x = cvt_pk_bf16(p0[0], p0[1]); t.y = cvt_pk_bf16(p0[2], p0[3]); t.z = cvt_pk_bf16(p0[4], p0[5]); t.w = cvt_pk_bf16(p0[6], p0[7]); pB[0] = __builtin_bit_cast(bf16x8, t);
      t.x = cvt_pk_bf16(p0[8], p0[9]); t.y = cvt_pk_bf16(p0[10], p0[11]); t.z = cvt_pk_bf16(p0[12], p0[13]); t.w = cvt_pk_bf16(p0[14], p0[15]); pB[1] = __builtin_bit_cast(bf16x8, t);
      t.x = cvt_pk_bf16(p1[0], p1[1]); t.y = cvt_pk_bf16(p1[2], p1[3]); t.z = cvt_pk_bf16(p1[4], p1[5]); t.w = cvt_pk_bf16(p1[6], p1[7]); pB[2] = __builtin_bit_cast(bf16x8, t);
      t.x = cvt_pk_bf16(p1[8], p1[9]); t.y = cvt_pk_bf16(p1[10], p1[11]); t.z = cvt_pk_bf16(p1[12], p1[13]); t.w = cvt_pk_bf16(p1[14], p1[15]); pB[3] = __builtin_bit_cast(bf16x8, t); }
    if (!keep) { const bf16x8 z = {0, 0, 0, 0, 0, 0, 0, 0}; pB[0] = z; pB[1] = z; pB[2] = z; pB[3] = z; }
}
__device__ __forceinline__ void nsa_pv_f(const bf16x8 (&vf)[8], const bf16x8 (&pB)[4], f32x16& o0, f32x16& o1) {
#pragma unroll
    for (int ks = 0; ks < 4; ++ks) { o0 = mfma32(vf[2 * ks], pB[ks], o0); o1 = mfma32(vf[2 * ks + 1], pB[ks], o1); }
}
__device__ __forceinline__ void nsa_pv(const LAS unsigned char* Vt, int lane, int hi, const f32x16& p0, const f32x16& p1, f32x16& o0, f32x16& o1, bool keep = true) {
    bf16x8 vf[8], pB[4]; nsa_vload(Vt, lane, hi, vf); nsa_pack(p0, p1, keep, pB); nsa_pv_f(vf, pB, o0, o1);
}

template <int MODE>
__device__ __forceinline__ void nsa_smp(int j, f32x16& p0, f32x16& p1, int qt, int ql, unsigned mysel, const LAS float* biasH, int hi, float& l, bf16x8 (&pB)[4]) {
    const int dj = qt - j;
    const bool selq = (MODE == 1) ? (((mysel >> j) & 1u) != 0u) : true;
    if (dj <= 2) {
        const LAS float* tb = biasH + (64 * dj + ql - 4 * hi + 64);
#pragma unroll
        for (int r = 0; r < 16; ++r) { p0[r] += tb[-((r & 3) + 8 * (r >> 2))]; p1[r] += tb[-((r & 3) + 8 * (r >> 2)) - 32]; }
    } else if (MODE == 2 && dj == 8) {
        const int dq = 512 + ql - 4 * hi;
#pragma unroll
        for (int r = 0; r < 16; ++r) { const int d0 = dq - ((r & 3) + 8 * (r >> 2)); p0[r] = (d0 < 512) ? p0[r] : NEGBIG; p1[r] = (d0 - 32 < 512) ? p1[r] : NEGBIG; }
    }
    f32x2 ls2 = {0.f, 0.f};
#pragma unroll
    for (int r = 0; r < 16; ++r) { p0[r] = fexp2(p0[r]); p1[r] = fexp2(p1[r]); ls2 += (f32x2){p0[r], p1[r]}; }
    l += selq ? (ls2.x + ls2.y) : 0.f;
    nsa_pack(p0, p1, selq, pB);
}

template <int MODE>
__device__ __forceinline__ void nsa_branch(const Ctx& F, const bf16_t* Kg, const bf16_t* Vg, unsigned tiles, int qt, int ql, unsigned mysel,
                                           const LAS float* biasH, const bf16_t* qptr, float gate, f32x16& out0, f32x16& out1) {
    LAS unsigned char* lds = F.lds; int tid_ = F.tid; asm volatile("" : "+v"(tid_)); const int tid = tid_, lane = tid & 63, r32 = lane & 31, hi = lane >> 5;
    bf16x8 qB[4];
#pragma unroll
    for (int d0 = 0; d0 < 4; ++d0) qB[d0] = *(const bf16x8*)(qptr + 16 * d0);
    float l = 0.f;
    f32x16 o0 = (f32x16){0.f, 0.f, 0.f, 0.f, 0.f, 0.f, 0.f, 0.f, 0.f, 0.f, 0.f, 0.f, 0.f, 0.f, 0.f, 0.f}, o1 = o0;
    const int w = F.wave;
    const unsigned lbase = (unsigned)(size_t)lds;
    const bf16_t* ksrc = Kg + (size_t)lane * LDP + 8 * w;
    const bf16_t* vsrc = Vg + (size_t)(16 * (w & 3) + (lane >> 2)) * LDP + (w >> 2) * 32 + (lane & 3) * 8;
    const unsigned kdst = (unsigned)__builtin_amdgcn_readfirstlane((int)(lbase + NL_KT + w * 1024)), vdst = (unsigned)__builtin_amdgcn_readfirstlane((int)(lbase + NL_VT + (w >> 2) * 4096 + (w & 3) * 1024));
#define NSA_DMA(jj, slot) do { glds16(ksrc + (size_t)(jj) * 64 * LDP, kdst + (slot) * 8192); glds16(vsrc + (size_t)(jj) * 64 * LDP, vdst + (slot) * 8192); } while (0)
#define NSA_POP(dst) do { if (rem) { dst = (MODE == 1) ? (__ffs(rem) - 1) : (31 - __clz(rem)); rem &= ~(1u << dst); } else dst = -1; } while (0)
    unsigned rem = tiles; int jp, cur, nxt;
    NSA_POP(jp); NSA_POP(cur);
    NSA_DMA(jp, 0); if (cur >= 0) NSA_DMA(cur, 1);
    f32x16 pp0, pp1;
    if (cur >= 0) NSA_WAITBAR(2); else NSA_WAITBAR(0);
    NSA_POP(nxt); if (nxt >= 0) NSA_DMA(nxt, 2);
    nsa_qk(lds + NL_KT, qB, r32, hi, pp0, pp1);
    int bufp = 0, buf = 1;
    while (cur >= 0) {
        if (nxt >= 0) NSA_WAITBAR(2); else NSA_WAITBAR(0);
        int q; NSA_POP(q);
        if (q >= 0) NSA_DMA(q, (buf + 2) & 3);
        { bf16x8 kf[8], vf[8], pB[4];
          nsa_vload(lds + NL_VT + bufp * 8192, lane, hi, vf);
          nsa_smp<MODE>(jp, pp0, pp1, qt, ql, mysel, biasH, hi, l, pB);
          nsa_kload(lds + NL_KT + buf * 8192, r32, hi, kf);
          nsa_pv_f(vf, pB, o0, o1);
          nsa_qk_f(kf, qB, pp0, pp1); }
        jp = cur; bufp = buf; cur = nxt; nxt = q; buf = (buf + 1) & 3;
    }
    { bf16x8 vf[8], pB[4]; nsa_vload(lds + NL_VT + bufp * 8192, lane, hi, vf); nsa_smp<MODE>(jp, pp0, pp1, qt, ql, mysel, biasH, hi, l, pB); nsa_pv_f(vf, pB, o0, o1); }
#undef NSA_DMA
#undef NSA_POP
    __syncthreads();
    const float lt = l + __shfl_xor(l, 32), sc = gate * frcp(lt);
#pragma unroll
    for (int r = 0; r < 16; ++r) { out0[r] += sc * o0[r]; out1[r] += sc * o1[r]; }
}

__device__ __forceinline__ void nsa_unit(const Ctx& F, int bl, int g, int qt, const bf16_t* P, const bf16_t* KC, const bf16_t* VC, const float* biasT, bf16_t* YB) {
    LAS unsigned char* lds = F.lds; int tid_ = F.tid; asm volatile("" : "+v"(tid_)); const int tid = tid_, lane = tid & 63, w = F.wave, r32 = lane & 31, hi = lane >> 5;
    const int h = w >> 1, ql = 32 * (w & 1) + r32, t = 64 * qt + ql;
    const size_t row = (size_t)bl * SEQ + t;
    if (tid == 0) *(LAS unsigned*)(lds + NL_UNI) = 0u;
    const bf16_t* qptr = P + row * LDP + C_Q + g * 256 + h * 64 + 8 * hi;
    const float g_c = sigmoidf_(bf1(P[row * LDP + C_NG + g * 4 + h])), g_s = sigmoidf_(bf1(P[row * LDP + C_NG + 8 + g * 4 + h])), g_w = sigmoidf_(bf1(P[row * LDP + C_NG + 16 + g * 4 + h]));
    const LAS float* biasH = (const LAS float*)(lds + NL_BIAS) + (g * 4 + h) * 256;
    f32x16 out0 = (f32x16){0.f, 0.f, 0.f, 0.f, 0.f, 0.f, 0.f, 0.f, 0.f, 0.f, 0.f, 0.f, 0.f, 0.f, 0.f, 0.f}, out1 = out0;

    const int ntile = (qt >= 16) ? 2 : 1;
    for (int tl = 0; tl < ntile; ++tl) {
        int nk = 64 * tl + (tid & 63); if (nk > 126) nk = 126;
        int nv = 64 * tl + (tid >> 3); if (nv > 126) nv = 126;
        const u32x4 kreg = *(const u32x4*)(KC + (size_t)(bl * 128 + nk) * 128 + g * 64 + 8 * (tid >> 6));
        const u32x4 vreg = *(const u32x4*)(VC + (size_t)(bl * 128 + nv) * 128 + g * 64 + 8 * (tid & 7));
        NSA_STORE_TILE(tl);
    }
    __syncthreads();
    {
        f32x16 s0, s1, s2, s3;
        { bf16x8 qB[4];
#pragma unroll
          for (int d0 = 0; d0 < 4; ++d0) qB[d0] = *(const bf16x8*)(qptr + 16 * d0);
          nsa_qk(lds + NL_KT, qB, r32, hi, s0, s1);
          if (ntile == 2) nsa_qk(lds + NL_KT + 8192, qB, r32, hi, s2, s3);
          else { s2 = (f32x16){0.f, 0.f, 0.f, 0.f, 0.f, 0.f, 0.f, 0.f, 0.f, 0.f, 0.f, 0.f, 0.f, 0.f, 0.f, 0.f}; s3 = s2; } }
        const int db = t - 31 - 64 * hi;
        float mx = NEGBIG;
#define CMP_MASK(S, V) _Pragma("unroll") for (int r = 0; r < 16; ++r) { const int d = db - 16 * (32 * (V) + (r & 3) + 8 * (r >> 2)); \
            const int c = d < 0 ? 0 : (d > 127 ? 127 : d); S[r] = (d >= 0) ? S[r] + biasH[64 + c] : NEGBIG; mx = fmaxf(mx, S[r]); }
        CMP_MASK(s0, 0) CMP_MASK(s1, 1)
        if (ntile == 2) { CMP_MASK(s2, 2) CMP_MASK(s3, 3) }
#undef CMP_MASK
        mx = fmaxf(mx, __shfl_xor(mx, 32));
        float ls = 0.f;
#define CMP_EXP(S) _Pragma("unroll") for (int r = 0; r < 16; ++r) { S[r] = (S[r] > -1e29f) ? fexp2(S[r] - mx) : 0.f; ls += S[r]; }
        CMP_EXP(s0) CMP_EXP(s1)
        if (ntile == 2) { CMP_EXP(s2) CMP_EXP(s3) }
#undef CMP_EXP
        ls += __shfl_xor(ls, 32);
        const float inv = ls > 0.f ? 1.f / ls : 0.f;
#pragma unroll
        for (int r = 0; r < 16; ++r) { s0[r] *= inv; s1[r] *= inv; s2[r] *= inv; s3[r] *= inv; }
        LAS float* I = (LAS float*)(lds + NL_IMP) + (h * 64 + ql) * 33 + hi;
        float yprev = 0.f;
#define CMP_IMP(S, V) _Pragma("unroll") for (int a = 0; a < 4; ++a) { const float own = S[4 * a] + S[4 * a + 1] + S[4 * a + 2] + 0.5f * S[4 * a + 3]; \
            const float y = __shfl_xor(0.5f * S[4 * a + 3], 32); I[2 * (4 * (V) + a)] = own + (hi ? y : yprev); yprev = y; }
        CMP_IMP(s0, 0) CMP_IMP(s1, 1) CMP_IMP(s2, 2) CMP_IMP(s3, 3)
#undef CMP_IMP
        f32x16 o0 = (f32x16){0.f, 0.f, 0.f, 0.f, 0.f, 0.f, 0.f, 0.f, 0.f, 0.f, 0.f, 0.f, 0.f, 0.f, 0.f, 0.f}, o1 = o0;
        nsa_pv(lds + NL_VT, lane, hi, s0, s1, o0, o1);
        if (ntile == 2) nsa_pv(lds + NL_VT + 8192, lane, hi, s2, s3, o0, o1);
#pragma unroll
        for (int r = 0; r < 16; ++r) { out0[r] += g_c * o0[r]; out1[r] += g_c * o1[r]; }
    }
    __syncthreads();
    if (w == 0) {
        const LAS float* I = (const LAS float*)(lds + NL_IMP) + lane * 33;
        float v[32];
#pragma unroll
        for (int jj = 0; jj < 32; ++jj) v[jj] = (I[jj] + I[64 * 33 + jj]) + (I[128 * 33 + jj] + I[192 * 33 + jj]);
        unsigned sel = 1u | (1u << qt) | (qt >= 1 ? (1u << (qt - 1)) : 0u);
        const int need = 8 - __popc(sel);
#pragma unroll
        for (int it = 0; it < 5; ++it) {
            if (it < need) {
                int best = -1; float bv = -1e30f;
#pragma unroll
                for (int jj = 1; jj < 32; ++jj) { const bool ok = (jj <= qt - 2) && (((sel >> jj) & 1u) == 0u) && (v[jj] > bv); bv = ok ? v[jj] : bv; best = ok ? jj : best; }
                if (best >= 0) sel |= 1u << best;
            }
        }
        ((LAS unsigned*)(lds + NL_SEL))[lane] = sel;
        atomicOr((unsigned*)(lds + NL_UNI), sel);
    }
    __syncthreads();
    const unsigned uni = *(const LAS unsigned*)(lds + NL_UNI) & ((qt >= 31) ? 0xffffffffu : ((2u << qt) - 1u));
    const unsigned mysel = ((const LAS unsigned*)(lds + NL_SEL))[ql];
    const bf16_t* Pb = P + (size_t)bl * SEQ * LDP + C_KV + g * 64;
    nsa_branch<1>(F, Pb + 256, Pb + 384, uni, qt, ql, mysel, biasH, qptr, g_s, out0, out1);
    { const int lo = qt >= 8 ? qt - 8 : 0; const unsigned wm = (((qt >= 31) ? 0xffffffffu : ((2u << qt) - 1u)) >> lo) << lo;
      nsa_branch<2>(F, Pb + 512, Pb + 640, wm, qt, ql, 0u, biasH, qptr, g_w, out0, out1); }
    unsigned char* yo = (unsigned char*)YB + row * 1024 + 512 + g * 256 + h * 64 + 4 * hi;
#pragma unroll
    for (int a = 0; a < 4; ++a) {
        *(unsigned*)(yo + 8 * a) = cvt4_i8s(out0[4 * a], out0[4 * a + 1], out0[4 * a + 2], out0[4 * a + 3], BSCALE);
        *(unsigned*)(yo + 32 + 8 * a) = cvt4_i8s(out1[4 * a], out1[4 * a + 1], out1[4 * a + 2], out1[4 * a + 3], BSCALE);
    }
    __syncthreads();
}

#define LDS_BARRIER() asm volatile("s_waitcnt lgkmcnt(0)\n\ts_barrier" ::: "memory")
constexpr int SL_CT = 0, SL_BT = 34816, SL_XT = 69632, SL_XD = 77824, SL_XW = 86016, SL_HT = 94208, SL_YO = 102912, SL_AW = 119296, SL_DW = 123392;
__device__ __forceinline__ void ssd_diag(const LAS unsigned char* lds, const LAS float* A_, const bf16x8 (&bbC)[8], int si, int li, int r32, int hi, int q4, int p4, int g1, f32x16& y) {
    const int lidx = 32 * li + r32; const float acl = A_[lidx];
    f32x16 s = (f32x16){0.f, 0.f, 0.f, 0.f, 0.f, 0.f, 0.f, 0.f, 0.f, 0.f, 0.f, 0.f, 0.f, 0.f, 0.f, 0.f};
#pragma unroll
    for (int kk = 0; kk < 8; ++kk) {
        const bf16x8 aa = *(const LAS bf16x8*)(lds + SL_BT + (32 * si + r32) * 272 + (16 * kk + 8 * hi) * 2);
        s = mfma32(aa, bbC[kk], s);
    }
    f32x4 av[4];
#pragma unroll
    for (int q = 0; q < 4; ++q) av[q] = *(const LAS f32x4*)(A_ + 32 * si + 4 * hi + 8 * q);
#pragma unroll
    for (int r = 0; r < 16; ++r) s[r] *= fexp2(acl - av[r >> 2][r & 3]);
    if (si == li) {
#pragma unroll
        for (int r = 0; r < 16; ++r) s[r] = (crow(r, hi) <= r32) ? s[r] : 0.f;
    }
    u32x4 t0, t1;
    t0.x = cvt_pk_bf16(s[0], s[1]); t0.y = cvt_pk_bf16(s[2], s[3]); t0.z = cvt_pk_bf16(s[4], s[5]); t0.w = cvt_pk_bf16(s[6], s[7]);
    t1.x = cvt_pk_bf16(s[8], s[9]); t1.y = cvt_pk_bf16(s[10], s[11]); t1.z = cvt_pk_bf16(s[12], s[13]); t1.w = cvt_pk_bf16(s[14], s[15]);
    const LAS unsigned char* xb = lds + SL_XD + (32 * si + 4 * hi + q4) * 64 + g1 * 32 + p4 * 8;
    y = mfma32(cat8(trrd(xb), trrd(xb + 512)), __builtin_bit_cast(bf16x8, t0), y);
    y = mfma32(cat8(trrd(xb + 1024), trrd(xb + 1536)), __builtin_bit_cast(bf16x8, t1), y);
}
__device__ __forceinline__ void ssd_yoff(const LAS unsigned char* lds, const LAS float* A_, const bf16x8 (&bbC)[8], int li, int r32, int hi, f32x16& y) {
    const int lidx = 32 * li + r32;
#pragma unroll
    for (int kk = 0; kk < 8; ++kk) {
        const bf16x8 aa = *(const LAS bf16x8*)(lds + SL_HT + r32 * 272 + (16 * kk + 8 * hi) * 2);
        y = mfma32(aa, bbC[kk], y);
    }
    const float el = fexp2(A_[lidx]);
#pragma unroll
    for (int r = 0; r < 16; ++r) y[r] *= el;
}
__device__ __forceinline__ void ssd_unit(const Ctx& F, int bl, int hd, int ph, const bf16_t* P, const bf16_t* XC, float dtb, float Aneg, float Dh, bf16_t* YP) {
    LAS unsigned char* lds = F.lds; int tid_ = F.tid; asm volatile("" : "+v"(tid_)); const int tid = tid_, lane = tid & 63, w = F.wave, r32 = lane & 31, hi = lane >> 5;
    const int g = hd >> 2, p0 = 32 * ph; const size_t rowb = (size_t)bl * SEQ;
    const int q4 = (lane & 15) >> 2, p4 = lane & 3, g1 = (lane >> 4) & 1;
    LAS float* A_ = (LAS float*)(lds + SL_AW) + w * 128; LAS float* D_ = (LAS float*)(lds + SL_DW) + w * 128;
    u32x4 creg[4], breg[4], xreg; float dt0 = 0.f, dt1 = 0.f;
#define SSD_LOAD(ch) do { const bf16_t* xc = XC + (rowb + (size_t)(ch) * 128) * 2048; \
        _Pragma("unroll") for (int i = 0; i < 4; ++i) { const int r = (tid >> 4) + 32 * i; \
            creg[i] = *(const u32x4*)(xc + (size_t)r * 2048 + 1536 + g * 128 + 8 * (tid & 15)); breg[i] = *(const u32x4*)(xc + (size_t)r * 2048 + 1024 + g * 128 + 8 * (tid & 15)); } \
        xreg = *(const u32x4*)(xc + (size_t)(tid >> 2) * 2048 + hd * 64 + p0 + 8 * (tid & 3)); \
        dt0 = bf1(P[(rowb + (size_t)(ch) * 128 + 2 * lane) * LDP + C_DT + hd]); dt1 = bf1(P[(rowb + (size_t)(ch) * 128 + 2 * lane + 1) * LDP + C_DT + hd]); } while (0)
    f32x16 hs = (f32x16){0.f, 0.f, 0.f, 0.f, 0.f, 0.f, 0.f, 0.f, 0.f, 0.f, 0.f, 0.f, 0.f, 0.f, 0.f, 0.f};
    SSD_LOAD(0);
    for (int ch = 0; ch < 16; ++ch) {
        { float x0 = dt0 + dtb, x1 = dt1 + dtb; const float v0 = x0 > 15.f ? x0 : __logf(1.f + __expf(x0)), v1 = x1 > 15.f ? x1 : __logf(1.f + __expf(x1));
          const float a0 = v0 * Aneg * LOG2E, a1 = v1 * Aneg * LOG2E; float sc = a0 + a1;
          sc = wave_scan_incl(sc);
          *(LAS f32x2*)(A_ + 2 * lane) = (f32x2){sc - a1, sc}; *(LAS f32x2*)(D_ + 2 * lane) = (f32x2){v0, v1}; }
#pragma unroll
        for (int i = 0; i < 4; ++i) { const int r = (tid >> 4) + 32 * i;
            *(LAS u32x4*)(lds + SL_CT + r * 272 + (tid & 15) * 16) = creg[i]; *(LAS u32x4*)(lds + SL_BT + r * 272 + (tid & 15) * 16) = breg[i]; }
        *(LAS u32x4*)(lds + SL_XT + (tid >> 2) * 64 + (tid & 3) * 16) = xreg;
        { const int lrow = tid >> 2; const float dl = D_[lrow], wl = dl * fexp2(A_[127] - A_[lrow]);
          float x[8], xd[8], xw[8]; unpack8(xreg, x);
#pragma unroll
          for (int i = 0; i < 8; ++i) { xd[i] = x[i] * dl; xw[i] = x[i] * wl; }
          *(LAS u32x4*)(lds + SL_XD + lrow * 64 + (tid & 3) * 16) = pack8(xd); *(LAS u32x4*)(lds + SL_XW + lrow * 64 + (tid & 3) * 16) = pack8(xw); }
        if (w >= 4) {
#pragma unroll
            for (int a = 0; a < 4; ++a) { u32x2 t; t.x = cvt_pk_bf16(hs[4 * a], hs[4 * a + 1]); t.y = cvt_pk_bf16(hs[4 * a + 2], hs[4 * a + 3]);
                *(LAS u32x2*)(lds + SL_HT + r32 * 272 + (32 * (w - 4) + 8 * a + 4 * hi) * 2) = t; }
        }
        if (ch + 1 < 16) SSD_LOAD(ch + 1);
        LDS_BARRIER();
        f32x16 y = (f32x16){0.f, 0.f, 0.f, 0.f, 0.f, 0.f, 0.f, 0.f, 0.f, 0.f, 0.f, 0.f, 0.f, 0.f, 0.f, 0.f};
        {
            const int li_ = (w == 0) ? 0 : (w == 1 || w == 7) ? 1 : (w == 2 || w == 5) ? 2 : 3;
            const int si0 = (w == 4 || w == 5) ? 2 : (w == 6) ? 3 : 0;
            const int nd = (w == 7) ? 0 : (w >= 1 && w <= 3) ? 2 : 1;
            const int yo = (w == 0) ? 0 : (w == 4) ? 3 : (w == 5) ? 2 : (w == 7) ? 1 : -1;
            bf16x8 bbC[8];
#pragma unroll
            for (int kk = 0; kk < 8; ++kk) bbC[kk] = *(const LAS bf16x8*)(lds + SL_CT + (32 * li_ + r32) * 272 + (16 * kk + 8 * hi) * 2);
            if (yo >= 0) ssd_yoff(lds, A_, bbC, yo, r32, hi, y);
#pragma unroll 1
            for (int d = 0; d < nd; ++d) ssd_diag(lds, A_, bbC, si0 + d, li_, r32, hi, q4, p4, g1, y);
        }
        if (w >= 4) {
            const int wi = w - 4;
            { const int slot = (w == 7) ? 0 : (w == 5) ? 1 : (w == 4) ? 2 : 3;
#pragma unroll
              for (int q = 0; q < 4; ++q) *(LAS f32x4*)(lds + SL_YO + slot * 4096 + lane * 64 + ((q ^ (lane & 3) ^ ((lane >> 2) & 3)) * 16)) = (f32x4){y[4 * q], y[4 * q + 1], y[4 * q + 2], y[4 * q + 3]}; }
            const float dec = fexp2(A_[127]);
#pragma unroll
            for (int r = 0; r < 16; ++r) hs[r] *= dec;
#pragma unroll
            for (int kk = 0; kk < 8; ++kk) {
                const LAS unsigned char* ab = lds + SL_BT + (16 * kk + 8 * hi + q4) * 272 + (32 * wi + 16 * g1 + 4 * p4) * 2;
                const LAS unsigned char* bb = lds + SL_XW + (16 * kk + 8 * hi + q4) * 64 + g1 * 32 + p4 * 8;
                hs = mfma32(cat8(trrd(ab), trrd(ab + 4 * 272)), cat8(trrd(bb), trrd(bb + 256)), hs);
            }
        }
        if (w < 4) {
#pragma unroll
            for (int a = 0; a < 4; ++a) {
                const u32x2 xr = *(const LAS u32x2*)(lds + SL_XT + (32 * w + r32) * 64 + (8 * a + 4 * hi) * 2);
                y[4 * a] += Dh * bflo(xr.x); y[4 * a + 1] += Dh * bfhi(xr.x); y[4 * a + 2] += Dh * bflo(xr.y); y[4 * a + 3] += Dh * bfhi(xr.y);
            }
        }
        LDS_BARRIER();
        if (w < 4) {
            const int li = w; bf16_t* yp = YP + (rowb + (size_t)ch * 128 + 32 * li + r32) * 1024 + hd * 64 + p0 + 4 * hi;
#pragma unroll
            for (int a = 0; a < 4; ++a) {
                float v[4] = {y[4 * a], y[4 * a + 1], y[4 * a + 2], y[4 * a + 3]};
                if (li >= 1) { const f32x4 t = *(const LAS f32x4*)(lds + SL_YO + (li - 1) * 4096 + lane * 64 + ((a ^ (lane & 3) ^ ((lane >> 2) & 3)) * 16));
                    v[0] += t[0]; v[1] += t[1]; v[2] += t[2]; v[3] += t[3]; }
                if (li == 3) { const f32x4 t = *(const LAS f32x4*)(lds + SL_YO + 3 * 4096 + lane * 64 + ((a ^ (lane & 3) ^ ((lane >> 2) & 3)) * 16));
                    v[0] += t[0]; v[1] += t[1]; v[2] += t[2]; v[3] += t[3]; }
                u32x2 o; o.x = cvt_pk_bf16(v[0], v[1]); o.y = cvt_pk_bf16(v[2], v[3]); *(u32x2*)(yp + 8 * a) = o;
            }
        }
    }
    LDS_BARRIER();
#undef SSD_LOAD
}

__device__ __forceinline__ void attn_phase(const Ctx& F, ArgsP a, int l, int gi) {
    LAS unsigned char* lds = F.lds;
    const bf16_t* P = (const bf16_t*)(a->ws + WS_ARENA + AR_P);
    const bf16_t* XC = (const bf16_t*)(F.dout + DO_XC);
    bf16_t* YP = (bf16_t*)(F.dout + DO_YC); bf16_t* YB = (bf16_t*)(F.dout + DO_R + (size_t)(gi & (NG - 1)) * TG * 1024);
    const bf16_t* KC = (const bf16_t*)(a->ws + WS_MISC + MI_KC); const bf16_t* VC = (const bf16_t*)(a->ws + WS_MISC + MI_VC);
    const float* biasT = (const float*)(a->ws + WS_MISC + MI_BIAS);
    unsigned* ctr = F.ctl + CW_WQ + 64 * (l * NG + gi);
    constexpr int NSSD = BG * 16 * 2, NNSA = BG * 2 * 32;
    for (int item = F.vcu; item < NSSD; item += F.G) {
        const int bl = item >> 5, hd = (item >> 1) & 15, ph = item & 1;
        for (int rr_ = 0; rr_ <= SSD_REP; ++rr_) ssd_unit(F, bl, hd, ph, P, XC, a->in[I_DTB][l * 16 + hd], -__expf(a->in[I_ALOG][l * 16 + hd]), a->in[I_DSKIP][l * 16 + hd], YP);
    }
    __syncthreads();
    for (int i = F.tid; i < 8 * 256; i += 512) { const int hd = i >> 8, d = (i & 255) - 64; ((LAS float*)(lds + NL_BIAS))[i] = d < 0 ? NEGBIG : (d < 128 ? biasT[hd * 128 + d] : 0.f); }
    __syncthreads();
    if (F.G * 2 == NNSA) {
#pragma unroll 1
        for (int k = 0; k < 2; ++k) {
            const int idx = k == 0 ? F.vcu : NNSA - 1 - F.vcu;
            const int qt = 31 - (idx >> 4), bg = idx & 15;
            nsa_unit(F, bg >> 1, bg & 1, qt, P, KC, VC, biasT, YB);
        }
        return;
    }
    for (;;) {
        if (F.tid == 0) *(LAS int*)(lds + LDSX + LX_WQ) = (int)__hip_atomic_fetch_add(ctr, 1u, __ATOMIC_RELAXED, __HIP_MEMORY_SCOPE_AGENT);
        __syncthreads();
        const int idx = *(const LAS int*)(lds + LDSX + LX_WQ);
        __syncthreads();
        if (idx >= NNSA) break;
        const int qt = 31 - (idx >> 4), bg = idx & 15;
        for (int rr_ = 0; rr_ <= NSA_REP; ++rr_) nsa_unit(F, bg >> 1, bg & 1, qt, P, KC, VC, biasT, YB);
    }
}


constexpr int RL_HI = 0, RL_LO = 33024, RL_GB = 66048, RL_LG = 74240, RL_ROWSTRIDE = 2064;
__device__ __forceinline__ void ln1_route_phase(const Ctx& F, ArgsP a, int l) {
    LAS unsigned char* lds = F.lds; const int tid = F.tid, lane = F.lane, w = F.wave, fr = lane & 15, q = lane >> 4;
    LAS int* lcnt = (LAS int*)(lds + LDSX + LX_CNTL); LAS int* lbase = (LAS int*)(lds + LDSX + LX_BASE); LAS int* rows = (LAS int*)(lds + LDSX + LX_ROWS);
    for (int i = tid; i < 16384; i += 512) { const float x = a->in[I_RW][i]; const bf16_t hi = f2bf(x); const bf16_t lo = f2bf(x - bf1(hi)); const int d = i >> 4, e = i & 15;
        *(LAS bf16_t*)(lds + RL_HI + e * RL_ROWSTRIDE + d * 2) = hi; *(LAS bf16_t*)(lds + RL_LO + e * RL_ROWSTRIDE + d * 2) = lo; }
    { LAS float* GB = (LAS float*)(lds + RL_GB); for (int i = tid; i < 1024; i += 512) { GB[i] = a->in[I_LN1G][l * DM + i]; GB[1024 + i] = a->in[I_LN1B][l * DM + i]; } }
    bf16_t* H1 = (bf16_t*)(a->ws + WS_PRE1);
    float rb[16];
#pragma unroll
    for (int e = 0; e < 16; ++e) rb[e] = a->in[I_RB][e];
    unsigned* gcnt = F.ctl + CW_CNT + 64 * l;
    int* rtok = (int*)(a->ws + WS_ARENA + AR_RTOK); int2* rinfo = (int2*)(a->ws + WS_ARENA + AR_RINFO);
    for (int rb0 = blockIdx.x * 128; rb0 < T_; rb0 += F.G * 128) {
        if (tid < 16) lcnt[tid] = 0;
        __syncthreads();
        {
            bf16_t* rowp = H1 + ((size_t)rb0 + w * 16 + fr) * DM + 8 * q;
            float s = 0.f, ss = 0.f;
#pragma unroll 8
            for (int kk = 0; kk < 32; ++kk) { float x[8]; unpack8(*(const u32x4*)(rowp + 32 * kk), x);
#pragma unroll
                for (int j = 0; j < 8; ++j) { s += x[j]; ss += x[j] * x[j]; } }
            s += __shfl_xor(s, 16); s += __shfl_xor(s, 32); ss += __shfl_xor(ss, 16); ss += __shfl_xor(ss, 32);
            const float mean = s * (1.f / DM), rstd = 1.f / sqrtf(fmaxf(ss * (1.f / DM) - mean * mean, 0.f) + LN_EPS);
            f32x4 acc = {0.f, 0.f, 0.f, 0.f};
            const LAS float* GB = (const LAS float*)(lds + RL_GB);
#pragma unroll 2
            for (int kk = 0; kk < 32; ++kk) {
                float x[8], lo[8]; unpack8(*(const u32x4*)(rowp + 32 * kk), x);
                const f32x4 g0 = *(const LAS f32x4*)(GB + 32 * kk + 8 * q), g1 = *(const LAS f32x4*)(GB + 32 * kk + 8 * q + 4);
                const f32x4 b0 = *(const LAS f32x4*)(GB + 1024 + 32 * kk + 8 * q), b1 = *(const LAS f32x4*)(GB + 1024 + 32 * kk + 8 * q + 4);
#pragma unroll
                for (int j = 0; j < 4; ++j) { x[j] = (x[j] - mean) * rstd * g0[j] + b0[j]; x[4 + j] = (x[4 + j] - mean) * rstd * g1[j] + b1[j]; }
                const u32x4 hp = pack8(x);
                *(u32x4*)(rowp + 32 * kk) = hp;
                *(u32x2*)(a->ws + WS_H18 + ((size_t)rb0 + w * 16 + fr) * DM + 8 * q + 32 * kk) = pack8_i8(x, ASCALE);
                { float hf[8]; unpack8(hp, hf);
#pragma unroll
                  for (int j = 0; j < 8; ++j) lo[j] = x[j] - hf[j]; }
                const bf16x8 ahi = __builtin_bit_cast(bf16x8, hp), alo = __builtin_bit_cast(bf16x8, pack8(lo));
                const bf16x8 bhi = *(const LAS bf16x8*)(lds + RL_HI + fr * RL_ROWSTRIDE + (32 * kk + 8 * q) * 2), blo = *(const LAS bf16x8*)(lds + RL_LO + fr * RL_ROWSTRIDE + (32 * kk + 8 * q) * 2);
                acc = mfma16(ahi, bhi, acc); acc = mfma16(ahi, blo, acc); acc = mfma16(alo, bhi, acc);
                asm volatile("" ::: "memory");
            }
            LAS float* LG = (LAS float*)(lds + RL_LG) + w * 256;
#pragma unroll
            for (int r = 0; r < 4; ++r) LG[(4 * q + r) * 16 + fr] = acc[r];
        }
        LDS_WAIT();
        if (lane < 16) {
            const LAS float* LG = (const LAS float*)(lds + RL_LG) + w * 256 + lane * 16;
            float lg[16];
#pragma unroll
            for (int e4 = 0; e4 < 4; ++e4) { const f32x4 t = *(const LAS f32x4*)(LG + 4 * e4); lg[4 * e4] = t[0]; lg[4 * e4 + 1] = t[1]; lg[4 * e4 + 2] = t[2]; lg[4 * e4 + 3] = t[3]; }
            float mx = lg[0];
#pragma unroll
            for (int e = 1; e < 16; ++e) mx = fmaxf(mx, lg[e]);
            float pr[16], ps = 0.f;
#pragma unroll
            for (int e = 0; e < 16; ++e) { pr[e] = __expf(lg[e] - mx); ps += pr[e]; }
            const float pinv = 1.f / ps;
            float sc[16];
#pragma unroll
            for (int e = 0; e < 16; ++e) { pr[e] *= pinv; sc[e] = pr[e] + rb[e]; }
            int grp = 0; float gbest = -1e30f;
#pragma unroll
            for (int qq = 0; qq < 4; ++qq) {
                const float s0 = sc[4 * qq], s1 = sc[4 * qq + 1], s2_ = sc[4 * qq + 2], s3 = sc[4 * qq + 3];
                const float tot = (s0 + s1) + (s2_ + s3), mn1 = fminf(fminf(s0, s1), fminf(s2_, s3));
                const float m2 = fminf(fminf(fminf(fmaxf(s0, s1), fmaxf(s0, s2_)), fminf(fmaxf(s0, s3), fmaxf(s1, s2_))), fminf(fmaxf(s1, s3), fmaxf(s2_, s3)));
                const float top2 = tot - mn1 - m2;
                if (top2 > gbest) { gbest = top2; grp = qq; }
            }
            float c0 = 0.f, c1 = 0.f, c2 = 0.f, c3 = 0.f, q0 = 0.f, q1 = 0.f, q2 = 0.f, q3 = 0.f;
#pragma unroll
            for (int qq = 0; qq < 4; ++qq) if (grp == qq) { c0 = sc[4 * qq]; c1 = sc[4 * qq + 1]; c2 = sc[4 * qq + 2]; c3 = sc[4 * qq + 3]; q0 = pr[4 * qq]; q1 = pr[4 * qq + 1]; q2 = pr[4 * qq + 2]; q3 = pr[4 * qq + 3]; }
            int i0 = 0; float b0 = c0; if (c1 > b0) { b0 = c1; i0 = 1; } if (c2 > b0) { b0 = c2; i0 = 2; } if (c3 > b0) { b0 = c3; i0 = 3; }
            int i1 = -1; float b1 = -1e30f;
            if (i0 != 0 && c0 > b1) { b1 = c0; i1 = 0; } if (i0 != 1 && c1 > b1) { b1 = c1; i1 = 1; } if (i0 != 2 && c2 > b1) { b1 = c2; i1 = 2; } if (i0 != 3 && c3 > b1) { b1 = c3; i1 = 3; }
            const float w0 = (i0 == 0) ? q0 : (i0 == 1) ? q1 : (i0 == 2) ? q2 : q3, w1 = (i1 == 0) ? q0 : (i1 == 1) ? q1 : (i1 == 2) ? q2 : q3;
            const float wn = 1.f / (w0 + w1);
            const int e0 = 4 * grp + i0, e1 = 4 * grp + i1, rl = w * 16 + lane;
            const int pos0 = atomicAdd((int*)(lds + LDSX + LX_CNTL) + e0, 1), pos1 = atomicAdd((int*)(lds + LDSX + LX_CNTL) + e1, 1);
            rows[rl * 8 + 0] = e0; rows[rl * 8 + 1] = e1; rows[rl * 8 + 2] = pos0; rows[rl * 8 + 3] = pos1; rows[rl * 8 + 4] = __float_as_int(w0 * wn); rows[rl * 8 + 5] = __float_as_int(w1 * wn);
        }
        __syncthreads();
        if (tid < 16) lbase[tid] = (int)__hip_atomic_fetch_add(gcnt + tid, (unsigned)lcnt[tid], __ATOMIC_RELAXED, __HIP_MEMORY_SCOPE_AGENT);
        __syncthreads();
        if (tid < 128) {
            const int e0 = rows[tid * 8], e1 = rows[tid * 8 + 1]; const int t = rb0 + tid;
            const int p0 = e0 * ECAP + lbase[e0] + rows[tid * 8 + 2], p1 = e1 * ECAP + lbase[e1] + rows[tid * 8 + 3];
            rtok[p0] = t; rinfo[p0] = make_int2(t, rows[tid * 8 + 4]); rtok[p1] = t; rinfo[p1] = make_int2(T_ + t, rows[tid * 8 + 5]);
        }
        __syncthreads();
    }
}

__device__ __forceinline__ int moe_tables(const Ctx& F, int l, const int* rtok) {
    LAS int* off = (LAS int*)(F.lds + LDSX + LX_OFF); LAS int* ecnt = (LAS int*)(F.lds + LDSX + LX_ECNT); LAS int* tile_e = (LAS int*)(F.lds + LDSX + LX_TILE); LAS int* gidx = (LAS int*)(F.lds + LDSX + LX_GIDX);
    __syncthreads();
    if (F.tid == 0) { int o = 0;
        for (int e = 0; e < 16; ++e) { off[e] = o; const int c = (int)__hip_atomic_load(F.ctl + CW_CNT + 64 * l + e, __ATOMIC_RELAXED, __HIP_MEMORY_SCOPE_AGENT); ecnt[e] = c; const int nt = (c + 255) >> 8;
            for (int k = 0; k < nt; ++k) tile_e[(o >> 8) + k] = e; o += nt << 8; }
        off[16] = o; }
    __syncthreads();
    const int nrt = off[16] >> 8;
    if (rtok) {
        for (int i = 0; i < 8; ++i) { const long L = (long)i * F.G + F.vcu; if (L >= (long)nrt * 4) break;
            const int rt = (int)(L >> 2), e = tile_e[rt], k0 = rt * 256 - off[e], c = ecnt[e];
            if (F.tid < 256) gidx[i * 256 + F.tid] = (k0 + F.tid < c) ? rtok[e * ECAP + k0 + F.tid] : 0; }
        __syncthreads();
    }
    return nrt;
}
__device__ __forceinline__ void ln2_phase(const Ctx& F, ArgsP a, int l, bool last) {
    const bf16_t* H1 = (const bf16_t*)(a->ws + WS_PRE1); const bf16_t* YS = (const bf16_t*)(a->ws + WS_ARENA + AR_XS);
    bf16_t* H = (bf16_t*)(a->ws + WS_H); float* OUT = a->out;
    const float* g = a->in[I_LN2G] + l * DM; const float* b = a->in[I_LN2B] + l * DM; const int lane = F.lane;
    float gg[16], bb[16];
#pragma unroll
    for (int i = 0; i < 8; ++i) { gg[i] = g[8 * lane + i]; gg[8 + i] = g[512 + 8 * lane + i]; bb[i] = b[8 * lane + i]; bb[8 + i] = b[512 + 8 * lane + i]; }
    u32x4 nx[6];
#define LN2_LOAD(t_) do { _Pragma("unroll") for (int hf = 0; hf < 2; ++hf) { nx[3 * hf] = *(const u32x4*)(H1 + (size_t)(t_) * DM + 512 * hf + 8 * lane); \
        nx[3 * hf + 1] = *(const u32x4*)(YS + (size_t)(t_) * DM + 512 * hf + 8 * lane); nx[3 * hf + 2] = *(const u32x4*)(YS + (size_t)(T_ + (t_)) * DM + 512 * hf + 8 * lane); } } while (0)
    LN2_LOAD(F.gw);
    for (int t = F.gw; t < T_; t += F.NGW) {
        float v[16];
        u32x4 cur[6];
#pragma unroll
        for (int i = 0; i < 6; ++i) cur[i] = nx[i];
        if (t + F.NGW < T_) LN2_LOAD(t + F.NGW);
#pragma unroll
        for (int hf = 0; hf < 2; ++hf) { float x[8], y0[8], y1[8];
            unpack8(cur[3 * hf], x);
            unpack8(cur[3 * hf + 1], y0);
            unpack8(cur[3 * hf + 2], y1);
#pragma unroll
            for (int i = 0; i < 8; ++i) v[8 * hf + i] = DN_ALPHA * x[i] + (y0[i] + y1[i]); }
        float s = 0.f;
#pragma unroll
        for (int i = 0; i < 16; ++i) s += v[i];
        const float mean = wave_sum(s) * (1.f / DM); float s2 = 0.f;
#pragma unroll
        for (int i = 0; i < 16; ++i) { v[i] -= mean; s2 += v[i] * v[i]; }
        const float rstd = 1.f / sqrtf(wave_sum(s2) * (1.f / DM) + LN_EPS);
#pragma unroll
        for (int i = 0; i < 16; ++i) v[i] = v[i] * rstd * gg[i] + bb[i];
        if (last) {
#pragma unroll
            for (int hf = 0; hf < 2; ++hf) { float* o = OUT + (size_t)t * DM + 512 * hf + 8 * lane;
                *(f32x4*)o = (f32x4){v[8 * hf], v[8 * hf + 1], v[8 * hf + 2], v[8 * hf + 3]}; *(f32x4*)(o + 4) = (f32x4){v[8 * hf + 4], v[8 * hf + 5], v[8 * hf + 6], v[8 * hf + 7]}; }
        } else {
#pragma unroll
            for (int hf = 0; hf < 2; ++hf) { float tt[8];
#pragma unroll
                for (int i = 0; i < 8; ++i) tt[i] = v[8 * hf + i];
                *(u32x4*)(H + (size_t)t * DM + 512 * hf + 8 * lane) = pack8(tt);
                *(u32x2*)(a->ws + WS_H8 + (size_t)t * DM + 512 * hf + 8 * lane) = pack8_i8(tt, ASCALE); }
        }
    }
}

#ifndef REP_MASK
#define REP_MASK 0
#endif
#ifndef PH_MASK
#define PH_MASK 0xfff
#endif
constexpr int NSTEPS = 1 + DEPTH * (NG * 4 + 6);
__global__ void __launch_bounds__(512, 2) fwd_kernel(Args a_unused) {
    const ArgsP a = (ArgsP)__builtin_amdgcn_kernarg_segment_ptr();
    extern __shared__ __attribute__((aligned(16))) unsigned char smem[];
    const int wave0_ = __builtin_amdgcn_readfirstlane((int)threadIdx.x >> 6);
    Ctx F;
#define MKCTX do { int t_; asm volatile("v_mbcnt_lo_u32_b32 %0, -1, 0\n\tv_mbcnt_hi_u32_b32 %0, -1, %0" : "=v"(t_)); t_ += wave0_ * 64; F.lds = (LAS unsigned char*)smem; F.tid = t_; F.lane = t_ & 63; F.wave = wave0_; \
        F.G = gridDim.x; { const int bx = blockIdx.x; F.vcu = (F.G % 8 == 0) ? (bx % 8) * (F.G / 8) + bx / 8 : bx; } \
        F.gw = blockIdx.x * 8 + F.wave; F.NGW = F.G * 8; F.ws = a->ws; F.dout = (unsigned char*)a->out; F.ctl = (unsigned*)(a->ws + WS_CTL); } while (0)
    MKCTX;
    for (int u = F.tid; u < (LDS_TOTAL - LDSX) / 4; u += 512) ((LAS unsigned*)(F.lds + LDSX))[u] = 0u;
    __syncthreads();
    const bool multi = (a->hi - a->lo) > 1;
    XcdBarrier bar; bar.bar = F.ctl + CW_BAR; bar.x = 0; bar.st = (volatile LAS unsigned*)(F.lds + LDSX + LX_BAR);
    if (multi) bar = xcd_barrier_post(F.ctl + CW_BAR, (volatile LAS unsigned*)(F.lds + LDSX + LX_BAR), F.tid);
    int step = 0;
#ifndef SKEW_S1
#define SKEW_S1 0
#endif
#define SKEW_WAIT(step_) do { const int n_ = (int)((blockIdx.x >> 3) & 7) * (step_); for (int i_ = 0; i_ < n_; ++i_) __builtin_amdgcn_s_sleep(16); } while (0)
#define RUN_STEP (step >= a->lo && step < a->hi)
#ifndef BAR_REP
#define BAR_REP 0
#endif
#define END_STEP do { if (RUN_STEP && step + 1 < a->hi) { xcd_barrier(bar, F.tid); if (BAR_REP) xcd_barrier(bar, F.tid); } ++step; } while (0)

    if (RUN_STEP && ((PH_MASK >> 0) & 1)) for (int rep_ = 0; rep_ <= ((REP_MASK >> 0) & 1); ++rep_) { MKCTX; p0_prologue(F, a); }
    END_STEP;

    {
        unsigned char* wl = a->ws + WS_W + (size_t)0 * W_LAYER;
        bf16_t* Hb = (bf16_t*)(a->ws + WS_H);
        bf16_t* P = (bf16_t*)(a->ws + WS_ARENA + AR_P);
        {
            const bf16_t* Hg = Hb + (size_t)0 * TG * DM;
            if (RUN_STEP && ((PH_MASK >> 1) & 1)) for (int rep_ = 0; rep_ <= ((REP_MASK >> 1) & 1); ++rep_) { MKCTX;
                pg8::Gemm g{(const bf16_t*)(a->ws + WS_H8 + (size_t)0 * TG * DM), (const bf16_t*)(wl + WO_IN), 512, 512, 512}; pg8::StaticOrder S; S.init(TG, LDP, 512, 512, F.G, (int)blockIdx.x, 512);
                pg8::Epi<pg8::EK_PROJ> E{P, LDP, nullptr, 0, nullptr, nullptr, nullptr, 1.f / (WSCALE * ASCALE)};
                SKEW_WAIT(SKEW_S1);
                pg8::gemm_phase<pg8::Epi<pg8::EK_PROJ>, pg8::StaticOrder, false, true>(F.lds, F.tid, g, S, E);
            }
            END_STEP;
            if (RUN_STEP && ((PH_MASK >> 2) & 1)) for (int rep_ = 0; rep_ <= ((REP_MASK >> 2) & 1); ++rep_) { MKCTX;
                for (int cu = blockIdx.x; cu < BG * 32; cu += F.G)
                    compress_unit(F, cu, P, (const bf16_t*)(wl + WO_W1), (const bf16_t*)(wl + WO_W2), (const float*)(a->ws + WS_MISC + MI_B1) + 0 * 256,
                                  (bf16_t*)(a->ws + WS_MISC + MI_KC), (bf16_t*)(a->ws + WS_MISC + MI_VC));
                conv_phase(F, P, (bf16_t*)(F.dout + DO_XC), a->in[I_CONVW] + (size_t)0 * 4 * 2048, a->in[I_CONVB] + (size_t)0 * 2048);
            }
            END_STEP;
            if (RUN_STEP && ((PH_MASK >> 3) & 1)) for (int rep_ = 0; rep_ <= ((REP_MASK >> 3) & 1); ++rep_) { MKCTX; attn_phase(F, a, 0, 0 + 4 * rep_); }
            END_STEP;
            if (RUN_STEP && ((PH_MASK >> 4) & 1)) for (int rep_ = 0; rep_ <= ((REP_MASK >> 4) & 1); ++rep_) { MKCTX; fin_phase(F, P, (bf16_t*)(F.dout + DO_R + (size_t)0 * TG * 1024), (const bf16_t*)(F.dout + DO_YC), a->ws + WS_ARENA + AR_YC8 + (size_t)0 * TG * 1024, a->in[I_SNG] + (size_t)0 * DM); }
            END_STEP;
        }
        {
            const bf16_t* Hg = Hb + (size_t)1 * TG * DM;
            if (RUN_STEP && ((PH_MASK >> 1) & 1)) for (int rep_ = 0; rep_ <= ((REP_MASK >> 1) & 1); ++rep_) { MKCTX;
                pg8::Gemm g{(const bf16_t*)(a->ws + WS_H8 + (size_t)1 * TG * DM), (const bf16_t*)(wl + WO_IN), 512, 512, 512}; pg8::StaticOrder S; S.init(TG, LDP, 512, 512, F.G, (int)blockIdx.x, 512);
                pg8::Epi<pg8::EK_PROJ> E{P, LDP, nullptr, 0, nullptr, nullptr, nullptr, 1.f / (WSCALE * ASCALE)};
                SKEW_WAIT(SKEW_S1);
                pg8::gemm_phase<pg8::Epi<pg8::EK_PROJ>, pg8::StaticOrder, false, true>(F.lds, F.tid, g, S, E);
            }
            END_STEP;
            if (RUN_STEP && ((PH_MASK >> 2) & 1)) for (int rep_ = 0; rep_ <= ((REP_MASK >> 2) & 1); ++rep_) { MKCTX;
                for (int cu = blockIdx.x; cu < BG * 32; cu += F.G)
                    compress_unit(F, cu, P, (const bf16_t*)(wl + WO_W1), (const bf16_t*)(wl + WO_W2), (const float*)(a->ws + WS_MISC + MI_B1) + 0 * 256,
                                  (bf16_t*)(a->ws + WS_MISC + MI_KC), (bf16_t*)(a->ws + WS_MISC + MI_VC));
                conv_phase(F, P, (bf16_t*)(F.dout + DO_XC), a->in[I_CONVW] + (size_t)0 * 4 * 2048, a->in[I_CONVB] + (size_t)0 * 2048);
            }
            END_STEP;
            if (RUN_STEP && ((PH_MASK >> 3) & 1)) for (int rep_ = 0; rep_ <= ((REP_MASK >> 3) & 1); ++rep_) { MKCTX; attn_phase(F, a, 0, 1 + 4 * rep_); }
            END_STEP;
            if (RUN_STEP && ((PH_MASK >> 4) & 1)) for (int rep_ = 0; rep_ <= ((REP_MASK >> 4) & 1); ++rep_) { MKCTX; fin_phase(F, P, (bf16_t*)(F.dout + DO_R + (size_t)1 * TG * 1024), (const bf16_t*)(F.dout + DO_YC), a->ws + WS_ARENA + AR_YC8 + (size_t)1 * TG * 1024, a->in[I_SNG] + (size_t)0 * DM); }
            END_STEP;
        }
        if (RUN_STEP && ((PH_MASK >> 5) & 1)) for (int rep_ = 0; rep_ <= ((REP_MASK >> 5) & 1); ++rep_) { MKCTX;
            bf16_t* GT = (bf16_t*)(a->ws + WS_ARENA + AR_GATES); bf16_t* MX = (bf16_t*)(a->ws + WS_H18);   float* TMP = (float*)(F.dout + DO_TMP);
            pg8::Gemm g{nullptr, nullptr, 512, 512, 512};
            pg8::S5Order S; S.so.init(T_, DM, 512, 512, F.G, (int)blockIdx.x, 512);
            S.aH = (long)(size_t)(a->ws + WS_H8); S.aRY = (long)(size_t)(F.dout + DO_R); S.aYC = (long)(size_t)(a->ws + WS_ARENA + AR_YC8);
            S.bG = (long)(size_t)(wl + WO_GATE); S.bCN = (long)(size_t)(wl + WO_C); S.bS = (long)(size_t)(wl + WO_SSD);
            { LAS unsigned char* lut = F.lds + LDSX + LX_LUT;
              for (int i = F.tid; i < 1024; i += 512) lut[i] = (unsigned char)__float2int_rn(127.f * sigmoidf_((float)(i - 512) * (1.f / 64.f)));
              __syncthreads(); }
            pg8::Epi<pg8::EK_S5> E{GT, 3072, nullptr, 0, TMP, nullptr, MX, 1.f, (unsigned)(size_t)(F.lds + LDSX + LX_LUT)};
            pg8::gemm_phase<pg8::Epi<pg8::EK_S5>, pg8::S5Order, false, true>(F.lds, F.tid, g, S, E);
        }
        END_STEP;
        if (RUN_STEP && ((PH_MASK >> 6) & 1)) for (int rep_ = 0; rep_ <= ((REP_MASK >> 6) & 1); ++rep_) { MKCTX;
            pg8::Gemm g{(const bf16_t*)(a->ws + WS_H18), (const bf16_t*)(wl + WO_OUT), 512, 512, 512}; pg8::StaticOrder S; S.init(T_, DM, 512, 512, F.G, (int)blockIdx.x, 512);
            pg8::Epi<pg8::EK_WOUT> E{(bf16_t*)(a->ws + WS_PRE1), DM, Hb, DM, nullptr, nullptr, nullptr, 1.f / (WSCALE_OUT * MSCALE)};
            pg8::gemm_phase<pg8::Epi<pg8::EK_WOUT>, pg8::StaticOrder, false, true>(F.lds, F.tid, g, S, E);
        }
        END_STEP;
        if (RUN_STEP && ((PH_MASK >> 7) & 1)) for (int rep_ = 0; rep_ <= ((REP_MASK >> 7) & 1); ++rep_) { MKCTX; ln1_route_phase(F, a, 0); }
        END_STEP;
        int nrt_keep = -1;
        if (RUN_STEP && ((PH_MASK >> 9) & 1)) for (int rep_ = 0; rep_ <= ((REP_MASK >> 9) & 1); ++rep_) { MKCTX;
            const int nrt = moe_tables(F, 0, (const int*)(a->ws + WS_ARENA + AR_RTOK));
            nrt_keep = nrt;
            pg8::Gemm g{(const bf16_t*)(a->ws + WS_H18), (const bf16_t*)(wl + WO_UP), 512, 512, 512};
            pg8::MoeOrder S{(const LAS int*)(F.lds + LDSX + LX_TILE), (const LAS int*)(F.lds + LDSX + LX_OFF), (const LAS int*)(F.lds + LDSX + LX_ECNT), nrt, F.G, F.vcu, 8, (long)256 * DM, (long)256 * DM, (long)1024 * DM};
            pg8::Epi<pg8::EK_GLU> E{(bf16_t*)(a->ws + WS_ARENA + AR_HID), 512, nullptr, 0, nullptr, nullptr, nullptr, 1.f / (WSCALE * ASCALE)};
            pg8::gemm_phase<pg8::Epi<pg8::EK_GLU>, pg8::MoeOrder, true, true>(F.lds, F.tid, g, S, E, (const LAS int*)(F.lds + LDSX + LX_GIDX));
        }
        END_STEP;
        if (RUN_STEP && ((PH_MASK >> 10) & 1)) for (int rep_ = 0; rep_ <= ((REP_MASK >> 10) & 1); ++rep_) { MKCTX;
            const int nrt = (nrt_keep >= 0) ? nrt_keep : moe_tables(F, 0, nullptr);
            pg8::Gemm g{(const bf16_t*)(a->ws + WS_ARENA + AR_HID), (const bf16_t*)(wl + WO_DN), 256, 256, 256};
            pg8::MoeOrder S{(const LAS int*)(F.lds + LDSX + LX_TILE), (const LAS int*)(F.lds + LDSX + LX_OFF), (const LAS int*)(F.lds + LDSX + LX_ECNT), nrt, F.G, F.vcu, 4, (long)256 * 512, (long)256 * 512, (long)1024 * 512};
            pg8::Epi<pg8::EK_DOWN> E{(bf16_t*)(a->ws + WS_ARENA + AR_XS), DM, nullptr, 0, nullptr, (const int2*)(a->ws + WS_ARENA + AR_RINFO), nullptr, 1.f / (WSCALE_DN * HSCALE)};
            pg8::gemm_phase<pg8::Epi<pg8::EK_DOWN>, pg8::MoeOrder, false, true>(F.lds, F.tid, g, S, E);
        }
        END_STEP;
        if (RUN_STEP && ((PH_MASK >> 11) & 1)) for (int rep_ = 0; rep_ <= ((REP_MASK >> 11) & 1); ++rep_) { MKCTX; ln2_phase(F, a, 0, 0 == DEPTH - 1); }
        END_STEP;
    }
    {
        unsigned char* wl = a->ws + WS_W + (size_t)1 * W_LAYER;
        bf16_t* Hb = (bf16_t*)(a->ws + WS_H);
        bf16_t* P = (bf16_t*)(a->ws + WS_ARENA + AR_P);
        {
            const bf16_t* Hg = Hb + (size_t)0 * TG * DM;
            if (RUN_STEP && ((PH_MASK >> 1) & 1)) for (int rep_ = 0; rep_ <= ((REP_MASK >> 1) & 1); ++rep_) { MKCTX;
                pg8::Gemm g{(const bf16_t*)(a->ws + WS_H8 + (size_t)0 * TG * DM), (const bf16_t*)(wl + WO_IN), 512, 512, 512}; pg8::StaticOrder S; S.init(TG, LDP, 512, 512, F.G, (int)blockIdx.x, 512);
                pg8::Epi<pg8::EK_PROJ> E{P, LDP, nullptr, 0, nullptr, nullptr, nullptr, 1.f / (WSCALE * ASCALE)};
                SKEW_WAIT(SKEW_S1);
                pg8::gemm_phase<pg8::Epi<pg8::EK_PROJ>, pg8::StaticOrder, false, true>(F.lds, F.tid, g, S, E);
            }
            END_STEP;
            if (RUN_STEP && ((PH_MASK >> 2) & 1)) for (int rep_ = 0; rep_ <= ((REP_MASK >> 2) & 1); ++rep_) { MKCTX;
                for (int cu = blockIdx.x; cu < BG * 32; cu += F.G)
                    compress_unit(F, cu, P, (const bf16_t*)(wl + WO_W1), (const bf16_t*)(wl + WO_W2), (const float*)(a->ws + WS_MISC + MI_B1) + 1 * 256,
                                  (bf16_t*)(a->ws + WS_MISC + MI_KC), (bf16_t*)(a->ws + WS_MISC + MI_VC));
                conv_phase(F, P, (bf16_t*)(F.dout + DO_XC), a->in[I_CONVW] + (size_t)1 * 4 * 2048, a->in[I_CONVB] + (size_t)1 * 2048);
            }
            END_STEP;
            if (RUN_STEP && ((PH_MASK >> 3) & 1)) for (int rep_ = 0; rep_ <= ((REP_MASK >> 3) & 1); ++rep_) { MKCTX; attn_phase(F, a, 1, 0 + 4 * rep_); }
            END_STEP;
            if (RUN_STEP && ((PH_MASK >> 4) & 1)) for (int rep_ = 0; rep_ <= ((REP_MASK >> 4) & 1); ++rep_) { MKCTX; fin_phase(F, P, (bf16_t*)(F.dout + DO_R + (size_t)0 * TG * 1024), (const bf16_t*)(F.dout + DO_YC), a->ws + WS_ARENA + AR_YC8 + (size_t)0 * TG * 1024, a->in[I_SNG] + (size_t)1 * DM); }
            END_STEP;
        }
        {
            const bf16_t* Hg = Hb + (size_t)1 * TG * DM;
            if (RUN_STEP && ((PH_MASK >> 1) & 1)) for (int rep_ = 0; rep_ <= ((REP_MASK >> 1) & 1); ++rep_) { MKCTX;
                pg8::Gemm g{(const bf16_t*)(a->ws + WS_H8 + (size_t)1 * TG * DM), (const bf16_t*)(wl + WO_IN), 512, 512, 512}; pg8::StaticOrder S; S.init(TG, LDP, 512, 512, F.G, (int)blockIdx.x, 512);
                pg8::Epi<pg8::EK_PROJ> E{P, LDP, nullptr, 0, nullptr, nullptr, nullptr, 1.f / (WSCALE * ASCALE)};
                SKEW_WAIT(SKEW_S1);
                pg8::gemm_phase<pg8::Epi<pg8::EK_PROJ>, pg8::StaticOrder, false, true>(F.lds, F.tid, g, S, E);
            }
            END_STEP;
            if (RUN_STEP && ((PH_MASK >> 2) & 1)) for (int rep_ = 0; rep_ <= ((REP_MASK >> 2) & 1); ++rep_) { MKCTX;
                for (int cu = blockIdx.x; cu < BG * 32; cu += F.G)
                    compress_unit(F, cu, P, (const bf16_t*)(wl + WO_W1), (const bf16_t*)(wl + WO_W2), (const float*)(a->ws + WS_MISC + MI_B1) + 1 * 256,
                                  (bf16_t*)(a->ws + WS_MISC + MI_KC), (bf16_t*)(a->ws + WS_MISC + MI_VC));
                conv_phase(F, P, (bf16_t*)(F.dout + DO_XC), a->in[I_CONVW] + (size_t)1 * 4 * 2048, a->in[I_CONVB] + (size_t)1 * 2048);
            }
            END_STEP;
            if (RUN_STEP && ((PH_MASK >> 3) & 1)) for (int rep_ = 0; rep_ <= ((REP_MASK >> 3) & 1); ++rep_) { MKCTX; attn_phase(F, a, 1, 1 + 4 * rep_); }
            END_STEP;
            if (RUN_STEP && ((PH_MASK >> 4) & 1)) for (int rep_ = 0; rep_ <= ((REP_MASK >> 4) & 1); ++rep_) { MKCTX; fin_phase(F, P, (bf16_t*)(F.dout + DO_R + (size_t)1 * TG * 1024), (const bf16_t*)(F.dout + DO_YC), a->ws + WS_ARENA + AR_YC8 + (size_t)1 * TG * 1024, a->in[I_SNG] + (size_t)1 * DM); }
            END_STEP;
        }
        if (RUN_STEP && ((PH_MASK >> 5) & 1)) for (int rep_ = 0; rep_ <= ((REP_MASK >> 5) & 1); ++rep_) { MKCTX;
            bf16_t* GT = (bf16_t*)(a->ws + WS_ARENA + AR_GATES); bf16_t* MX = (bf16_t*)(a->ws + WS_H18);   float* TMP = (float*)(F.dout + DO_TMP);
            pg8::Gemm g{nullptr, nullptr, 512, 512, 512};
            pg8::S5Order S; S.so.init(T_, DM, 512, 512, F.G, (int)blockIdx.x, 512);
            S.aH = (long)(size_t)(a->ws + WS_H8); S.aRY = (long)(size_t)(F.dout + DO_R); S.aYC = (long)(size_t)(a->ws + WS_ARENA + AR_YC8);
            S.bG = (long)(size_t)(wl + WO_GATE); S.bCN = (long)(size_t)(wl + WO_C); S.bS = (long)(size_t)(wl + WO_SSD);
            { LAS unsigned char* lut = F.lds + LDSX + LX_LUT;
              for (int i = F.tid; i < 1024; i += 512) lut[i] = (unsigned char)__float2int_rn(127.f * sigmoidf_((float)(i - 512) * (1.f / 64.f)));
              __syncthreads(); }
            pg8::Epi<pg8::EK_S5> E{GT, 3072, nullptr, 0, TMP, nullptr, MX, 1.f, (unsigned)(size_t)(F.lds + LDSX + LX_LUT)};
            pg8::gemm_phase<pg8::Epi<pg8::EK_S5>, pg8::S5Order, false, true>(F.lds, F.tid, g, S, E);
        }
        END_STEP;
        if (RUN_STEP && ((PH_MASK >> 6) & 1)) for (int rep_ = 0; rep_ <= ((REP_MASK >> 6) & 1); ++rep_) { MKCTX;
            pg8::Gemm g{(const bf16_t*)(a->ws + WS_H18), (const bf16_t*)(wl + WO_OUT), 512, 512, 512}; pg8::StaticOrder S; S.init(T_, DM, 512, 512, F.G, (int)blockIdx.x, 512);
            pg8::Epi<pg8::EK_WOUT> E{(bf16_t*)(a->ws + WS_PRE1), DM, Hb, DM, nullptr, nullptr, nullptr, 1.f / (WSCALE_OUT * MSCALE)};
            pg8::gemm_phase<pg8::Epi<pg8::EK_WOUT>, pg8::StaticOrder, false, true>(F.lds, F.tid, g, S, E);
        }
        END_STEP;
        if (RUN_STEP && ((PH_MASK >> 7) & 1)) for (int rep_ = 0; rep_ <= ((REP_MASK >> 7) & 1); ++rep_) { MKCTX; ln1_route_phase(F, a, 1); }
        END_STEP;
        int nrt_keep = -1;
        if (RUN_STEP && ((PH_MASK >> 9) & 1)) for (int rep_ = 0; rep_ <= ((REP_MASK >> 9) & 1); ++rep_) { MKCTX;
            const int nrt = moe_tables(F, 1, (const int*)(a->ws + WS_ARENA + AR_RTOK));
            nrt_keep = nrt;
            pg8::Gemm g{(const bf16_t*)(a->ws + WS_H18), (const bf16_t*)(wl + WO_UP), 512, 512, 512};
            pg8::MoeOrder S{(const LAS int*)(F.lds + LDSX + LX_TILE), (const LAS int*)(F.lds + LDSX + LX_OFF), (const LAS int*)(F.lds + LDSX + LX_ECNT), nrt, F.G, F.vcu, 8, (long)256 * DM, (long)256 * DM, (long)1024 * DM};
            pg8::Epi<pg8::EK_GLU> E{(bf16_t*)(a->ws + WS_ARENA + AR_HID), 512, nullptr, 0, nullptr, nullptr, nullptr, 1.f / (WSCALE * ASCALE)};
            pg8::gemm_phase<pg8::Epi<pg8::EK_GLU>, pg8::MoeOrder, true, true>(F.lds, F.tid, g, S, E, (const LAS int*)(F.lds + LDSX + LX_GIDX));
        }
        END_STEP;
        if (RUN_STEP && ((PH_MASK >> 10) & 1)) for (int rep_ = 0; rep_ <= ((REP_MASK >> 10) & 1); ++rep_) { MKCTX;
            const int nrt = (nrt_keep >= 0) ? nrt_keep : moe_tables(F, 1, nullptr);
            pg8::Gemm g{(const bf16_t*)(a->ws + WS_ARENA + AR_HID), (const bf16_t*)(wl + WO_DN), 256, 256, 256};
            pg8::MoeOrder S{(const LAS int*)(F.lds + LDSX + LX_TILE), (const LAS int*)(F.lds + LDSX + LX_OFF), (const LAS int*)(F.lds + LDSX + LX_ECNT), nrt, F.G, F.vcu, 4, (long)256 * 512, (long)256 * 512, (long)1024 * 512};
            pg8::Epi<pg8::EK_DOWN> E{(bf16_t*)(a->ws + WS_ARENA + AR_XS), DM, nullptr, 0, nullptr, (const int2*)(a->ws + WS_ARENA + AR_RINFO), nullptr, 1.f / (WSCALE_DN * HSCALE)};
            pg8::gemm_phase<pg8::Epi<pg8::EK_DOWN>, pg8::MoeOrder, false, true>(F.lds, F.tid, g, S, E);
        }
        END_STEP;
        if (RUN_STEP && ((PH_MASK >> 11) & 1)) for (int rep_ = 0; rep_ <= ((REP_MASK >> 11) & 1); ++rep_) { MKCTX; ln2_phase(F, a, 1, 1 == DEPTH - 1); }
        END_STEP;
    }
#undef RUN_STEP
#undef END_STEP
}

__global__ void dump_bf16(const bf16_t* src, float* dst, size_t n) { for (size_t i = (size_t)blockIdx.x * blockDim.x + threadIdx.x; i < n; i += (size_t)gridDim.x * blockDim.x) dst[i] = bf1(src[i]); }
#ifndef N_LAUNCH_MODE
#define N_LAUNCH_MODE 0
#endif
extern "C" void kernel_launch(void* const* d_in, const int* in_sizes, int n_in, void* d_out, int out_size, void* d_ws, size_t ws_size, hipStream_t stream) {
    static int grid = 0;
    if (grid == 0) {
        if (n_in != 32 || out_size != T_ * DM || ws_size < WS_END) { fprintf(stderr, "kernel_launch: unexpected problem (n_in %d out %d ws %zu)\n", n_in, out_size, ws_size); grid = -1; return; }
        int dev = 0, cus = 0, per_cu = 0;
        if (hipGetDevice(&dev) != hipSuccess || hipDeviceGetAttribute(&cus, hipDeviceAttributeMultiprocessorCount, dev) != hipSuccess) { grid = -1; return; }
        if (hipFuncSetAttribute((const void*)fwd_kernel, hipFuncAttributeMaxDynamicSharedMemorySize, LDS_TOTAL) != hipSuccess) { fprintf(stderr, "kernel_launch: hipFuncSetAttribute failed\n"); grid = -1; return; }
        if (hipOccupancyMaxActiveBlocksPerMultiprocessor(&per_cu, (const void*)fwd_kernel, 512, LDS_TOTAL) != hipSuccess || per_cu < 1)
            fprintf(stderr, "kernel_launch: occupancy query reports %d workgroups per CU\n", per_cu);
        (void)hipGetLastError();
        grid = cus;
    }
    if (grid < 0) return;
    (void)hipMemsetAsync((char*)d_ws + WS_CTL, 0, CTL_ZERO_BYTES, stream);
    Args a{};
    for (int i = 0; i < 32; ++i) a.in[i] = (const float*)d_in[i];
    a.out = (float*)d_out; a.ws = (unsigned char*)d_ws;
#if N_LAUNCH_MODE == 1
    a.lo = 0; a.hi = NSTEPS;
    hipLaunchKernelGGL(fwd_kernel, dim3(grid), dim3(512), LDS_TOTAL, stream, a);
#else
#ifdef DBG_STOP
    for (int s = 0; s <= DBG_STOP; ++s) { a.lo = s; a.hi = s + 1; hipLaunchKernelGGL(fwd_kernel, dim3(grid), dim3(512), LDS_TOTAL, stream, a); }
    hipLaunchKernelGGL(dump_bf16, dim3(1024), dim3(256), 0, stream, (const bf16_t*)((char*)d_ws + DBG_SRC), (float*)d_out, (size_t)T_ * DM);
#else
    for (int s = 0; s < NSTEPS; ++s) { a.lo = s; a.hi = s + 1; hipLaunchKernelGGL(fwd_kernel, dim3(grid), dim3(512), LDS_TOTAL, stream, a); }
#endif
#endif
}
```

```cpp
#define N_LAUNCH_MODE 1
#include <hip/hip_runtime.h>
#include <cstdio>
#include <cstdint>

#define LAS __attribute__((address_space(3)))
#define GAS __attribute__((address_space(1)))
typedef unsigned short bf16_t;
typedef short bf16x8 __attribute__((ext_vector_type(8)));
typedef short s16x4 __attribute__((ext_vector_type(4)));
typedef float f32x2 __attribute__((ext_vector_type(2)));
typedef float f32x4 __attribute__((ext_vector_type(4)));
typedef float f32x16 __attribute__((ext_vector_type(16)));
typedef unsigned u32x2 __attribute__((ext_vector_type(2)));
typedef unsigned u32x4 __attribute__((ext_vector_type(4)));

constexpr int T_ = 32768, SEQ = 2048, DM = 1024, NBATCH = 16, DEPTH = 2;
constexpr int NG = 2, BG = NBATCH / NG, TG = T_ / NG;
constexpr int LDP = 5120;
constexpr int C_POOL = 0, C_Q = 512, C_KV = 1024, C_Z = 1792, C_XBC = 2816, C_NG = 4864, C_DT = 4888;
constexpr int D_IN = 7976;
constexpr float LN_EPS = 1e-5f, DN_ALPHA = 1.41421356237f, LOG2E = 1.4426950408889634f;
constexpr float QSCALE = 0.125f * LOG2E;
constexpr float NEGBIG = -1e30f;
constexpr int MOE_ROWS = 69632;

constexpr size_t MiB = 1ull << 20;
constexpr size_t WS_CTL = 0, CTL_ZERO_BYTES = 65536;
constexpr size_t WS_MISC = 1 * MiB;
constexpr size_t WS_W = 2 * MiB, W_LAYER = 52 * MiB;
constexpr size_t WO_IN = 0, WO_GATE = 5 * MiB, WO_C = 11 * MiB, WO_NSA = 12 * MiB, WO_SSD = 13 * MiB, WO_OUT = 15 * MiB, WO_W1 = 17 * MiB, WO_W2 = 18 * MiB, WO_UP = 19 * MiB, WO_DN = 35 * MiB;
constexpr size_t WS_H = 106 * MiB, WS_PRE1 = 170 * MiB, WS_H8 = 234 * MiB, WS_H18 = 266 * MiB, WS_ARENA = 298 * MiB;
constexpr float P8SCALE = 24.f;
constexpr float RSCALE = 16.f, BSCALE = 16.f, YSCALE = 8.f, WSCALE_CN = 480.f;
constexpr float WSCALE = 704.f, ASCALE = 24.f, MSCALE = 32.f, HSCALE = 16.f, WSCALE_OUT = 1408.f, WSCALE_DN = 992.f;
constexpr size_t AR_P = 0, AR_GATES = 0, AR_YC8 = 160 * MiB;
constexpr size_t AR_XS = 0, AR_RTOK = 128 * MiB, AR_RINFO = 132 * MiB, AR_HID = 140 * MiB;
constexpr size_t WS_END = 506 * MiB;
constexpr int ECAP = 65536;
constexpr size_t DO_XC = 0, DO_TMP = 0, DO_YC = 64 * MiB, DO_R = 96 * MiB, DO_YC8 = 112 * MiB;
constexpr size_t MI_BIAS = 0, MI_B1 = 4096, MI_KC = 65536, MI_VC = MI_KC + 262144, MI_ROUTE = 1 * MiB, MI_RINFO = 2 * MiB;
constexpr int CW_BAR = 4096, CW_WQ = 8192, CW_CNT = 12288;
constexpr int LDS_TOTAL = 147456, LDSX = 131072;
constexpr int LX_BAR = 0, LX_WQ = 16, LX_OFF = 64, LX_ECNT = 160, LX_TILE = 256, LX_CNTL = 1536, LX_BASE = 1600, LX_ROWS = 2048, LX_GIDX = 6144, LX_LUT = 14336;

__device__ __forceinline__ float bflo(unsigned u) { return __uint_as_float(u << 16); }
__device__ __forceinline__ float bfhi(unsigned u) { return __uint_as_float(u & 0xffff0000u); }
__device__ __forceinline__ float bf1(bf16_t b) { return __uint_as_float(((unsigned)b) << 16); }
typedef __bf16 bf16x2_t __attribute__((ext_vector_type(2)));
__device__ __forceinline__ unsigned cvt_pk_bf16(float lo, float hi) { const f32x2 v = {lo, hi}; const bf16x2_t b = __builtin_convertvector(v, bf16x2_t); return __builtin_bit_cast(unsigned, b); }
__device__ __forceinline__ bf16_t f2bf(float f) { return (bf16_t)(cvt_pk_bf16(f, 0.f) & 0xffffu); }
__device__ __forceinline__ float fexp2(float x) { return __builtin_amdgcn_exp2f(x); }
__device__ __forceinline__ float frcp(float x) { return __builtin_amdgcn_rcpf(x); }
__device__ __forceinline__ float sigmoidf_(float x) { return frcp(1.f + fexp2(-x * LOG2E)); }
__device__ __forceinline__ float siluf_(float x) { return x * sigmoidf_(x); }
__device__ __forceinline__ float wave_sum(float v) {
#pragma unroll
    for (int o = 1; o < 64; o <<= 1) v += __shfl_xor(v, o);
    return v;
}
__device__ __forceinline__ float wave_scan_incl(float v) {
#define WS_DPP(ctrl, rmask) __int_as_float(__builtin_amdgcn_update_dpp(0, __float_as_int(v), ctrl, rmask, 0xf, false))
    v += WS_DPP(0x111, 0xf); v += WS_DPP(0x112, 0xf); v += WS_DPP(0x114, 0xf); v += WS_DPP(0x118, 0xf);
    v += WS_DPP(0x142, 0xa); v += WS_DPP(0x143, 0xc);
#undef WS_DPP
    return v;
}
__device__ __forceinline__ void unpack8(const u32x4 v, float (&x)[8]) {
    x[0] = bflo(v.x); x[1] = bfhi(v.x); x[2] = bflo(v.y); x[3] = bfhi(v.y); x[4] = bflo(v.z); x[5] = bfhi(v.z); x[6] = bflo(v.w); x[7] = bfhi(v.w);
}
__device__ __forceinline__ u32x4 pack8(const float (&x)[8]) {
    u32x4 w; w.x = cvt_pk_bf16(x[0], x[1]); w.y = cvt_pk_bf16(x[2], x[3]); w.z = cvt_pk_bf16(x[4], x[5]); w.w = cvt_pk_bf16(x[6], x[7]); return w;
}
typedef int v4i __attribute__((ext_vector_type(4)));
__device__ __forceinline__ unsigned q1_i8(float x) { int q = __float2int_rn(x); q = q < -127 ? -127 : (q > 127 ? 127 : q); return (unsigned)q & 255u; }
__device__ __forceinline__ unsigned cvt4_i8s(float a, float b, float c, float d, float sc) {
    const float M = 12582912.f;
    const unsigned ua = __float_as_uint(__builtin_amdgcn_fmed3f(fmaf(a, sc, M), M - 127.f, M + 127.f)), ub = __float_as_uint(__builtin_amdgcn_fmed3f(fmaf(b, sc, M), M - 127.f, M + 127.f));
    const unsigned uc = __float_as_uint(__builtin_amdgcn_fmed3f(fmaf(c, sc, M), M - 127.f, M + 127.f)), ud = __float_as_uint(__builtin_amdgcn_fmed3f(fmaf(d, sc, M), M - 127.f, M + 127.f));
    const unsigned lo = __builtin_amdgcn_perm(ub, ua, 0x0c0c0400u), hi = __builtin_amdgcn_perm(ud, uc, 0x04000c0cu);
    return lo | hi;
}
__device__ __forceinline__ unsigned cvt4_i8(float a, float b, float c, float d) { return cvt4_i8s(a, b, c, d, 1.f); }
__device__ __forceinline__ u32x2 pack8_i8(const float (&x)[8], float sc) { u32x2 w; w.x = cvt4_i8s(x[0], x[1], x[2], x[3], sc); w.y = cvt4_i8s(x[4], x[5], x[6], x[7], sc); return w; }
__device__ __forceinline__ void unpack4_i8(unsigned w, float* x) { const unsigned u = w ^ 0x80808080u;
    x[0] = (float)(u & 255u) - 128.f; x[1] = (float)((u >> 8) & 255u) - 128.f; x[2] = (float)((u >> 16) & 255u) - 128.f; x[3] = (float)(u >> 24) - 128.f; }
__device__ __forceinline__ void unpack8_i8(const u32x2 w, float (&x)[8]) { unpack4_i8(w.x, x); unpack4_i8(w.y, x + 4); }
#define LDS_WAIT() asm volatile("s_waitcnt lgkmcnt(0)" ::: "memory")
__device__ __forceinline__ int crow(int r, int hi) { return (r & 3) + 8 * (r >> 2) + 4 * hi; }
__device__ __forceinline__ f32x16 mfma32(bf16x8 a, bf16x8 b, f32x16 c) { return __builtin_amdgcn_mfma_f32_32x32x16_bf16(a, b, c, 0, 0, 0); }
__device__ __forceinline__ f32x4 mfma16(bf16x8 a, bf16x8 b, f32x4 c) { return __builtin_amdgcn_mfma_f32_16x16x32_bf16(a, b, c, 0, 0, 0); }
typedef short v4i16_t __attribute__((ext_vector_type(4)));
__device__ __forceinline__ s16x4 trrd(const LAS unsigned char* p) { return __builtin_bit_cast(s16x4, __builtin_amdgcn_ds_read_tr16_b64_v4i16((LAS v4i16_t*)p)); }
__device__ __forceinline__ bf16x8 cat8(s16x4 lo, s16x4 hi) { return (bf16x8){lo[0], lo[1], lo[2], lo[3], hi[0], hi[1], hi[2], hi[3]}; }

namespace pg8 {
constexpr int BM = 256, BK = 64, HALF = 128, HTB = HALF * BK * 2, STAGE_BYTES = 8 * HTB, NXCD = 8, WGM = 8;
__host__ __device__ __forceinline__ int lds_byte(int r, int c) { const int st = (r >> 4) * 2 + (c >> 5), rr = r & 15, cc = c & 31, ob = rr * 64 + cc * 2; return st * 1024 + (ob ^ (((ob >> 9) & 1) << 5)); }
__host__ __device__ __forceinline__ void stage_rc(int b, int& R, int& C) { const int st = b / 1024, sb = b % 1024, swz = sb ^ (((sb >> 9) & 1) << 5); R = (st >> 1) * 16 + swz / 64; C = (st & 1) * 32 + (swz % 64) / 2; }
__host__ __device__ __forceinline__ int perm32(int rho) { const int n = rho >> 4, i = rho & 15; return 8 * (i >> 2) + 4 * n + (i & 3); }

struct Unit { int pm, pn, nt, kind, gx, nv, gi; long ab, bb; };
struct Gemm { const bf16_t* A; const bf16_t* Bt; int lda, ldb, K; };

struct StaticOrder {
    int nM, nN, nwg, G, c, nt0; long tsA, tsB;
    __device__ void init(int M, int N, int lda, int ldb, int G_, int c_, int K_ = 1024) { nM = M / BM; nN = N / BM; nwg = nM * nN; G = G_; c = c_; nt0 = K_ / BK; tsA = (long)BM * lda * 2; tsB = (long)BM * ldb * 2; }
    __device__ bool next(int i, Unit& u) const {
        const long L = (long)i * G + c; if (L >= nwg) return false;
        int wgid = (int)L; { const int q = nwg / NXCD, r = nwg % NXCD, xcd = wgid % NXCD, off = wgid / NXCD; wgid = (xcd < r ? xcd * (q + 1) : r * (q + 1) + (xcd - r) * q) + off; }
        const int nig = WGM * nN, gid = wgid / nig, fm = gid * WGM, gsz = (nM - fm) < WGM ? (nM - fm) : WGM;
        u.pm = fm + ((wgid % nig) % gsz); u.pn = (wgid % nig) / gsz; u.ab = u.pm * tsA; u.bb = u.pn * tsB; u.nt = nt0; u.kind = 0; u.gx = 0; u.nv = 0; u.gi = 0; return true;
    }
};
struct S5Order {
    StaticOrder so; long aH, aRY, aYC, bG, bCN, bS;
    __device__ bool next(int i, Unit& u) const {
        const int base = i / 6, s = i - 6 * base, x = s >> 1;
        if (!so.next(base, u)) return false;
        const long ra = u.ab, rb = u.bb;
        if ((s & 1) == 0) { u.ab = aH + ra; u.bb = bG + rb + (long)x * 1024 * 1024; u.nt = 8; u.kind = 0; u.pn += 4 * x; }
        else if (x == 0) { u.ab = aRY + ra; u.bb = bCN + rb; u.nt = 4; u.kind = 1; }
        else if (x == 1) { u.ab = aRY + ra + 512; u.bb = bCN + rb + 512; u.nt = 4; u.kind = 2; }
        else { u.ab = aYC + ra; u.bb = bS + rb; u.nt = 8; u.kind = 3; }
        return true;
    }
};
struct MoeOrder {
    const LAS int* tile_e; const LAS int* off; const LAS int* cnt; int nrt, G, vcu, nt0; long tsA, tsB, eB;
    __device__ bool next(int i, Unit& u) const {
        const long L = (long)i * G + vcu; if (L >= (long)nrt * 4) return false;
        const int rt = (int)(L >> 2), pn = (int)(L & 3), e = __builtin_amdgcn_readfirstlane(tile_e[rt]), k0 = rt * 256 - __builtin_amdgcn_readfirstlane(off[e]), c = __builtin_amdgcn_readfirstlane(cnt[e]);
        u.pm = rt; u.pn = pn; u.ab = rt * tsA; u.bb = e * eB + pn * tsB; u.nt = nt0; u.kind = 0; u.gx = e * ECAP + k0; u.nv = (c - k0) < 256 ? (c - k0) : 256; u.gi = i; return true;
    }
};

template <class Epi, class Sched, bool GATHER = false, bool FP8 = false>
__device__ __forceinline__ void gemm_phase(LAS unsigned char* lds, int tid_, const Gemm g, const Sched& S, const Epi& E, const LAS int* gidx = nullptr) {
    asm volatile("" : "+v"(tid_));
    const int tid = tid_, wid = __builtin_amdgcn_readfirstlane(tid >> 6), lane = tid & 63, wr = wid >> 2, wc = wid & 3, fr = lane & 15, fq = lane >> 4;
    unsigned voffA0[2], voffA1[2], nvA0[2], nvA1[2], voffB[2]; int RA[2], CA[2];
#pragma unroll
    for (int i = 0; i < 2; ++i) { int R, C; stage_rc(tid * 16 + i * 8192, R, C); const int Rb = Epi::PERM ? ((R & ~31) + perm32(R & 31)) : R; RA[i] = R; CA[i] = C;
        voffA0[i] = (unsigned)(R * g.lda + C) * 2u; voffA1[i] = (unsigned)((R + HALF) * g.lda + C) * 2u; nvA0[i] = voffA0[i]; nvA1[i] = voffA1[i]; voffB[i] = (unsigned)(Rb * g.ldb + C) * 2u; }
#define PG8_GATHER(dst0, dst1, u_) do { _Pragma("unroll") for (int _i = 0; _i < 2; ++_i) { \
        dst0[_i] = (unsigned)(gidx[((u_).gi & 7) * 256 + RA[_i]] * g.lda + CA[_i]) * 2u; dst1[_i] = (unsigned)(gidx[((u_).gi & 7) * 256 + HALF + RA[_i]] * g.lda + CA[_i]) * 2u; } } while (0)
    const size_t kstep = (size_t)(BK * 2);
    const size_t hstepB = (size_t)HALF * g.ldb * 2;
    const unsigned ldsw = (unsigned)wid * 1024u;
    const int aoff = lds_byte(wr * 64 + fr, fq * 8), boff = lds_byte(wc * 32 + fr, fq * 8);
#define PG8_SA(b, h) (((b) * 2 + (h)) * HTB)
#define PG8_SB(b, h) ((4 + (b) * 2 + (h)) * HTB)
#define PG8_STAGE(bufoff, gbase, voff) do { _Pragma("unroll") for (int _i = 0; _i < 2; ++_i) \
        __builtin_amdgcn_global_load_lds((const unsigned*)((const char*)(gbase) + (voff)[_i]), (LAS unsigned*)(lds + (bufoff) + ldsw + _i * 8192), 16, 0, 0); } while (0)
#define PG8_LDA(dst, b, h) do { _Pragma("unroll") for (int m = 0; m < 4; ++m) _Pragma("unroll") for (int k = 0; k < 2; ++k) dst[m][k] = *(const LAS bf16x8*)(lds + PG8_SA(b, h) + aoff + m * 2048 + k * 1024); } while (0)
#define PG8_LDB(dst, b, h) do { _Pragma("unroll") for (int n = 0; n < 2; ++n) _Pragma("unroll") for (int k = 0; k < 2; ++k) dst[n][k] = *(const LAS bf16x8*)(lds + PG8_SB(b, h) + boff + n * 2048 + k * 1024); } while (0)
#define PG8_MMA(ai, bj, At, Bt) do { __builtin_amdgcn_s_setprio(1); _Pragma("unroll") for (int m = 0; m < 4; ++m) _Pragma("unroll") for (int n = 0; n < 2; ++n) _Pragma("unroll") for (int k = 0; k < 2; ++k) { \
        if constexpr (FP8) acc[ai][bj][m][n] = __builtin_bit_cast(f32x4, __builtin_amdgcn_mfma_i32_16x16x64_i8(__builtin_bit_cast(v4i, Bt[n][k]), __builtin_bit_cast(v4i, At[m][k]), __builtin_bit_cast(v4i, acc[ai][bj][m][n]), 0, 0, 0)); \
        else acc[ai][bj][m][n] = __builtin_amdgcn_mfma_f32_16x16x32_bf16(Bt[n][k], At[m][k], acc[ai][bj][m][n], 0, 0, 0); } __builtin_amdgcn_s_setprio(0); } while (0)
#define PG8_WAIT_V(n) asm volatile("s_waitcnt vmcnt(" #n ")" ::: "memory")
#define PG8_WAIT_L(n) asm volatile("s_waitcnt lgkmcnt(" #n ")" ::: "memory")
#define PG8_WAIT_V8R(sel) asm volatile("s_cmp_eq_u32 %0, 0\n\ts_cbranch_scc1 .Lpg8rx%=\n\ts_waitcnt vmcnt(8)\n.Lpg8rx%=:\n\ts_waitcnt vmcnt(%1)" :: "s"(__builtin_amdgcn_readfirstlane(sel)), "n"(8 + Epi::NST) : "memory", "scc")
#define PG8_BAR __builtin_amdgcn_s_barrier()
#define PG8_SCHED __builtin_amdgcn_sched_barrier(0)
    Unit cur, nxt; int ui = 0;
    if (!S.next(0, cur)) return;
    f32x4 acc[2][2][4][2];
#pragma unroll
    for (int a = 0; a < 2; ++a)
#pragma unroll
        for (int b = 0; b < 2; ++b)
#pragma unroll
            for (int m = 0; m < 4; ++m)
#pragma unroll
                for (int n = 0; n < 2; ++n) acc[a][b][m][n] = (f32x4){0.f, 0.f, 0.f, 0.f};
    bf16x8 At[4][2], B0[2][2], B1[2][2];
    const char* cA = (const char*)g.A + (GATHER ? 0 : cur.ab); const char* cB = (const char*)g.Bt + cur.bb;
    if constexpr (GATHER) PG8_GATHER(voffA0, voffA1, cur);
    PG8_STAGE(PG8_SB(0, 0), cB, voffB); PG8_STAGE(PG8_SB(0, 1), cB + hstepB, voffB); PG8_STAGE(PG8_SA(0, 0), cA, voffA0); PG8_STAGE(PG8_SA(0, 1), cA, voffA1);
    if (wr == 1) PG8_BAR;
    PG8_WAIT_V(2); PG8_BAR;
    PG8_STAGE(PG8_SB(1, 0), cB + kstep, voffB); PG8_STAGE(PG8_SA(1, 0), cA + kstep, voffA0); PG8_STAGE(PG8_SB(1, 1), cB + hstepB + kstep, voffB);
    PG8_WAIT_V(6); PG8_BAR;
    for (;;) {
        const bool has_next = S.next(ui + 1, nxt);
        const char* nA = (has_next && !GATHER) ? (const char*)g.A + nxt.ab : cA; const char* nB = has_next ? (const char*)g.Bt + nxt.bb : cB;
        if constexpr (GATHER) { if (has_next) PG8_GATHER(nvA0, nvA1, nxt); else { nvA0[0] = voffA0[0]; nvA0[1] = voffA0[1]; nvA1[0] = voffA1[0]; nvA1[1] = voffA1[1]; } }
        const int nt = cur.nt; const int tf = (ui == 0) ? 1 : 0;
        for (int t = 0; t < nt; t += 2) {
            const bool last = (t == nt - 2);
            const char* a1 = cA + (size_t)(t + 1) * kstep;
            const char* a2 = last ? nA : cA + (size_t)(t + 2) * kstep; const char* b2 = last ? nB : cB + (size_t)(t + 2) * kstep;
            const char* a3 = a2 + kstep; const char* b3 = b2 + kstep;
            unsigned xA0[2], xA1[2];
            xA0[0] = (GATHER && last) ? nvA0[0] : voffA0[0]; xA0[1] = (GATHER && last) ? nvA0[1] : voffA0[1]; xA1[0] = (GATHER && last) ? nvA1[0] : voffA1[0]; xA1[1] = (GATHER && last) ? nvA1[1] : voffA1[1];
            PG8_LDB(B0, 0, 0); PG8_LDB(B1, 0, 1); PG8_SCHED; PG8_LDA(At, 0, 0); PG8_STAGE(PG8_SA(1, 1), a1, voffA1);
            PG8_WAIT_V8R(t + tf); PG8_WAIT_L(0); PG8_BAR; PG8_MMA(0, 0, At, B0); PG8_MMA(0, 1, At, B1); PG8_BAR; PG8_SCHED;
            PG8_LDA(At, 0, 1); PG8_STAGE(PG8_SB(0, 0), b2, voffB); PG8_STAGE(PG8_SB(0, 1), b2 + hstepB, voffB); PG8_STAGE(PG8_SA(0, 0), a2, xA0);
            PG8_WAIT_V8R(t + tf); PG8_WAIT_L(0); PG8_BAR; PG8_MMA(1, 0, At, B0); PG8_MMA(1, 1, At, B1); PG8_BAR; PG8_SCHED;
            PG8_LDB(B0, 1, 0); PG8_LDB(B1, 1, 1); PG8_SCHED; PG8_LDA(At, 1, 0); PG8_STAGE(PG8_SA(0, 1), a2, xA1);
            PG8_WAIT_V(8); PG8_WAIT_L(0); PG8_BAR; PG8_MMA(0, 0, At, B0); PG8_MMA(0, 1, At, B1); PG8_BAR; PG8_SCHED;
            PG8_LDA(At, 1, 1); PG8_STAGE(PG8_SB(1, 0), b3, voffB); PG8_STAGE(PG8_SB(1, 1), b3 + hstepB, voffB); PG8_STAGE(PG8_SA(1, 0), a3, xA0);
            PG8_WAIT_V(8); PG8_WAIT_L(0); PG8_BAR; PG8_MMA(1, 0, At, B0); PG8_MMA(1, 1, At, B1); PG8_BAR; PG8_SCHED;
        }
        if (wr == 0) PG8_BAR;
        if constexpr (FP8) {
#pragma unroll
            for (int a = 0; a < 2; ++a)
#pragma unroll
                for (int b = 0; b < 2; ++b)
#pragma unroll
                    for (int m = 0; m < 4; ++m)
#pragma unroll
                        for (int n = 0; n < 2; ++n)
#pragma unroll
                            for (int j = 0; j < 4; ++j) acc[a][b][m][n][j] = (float)__float_as_int(acc[a][b][m][n][j]);
        }
        E(acc, cur, wr, wc, fr, fq);
        if (!has_next) break;
#pragma unroll
        for (int a = 0; a < 2; ++a)
#pragma unroll
            for (int b = 0; b < 2; ++b)
#pragma unroll
                for (int m = 0; m < 4; ++m)
#pragma unroll
                    for (int n = 0; n < 2; ++n) acc[a][b][m][n] = (f32x4){0.f, 0.f, 0.f, 0.f};
        cur = nxt; cA = nA; cB = nB; ++ui;
        if constexpr (GATHER) { voffA0[0] = nvA0[0]; voffA0[1] = nvA0[1]; voffA1[0] = nvA1[0]; voffA1[1] = nvA1[1]; }
        if (wr == 1) PG8_BAR;
    }
    PG8_WAIT_V(0);
    PG8_BAR;
#undef PG8_GATHER
#undef PG8_SA
#undef PG8_SB
#undef PG8_STAGE
#undef PG8_LDA
#undef PG8_LDB
#undef PG8_MMA
#undef PG8_WAIT_V
#undef PG8_WAIT_V8R
#undef PG8_WAIT_L
#undef PG8_BAR
#undef PG8_SCHED
}

enum { EK_PROJ = 0, EK_GATE, EK_BR0, EK_BR1, EK_BR2, EK_WOUT, EK_GLU, EK_DOWN, EK_S5 };
template <int KIND> struct Epi {
    static constexpr int NST = (KIND == EK_DOWN) ? 0 : ((KIND == EK_GLU) ? 8 : 16);
    static constexpr bool PERM = true;
    bf16_t* O; int ldo;
    const bf16_t* X; int ldx;
    float* F;
    const int2* RI;
    bf16_t* O2;
    float osc;
    unsigned lut;
    template <int MODE> __device__ __forceinline__ void proj_tiles(const f32x4 (&acc)[2][2][4][2], int row0, int col0, int segb) const {
        const float mul = (MODE == 1) ? osc * QSCALE : ((MODE == 3) ? osc * P8SCALE : osc);
#pragma unroll
        for (int ai = 0; ai < 2; ++ai)
#pragma unroll
            for (int m = 0; m < 4; ++m) {
                const int row = row0 + ai * HALF + m * 16;
#pragma unroll
                for (int bj = 0; bj < 2; ++bj) {
                    const int col = col0 + bj * HALF; float v[8];
#pragma unroll
                    for (int n = 0; n < 2; ++n)
#pragma unroll
                        for (int j = 0; j < 4; ++j) v[4 * n + j] = acc[ai][bj][m][n][j] * mul;
                    if constexpr (MODE == 2) {
#pragma unroll
                        for (int j = 0; j < 8; ++j) v[j] = siluf_(v[j]) * P8SCALE;
                    }
                    if constexpr (MODE >= 2) *(u32x2*)((unsigned char*)O + (size_t)row * ldo * 2 + col + segb) = pack8_i8(v, 1.f);
                    else *(u32x4*)(O + (size_t)row * ldo + col) = pack8(v);
                    asm volatile("" ::: "memory");
                }
            }
    }
    __device__ __forceinline__ void operator()(const f32x4 (&acc)[2][2][4][2], const Unit& u, int wr, int wc, int fr, int fq) const {
        const int row0 = u.pm * BM + wr * 64 + fr, col0 = u.pn * BM + wc * 32 + 8 * fq;
        if constexpr (KIND == EK_GLU) {
            const int hc0 = u.pn * 128 + wc * 32 + 8 * fq;
#pragma unroll
            for (int ai = 0; ai < 2; ++ai)
#pragma unroll
                for (int m = 0; m < 4; ++m) {
                    const int row = row0 + ai * HALF + m * 16; float o[8];
#pragma unroll
                    for (int n = 0; n < 2; ++n)
#pragma unroll
                        for (int j = 0; j < 4; ++j) o[4 * n + j] = siluf_(acc[ai][0][m][n][j] * osc) * (acc[ai][1][m][n][j] * osc);
                    *(u32x2*)((unsigned char*)O + (size_t)row * ldo + hc0) = pack8_i8(o, HSCALE);
                    asm volatile("" ::: "memory");
                }
        } else if constexpr (KIND == EK_DOWN) {
#pragma unroll
            for (int ai = 0; ai < 2; ++ai)
#pragma unroll
                for (int m = 0; m < 4; ++m) {
                    const int lr = ai * HALF + wr * 64 + m * 16 + fr; const bool ok = lr < u.nv; const int2 ri = RI[u.gx + (ok ? lr : 0)]; const float w = __int_as_float(ri.y) * osc;
                    if (ok) {
#pragma unroll
                        for (int bj = 0; bj < 2; ++bj) { float o[8];
#pragma unroll
                            for (int n = 0; n < 2; ++n)
#pragma unroll
                                for (int j = 0; j < 4; ++j) o[4 * n + j] = w * acc[ai][bj][m][n][j];
                            *(u32x4*)(O + (size_t)ri.x * ldo + col0 + bj * HALF) = pack8(o); }
                    }
                    asm volatile("" ::: "memory");
                }
        } else if constexpr (KIND == EK_PROJ) {
            const int pn = u.pn;
            if (pn == 2 || pn == 3) proj_tiles<1>(acc, row0, col0, 0);
            else if (pn >= 7 && pn <= 10) proj_tiles<2>(acc, row0, col0, C_Z);
            else if (pn < 2) proj_tiles<3>(acc, row0, col0, C_POOL);
            else if (pn >= 11 && pn <= 18) proj_tiles<3>(acc, row0, col0, C_XBC);
            else proj_tiles<0>(acc, row0, col0, 0);
        } else if constexpr (KIND == EK_S5) {
            if (u.kind == 0) { Epi<EK_GATE> e{O, ldo, nullptr, 0, nullptr, nullptr, nullptr, 1.f / (WSCALE * ASCALE), lut}; e(acc, u, wr, wc, fr, fq); }
            else if (u.kind == 1) { Epi<EK_BR0> e{nullptr, 0, O, ldo, F, nullptr, nullptr, 1.f / (RSCALE * WSCALE_CN)}; e(acc, u, wr, wc, fr, fq); }
            else if (u.kind == 2) { Epi<EK_BR1> e{nullptr, 0, (const bf16_t*)((const unsigned char*)O + 1024), ldo, F, nullptr, nullptr, 1.f / (BSCALE * WSCALE_CN)}; e(acc, u, wr, wc, fr, fq); }
            else { Epi<EK_BR2> e{O2, 1024, (const bf16_t*)((const unsigned char*)O + 2048), ldo, F, nullptr, nullptr, 1.f / (YSCALE * WSCALE)}; e(acc, u, wr, wc, fr, fq); }
        } else {
            constexpr bool HAS_G = (KIND == EK_BR0 || KIND == EK_BR1 || KIND == EK_BR2), HAS_S = (KIND == EK_BR1 || KIND == EK_BR2 || KIND == EK_WOUT);
#pragma unroll
            for (int ai = 0; ai < 2; ++ai) {
                u32x2 gq[8]; u32x4 sq[8];
                if constexpr (HAS_G || HAS_S) {
#pragma unroll
                    for (int m = 0; m < 4; ++m)
#pragma unroll
                        for (int bj = 0; bj < 2; ++bj) {
                            const int row = row0 + ai * HALF + m * 16, col = col0 + bj * HALF;
                            if constexpr (HAS_G) gq[m * 2 + bj] = *(const u32x2*)((const unsigned char*)X + (size_t)row * ldx + col);
                            if constexpr (KIND == EK_BR1 || KIND == EK_BR2) sq[m * 2 + bj] = *(const u32x4*)((const bf16_t*)F + (size_t)row * 1024 + col);
                            if constexpr (KIND == EK_WOUT) sq[m * 2 + bj] = *(const u32x4*)(X + (size_t)row * ldx + col);
                        }
                    __builtin_amdgcn_sched_barrier(0);
                }
#pragma unroll
                for (int m = 0; m < 4; ++m) {
                    const int row = row0 + ai * HALF + m * 16;
#pragma unroll
                    for (int bj = 0; bj < 2; ++bj) {
                        const int col = col0 + bj * HALF; float v[8];
#pragma unroll
                        for (int n = 0; n < 2; ++n)
#pragma unroll
                            for (int j = 0; j < 4; ++j) v[4 * n + j] = acc[ai][bj][m][n][j];
                        if constexpr (KIND == EK_GATE) {
                            unsigned gb[8];
#pragma unroll
                            for (int j = 0; j < 8; ++j) { const float t = __builtin_amdgcn_fmed3f(fmaf(v[j], osc * 64.f, 512.5f), 0.f, 1023.f);
                                gb[j] = *(const LAS unsigned char*)(size_t)(lut + (unsigned)(int)t); }
                            u32x2 gw; gw.x = gb[0] | (gb[1] << 8) | (gb[2] << 16) | (gb[3] << 24); gw.y = gb[4] | (gb[5] << 8) | (gb[6] << 16) | (gb[7] << 24);
                            *(u32x2*)((unsigned char*)O + (size_t)row * ldo + col) = gw;
                        } else if constexpr (HAS_G) {
                            const u32x2 gw = gq[m * 2 + bj]; float gt[8];
#pragma unroll
                            for (int j = 0; j < 4; ++j) { gt[j] = (float)((gw.x >> (8 * j)) & 255u) * (osc * (1.f / 127.f)); gt[4 + j] = (float)((gw.y >> (8 * j)) & 255u) * (osc * (1.f / 127.f)); }
                            bf16_t* fp = (bf16_t*)F + (size_t)row * 1024 + col;
                            if constexpr (KIND == EK_BR0) {
                                float s[8];
#pragma unroll
                                for (int j = 0; j < 8; ++j) s[j] = gt[j] * v[j];
                                *(u32x4*)fp = pack8(s);
                            } else {
                                float s[8]; unpack8(sq[m * 2 + bj], s);
#pragma unroll
                                for (int j = 0; j < 8; ++j) s[j] += gt[j] * v[j];
                                if constexpr (KIND == EK_BR1) *(u32x4*)fp = pack8(s);
                                else *(u32x2*)((unsigned char*)O + (size_t)row * ldo + col) = pack8_i8(s, MSCALE);
                            }
                        } else if constexpr (KIND == EK_WOUT) {
                            float hv[8]; unpack8(sq[m * 2 + bj], hv);
#pragma unroll
                            for (int j = 0; j < 8; ++j) v[j] = v[j] * osc + DN_ALPHA * hv[j];
                            *(u32x4*)(O + (size_t)row * ldo + col) = pack8(v);
                        }
                    }
                }
                asm volatile("" ::: "memory");
            }
        }
    }
};
}

#define XB_TMO      128
#define XB_XCNT(j)  (256  + 64 * (j))
#define XB_XSUB(j)  (1280 + 64 * (j))
#define XB_XGEN(j)  (2304 + 64 * (j))
#define XB_TOP      3328
#define XB_TOPGEN   3392
#define XCD_BAR_WORDS 3456
#define XB_SPIN_CAP (1u << 20)
__device__ __forceinline__ unsigned xb_ld(unsigned* p)              { return __hip_atomic_load(p, __ATOMIC_RELAXED, __HIP_MEMORY_SCOPE_AGENT); }
__device__ __forceinline__ unsigned xb_add(unsigned* p, unsigned v) { return __hip_atomic_fetch_add(p, v, __ATOMIC_RELAXED, __HIP_MEMORY_SCOPE_AGENT); }
__device__ __forceinline__ unsigned xb_xcc_id() { return (unsigned)__builtin_amdgcn_s_getreg((3 << 11) | 20) & 0xFu; }
#define XB_SPIN(cond, bar) do { unsigned _sp = 0; while (cond) { __builtin_amdgcn_s_sleep(1); \
    if ((++_sp & 255u) == 0u) { if (xb_ld(&(bar)[XB_TMO])) break; if (_sp > XB_SPIN_CAP) { atomicAdd(&(bar)[XB_TMO], 1u); break; } } } } while (0)
struct XcdBarrier { unsigned* bar; unsigned x; volatile LAS unsigned* st; };
__device__ __forceinline__ XcdBarrier xcd_barrier_post(unsigned* bar, volatile LAS unsigned* st, int tid) {
    XcdBarrier b; b.bar = bar; b.x = xb_xcc_id(); b.st = st;
    if (tid == 0) (void)xb_add(&bar[XB_XCNT(b.x)], 1u);
    return b;
}
__device__ __forceinline__ void xcd_barrier_complete(unsigned* bar, unsigned x, unsigned& nloc, unsigned& nx) {
    const unsigned G = gridDim.x * gridDim.y * gridDim.z;
    unsigned sum, cnt, mine, sp = 0u;
    for (;;) {
        sum = 0u; cnt = 0u; mine = 0u;
#pragma unroll
        for (unsigned j = 0; j < 16; ++j) { const unsigned c = xb_ld(&bar[XB_XCNT(j)]); sum += c; cnt += (c > 0u) ? 1u : 0u; mine = (j == x) ? c : mine; }
        if (sum == G) break;
        __builtin_amdgcn_s_sleep(1);
        if ((++sp & 255u) == 0u) { if (xb_ld(&bar[XB_TMO])) break; if (sp > XB_SPIN_CAP) { atomicAdd(&bar[XB_TMO], 1u); break; } }
    }
    nloc = mine > 0u ? mine : 1u; nx = cnt > 0u ? cnt : 1u;
}
__device__ __forceinline__ void xcd_barrier(const XcdBarrier& b, int tid) {
    asm volatile("s_waitcnt vmcnt(0)" ::: "memory");
    __syncthreads();
    if (tid == 0) {
        unsigned* bar = b.bar;
        __builtin_amdgcn_s_waitcnt(0);
        unsigned nloc = b.st[0], nx = b.st[1];
        if (nloc == 0u) { xcd_barrier_complete(bar, b.x, nloc, nx); b.st[0] = nloc; b.st[1] = nx; }
        const unsigned old = xb_add(&bar[XB_XSUB(b.x)], 1u);
        const unsigned gen = old / nloc;
        if (old + 1u == (gen + 1u) * nloc) {
            __builtin_amdgcn_fence(__ATOMIC_RELEASE, "agent");
            asm volatile("s_waitcnt vmcnt(0)" ::: "memory");
            const unsigned og = xb_add(&bar[XB_TOP], 1u);
            const unsigned tg = og / nx;
            if (og + 1u == (tg + 1u) * nx) xb_add(&bar[XB_TOPGEN], 1u);
            else XB_SPIN(xb_ld(&bar[XB_TOPGEN]) == tg, bar);
            __builtin_amdgcn_fence(__ATOMIC_ACQUIRE, "agent");
            xb_add(&bar[XB_XGEN(b.x)], 1u);
            asm volatile("s_waitcnt vmcnt(0)" ::: "memory");
        } else {
            XB_SPIN(xb_ld(&bar[XB_XGEN(b.x)]) == gen, bar);
            __builtin_amdgcn_fence(__ATOMIC_ACQUIRE, "agent");
            asm volatile("s_waitcnt vmcnt(0)" ::: "memory");
        }
    }
    __syncthreads();
}

struct Args { const float* in[32]; float* out; unsigned char* ws; int lo, hi; };
typedef const __attribute__((address_space(4))) Args* ArgsP;
enum { I_X = 0, I_LN0G, I_LN0B, I_WIN, I_POOLW, I_POOLS, I_CKPE, I_CKW1, I_CKW2, I_CVPE, I_CVW1, I_CVW2, I_RELB, I_CONVW, I_CONVB, I_DTB, I_ALOG, I_DSKIP, I_SNG,
       I_WBP, I_WBN, I_WBS, I_WOUT, I_LN1G, I_LN1B, I_RW, I_RB, I_EW1, I_EW3, I_EW2, I_LN2G, I_LN2B };


struct Ctx {
    LAS unsigned char* lds;
    unsigned* ctl;
    unsigned char* ws; unsigned char* dout;
    int tid, lane, wave, G, vcu, gw, NGW;
};

struct Job { const float* src; size_t sbatch; int ldw, K, c0, ncols; bf16_t* dst; int dbatch_rows, ldt, drow0, mode, nbatch, fp8; float wsc; };
constexpr int NJOBS = 15;
__device__ __forceinline__ Job get_job(ArgsP a, int l, int j) {
    unsigned char* wl = a->ws + WS_W + (size_t)l * W_LAYER;
    bf16_t* win = (bf16_t*)(wl + WO_IN); bf16_t* wg = (bf16_t*)(wl + WO_GATE);
    const float* w_in = a->in[I_WIN] + (size_t)l * DM * D_IN;
    Job J; J.sbatch = 0; J.dbatch_rows = 0; J.mode = 0; J.nbatch = 1; J.c0 = 0; J.drow0 = 0; J.fp8 = 0; J.wsc = WSCALE;
    switch (j) {
    case 0:  J.src = w_in; J.ldw = D_IN; J.K = 1024; J.c0 = 0;    J.ncols = 1792; J.dst = win; J.ldt = 1024; J.drow0 = 0; J.fp8 = 1; break;
    case 1:  J.src = w_in; J.ldw = D_IN; J.K = 1024; J.c0 = 1792; J.ncols = 24;   J.dst = win; J.ldt = 1024; J.drow0 = C_NG; J.fp8 = 1; break;
    case 2:  J.src = w_in; J.ldw = D_IN; J.K = 1024; J.c0 = 1816; J.ncols = 3072; J.dst = win; J.ldt = 1024; J.drow0 = C_Z; J.fp8 = 1; break;
    case 3:  J.src = w_in; J.ldw = D_IN; J.K = 1024; J.c0 = 4888; J.ncols = 16;   J.dst = win; J.ldt = 1024; J.drow0 = C_DT; J.fp8 = 1; break;
    case 4:  J.src = w_in; J.ldw = D_IN; J.K = 1024; J.c0 = 4904; J.ncols = 3072; J.dst = wg;  J.ldt = 1024; J.drow0 = 0; J.fp8 = 1; break;
    case 5:  J.src = a->in[I_WBN] + (size_t)l * 512 * 1024;  J.ldw = 1024; J.K = 512;  J.ncols = 1024; J.dst = (bf16_t*)(wl + WO_C + 512); J.ldt = 1024; J.fp8 = 1; J.wsc = WSCALE_CN; break;
    case 6:  J.src = a->in[I_WBS] + (size_t)l * 1024 * 1024; J.ldw = 1024; J.K = 1024; J.ncols = 1024; J.dst = (bf16_t*)(wl + WO_SSD); J.ldt = 1024; J.fp8 = 1; break;
    case 7:  J.src = a->in[I_WOUT] + (size_t)l * 1024 * 1024; J.ldw = 1024; J.K = 1024; J.ncols = 1024; J.dst = (bf16_t*)(wl + WO_OUT); J.ldt = 1024; J.fp8 = 1; J.wsc = WSCALE_OUT; break;
    case 8:  J.src = a->in[I_CKW1] + (size_t)l * 2048 * 128; J.ldw = 128; J.K = 2048; J.ncols = 128; J.dst = (bf16_t*)(wl + WO_W1); J.ldt = 2048; break;
    case 9:  J.src = a->in[I_CVW1] + (size_t)l * 2048 * 128; J.ldw = 128; J.K = 2048; J.ncols = 128; J.dst = (bf16_t*)(wl + WO_W1) + 128 * 2048; J.ldt = 2048; break;
    case 10: J.src = a->in[I_CKW2] + (size_t)l * 128 * 64; J.ldw = 64; J.K = 128; J.ncols = 64; J.dst = (bf16_t*)(wl + WO_W2); J.ldt = 128; break;
    case 11: J.src = a->in[I_CVW2] + (size_t)l * 128 * 64; J.ldw = 64; J.K = 128; J.ncols = 64; J.dst = (bf16_t*)(wl + WO_W2) + 64 * 128; J.ldt = 128; break;
    case 12: J.src = a->in[I_EW1] + (size_t)l * 16 * 1024 * 512; J.sbatch = (size_t)1024 * 512; J.ldw = 512; J.K = 1024; J.ncols = 512; J.dst = (bf16_t*)(wl + WO_UP); J.dbatch_rows = 1024; J.ldt = 1024; J.drow0 = 0;   J.mode = 1; J.nbatch = 16; J.fp8 = 1; break;
    case 13: J.src = a->in[I_EW3] + (size_t)l * 16 * 1024 * 512; J.sbatch = (size_t)1024 * 512; J.ldw = 512; J.K = 1024; J.ncols = 512; J.dst = (bf16_t*)(wl + WO_UP); J.dbatch_rows = 1024; J.ldt = 1024; J.drow0 = 128; J.mode = 1; J.nbatch = 16; J.fp8 = 1; break;
    default: J.src = a->in[I_EW2] + (size_t)l * 16 * 512 * 1024; J.sbatch = (size_t)512 * 1024; J.ldw = 1024; J.K = 512; J.ncols = 1024; J.dst = (bf16_t*)(wl + WO_DN); J.dbatch_rows = 1024; J.ldt = 512; J.nbatch = 16; J.fp8 = 1; J.wsc = WSCALE_DN; break;
    }
    return J;
}
__device__ __forceinline__ void tr_item(const Job& J, int item, LAS float* scr, int lane) {
    const int nblk = (J.ncols + 31) >> 5, kblk = J.K >> 6, per = nblk * kblk;
    const int bt = item / per, r = item - bt * per, kb = r / nblk, nb = r - kb * nblk, k0 = 64 * kb, n0 = 32 * nb;
    const int nv = (J.ncols - n0) < 32 ? (J.ncols - n0) : 32;
    const float* W = J.src + (size_t)bt * J.sbatch;
    { const int nn = lane & 31; const float* wp = W + (size_t)(k0 + (lane >> 5)) * J.ldw + J.c0 + n0 + nn; float v[32];
#pragma unroll
      for (int i = 0; i < 32; ++i) v[i] = (nn < nv) ? wp[(size_t)(2 * i) * J.ldw] : 0.f;
#pragma unroll
      for (int i = 0; i < 32; ++i) scr[(2 * i + (lane >> 5)) * 33 + nn] = v[i]; }
    LDS_WAIT();
    const int c = lane & 7;
#pragma unroll
    for (int j = 0; j < 4; ++j) { const int n = (lane >> 3) + 8 * j;
        if (n < nv) {
            const LAS float* s = scr + (8 * c) * 33 + n; const int nn = n0 + n;
            const int drow = bt * J.dbatch_rows + J.drow0 + (J.mode == 1 ? ((nn >> 7) * 256 + (nn & 127)) : nn);
            if (J.fp8) { u32x2 o; o.x = cvt4_i8s(s[0 * 33], s[1 * 33], s[2 * 33], s[3 * 33], J.wsc); o.y = cvt4_i8s(s[4 * 33], s[5 * 33], s[6 * 33], s[7 * 33], J.wsc);
                *(u32x2*)((unsigned char*)J.dst + (size_t)drow * J.ldt + k0 + 8 * c) = o; }
            else { u32x4 o; o.x = cvt_pk_bf16(s[0 * 33], s[1 * 33]); o.y = cvt_pk_bf16(s[2 * 33], s[3 * 33]); o.z = cvt_pk_bf16(s[4 * 33], s[5 * 33]); o.w = cvt_pk_bf16(s[6 * 33], s[7 * 33]);
                *(u32x4*)(J.dst + (size_t)drow * J.ldt + k0 + 8 * c) = o; } } }
    LDS_WAIT();
}
__device__ __forceinline__ void ln_row_f32(const float* xrow, const float* g, const float* b, bf16_t* orow, unsigned char* orow8, int lane) {
    const f32x4* xr = (const f32x4*)xrow + lane; f32x4 v[4]; float s = 0.f;
#pragma unroll
    for (int j = 0; j < 4; ++j) { v[j] = xr[64 * j]; s += (v[j].x + v[j].y) + (v[j].z + v[j].w); }
    const float mean = wave_sum(s) * (1.f / DM); float s2 = 0.f;
#pragma unroll
    for (int j = 0; j < 4; ++j) { v[j] = v[j] - mean; s2 += (v[j].x * v[j].x + v[j].y * v[j].y) + (v[j].z * v[j].z + v[j].w * v[j].w); }
    const float rstd = 1.f / sqrtf(wave_sum(s2) * (1.f / DM) + LN_EPS);
    u32x2* o8 = (u32x2*)orow + lane;
#pragma unroll
    for (int j = 0; j < 4; ++j) { const f32x4 gg = ((const f32x4*)g + lane)[64 * j], bb = ((const f32x4*)b + lane)[64 * j];
        const float y0 = v[j].x * rstd * gg.x + bb.x, y1 = v[j].y * rstd * gg.y + bb.y, y2 = v[j].z * rstd * gg.z + bb.z, y3 = v[j].w * rstd * gg.w + bb.w;
        u32x2 w; w.x = cvt_pk_bf16(y0, y1); w.y = cvt_pk_bf16(y2, y3); o8[64 * j] = w;
        ((unsigned*)orow8 + lane)[64 * j] = cvt4_i8s(y0, y1, y2, y3, ASCALE); }
}
__device__ __forceinline__ int rel_bucket_dev(int n) {
    if (n < 16) return n;
    int b = 16;
    b += (n >= 19) + (n >= 21) + (n >= 24) + (n >= 27) + (n >= 31) + (n >= 35) + (n >= 40) + (n >= 46) + (n >= 52) + (n >= 59) + (n >= 67) + (n >= 77) + (n >= 87) + (n >= 99) + (n >= 113);
    return b;
}
__device__ __forceinline__ void p0_prologue(const Ctx& F, ArgsP a) {
    LAS float* scr = (LAS float*)(F.lds + F.wave * 16384);
    int base = 0;
    for (int l = 0; l < DEPTH; ++l)
        for (int j = 0; j < NJOBS; ++j) {
            const Job J = get_job(a, l, j);
            const int nitems = J.nbatch * (J.K >> 6) * ((J.ncols + 31) >> 5);
            int first = (F.gw - base) % F.NGW; if (first < 0) first += F.NGW;
            for (int it = first; it < nitems; it += F.NGW) tr_item(J, it, scr, F.lane);
            base = (base + nitems) % F.NGW;
        }
    { bf16_t* H = (bf16_t*)(a->ws + WS_H);
      for (int m = F.gw; m < T_; m += F.NGW) ln_row_f32(a->in[I_X] + (size_t)m * DM, a->in[I_LN0G], a->in[I_LN0B], H + (size_t)m * DM, a->ws + WS_H8 + (size_t)m * DM, F.lane); }
    { const int gt = blockIdx.x * 512 + F.tid, nthr = F.G * 512;
      for (int id = gt; id < DEPTH * 65536; id += nthr) {
          const int l = id >> 16, r = id & 65535, n = r & 1023, k8 = r >> 10, g = k8 >> 4, c0 = (k8 & 15) * 8;
          const float* pw = a->in[I_POOLW] + (size_t)l * 4 * 128 * 128 + (size_t)(g * 128 + c0) * 128;
          const float* sc = a->in[I_POOLS] + l * 512 + g * 128;
          const float* wb = a->in[I_WBP] + (size_t)l * 512 * 1024 + (size_t)(g * 128) * 1024 + n;
          float pwr[8][2], scr2[2];
#pragma unroll
          for (int i = 0; i < 8; ++i) { pwr[i][0] = pw[i * 128 + F.lane]; pwr[i][1] = pw[i * 128 + 64 + F.lane]; }
          scr2[0] = sc[F.lane]; scr2[1] = sc[64 + F.lane];
          float acc[8] = {0.f, 0.f, 0.f, 0.f, 0.f, 0.f, 0.f, 0.f};
#pragma unroll
          for (int hf = 0; hf < 2; ++hf)
#pragma unroll 16
              for (int dd = 0; dd < 64; ++dd) { const int d = 64 * hf + dd;
                  const float w = wb[(size_t)d * 1024] * __int_as_float(__builtin_amdgcn_readlane(__float_as_int(scr2[hf]), dd));
#pragma unroll
                  for (int i = 0; i < 8; ++i) acc[i] += __int_as_float(__builtin_amdgcn_readlane(__float_as_int(pwr[i][hf]), dd)) * w; }
          unsigned char* dst = a->ws + WS_W + (size_t)l * W_LAYER + WO_C + (size_t)n * 1024 + g * 128 + c0;
          *(u32x2*)dst = pack8_i8(acc, WSCALE_CN);
      } }
    for (int o4 = F.gw; o4 < 4 * DEPTH * 2 * 128; o4 += F.NGW) {
        const int part = o4 >> 9, o = o4 & 511;
        const int l = o >> 8, kv = (o >> 7) & 1, col = o & 127;
        const float* pe = a->in[kv ? I_CVPE : I_CKPE] + (size_t)l * 2048; const float* w1 = a->in[kv ? I_CVW1 : I_CKW1] + (size_t)l * 2048 * 128 + col;
        float s = 0.f;
        for (int k = 512 * part + F.lane; k < 512 * part + 512; k += 64) s += pe[k] * w1[(size_t)k * 128];
        s = wave_sum(s);
        if (F.lane == 0) ((float*)(a->ws + WS_MISC + MI_B1))[part * 512 + o] = s;
    }
    if (blockIdx.x == 0) {
        float* bt = (float*)(a->ws + WS_MISC + MI_BIAS);
        for (int i = F.tid; i < 8 * 128; i += 512) { const int hd = i >> 7, d = i & 127;
            bt[i] = (a->in[I_RELB][rel_bucket_dev(d) * 8 + hd] - a->in[I_RELB][31 * 8 + hd]) * LOG2E; }
    }
}

__device__ __forceinline__ void conv_phase(const Ctx& F, const bf16_t* P, bf16_t* XC, const float* cw, const float* cb) {
    const int gt = blockIdx.x * 512 + F.tid, nthr = F.G * 512;
    const int c = gt & 255;
    float w[4][8], b[8];
#pragma unroll
    for (int k = 0; k < 4; ++k)
#pragma unroll
        for (int i = 0; i < 8; ++i) w[k][i] = cw[k * 2048 + 8 * c + i] * (1.f / P8SCALE);
#pragma unroll
    for (int i = 0; i < 8; ++i) b[i] = cb[8 * c + i];
    for (int id = gt; id < (TG / 16) * 256; id += nthr) {
        const int tl0 = (id >> 8) * 16, s0 = tl0 & (SEQ - 1);
        u32x2 raw[19];
#pragma unroll
        for (int r = 0; r < 19; ++r) raw[r] = (s0 + r - 3 >= 0) ? *(const u32x2*)((const unsigned char*)P + (size_t)(tl0 + r - 3) * LDP * 2 + 2 * C_XBC + 8 * c) : (u32x2){0u, 0u};
#pragma unroll
        for (int i = 0; i < 16; ++i) {
            float acc[8];
#pragma unroll
            for (int j = 0; j < 8; ++j) acc[j] = b[j];
#pragma unroll
            for (int k = 0; k < 4; ++k) { float x[8]; unpack8_i8(raw[i + k], x);
#pragma unroll
                for (int j = 0; j < 8; ++j) acc[j] += w[k][j] * x[j]; }
#pragma unroll
            for (int j = 0; j < 8; ++j) acc[j] = siluf_(acc[j]);
            *(u32x4*)(XC + (size_t)(tl0 + i) * 2048 + 8 * c) = pack8(acc);
        }
    }
}
__device__ __forceinline__ void compress_unit(const Ctx& F, int cu, const bf16_t* P, const bf16_t* W1t, const bf16_t* W2t, const float* b1, bf16_t* KC, bf16_t* VC) {
    const int kv = cu & 1, g = (cu >> 1) & 1, nb = (cu >> 2) & 7, bl = cu >> 5;
    const int lane = F.lane, w = F.wave, fr = lane & 15, fq = lane >> 4;
    LAS bf16_t* hid = (LAS bf16_t*)F.lds;
    const bf16_t* w1 = W1t + (size_t)kv * 128 * 2048 + (size_t)(16 * w + fr) * 2048 + 8 * fq;
    int n0 = nb * 16 + fr; if (n0 > 126) n0 = 126;
    const bf16_t* a0 = P + (size_t)(bl * SEQ + 16 * n0) * LDP + C_KV + kv * 128 + g * 64 + 8 * fq;
    f32x4 acc0 = {0.f, 0.f, 0.f, 0.f}, acc1 = {0.f, 0.f, 0.f, 0.f};
#pragma unroll 8
    for (int kk = 0; kk < 64; kk += 2) {
        const int l = kk >> 1;
        const bf16x8 bb0 = *(const bf16x8*)(w1 + kk * 32), bb1 = *(const bf16x8*)(w1 + kk * 32 + 32);
        const bf16x8 x0 = *(const bf16x8*)(a0 + (size_t)l * LDP), x1 = *(const bf16x8*)(a0 + (size_t)l * LDP + 32);
        acc0 = mfma16(x0, bb0, acc0); acc1 = mfma16(x1, bb1, acc1);
    }
    const float bias = (b1[kv * 128 + 16 * w + fr] + b1[512 + kv * 128 + 16 * w + fr]) + (b1[1024 + kv * 128 + 16 * w + fr] + b1[1536 + kv * 128 + 16 * w + fr]);
#pragma unroll
    for (int r = 0; r < 4; ++r) { const float x = acc0[r] + acc1[r] + bias, u = 0.7978845608f * (x + 0.044715f * x * x * x); hid[(4 * fq + r) * 136 + 16 * w + fr] = f2bf(x * sigmoidf_(2.f * u)); }
    __syncthreads();
    if (w < 4) { f32x4 acc = {0.f, 0.f, 0.f, 0.f};
      const bf16_t* w2 = W2t + (size_t)kv * 64 * 128 + (size_t)(16 * w + fr) * 128 + 8 * fq;
#pragma unroll
      for (int ks = 0; ks < 4; ++ks) { const bf16x8 aa = *(const LAS bf16x8*)(hid + fr * 136 + ks * 32 + 8 * fq); const bf16x8 bb = *(const bf16x8*)(w2 + ks * 32); acc = mfma16(aa, bb, acc); }
      bf16_t* dst = kv ? VC : KC;
#pragma unroll
      for (int r = 0; r < 4; ++r) { const int n = nb * 16 + 4 * fq + r; if (n < 127) dst[(size_t)(bl * 128 + n) * 128 + g * 64 + 16 * w + fr] = f2bf(acc[r]); }
    }
    __syncthreads();
}

template <int WIN>
__device__ __forceinline__ void pool_item(const bf16_t* P, bf16_t* R, int grp, int rq, int lane) {
    const int c = 16 * grp + (lane & 15), tl0 = (4 * rq + (lane >> 4)) * 8, s0 = tl0 & (SEQ - 1);
    constexpr int NROW = 7 + WIN;
    u32x2 raw[NROW];
#pragma unroll
    for (int k = 0; k < NROW; ++k) { const int sp = s0 - (WIN - 1) + k; raw[k] = (sp >= 0) ? *(const u32x2*)((const unsigned char*)P + (size_t)(tl0 - (WIN - 1) + k) * LDP * 2 + 2 * C_POOL + 8 * c) : (u32x2){0u, 0u}; }
    float sum[8] = {0.f, 0.f, 0.f, 0.f, 0.f, 0.f, 0.f, 0.f};
#pragma unroll
    for (int k = 0; k < WIN - 1; ++k) { float x[8]; unpack8_i8(raw[k], x);
#pragma unroll
        for (int q = 0; q < 8; ++q) sum[q] += x[q]; }
#pragma unroll
    for (int i = 0; i < 8; ++i) {
        float u0[8], o[8]; unpack8_i8(raw[i + WIN - 1], u0);
#pragma unroll
        for (int q = 0; q < 8; ++q) sum[q] += u0[q];
        const int s = s0 + i, cnt = (s + 1) < WIN ? (s + 1) : WIN; const float inv = 1.f / (float)cnt;
#pragma unroll
        for (int q = 0; q < 8; ++q) o[q] = sum[q] * inv - u0[q];
        *(u32x2*)((unsigned char*)R + (size_t)(tl0 + i) * 1024 + 8 * c) = pack8_i8(o, RSCALE / P8SCALE);
        { u32x2 lv = raw[i]; asm volatile("" : "+v"(lv.x), "+v"(lv.y)); float x[8]; unpack8_i8(lv, x);
#pragma unroll
          for (int q = 0; q < 8; ++q) sum[q] -= x[q]; }
    }
}
__device__ __forceinline__ void fin_phase(const Ctx& F, const bf16_t* P, bf16_t* R, const bf16_t* Y, unsigned char* Y8, const float* normg) {
    for (int wi = F.gw; wi < 4 * (TG / 32); wi += F.NGW) {
        const int grp = wi & 3, rq = wi >> 2;
        if (grp == 0) pool_item<2>(P, R, 0, rq, F.lane); else if (grp == 1) pool_item<4>(P, R, 1, rq, F.lane); else if (grp == 2) pool_item<8>(P, R, 2, rq, F.lane); else pool_item<16>(P, R, 3, rq, F.lane);
    }
    const int lane = F.lane;
    float ng[16];
#pragma unroll
    for (int i = 0; i < 16; ++i) ng[i] = normg[16 * lane + i];
    u32x4 nx[3];
#define FIN_LOAD(tl_) do { nx[0] = *(const u32x4*)(Y + (size_t)(tl_) * 1024 + 16 * lane); nx[1] = *(const u32x4*)(Y + (size_t)(tl_) * 1024 + 16 * lane + 8); \
        nx[2] = *(const u32x4*)((const unsigned char*)P + (size_t)(tl_) * LDP * 2 + 2 * C_Z + 16 * lane); } while (0)
    if (F.gw < TG) FIN_LOAD(F.gw);
    for (int tl = F.gw; tl < TG; tl += F.NGW) {
        const u32x4 c0 = nx[0], c1 = nx[1], c2 = nx[2];
        if (tl + F.NGW < TG) FIN_LOAD(tl + F.NGW);
        float y[16], z[16];
        { float t[8]; unpack8(c0, t);
#pragma unroll
          for (int i = 0; i < 8; ++i) y[i] = t[i];
          unpack8(c1, t);
#pragma unroll
          for (int i = 0; i < 8; ++i) y[8 + i] = t[i];
          unpack4_i8(c2.x, z); unpack4_i8(c2.y, z + 4); unpack4_i8(c2.z, z + 8); unpack4_i8(c2.w, z + 12);
#pragma unroll
          for (int i = 0; i < 16; ++i) z[i] *= (1.f / P8SCALE); }
        float ss = 0.f;
#pragma unroll
        for (int i = 0; i < 16; ++i) { y[i] *= z[i]; ss += y[i] * y[i]; }
        ss += __shfl_xor(ss, 1); ss += __shfl_xor(ss, 2); ss += __shfl_xor(ss, 4); ss += __shfl_xor(ss, 8);
        const float rstd = 1.f / sqrtf(ss * (1.f / 256.f) + LN_EPS);
        float o[8];
#pragma unroll
        for (int i = 0; i < 8; ++i) o[i] = y[i] * rstd * ng[i];
        *(u32x2*)(Y8 + (size_t)tl * 1024 + 16 * lane) = pack8_i8(o, YSCALE);
#pragma unroll
        for (int i = 0; i < 8; ++i) o[i] = y[8 + i] * rstd * ng[8 + i];
        *(u32x2*)(Y8 + (size_t)tl * 1024 + 16 * lane + 8) = pack8_i8(o, YSCALE);
    }
#undef FIN_LOAD
}

#ifndef NSA_X1
#define NSA_X1 0
#endif
#ifndef NSA_X2
#define NSA_X2 0
#endif
#ifndef SSD_REP
#define SSD_REP 0
#endif
#ifndef NSA_REP
#define NSA_REP 0
#endif
constexpr int NL_KT = 0, NL_VT = 32768, NL_BIAS = 65536, NL_IMP = 73728, NL_SEL = 107520, NL_UNI = 107776;
__device__ __forceinline__ void glds16(const void* gsrc, unsigned lds_dst) { unsigned keep;
    asm volatile("s_mov_b32 %0, m0\n\ts_mov_b32 m0, %2\n\ts_nop 0\n\tglobal_load_lds_dwordx4 %1, off\n\ts_mov_b32 m0, %0" : "=&s"(keep) : "v"(gsrc), "s"(lds_dst) : "memory"); }
#define NSA_WAITBAR(N) asm volatile("s_waitcnt vmcnt(" #N ") lgkmcnt(0)\n\ts_barrier" ::: "memory")

#define NSA_STORE_TILE(buf) do { \
    *(LAS u32x4*)(lds + NL_KT + (buf) * 8192 + (tid >> 6) * 1024 + (tid & 63) * 16) = kreg; \
    *(LAS u32x4*)(lds + NL_VT + (buf) * 8192 + ((tid & 7) >> 2) * 4096 + (tid >> 3) * 64 + (tid & 3) * 16) = vreg; } while (0)

__device__ __forceinline__ void nsa_kload(const LAS unsigned char* Kt, int r32, int hi, bf16x8 (&kf)[8]) {
#pragma unroll
    for (int d0 = 0; d0 < 4; ++d0) { kf[2 * d0] = *(const LAS bf16x8*)(Kt + (2 * d0 + hi) * 1024 + r32 * 16); kf[2 * d0 + 1] = *(const LAS bf16x8*)(Kt + (2 * d0 + hi) * 1024 + 512 + r32 * 16); }
}
__device__ __forceinline__ void nsa_qk_f(const bf16x8 (&kf)[8], const bf16x8 (&qB)[4], f32x16& p0, f32x16& p1) {
    p0 = (f32x16){0.f, 0.f, 0.f, 0.f, 0.f, 0.f, 0.f, 0.f, 0.f, 0.f, 0.f, 0.f, 0.f, 0.f, 0.f, 0.f}; p1 = p0;
#pragma unroll
    for (int d0 = 0; d0 < 4; ++d0) { p0 = mfma32(kf[2 * d0], qB[d0], p0); p1 = mfma32(kf[2 * d0 + 1], qB[d0], p1); }
}
__device__ __forceinline__ void nsa_qk(const LAS unsigned char* Kt, const bf16x8 (&qB)[4], int r32, int hi, f32x16& p0, f32x16& p1) {
    bf16x8 kf[8]; nsa_kload(Kt, r32, hi, kf); nsa_qk_f(kf, qB, p0, p1);
}
__device__ __forceinline__ void nsa_vload(const LAS unsigned char* Vt, int lane, int hi, bf16x8 (&vf)[8]) {
    const LAS unsigned char* vb = Vt + (4 * hi + ((lane & 15) >> 2)) * 64 + ((lane >> 4) & 1) * 32 + (lane & 3) * 8;
#pragma unroll
    for (int ks = 0; ks < 4; ++ks) { vf[2 * ks] = cat8(trrd(vb + ks * 1024), trrd(vb + ks * 1024 + 512)); vf[2 * ks + 1] = cat8(trrd(vb + 4096 + ks * 1024), trrd(vb + 4096 + ks * 1024 + 512)); }
}
__device__ __forceinline__ void nsa_pack(const f32x16& p0, const f32x16& p1, bool keep, bf16x8 (&pB)[4]) {
    { u32x4 t; t.x = cvt_pk_bf16(p0[0], p0[1]); t.y = cvt_pk_bf16(p0[2], p0[3]); t.z = cvt_pk_bf16(p0[4], p0[5]); t.w = cvt_pk_bf16(p0[6], p0[7]); pB[0] = __builtin_bit_cast(bf16x8, t);
      t.x = cvt_pk_bf16(p0[8], p0[9]); t.y = cvt_pk_bf16(p0[10], p0[11]); t.z = cvt_pk_bf16(p0[12], p0[13]); t.w = cvt_pk_bf16(p0[14], p0[15]); pB[1] = __builtin_bit_cast(bf16x8, t);
      t.x = cvt_pk_bf16(p1[0], p1[1]); t.y = cvt_pk_bf16(p1[2], p1[3]); t.z = cvt_pk_bf16(p1[4], p1[5]); t.w = cvt_pk_bf16(p1[6], p1[7]); pB[2] = __builtin_bit_cast(bf16x8, t);
      t.x = cvt_pk_bf16(p1[8], p1[9]); t.y = cvt_pk_bf16(p1[10], p1[11]); t.z = cvt_pk_bf16(p1[12], p1[13]); t.w = cvt_pk_bf16(p1[14], p1[15]); pB[3] = __builtin_bit_cast(bf16x8, t); }
    if (!keep) { const bf16x8 z = {0, 0, 0, 0, 0, 0, 0, 0}; pB[0] = z; pB[1] = z; pB[2] = z; pB[3] = z; }
}
__device__ __forceinline__ void nsa_pv_f(const bf16x8 (&vf)[8], const bf16x8 (&pB)[4], f32x16& o0, f32x16& o1) {
#pragma unroll
    for (int ks = 0; ks < 4; ++ks) { o0 = mfma32(vf[2 * ks], pB[ks], o0); o1 = mfma32(vf[2 * ks + 1], pB[ks], o1); }
}
__device__ __forceinline__ void nsa_pv(const LAS unsigned char* Vt, int lane, int hi, const f32x16& p0, const f32x16& p1, f32x16& o0, f32x16& o1, bool keep = true) {
    bf16x8 vf[8], pB[4]; nsa_vload(Vt, lane, hi, vf); nsa_pack(p0, p1, keep, pB); nsa_pv_f(vf, pB, o0, o1);
}

template <int MODE>
__device__ __forceinline__ void nsa_smp(int j, f32x16& p0, f32x16& p1, int qt, int ql, unsigned mysel, const LAS float* biasH, int hi, float& l, bf16x8 (&pB)[4]) {
    const int dj = qt - j;
    const bool selq = (MODE == 1) ? (((mysel >> j) & 1u) != 0u) : true;
    if (dj <= 2) {
        const LAS float* tb = biasH + (64 * dj + ql - 4 * hi + 64);
#pragma unroll
        for (int r = 0; r < 16; ++r) { p0[r] += tb[-((r & 3) + 8 * (r >> 2))]; p1[r] += tb[-((r & 3) + 8 * (r >> 2)) - 32]; }
    } else if (MODE == 2 && dj == 8) {
        const int dq = 512 + ql - 4 * hi;
#pragma unroll
        for (int r = 0; r < 16; ++r) { const int d0 = dq - ((r & 3) + 8 * (r >> 2)); p0[r] = (d0 < 512) ? p0[r] : NEGBIG; p1[r] = (d0 - 32 < 512) ? p1[r] : NEGBIG; }
    }
    f32x2 ls2 = {0.f, 0.f};
#pragma unroll
    for (int r = 0; r < 16; ++r) { p0[r] = fexp2(p0[r]); p1[r] = fexp2(p1[r]); ls2 += (f32x2){p0[r], p1[r]}; }
    l += selq ? (ls2.x + ls2.y) : 0.f;
    nsa_pack(p0, p1, selq, pB);
}

template <int MODE>
__device__ __forceinline__ void nsa_branch(const Ctx& F, const bf16_t* Kg, const bf16_t* Vg, unsigned tiles, int qt, int ql, unsigned mysel,
                                           const LAS float* biasH, const bf16_t* qptr, float gate, f32x16& out0, f32x16& out1) {
    LAS unsigned char* lds = F.lds; int tid_ = F.tid; asm volatile("" : "+v"(tid_)); const int tid = tid_, lane = tid & 63, r32 = lane & 31, hi = lane >> 5;
    bf16x8 qB[4];
#pragma unroll
    for (int d0 = 0; d0 < 4; ++d0) qB[d0] = *(const bf16x8*)(qptr + 16 * d0);
    float l = 0.f;
    f32x16 o0 = (f32x16){0.f, 0.f, 0.f, 0.f, 0.f, 0.f, 0.f, 0.f, 0.f, 0.f, 0.f, 0.f, 0.f, 0.f, 0.f, 0.f}, o1 = o0;
    const int w = F.wave;
    const unsigned lbase = (unsigned)(size_t)lds;
    const bf16_t* ksrc = Kg + (size_t)lane * LDP + 8 * w;
    const bf16_t* vsrc = Vg + (size_t)(16 * (w & 3) + (lane >> 2)) * LDP + (w >> 2) * 32 + (lane & 3) * 8;
    const unsigned kdst = (unsigned)__builtin_amdgcn_readfirstlane((int)(lbase + NL_KT + w * 1024)), vdst = (unsigned)__builtin_amdgcn_readfirstlane((int)(lbase + NL_VT + (w >> 2) * 4096 + (w & 3) * 1024));
#define NSA_DMA(jj, slot) do { glds16(ksrc + (size_t)(jj) * 64 * LDP, kdst + (slot) * 8192); glds16(vsrc + (size_t)(jj) * 64 * LDP, vdst + (slot) * 8192); } while (0)
#define NSA_POP(dst) do { if (rem) { dst = (MODE == 1) ? (__ffs(rem) - 1) : (31 - __clz(rem)); rem &= ~(1u << dst); } else dst = -1; } while (0)
    unsigned rem = tiles; int jp, cur, nxt;
    NSA_POP(jp); NSA_POP(cur);
    NSA_DMA(jp, 0); if (cur >= 0) NSA_DMA(cur, 1);
    f32x16 pp0, pp1;
    if (cur >= 0) NSA_WAITBAR(2); else NSA_WAITBAR(0);
    NSA_POP(nxt); if (nxt >= 0) NSA_DMA(nxt, 2);
    nsa_qk(lds + NL_KT, qB, r32, hi, pp0, pp1);
    int bufp = 0, buf = 1;
    while (cur >= 0) {
        if (nxt >= 0) NSA_WAITBAR(2); else NSA_WAITBAR(0);
        int q; NSA_POP(q);
        if (q >= 0) NSA_DMA(q, (buf + 2) & 3);
        { bf16x8 kf[8], vf[8], pB[4];
          nsa_vload(lds + NL_VT + bufp * 8192, lane, hi, vf);
          nsa_smp<MODE>(jp, pp0, pp1, qt, ql, mysel, biasH, hi, l, pB);
          nsa_kload(lds + NL_KT + buf * 8192, r32, hi, kf);
          nsa_pv_f(vf, pB, o0, o1);
          nsa_qk_f(kf, qB, pp0, pp1); }
        jp = cur; bufp = buf; cur = nxt; nxt = q; buf = (buf + 1) & 3;
    }
    { bf16x8 vf[8], pB[4]; nsa_vload(lds + NL_VT + bufp * 8192, lane, hi, vf); nsa_smp<MODE>(jp, pp0, pp1, qt, ql, mysel, biasH, hi, l, pB); nsa_pv_f(vf, pB, o0, o1); }
#undef NSA_DMA
#undef NSA_POP
    __syncthreads();
    const float lt = l + __shfl_xor(l, 32), sc = gate * frcp(lt);
#pragma unroll
    for (int r = 0; r < 16; ++r) { out0[r] += sc * o0[r]; out1[r] += sc * o1[r]; }
}

__device__ __forceinline__ void nsa_unit(const Ctx& F, int bl, int g, int qt, const bf16_t* P, const bf16_t* KC, const bf16_t* VC, const float* biasT, bf16_t* YB) {
    LAS unsigned char* lds = F.lds; int tid_ = F.tid; asm volatile("" : "+v"(tid_)); const int tid = tid_, lane = tid & 63, w = F.wave, r32 = lane & 31, hi = lane >> 5;
    const int h = w >> 1, ql = 32 * (w & 1) + r32, t = 64 * qt + ql;
    const size_t row = (size_t)bl * SEQ + t;
    if (tid == 0) *(LAS unsigned*)(lds + NL_UNI) = 0u;
    const bf16_t* qptr = P + row * LDP + C_Q + g * 256 + h * 64 + 8 * hi;
    const float g_c = sigmoidf_(bf1(P[row * LDP + C_NG + g * 4 + h])), g_s = sigmoidf_(bf1(P[row * LDP + C_NG + 8 + g * 4 + h])), g_w = sigmoidf_(bf1(P[row * LDP + C_NG + 16 + g * 4 + h]));
    const LAS float* biasH = (const LAS float*)(lds + NL_BIAS) + (g * 4 + h) * 256;
    f32x16 out0 = (f32x16){0.f, 0.f, 0.f, 0.f, 0.f, 0.f, 0.f, 0.f, 0.f, 0.f, 0.f, 0.f, 0.f, 0.f, 0.f, 0.f}, out1 = out0;

    const int ntile = (qt >= 16) ? 2 : 1;
    for (int tl = 0; tl < ntile; ++tl) {
        int nk = 64 * tl + (tid & 63); if (nk > 126) nk = 126;
        int nv = 64 * tl + (tid >> 3); if (nv > 126) nv = 126;
        const u32x4 kreg = *(const u32x4*)(KC + (size_t)(bl * 128 + nk) * 128 + g * 64 + 8 * (tid >> 6));
        const u32x4 vreg = *(const u32x4*)(VC + (size_t)(bl * 128 + nv) * 128 + g * 64 + 8 * (tid & 7));
        NSA_STORE_TILE(tl);
    }
    __syncthreads();
    {
        f32x16 s0, s1, s2, s3;
        { bf16x8 qB[4];
#pragma unroll
          for (int d0 = 0; d0 < 4; ++d0) qB[d0] = *(const bf16x8*)(qptr + 16 * d0);
          nsa_qk(lds + NL_KT, qB, r32, hi, s0, s1);
          if (ntile == 2) nsa_qk(lds + NL_KT + 8192, qB, r32, hi, s2, s3);
          else { s2 = (f32x16){0.f, 0.f, 0.f, 0.f, 0.f, 0.f, 0.f, 0.f, 0.f, 0.f, 0.f, 0.f, 0.f, 0.f, 0.f, 0.f}; s3 = s2; } }
        const int db = t - 31 - 64 * hi;
        float mx = NEGBIG;
#define CMP_MASK(S, V) _Pragma("unroll") for (int r = 0; r < 16; ++r) { const int d = db - 16 * (32 * (V) + (r & 3) + 8 * (r >> 2)); \
            const int c = d < 0 ? 0 : (d > 127 ? 127 : d); S[r] = (d >= 0) ? S[r] + biasH[64 + c] : NEGBIG; mx = fmaxf(mx, S[r]); }
        CMP_MASK(s0, 0) CMP_MASK(s1, 1)
        if (ntile == 2) { CMP_MASK(s2, 2) CMP_MASK(s3, 3) }
#undef CMP_MASK
        mx = fmaxf(mx, __shfl_xor(mx, 32));
        float ls = 0.f;
#define CMP_EXP(S) _Pragma("unroll") for (int r = 0; r < 16; ++r) { S[r] = (S[r] > -1e29f) ? fexp2(S[r] - mx) : 0.f; ls += S[r]; }
        CMP_EXP(s0) CMP_EXP(s1)
        if (ntile == 2) { CMP_EXP(s2) CMP_EXP(s3) }
#undef CMP_EXP
        ls += __shfl_xor(ls, 32);
        const float inv = ls > 0.f ? 1.f / ls : 0.f;
#pragma unroll
        for (int r = 0; r < 16; ++r) { s0[r] *= inv; s1[r] *= inv; s2[r] *= inv; s3[r] *= inv; }
        LAS float* I = (LAS float*)(lds + NL_IMP) + (h * 64 + ql) * 33 + hi;
        float yprev = 0.f;
#define CMP_IMP(S, V) _Pragma("unroll") for (int a = 0; a < 4; ++a) { const float own = S[4 * a] + S[4 * a + 1] + S[4 * a + 2] + 0.5f * S[4 * a + 3]; \
            const float y = __shfl_xor(0.5f * S[4 * a + 3], 32); I[2 * (4 * (V) + a)] = own + (hi ? y : yprev); yprev = y; }
        CMP_IMP(s0, 0) CMP_IMP(s1, 1) CMP_IMP(s2, 2) CMP_IMP(s3, 3)
#undef CMP_IMP
        f32x16 o0 = (f32x16){0.f, 0.f, 0.f, 0.f, 0.f, 0.f, 0.f, 0.f, 0.f, 0.f, 0.f, 0.f, 0.f, 0.f, 0.f, 0.f}, o1 = o0;
        nsa_pv(lds + NL_VT, lane, hi, s0, s1, o0, o1);
        if (ntile == 2) nsa_pv(lds + NL_VT + 8192, lane, hi, s2, s3, o0, o1);
#pragma unroll
        for (int r = 0; r < 16; ++r) { out0[r] += g_c * o0[r]; out1[r] += g_c * o1[r]; }
    }
    __syncthreads();
    if (w == 0) {
        const LAS float* I = (const LAS float*)(lds + NL_IMP) + lane * 33;
        float v[32];
#pragma unroll
        for (int jj = 0; jj < 32; ++jj) v[jj] = (I[jj] + I[64 * 33 + jj]) + (I[128 * 33 + jj] + I[192 * 33 + jj]);
        unsigned sel = 1u | (1u << qt) | (qt >= 1 ? (1u << (qt - 1)) : 0u);
        const int need = 8 - __popc(sel);
#pragma unroll
        for (int it = 0; it < 5; ++it) {
            if (it < need) {
                int best = -1; float bv = -1e30f;
#pragma unroll
                for (int jj = 1; jj < 32; ++jj) { const bool ok = (jj <= qt - 2) && (((sel >> jj) & 1u) == 0u) && (v[jj] > bv); bv = ok ? v[jj] : bv; best = ok ? jj : best; }
                if (best >= 0) sel |= 1u << best;
            }
        }
        ((LAS unsigned*)(lds + NL_SEL))[lane] = sel;
        atomicOr((unsigned*)(lds + NL_UNI), sel);
    }
    __syncthreads();
    const unsigned uni = *(const LAS unsigned*)(lds + NL_UNI) & ((qt >= 31) ? 0xffffffffu : ((2u << qt) - 1u));
    const unsigned mysel = ((const LAS unsigned*)(lds + NL_SEL))[ql];
    const bf16_t* Pb = P + (size_t)bl * SEQ * LDP + C_KV + g * 64;
    nsa_branch<1>(F, Pb + 256, Pb + 384, uni, qt, ql, mysel, biasH, qptr, g_s, out0, out1);
    { const int lo = qt >= 8 ? qt - 8 : 0; const unsigned wm = (((qt >= 31) ? 0xffffffffu : ((2u << qt) - 1u)) >> lo) << lo;
      nsa_branch<2>(F, Pb + 512, Pb + 640, wm, qt, ql, 0u, biasH, qptr, g_w, out0, out1); }
    unsigned char* yo = (unsigned char*)YB + row * 1024 + 512 + g * 256 + h * 64 + 4 * hi;
#pragma unroll
    for (int a = 0; a < 4; ++a) {
        *(unsigned*)(yo + 8 * a) = cvt4_i8s(out0[4 * a], out0[4 * a + 1], out0[4 * a + 2], out0[4 * a + 3], BSCALE);
        *(unsigned*)(yo + 32 + 8 * a) = cvt4_i8s(out1[4 * a], out1[4 * a + 1], out1[4 * a + 2], out1[4 * a + 3], BSCALE);
    }
    __syncthreads();
}

#define LDS_BARRIER() asm volatile("s_waitcnt lgkmcnt(0)\n\ts_barrier" ::: "memory")
constexpr int SL_CT = 0, SL_BT = 34816, SL_XT = 69632, SL_XD = 77824, SL_XW = 86016, SL_HT = 94208, SL_YO = 102912, SL_AW = 119296, SL_DW = 123392;
__device__ __forceinline__ void ssd_diag(const LAS unsigned char* lds, const LAS float* A_, const bf16x8 (&bbC)[8], int si, int li, int r32, int hi, int q4, int p4, int g1, f32x16& y) {
    const int lidx = 32 * li + r32; const float acl = A_[lidx];
    f32x16 s = (f32x16){0.f, 0.f, 0.f, 0.f, 0.f, 0.f, 0.f, 0.f, 0.f, 0.f, 0.f, 0.f, 0.f, 0.f, 0.f, 0.f};
#pragma unroll
    for (int kk = 0; kk < 8; ++kk) {
        const bf16x8 aa = *(const LAS bf16x8*)(lds + SL_BT + (32 * si + r32) * 272 + (16 * kk + 8 * hi) * 2);
        s = mfma32(aa, bbC[kk], s);
    }
    f32x4 av[4];
#pragma unroll
    for (int q = 0; q < 4; ++q) av[q] = *(const LAS f32x4*)(A_ + 32 * si + 4 * hi + 8 * q);
#pragma unroll
    for (int r = 0; r < 16; ++r) s[r] *= fexp2(acl - av[r >> 2][r & 3]);
    if (si == li) {
#pragma unroll
        for (int r = 0; r < 16; ++r) s[r] = (crow(r, hi) <= r32) ? s[r] : 0.f;
    }
    u32x4 t0, t1;
    t0.x = cvt_pk_bf16(s[0], s[1]); t0.y = cvt_pk_bf16(s[2], s[3]); t0.z = cvt_pk_bf16(s[4], s[5]); t0.w = cvt_pk_bf16(s[6], s[7]);
    t1.x = cvt_pk_bf16(s[8], s[9]); t1.y = cvt_pk_bf16(s[10], s[11]); t1.z = cvt_pk_bf16(s[12], s[13]); t1.w = cvt_pk_bf16(s[14], s[15]);
    const LAS unsigned char* xb = lds + SL_XD + (32 * si + 4 * hi + q4) * 64 + g1 * 32 + p4 * 8;
    y = mfma32(cat8(trrd(xb), trrd(xb + 512)), __builtin_bit_cast(bf16x8, t0), y);
    y = mfma32(cat8(trrd(xb + 1024), trrd(xb + 1536)), __builtin_bit_cast(bf16x8, t1), y);
}
__device__ __forceinline__ void ssd_yoff(const LAS unsigned char* lds, const LAS float* A_, const bf16x8 (&bbC)[8], int li, int r32, int hi, f32x16& y) {
    const int lidx = 32 * li + r32;
#pragma unroll
    for (int kk = 0; kk < 8; ++kk) {
        const bf16x8 aa = *(const LAS bf16x8*)(lds + SL_HT + r32 * 272 + (16 * kk + 8 * hi) * 2);
        y = mfma32(aa, bbC[kk], y);
    }
    const float el = fexp2(A_[lidx]);
#pragma unroll
    for (int r = 0; r < 16; ++r) y[r] *= el;
}
__device__ __forceinline__ void ssd_unit(const Ctx& F, int bl, int hd, int ph, const bf16_t* P, const bf16_t* XC, float dtb, float Aneg, float Dh, bf16_t* YP) {
    LAS unsigned char* lds = F.lds; int tid_ = F.tid; asm volatile("" : "+v"(tid_)); const int tid = tid_, lane = tid & 63, w = F.wave, r32 = lane & 31, hi = lane >> 5;
    const int g = hd >> 2, p0 = 32 * ph; const size_t rowb = (size_t)bl * SEQ;
    const int q4 = (lane & 15) >> 2, p4 = lane & 3, g1 = (lane >> 4) & 1;
    LAS float* A_ = (LAS float*)(lds + SL_AW) + w * 128; LAS float* D_ = (LAS float*)(lds + SL_DW) + w * 128;
    u32x4 creg[4], breg[4], xreg; float dt0 = 0.f, dt1 = 0.f;
#define SSD_LOAD(ch) do { const bf16_t* xc = XC + (rowb + (size_t)(ch) * 128) * 2048; \
        _Pragma("unroll") for (int i = 0; i < 4; ++i) { const int r = (tid >> 4) + 32 * i; \
            creg[i] = *(const u32x4*)(xc + (size_t)r * 2048 + 1536 + g * 128 + 8 * (tid & 15)); breg[i] = *(const u32x4*)(xc + (size_t)r * 2048 + 1024 + g * 128 + 8 * (tid & 15)); } \
        xreg = *(const u32x4*)(xc + (size_t)(tid >> 2) * 2048 + hd * 64 + p0 + 8 * (tid & 3)); \
        dt0 = bf1(P[(rowb + (size_t)(ch) * 128 + 2 * lane) * LDP + C_DT + hd]); dt1 = bf1(P[(rowb + (size_t)(ch) * 128 + 2 * lane + 1) * LDP + C_DT + hd]); } while (0)
    f32x16 hs = (f32x16){0.f, 0.f, 0.f, 0.f, 0.f, 0.f, 0.f, 0.f, 0.f, 0.f, 0.f, 0.f, 0.f, 0.f, 0.f, 0.f};
    SSD_LOAD(0);
    for (int ch = 0; ch < 16; ++ch) {
        { float x0 = dt0 + dtb, x1 = dt1 + dtb; const float v0 = x0 > 15.f ? x0 : __logf(1.f + __expf(x0)), v1 = x1 > 15.f ? x1 : __logf(1.f + __expf(x1));
          const float a0 = v0 * Aneg * LOG2E, a1 = v1 * Aneg * LOG2E; float sc = a0 + a1;
          sc = wave_scan_incl(sc);
          *(LAS f32x2*)(A_ + 2 * lane) = (f32x2){sc - a1, sc}; *(LAS f32x2*)(D_ + 2 * lane) = (f32x2){v0, v1}; }
#pragma unroll
        for (int i = 0; i < 4; ++i) { const int r = (tid >> 4) + 32 * i;
            *(LAS u32x4*)(lds + SL_CT + r * 272 + (tid & 15) * 16) = creg[i]; *(LAS u32x4*)(lds + SL_BT + r * 272 + (tid & 15) * 16) = breg[i]; }
        *(LAS u32x4*)(lds + SL_XT + (tid >> 2) * 64 + (tid & 3) * 16) = xreg;
        { const int lrow = tid >> 2; const float dl = D_[lrow], wl = dl * fexp2(A_[127] - A_[lrow]);
          float x[8], xd[8], xw[8]; unpack8(xreg, x);
#pragma unroll
          for (int i = 0; i < 8; ++i) { xd[i] = x[i] * dl; xw[i] = x[i] * wl; }
          *(LAS u32x4*)(lds + SL_XD + lrow * 64 + (tid & 3) * 16) = pack8(xd); *(LAS u32x4*)(lds + SL_XW + lrow * 64 + (tid & 3) * 16) = pack8(xw); }
        if (w >= 4) {
#pragma unroll
            for (int a = 0; a < 4; ++a) { u32x2 t; t.x = cvt_pk_bf16(hs[4 * a], hs[4 * a + 1]); t.y = cvt_pk_bf16(hs[4 * a + 2], hs[4 * a + 3]);
                *(LAS u32x2*)(lds + SL_HT + r32 * 272 + (32 * (w - 4) + 8 * a + 4 * hi) * 2) = t; }
        }
        if (ch + 1 < 16) SSD_LOAD(ch + 1);
        LDS_BARRIER();
        f32x16 y = (f32x16){0.f, 0.f, 0.f, 0.f, 0.f, 0.f, 0.f, 0.f, 0.f, 0.f, 0.f, 0.f, 0.f, 0.f, 0.f, 0.f};
        {
            const int li_ = (w == 0) ? 0 : (w == 1 || w == 7) ? 1 : (w == 2 || w == 5) ? 2 : 3;
            const int si0 = (w == 4 || w == 5) ? 2 : (w == 6) ? 3 : 0;
            const int nd = (w == 7) ? 0 : (w >= 1 && w <= 3) ? 2 : 1;
            const int yo = (w == 0) ? 0 : (w == 4) ? 3 : (w == 5) ? 2 : (w == 7) ? 1 : -1;
            bf16x8 bbC[8];
#pragma unroll
            for (int kk = 0; kk < 8; ++kk) bbC[kk] = *(const LAS bf16x8*)(lds + SL_CT + (32 * li_ + r32) * 272 + (16 * kk + 8 * hi) * 2);
            if (yo >= 0) ssd_yoff(lds, A_, bbC, yo, r32, hi, y);
#pragma unroll 1
            for (int d = 0; d < nd; ++d) ssd_diag(lds, A_, bbC, si0 + d, li_, r32, hi, q4, p4, g1, y);
        }
        if (w >= 4) {
            const int wi = w - 4;
            { const int slot = (w == 7) ? 0 : (w == 5) ? 1 : (w == 4) ? 2 : 3;
#pragma unroll
              for (int q = 0; q < 4; ++q) *(LAS f32x4*)(lds + SL_YO + slot * 4096 + lane * 64 + ((q ^ (lane & 3) ^ ((lane >> 2) & 3)) * 16)) = (f32x4){y[4 * q], y[4 * q + 1], y[4 * q + 2], y[4 * q + 3]}; }
            const float dec = fexp2(A_[127]);
#pragma unroll
            for (int r = 0; r < 16; ++r) hs[r] *= dec;
#pragma unroll
            for (int kk = 0; kk < 8; ++kk) {
                const LAS unsigned char* ab = lds + SL_BT + (16 * kk + 8 * hi + q4) * 272 + (32 * wi + 16 * g1 + 4 * p4) * 2;
                const LAS unsigned char* bb = lds + SL_XW + (16 * kk + 8 * hi + q4) * 64 + g1 * 32 + p4 * 8;
                hs = mfma32(cat8(trrd(ab), trrd(ab + 4 * 272)), cat8(trrd(bb), trrd(bb + 256)), hs);
            }
        }
        if (w < 4) {
#pragma unroll
            for (int a = 0; a < 4; ++a) {
                const u32x2 xr = *(const LAS u32x2*)(lds + SL_XT + (32 * w + r32) * 64 + (8 * a + 4 * hi) * 2);
                y[4 * a] += Dh * bflo(xr.x); y[4 * a + 1] += Dh * bfhi(xr.x); y[4 * a + 2] += Dh * bflo(xr.y); y[4 * a + 3] += Dh * bfhi(xr.y);
            }
        }
        LDS_BARRIER();
        if (w < 4) {
            const int li = w; bf16_t* yp = YP + (rowb + (size_t)ch * 128 + 32 * li + r32) * 1024 + hd * 64 + p0 + 4 * hi;
#pragma unroll
            for (int a = 0; a < 4; ++a) {
                float v[4] = {y[4 * a], y[4 * a + 1], y[4 * a + 2], y[4 * a + 3]};
                if (li >= 1) { const f32x4 t = *(const LAS f32x4*)(lds + SL_YO + (li - 1) * 4096 + lane * 64 + ((a ^ (lane & 3) ^ ((lane >> 2) & 3)) * 16));
                    v[0] += t[0]; v[1] += t[1]; v[2] += t[2]; v[3] += t[3]; }
                if (li == 3) { const f32x4 t = *(const LAS f32x4*)(lds + SL_YO + 3 * 4096 + lane * 64 + ((a ^ (lane & 3) ^ ((lane >> 2) & 3)) * 16));
                    v[0] += t[0]; v[1] += t[1]; v[2] += t[2]; v[3] += t[3]; }
                u32x2 o; o.x = cvt_pk_bf16(v[0], v[1]); o.y = cvt_pk_bf16(v[2], v[3]); *(u32x2*)(yp + 8 * a) = o;
            }
        }
    }
    LDS_BARRIER();
#undef SSD_LOAD
}

__device__ __forceinline__ void attn_phase(const Ctx& F, ArgsP a, int l, int gi) {
    LAS unsigned char* lds = F.lds;
    const bf16_t* P = (const bf16_t*)(a->ws + WS_ARENA + AR_P);
    const bf16_t* XC = (const bf16_t*)(F.dout + DO_XC);
    bf16_t* YP = (bf16_t*)(F.dout + DO_YC); bf16_t* YB = (bf16_t*)(F.dout + DO_R + (size_t)(gi & (NG - 1)) * TG * 1024);
    const bf16_t* KC = (const bf16_t*)(a->ws + WS_MISC + MI_KC); const bf16_t* VC = (const bf16_t*)(a->ws + WS_MISC + MI_VC);
    const float* biasT = (const float*)(a->ws + WS_MISC + MI_BIAS);
    unsigned* ctr = F.ctl + CW_WQ + 64 * (l * NG + gi);
    constexpr int NSSD = BG * 16 * 2, NNSA = BG * 2 * 32;
    for (int item = F.vcu; item < NSSD; item += F.G) {
        const int bl = item >> 5, hd = (item >> 1) & 15, ph = item & 1;
        for (int rr_ = 0; rr_ <= SSD_REP; ++rr_) ssd_unit(F, bl, hd, ph, P, XC, a->in[I_DTB][l * 16 + hd], -__expf(a->in[I_ALOG][l * 16 + hd]), a->in[I_DSKIP][l * 16 + hd], YP);
    }
    __syncthreads();
    for (int i = F.tid; i < 8 * 256; i += 512) { const int hd = i >> 8, d = (i & 255) - 64; ((LAS float*)(lds + NL_BIAS))[i] = d < 0 ? NEGBIG : (d < 128 ? biasT[hd * 128 + d] : 0.f); }
    __syncthreads();
    if (F.G * 2 == NNSA) {
#pragma unroll 1
        for (int k = 0; k < 2; ++k) {
            const int idx = k == 0 ? F.vcu : NNSA - 1 - F.vcu;
            const int qt = 31 - (idx >> 4), bg = idx & 15;
            nsa_unit(F, bg >> 1, bg & 1, qt, P, KC, VC, biasT, YB);
        }
        return;
    }
    for (;;) {
        if (F.tid == 0) *(LAS int*)(lds + LDSX + LX_WQ) = (int)__hip_atomic_fetch_add(ctr, 1u, __ATOMIC_RELAXED, __HIP_MEMORY_SCOPE_AGENT);
        __syncthreads();
        const int idx = *(const LAS int*)(lds + LDSX + LX_WQ);
        __syncthreads();
        if (idx >= NNSA) break;
        const int qt = 31 - (idx >> 4), bg = idx & 15;
        for (int rr_ = 0; rr_ <= NSA_REP; ++rr_) nsa_unit(F, bg >> 1, bg & 1, qt, P, KC, VC, biasT, YB);
    }
}


constexpr int RL_HI = 0, RL_LO = 33024, RL_GB = 66048, RL_LG = 74240, RL_ROWSTRIDE = 2064;
__device__ __forceinline__ void ln1_route_phase(const Ctx& F, ArgsP a, int l) {
    LAS unsigned char* lds = F.lds; const int tid = F.tid, lane = F.lane, w = F.wave, fr = lane & 15, q = lane >> 4;
    LAS int* lcnt = (LAS int*)(lds + LDSX + LX_CNTL); LAS int* lbase = (LAS int*)(lds + LDSX + LX_BASE); LAS int* rows = (LAS int*)(lds + LDSX + LX_ROWS);
    for (int i = tid; i < 16384; i += 512) { const float x = a->in[I_RW][i]; const bf16_t hi = f2bf(x); const bf16_t lo = f2bf(x - bf1(hi)); const int d = i >> 4, e = i & 15;
        *(LAS bf16_t*)(lds + RL_HI + e * RL_ROWSTRIDE + d * 2) = hi; *(LAS bf16_t*)(lds + RL_LO + e * RL_ROWSTRIDE + d * 2) = lo; }
    { LAS float* GB = (LAS float*)(lds + RL_GB); for (int i = tid; i < 1024; i += 512) { GB[i] = a->in[I_LN1G][l * DM + i]; GB[1024 + i] = a->in[I_LN1B][l * DM + i]; } }
    bf16_t* H1 = (bf16_t*)(a->ws + WS_PRE1);
    float rb[16];
#pragma unroll
    for (int e = 0; e < 16; ++e) rb[e] = a->in[I_RB][e];
    unsigned* gcnt = F.ctl + CW_CNT + 64 * l;
    int* rtok = (int*)(a->ws + WS_ARENA + AR_RTOK); int2* rinfo = (int2*)(a->ws + WS_ARENA + AR_RINFO);
    for (int rb0 = blockIdx.x * 128; rb0 < T_; rb0 += F.G * 128) {
        if (tid < 16) lcnt[tid] = 0;
        __syncthreads();
        {
            bf16_t* rowp = H1 + ((size_t)rb0 + w * 16 + fr) * DM + 8 * q;
            float s = 0.f, ss = 0.f;
#pragma unroll 8
            for (int kk = 0; kk < 32; ++kk) { float x[8]; unpack8(*(const u32x4*)(rowp + 32 * kk), x);
#pragma unroll
                for (int j = 0; j < 8; ++j) { s += x[j]; ss += x[j] * x[j]; } }
            s += __shfl_xor(s, 16); s += __shfl_xor(s, 32); ss += __shfl_xor(ss, 16); ss += __shfl_xor(ss, 32);
            const float mean = s * (1.f / DM), rstd = 1.f / sqrtf(fmaxf(ss * (1.f / DM) - mean * mean, 0.f) + LN_EPS);
            f32x4 acc = {0.f, 0.f, 0.f, 0.f};
            const LAS float* GB = (const LAS float*)(lds + RL_GB);
#pragma unroll 2
            for (int kk = 0; kk < 32; ++kk) {
                float x[8], lo[8]; unpack8(*(const u32x4*)(rowp + 32 * kk), x);
                const f32x4 g0 = *(const LAS f32x4*)(GB + 32 * kk + 8 * q), g1 = *(const LAS f32x4*)(GB + 32 * kk + 8 * q + 4);
                const f32x4 b0 = *(const LAS f32x4*)(GB + 1024 + 32 * kk + 8 * q), b1 = *(const LAS f32x4*)(GB + 1024 + 32 * kk + 8 * q + 4);
#pragma unroll
                for (int j = 0; j < 4; ++j) { x[j] = (x[j] - mean) * rstd * g0[j] + b0[j]; x[4 + j] = (x[4 + j] - mean) * rstd * g1[j] + b1[j]; }
                const u32x4 hp = pack8(x);
                *(u32x4*)(rowp + 32 * kk) = hp;
                *(u32x2*)(a->ws + WS_H18 + ((size_t)rb0 + w * 16 + fr) * DM + 8 * q + 32 * kk) = pack8_i8(x, ASCALE);
                { float hf[8]; unpack8(hp, hf);
#pragma unroll
                  for (int j = 0; j < 8; ++j) lo[j] = x[j] - hf[j]; }
                const bf16x8 ahi = __builtin_bit_cast(bf16x8, hp), alo = __builtin_bit_cast(bf16x8, pack8(lo));
                const bf16x8 bhi = *(const LAS bf16x8*)(lds + RL_HI + fr * RL_ROWSTRIDE + (32 * kk + 8 * q) * 2), blo = *(const LAS bf16x8*)(lds + RL_LO + fr * RL_ROWSTRIDE + (32 * kk + 8 * q) * 2);
                acc = mfma16(ahi, bhi, acc); acc = mfma16(ahi, blo, acc); acc = mfma16(alo, bhi, acc);
                asm volatile("" ::: "memory");
            }
            LAS float* LG = (LAS float*)(lds + RL_LG) + w * 256;
#pragma unroll
            for (int r = 0; r < 4; ++r) LG[(4 * q + r) * 16 + fr] = acc[r];
        }
        LDS_WAIT();
        if (lane < 16) {
            const LAS float* LG = (const LAS float*)(lds + RL_LG) + w * 256 + lane * 16;
            float lg[16];
#pragma unroll
            for (int e4 = 0; e4 < 4; ++e4) { const f32x4 t = *(const LAS f32x4*)(LG + 4 * e4); lg[4 * e4] = t[0]; lg[4 * e4 + 1] = t[1]; lg[4 * e4 + 2] = t[2]; lg[4 * e4 + 3] = t[3]; }
            float mx = lg[0];
#pragma unroll
            for (int e = 1; e < 16; ++e) mx = fmaxf(mx, lg[e]);
            float pr[16], ps = 0.f;
#pragma unroll
            for (int e = 0; e < 16; ++e) { pr[e] = __expf(lg[e] - mx); ps += pr[e]; }
            const float pinv = 1.f / ps;
            float sc[16];
#pragma unroll
            for (int e = 0; e < 16; ++e) { pr[e] *= pinv; sc[e] = pr[e] + rb[e]; }
            int grp = 0; float gbest = -1e30f;
#pragma unroll
            for (int qq = 0; qq < 4; ++qq) {
                const float s0 = sc[4 * qq], s1 = sc[4 * qq + 1], s2_ = sc[4 * qq + 2], s3 = sc[4 * qq + 3];
                const float tot = (s0 + s1) + (s2_ + s3), mn1 = fminf(fminf(s0, s1), fminf(s2_, s3));
                const float m2 = fminf(fminf(fminf(fmaxf(s0, s1), fmaxf(s0, s2_)), fminf(fmaxf(s0, s3), fmaxf(s1, s2_))), fminf(fmaxf(s1, s3), fmaxf(s2_, s3)));
                const float top2 = tot - mn1 - m2;
                if (top2 > gbest) { gbest = top2; grp = qq; }
            }
            float c0 = 0.f, c1 = 0.f, c2 = 0.f, c3 = 0.f, q0 = 0.f, q1 = 0.f, q2 = 0.f, q3 = 0.f;
#pragma unroll
            for (int qq = 0; qq < 4; ++qq) if (grp == qq) { c0 = sc[4 * qq]; c1 = sc[4 * qq + 1]; c2 = sc[4 * qq + 2]; c3 = sc[4 * qq + 3]; q0 = pr[4 * qq]; q1 = pr[4 * qq + 1]; q2 = pr[4 * qq + 2]; q3 = pr[4 * qq + 3]; }
            int i0 = 0; float b0 = c0; if (c1 > b0) { b0 = c1; i0 = 1; } if (c2 > b0) { b0 = c2; i0 = 2; } if (c3 > b0) { b0 = c3; i0 = 3; }
            int i1 = -1; float b1 = -1e30f;
            if (i0 != 0 && c0 > b1) { b1 = c0; i1 = 0; } if (i0 != 1 && c1 > b1) { b1 = c1; i1 = 1; } if (i0 != 2 && c2 > b1) { b1 = c2; i1 = 2; } if (i0 != 3 && c3 > b1) { b1 = c3; i1 = 3; }
            const float w0 = (i0 == 0) ? q0 : (i0 == 1) ? q1 : (i0 == 2) ? q2 : q3, w1 = (i1 == 0) ? q0 : (i1 == 1) ? q1 : (i1 == 2) ? q2 : q3;
            const float wn = 1.f / (w0 + w1);
            const int e0 = 4 * grp + i0, e1 = 4 * grp + i1, rl = w * 16 + lane;
            const int pos0 = atomicAdd((int*)(lds + LDSX + LX_CNTL) + e0, 1), pos1 = atomicAdd((int*)(lds + LDSX + LX_CNTL) + e1, 1);
            rows[rl * 8 + 0] = e0; rows[rl * 8 + 1] = e1; rows[rl * 8 + 2] = pos0; rows[rl * 8 + 3] = pos1; rows[rl * 8 + 4] = __float_as_int(w0 * wn); rows[rl * 8 + 5] = __float_as_int(w1 * wn);
        }
        __syncthreads();
        if (tid < 16) lbase[tid] = (int)__hip_atomic_fetch_add(gcnt + tid, (unsigned)lcnt[tid], __ATOMIC_RELAXED, __HIP_MEMORY_SCOPE_AGENT);
        __syncthreads();
        if (tid < 128) {
            const int e0 = rows[tid * 8], e1 = rows[tid * 8 + 1]; const int t = rb0 + tid;
            const int p0 = e0 * ECAP + lbase[e0] + rows[tid * 8 + 2], p1 = e1 * ECAP + lbase[e1] + rows[tid * 8 + 3];
            rtok[p0] = t; rinfo[p0] = make_int2(t, rows[tid * 8 + 4]); rtok[p1] = t; rinfo[p1] = make_int2(T_ + t, rows[tid * 8 + 5]);
        }
        __syncthreads();
    }
}

__device__ __forceinline__ int moe_tables(const Ctx& F, int l, const int* rtok) {
    LAS int* off = (LAS int*)(F.lds + LDSX + LX_OFF); LAS int* ecnt = (LAS int*)(F.lds + LDSX + LX_ECNT); LAS int* tile_e = (LAS int*)(F.lds + LDSX + LX_TILE); LAS int* gidx = (LAS int*)(F.lds + LDSX + LX_GIDX);
    __syncthreads();
    if (F.tid == 0) { int o = 0;
        for (int e = 0; e < 16; ++e) { off[e] = o; const int c = (int)__hip_atomic_load(F.ctl + CW_CNT + 64 * l + e, __ATOMIC_RELAXED, __HIP_MEMORY_SCOPE_AGENT); ecnt[e] = c; const int nt = (c + 255) >> 8;
            for (int k = 0; k < nt; ++k) tile_e[(o >> 8) + k] = e; o += nt << 8; }
        off[16] = o; }
    __syncthreads();
    const int nrt = off[16] >> 8;
    if (rtok) {
        for (int i = 0; i < 8; ++i) { const long L = (long)i * F.G + F.vcu; if (L >= (long)nrt * 4) break;
            const int rt = (int)(L >> 2), e = tile_e[rt], k0 = rt * 256 - off[e], c = ecnt[e];
            if (F.tid < 256) gidx[i * 256 + F.tid] = (k0 + F.tid < c) ? rtok[e * ECAP + k0 + F.tid] : 0; }
        __syncthreads();
    }
    return nrt;
}
__device__ __forceinline__ void ln2_phase(const Ctx& F, ArgsP a, int l, bool last) {
    const bf16_t* H1 = (const bf16_t*)(a->ws + WS_PRE1); const bf16_t* YS = (const bf16_t*)(a->ws + WS_ARENA + AR_XS);
    bf16_t* H = (bf16_t*)(a->ws + WS_H); float* OUT = a->out;
    const float* g = a->in[I_LN2G] + l * DM; const float* b = a->in[I_LN2B] + l * DM; const int lane = F.lane;
    float gg[16], bb[16];
#pragma unroll
    for (int i = 0; i < 8; ++i) { gg[i] = g[8 * lane + i]; gg[8 + i] = g[512 + 8 * lane + i]; bb[i] = b[8 * lane + i]; bb[8 + i] = b[512 + 8 * lane + i]; }
    u32x4 nx[6];
#define LN2_LOAD(t_) do { _Pragma("unroll") for (int hf = 0; hf < 2; ++hf) { nx[3 * hf] = *(const u32x4*)(H1 + (size_t)(t_) * DM + 512 * hf + 8 * lane); \
        nx[3 * hf + 1] = *(const u32x4*)(YS + (size_t)(t_) * DM + 512 * hf + 8 * lane); nx[3 * hf + 2] = *(const u32x4*)(YS + (size_t)(T_ + (t_)) * DM + 512 * hf + 8 * lane); } } while (0)
    LN2_LOAD(F.gw);
    for (int t = F.gw; t < T_; t += F.NGW) {
        float v[16];
        u32x4 cur[6];
#pragma unroll
        for (int i = 0; i < 6; ++i) cur[i] = nx[i];
        if (t + F.NGW < T_) LN2_LOAD(t + F.NGW);
#pragma unroll
        for (int hf = 0; hf < 2; ++hf) { float x[8], y0[8], y1[8];
            unpack8(cur[3 * hf], x);
            unpack8(cur[3 * hf + 1], y0);
            unpack8(cur[3 * hf + 2], y1);
#pragma unroll
            for (int i = 0; i < 8; ++i) v[8 * hf + i] = DN_ALPHA * x[i] + (y0[i] + y1[i]); }
        float s = 0.f;
#pragma unroll
        for (int i = 0; i < 16; ++i) s += v[i];
        const float mean = wave_sum(s) * (1.f / DM); float s2 = 0.f;
#pragma unroll
        for (int i = 0; i < 16; ++i) { v[i] -= mean; s2 += v[i] * v[i]; }
        const float rstd = 1.f / sqrtf(wave_sum(s2) * (1.f / DM) + LN_EPS);
#pragma unroll
        for (int i = 0; i < 16; ++i) v[i] = v[i] * rstd * gg[i] + bb[i];
        if (last) {
#pragma unroll
            for (int hf = 0; hf < 2; ++hf) { float* o = OUT + (size_t)t * DM + 512 * hf + 8 * lane;
                *(f32x4*)o = (f32x4){v[8 * hf], v[8 * hf + 1], v[8 * hf + 2], v[8 * hf + 3]}; *(f32x4*)(o + 4) = (f32x4){v[8 * hf + 4], v[8 * hf + 5], v[8 * hf + 6], v[8 * hf + 7]}; }
        } else {
#pragma unroll
            for (int hf = 0; hf < 2; ++hf) { float tt[8];
#pragma unroll
                for (int i = 0; i < 8; ++i) tt[i] = v[8 * hf + i];
                *(u32x4*)(H + (size_t)t * DM + 512 * hf + 8 * lane) = pack8(tt);
                *(u32x2*)(a->ws + WS_H8 + (size_t)t * DM + 512 * hf + 8 * lane) = pack8_i8(tt, ASCALE); }
        }
    }
}

#ifndef REP_MASK
#define REP_MASK 0
#endif
#ifndef PH_MASK
#define PH_MASK 0xfff
#endif
constexpr int NSTEPS = 1 + DEPTH * (NG * 4 + 6);
__global__ void __launch_bounds__(512, 2) fwd_kernel(Args a_unused) {
    const ArgsP a = (ArgsP)__builtin_amdgcn_kernarg_segment_ptr();
    extern __shared__ __attribute__((aligned(16))) unsigned char smem[];
    const int wave0_ = __builtin_amdgcn_readfirstlane((int)threadIdx.x >> 6);
    Ctx F;
#define MKCTX do { int t_; asm volatile("v_mbcnt_lo_u32_b32 %0, -1, 0\n\tv_mbcnt_hi_u32_b32 %0, -1, %0" : "=v"(t_)); t_ += wave0_ * 64; F.lds = (LAS unsigned char*)smem; F.tid = t_; F.lane = t_ & 63; F.wave = wave0_; \
        F.G = gridDim.x; { const int bx = blockIdx.x; F.vcu = (F.G % 8 == 0) ? (bx % 8) * (F.G / 8) + bx / 8 : bx; } \
        F.gw = blockIdx.x * 8 + F.wave; F.NGW = F.G * 8; F.ws = a->ws; F.dout = (unsigned char*)a->out; F.ctl = (unsigned*)(a->ws + WS_CTL); } while (0)
    MKCTX;
    for (int u = F.tid; u < (LDS_TOTAL - LDSX) / 4; u += 512) ((LAS unsigned*)(F.lds + LDSX))[u] = 0u;
    __syncthreads();
    const bool multi = (a->hi - a->lo) > 1;
    XcdBarrier bar; bar.bar = F.ctl + CW_BAR; bar.x = 0; bar.st = (volatile LAS unsigned*)(F.lds + LDSX + LX_BAR);
    if (multi) bar = xcd_barrier_post(F.ctl + CW_BAR, (volatile LAS unsigned*)(F.lds + LDSX + LX_BAR), F.tid);
    int step = 0;
#ifndef SKEW_S1
#define SKEW_S1 0
#endif
#define SKEW_WAIT(step_) do { const int n_ = (int)((blockIdx.x >> 3) & 7) * (step_); for (int i_ = 0; i_ < n_; ++i_) __builtin_amdgcn_s_sleep(16); } while (0)
#define RUN_STEP (step >= a->lo && step < a->hi)
#ifndef BAR_REP
#define BAR_REP 0
#endif
#define END_STEP do { if (RUN_STEP && step + 1 < a->hi) { xcd_barrier(bar, F.tid); if (BAR_REP) xcd_barrier(bar, F.tid); } ++step; } while (0)

    if (RUN_STEP && ((PH_MASK >> 0) & 1)) for (int rep_ = 0; rep_ <= ((REP_MASK >> 0) & 1); ++rep_) { MKCTX; p0_prologue(F, a); }
    END_STEP;

    {
        unsigned char* wl = a->ws + WS_W + (size_t)0 * W_LAYER;
        bf16_t* Hb = (bf16_t*)(a->ws + WS_H);
        bf16_t* P = (bf16_t*)(a->ws + WS_ARENA + AR_P);
        {
            const bf16_t* Hg = Hb + (size_t)0 * TG * DM;
            if (RUN_STEP && ((PH_MASK >> 1) & 1)) for (int rep_ = 0; rep_ <= ((REP_MASK >> 1) & 1); ++rep_) { MKCTX;
                pg8::Gemm g{(const bf16_t*)(a->ws + WS_H8 + (size_t)0 * TG * DM), (const bf16_t*)(wl + WO_IN), 512, 512, 512}; pg8::StaticOrder S; S.init(TG, LDP, 512, 512, F.G, (int)blockIdx.x, 512);
                pg8::Epi<pg8::EK_PROJ> E{P, LDP, nullptr, 0, nullptr, nullptr, nullptr, 1.f / (WSCALE * ASCALE)};
                SKEW_WAIT(SKEW_S1);
                pg8::gemm_phase<pg8::Epi<pg8::EK_PROJ>, pg8::StaticOrder, false, true>(F.lds, F.tid, g, S, E);
            }
            END_STEP;
            if (RUN_STEP && ((PH_MASK >> 2) & 1)) for (int rep_ = 0; rep_ <= ((REP_MASK >> 2) & 1); ++rep_) { MKCTX;
                for (int cu = blockIdx.x; cu < BG * 32; cu += F.G)
                    compress_unit(F, cu, P, (const bf16_t*)(wl + WO_W1), (const bf16_t*)(wl + WO_W2), (const float*)(a->ws + WS_MISC + MI_B1) + 0 * 256,
                                  (bf16_t*)(a->ws + WS_MISC + MI_KC), (bf16_t*)(a->ws + WS_MISC + MI_VC));
                conv_phase(F, P, (bf16_t*)(F.dout + DO_XC), a->in[I_CONVW] + (size_t)0 * 4 * 2048, a->in[I_CONVB] + (size_t)0 * 2048);
            }
            END_STEP;
            if (RUN_STEP && ((PH_MASK >> 3) & 1)) for (int rep_ = 0; rep_ <= ((REP_MASK >> 3) & 1); ++rep_) { MKCTX; attn_phase(F, a, 0, 0 + 4 * rep_); }
            END_STEP;
            if (RUN_STEP && ((PH_MASK >> 4) & 1)) for (int rep_ = 0; rep_ <= ((REP_MASK >> 4) & 1); ++rep_) { MKCTX; fin_phase(F, P, (bf16_t*)(F.dout + DO_R + (size_t)0 * TG * 1024), (const bf16_t*)(F.dout + DO_YC), a->ws + WS_ARENA + AR_YC8 + (size_t)0 * TG * 1024, a->in[I_SNG] + (size_t)0 * DM); }
            END_STEP;
        }
        {
            const bf16_t* Hg = Hb + (size_t)1 * TG * DM;
            if (RUN_STEP && ((PH_MASK >> 1) & 1)) for (int rep_ = 0; rep_ <= ((REP_MASK >> 1) & 1); ++rep_) { MKCTX;
                pg8::Gemm g{(const bf16_t*)(a->ws + WS_H8 + (size_t)1 * TG * DM), (const bf16_t*)(wl + WO_IN), 512, 512, 512}; pg8::StaticOrder S; S.init(TG, LDP, 512, 512, F.G, (int)blockIdx.x, 512);
                pg8::Epi<pg8::EK_PROJ> E{P, LDP, nullptr, 0, nullptr, nullptr, nullptr, 1.f / (WSCALE * ASCALE)};
                SKEW_WAIT(SKEW_S1);
                pg8::gemm_phase<pg8::Epi<pg8::EK_PROJ>, pg8::StaticOrder, false, true>(F.lds, F.tid, g, S, E);
            }
            END_STEP;
            if (RUN_STEP && ((PH_MASK >> 2) & 1)) for (int rep_ = 0; rep_ <= ((REP_MASK >> 2) & 1); ++rep_) { MKCTX;
                for (int cu = blockIdx.x; cu < BG * 32; cu += F.G)
                    compress_unit(F, cu, P, (const bf16_t*)(wl + WO_W1), (const bf16_t*)(wl + WO_W2), (const float*)(a->ws + WS_MISC + MI_B1) + 0 * 256,
                                  (bf16_t*)(a->ws + WS_MISC + MI_KC), (bf16_t*)(a->ws + WS_MISC + MI_VC));
                conv_phase(F, P, (bf16_t*)(F.dout + DO_XC), a->in[I_CONVW] + (size_t)0 * 4 * 2048, a->in[I_CONVB] + (size_t)0 * 2048);
            }
            END_STEP;
            if (RUN_STEP && ((PH_MASK >> 3) & 1)) for (int rep_ = 0; rep_ <= ((REP_MASK >> 3) & 1); ++rep_) { MKCTX; attn_phase(F, a, 0, 1 + 4 * rep_); }
            END_STEP;
            if (RUN_STEP && ((PH_MASK >> 4) & 1)) for (int rep_ = 0; rep_ <= ((REP_MASK >> 4) & 1); ++rep_) { MKCTX; fin_phase(F, P, (bf16_t*)(F.dout + DO_R + (size_t)1 * TG * 1024), (const bf16_t*)(F.dout + DO_YC), a->ws + WS_ARENA + AR_YC8 + (size_t)1 * TG * 1024, a->in[I_SNG] + (size_t)0 * DM); }
            END_STEP;
        }
        if (RUN_STEP && ((PH_MASK >> 5) & 1)) for (int rep_ = 0; rep_ <= ((REP_MASK >> 5) & 1); ++rep_) { MKCTX;
            bf16_t* GT = (bf16_t*)(a->ws + WS_ARENA + AR_GATES); bf16_t* MX = (bf16_t*)(a->ws + WS_H18);   float* TMP = (float*)(F.dout + DO_TMP);
            pg8::Gemm g{nullptr, nullptr, 512, 512, 512};
            pg8::S5Order S; S.so.init(T_, DM, 512, 512, F.G, (int)blockIdx.x, 512);
            S.aH = (long)(size_t)(a->ws + WS_H8); S.aRY = (long)(size_t)(F.dout + DO_R); S.aYC = (long)(size_t)(a->ws + WS_ARENA + AR_YC8);
            S.bG = (long)(size_t)(wl + WO_GATE); S.bCN = (long)(size_t)(wl + WO_C); S.bS = (long)(size_t)(wl + WO_SSD);
            { LAS unsigned char* lut = F.lds + LDSX + LX_LUT;
              for (int i = F.tid; i < 1024; i += 512) lut[i] = (unsigned char)__float2int_rn(127.f * sigmoidf_((float)(i - 512) * (1.f / 64.f)));
              __syncthreads(); }
            pg8::Epi<pg8::EK_S5> E{GT, 3072, nullptr, 0, TMP, nullptr, MX, 1.f, (unsigned)(size_t)(F.lds + LDSX + LX_LUT)};
            pg8::gemm_phase<pg8::Epi<pg8::EK_S5>, pg8::S5Order, false, true>(F.lds, F.tid, g, S, E);
        }
        END_STEP;
        if (RUN_STEP && ((PH_MASK >> 6) & 1)) for (int rep_ = 0; rep_ <= ((REP_MASK >> 6) & 1); ++rep_) { MKCTX;
            pg8::Gemm g{(const bf16_t*)(a->ws + WS_H18), (const bf16_t*)(wl + WO_OUT), 512, 512, 512}; pg8::StaticOrder S; S.init(T_, DM, 512, 512, F.G, (int)blockIdx.x, 512);
            pg8::Epi<pg8::EK_WOUT> E{(bf16_t*)(a->ws + WS_PRE1), DM, Hb, DM, nullptr, nullptr, nullptr, 1.f / (WSCALE_OUT * MSCALE)};
            pg8::gemm_phase<pg8::Epi<pg8::EK_WOUT>, pg8::StaticOrder, false, true>(F.lds, F.tid, g, S, E);
        }
        END_STEP;
        if (RUN_STEP && ((PH_MASK >> 7) & 1)) for (int rep_ = 0; rep_ <= ((REP_MASK >> 7) & 1); ++rep_) { MKCTX; ln1_route_phase(F, a, 0); }
        END_STEP;
        if (RUN_STEP && ((PH_MASK >> 9) & 1)) for (int rep_ = 0; rep_ <= ((REP_MASK >> 9) & 1); ++rep_) { MKCTX;
            const int nrt = moe_tables(F, 0, (const int*)(a->ws + WS_ARENA + AR_RTOK));
            pg8::Gemm g{(const bf16_t*)(a->ws + WS_H18), (const bf16_t*)(wl + WO_UP), 512, 512, 512};
            pg8::MoeOrder S{(const LAS int*)(F.lds + LDSX + LX_TILE), (const LAS int*)(F.lds + LDSX + LX_OFF), (const LAS int*)(F.lds + LDSX + LX_ECNT), nrt, F.G, F.vcu, 8, (long)256 * DM, (long)256 * DM, (long)1024 * DM};
            pg8::Epi<pg8::EK_GLU> E{(bf16_t*)(a->ws + WS_ARENA + AR_HID), 512, nullptr, 0, nullptr, nullptr, nullptr, 1.f / (WSCALE * ASCALE)};
            pg8::gemm_phase<pg8::Epi<pg8::EK_GLU>, pg8::MoeOrder, true, true>(F.lds, F.tid, g, S, E, (const LAS int*)(F.lds + LDSX + LX_GIDX));
        }
        END_STEP;
        if (RUN_STEP && ((PH_MASK >> 10) & 1)) for (int rep_ = 0; rep_ <= ((REP_MASK >> 10) & 1); ++rep_) { MKCTX;
            const int nrt = moe_tables(F, 0, nullptr);
            pg8::Gemm g{(const bf16_t*)(a->ws + WS_ARENA + AR_HID), (const bf16_t*)(wl + WO_DN), 256, 256, 256};
            pg8::MoeOrder S{(const LAS int*)(F.lds + LDSX + LX_TILE), (const LAS int*)(F.lds + LDSX + LX_OFF), (const LAS int*)(F.lds + LDSX + LX_ECNT), nrt, F.G, F.vcu, 4, (long)256 * 512, (long)256 * 512, (long)1024 * 512};
            pg8::Epi<pg8::EK_DOWN> E{(bf16_t*)(a->ws + WS_ARENA + AR_XS), DM, nullptr, 0, nullptr, (const int2*)(a->ws + WS_ARENA + AR_RINFO), nullptr, 1.f / (WSCALE_DN * HSCALE)};
            pg8::gemm_phase<pg8::Epi<pg8::EK_DOWN>, pg8::MoeOrder, false, true>(F.lds, F.tid, g, S, E);
        }
        END_STEP;
        if (RUN_STEP && ((PH_MASK >> 11) & 1)) for (int rep_ = 0; rep_ <= ((REP_MASK >> 11) & 1); ++rep_) { MKCTX; ln2_phase(F, a, 0, 0 == DEPTH - 1); }
        END_STEP;
    }
    {
        unsigned char* wl = a->ws + WS_W + (size_t)1 * W_LAYER;
        bf16_t* Hb = (bf16_t*)(a->ws + WS_H);
        bf16_t* P = (bf16_t*)(a->ws + WS_ARENA + AR_P);
        {
            const bf16_t* Hg = Hb + (size_t)0 * TG * DM;
            if (RUN_STEP && ((PH_MASK >> 1) & 1)) for (int rep_ = 0; rep_ <= ((REP_MASK >> 1) & 1); ++rep_) { MKCTX;
                pg8::Gemm g{(const bf16_t*)(a->ws + WS_H8 + (size_t)0 * TG * DM), (const bf16_t*)(wl + WO_IN), 512, 512, 512}; pg8::StaticOrder S; S.init(TG, LDP, 512, 512, F.G, (int)blockIdx.x, 512);
                pg8::Epi<pg8::EK_PROJ> E{P, LDP, nullptr, 0, nullptr, nullptr, nullptr, 1.f / (WSCALE * ASCALE)};
                SKEW_WAIT(SKEW_S1);
                pg8::gemm_phase<pg8::Epi<pg8::EK_PROJ>, pg8::StaticOrder, false, true>(F.lds, F.tid, g, S, E);
            }
            END_STEP;
            if (RUN_STEP && ((PH_MASK >> 2) & 1)) for (int rep_ = 0; rep_ <= ((REP_MASK >> 2) & 1); ++rep_) { MKCTX;
                for (int cu = blockIdx.x; cu < BG * 32; cu += F.G)
                    compress_unit(F, cu, P, (const bf16_t*)(wl + WO_W1), (const bf16_t*)(wl + WO_W2), (const float*)(a->ws + WS_MISC + MI_B1) + 1 * 256,
                                  (bf16_t*)(a->ws + WS_MISC + MI_KC), (bf16_t*)(a->ws + WS_MISC + MI_VC));
                conv_phase(F, P, (bf16_t*)(F.dout + DO_XC), a->in[I_CONVW] + (size_t)1 * 4 * 2048, a->in[I_CONVB] + (size_t)1 * 2048);
            }
            END_STEP;
            if (RUN_STEP && ((PH_MASK >> 3) & 1)) for (int rep_ = 0; rep_ <= ((REP_MASK >> 3) & 1); ++rep_) { MKCTX; attn_phase(F, a, 1, 0 + 4 * rep_); }
            END_STEP;
            if (RUN_STEP && ((PH_MASK >> 4) & 1)) for (int rep_ = 0; rep_ <= ((REP_MASK >> 4) & 1); ++rep_) { MKCTX; fin_phase(F, P, (bf16_t*)(F.dout + DO_R + (size_t)0 * TG * 1024), (const bf16_t*)(F.dout + DO_YC), a->ws + WS_ARENA + AR_YC8 + (size_t)0 * TG * 1024, a->in[I_SNG] + (size_t)1 * DM); }
            END_STEP;
        }
        {
            const bf16_t* Hg = Hb + (size_t)1 * TG * DM;
            if (RUN_STEP && ((PH_MASK >> 1) & 1)) for (int rep_ = 0; rep_ <= ((REP_MASK >> 1) & 1); ++rep_) { MKCTX;
                pg8::Gemm g{(const bf16_t*)(a->ws + WS_H8 + (size_t)1 * TG * DM), (const bf16_t*)(wl + WO_IN), 512, 512, 512}; pg8::StaticOrder S; S.init(TG, LDP, 512, 512, F.G, (int)blockIdx.x, 512);
                pg8::Epi<pg8::EK_PROJ> E{P, LDP, nullptr, 0, nullptr, nullptr, nullptr, 1.f / (WSCALE * ASCALE)};
                SKEW_WAIT(SKEW_S1);
                pg8::gemm_phase<pg8::Epi<pg8::EK_PROJ>, pg8::StaticOrder, false, true>(F.lds, F.tid, g, S, E);
            }
            END_STEP;
            if (RUN_STEP && ((PH_MASK >> 2) & 1)) for (int rep_ = 0; rep_ <= ((REP_MASK >> 2) & 1); ++rep_) { MKCTX;
                for (int cu = blockIdx.x; cu < BG * 32; cu += F.G)
                    compress_unit(F, cu, P, (const bf16_t*)(wl + WO_W1), (const bf16_t*)(wl + WO_W2), (const float*)(a->ws + WS_MISC + MI_B1) + 1 * 256,
                                  (bf16_t*)(a->ws + WS_MISC + MI_KC), (bf16_t*)(a->ws + WS_MISC + MI_VC));
                conv_phase(F, P, (bf16_t*)(F.dout + DO_XC), a->in[I_CONVW] + (size_t)1 * 4 * 2048, a->in[I_CONVB] + (size_t)1 * 2048);
            }
            END_STEP;
            if (RUN_STEP && ((PH_MASK >> 3) & 1)) for (int rep_ = 0; rep_ <= ((REP_MASK >> 3) & 1); ++rep_) { MKCTX; attn_phase(F, a, 1, 1 + 4 * rep_); }
            END_STEP;
            if (RUN_STEP && ((PH_MASK >> 4) & 1)) for (int rep_ = 0; rep_ <= ((REP_MASK >> 4) & 1); ++rep_) { MKCTX; fin_phase(F, P, (bf16_t*)(F.dout + DO_R + (size_t)1 * TG * 1024), (const bf16_t*)(F.dout + DO_YC), a->ws + WS_ARENA + AR_YC8 + (size_t)1 * TG * 1024, a->in[I_SNG] + (size_t)1 * DM); }
            END_STEP;
        }
        if (RUN_STEP && ((PH_MASK >> 5) & 1)) for (int rep_ = 0; rep_ <= ((REP_MASK >> 5) & 1); ++rep_) { MKCTX;
            bf16_t* GT = (bf16_t*)(a->ws + WS_ARENA + AR_GATES); bf16_t* MX = (bf16_t*)(a->ws + WS_H18);   float* TMP = (float*)(F.dout + DO_TMP);
            pg8::Gemm g{nullptr, nullptr, 512, 512, 512};
            pg8::S5Order S; S.so.init(T_, DM, 512, 512, F.G, (int)blockIdx.x, 512);
            S.aH = (long)(size_t)(a->ws + WS_H8); S.aRY = (long)(size_t)(F.dout + DO_R); S.aYC = (long)(size_t)(a->ws + WS_ARENA + AR_YC8);
            S.bG = (long)(size_t)(wl + WO_GATE); S.bCN = (long)(size_t)(wl + WO_C); S.bS = (long)(size_t)(wl + WO_SSD);
            { LAS unsigned char* lut = F.lds + LDSX + LX_LUT;
              for (int i = F.tid; i < 1024; i += 512) lut[i] = (unsigned char)__float2int_rn(127.f * sigmoidf_((float)(i - 512) * (1.f / 64.f)));
              __syncthreads(); }
            pg8::Epi<pg8::EK_S5> E{GT, 3072, nullptr, 0, TMP, nullptr, MX, 1.f, (unsigned)(size_t)(F.lds + LDSX + LX_LUT)};
            pg8::gemm_phase<pg8::Epi<pg8::EK_S5>, pg8::S5Order, false, true>(F.lds, F.tid, g, S, E);
        }
        END_STEP;
        if (RUN_STEP && ((PH_MASK >> 6) & 1)) for (int rep_ = 0; rep_ <= ((REP_MASK >> 6) & 1); ++rep_) { MKCTX;
            pg8::Gemm g{(const bf16_t*)(a->ws + WS_H18), (const bf16_t*)(wl + WO_OUT), 512, 512, 512}; pg8::StaticOrder S; S.init(T_, DM, 512, 512, F.G, (int)blockIdx.x, 512);
            pg8::Epi<pg8::EK_WOUT> E{(bf16_t*)(a->ws + WS_PRE1), DM, Hb, DM, nullptr, nullptr, nullptr, 1.f / (WSCALE_OUT * MSCALE)};
            pg8::gemm_phase<pg8::Epi<pg8::EK_WOUT>, pg8::StaticOrder, false, true>(F.lds, F.tid, g, S, E);
        }
        END_STEP;
        if (RUN_STEP && ((PH_MASK >> 7) & 1)) for (int rep_ = 0; rep_ <= ((REP_MASK >> 7) & 1); ++rep_) { MKCTX; ln1_route_phase(F, a, 1); }
        END_STEP;
        if (RUN_STEP && ((PH_MASK >> 9) & 1)) for (int rep_ = 0; rep_ <= ((REP_MASK >> 9) & 1); ++rep_) { MKCTX;
            const int nrt = moe_tables(F, 1, (const int*)(a->ws + WS_ARENA + AR_RTOK));
            pg8::Gemm g{(const bf16_t*)(a->ws + WS_H18), (const bf16_t*)(wl + WO_UP), 512, 512, 512};
            pg8::MoeOrder S{(const LAS int*)(F.lds + LDSX + LX_TILE), (const LAS int*)(F.lds + LDSX + LX_OFF), (const LAS int*)(F.lds + LDSX + LX_ECNT), nrt, F.G, F.vcu, 8, (long)256 * DM, (long)256 * DM, (long)1024 * DM};
            pg8::Epi<pg8::EK_GLU> E{(bf16_t*)(a->ws + WS_ARENA + AR_HID), 512, nullptr, 0, nullptr, nullptr, nullptr, 1.f / (WSCALE * ASCALE)};
            pg8::gemm_phase<pg8::Epi<pg8::EK_GLU>, pg8::MoeOrder, true, true>(F.lds, F.tid, g, S, E, (const LAS int*)(F.lds + LDSX + LX_GIDX));
        }
        END_STEP;
        if (RUN_STEP && ((PH_MASK >> 10) & 1)) for (int rep_ = 0; rep_ <= ((REP_MASK >> 10) & 1); ++rep_) { MKCTX;
            const int nrt = moe_tables(F, 1, nullptr);
            pg8::Gemm g{(const bf16_t*)(a->ws + WS_ARENA + AR_HID), (const bf16_t*)(wl + WO_DN), 256, 256, 256};
            pg8::MoeOrder S{(const LAS int*)(F.lds + LDSX + LX_TILE), (const LAS int*)(F.lds + LDSX + LX_OFF), (const LAS int*)(F.lds + LDSX + LX_ECNT), nrt, F.G, F.vcu, 4, (long)256 * 512, (long)256 * 512, (long)1024 * 512};
            pg8::Epi<pg8::EK_DOWN> E{(bf16_t*)(a->ws + WS_ARENA + AR_XS), DM, nullptr, 0, nullptr, (const int2*)(a->ws + WS_ARENA + AR_RINFO), nullptr, 1.f / (WSCALE_DN * HSCALE)};
            pg8::gemm_phase<pg8::Epi<pg8::EK_DOWN>, pg8::MoeOrder, false, true>(F.lds, F.tid, g, S, E);
        }
        END_STEP;
        if (RUN_STEP && ((PH_MASK >> 11) & 1)) for (int rep_ = 0; rep_ <= ((REP_MASK >> 11) & 1); ++rep_) { MKCTX; ln2_phase(F, a, 1, 1 == DEPTH - 1); }
        END_STEP;
    }
#undef RUN_STEP
#undef END_STEP
}

__global__ void dump_bf16(const bf16_t* src, float* dst, size_t n) { for (size_t i = (size_t)blockIdx.x * blockDim.x + threadIdx.x; i < n; i += (size_t)gridDim.x * blockDim.x) dst[i] = bf1(src[i]); }
#ifndef N_LAUNCH_MODE
#define N_LAUNCH_MODE 0
#endif
extern "C" void kernel_launch(void* const* d_in, const int* in_sizes, int n_in, void* d_out, int out_size, void* d_ws, size_t ws_size, hipStream_t stream) {
    static int grid = 0;
    if (grid == 0) {
        if (n_in != 32 || out_size != T_ * DM || ws_size < WS_END) { fprintf(stderr, "kernel_launch: unexpected problem (n_in %d out %d ws %zu)\n", n_in, out_size, ws_size); grid = -1; return; }
        int dev = 0, cus = 0, per_cu = 0;
        if (hipGetDevice(&dev) != hipSuccess || hipDeviceGetAttribute(&cus, hipDeviceAttributeMultiprocessorCount, dev) != hipSuccess) { grid = -1; return; }
        if (hipFuncSetAttribute((const void*)fwd_kernel, hipFuncAttributeMaxDynamicSharedMemorySize, LDS_TOTAL) != hipSuccess) { fprintf(stderr, "kernel_launch: hipFuncSetAttribute failed\n"); grid = -1; return; }
        if (hipOccupancyMaxActiveBlocksPerMultiprocessor(&per_cu, (const void*)fwd_kernel, 512, LDS_TOTAL) != hipSuccess || per_cu < 1)
            fprintf(stderr, "kernel_launch: occupancy query reports %d workgroups per CU\n", per_cu);
        (void)hipGetLastError();
        grid = cus;
    }
    if (grid < 0) return;
    (void)hipMemsetAsync((char*)d_ws + WS_CTL, 0, CTL_ZERO_BYTES, stream);
    Args a{};
    for (int i = 0; i < 32; ++i) a.in[i] = (const float*)d_in[i];
    a.out = (float*)d_out; a.ws = (unsigned char*)d_ws;
#if N_LAUNCH_MODE == 1
    a.lo = 0; a.hi = NSTEPS;
    hipLaunchKernelGGL(fwd_kernel, dim3(grid), dim3(512), LDS_TOTAL, stream, a);
#else
#ifdef DBG_STOP
    for (int s = 0; s <= DBG_STOP; ++s) { a.lo = s; a.hi = s + 1; hipLaunchKernelGGL(fwd_kernel, dim3(grid), dim3(512), LDS_TOTAL, stream, a); }
    hipLaunchKernelGGL(dump_bf16, dim3(1024), dim3(256), 0, stream, (const bf16_t*)((char*)d_ws + DBG_SRC), (float*)d_out, (size_t)T_ * DM);
#else
    for (int s = 0; s < NSTEPS; ++s) { a.lo = s; a.hi = s + 1; hipLaunchKernelGGL(fwd_kernel, dim3(grid), dim3(512), LDS_TOTAL, stream, a); }
#endif
#endif
}
```
